# Optimizing an MI355X kernel written in HIP

```python
import jax, jax.numpy as jnp
from jax import lax
import numpy as np

D_MODEL = 1024
BATCH = 8
SEQ = 4096
DEPTH = 2

D_A = 512
CONV_WIDTH = 3
H_B = 4
DK_B = 128
DV_B = 128
D_BK = H_B * DK_B
D_BV = H_B * DV_B
HGRN_CHUNK = 16
G_C = 4
GC_CH = 128
D_C = G_C * GC_CH
SGU_CHUNK = 128
D_FF = 2816
N_EXPERTS = 8
TOP_K = 2
D_FF_EXPERT = 2816
N_DENSE = (DEPTH + 1) // 2
N_MOE = DEPTH // 2
N_IN = 3 * D_A + 2 * D_BK + 2 * D_BV + 2 * D_C + 3 * D_MODEL
EPS = 1e-6
LB_FLOOR = 1e-30

kernel_name = "hybrid_conv_hgrn2_gmlp_moe_adaln"


def rmsnorm(x, w):
    xf = x.astype(jnp.float32)
    y = xf * lax.rsqrt(jnp.mean(xf * xf, axis=-1, keepdims=True) + EPS)
    return (y * w.astype(jnp.float32)).astype(x.dtype)


def short_conv_mixer(gate_b, gate_c, h, conv_w):
    z = gate_c * h
    seq = z.shape[1]
    zp = jnp.pad(z, ((0, 0), (CONV_WIDTH - 1, 0), (0, 0)))
    y = conv_w[0] * zp[:, CONV_WIDTH - 1:CONV_WIDTH - 1 + seq]
    for k in range(1, CONV_WIDTH):
        y = y + conv_w[k] * zp[:, CONV_WIDTH - 1 - k:CONV_WIDTH - 1 - k + seq]
    return gate_b * y


def hgrn2_mixer(q, f_raw, i, g, lb, norm_w):
    bsz, seq, _ = q.shape
    nc = seq // HGRN_CHUNK
    f32 = jnp.float32
    fr = f_raw.astype(f32)
    lb = lb.astype(f32)
    log_f = jnp.logaddexp(jnp.log(jnp.maximum(lb, LB_FLOOR)), jnp.log1p(-lb) + jax.nn.log_sigmoid(fr))
    k = (1.0 - lb) * jax.nn.sigmoid(-fr)
    qf = jax.nn.silu(q.astype(f32))
    v = i.astype(f32)

    def to_chunks(t, d):
        return t.reshape(bsz, nc, HGRN_CHUNK, H_B, d).transpose(1, 0, 3, 2, 4)

    xs = (to_chunks(qf, DK_B), to_chunks(k, DK_B), to_chunks(v, DV_B), to_chunks(log_f, DK_B))
    causal = jnp.tril(jnp.ones((HGRN_CHUNK, HGRN_CHUNK), dtype=bool))[:, :, None]

    def chunk_step(state, inp):
        qc, kc, vc, lc = inp
        b = jnp.cumsum(lc, axis=2)
        diff = b[:, :, :, None, :] - b[:, :, None, :, :]
        decay = jnp.where(causal, jnp.exp(jnp.where(causal, diff, 0.0)), 0.0)
        scores = jnp.einsum('bhtd,bhsd,bhtsd->bhts', qc, kc, decay)
        o = (jnp.einsum('bhts,bhsv->bhtv', scores, vc)
             + jnp.einsum('bhtd,bhdv->bhtv', qc * jnp.exp(b), state))
        b_last = b[:, :, -1:, :]
        new_state = (jnp.exp(b_last[:, :, 0, :])[..., None] * state
                     + jnp.einsum('bhsd,bhsv->bhdv', kc * jnp.exp(b_last - b), vc))
        return new_state, o

    state0 = jnp.zeros((bsz, H_B, DK_B, DV_B), f32)
    _, o = lax.scan(chunk_step, state0, xs)
    o = o.transpose(1, 0, 3, 2, 4).reshape(bsz, seq, H_B, DV_B)
    o = o * lax.rsqrt(jnp.mean(o * o, axis=-1, keepdims=True) + EPS) * norm_w.astype(f32).reshape(H_B, DV_B)
    o = o.reshape(bsz, seq, D_BV) * jax.nn.silu(g.astype(f32))
    return o.astype(q.dtype)


def chunked_sgu(u, v, norm_w, w_s, b_s):
    bsz, seq, _ = u.shape
    v = rmsnorm(v, norm_w)
    vg = v.reshape(bsz, seq // SGU_CHUNK, SGU_CHUNK, G_C, GC_CH)
    tril = jnp.tril(jnp.ones((SGU_CHUNK, SGU_CHUNK), dtype=w_s.dtype))
    mixed = jnp.einsum('gts,bnsgc->bntgc', w_s * tril, vg) + b_s.T[None, None, :, :, None]
    return u * mixed.reshape(bsz, seq, D_C)


def hybrid_mixer(h, lb, w_in, conv_w, hgrn_norm_w, sgu_norm_w, sgu_w, sgu_b, w_br_a, w_br_b, w_br_c, w_o):
    sizes = (D_A, D_A, D_A, D_BK, D_BK, D_BV, D_BV, D_C, D_C, D_MODEL, D_MODEL, D_MODEL)
    split_idx = np.cumsum(sizes)[:-1].tolist()
    proj = h @ w_in
    (a_b, a_c, a_h, b_q, b_f, b_i, b_g, c_u, c_v, gate_a, gate_b, gate_c) = jnp.split(proj, split_idx, axis=-1)
    y_a = short_conv_mixer(a_b, a_c, a_h, conv_w) @ w_br_a
    y_b = hgrn2_mixer(b_q, b_f, b_i, b_g, lb, hgrn_norm_w) @ w_br_b
    y_c = chunked_sgu(c_u, c_v, sgu_norm_w, sgu_w, sgu_b) @ w_br_c
    merged = jax.nn.sigmoid(gate_a) * y_a + jax.nn.sigmoid(gate_b) * y_b + jax.nn.sigmoid(gate_c) * y_c
    return merged @ w_o


def swiglu(h, w1, w3, w2):
    return (jax.nn.silu(h @ w1) * (h @ w3)) @ w2


def moe_swiglu(h, router_w, router_b, w1, w3, w2):
    logits = (h @ router_w).astype(jnp.float32) + router_b.astype(jnp.float32)
    top_v, top_i = lax.top_k(logits, TOP_K)
    top_p = jax.nn.softmax(top_v, axis=-1)
    gates = jnp.sum(jax.nn.one_hot(top_i, N_EXPERTS, dtype=jnp.float32) * top_p[..., None], axis=-2)
    gates = gates.astype(h.dtype)
    out = jnp.zeros_like(h)
    for e in range(N_EXPERTS):
        out = out + gates[..., e:e + 1] * swiglu(h, w1[e], w3[e], w2[e])
    return out


def setup_inputs(seed: int = 0) -> dict:
    key = jax.random.key(seed)
    ks = jax.random.split(key, 32)
    f32 = jnp.float32

    def nrm(k, shape, scale):
        return jax.random.normal(k, shape, f32) * scale

    return {
        "x": nrm(ks[0], (BATCH, SEQ, D_MODEL), 1.0),
        "c": nrm(ks[1], (BATCH, D_MODEL), 1.0),
        "ada_w": nrm(ks[2], (DEPTH, D_MODEL, 6 * D_MODEL), D_MODEL ** -0.5),
        "ada_b": nrm(ks[3], (DEPTH, 6 * D_MODEL), 0.02),
        "norm_mix_w": 1.0 + nrm(ks[4], (DEPTH, D_MODEL), 0.02),
        "norm_ffn_w": 1.0 + nrm(ks[5], (DEPTH, D_MODEL), 0.02),
        "w_in": nrm(ks[6], (DEPTH, D_MODEL, N_IN), D_MODEL ** -0.5),
        "conv_w": nrm(ks[7], (DEPTH, CONV_WIDTH, D_A), CONV_WIDTH ** -0.5),
        "hgrn_lb_logits": nrm(ks[8], (DEPTH, D_BK), 0.5),
        "hgrn_norm_w": 1.0 + nrm(ks[9], (DEPTH, D_BV), 0.02),
        "sgu_norm_w": 1.0 + nrm(ks[10], (DEPTH, D_C), 0.02),
        "sgu_w": nrm(ks[11], (DEPTH, G_C, SGU_CHUNK, SGU_CHUNK), SGU_CHUNK ** -0.5),
        "sgu_b": 1.0 + nrm(ks[12], (DEPTH, G_C, SGU_CHUNK), 0.1),
        "w_br_a": nrm(ks[13], (DEPTH, D_A, D_MODEL), D_A ** -0.5),
        "w_br_b": nrm(ks[14], (DEPTH, D_BV, D_MODEL), D_BV ** -0.5),
        "w_br_c": nrm(ks[15], (DEPTH, D_C, D_MODEL), D_C ** -0.5),
        "w_o": nrm(ks[16], (DEPTH, D_MODEL, D_MODEL), D_MODEL ** -0.5),
        "ffn_w1": nrm(ks[17], (N_DENSE, D_MODEL, D_FF), D_MODEL ** -0.5),
        "ffn_w3": nrm(ks[18], (N_DENSE, D_MODEL, D_FF), D_MODEL ** -0.5),
        "ffn_w2": nrm(ks[19], (N_DENSE, D_FF, D_MODEL), D_FF ** -0.5),
        "moe_router_w": nrm(ks[20], (N_MOE, D_MODEL, N_EXPERTS), D_MODEL ** -0.5),
        "moe_router_b": nrm(ks[21], (N_MOE, N_EXPERTS), 0.01),
        "moe_w1": nrm(ks[22], (N_MOE, N_EXPERTS, D_MODEL, D_FF_EXPERT), D_MODEL ** -0.5),
        "moe_w3": nrm(ks[23], (N_MOE, N_EXPERTS, D_MODEL, D_FF_EXPERT), D_MODEL ** -0.5),
        "moe_w2": nrm(ks[24], (N_MOE, N_EXPERTS, D_FF_EXPERT, D_MODEL), D_FF_EXPERT ** -0.5),
        "final_norm_w": 1.0 + nrm(ks[25], (D_MODEL,), 0.02),
    }


def reference(x, c, ada_w, ada_b, norm_mix_w, norm_ffn_w, w_in, conv_w, hgrn_lb_logits, hgrn_norm_w,
              sgu_norm_w, sgu_w, sgu_b, w_br_a, w_br_b, w_br_c, w_o, ffn_w1, ffn_w3, ffn_w2,
              moe_router_w, moe_router_b, moe_w1, moe_w3, moe_w2, final_norm_w):
    p = jax.nn.softmax(hgrn_lb_logits.astype(jnp.float32), axis=0)
    lb_all = jnp.clip(jnp.cumsum(p, axis=0) - p[0:1], 0.0, 1.0)
    c_act = jax.nn.silu(c)
    for l in range(DEPTH):
        mod = (c_act @ ada_w[l] + ada_b[l])[:, None, :]
        sh1, sc1, g1, sh2, sc2, g2 = jnp.split(mod, 6, axis=-1)
        h = rmsnorm(x, norm_mix_w[l]) * (1.0 + sc1) + sh1
        x = x + g1 * hybrid_mixer(h, lb_all[l], w_in[l], conv_w[l], hgrn_norm_w[l], sgu_norm_w[l], sgu_w[l],
                                  sgu_b[l], w_br_a[l], w_br_b[l], w_br_c[l], w_o[l])
        h = rmsnorm(x, norm_ffn_w[l]) * (1.0 + sc2) + sh2
        j = l // 2
        if l % 2 == 0:
            ffn = swiglu(h, ffn_w1[j], ffn_w3[j], ffn_w2[j])
        else:
            ffn = moe_swiglu(h, moe_router_w[j], moe_router_b[j], moe_w1[j], moe_w3[j], moe_w2[j])
        x = x + g2 * ffn
    return rmsnorm(x, final_norm_w)
```

```cpp
#include <hip/hip_runtime.h>
#include <cstdio>
#include <cstdint>

#ifndef MK_PER_PHASE
#define MK_PER_PHASE 0
#endif

namespace pg8 {
#define PG8_LAS __attribute__((address_space(3)))
typedef unsigned short bf16_t;
typedef short bf16x8 __attribute__((ext_vector_type(8)));
typedef float f32x4 __attribute__((ext_vector_type(4)));
typedef unsigned u32x4 __attribute__((ext_vector_type(4)));
constexpr int BM = 256, BK = 64, HALF = 128, HTB = HALF * BK * 2, STAGE_BYTES = 8 * HTB, NXCD = 8, WGM = 8;

__host__ __device__ __forceinline__ int lds_byte(int r, int c) { const int st = (r >> 4) * 2 + (c >> 5), rr = r & 15, cc = c & 31, ob = rr * 64 + cc * 2; return st * 1024 + (ob ^ (((ob >> 9) & 1) << 5)); }
__host__ __device__ __forceinline__ void stage_rc(int b, int& R, int& C) { const int st = b / 1024, sb = b % 1024, swz = sb ^ (((sb >> 9) & 1) << 5); R = (st >> 1) * 16 + swz / 64; C = (st & 1) * 32 + (swz % 64) / 2; }
__host__ __device__ __forceinline__ int perm32(int rho) { const int n = rho >> 4, i = rho & 15; return 8 * (i >> 2) + 4 * n + (i & 3); }

struct Unit { int pm, pn, pb; };
struct Gemm { const bf16_t* A; const bf16_t* Bt; int lda, ldb, K; };

struct StaticOrder {
    static constexpr bool GATHER = false;
    int nM, nN, nwg, G, c;
    __device__ __forceinline__ void init(int nM_, int nN_, int G_, int c_) { nM = nM_; nN = nN_; nwg = nM * nN; G = G_; c = c_; }
    __device__ __forceinline__ bool next(int i, Unit& u) const {
        const long L = (long)i * G + c; if (L >= nwg) return false;
        int wgid = (int)L; { const int q = nwg / NXCD, r = nwg % NXCD, xcd = wgid % NXCD, off = wgid / NXCD; wgid = (xcd < r ? xcd * (q + 1) : r * (q + 1) + (xcd - r) * q) + off; }
        const int nig = WGM * nN, gid = wgid / nig, fm = gid * WGM, gsz = (nM - fm) < WGM ? (nM - fm) : WGM;
        u.pm = fm + ((wgid % nig) % gsz); u.pn = (wgid % nig) / gsz; u.pb = u.pn; return true;
    }
    __device__ __forceinline__ unsigned a_row_off(const Unit&, int) const { return 0u; }
};

__device__ __forceinline__ unsigned cvt_pk_bf16(float lo, float hi) { unsigned r; asm volatile("v_cvt_pk_bf16_f32 %0, %1, %2" : "=v"(r) : "v"(lo), "v"(hi)); return r; }

struct EpiBf16 {
    static constexpr bool PERM = true;
    bf16_t* O; int ldc;
    __device__ __forceinline__ void operator()(const f32x4 (&acc)[2][2][4][2], const Unit& u, int wr, int wc, int fr, int fq) const {
        const int row0 = u.pm * BM + wr * 64 + fr, col0 = u.pn * BM + wc * 32 + 8 * fq;
#pragma unroll
        for (int ai = 0; ai < 2; ++ai)
#pragma unroll
            for (int m = 0; m < 4; ++m) { bf16_t* rowp = O + (size_t)(row0 + ai * HALF + m * 16) * ldc + col0;
#pragma unroll
                for (int bj = 0; bj < 2; ++bj) { const f32x4 v0 = acc[ai][bj][m][0], v1 = acc[ai][bj][m][1];
                    u32x4 w; w.x = cvt_pk_bf16(v0[0], v0[1]); w.y = cvt_pk_bf16(v0[2], v0[3]); w.z = cvt_pk_bf16(v1[0], v1[1]); w.w = cvt_pk_bf16(v1[2], v1[3]);
                    *(u32x4*)(rowp + bj * HALF) = w; } }
    }
};

template <class Epi, class Sched>
__device__ __forceinline__ void gemm_phase(PG8_LAS unsigned char* lds, const Gemm g, const Sched& S, const Epi& E) {
    constexpr bool GATHER = Sched::GATHER;
    int tid_ = threadIdx.x; asm volatile("" : "+v"(tid_));
    const int tid = tid_, wid = __builtin_amdgcn_readfirstlane(tid >> 6), lane = tid & 63, wr = wid >> 2, wc = wid & 3, fr = lane & 15, fq = lane >> 4;
    const int K = g.K, nt = K / BK;
    unsigned voffB[2], vA0[2], vA1[2], nA0[2], nA1[2];
#pragma unroll
    for (int i = 0; i < 2; ++i) { int R, C; stage_rc(tid * 16 + i * 8192, R, C); const int Rb = Epi::PERM ? ((R & ~31) + perm32(R & 31)) : R;
        voffB[i] = (unsigned)(Rb * g.ldb + C) * 2u;
        vA0[i] = (unsigned)(R * g.lda + C) * 2u; vA1[i] = vA0[i]; nA0[i] = vA0[i]; nA1[i] = vA0[i]; }
    const size_t kstep = (size_t)(BK * 2);
    const size_t hstepB = (size_t)HALF * g.ldb * 2, tstepB = 2 * hstepB, tstepA = (size_t)BM * g.lda * 2;
    const size_t hstepA = GATHER ? (size_t)0 : (size_t)HALF * g.lda * 2;
    const unsigned ldsw = (unsigned)wid * 1024u;
    const int aoff = lds_byte(wr * 64 + fr, fq * 8), boff = lds_byte(wc * 32 + fr, fq * 8);
#define PG8_SA(b, h) (((b) * 2 + (h)) * HTB)
#define PG8_SB(b, h) ((4 + (b) * 2 + (h)) * HTB)
#define PG8_STAGE(bufoff, gbase, voff) do { _Pragma("unroll") for (int _i = 0; _i < 2; ++_i) \
        __builtin_amdgcn_global_load_lds((const unsigned*)((const char*)(gbase) + (voff)[_i]), (PG8_LAS unsigned*)(lds + (bufoff) + ldsw + _i * 8192), 16, 0, 0); } while (0)
#define PG8_LDA(dst, b, h) do { _Pragma("unroll") for (int m = 0; m < 4; ++m) _Pragma("unroll") for (int k = 0; k < 2; ++k) dst[m][k] = *(const PG8_LAS bf16x8*)(lds + PG8_SA(b, h) + aoff + m * 2048 + k * 1024); } while (0)
#define PG8_LDB(dst, b, h) do { _Pragma("unroll") for (int n = 0; n < 2; ++n) _Pragma("unroll") for (int k = 0; k < 2; ++k) dst[n][k] = *(const PG8_LAS bf16x8*)(lds + PG8_SB(b, h) + boff + n * 2048 + k * 1024); } while (0)
#define PG8_MMA(ai, bj, At, Bt) do { __builtin_amdgcn_s_setprio(1); _Pragma("unroll") for (int m = 0; m < 4; ++m) _Pragma("unroll") for (int n = 0; n < 2; ++n) _Pragma("unroll") for (int k = 0; k < 2; ++k) \
        acc[ai][bj][m][n] = __builtin_amdgcn_mfma_f32_16x16x32_bf16(Bt[n][k], At[m][k], acc[ai][bj][m][n], 0, 0, 0); __builtin_amdgcn_s_setprio(0); } while (0)
#define PG8_WAIT_V(n) asm volatile("s_waitcnt vmcnt(" #n ")" ::: "memory")
#define PG8_WAIT_L(n) asm volatile("s_waitcnt lgkmcnt(" #n ")" ::: "memory")
#define PG8_BAR __builtin_amdgcn_s_barrier()
#define PG8_SCHED __builtin_amdgcn_sched_barrier(0)
#define PG8_GOFF(unit, d0, d1) do { _Pragma("unroll") for (int _i = 0; _i < 2; ++_i) { int R_, C_; stage_rc(tid * 16 + _i * 8192, R_, C_); \
        d0[_i] = S.a_row_off(unit, R_) + (unsigned)C_ * 2u; d1[_i] = S.a_row_off(unit, R_ + HALF) + (unsigned)C_ * 2u; } } while (0)
    Unit cur, nxt; int ui = 0;
    if (!S.next(0, cur)) return;
    f32x4 acc[2][2][4][2];
#pragma unroll
    for (int a = 0; a < 2; ++a)
#pragma unroll
        for (int b = 0; b < 2; ++b)
#pragma unroll
            for (int m = 0; m < 4; ++m)
#pragma unroll
                for (int n = 0; n < 2; ++n) acc[a][b][m][n] = (f32x4){0.f, 0.f, 0.f, 0.f};
    bf16x8 At[4][2], B0[2][2], B1[2][2];
    if constexpr (GATHER) { PG8_GOFF(cur, vA0, vA1); }
    const char* cA = GATHER ? (const char*)g.A : (const char*)g.A + (size_t)cur.pm * tstepA; const char* cB = (const char*)g.Bt + (size_t)cur.pb * tstepB;
    PG8_STAGE(PG8_SB(0, 0), cB, voffB); PG8_STAGE(PG8_SB(0, 1), cB + hstepB, voffB); PG8_STAGE(PG8_SA(0, 0), cA, vA0); PG8_STAGE(PG8_SA(0, 1), cA + hstepA, vA1);
    if (wr == 1) PG8_BAR;
    PG8_WAIT_V(2); PG8_BAR;
    PG8_STAGE(PG8_SB(1, 0), cB + kstep, voffB); PG8_STAGE(PG8_SA(1, 0), cA + kstep, vA0); PG8_STAGE(PG8_SB(1, 1), cB + hstepB + kstep, voffB);
    PG8_WAIT_V(6); PG8_BAR;
    for (;;) {
        const bool has_next = S.next(ui + 1, nxt);
        const char* nA = GATHER ? (const char*)g.A : (has_next ? (const char*)g.A + (size_t)nxt.pm * tstepA : cA); const char* nB = has_next ? (const char*)g.Bt + (size_t)nxt.pb * tstepB : cB;
        if constexpr (GATHER) { if (has_next) { PG8_GOFF(nxt, nA0, nA1); } else {
#pragma unroll
            for (int i = 0; i < 2; ++i) { nA0[i] = vA0[i]; nA1[i] = vA1[i]; } } }
        for (int t = 0; t < nt; t += 2) {
            const bool last = (t == nt - 2);
            const char* a1 = cA + (size_t)(t + 1) * kstep;
            const char* a2 = last ? nA : cA + (size_t)(t + 2) * kstep; const char* b2 = last ? nB : cB + (size_t)(t + 2) * kstep;
            const char* a3 = a2 + kstep; const char* b3 = b2 + kstep;
            unsigned s0[2], s1[2];
#pragma unroll
            for (int i = 0; i < 2; ++i) { s0[i] = (GATHER && last) ? nA0[i] : vA0[i]; s1[i] = GATHER ? (last ? nA1[i] : vA1[i]) : vA0[i]; }
            PG8_LDB(B0, 0, 0); PG8_LDB(B1, 0, 1); PG8_SCHED; PG8_LDA(At, 0, 0); PG8_STAGE(PG8_SA(1, 1), a1 + hstepA, vA1);
            PG8_WAIT_V(8); PG8_WAIT_L(0); PG8_BAR; PG8_MMA(0, 0, At, B0); PG8_MMA(0, 1, At, B1); PG8_BAR; PG8_SCHED;
            PG8_LDA(At, 0, 1); PG8_STAGE(PG8_SB(0, 0), b2, voffB); PG8_STAGE(PG8_SB(0, 1), b2 + hstepB, voffB); PG8_STAGE(PG8_SA(0, 0), a2, s0);
            PG8_WAIT_V(8); PG8_WAIT_L(0); PG8_BAR; PG8_MMA(1, 0, At, B0); PG8_MMA(1, 1, At, B1); PG8_BAR; PG8_SCHED;
            PG8_LDB(B0, 1, 0); PG8_LDB(B1, 1, 1); PG8_SCHED; PG8_LDA(At, 1, 0); PG8_STAGE(PG8_SA(0, 1), a2 + hstepA, s1);
            PG8_WAIT_V(8); PG8_WAIT_L(0); PG8_BAR; PG8_MMA(0, 0, At, B0); PG8_MMA(0, 1, At, B1); PG8_BAR; PG8_SCHED;
            PG8_LDA(At, 1, 1); PG8_STAGE(PG8_SB(1, 0), b3, voffB); PG8_STAGE(PG8_SB(1, 1), b3 + hstepB, voffB); PG8_STAGE(PG8_SA(1, 0), a3, s0);
            PG8_WAIT_V(8); PG8_WAIT_L(0); PG8_BAR; PG8_MMA(1, 0, At, B0); PG8_MMA(1, 1, At, B1); PG8_BAR; PG8_SCHED;
        }
        if (wr == 0) PG8_BAR;
        E(acc, cur, wr, wc, fr, fq);
        if (!has_next) break;
#pragma unroll
        for (int a = 0; a < 2; ++a)
#pragma unroll
            for (int b = 0; b < 2; ++b)
#pragma unroll
                for (int m = 0; m < 4; ++m)
#pragma unroll
                    for (int n = 0; n < 2; ++n) acc[a][b][m][n] = (f32x4){0.f, 0.f, 0.f, 0.f};
        cur = nxt; cA = nA; cB = nB; ++ui;
        if constexpr (GATHER) {
#pragma unroll
            for (int i = 0; i < 2; ++i) { vA0[i] = nA0[i]; vA1[i] = nA1[i]; } }
        if (wr == 1) PG8_BAR;
    }
    PG8_WAIT_V(0);
    PG8_BAR;
#undef PG8_SA
#undef PG8_SB
#undef PG8_STAGE
#undef PG8_LDA
#undef PG8_LDB
#undef PG8_MMA
#undef PG8_WAIT_V
#undef PG8_WAIT_L
#undef PG8_BAR
#undef PG8_SCHED
#undef PG8_GOFF
}
}

constexpr int D = 1024, BATCH = 8, SEQ = 4096, M = BATCH * SEQ, DEPTH = 2;
constexpr int D_A = 512, D_BK = 512, D_BV = 512, D_C = 512, H_B = 4;
constexpr int N_IN = 7680, N_BCA = 4608, N_G = 3072;
constexpr int D_FF = 2816, NE = 8, N13 = 2 * D_FF;
constexpr int MOD_LD = 6 * D;
constexpr float EPS = 1e-6f;
constexpr int LIST_CAP = M;
constexpr int MOE_ROWS = M + NE * 256;

constexpr size_t MiB = 1u << 20;
constexpr size_t WS_CTL = 0, CTL_ZERO_BYTES = 1 * MiB;
constexpr size_t WS_MOD = 1 * MiB;
constexpr size_t WS_TOPP = 2 * MiB;
constexpr size_t WS_LIST = 3 * MiB;
constexpr size_t WS_WMIX = 6 * MiB, WMIX_STRIDE = 20 * MiB;
constexpr size_t WS_W13 = 46 * MiB, WS_W2 = 57 * MiB;
constexpr size_t WS_BIG = 64 * MiB;
constexpr size_t WS_H = WS_BIG;
constexpr size_t WS_P1 = WS_BIG + 64 * MiB;
constexpr size_t WS_PG = WS_P1;
constexpr size_t WS_MRG = WS_P1 + 192 * MiB;
constexpr size_t WS_YA = WS_P1 + 288 * MiB, WS_YB = WS_YA + 32 * MiB, WS_YC = WS_YB + 32 * MiB;
constexpr size_t WS_ACT = WS_P1;
constexpr size_t WS_MIX_END = WS_YC + 32 * MiB;
constexpr size_t WS_WM13 = 6 * MiB;
constexpr size_t WS_WM2 = WS_WM13 + 88 * MiB;
constexpr size_t WS_H2M = WS_WM2 + 44 * MiB;
constexpr size_t WS_ACTM = WS_H2M + 64 * MiB;
constexpr size_t WS_MOE_END = WS_ACTM + (size_t)MOE_ROWS * D_FF * 2;
constexpr size_t WS_NEED = WS_MIX_END > WS_MOE_END ? WS_MIX_END : WS_MOE_END;
static_assert(WS_W2 + (size_t)D * D_FF * 2 <= WS_BIG && WS_WMIX + 2 * WMIX_STRIDE <= WS_W13, "ws map");
constexpr int CW_BAR = 4096;
constexpr int CW_CNT = 16384;

constexpr int LDS_BYTES = 147456;
constexpr int SCR_BYTES = 139264;
constexpr int TAB_OFF = SCR_BYTES;
constexpr int MISC_OFF = TAB_OFF + 4096;
static_assert(MISC_OFF + 128 <= LDS_BYTES, "LDS map");
constexpr int NWAVES = 8, NT = 512;

#define GAS __attribute__((address_space(1)))
#define LAS __attribute__((address_space(3)))
typedef unsigned short bf16;
typedef unsigned v4u __attribute__((ext_vector_type(4)));
typedef float f32x4 __attribute__((ext_vector_type(4)));
#define LDS_WAIT() asm volatile("s_waitcnt lgkmcnt(0)" ::: "memory")

__device__ __forceinline__ unsigned pk2(float lo, float hi) { return pg8::cvt_pk_bf16(lo, hi); }
__device__ __forceinline__ float bf_lo(unsigned u) { return __uint_as_float(u << 16); }
__device__ __forceinline__ float bf_hi(unsigned u) { return __uint_as_float(u & 0xffff0000u); }
__device__ __forceinline__ void unpack8(const v4u w, float (&f)[8]) { f[0] = bf_lo(w.x); f[1] = bf_hi(w.x); f[2] = bf_lo(w.y); f[3] = bf_hi(w.y); f[4] = bf_lo(w.z); f[5] = bf_hi(w.z); f[6] = bf_lo(w.w); f[7] = bf_hi(w.w); }
__device__ __forceinline__ v4u pack8(const float (&f)[8]) { v4u w; w.x = pk2(f[0], f[1]); w.y = pk2(f[2], f[3]); w.z = pk2(f[4], f[5]); w.w = pk2(f[6], f[7]); return w; }
__device__ __forceinline__ float sigmoidf_(float x) { return __builtin_amdgcn_rcpf(1.0f + __expf(-x)); }
__device__ __forceinline__ float siluf_(float x) { return x * sigmoidf_(x); }
__device__ __forceinline__ float wave_sum(float v) {
#pragma unroll
    for (int o = 1; o < 64; o <<= 1) v += __shfl_xor(v, o);
    return v;
}

#define XB_TMO      128
#define XB_XCNT(j)  (256  + 64 * (j))
#define XB_XSUB(j)  (1280 + 64 * (j))
#define XB_XGEN(j)  (2304 + 64 * (j))
#define XB_TOP      3328
#define XB_TOPGEN   3392
#define XCD_BAR_WORDS 3456
#define XB_SPIN_CAP (1u << 18)

__device__ __forceinline__ unsigned xb_ld(unsigned* p)              { return __hip_atomic_load(p, __ATOMIC_RELAXED, __HIP_MEMORY_SCOPE_AGENT); }
__device__ __forceinline__ unsigned xb_add(unsigned* p, unsigned v) { return __hip_atomic_fetch_add(p, v, __ATOMIC_RELAXED, __HIP_MEMORY_SCOPE_AGENT); }
__device__ __forceinline__ unsigned xb_xcc_id() { return (unsigned)__builtin_amdgcn_s_getreg((3 << 11) | 20) & 0xFu; }
#define XB_SPIN(cond, bar) do { unsigned _sp = 0; while (cond) { __builtin_amdgcn_s_sleep(1); \
    if ((++_sp & 255u) == 0u) { if (xb_ld(&(bar)[XB_TMO])) break; if (_sp > XB_SPIN_CAP) { atomicAdd(&(bar)[XB_TMO], 1u); break; } } } } while (0)

struct XcdBarrier { unsigned* bar; unsigned x; volatile LAS unsigned* st; };

__device__ __forceinline__ XcdBarrier xcd_barrier_post(unsigned* bar, volatile LAS unsigned* st) {
    XcdBarrier b; b.bar = bar; b.x = xb_xcc_id(); b.st = st;
    if (threadIdx.x == 0) (void)xb_add(&bar[XB_XCNT(b.x)], 1u);
    return b;
}
__device__ __forceinline__ void xcd_barrier_complete(unsigned* bar, unsigned x, unsigned& nloc, unsigned& nx) {
    const unsigned G = gridDim.x * gridDim.y * gridDim.z;
    unsigned sum, cnt, mine, sp = 0u;
    for (;;) {
        sum = 0u; cnt = 0u; mine = 0u;
#pragma unroll
        for (unsigned j = 0; j < 16; ++j) { const unsigned c = xb_ld(&bar[XB_XCNT(j)]); sum += c; cnt += (c > 0u) ? 1u : 0u; mine = (j == x) ? c : mine; }
        if (sum == G) break;
        __builtin_amdgcn_s_sleep(1);
        if ((++sp & 255u) == 0u) { if (xb_ld(&bar[XB_TMO])) break; if (sp > XB_SPIN_CAP) { atomicAdd(&bar[XB_TMO], 1u); break; } }
    }
    nloc = mine > 0u ? mine : 1u; nx = cnt > 0u ? cnt : 1u;
}
__device__ __forceinline__ void xcd_barrier(const XcdBarrier& b) {
    asm volatile("s_waitcnt vmcnt(0)" ::: "memory");
    __syncthreads();
    if (threadIdx.x == 0) {
        unsigned* bar = b.bar;
        __builtin_amdgcn_s_waitcnt(0);
        unsigned nloc = b.st[0], nx = b.st[1];
        if (nloc == 0u) { xcd_barrier_complete(bar, b.x, nloc, nx); b.st[0] = nloc; b.st[1] = nx; }
        const unsigned old = xb_add(&bar[XB_XSUB(b.x)], 1u);
        const unsigned gen = old / nloc;
        if (old + 1u == (gen + 1u) * nloc) {
            __builtin_amdgcn_fence(__ATOMIC_RELEASE, "agent");
            asm volatile("s_waitcnt vmcnt(0)" ::: "memory");
            const unsigned og = xb_add(&bar[XB_TOP], 1u);
            const unsigned tg = og / nx;
            if (og + 1u == (tg + 1u) * nx) xb_add(&bar[XB_TOPGEN], 1u);
            else XB_SPIN(xb_ld(&bar[XB_TOPGEN]) == tg, bar);
            __builtin_amdgcn_fence(__ATOMIC_ACQUIRE, "agent");
            xb_add(&bar[XB_XGEN(b.x)], 1u);
            asm volatile("s_waitcnt vmcnt(0)" ::: "memory");
        } else {
            XB_SPIN(xb_ld(&bar[XB_XGEN(b.x)]) == gen, bar);
            __builtin_amdgcn_fence(__ATOMIC_ACQUIRE, "agent");
            asm volatile("s_waitcnt vmcnt(0)" ::: "memory");
        }
    }
    __syncthreads();
}

struct Args { const float* in[26]; float* out; unsigned char* ws; int ph_lo, ph_hi; };
typedef const Args __attribute__((address_space(4)))* KArgs;
#define KA() ({ KArgs p_ = (KArgs)__builtin_amdgcn_kernarg_segment_ptr(); asm volatile("" : "+s"(p_)); p_; })
struct Frame {
    LAS unsigned char* lds;
    int tid, lane, wave, G, bid;
};

template <int MAP>
__device__ __forceinline__ void transpose_item(const float* W, int K, int N, bf16* WT, int row_off, LAS float* scr, int item, int lane) {
    const int nblk = N / 32, kb = item / nblk, nb = item % nblk, k0 = 64 * kb, n0 = 32 * nb;
#pragma unroll 8
    for (int i = 0; i < 32; ++i) { const int kk = 2 * i + (lane >> 5); scr[kk * 33 + (lane & 31)] = W[(size_t)(k0 + kk) * N + n0 + (lane & 31)]; }
    LDS_WAIT(); asm volatile("" ::: "memory");
    const int c = lane & 7;
#pragma unroll
    for (int j = 0; j < 4; ++j) { const int n = (lane >> 3) + 8 * j; const LAS float* s = scr + (8 * c) * 33 + n;
        v4u o; o.x = pk2(s[0 * 33], s[1 * 33]); o.y = pk2(s[2 * 33], s[3 * 33]); o.z = pk2(s[4 * 33], s[5 * 33]); o.w = pk2(s[6 * 33], s[7 * 33]);
        const int nn = n0 + n; const int row = (MAP == 0) ? (row_off + nn) : ((nn >> 7) * 256 + row_off + (nn & 127));
        *(v4u*)(WT + (size_t)row * K + k0 + 8 * c) = o; }
    LDS_WAIT(); asm volatile("" ::: "memory");
}

__device__ __forceinline__ void p_prologue(Frame& F, KArgs ka) {
    const float* c = ka->in[1]; const float* ada_w = ka->in[2]; const float* ada_b = ka->in[3];
    unsigned char* aws = ka->ws; float* mod = (float*)(aws + WS_MOD);
    LAS float* cact = (LAS float*)F.lds;
    LAS float* red = cact + 8192;
    for (int i = F.tid; i < BATCH * D; i += NT) cact[i] = siluf_(c[i]);
    __syncthreads();
    for (int chunk = F.bid; chunk < 256; chunk += F.G) {
        const int l = chunk >> 7, n0 = (chunk & 127) * 48;
        if (F.tid < 480) {
            const int kg = F.tid / 48, col = F.tid % 48;
            float acc[8];
#pragma unroll
            for (int b = 0; b < 8; ++b) acc[b] = 0.f;
            const float* wp = ada_w + (size_t)l * D * MOD_LD + n0 + col;
            for (int k = kg; k < D; k += 10) { const float w = wp[(size_t)k * MOD_LD];
#pragma unroll
                for (int b = 0; b < 8; ++b) acc[b] += cact[b * D + k] * w; }
#pragma unroll
            for (int b = 0; b < 8; ++b) red[(kg * 48 + col) * 8 + b] = acc[b];
        }
        __syncthreads();
        if (F.tid < 384) {
            const int col = F.tid >> 3, b = F.tid & 7; float s = 0.f;
#pragma unroll
            for (int kg = 0; kg < 10; ++kg) s += red[(kg * 48 + col) * 8 + b];
            mod[(size_t)(l * 8 + b) * MOD_LD + n0 + col] = s + ada_b[l * MOD_LD + n0 + col];
        }
        __syncthreads();
    }
    LAS float* scr = (LAS float*)(F.lds + F.wave * 16384);
    const int gw = F.bid * NWAVES + F.wave, NGW = F.G * NWAVES;
    constexpr int I_IN = (D / 64) * (N_IN / 32), I_BR = (512 / 64) * (D / 32), I_O = (D / 64) * (D / 32), I_L = I_IN + 3 * I_BR + I_O;
    constexpr int I_F1 = (D / 64) * (D_FF / 32), I_F2 = (D_FF / 64) * (D / 32);
    constexpr int NITEMS = 2 * I_L + 2 * I_F1 + I_F2;
    for (int it = gw; it < NITEMS; it += NGW) {
        int r = it;
        if (r < 2 * I_L) {
            const int l = r / I_L; r -= l * I_L;
            bf16* base = (bf16*)(aws + WS_WMIX + (size_t)l * WMIX_STRIDE);
            if (r < I_IN) { transpose_item<0>(ka->in[6] + (size_t)l * D * N_IN, D, N_IN, base, 0, scr, r, F.lane); continue; } r -= I_IN;
            if (r < I_BR) { transpose_item<0>(ka->in[13] + (size_t)l * 512 * D, 512, D, base + (size_t)N_IN * D, 0, scr, r, F.lane); continue; } r -= I_BR;
            if (r < I_BR) { transpose_item<0>(ka->in[14] + (size_t)l * 512 * D, 512, D, base + (size_t)N_IN * D + 512 * 1024, 0, scr, r, F.lane); continue; } r -= I_BR;
            if (r < I_BR) { transpose_item<0>(ka->in[15] + (size_t)l * 512 * D, 512, D, base + (size_t)N_IN * D + 2 * 512 * 1024, 0, scr, r, F.lane); continue; } r -= I_BR;
            transpose_item<0>(ka->in[16] + (size_t)l * D * D, D, D, base + (size_t)N_IN * D + 3 * 512 * 1024, 0, scr, r, F.lane); continue;
        }
        r -= 2 * I_L;
        if (r < I_F1) { transpose_item<1>(ka->in[17], D, D_FF, (bf16*)(aws + WS_W13), 0, scr, r, F.lane); continue; } r -= I_F1;
        if (r < I_F1) { transpose_item<1>(ka->in[18], D, D_FF, (bf16*)(aws + WS_W13), 128, scr, r, F.lane); continue; } r -= I_F1;
        transpose_item<0>(ka->in[19], D_FF, D, (bf16*)(aws + WS_W2), 0, scr, r, F.lane);
    }
}
__device__ __forceinline__ void p_moe_weights(Frame& F, KArgs ka) {
    unsigned char* aws = ka->ws;
    LAS float* scr = (LAS float*)(F.lds + F.wave * 16384);
    const int gw = F.bid * NWAVES + F.wave, NGW = F.G * NWAVES;
    constexpr int I_F1 = (D / 64) * (D_FF / 32), I_F2 = (D_FF / 64) * (D / 32), I_E = 2 * I_F1 + I_F2;
    for (int it = gw; it < NE * I_E; it += NGW) {
        const int e = it / I_E; int r = it - e * I_E;
        bf16* w13 = (bf16*)(aws + WS_WM13) + (size_t)e * N13 * D; bf16* w2 = (bf16*)(aws + WS_WM2) + (size_t)e * D * D_FF;
        if (r < I_F1) { transpose_item<1>(ka->in[22] + (size_t)e * D * D_FF, D, D_FF, w13, 0, scr, r, F.lane); continue; } r -= I_F1;
        if (r < I_F1) { transpose_item<1>(ka->in[23] + (size_t)e * D * D_FF, D, D_FF, w13, 128, scr, r, F.lane); continue; } r -= I_F1;
        transpose_item<0>(ka->in[24] + (size_t)e * D_FF * D, D_FF, D, w2, 0, scr, r, F.lane);
    }
}

__device__ __forceinline__ void norm_row(const float* xrow, const float* w, const float* sc, const float* sh, int lane, f32x4 (&o)[4]) {
    const f32x4* xr = (const f32x4*)xrow + lane;
    f32x4 v[4]; float s = 0.f;
#pragma unroll
    for (int j = 0; j < 4; ++j) { v[j] = xr[64 * j]; s += (v[j].x * v[j].x + v[j].y * v[j].y) + (v[j].z * v[j].z + v[j].w * v[j].w); }
    const float rstd = 1.0f / sqrtf(wave_sum(s) * (1.0f / D) + EPS);
#pragma unroll
    for (int j = 0; j < 4; ++j) { const f32x4 wv = ((const f32x4*)w)[lane + 64 * j], scv = ((const f32x4*)sc)[lane + 64 * j], shv = ((const f32x4*)sh)[lane + 64 * j];
        o[j] = v[j] * rstd * wv * (scv + 1.0f) + shv; }
}
__device__ __forceinline__ void store_row_bf16(bf16* orow, int lane, const f32x4 (&o)[4]) {
    unsigned long long* o8 = (unsigned long long*)orow + lane;
#pragma unroll
    for (int j = 0; j < 4; ++j) o8[64 * j] = (unsigned long long)pk2(o[j].x, o[j].y) | ((unsigned long long)pk2(o[j].z, o[j].w) << 32);
}
__device__ __forceinline__ void p_norm(Frame& F, const float* xin, const float* w, const float* mod_l, int sc_off, int sh_off, bf16* hout) {
    const int gw = F.bid * NWAVES + F.wave, NGW = F.G * NWAVES;
    for (int row = gw; row < M; row += NGW) {
        const float* mb = mod_l + (size_t)(row >> 12) * MOD_LD;
        f32x4 o[4]; norm_row(xin + (size_t)row * D, w, mb + sc_off, mb + sh_off, F.lane, o);
        store_row_bf16(hout + (size_t)row * D, F.lane, o);
    }
}

__device__ __forceinline__ void p_conv(Frame& F, const bf16* P1, const float* conv_w, bf16* ya) {
    const int gt = F.bid * NT + F.tid, NGT = F.G * NT;
    for (int it = gt; it < M * 64; it += NGT) {
        const int row = it >> 6, c8 = (it & 63) * 8, pos = row & (SEQ - 1);
        const bf16* p = P1 + (size_t)row * N_BCA + c8;
        float ab[8], ac[8], ah[8], z1[8], z2[8], y[8];
        unpack8(*(const v4u*)p, ab); unpack8(*(const v4u*)(p + 512), ac); unpack8(*(const v4u*)(p + 1024), ah);
#pragma unroll
        for (int i = 0; i < 8; ++i) { z1[i] = 0.f; z2[i] = 0.f; }
        if (pos >= 1) { float c1[8], h1[8]; unpack8(*(const v4u*)(p - N_BCA + 512), c1); unpack8(*(const v4u*)(p - N_BCA + 1024), h1);
#pragma unroll
            for (int i = 0; i < 8; ++i) z1[i] = c1[i] * h1[i]; }
        if (pos >= 2) { float c2[8], h2[8]; unpack8(*(const v4u*)(p - 2 * N_BCA + 512), c2); unpack8(*(const v4u*)(p - 2 * N_BCA + 1024), h2);
#pragma unroll
            for (int i = 0; i < 8; ++i) z2[i] = c2[i] * h2[i]; }
#pragma unroll
        for (int i = 0; i < 8; ++i) y[i] = ab[i] * (conv_w[c8 + i] * (ac[i] * ah[i]) + conv_w[512 + c8 + i] * z1[i] + conv_w[1024 + c8 + i] * z2[i]);
        *(v4u*)(ya + (size_t)row * 512 + c8) = pack8(y);
    }
}

__device__ __forceinline__ void p_sgu(Frame& F, const bf16* P1, const float* norm_w, const float* sgu_w, const float* sgu_b, bf16* yc) {
    LAS float* V = (LAS float*)F.lds;
    LAS float* Wl = V + 128 * 128;
    LAS float* rstd = Wl + 128 * 129;
    for (int u = F.bid; u < 1024; u += F.G) {
        const int n = u >> 2, g = u & 3, row0 = n * 128;
        for (int rr = 0; rr < 16; ++rr) { const int r = F.wave * 16 + rr; float f[8]; unpack8(*(const v4u*)(P1 + (size_t)(row0 + r) * N_BCA + 4096 + F.lane * 8), f);
            float s = 0.f;
#pragma unroll
            for (int i = 0; i < 8; ++i) s += f[i] * f[i];
            s = wave_sum(s); if (F.lane == 0) rstd[r] = 1.0f / sqrtf(s * (1.0f / 512.0f) + EPS); }
        __syncthreads();
        { const int c8 = (F.tid & 15) * 8;
#pragma unroll
          for (int j = 0; j < 4; ++j) { const int r = (F.tid >> 4) + 32 * j; float f[8]; unpack8(*(const v4u*)(P1 + (size_t)(row0 + r) * N_BCA + 4096 + g * 128 + c8), f);
              const float rs = rstd[r];
#pragma unroll
              for (int i = 0; i < 8; ++i) V[r * 128 + c8 + i] = f[i] * rs * norm_w[g * 128 + c8 + i]; }
          const int s4 = (F.tid & 31) * 4;
#pragma unroll
          for (int j = 0; j < 8; ++j) { const int t = (F.tid >> 5) + 16 * j; const f32x4 w = *(const f32x4*)(sgu_w + ((size_t)g * 128 + t) * 128 + s4);
              Wl[t * 129 + s4 + 0] = (s4 + 0 <= t) ? w.x : 0.f; Wl[t * 129 + s4 + 1] = (s4 + 1 <= t) ? w.y : 0.f; Wl[t * 129 + s4 + 2] = (s4 + 2 <= t) ? w.z : 0.f; Wl[t * 129 + s4 + 3] = (s4 + 3 <= t) ? w.w : 0.f; } }
        __syncthreads();
        const int ty = F.tid >> 4, tx = F.tid & 15;
        float acc[4][8];
#pragma unroll
        for (int i = 0; i < 4; ++i)
#pragma unroll
            for (int j = 0; j < 8; ++j) acc[i][j] = 0.f;
        for (int s = 0; s <= ty * 4 + 3; ++s) {
            const f32x4 v0 = *(const LAS f32x4*)(V + s * 128 + tx * 8), v1 = *(const LAS f32x4*)(V + s * 128 + tx * 8 + 4);
#pragma unroll
            for (int i = 0; i < 4; ++i) { const float w = Wl[(ty * 4 + i) * 129 + s];
                acc[i][0] += w * v0.x; acc[i][1] += w * v0.y; acc[i][2] += w * v0.z; acc[i][3] += w * v0.w; acc[i][4] += w * v1.x; acc[i][5] += w * v1.y; acc[i][6] += w * v1.z; acc[i][7] += w * v1.w; }
        }
#pragma unroll
        for (int i = 0; i < 4; ++i) { const int t = ty * 4 + i; const float bias = sgu_b[g * 128 + t];
            float uu[8], y[8]; unpack8(*(const v4u*)(P1 + (size_t)(row0 + t) * N_BCA + 3584 + g * 128 + tx * 8), uu);
#pragma unroll
            for (int j = 0; j < 8; ++j) y[j] = (acc[i][j] + bias) * uu[j];
            *(v4u*)(yc + (size_t)(row0 + t) * 512 + g * 128 + tx * 8) = pack8(y); }
        __syncthreads();
    }
}

__device__ __forceinline__ void p_hgrn_naive(Frame& F, const bf16* P1, const float* lb_logits  , int layer, const float* norm_w, bf16* yb) {
    LAS float* qf = (LAS float*)F.lds;
    LAS float* fd = qf + 4096; LAS float* kk = fd + 4096; LAS float* vv = kk + 4096; LAS float* O = vv + 4096;
    for (int u = F.bid; u < BATCH * H_B; u += F.G) {
        const int b = u >> 2, h = u & 3;
        const int dg = F.lane >> 4, j = (F.lane & 15) + 16 * F.wave;
        float S[32];
#pragma unroll
        for (int i = 0; i < 32; ++i) S[i] = 0.f;
        const int pc8 = (F.tid & 15) * 8, pt = F.tid >> 4;
        float lbv[8];
#pragma unroll
        for (int i = 0; i < 8; ++i) { const int ch = h * 128 + pc8 + i; const float l0 = lb_logits[ch], l1 = lb_logits[512 + ch]; const float mx = fmaxf(l0, l1);
            const float e0 = expf(l0 - mx), e1 = expf(l1 - mx); const float p0 = e0 / (e0 + e1), p1 = e1 / (e0 + e1);
            float lbx = (layer == 0) ? (p0 - p0) : ((p0 + p1) - p0); lbv[i] = fminf(fmaxf(lbx, 0.f), 1.f); }
        for (int tile = 0; tile < SEQ / 32; ++tile) {
            const int row0 = b * SEQ + tile * 32;
            { const bf16* p = P1 + (size_t)(row0 + pt) * N_BCA + 1536 + h * 128 + pc8;
              float q8[8], f8[8], i8[8]; unpack8(*(const v4u*)p, q8); unpack8(*(const v4u*)(p + 512), f8); unpack8(*(const v4u*)(p + 1024), i8);
#pragma unroll
              for (int i = 0; i < 8; ++i) { const float sg = 1.0f / (1.0f + expf(-f8[i])); const float lbb = lbv[i];
                  qf[pt * 128 + pc8 + i] = q8[i] / (1.0f + expf(-q8[i])); fd[pt * 128 + pc8 + i] = fmaxf(lbb, 1e-30f) + (1.0f - lbb) * sg;
                  kk[pt * 128 + pc8 + i] = (1.0f - lbb) * (1.0f - sg); vv[pt * 128 + pc8 + i] = i8[i]; } }
            __syncthreads();
            for (int t = 0; t < 32; ++t) {
                const float v = vv[t * 128 + j]; float part = 0.f;
#pragma unroll
                for (int i4 = 0; i4 < 8; ++i4) {
                    const f32x4 f4 = *(const LAS f32x4*)(fd + t * 128 + dg * 32 + i4 * 4), k4 = *(const LAS f32x4*)(kk + t * 128 + dg * 32 + i4 * 4), q4 = *(const LAS f32x4*)(qf + t * 128 + dg * 32 + i4 * 4);
                    S[i4 * 4 + 0] = f4.x * S[i4 * 4 + 0] + k4.x * v; part += q4.x * S[i4 * 4 + 0];
                    S[i4 * 4 + 1] = f4.y * S[i4 * 4 + 1] + k4.y * v; part += q4.y * S[i4 * 4 + 1];
                    S[i4 * 4 + 2] = f4.z * S[i4 * 4 + 2] + k4.z * v; part += q4.z * S[i4 * 4 + 2];
                    S[i4 * 4 + 3] = f4.w * S[i4 * 4 + 3] + k4.w * v; part += q4.w * S[i4 * 4 + 3];
                }
                part += __shfl_xor(part, 16); part += __shfl_xor(part, 32);
                if (dg == 0) O[t * 128 + j] = part;
            }
            __syncthreads();
            { float o8[8], g8[8], y[8]; float ss = 0.f;
#pragma unroll
              for (int i = 0; i < 8; ++i) { o8[i] = O[pt * 128 + pc8 + i]; ss += o8[i] * o8[i]; }
              ss += __shfl_xor(ss, 1); ss += __shfl_xor(ss, 2); ss += __shfl_xor(ss, 4); ss += __shfl_xor(ss, 8);
              const float rs = 1.0f / sqrtf(ss * (1.0f / 128.0f) + EPS);
              unpack8(*(const v4u*)(P1 + (size_t)(row0 + pt) * N_BCA + 3072 + h * 128 + pc8), g8);
#pragma unroll
              for (int i = 0; i < 8; ++i) y[i] = o8[i] * rs * norm_w[h * 128 + pc8 + i] * (g8[i] / (1.0f + expf(-g8[i])));
              *(v4u*)(yb + (size_t)(row0 + pt) * 512 + h * 128 + pc8) = pack8(y); }
            __syncthreads();
        }
    }
}

__device__ __forceinline__ void p_norm_router(Frame& F, KArgs ka, const float* x, const float* w, const float* mod_l, bf16* h2) {
    const float* rw = ka->in[20]; const float* rb = ka->in[21]; unsigned* ctl = (unsigned*)(ka->ws + WS_CTL);
    float* topp = (float*)(ka->ws + WS_TOPP); int* list = (int*)(ka->ws + WS_LIST);
    LAS float* RWt = (LAS float*)F.lds;
    LAS int* lcnt = (LAS int*)(RWt + 8192);
    LAS int* lbase = lcnt + 16;
    LAS int* sel = lbase + 16;
    LAS int* rnk = sel + 128;
    for (int i = F.tid; i < D * NE; i += NT) { const int k = i >> 3, e = i & 7; RWt[e * D + k] = rw[i]; }
    __syncthreads();
    for (int batch = F.bid; batch < M / 128; batch += F.G) {
        const int row0 = batch * 128;
        if (F.tid < 16) lcnt[F.tid] = 0;
        __syncthreads();
        for (int rr = 0; rr < 16; ++rr) {
            const int r = F.wave * 16 + rr, row = row0 + r;
            const float* mb = mod_l + (size_t)(row >> 12) * MOD_LD;
            f32x4 o[4]; norm_row(x + (size_t)row * D, w, mb + 4 * D, mb + 3 * D, F.lane, o);
            store_row_bf16(h2 + (size_t)row * D, F.lane, o);
            float lg[8];
#pragma unroll
            for (int e = 0; e < 8; ++e) { float s = 0.f;
#pragma unroll
                for (int j = 0; j < 4; ++j) { const f32x4 r4 = *(const LAS f32x4*)(RWt + e * D + 4 * F.lane + 256 * j); s += (o[j].x * r4.x + o[j].y * r4.y) + (o[j].z * r4.z + o[j].w * r4.w); }
                lg[e] = wave_sum(s) + rb[e]; }
            int i0 = 0; float v0 = lg[0];
#pragma unroll
            for (int e = 1; e < 8; ++e) if (lg[e] > v0) { v0 = lg[e]; i0 = e; }
            int i1 = -1; float v1 = -3.0e38f;
#pragma unroll
            for (int e = 0; e < 8; ++e) if (e != i0 && lg[e] > v1) { v1 = lg[e]; i1 = e; }
            if (F.lane == 0) {
                const float p0 = 1.0f / (1.0f + expf(v1 - v0));
                topp[(size_t)row * 2] = p0; topp[(size_t)row * 2 + 1] = 1.0f - p0;
                const int rk0 = __hip_atomic_fetch_add(lcnt + i0, 1, __ATOMIC_RELAXED, __HIP_MEMORY_SCOPE_WORKGROUP), rk1 = __hip_atomic_fetch_add(lcnt + 8 + i1, 1, __ATOMIC_RELAXED, __HIP_MEMORY_SCOPE_WORKGROUP);
                sel[r] = i0 | (i1 << 8); rnk[r] = rk0 | (rk1 << 16);
            }
        }
        __syncthreads();
        if (F.tid < 16) lbase[F.tid] = (int)__hip_atomic_fetch_add(ctl + CW_CNT + 64 * F.tid, (unsigned)lcnt[F.tid], __ATOMIC_RELAXED, __HIP_MEMORY_SCOPE_AGENT);
        __syncthreads();
        if (F.tid < 128) { const int sv = sel[F.tid], rv = rnk[F.tid]; const int e0 = sv & 255, e1 = sv >> 8;
            list[(size_t)e0 * LIST_CAP + lbase[e0] + (rv & 0xffff)] = row0 + F.tid;
            list[(size_t)(8 + e1) * LIST_CAP + lbase[8 + e1] + (rv >> 16)] = row0 + F.tid; }
        __syncthreads();
    }
}
__device__ __forceinline__ void moe_tables(Frame& F, unsigned* ctl, int pass) {
    LAS int* tab = (LAS int*)(F.lds + TAB_OFF);
    __syncthreads();
    if (F.tid == 0) { int pb = 0;
        for (int e = 0; e < 8; ++e) { int c = (int)__hip_atomic_load(ctl + CW_CNT + 64 * (pass * 8 + e), __ATOMIC_RELAXED, __HIP_MEMORY_SCOPE_AGENT); if (c > LIST_CAP) c = LIST_CAP; if (c < 0) c = 0;
            const int np = (c + 255) >> 8; tab[e] = c; tab[8 + e] = pb; for (int p = 0; p < np; ++p) tab[32 + pb + p] = e; pb += np; }
        tab[16] = pb; }
    __syncthreads();
}
template <bool GATHER_>
struct MoeOrder {
    static constexpr bool GATHER = GATHER_;
    pg8::StaticOrder so; const LAS int* tab; const int* list; int npn; unsigned rowbytes;
    __device__ __forceinline__ bool next(int i, pg8::Unit& u) const { if (!so.next(i, u)) return false; u.pb = tab[32 + u.pm] * npn + u.pn; return true; }
    __device__ __forceinline__ int tok_of(int pm, int r) const { const int e = tab[32 + pm]; const int idx = (pm - tab[8 + e]) * 256 + r; return idx < tab[e] ? list[(size_t)e * LIST_CAP + idx] : -1; }
    __device__ __forceinline__ unsigned a_row_off(const pg8::Unit& u, int r) const { const int t = tok_of(u.pm, r); return (unsigned)(t < 0 ? 0 : t) * rowbytes; }
};

struct EpiBranch {
    static constexpr bool PERM = true;
    const bf16* gate; bf16* mrg; int first;
    __device__ __forceinline__ void operator()(const pg8::f32x4 (&acc)[2][2][4][2], const pg8::Unit& u, int wr, int wc, int fr, int fq) const {
        const int row0 = u.pm * 256 + wr * 64 + fr, col0 = u.pn * 256 + wc * 32 + 8 * fq;
#pragma unroll
        for (int ai = 0; ai < 2; ++ai)
#pragma unroll
            for (int m = 0; m < 4; ++m) { const size_t row = (size_t)(row0 + ai * 128 + m * 16);
#pragma unroll
                for (int bj = 0; bj < 2; ++bj) { const int col = col0 + bj * 128;
                    float gg[8], mm[8], o[8]; unpack8(*(const v4u*)(gate + row * N_G + col), gg);
                    if (first) {
#pragma unroll
                        for (int i = 0; i < 8; ++i) mm[i] = 0.f; } else unpack8(*(const v4u*)(mrg + row * D + col), mm);
                    const pg8::f32x4 v0 = acc[ai][bj][m][0], v1 = acc[ai][bj][m][1];
                    o[0] = mm[0] + sigmoidf_(gg[0]) * v0[0]; o[1] = mm[1] + sigmoidf_(gg[1]) * v0[1]; o[2] = mm[2] + sigmoidf_(gg[2]) * v0[2]; o[3] = mm[3] + sigmoidf_(gg[3]) * v0[3];
                    o[4] = mm[4] + sigmoidf_(gg[4]) * v1[0]; o[5] = mm[5] + sigmoidf_(gg[5]) * v1[1]; o[6] = mm[6] + sigmoidf_(gg[6]) * v1[2]; o[7] = mm[7] + sigmoidf_(gg[7]) * v1[3];
                    *(v4u*)(mrg + row * D + col) = pack8(o); }
                asm volatile("" ::: "memory"); }
    }
};
struct EpiResid {
    static constexpr bool PERM = false;
    const float* xin; float* xout; const float* gmod;
    __device__ __forceinline__ void operator()(const pg8::f32x4 (&acc)[2][2][4][2], const pg8::Unit& u, int wr, int wc, int fr, int fq) const {
        const int row0 = u.pm * 256 + wr * 64 + fr, col0 = u.pn * 256 + wc * 32 + 4 * fq;
        const float* gb = gmod + (size_t)((u.pm * 256) >> 12) * MOD_LD + col0;
        pg8::f32x4 gv[2][2];
#pragma unroll
        for (int bj = 0; bj < 2; ++bj)
#pragma unroll
            for (int n = 0; n < 2; ++n) gv[bj][n] = *(const pg8::f32x4*)(gb + bj * 128 + n * 16);
#pragma unroll
        for (int ai = 0; ai < 2; ++ai)
#pragma unroll
            for (int m = 0; m < 4; ++m) { const size_t off = (size_t)(row0 + ai * 128 + m * 16) * D + col0;
#pragma unroll
                for (int bj = 0; bj < 2; ++bj)
#pragma unroll
                    for (int n = 0; n < 2; ++n) { const pg8::f32x4 xv = *(const pg8::f32x4*)(xin + off + bj * 128 + n * 16);
                        *(pg8::f32x4*)(xout + off + bj * 128 + n * 16) = xv + gv[bj][n] * acc[ai][bj][m][n]; }
                asm volatile("" ::: "memory"); }
    }
};
struct EpiSwiglu {
    static constexpr bool PERM = true;
    bf16* act;
    __device__ __forceinline__ void operator()(const pg8::f32x4 (&acc)[2][2][4][2], const pg8::Unit& u, int wr, int wc, int fr, int fq) const {
        const int row0 = u.pm * 256 + wr * 64 + fr, col0 = u.pn * 128 + wc * 32 + 8 * fq;
#pragma unroll
        for (int ai = 0; ai < 2; ++ai)
#pragma unroll
            for (int m = 0; m < 4; ++m) { float o[8];
#pragma unroll
                for (int n = 0; n < 2; ++n)
#pragma unroll
                    for (int i = 0; i < 4; ++i) o[n * 4 + i] = siluf_(acc[ai][0][m][n][i]) * acc[ai][1][m][n][i];
                *(v4u*)(act + (size_t)(row0 + ai * 128 + m * 16) * D_FF + col0) = pack8(o); }
    }
};
struct EpiMoeDown {
    static constexpr bool PERM = false;
    float* x; const float* gmod; const float* topp; int pass; const LAS int* tab; const int* list;
    __device__ __forceinline__ int tok_of(int pm, int r) const { const int e = tab[32 + pm]; const int idx = (pm - tab[8 + e]) * 256 + r; return idx < tab[e] ? list[(size_t)e * LIST_CAP + idx] : -1; }
    __device__ __forceinline__ void operator()(const pg8::f32x4 (&acc)[2][2][4][2], const pg8::Unit& u, int wr, int wc, int fr, int fq) const {
        const int col0 = u.pn * 256 + wc * 32 + 4 * fq;
#pragma unroll
        for (int ai = 0; ai < 2; ++ai)
#pragma unroll
            for (int m = 0; m < 4; ++m) { const int tok = tok_of(u.pm, ai * 128 + wr * 64 + m * 16 + fr);
                if (tok >= 0) { const float p = topp[(size_t)tok * 2 + pass]; const float* gb = gmod + (size_t)(tok >> 12) * MOD_LD + col0; float* xr = x + (size_t)tok * D + col0;
#pragma unroll
                    for (int bj = 0; bj < 2; ++bj)
#pragma unroll
                        for (int n = 0; n < 2; ++n) { const pg8::f32x4 gv = *(const pg8::f32x4*)(gb + bj * 128 + n * 16); const pg8::f32x4 xv = *(const pg8::f32x4*)(xr + bj * 128 + n * 16);
                            *(pg8::f32x4*)(xr + bj * 128 + n * 16) = xv + gv * p * acc[ai][bj][m][n]; } }
                asm volatile("" ::: "memory"); }
    }
};

__device__ __forceinline__ void p_final_norm(Frame& F, float* x, const float* w) {
    const int gw = F.bid * NWAVES + F.wave, NGW = F.G * NWAVES;
    for (int row = gw; row < M; row += NGW) {
        f32x4* xr = (f32x4*)(x + (size_t)row * D) + F.lane;
        f32x4 v[4]; float s = 0.f;
#pragma unroll
        for (int j = 0; j < 4; ++j) { v[j] = xr[64 * j]; s += (v[j].x * v[j].x + v[j].y * v[j].y) + (v[j].z * v[j].z + v[j].w * v[j].w); }
        const float rstd = 1.0f / sqrtf(wave_sum(s) * (1.0f / D) + EPS);
#pragma unroll
        for (int j = 0; j < 4; ++j) xr[64 * j] = v[j] * rstd * ((const f32x4*)w)[F.lane + 64 * j];
    }
}

__device__ __forceinline__ bool fresh(Frame& F) {
    int t_ = threadIdx.x, b_ = blockIdx.x, g_ = gridDim.x; asm volatile("" : "+v"(t_), "+s"(b_), "+s"(g_));
    F.tid = t_; F.lane = t_ & 63; F.wave = __builtin_amdgcn_readfirstlane(t_ >> 6); F.bid = b_; F.G = g_; return true;
}
constexpr int NPL = 12, NPHASE = 1 + DEPTH * NPL;
__global__ void __launch_bounds__(NT, 2) fwd(Args args) {
    extern __shared__ __attribute__((aligned(16))) unsigned char lds[];
    Frame F;
    F.lds = (LAS unsigned char*)lds;
    F.tid = threadIdx.x; F.lane = F.tid & 63; F.wave = __builtin_amdgcn_readfirstlane(F.tid >> 6);
    F.G = gridDim.x; F.bid = blockIdx.x;
    volatile LAS unsigned* MISC = (volatile LAS unsigned*)(F.lds + MISC_OFF);
    if (F.tid < 32) MISC[F.tid] = 0u;
    __syncthreads();
#if MK_PER_PHASE
#define GRID_BAR() do { } while (0)
#else
    XcdBarrier bar = xcd_barrier_post((unsigned*)(KA()->ws + WS_CTL) + CW_BAR, MISC + 8);
#define GRID_BAR() xcd_barrier(bar)
#endif
    const int lo = KA()->ph_lo, hi = KA()->ph_hi;
#ifdef ONLY_REL
#define IN(k) (fresh(F) && ((k) == 0 ? 100 : ((k) - 1) % NPL) == ONLY_REL && (ONLY_L < 0 || ((k) - 1) / NPL == ONLY_L) && lo <= (k) && (k) < hi)
#else
#define IN(k) (lo <= (k) && (k) < hi && fresh(F))
#endif
#define SEAM(k) do { if ((k) + 1 < hi) GRID_BAR(); } while (0)
    PG8_LAS unsigned char* ring = (PG8_LAS unsigned char*)lds;

    if (IN(0)) { p_prologue(F, KA()); SEAM(0); }

#ifdef UNROLL_L
#pragma unroll
#else
#pragma unroll 1
#endif
    for (int l = 0; l < DEPTH; ++l) {
        const int pb = 1 + l * NPL;
#define WSP(off) (ka->ws + (off))
#define MODL ((const float*)WSP(WS_MOD) + (size_t)l * BATCH * MOD_LD)
#define WMIXL ((bf16*)WSP(WS_WMIX + (size_t)l * WMIX_STRIDE))
        if (IN(pb + 0)) { KArgs ka = KA(); p_norm(F, l == 0 ? ka->in[0] : (const float*)ka->out, ka->in[4] + l * D, MODL, 1 * D, 0, (bf16*)WSP(WS_H)); SEAM(pb + 0); }
        if (IN(pb + 1)) {
            KArgs ka = KA();
            pg8::Gemm g{(bf16*)WSP(WS_H), WMIXL, D, D, D}; pg8::StaticOrder S; S.init(M / 256, N_BCA / 256, F.G, F.bid);
            pg8::EpiBf16 E{(bf16*)WSP(WS_P1), N_BCA};
            pg8::gemm_phase(ring, g, S, E); SEAM(pb + 1);
        }
        if (IN(pb + 2)) {
            { KArgs ka = KA(); p_hgrn_naive(F, (const bf16*)WSP(WS_P1), ka->in[8], l, ka->in[9] + l * D_BV, (bf16*)WSP(WS_YB)); }
            __syncthreads();
            { KArgs ka = KA(); p_sgu(F, (const bf16*)WSP(WS_P1), ka->in[10] + l * D_C, ka->in[11] + (size_t)l * 4 * 128 * 128, ka->in[12] + l * 4 * 128, (bf16*)WSP(WS_YC)); }
            { KArgs ka = KA(); p_conv(F, (const bf16*)WSP(WS_P1), ka->in[7] + l * 3 * D_A, (bf16*)WSP(WS_YA)); }
            SEAM(pb + 2);
        }
        if (IN(pb + 3)) {
            KArgs ka = KA();
            pg8::Gemm g{(bf16*)WSP(WS_H), WMIXL + (size_t)N_BCA * D, D, D, D}; pg8::StaticOrder S; S.init(M / 256, N_G / 256, F.G, F.bid);
            pg8::EpiBf16 E{(bf16*)WSP(WS_PG), N_G};
            pg8::gemm_phase(ring, g, S, E); SEAM(pb + 3);
        }
        if (IN(pb + 4)) {
#pragma unroll 1
            for (int br = 0; br < 3; ++br) {
                KArgs ka = KA();
                pg8::Gemm g{(bf16*)WSP(WS_YA + (size_t)br * 32 * MiB), WMIXL + (size_t)N_IN * D + (size_t)br * 512 * 1024, 512, 512, 512}; pg8::StaticOrder S; S.init(M / 256, D / 256, F.G, F.bid);
                EpiBranch E{(const bf16*)WSP(WS_PG) + br * D, (bf16*)WSP(WS_MRG), br == 0 ? 1 : 0};
                pg8::gemm_phase(ring, g, S, E);
            }
            SEAM(pb + 4);
        }
        if (IN(pb + 5)) {
            KArgs ka = KA();
            pg8::Gemm g{(bf16*)WSP(WS_MRG), WMIXL + (size_t)N_IN * D + 3 * 512 * 1024, D, D, D}; pg8::StaticOrder S; S.init(M / 256, D / 256, F.G, F.bid);
            EpiResid E{l == 0 ? ka->in[0] : (const float*)ka->out, ka->out, MODL + 2 * D};
            pg8::gemm_phase(ring, g, S, E); SEAM(pb + 5);
        }
        if (l == 0) {
            if (IN(pb + 6)) { KArgs ka = KA(); p_norm(F, ka->out, ka->in[5] + l * D, MODL, 4 * D, 3 * D, (bf16*)WSP(WS_H)); SEAM(pb + 6); }
            if (IN(pb + 7)) {
                KArgs ka = KA();
                pg8::Gemm g{(bf16*)WSP(WS_H), (bf16*)WSP(WS_W13), D, D, D}; pg8::StaticOrder S; S.init(M / 256, N13 / 256, F.G, F.bid);
                EpiSwiglu E{(bf16*)WSP(WS_ACT)};
                pg8::gemm_phase(ring, g, S, E); SEAM(pb + 7);
            }
            if (IN(pb + 8)) {
                KArgs ka = KA();
                pg8::Gemm g{(bf16*)WSP(WS_ACT), (bf16*)WSP(WS_W2), D_FF, D_FF, D_FF}; pg8::StaticOrder S; S.init(M / 256, D / 256, F.G, F.bid);
                EpiResid E{ka->out, ka->out, MODL + 5 * D};
                pg8::gemm_phase(ring, g, S, E); SEAM(pb + 8);
            }
        } else {
            if (IN(pb + 6)) { p_moe_weights(F, KA()); __syncthreads(); { KArgs ka = KA(); p_norm_router(F, ka, ka->out, ka->in[5] + l * D, MODL, (bf16*)WSP(WS_H2M)); } SEAM(pb + 6); }
#pragma unroll 1
            for (int pass = 0; pass < 2; ++pass) {
#ifndef NO_MOE_UP
                if (IN(pb + 7 + 2 * pass)) {
                    KArgs ka = KA();
                    moe_tables(F, (unsigned*)WSP(WS_CTL), pass);
                    const LAS int* tab = (const LAS int*)(F.lds + TAB_OFF);
                    MoeOrder<true> S; S.so.init(tab[16], N13 / 256, F.G, F.bid); S.tab = tab; S.list = (const int*)WSP(WS_LIST) + (size_t)pass * 8 * LIST_CAP; S.npn = N13 / 256; S.rowbytes = D * 2;
                    pg8::Gemm g{(bf16*)WSP(WS_H2M), (bf16*)WSP(WS_WM13), D, D, D};
                    EpiSwiglu E{(bf16*)WSP(WS_ACTM)};
                    pg8::gemm_phase(ring, g, S, E); SEAM(pb + 7 + 2 * pass);
                }
#endif
#ifndef NO_MOE_DOWN
                if (IN(pb + 8 + 2 * pass)) {
                    KArgs ka = KA();
                    moe_tables(F, (unsigned*)WSP(WS_CTL), pass);
                    const LAS int* tab = (const LAS int*)(F.lds + TAB_OFF);
                    MoeOrder<false> S; S.so.init(tab[16], D / 256, F.G, F.bid); S.tab = tab; S.list = (const int*)WSP(WS_LIST) + (size_t)pass * 8 * LIST_CAP; S.npn = D / 256; S.rowbytes = 0;
                    pg8::Gemm g{(bf16*)WSP(WS_ACTM), (bf16*)WSP(WS_WM2), D_FF, D_FF, D_FF};
                    EpiMoeDown E{ka->out, MODL + 5 * D, (const float*)WSP(WS_TOPP), pass, tab, S.list};
                    pg8::gemm_phase(ring, g, S, E); SEAM(pb + 8 + 2 * pass);
                }
#endif
            }
            if (IN(pb + 11)) { KArgs ka = KA(); p_final_norm(F, ka->out, ka->in[25]); }
        }
    }
#undef IN
#undef SEAM
}

extern "C" void kernel_launch(void* const* d_in, const int* in_sizes, int n_in, void* d_out, int out_size, void* d_ws, size_t ws_size, hipStream_t stream) {
    static int grid = 0;
    if (grid == 0) {
        if (n_in != 26 || in_sizes[0] != M * D || out_size != M * D || ws_size < WS_NEED) { fprintf(stderr, "kernel_launch: unexpected shapes / workspace (n_in %d, ws %zu, need %zu); nothing launched\n", n_in, ws_size, (size_t)WS_NEED); grid = -1; return; }
        int dev = 0, cus = 0, per_cu = 0;
        if (hipGetDevice(&dev) != hipSuccess || hipDeviceGetAttribute(&cus, hipDeviceAttributeMultiprocessorCount, dev) != hipSuccess) { grid = -1; return; }
        if (hipFuncSetAttribute((const void*)fwd, hipFuncAttributeMaxDynamicSharedMemorySize, LDS_BYTES) != hipSuccess) { fprintf(stderr, "kernel_launch: hipFuncSetAttribute failed\n"); grid = -1; return; }
        if (hipOccupancyMaxActiveBlocksPerMultiprocessor(&per_cu, (const void*)fwd, NT, LDS_BYTES) != hipSuccess || per_cu < 1) fprintf(stderr, "kernel_launch: occupancy query reports %d\n", per_cu);
        (void)hipGetLastError();
        grid = cus;
    }
    if (grid < 0) return;
    if (hipMemsetAsync((char*)d_ws + WS_CTL, 0, CTL_ZERO_BYTES, stream) != hipSuccess) return;
    Args a{};
    for (int i = 0; i < 26; ++i) a.in[i] = (const float*)d_in[i];
    a.out = (float*)d_out; a.ws = (unsigned char*)d_ws;
#if MK_PER_PHASE
    for (int p = 0; p < NPHASE; ++p) {
        if (p >= 1 + 9 && p <= 1 + 11) continue;
        a.ph_lo = p; a.ph_hi = p + 1;
        hipLaunchKernelGGL(fwd, dim3(grid), dim3(NT), LDS_BYTES, stream, a);
    }
#else
    a.ph_lo = 0; a.ph_hi = NPHASE;
    hipLaunchKernelGGL(fwd, dim3(grid), dim3(NT), LDS_BYTES, stream, a);
#endif
}
```

```cpp
#include <hip/hip_runtime.h>
#include <cstdio>
#include <cstdint>

#ifndef MK_PER_PHASE
#define MK_PER_PHASE 0
#endif

namespace pg8 {
#define PG8_LAS __attribute__((address_space(3)))
typedef unsigned short bf16_t;
typedef short bf16x8 __attribute__((ext_vector_type(8)));
typedef float f32x4 __attribute__((ext_vector_type(4)));
typedef unsigned u32x4 __attribute__((ext_vector_type(4)));
constexpr int BM = 256, BK = 64, HALF = 128, HTB = HALF * BK * 2, STAGE_BYTES = 8 * HTB, NXCD = 8, WGM = 8;

__host__ __device__ __forceinline__ int lds_byte(int r, int c) { const int st = (r >> 4) * 2 + (c >> 5), rr = r & 15, cc = c & 31, ob = rr * 64 + cc * 2; return st * 1024 + (ob ^ (((ob >> 9) & 1) << 5)); }
__host__ __device__ __forceinline__ void stage_rc(int b, int& R, int& C) { const int st = b / 1024, sb = b % 1024, swz = sb ^ (((sb >> 9) & 1) << 5); R = (st >> 1) * 16 + swz / 64; C = (st & 1) * 32 + (swz % 64) / 2; }
__host__ __device__ __forceinline__ int perm32(int rho) { const int n = rho >> 4, i = rho & 15; return 8 * (i >> 2) + 4 * n + (i & 3); }

struct Unit { int pm, pn, pb; };
struct Gemm { const bf16_t* A; const bf16_t* Bt; int lda, ldb, K; };

struct StaticOrder {
    static constexpr bool GATHER = false;
    int nM, nN, nwg, G, c;
    __device__ __forceinline__ void init(int nM_, int nN_, int G_, int c_) { nM = nM_; nN = nN_; nwg = nM * nN; G = G_; c = c_; }
    __device__ __forceinline__ bool next(int i, Unit& u) const {
        const long L = (long)i * G + c; if (L >= nwg) return false;
        int wgid = (int)L; { const int q = nwg / NXCD, r = nwg % NXCD, xcd = wgid % NXCD, off = wgid / NXCD; wgid = (xcd < r ? xcd * (q + 1) : r * (q + 1) + (xcd - r) * q) + off; }
        const int nig = WGM * nN, gid = wgid / nig, fm = gid * WGM, gsz = (nM - fm) < WGM ? (nM - fm) : WGM;
        u.pm = fm + ((wgid % nig) % gsz); u.pn = (wgid % nig) / gsz; u.pb = u.pn; return true;
    }
    __device__ __forceinline__ unsigned a_row_off(const Unit&, int) const { return 0u; }
};

__device__ __forceinline__ unsigned cvt_pk_bf16(float lo, float hi) { unsigned r; asm volatile("v_cvt_pk_bf16_f32 %0, %1, %2" : "=v"(r) : "v"(lo), "v"(hi)); return r; }

struct EpiBf16 {
    static constexpr bool PERM = true;
    bf16_t* O; int ldc;
    __device__ __forceinline__ void operator()(const f32x4 (&acc)[2][2][4][2], const Unit& u, int wr, int wc, int fr, int fq) const {
        const int row0 = u.pm * BM + wr * 64 + fr, col0 = u.pn * BM + wc * 32 + 8 * fq;
#pragma unroll
        for (int ai = 0; ai < 2; ++ai)
#pragma unroll
            for (int m = 0; m < 4; ++m) { bf16_t* rowp = O + (size_t)(row0 + ai * HALF + m * 16) * ldc + col0;
#pragma unroll
                for (int bj = 0; bj < 2; ++bj) { const f32x4 v0 = acc[ai][bj][m][0], v1 = acc[ai][bj][m][1];
                    u32x4 w; w.x = cvt_pk_bf16(v0[0], v0[1]); w.y = cvt_pk_bf16(v0[2], v0[3]); w.z = cvt_pk_bf16(v1[0], v1[1]); w.w = cvt_pk_bf16(v1[2], v1[3]);
                    *(u32x4*)(rowp + bj * HALF) = w; } }
    }
};

template <class Epi, class Sched>
__device__ __forceinline__ void gemm_phase(PG8_LAS unsigned char* lds, const Gemm g, const Sched& S, const Epi& E) {
    constexpr bool GATHER = Sched::GATHER;
    int tid_ = threadIdx.x; asm volatile("" : "+v"(tid_));
    const int tid = tid_, wid = __builtin_amdgcn_readfirstlane(tid >> 6), lane = tid & 63, wr = wid >> 2, wc = wid & 3, fr = lane & 15, fq = lane >> 4;
    const int K = g.K, nt = K / BK;
    unsigned voffB[2], vA0[2], vA1[2], nA0[2], nA1[2];
#pragma unroll
    for (int i = 0; i < 2; ++i) { int R, C; stage_rc(tid * 16 + i * 8192, R, C); const int Rb = Epi::PERM ? ((R & ~31) + perm32(R & 31)) : R;
        voffB[i] = (unsigned)(Rb * g.ldb + C) * 2u;
        vA0[i] = (unsigned)(R * g.lda + C) * 2u; vA1[i] = vA0[i]; nA0[i] = vA0[i]; nA1[i] = vA0[i]; }
    const size_t kstep = (size_t)(BK * 2);
    const size_t hstepB = (size_t)HALF * g.ldb * 2, tstepB = 2 * hstepB, tstepA = (size_t)BM * g.lda * 2;
    const size_t hstepA = GATHER ? (size_t)0 : (size_t)HALF * g.lda * 2;
    const unsigned ldsw = (unsigned)wid * 1024u;
    const int aoff = lds_byte(wr * 64 + fr, fq * 8), boff = lds_byte(wc * 32 + fr, fq * 8);
#define PG8_SA(b, h) (((b) * 2 + (h)) * HTB)
#define PG8_SB(b, h) ((4 + (b) * 2 + (h)) * HTB)
#define PG8_STAGE(bufoff, gbase, voff) do { _Pragma("unroll") for (int _i = 0; _i < 2; ++_i) \
        __builtin_amdgcn_global_load_lds((const unsigned*)((const char*)(gbase) + (voff)[_i]), (PG8_LAS unsigned*)(lds + (bufoff) + ldsw + _i * 8192), 16, 0, 0); } while (0)
#define PG8_LDA(dst, b, h) do { _Pragma("unroll") for (int m = 0; m < 4; ++m) _Pragma("unroll") for (int k = 0; k < 2; ++k) dst[m][k] = *(const PG8_LAS bf16x8*)(lds + PG8_SA(b, h) + aoff + m * 2048 + k * 1024); } while (0)
#define PG8_LDB(dst, b, h) do { _Pragma("unroll") for (int n = 0; n < 2; ++n) _Pragma("unroll") for (int k = 0; k < 2; ++k) dst[n][k] = *(const PG8_LAS bf16x8*)(lds + PG8_SB(b, h) + boff + n * 2048 + k * 1024); } while (0)
#define PG8_MMA(ai, bj, At, Bt) do { __builtin_amdgcn_s_setprio(1); _Pragma("unroll") for (int m = 0; m < 4; ++m) _Pragma("unroll") for (int n = 0; n < 2; ++n) _Pragma("unroll") for (int k = 0; k < 2; ++k) \
        acc[ai][bj][m][n] = __builtin_amdgcn_mfma_f32_16x16x32_bf16(Bt[n][k], At[m][k], acc[ai][bj][m][n], 0, 0, 0); __builtin_amdgcn_s_setprio(0); } while (0)
#define PG8_WAIT_V(n) asm volatile("s_waitcnt vmcnt(" #n ")" ::: "memory")
#define PG8_WAIT_L(n) asm volatile("s_waitcnt lgkmcnt(" #n ")" ::: "memory")
#define PG8_BAR __builtin_amdgcn_s_barrier()
#define PG8_SCHED __builtin_amdgcn_sched_barrier(0)
#define PG8_GOFF(unit, d0, d1) do { _Pragma("unroll") for (int _i = 0; _i < 2; ++_i) { int R_, C_; stage_rc(tid * 16 + _i * 8192, R_, C_); \
        d0[_i] = S.a_row_off(unit, R_) + (unsigned)C_ * 2u; d1[_i] = S.a_row_off(unit, R_ + HALF) + (unsigned)C_ * 2u; } } while (0)
    Unit cur, nxt; int ui = 0;
    if (!S.next(0, cur)) return;
    f32x4 acc[2][2][4][2];
#pragma unroll
    for (int a = 0; a < 2; ++a)
#pragma unroll
        for (int b = 0; b < 2; ++b)
#pragma unroll
            for (int m = 0; m < 4; ++m)
#pragma unroll
                for (int n = 0; n < 2; ++n) acc[a][b][m][n] = (f32x4){0.f, 0.f, 0.f, 0.f};
    bf16x8 At[4][2], B0[2][2], B1[2][2];
    if constexpr (GATHER) { PG8_GOFF(cur, vA0, vA1); }
    const char* cA = GATHER ? (const char*)g.A : (const char*)g.A + (size_t)cur.pm * tstepA; const char* cB = (const char*)g.Bt + (size_t)cur.pb * tstepB;
    PG8_STAGE(PG8_SB(0, 0), cB, voffB); PG8_STAGE(PG8_SB(0, 1), cB + hstepB, voffB); PG8_STAGE(PG8_SA(0, 0), cA, vA0); PG8_STAGE(PG8_SA(0, 1), cA + hstepA, vA1);
    if (wr == 1) PG8_BAR;
    PG8_WAIT_V(2); PG8_BAR;
    PG8_STAGE(PG8_SB(1, 0), cB + kstep, voffB); PG8_STAGE(PG8_SA(1, 0), cA + kstep, vA0); PG8_STAGE(PG8_SB(1, 1), cB + hstepB + kstep, voffB);
    PG8_WAIT_V(6); PG8_BAR;
    for (;;) {
        const bool has_next = S.next(ui + 1, nxt);
        const char* nA = GATHER ? (const char*)g.A : (has_next ? (const char*)g.A + (size_t)nxt.pm * tstepA : cA); const char* nB = has_next ? (const char*)g.Bt + (size_t)nxt.pb * tstepB : cB;
        if constexpr (GATHER) { if (has_next) { PG8_GOFF(nxt, nA0, nA1); } else {
#pragma unroll
            for (int i = 0; i < 2; ++i) { nA0[i] = vA0[i]; nA1[i] = vA1[i]; } } }
        for (int t = 0; t < nt; t += 2) {
            const bool last = (t == nt - 2);
            const char* a1 = cA + (size_t)(t + 1) * kstep;
            const char* a2 = last ? nA : cA + (size_t)(t + 2) * kstep; const char* b2 = last ? nB : cB + (size_t)(t + 2) * kstep;
            const char* a3 = a2 + kstep; const char* b3 = b2 + kstep;
            unsigned s0[2], s1[2];
#pragma unroll
            for (int i = 0; i < 2; ++i) { s0[i] = (GATHER && last) ? nA0[i] : vA0[i]; s1[i] = GATHER ? (last ? nA1[i] : vA1[i]) : vA0[i]; }
            PG8_LDB(B0, 0, 0); PG8_LDB(B1, 0, 1); PG8_SCHED; PG8_LDA(At, 0, 0); PG8_STAGE(PG8_SA(1, 1), a1 + hstepA, vA1);
            PG8_WAIT_V(8); PG8_WAIT_L(0); PG8_BAR; PG8_MMA(0, 0, At, B0); PG8_MMA(0, 1, At, B1); PG8_BAR; PG8_SCHED;
            PG8_LDA(At, 0, 1); PG8_STAGE(PG8_SB(0, 0), b2, voffB); PG8_STAGE(PG8_SB(0, 1), b2 + hstepB, voffB); PG8_STAGE(PG8_SA(0, 0), a2, s0);
            PG8_WAIT_V(8); PG8_WAIT_L(0); PG8_BAR; PG8_MMA(1, 0, At, B0); PG8_MMA(1, 1, At, B1); PG8_BAR; PG8_SCHED;
            PG8_LDB(B0, 1, 0); PG8_LDB(B1, 1, 1); PG8_SCHED; PG8_LDA(At, 1, 0); PG8_STAGE(PG8_SA(0, 1), a2 + hstepA, s1);
            PG8_WAIT_V(8); PG8_WAIT_L(0); PG8_BAR; PG8_MMA(0, 0, At, B0); PG8_MMA(0, 1, At, B1); PG8_BAR; PG8_SCHED;
            PG8_LDA(At, 1, 1); PG8_STAGE(PG8_SB(1, 0), b3, voffB); PG8_STAGE(PG8_SB(1, 1), b3 + hstepB, voffB); PG8_STAGE(PG8_SA(1, 0), a3, s0);
            PG8_WAIT_V(8); PG8_WAIT_L(0); PG8_BAR; PG8_MMA(1, 0, At, B0); PG8_MMA(1, 1, At, B1); PG8_BAR; PG8_SCHED;
        }
        if (wr == 0) PG8_BAR;
        E(acc, cur, wr, wc, fr, fq);
        if (!has_next) break;
#pragma unroll
        for (int a = 0; a < 2; ++a)
#pragma unroll
            for (int b = 0; b < 2; ++b)
#pragma unroll
                for (int m = 0; m < 4; ++m)
#pragma unroll
                    for (int n = 0; n < 2; ++n) acc[a][b][m][n] = (f32x4){0.f, 0.f, 0.f, 0.f};
        cur = nxt; cA = nA; cB = nB; ++ui;
        if constexpr (GATHER) {
#pragma unroll
            for (int i = 0; i < 2; ++i) { vA0[i] = nA0[i]; vA1[i] = nA1[i]; } }
        if (wr == 1) PG8_BAR;
    }
    PG8_WAIT_V(0);
    PG8_BAR;
#undef PG8_SA
#undef PG8_SB
#undef PG8_STAGE
#undef PG8_LDA
#undef PG8_LDB
#undef PG8_MMA
#undef PG8_WAIT_V
#undef PG8_WAIT_L
#undef PG8_BAR
#undef PG8_SCHED
#undef PG8_GOFF
}
}

constexpr int D = 1024, BATCH = 8, SEQ = 4096, M = BATCH * SEQ, DEPTH = 2;
constexpr int D_A = 512, D_BK = 512, D_BV = 512, D_C = 512, H_B = 4;
constexpr int N_IN = 7680, N_BCA = 4608, N_G = 3072;
constexpr int D_FF = 2816, NE = 8, N13 = 2 * D_FF;
constexpr int MOD_LD = 6 * D;
constexpr float EPS = 1e-6f;
constexpr int LIST_CAP = M;
constexpr int MOE_ROWS = M + NE * 256;

constexpr size_t MiB = 1u << 20;
constexpr size_t WS_CTL = 0, CTL_ZERO_BYTES = 1 * MiB;
constexpr size_t WS_MOD = 1 * MiB;
constexpr size_t WS_TOPP = 2 * MiB;
constexpr size_t WS_LIST = 3 * MiB;
constexpr size_t WS_WMIX = 6 * MiB, WMIX_STRIDE = 20 * MiB;
constexpr size_t WS_W13 = 46 * MiB, WS_W2 = 57 * MiB;
constexpr size_t WS_BIG = 64 * MiB;
constexpr size_t WS_H = WS_BIG;
constexpr size_t WS_P1 = WS_BIG + 64 * MiB;
constexpr size_t WS_PG = WS_P1;
constexpr size_t WS_MRG = WS_P1 + 192 * MiB;
constexpr size_t WS_YA = WS_P1 + 288 * MiB, WS_YB = WS_YA + 32 * MiB, WS_YC = WS_YB + 32 * MiB;
constexpr size_t WS_ACT = WS_P1;
constexpr size_t WS_HU = WS_YC + 32 * MiB;
constexpr size_t WS_HD = WS_HU + 16 * MiB;
constexpr size_t WS_MIX_END = WS_HD + 1 * MiB;
constexpr size_t WS_WM13 = 6 * MiB;
constexpr size_t WS_WM2 = WS_WM13 + 88 * MiB;
constexpr size_t WS_H2M = WS_WM2 + 44 * MiB;
constexpr size_t WS_ACTM = WS_H2M + 64 * MiB;
constexpr size_t WS_MOE_END = WS_ACTM + (size_t)MOE_ROWS * D_FF * 2;
constexpr size_t WS_NEED = WS_MIX_END > WS_MOE_END ? WS_MIX_END : WS_MOE_END;
static_assert(WS_W2 + (size_t)D * D_FF * 2 <= WS_BIG && WS_WMIX + 2 * WMIX_STRIDE <= WS_W13, "ws map");
constexpr int CW_BAR = 4096;
constexpr int CW_CNT = 16384;

constexpr int LDS_BYTES = 147456;
constexpr int SCR_BYTES = 139264;
constexpr int TAB_OFF = SCR_BYTES;
constexpr int MISC_OFF = TAB_OFF + 4096;
static_assert(MISC_OFF + 128 <= LDS_BYTES, "LDS map");
constexpr int NWAVES = 8, NT = 512;

#define GAS __attribute__((address_space(1)))
#define LAS __attribute__((address_space(3)))
typedef unsigned short bf16;
typedef unsigned v4u __attribute__((ext_vector_type(4)));
typedef float f32x4 __attribute__((ext_vector_type(4)));
#define LDS_WAIT() asm volatile("s_waitcnt lgkmcnt(0)" ::: "memory")

typedef float f32x2_t __attribute__((ext_vector_type(2)));
typedef __bf16 bf16x2_t __attribute__((ext_vector_type(2)));
__device__ __forceinline__ unsigned pk2(float lo, float hi) { f32x2_t v = {lo, hi}; bf16x2_t b = __builtin_convertvector(v, bf16x2_t); return __builtin_bit_cast(unsigned, b); }
__device__ __forceinline__ float bf_lo(unsigned u) { return __uint_as_float(u << 16); }
__device__ __forceinline__ float bf_hi(unsigned u) { return __uint_as_float(u & 0xffff0000u); }
__device__ __forceinline__ void unpack8(const v4u w, float (&f)[8]) { f[0] = bf_lo(w.x); f[1] = bf_hi(w.x); f[2] = bf_lo(w.y); f[3] = bf_hi(w.y); f[4] = bf_lo(w.z); f[5] = bf_hi(w.z); f[6] = bf_lo(w.w); f[7] = bf_hi(w.w); }
__device__ __forceinline__ v4u pack8(const float (&f)[8]) { v4u w; w.x = pk2(f[0], f[1]); w.y = pk2(f[2], f[3]); w.z = pk2(f[4], f[5]); w.w = pk2(f[6], f[7]); return w; }
__device__ __forceinline__ float sigmoidf_(float x) { return __builtin_amdgcn_rcpf(1.0f + __expf(-x)); }
__device__ __forceinline__ float siluf_(float x) { return x * sigmoidf_(x); }
__device__ __forceinline__ float wave_sum(float v) {
#pragma unroll
    for (int o = 1; o < 64; o <<= 1) v += __shfl_xor(v, o);
    return v;
}

#define XB_TMO      128
#define XB_XCNT(j)  (256  + 64 * (j))
#define XB_XSUB(j)  (1280 + 64 * (j))
#define XB_XGEN(j)  (2304 + 64 * (j))
#define XB_TOP      3328
#define XB_TOPGEN   3392
#define XCD_BAR_WORDS 3456
#define XB_SPIN_CAP (1u << 18)

__device__ __forceinline__ unsigned xb_ld(unsigned* p)              { return __hip_atomic_load(p, __ATOMIC_RELAXED, __HIP_MEMORY_SCOPE_AGENT); }
__device__ __forceinline__ unsigned xb_add(unsigned* p, unsigned v) { return __hip_atomic_fetch_add(p, v, __ATOMIC_RELAXED, __HIP_MEMORY_SCOPE_AGENT); }
__device__ __forceinline__ unsigned xb_xcc_id() { return (unsigned)__builtin_amdgcn_s_getreg((3 << 11) | 20) & 0xFu; }
#define XB_SPIN(cond, bar) do { unsigned _sp = 0; while (cond) { __builtin_amdgcn_s_sleep(1); \
    if ((++_sp & 255u) == 0u) { if (xb_ld(&(bar)[XB_TMO])) break; if (_sp > XB_SPIN_CAP) { atomicAdd(&(bar)[XB_TMO], 1u); break; } } } } while (0)

struct XcdBarrier { unsigned* bar; unsigned x; volatile LAS unsigned* st; };

__device__ __forceinline__ XcdBarrier xcd_barrier_post(unsigned* bar, volatile LAS unsigned* st) {
    XcdBarrier b; b.bar = bar; b.x = xb_xcc_id(); b.st = st;
    if (threadIdx.x == 0) (void)xb_add(&bar[XB_XCNT(b.x)], 1u);
    return b;
}
__device__ __forceinline__ void xcd_barrier_complete(unsigned* bar, unsigned x, unsigned& nloc, unsigned& nx) {
    const unsigned G = gridDim.x * gridDim.y * gridDim.z;
    unsigned sum, cnt, mine, sp = 0u;
    for (;;) {
        sum = 0u; cnt = 0u; mine = 0u;
#pragma unroll
        for (unsigned j = 0; j < 16; ++j) { const unsigned c = xb_ld(&bar[XB_XCNT(j)]); sum += c; cnt += (c > 0u) ? 1u : 0u; mine = (j == x) ? c : mine; }
        if (sum == G) break;
        __builtin_amdgcn_s_sleep(1);
        if ((++sp & 255u) == 0u) { if (xb_ld(&bar[XB_TMO])) break; if (sp > XB_SPIN_CAP) { atomicAdd(&bar[XB_TMO], 1u); break; } }
    }
    nloc = mine > 0u ? mine : 1u; nx = cnt > 0u ? cnt : 1u;
}
__device__ __forceinline__ void xcd_barrier(const XcdBarrier& b) {
    asm volatile("s_waitcnt vmcnt(0)" ::: "memory");
    __syncthreads();
    if (threadIdx.x == 0) {
        unsigned* bar = b.bar;
        __builtin_amdgcn_s_waitcnt(0);
        unsigned nloc = b.st[0], nx = b.st[1];
        if (nloc == 0u) { xcd_barrier_complete(bar, b.x, nloc, nx); b.st[0] = nloc; b.st[1] = nx; }
        const unsigned old = xb_add(&bar[XB_XSUB(b.x)], 1u);
        const unsigned gen = old / nloc;
        if (old + 1u == (gen + 1u) * nloc) {
            __builtin_amdgcn_fence(__ATOMIC_RELEASE, "agent");
            asm volatile("s_waitcnt vmcnt(0)" ::: "memory");
            const unsigned og = xb_add(&bar[XB_TOP], 1u);
            const unsigned tg = og / nx;
            if (og + 1u == (tg + 1u) * nx) xb_add(&bar[XB_TOPGEN], 1u);
            else XB_SPIN(xb_ld(&bar[XB_TOPGEN]) == tg, bar);
            __builtin_amdgcn_fence(__ATOMIC_ACQUIRE, "agent");
            xb_add(&bar[XB_XGEN(b.x)], 1u);
            asm volatile("s_waitcnt vmcnt(0)" ::: "memory");
        } else {
            XB_SPIN(xb_ld(&bar[XB_XGEN(b.x)]) == gen, bar);
            __builtin_amdgcn_fence(__ATOMIC_ACQUIRE, "agent");
            asm volatile("s_waitcnt vmcnt(0)" ::: "memory");
        }
    }
    __syncthreads();
}

struct Args { const float* in[26]; float* out; unsigned char* ws; int ph_lo, ph_hi; };
typedef const Args __attribute__((address_space(4)))* KArgs;
#define KA() ({ KArgs p_ = (KArgs)__builtin_amdgcn_kernarg_segment_ptr(); asm volatile("" : "+s"(p_)); p_; })
struct Frame {
    LAS unsigned char* lds;
    int tid, lane, wave, G, bid;
};

template <int MAP>
__device__ __forceinline__ void transpose_item(const float* W, int K, int N, bf16* WT, int row_off, LAS float* scr, int item, int lane) {
    const int nblk = N / 32, kb = item / nblk, nb = item % nblk, k0 = 64 * kb, n0 = 32 * nb;
#pragma unroll 8
    for (int i = 0; i < 32; ++i) { const int kk = 2 * i + (lane >> 5); scr[kk * 33 + (lane & 31)] = W[(size_t)(k0 + kk) * N + n0 + (lane & 31)]; }
    LDS_WAIT(); asm volatile("" ::: "memory");
    const int c = lane & 7;
#pragma unroll
    for (int j = 0; j < 4; ++j) { const int n = (lane >> 3) + 8 * j; const LAS float* s = scr + (8 * c) * 33 + n;
        v4u o; o.x = pk2(s[0 * 33], s[1 * 33]); o.y = pk2(s[2 * 33], s[3 * 33]); o.z = pk2(s[4 * 33], s[5 * 33]); o.w = pk2(s[6 * 33], s[7 * 33]);
        const int nn = n0 + n; const int row = (MAP == 0) ? (row_off + nn) : ((nn >> 7) * 256 + row_off + (nn & 127));
        *(v4u*)(WT + (size_t)row * K + k0 + 8 * c) = o; }
    LDS_WAIT(); asm volatile("" ::: "memory");
}

__device__ __forceinline__ void p_prologue(Frame& F, KArgs ka) {
    const float* c = ka->in[1]; const float* ada_w = ka->in[2]; const float* ada_b = ka->in[3];
    unsigned char* aws = ka->ws; float* mod = (float*)(aws + WS_MOD);
    LAS float* cact = (LAS float*)F.lds;
    LAS float* red = cact + 8192;
    for (int i = F.tid; i < BATCH * D; i += NT) cact[i] = siluf_(c[i]);
    __syncthreads();
    for (int chunk = F.bid; chunk < 256; chunk += F.G) {
        const int l = chunk >> 7, n0 = (chunk & 127) * 48;
        if (F.tid < 480) {
            const int kg = F.tid / 48, col = F.tid % 48;
            float acc[8];
#pragma unroll
            for (int b = 0; b < 8; ++b) acc[b] = 0.f;
            const float* wp = ada_w + (size_t)l * D * MOD_LD + n0 + col;
            for (int k = kg; k < D; k += 10) { const float w = wp[(size_t)k * MOD_LD];
#pragma unroll
                for (int b = 0; b < 8; ++b) acc[b] += cact[b * D + k] * w; }
#pragma unroll
            for (int b = 0; b < 8; ++b) red[(kg * 48 + col) * 8 + b] = acc[b];
        }
        __syncthreads();
        if (F.tid < 384) {
            const int col = F.tid >> 3, b = F.tid & 7; float s = 0.f;
#pragma unroll
            for (int kg = 0; kg < 10; ++kg) s += red[(kg * 48 + col) * 8 + b];
            mod[(size_t)(l * 8 + b) * MOD_LD + n0 + col] = s + ada_b[l * MOD_LD + n0 + col];
        }
        __syncthreads();
    }
    LAS float* scr = (LAS float*)(F.lds + F.wave * 16384);
    const int gw = F.bid * NWAVES + F.wave, NGW = F.G * NWAVES;
    constexpr int I_IN = (D / 64) * (N_IN / 32), I_BR = (512 / 64) * (D / 32), I_O = (D / 64) * (D / 32), I_L = I_IN + 3 * I_BR + I_O;
    constexpr int I_F1 = (D / 64) * (D_FF / 32), I_F2 = (D_FF / 64) * (D / 32);
    constexpr int NITEMS = 2 * I_L + 2 * I_F1 + I_F2;
    for (int it = gw; it < NITEMS; it += NGW) {
        int r = it;
        if (r < 2 * I_L) {
            const int l = r / I_L; r -= l * I_L;
            bf16* base = (bf16*)(aws + WS_WMIX + (size_t)l * WMIX_STRIDE);
            if (r < I_IN) { transpose_item<0>(ka->in[6] + (size_t)l * D * N_IN, D, N_IN, base, 0, scr, r, F.lane); continue; } r -= I_IN;
            if (r < I_BR) { transpose_item<0>(ka->in[13] + (size_t)l * 512 * D, 512, D, base + (size_t)N_IN * D, 0, scr, r, F.lane); continue; } r -= I_BR;
            if (r < I_BR) { transpose_item<0>(ka->in[14] + (size_t)l * 512 * D, 512, D, base + (size_t)N_IN * D + 512 * 1024, 0, scr, r, F.lane); continue; } r -= I_BR;
            if (r < I_BR) { transpose_item<0>(ka->in[15] + (size_t)l * 512 * D, 512, D, base + (size_t)N_IN * D + 2 * 512 * 1024, 0, scr, r, F.lane); continue; } r -= I_BR;
            transpose_item<0>(ka->in[16] + (size_t)l * D * D, D, D, base + (size_t)N_IN * D + 3 * 512 * 1024, 0, scr, r, F.lane); continue;
        }
        r -= 2 * I_L;
        if (r < I_F1) { transpose_item<1>(ka->in[17], D, D_FF, (bf16*)(aws + WS_W13), 0, scr, r, F.lane); continue; } r -= I_F1;
        if (r < I_F1) { transpose_item<1>(ka->in[18], D, D_FF, (bf16*)(aws + WS_W13), 128, scr, r, F.lane); continue; } r -= I_F1;
        transpose_item<0>(ka->in[19], D_FF, D, (bf16*)(aws + WS_W2), 0, scr, r, F.lane);
    }
}
__device__ __forceinline__ void p_moe_weights(Frame& F, KArgs ka) {
    unsigned char* aws = ka->ws;
    LAS float* scr = (LAS float*)(F.lds + F.wave * 16384);
    const int gw = F.bid * NWAVES + F.wave, NGW = F.G * NWAVES;
    constexpr int I_F1 = (D / 64) * (D_FF / 32), I_F2 = (D_FF / 64) * (D / 32), I_E = 2 * I_F1 + I_F2;
    for (int it = gw; it < NE * I_E; it += NGW) {
        const int e = it / I_E; int r = it - e * I_E;
        bf16* w13 = (bf16*)(aws + WS_WM13) + (size_t)e * N13 * D; bf16* w2 = (bf16*)(aws + WS_WM2) + (size_t)e * D * D_FF;
        if (r < I_F1) { transpose_item<1>(ka->in[22] + (size_t)e * D * D_FF, D, D_FF, w13, 0, scr, r, F.lane); continue; } r -= I_F1;
        if (r < I_F1) { transpose_item<1>(ka->in[23] + (size_t)e * D * D_FF, D, D_FF, w13, 128, scr, r, F.lane); continue; } r -= I_F1;
        transpose_item<0>(ka->in[24] + (size_t)e * D_FF * D, D_FF, D, w2, 0, scr, r, F.lane);
    }
}

__device__ __forceinline__ void norm_row(const float* xrow, const float* w, const float* sc, const float* sh, int lane, f32x4 (&o)[4]) {
    const f32x4* xr = (const f32x4*)xrow + lane;
    f32x4 v[4]; float s = 0.f;
#pragma unroll
    for (int j = 0; j < 4; ++j) { v[j] = xr[64 * j]; s += (v[j].x * v[j].x + v[j].y * v[j].y) + (v[j].z * v[j].z + v[j].w * v[j].w); }
    const float rstd = 1.0f / sqrtf(wave_sum(s) * (1.0f / D) + EPS);
#pragma unroll
    for (int j = 0; j < 4; ++j) { const f32x4 wv = ((const f32x4*)w)[lane + 64 * j], scv = ((const f32x4*)sc)[lane + 64 * j], shv = ((const f32x4*)sh)[lane + 64 * j];
        o[j] = v[j] * rstd * wv * (scv + 1.0f) + shv; }
}
__device__ __forceinline__ void store_row_bf16(bf16* orow, int lane, const f32x4 (&o)[4]) {
    unsigned long long* o8 = (unsigned long long*)orow + lane;
#pragma unroll
    for (int j = 0; j < 4; ++j) o8[64 * j] = (unsigned long long)pk2(o[j].x, o[j].y) | ((unsigned long long)pk2(o[j].z, o[j].w) << 32);
}
__device__ __forceinline__ void p_norm(Frame& F, const float* xin, const float* w, const float* mod_l, int sc_off, int sh_off, bf16* hout) {
    const int gw = F.bid * NWAVES + F.wave, NGW = F.G * NWAVES;
    for (int row = gw; row < M; row += NGW) {
        const float* mb = mod_l + (size_t)(row >> 12) * MOD_LD;
        f32x4 o[4]; norm_row(xin + (size_t)row * D, w, mb + sc_off, mb + sh_off, F.lane, o);
        store_row_bf16(hout + (size_t)row * D, F.lane, o);
    }
}

__device__ __forceinline__ void p_conv(Frame& F, const bf16* P1, const float* conv_w, bf16* ya) {
    const int gt = F.bid * NT + F.tid, NGT = F.G * NT;
    for (int it = gt; it < M * 64; it += NGT) {
        const int row = it >> 6, c8 = (it & 63) * 8, pos = row & (SEQ - 1);
        const bf16* p = P1 + (size_t)row * N_BCA + c8;
        float ab[8], ac[8], ah[8], z1[8], z2[8], y[8];
        unpack8(*(const v4u*)p, ab); unpack8(*(const v4u*)(p + 512), ac); unpack8(*(const v4u*)(p + 1024), ah);
#pragma unroll
        for (int i = 0; i < 8; ++i) { z1[i] = 0.f; z2[i] = 0.f; }
        if (pos >= 1) { float c1[8], h1[8]; unpack8(*(const v4u*)(p - N_BCA + 512), c1); unpack8(*(const v4u*)(p - N_BCA + 1024), h1);
#pragma unroll
            for (int i = 0; i < 8; ++i) z1[i] = c1[i] * h1[i]; }
        if (pos >= 2) { float c2[8], h2[8]; unpack8(*(const v4u*)(p - 2 * N_BCA + 512), c2); unpack8(*(const v4u*)(p - 2 * N_BCA + 1024), h2);
#pragma unroll
            for (int i = 0; i < 8; ++i) z2[i] = c2[i] * h2[i]; }
#pragma unroll
        for (int i = 0; i < 8; ++i) y[i] = ab[i] * (conv_w[c8 + i] * (ac[i] * ah[i]) + conv_w[512 + c8 + i] * z1[i] + conv_w[1024 + c8 + i] * z2[i]);
        *(v4u*)(ya + (size_t)row * 512 + c8) = pack8(y);
    }
}

__device__ __forceinline__ void p_sgu(Frame& F, const bf16* P1, const float* norm_w, const float* sgu_w, const float* sgu_b, bf16* yc) {
    LAS float* V = (LAS float*)F.lds;
    LAS float* Wl = V + 128 * 128;
    LAS float* rstd = Wl + 128 * 129;
    for (int u = F.bid; u < 1024; u += F.G) {
        const int n = u >> 2, g = u & 3, row0 = n * 128;
        for (int rr = 0; rr < 16; ++rr) { const int r = F.wave * 16 + rr; float f[8]; unpack8(*(const v4u*)(P1 + (size_t)(row0 + r) * N_BCA + 4096 + F.lane * 8), f);
            float s = 0.f;
#pragma unroll
            for (int i = 0; i < 8; ++i) s += f[i] * f[i];
            s = wave_sum(s); if (F.lane == 0) rstd[r] = 1.0f / sqrtf(s * (1.0f / 512.0f) + EPS); }
        __syncthreads();
        { const int c8 = (F.tid & 15) * 8;
#pragma unroll
          for (int j = 0; j < 4; ++j) { const int r = (F.tid >> 4) + 32 * j; float f[8]; unpack8(*(const v4u*)(P1 + (size_t)(row0 + r) * N_BCA + 4096 + g * 128 + c8), f);
              const float rs = rstd[r];
#pragma unroll
              for (int i = 0; i < 8; ++i) V[r * 128 + c8 + i] = f[i] * rs * norm_w[g * 128 + c8 + i]; }
          const int s4 = (F.tid & 31) * 4;
#pragma unroll
          for (int j = 0; j < 8; ++j) { const int t = (F.tid >> 5) + 16 * j; const f32x4 w = *(const f32x4*)(sgu_w + ((size_t)g * 128 + t) * 128 + s4);
              Wl[t * 129 + s4 + 0] = (s4 + 0 <= t) ? w.x : 0.f; Wl[t * 129 + s4 + 1] = (s4 + 1 <= t) ? w.y : 0.f; Wl[t * 129 + s4 + 2] = (s4 + 2 <= t) ? w.z : 0.f; Wl[t * 129 + s4 + 3] = (s4 + 3 <= t) ? w.w : 0.f; } }
        __syncthreads();
        const int ty = F.tid >> 4, tx = F.tid & 15;
        float acc[4][8];
#pragma unroll
        for (int i = 0; i < 4; ++i)
#pragma unroll
            for (int j = 0; j < 8; ++j) acc[i][j] = 0.f;
        for (int s = 0; s <= ty * 4 + 3; ++s) {
            const f32x4 v0 = *(const LAS f32x4*)(V + s * 128 + tx * 8), v1 = *(const LAS f32x4*)(V + s * 128 + tx * 8 + 4);
#pragma unroll
            for (int i = 0; i < 4; ++i) { const float w = Wl[(ty * 4 + i) * 129 + s];
                acc[i][0] += w * v0.x; acc[i][1] += w * v0.y; acc[i][2] += w * v0.z; acc[i][3] += w * v0.w; acc[i][4] += w * v1.x; acc[i][5] += w * v1.y; acc[i][6] += w * v1.z; acc[i][7] += w * v1.w; }
        }
#pragma unroll
        for (int i = 0; i < 4; ++i) { const int t = ty * 4 + i; const float bias = sgu_b[g * 128 + t];
            float uu[8], y[8]; unpack8(*(const v4u*)(P1 + (size_t)(row0 + t) * N_BCA + 3584 + g * 128 + tx * 8), uu);
#pragma unroll
            for (int j = 0; j < 8; ++j) y[j] = (acc[i][j] + bias) * uu[j];
            *(v4u*)(yc + (size_t)(row0 + t) * 512 + g * 128 + tx * 8) = pack8(y); }
        __syncthreads();
    }
}

__device__ __forceinline__ void p_hgrn_naive(Frame& F, const bf16* P1, const float* lb_logits  , int layer, const float* norm_w, bf16* yb) {
    LAS float* qf = (LAS float*)F.lds;
    LAS float* fd = qf + 4096; LAS float* kk = fd + 4096; LAS float* vv = kk + 4096; LAS float* O = vv + 4096;
    for (int u = F.bid; u < BATCH * H_B; u += F.G) {
        const int b = u >> 2, h = u & 3;
        const int dg = F.lane >> 4, j = (F.lane & 15) + 16 * F.wave;
        float S[32];
#pragma unroll
        for (int i = 0; i < 32; ++i) S[i] = 0.f;
        const int pc8 = (F.tid & 15) * 8, pt = F.tid >> 4;
        float lbv[8];
#pragma unroll
        for (int i = 0; i < 8; ++i) { const int ch = h * 128 + pc8 + i; const float l0 = lb_logits[ch], l1 = lb_logits[512 + ch]; const float mx = fmaxf(l0, l1);
            const float e0 = expf(l0 - mx), e1 = expf(l1 - mx); const float p0 = e0 / (e0 + e1), p1 = e1 / (e0 + e1);
            float lbx = (layer == 0) ? (p0 - p0) : ((p0 + p1) - p0); lbv[i] = fminf(fmaxf(lbx, 0.f), 1.f); }
        for (int tile = 0; tile < SEQ / 32; ++tile) {
            const int row0 = b * SEQ + tile * 32;
            { const bf16* p = P1 + (size_t)(row0 + pt) * N_BCA + 1536 + h * 128 + pc8;
              float q8[8], f8[8], i8[8]; unpack8(*(const v4u*)p, q8); unpack8(*(const v4u*)(p + 512), f8); unpack8(*(const v4u*)(p + 1024), i8);
#pragma unroll
              for (int i = 0; i < 8; ++i) { const float sg = 1.0f / (1.0f + expf(-f8[i])); const float lbb = lbv[i];
                  qf[pt * 128 + pc8 + i] = q8[i] / (1.0f + expf(-q8[i])); fd[pt * 128 + pc8 + i] = fmaxf(lbb, 1e-30f) + (1.0f - lbb) * sg;
                  kk[pt * 128 + pc8 + i] = (1.0f - lbb) * (1.0f - sg); vv[pt * 128 + pc8 + i] = i8[i]; } }
            __syncthreads();
            for (int t = 0; t < 32; ++t) {
                const float v = vv[t * 128 + j]; float part = 0.f;
#pragma unroll
                for (int i4 = 0; i4 < 8; ++i4) {
                    const f32x4 f4 = *(const LAS f32x4*)(fd + t * 128 + dg * 32 + i4 * 4), k4 = *(const LAS f32x4*)(kk + t * 128 + dg * 32 + i4 * 4), q4 = *(const LAS f32x4*)(qf + t * 128 + dg * 32 + i4 * 4);
                    S[i4 * 4 + 0] = f4.x * S[i4 * 4 + 0] + k4.x * v; part += q4.x * S[i4 * 4 + 0];
                    S[i4 * 4 + 1] = f4.y * S[i4 * 4 + 1] + k4.y * v; part += q4.y * S[i4 * 4 + 1];
                    S[i4 * 4 + 2] = f4.z * S[i4 * 4 + 2] + k4.z * v; part += q4.z * S[i4 * 4 + 2];
                    S[i4 * 4 + 3] = f4.w * S[i4 * 4 + 3] + k4.w * v; part += q4.w * S[i4 * 4 + 3];
                }
                part += __shfl_xor(part, 16); part += __shfl_xor(part, 32);
                if (dg == 0) O[t * 128 + j] = part;
            }
            __syncthreads();
            { float o8[8], g8[8], y[8]; float ss = 0.f;
#pragma unroll
              for (int i = 0; i < 8; ++i) { o8[i] = O[pt * 128 + pc8 + i]; ss += o8[i] * o8[i]; }
              ss += __shfl_xor(ss, 1); ss += __shfl_xor(ss, 2); ss += __shfl_xor(ss, 4); ss += __shfl_xor(ss, 8);
              const float rs = 1.0f / sqrtf(ss * (1.0f / 128.0f) + EPS);
              unpack8(*(const v4u*)(P1 + (size_t)(row0 + pt) * N_BCA + 3072 + h * 128 + pc8), g8);
#pragma unroll
              for (int i = 0; i < 8; ++i) y[i] = o8[i] * rs * norm_w[h * 128 + pc8 + i] * (g8[i] / (1.0f + expf(-g8[i])));
              *(v4u*)(yb + (size_t)(row0 + pt) * 512 + h * 128 + pc8) = pack8(y); }
            __syncthreads();
        }
    }
}


typedef short v4i16_t __attribute__((ext_vector_type(4)));
typedef short bf16x8_t __attribute__((ext_vector_type(8)));
typedef unsigned v2u __attribute__((ext_vector_type(2)));
constexpr int HRS = 272;
constexpr int H_RAWQ = 0, H_RAWF = 8704, H_V = 17408, H_QH = 26112, H_KT = 34816, H_KH = 43520, H_DL = 52224, H_OB = 52736, H_OBS = 132;
constexpr int HSEG = 512, HNSEG = SEQ / HSEG, HCH = 32;
__device__ __forceinline__ v4i16_t tr_read(LAS unsigned char* p) { return __builtin_amdgcn_ds_read_tr16_b64_v4i16((LAS v4i16_t*)p); }
__device__ __forceinline__ bf16x8_t cat4(v4i16_t lo, v4i16_t hi) { return __builtin_shufflevector(lo, hi, 0, 1, 2, 3, 4, 5, 6, 7); }
__device__ __forceinline__ bf16x8_t pack_acc(const f32x4 a, const f32x4 b) { v4u w; w.x = pk2(a[0], a[1]); w.y = pk2(a[2], a[3]); w.z = pk2(b[0], b[1]); w.w = pk2(b[2], b[3]); return __builtin_bit_cast(bf16x8_t, w); }
__device__ __forceinline__ unsigned short bf1(float x) { return (unsigned short)(pk2(x, x) & 0xffffu); }
template <int PASS>
__device__ __forceinline__ void p_hgrn(Frame& F, const bf16* P1, const float* lb_logits, int layer, const float* norm_w, bf16* yb, float* ust, float* dst) {
    LAS unsigned char* L = F.lds;
    const int lane = F.lane, w = F.wave, g = lane >> 4, n = lane & 15, q_ = n >> 2, p_ = n & 3;
    const int pt = F.tid >> 4, pc8 = (F.tid & 15) * 8;
    for (int u = F.bid; u < BATCH * H_B * HNSEG; u += F.G) {
        const int seg = u & (HNSEG - 1), bh = u / HNSEG, b = bh >> 2, h = bh & 3;
        const int d = 16 * w + n;
        float lb; { const int ch = h * 128 + d; const float l0 = lb_logits[ch], l1 = lb_logits[512 + ch]; const float mx = fmaxf(l0, l1);
            const float e0 = expf(l0 - mx), e1 = expf(l1 - mx); const float p0 = e0 / (e0 + e1), p1 = e1 / (e0 + e1);
            const float lbx = (layer == 0) ? (p0 - p0) : ((p0 + p1) - p0); lb = fminf(fmaxf(lbx, 0.f), 1.f); }
        const float lbf = fmaxf(lb, 1e-30f), oml = 1.0f - lb;
        f32x4 S[8];
#pragma unroll
        for (int kt = 0; kt < 8; ++kt) S[kt] = (f32x4){0.f, 0.f, 0.f, 0.f};
        if (PASS == 2) {
            for (int j = 0; j < seg; ++j) { const int uj = u - seg + j;
#pragma unroll
                for (int kt = 0; kt < 8; ++kt) { const f32x4 dj = *(const f32x4*)(dst + (size_t)uj * 128 + 16 * kt + 4 * g); const f32x4 uu = *(const f32x4*)(ust + ((((size_t)uj * 8 + w) * 8 + kt) * 64 + lane) * 4);
                    S[kt] = dj * S[kt] + uu; } }
        }
        float nw8[8];
        if (PASS == 2) {
#pragma unroll
            for (int i = 0; i < 8; ++i) nw8[i] = norm_w[h * 128 + pc8 + i]; }
        float bsum = 0.f;
        const bf16* gp = P1 + ((size_t)b * SEQ + (size_t)seg * HSEG + pt) * N_BCA + 1536 + h * 128 + pc8;
        v4u rq, rf, rv, rg;
        rf = *(const v4u*)(gp + 512); rv = *(const v4u*)(gp + 1024);
        if (PASS == 2) { rq = *(const v4u*)gp; rg = *(const v4u*)(gp + 1536); }
        for (int c = 0; c < HSEG / HCH; ++c) {
            *(LAS v4u*)(L + H_RAWF + pt * HRS + pc8 * 2) = rf; *(LAS v4u*)(L + H_V + pt * HRS + pc8 * 2) = rv;
            if (PASS == 2) *(LAS v4u*)(L + H_RAWQ + pt * HRS + pc8 * 2) = rq;
            v4u cg; if (PASS == 2) cg = rg;
            __syncthreads();
            if (c + 1 < HSEG / HCH) { const bf16* np = gp + (size_t)(c + 1) * HCH * N_BCA; rf = *(const v4u*)(np + 512); rv = *(const v4u*)(np + 1024);
                if (PASS == 2) { rq = *(const v4u*)np; rg = *(const v4u*)(np + 1536); } }
            { float lf[8], kk[8];
#pragma unroll
              for (int i = 0; i < 8; ++i) { const float fr = __uint_as_float((unsigned)(*(const LAS unsigned short*)(L + H_RAWF + (8 * g + i) * HRS + 2 * d)) << 16);
                  const float sg = __builtin_amdgcn_rcpf(1.0f + __expf(-fr)); const float f = lbf + oml * sg; lf[i] = __logf(f); kk[i] = oml * (1.0f - sg); }
              float cs = 0.f;
#pragma unroll
              for (int i = 0; i < 8; ++i) { cs += lf[i]; lf[i] = cs; }
              const float s1 = __shfl(cs, n), s2 = __shfl(cs, 16 + n), s3 = __shfl(cs, 32 + n), s4 = __shfl(cs, 48 + n);
              const float pre = (g > 0 ? s1 : 0.f) + (g > 1 ? s2 : 0.f) + (g > 2 ? s3 : 0.f);
              const float blast = ((s1 + s2) + s3) + s4;
#pragma unroll
              for (int i = 0; i < 8; ++i) { const float bb = pre + lf[i]; const int t = 8 * g + i;
                  *(LAS unsigned short*)(L + H_KH + t * HRS + 2 * d) = bf1(kk[i] * __expf(blast - bb));
                  if (PASS == 2) { const float qv = __uint_as_float((unsigned)(*(const LAS unsigned short*)(L + H_RAWQ + t * HRS + 2 * d)) << 16);
                      *(LAS unsigned short*)(L + H_QH + t * HRS + 2 * d) = bf1(siluf_(qv) * __expf(bb));
                      *(LAS unsigned short*)(L + H_KT + t * HRS + 2 * d) = bf1(kk[i] * __expf(fminf(-bb, 80.0f))); } }
              if (g == 0) *(LAS float*)(L + H_DL + 4 * d) = __expf(blast);
              bsum += blast; }
            __syncthreads();
            const bf16x8_t bV = cat4(tr_read(L + H_V + (4 * g + q_) * HRS + 32 * w + 8 * p_), tr_read(L + H_V + (16 + 4 * g + q_) * HRS + 32 * w + 8 * p_));
            if (PASS == 2) {
                f32x4 o[2], pt00 = {0.f, 0.f, 0.f, 0.f}, pt01 = {0.f, 0.f, 0.f, 0.f}, pt11 = {0.f, 0.f, 0.f, 0.f};
                o[0] = (f32x4){0.f, 0.f, 0.f, 0.f}; o[1] = (f32x4){0.f, 0.f, 0.f, 0.f};
#pragma unroll
                for (int ks = 0; ks < 4; ++ks) {
                    const bf16x8_t sb = pack_acc(S[2 * ks], S[2 * ks + 1]);
#pragma unroll
                    for (int tm = 0; tm < 2; ++tm) { const v2u lo = *(const LAS v2u*)(L + H_QH + (16 * tm + n) * HRS + (32 * ks + 4 * g) * 2), hi = *(const LAS v2u*)(L + H_QH + (16 * tm + n) * HRS + (32 * ks + 16 + 4 * g) * 2);
                        v4u aw; aw.x = lo.x; aw.y = lo.y; aw.z = hi.x; aw.w = hi.y;
                        o[tm] = __builtin_amdgcn_mfma_f32_16x16x32_bf16(__builtin_bit_cast(bf16x8_t, aw), sb, o[tm], 0, 0, 0); }
                    const bf16x8_t aK0 = *(const LAS bf16x8_t*)(L + H_KT + n * HRS + (32 * ks + 8 * g) * 2), aK1 = *(const LAS bf16x8_t*)(L + H_KT + (16 + n) * HRS + (32 * ks + 8 * g) * 2);
                    const bf16x8_t bQ0 = *(const LAS bf16x8_t*)(L + H_QH + n * HRS + (32 * ks + 8 * g) * 2), bQ1 = *(const LAS bf16x8_t*)(L + H_QH + (16 + n) * HRS + (32 * ks + 8 * g) * 2);
                    pt00 = __builtin_amdgcn_mfma_f32_16x16x32_bf16(aK0, bQ0, pt00, 0, 0, 0);
                    pt01 = __builtin_amdgcn_mfma_f32_16x16x32_bf16(aK0, bQ1, pt01, 0, 0, 0);
                    pt11 = __builtin_amdgcn_mfma_f32_16x16x32_bf16(aK1, bQ1, pt11, 0, 0, 0);
                }
#pragma unroll
                for (int j = 0; j < 4; ++j) if (4 * g + j > n) { pt00[j] = 0.f; pt11[j] = 0.f; }
                const f32x4 z4 = {0.f, 0.f, 0.f, 0.f};
                o[0] = __builtin_amdgcn_mfma_f32_16x16x32_bf16(pack_acc(pt00, z4), bV, o[0], 0, 0, 0);
                o[1] = __builtin_amdgcn_mfma_f32_16x16x32_bf16(pack_acc(pt01, pt11), bV, o[1], 0, 0, 0);
#pragma unroll
                for (int tm = 0; tm < 2; ++tm)
#pragma unroll
                    for (int j = 0; j < 4; ++j) *(LAS float*)(L + H_OB + ((16 * tm + 4 * g + j) * H_OBS + 16 * w + n) * 4) = o[tm][j];
            }
#pragma unroll
            for (int kt = 0; kt < 8; ++kt) { const f32x4 dl4 = *(const LAS f32x4*)(L + H_DL + (16 * kt + 4 * g) * 4);
                const bf16x8_t aKh = cat4(tr_read(L + H_KH + (4 * g + q_) * HRS + 32 * kt + 8 * p_), tr_read(L + H_KH + (16 + 4 * g + q_) * HRS + 32 * kt + 8 * p_));
                S[kt] = __builtin_amdgcn_mfma_f32_16x16x32_bf16(aKh, bV, S[kt] * dl4, 0, 0, 0); }
            __syncthreads();
            if (PASS == 2) {
                const f32x4 o0 = *(const LAS f32x4*)(L + H_OB + (pt * H_OBS + pc8) * 4), o1 = *(const LAS f32x4*)(L + H_OB + (pt * H_OBS + pc8 + 4) * 4);
                const float o8[8] = {o0.x, o0.y, o0.z, o0.w, o1.x, o1.y, o1.z, o1.w};
                float ss = 0.f;
#pragma unroll
                for (int i = 0; i < 8; ++i) ss += o8[i] * o8[i];
                ss += __shfl_xor(ss, 1); ss += __shfl_xor(ss, 2); ss += __shfl_xor(ss, 4); ss += __shfl_xor(ss, 8);
                const float rs = 1.0f / sqrtf(ss * (1.0f / 128.0f) + EPS);
                float g8[8], y[8]; unpack8(cg, g8);
#pragma unroll
                for (int i = 0; i < 8; ++i) y[i] = o8[i] * rs * nw8[i] * siluf_(g8[i]);
                *(v4u*)(yb + ((size_t)b * SEQ + (size_t)seg * HSEG + (size_t)c * HCH + pt) * 512 + h * 128 + pc8) = pack8(y);
            }
        }
        if (PASS == 1) {
#pragma unroll
            for (int kt = 0; kt < 8; ++kt) *(f32x4*)(ust + ((((size_t)u * 8 + w) * 8 + kt) * 64 + lane) * 4) = S[kt];
            if (g == 0) dst[(size_t)u * 128 + d] = __expf(bsum);
        }
        __syncthreads();
    }
}

__device__ __forceinline__ void p_norm_router(Frame& F, KArgs ka, const float* x, const float* w, const float* mod_l, bf16* h2) {
    const float* rw = ka->in[20]; const float* rb = ka->in[21]; unsigned* ctl = (unsigned*)(ka->ws + WS_CTL);
    float* topp = (float*)(ka->ws + WS_TOPP); int* list = (int*)(ka->ws + WS_LIST);
    LAS float* RWt = (LAS float*)F.lds;
    LAS int* lcnt = (LAS int*)(RWt + 8192);
    LAS int* lbase = lcnt + 16;
    LAS int* sel = lbase + 16;
    LAS int* rnk = sel + 128;
    for (int i = F.tid; i < D * NE; i += NT) { const int k = i >> 3, e = i & 7; RWt[e * D + k] = rw[i]; }
    __syncthreads();
    for (int batch = F.bid; batch < M / 128; batch += F.G) {
        const int row0 = batch * 128;
        if (F.tid < 16) lcnt[F.tid] = 0;
        __syncthreads();
        for (int rr = 0; rr < 16; ++rr) {
            const int r = F.wave * 16 + rr, row = row0 + r;
            const float* mb = mod_l + (size_t)(row >> 12) * MOD_LD;
            f32x4 o[4]; norm_row(x + (size_t)row * D, w, mb + 4 * D, mb + 3 * D, F.lane, o);
            store_row_bf16(h2 + (size_t)row * D, F.lane, o);
            float lg[8];
#pragma unroll
            for (int e = 0; e < 8; ++e) { float s = 0.f;
#pragma unroll
                for (int j = 0; j < 4; ++j) { const f32x4 r4 = *(const LAS f32x4*)(RWt + e * D + 4 * F.lane + 256 * j); s += (o[j].x * r4.x + o[j].y * r4.y) + (o[j].z * r4.z + o[j].w * r4.w); }
                lg[e] = wave_sum(s) + rb[e]; }
            int i0 = 0; float v0 = lg[0];
#pragma unroll
            for (int e = 1; e < 8; ++e) if (lg[e] > v0) { v0 = lg[e]; i0 = e; }
            int i1 = -1; float v1 = -3.0e38f;
#pragma unroll
            for (int e = 0; e < 8; ++e) if (e != i0 && lg[e] > v1) { v1 = lg[e]; i1 = e; }
            if (F.lane == 0) {
                const float p0 = 1.0f / (1.0f + expf(v1 - v0));
                topp[(size_t)row * 2] = p0; topp[(size_t)row * 2 + 1] = 1.0f - p0;
                const int rk0 = __hip_atomic_fetch_add(lcnt + i0, 1, __ATOMIC_RELAXED, __HIP_MEMORY_SCOPE_WORKGROUP), rk1 = __hip_atomic_fetch_add(lcnt + 8 + i1, 1, __ATOMIC_RELAXED, __HIP_MEMORY_SCOPE_WORKGROUP);
                sel[r] = i0 | (i1 << 8); rnk[r] = rk0 | (rk1 << 16);
            }
        }
        __syncthreads();
        if (F.tid < 16) lbase[F.tid] = (int)__hip_atomic_fetch_add(ctl + CW_CNT + 64 * F.tid, (unsigned)lcnt[F.tid], __ATOMIC_RELAXED, __HIP_MEMORY_SCOPE_AGENT);
        __syncthreads();
        if (F.tid < 128) { const int sv = sel[F.tid], rv = rnk[F.tid]; const int e0 = sv & 255, e1 = sv >> 8;
            list[(size_t)e0 * LIST_CAP + lbase[e0] + (rv & 0xffff)] = row0 + F.tid;
            list[(size_t)(8 + e1) * LIST_CAP + lbase[8 + e1] + (rv >> 16)] = row0 + F.tid; }
        __syncthreads();
    }
}
__device__ __forceinline__ void moe_tables(Frame& F, unsigned* ctl, int pass) {
    LAS int* tab = (LAS int*)(F.lds + TAB_OFF);
    __syncthreads();
    if (F.tid == 0) { int pb = 0;
        for (int e = 0; e < 8; ++e) { int c = (int)__hip_atomic_load(ctl + CW_CNT + 64 * (pass * 8 + e), __ATOMIC_RELAXED, __HIP_MEMORY_SCOPE_AGENT); if (c > LIST_CAP) c = LIST_CAP; if (c < 0) c = 0;
            const int np = (c + 255) >> 8; tab[e] = c; tab[8 + e] = pb; for (int p = 0; p < np; ++p) tab[32 + pb + p] = e; pb += np; }
        tab[16] = pb; }
    __syncthreads();
}
template <bool GATHER_>
struct MoeOrder {
    static constexpr bool GATHER = GATHER_;
    pg8::StaticOrder so; const LAS int* tab; const int* list; int npn; unsigned rowbytes;
    __device__ __forceinline__ bool next(int i, pg8::Unit& u) const { if (!so.next(i, u)) return false; u.pb = tab[32 + u.pm] * npn + u.pn; return true; }
    __device__ __forceinline__ int tok_of(int pm, int r) const { const int e = tab[32 + pm]; const int idx = (pm - tab[8 + e]) * 256 + r; return idx < tab[e] ? list[(size_t)e * LIST_CAP + idx] : -1; }
    __device__ __forceinline__ unsigned a_row_off(const pg8::Unit& u, int r) const { const int t = tok_of(u.pm, r); return (unsigned)(t < 0 ? 0 : t) * rowbytes; }
};

struct EpiBranch {
    static constexpr bool PERM = true;
    const bf16* gate; bf16* mrg; int first;
    __device__ __forceinline__ void operator()(const pg8::f32x4 (&acc)[2][2][4][2], const pg8::Unit& u, int wr, int wc, int fr, int fq) const {
        const int row0 = u.pm * 256 + wr * 64 + fr, col0 = u.pn * 256 + wc * 32 + 8 * fq;
#pragma unroll
        for (int ai = 0; ai < 2; ++ai)
#pragma unroll
            for (int m = 0; m < 4; ++m) { const size_t row = (size_t)(row0 + ai * 128 + m * 16);
#pragma unroll
                for (int bj = 0; bj < 2; ++bj) { const int col = col0 + bj * 128;
                    float gg[8], mm[8], o[8]; unpack8(*(const v4u*)(gate + row * N_G + col), gg);
                    if (first) {
#pragma unroll
                        for (int i = 0; i < 8; ++i) mm[i] = 0.f; } else unpack8(*(const v4u*)(mrg + row * D + col), mm);
                    const pg8::f32x4 v0 = acc[ai][bj][m][0], v1 = acc[ai][bj][m][1];
                    o[0] = mm[0] + sigmoidf_(gg[0]) * v0[0]; o[1] = mm[1] + sigmoidf_(gg[1]) * v0[1]; o[2] = mm[2] + sigmoidf_(gg[2]) * v0[2]; o[3] = mm[3] + sigmoidf_(gg[3]) * v0[3];
                    o[4] = mm[4] + sigmoidf_(gg[4]) * v1[0]; o[5] = mm[5] + sigmoidf_(gg[5]) * v1[1]; o[6] = mm[6] + sigmoidf_(gg[6]) * v1[2]; o[7] = mm[7] + sigmoidf_(gg[7]) * v1[3];
                    *(v4u*)(mrg + row * D + col) = pack8(o); }
                asm volatile("" ::: "memory"); }
    }
};
struct EpiResid {
    static constexpr bool PERM = false;
    const float* xin; float* xout; const float* gmod;
    __device__ __forceinline__ void operator()(const pg8::f32x4 (&acc)[2][2][4][2], const pg8::Unit& u, int wr, int wc, int fr, int fq) const {
        const int row0 = u.pm * 256 + wr * 64 + fr, col0 = u.pn * 256 + wc * 32 + 4 * fq;
        const float* gb = gmod + (size_t)((u.pm * 256) >> 12) * MOD_LD + col0;
        pg8::f32x4 gv[2][2];
#pragma unroll
        for (int bj = 0; bj < 2; ++bj)
#pragma unroll
            for (int n = 0; n < 2; ++n) gv[bj][n] = *(const pg8::f32x4*)(gb + bj * 128 + n * 16);
#pragma unroll
        for (int ai = 0; ai < 2; ++ai)
#pragma unroll
            for (int m = 0; m < 4; ++m) { const size_t off = (size_t)(row0 + ai * 128 + m * 16) * D + col0;
#pragma unroll
                for (int bj = 0; bj < 2; ++bj)
#pragma unroll
                    for (int n = 0; n < 2; ++n) { const pg8::f32x4 xv = *(const pg8::f32x4*)(xin + off + bj * 128 + n * 16);
                        *(pg8::f32x4*)(xout + off + bj * 128 + n * 16) = xv + gv[bj][n] * acc[ai][bj][m][n]; }
                asm volatile("" ::: "memory"); }
    }
};
struct EpiSwiglu {
    static constexpr bool PERM = true;
    bf16* act;
    __device__ __forceinline__ void operator()(const pg8::f32x4 (&acc)[2][2][4][2], const pg8::Unit& u, int wr, int wc, int fr, int fq) const {
        const int row0 = u.pm * 256 + wr * 64 + fr, col0 = u.pn * 128 + wc * 32 + 8 * fq;
#pragma unroll
        for (int ai = 0; ai < 2; ++ai)
#pragma unroll
            for (int m = 0; m < 4; ++m) { float o[8];
#pragma unroll
                for (int n = 0; n < 2; ++n)
#pragma unroll
                    for (int i = 0; i < 4; ++i) o[n * 4 + i] = siluf_(acc[ai][0][m][n][i]) * acc[ai][1][m][n][i];
                *(v4u*)(act + (size_t)(row0 + ai * 128 + m * 16) * D_FF + col0) = pack8(o); }
    }
};
struct EpiMoeDown {
    static constexpr bool PERM = false;
    float* x; const float* gmod; const float* topp; int pass; const LAS int* tab; const int* list;
    __device__ __forceinline__ int tok_of(int pm, int r) const { const int e = tab[32 + pm]; const int idx = (pm - tab[8 + e]) * 256 + r; return idx < tab[e] ? list[(size_t)e * LIST_CAP + idx] : -1; }
    __device__ __forceinline__ void operator()(const pg8::f32x4 (&acc)[2][2][4][2], const pg8::Unit& u, int wr, int wc, int fr, int fq) const {
        const int col0 = u.pn * 256 + wc * 32 + 4 * fq;
#pragma unroll
        for (int ai = 0; ai < 2; ++ai)
#pragma unroll
            for (int m = 0; m < 4; ++m) { const int tok = tok_of(u.pm, ai * 128 + wr * 64 + m * 16 + fr);
                if (tok >= 0) { const float p = topp[(size_t)tok * 2 + pass]; const float* gb = gmod + (size_t)(tok >> 12) * MOD_LD + col0; float* xr = x + (size_t)tok * D + col0;
#pragma unroll
                    for (int bj = 0; bj < 2; ++bj)
#pragma unroll
                        for (int n = 0; n < 2; ++n) { const pg8::f32x4 gv = *(const pg8::f32x4*)(gb + bj * 128 + n * 16); const pg8::f32x4 xv = *(const pg8::f32x4*)(xr + bj * 128 + n * 16);
                            *(pg8::f32x4*)(xr + bj * 128 + n * 16) = xv + gv * p * acc[ai][bj][m][n]; } }
                asm volatile("" ::: "memory"); }
    }
};

__device__ __forceinline__ void p_final_norm(Frame& F, float* x, const float* w) {
    const int gw = F.bid * NWAVES + F.wave, NGW = F.G * NWAVES;
    for (int row = gw; row < M; row += NGW) {
        f32x4* xr = (f32x4*)(x + (size_t)row * D) + F.lane;
        f32x4 v[4]; float s = 0.f;
#pragma unroll
        for (int j = 0; j < 4; ++j) { v[j] = xr[64 * j]; s += (v[j].x * v[j].x + v[j].y * v[j].y) + (v[j].z * v[j].z + v[j].w * v[j].w); }
        const float rstd = 1.0f / sqrtf(wave_sum(s) * (1.0f / D) + EPS);
#pragma unroll
        for (int j = 0; j < 4; ++j) xr[64 * j] = v[j] * rstd * ((const f32x4*)w)[F.lane + 64 * j];
    }
}

__device__ __forceinline__ bool fresh(Frame& F) {
    int t_ = threadIdx.x, b_ = blockIdx.x, g_ = gridDim.x; asm volatile("" : "+v"(t_), "+s"(b_), "+s"(g_));
    F.tid = t_; F.lane = t_ & 63; F.wave = __builtin_amdgcn_readfirstlane(t_ >> 6); F.bid = b_; F.G = g_; return true;
}
constexpr int NPL = 13, NPHASE = 1 + DEPTH * NPL;
__global__ void __launch_bounds__(NT, 2) fwd(Args args) {
    extern __shared__ __attribute__((aligned(16))) unsigned char lds[];
    Frame F;
    F.lds = (LAS unsigned char*)lds;
    F.tid = threadIdx.x; F.lane = F.tid & 63; F.wave = __builtin_amdgcn_readfirstlane(F.tid >> 6);
    F.G = gridDim.x; F.bid = blockIdx.x;
    volatile LAS unsigned* MISC = (volatile LAS unsigned*)(F.lds + MISC_OFF);
    if (F.tid < 32) MISC[F.tid] = 0u;
    __syncthreads();
#if MK_PER_PHASE
#define GRID_BAR() do { } while (0)
#else
    XcdBarrier bar = xcd_barrier_post((unsigned*)(KA()->ws + WS_CTL) + CW_BAR, MISC + 8);
#define GRID_BAR() xcd_barrier(bar)
#endif
    const int lo = KA()->ph_lo, hi = KA()->ph_hi;
#ifdef ONLY_REL
#define IN(k) (fresh(F) && ((k) == 0 ? 100 : ((k) - 1) % NPL) == ONLY_REL && (ONLY_L < 0 || ((k) - 1) / NPL == ONLY_L) && lo <= (k) && (k) < hi)
#else
#define IN(k) (lo <= (k) && (k) < hi && fresh(F))
#endif
#define SEAM(k) do { if ((k) + 1 < hi) GRID_BAR(); } while (0)
    PG8_LAS unsigned char* ring = (PG8_LAS unsigned char*)lds;

    if (IN(0)) { p_prologue(F, KA()); SEAM(0); }

#ifdef UNROLL_L
#pragma unroll
#else
#pragma unroll 1
#endif
    for (int l = 0; l < DEPTH; ++l) {
        const int pb = 1 + l * NPL;
#define WSP(off) (ka->ws + (off))
#define MODL ((const float*)WSP(WS_MOD) + (size_t)l * BATCH * MOD_LD)
#define WMIXL ((bf16*)WSP(WS_WMIX + (size_t)l * WMIX_STRIDE))
        if (IN(pb + 0)) { KArgs ka = KA(); p_norm(F, l == 0 ? ka->in[0] : (const float*)ka->out, ka->in[4] + l * D, MODL, 1 * D, 0, (bf16*)WSP(WS_H)); SEAM(pb + 0); }
        if (IN(pb + 1)) {
            KArgs ka = KA();
            pg8::Gemm g{(bf16*)WSP(WS_H), WMIXL, D, D, D}; pg8::StaticOrder S; S.init(M / 256, N_BCA / 256, F.G, F.bid);
            pg8::EpiBf16 E{(bf16*)WSP(WS_P1), N_BCA};
            pg8::gemm_phase(ring, g, S, E); SEAM(pb + 1);
        }
        if (IN(pb + 2)) {
            { KArgs ka = KA(); p_hgrn<1>(F, (const bf16*)WSP(WS_P1), ka->in[8], l, ka->in[9] + l * D_BV, (bf16*)WSP(WS_YB), (float*)WSP(WS_HU), (float*)WSP(WS_HD)); }
            __syncthreads();
            { KArgs ka = KA(); p_sgu(F, (const bf16*)WSP(WS_P1), ka->in[10] + l * D_C, ka->in[11] + (size_t)l * 4 * 128 * 128, ka->in[12] + l * 4 * 128, (bf16*)WSP(WS_YC)); }
            { KArgs ka = KA(); p_conv(F, (const bf16*)WSP(WS_P1), ka->in[7] + l * 3 * D_A, (bf16*)WSP(WS_YA)); }
            SEAM(pb + 2);
        }
        if (IN(pb + 3)) {
            { KArgs ka = KA(); p_hgrn<2>(F, (const bf16*)WSP(WS_P1), ka->in[8], l, ka->in[9] + l * D_BV, (bf16*)WSP(WS_YB), (float*)WSP(WS_HU), (float*)WSP(WS_HD)); }
            SEAM(pb + 3);
        }
        if (IN(pb + 4)) {
            KArgs ka = KA();
            pg8::Gemm g{(bf16*)WSP(WS_H), WMIXL + (size_t)N_BCA * D, D, D, D}; pg8::StaticOrder S; S.init(M / 256, N_G / 256, F.G, F.bid);
            pg8::EpiBf16 E{(bf16*)WSP(WS_PG), N_G};
            pg8::gemm_phase(ring, g, S, E); SEAM(pb + 4);
        }
        if (IN(pb + 5)) {
#pragma unroll 1
            for (int br = 0; br < 3; ++br) {
                KArgs ka = KA();
                pg8::Gemm g{(bf16*)WSP(WS_YA + (size_t)br * 32 * MiB), WMIXL + (size_t)N_IN * D + (size_t)br * 512 * 1024, 512, 512, 512}; pg8::StaticOrder S; S.init(M / 256, D / 256, F.G, F.bid);
                EpiBranch E{(const bf16*)WSP(WS_PG) + br * D, (bf16*)WSP(WS_MRG), br == 0 ? 1 : 0};
                pg8::gemm_phase(ring, g, S, E);
            }
            SEAM(pb + 5);
        }
        if (IN(pb + 6)) {
            KArgs ka = KA();
            pg8::Gemm g{(bf16*)WSP(WS_MRG), WMIXL + (size_t)N_IN * D + 3 * 512 * 1024, D, D, D}; pg8::StaticOrder S; S.init(M / 256, D / 256, F.G, F.bid);
            EpiResid E{l == 0 ? ka->in[0] : (const float*)ka->out, ka->out, MODL + 2 * D};
            pg8::gemm_phase(ring, g, S, E); SEAM(pb + 6);
        }
        if (l == 0) {
            if (IN(pb + 7)) { KArgs ka = KA(); p_norm(F, ka->out, ka->in[5] + l * D, MODL, 4 * D, 3 * D, (bf16*)WSP(WS_H)); SEAM(pb + 7); }
            if (IN(pb + 8)) {
                KArgs ka = KA();
                pg8::Gemm g{(bf16*)WSP(WS_H), (bf16*)WSP(WS_W13), D, D, D}; pg8::StaticOrder S; S.init(M / 256, N13 / 256, F.G, F.bid);
                EpiSwiglu E{(bf16*)WSP(WS_ACT)};
                pg8::gemm_phase(ring, g, S, E); SEAM(pb + 8);
            }
            if (IN(pb + 9)) {
                KArgs ka = KA();
                pg8::Gemm g{(bf16*)WSP(WS_ACT), (bf16*)WSP(WS_W2), D_FF, D_FF, D_FF}; pg8::StaticOrder S; S.init(M / 256, D / 256, F.G, F.bid);
                EpiResid E{ka->out, ka->out, MODL + 5 * D};
                pg8::gemm_phase(ring, g, S, E); SEAM(pb + 9);
            }
        } else {
            if (IN(pb + 7)) { p_moe_weights(F, KA()); __syncthreads(); { KArgs ka = KA(); p_norm_router(F, ka, ka->out, ka->in[5] + l * D, MODL, (bf16*)WSP(WS_H2M)); } SEAM(pb + 7); }
#pragma unroll 1
            for (int pass = 0; pass < 2; ++pass) {
#ifndef NO_MOE_UP
                if (IN(pb + 8 + 2 * pass)) {
                    KArgs ka = KA();
                    moe_tables(F, (unsigned*)WSP(WS_CTL), pass);
                    const LAS int* tab = (const LAS int*)(F.lds + TAB_OFF);
                    MoeOrder<true> S; S.so.init(tab[16], N13 / 256, F.G, F.bid); S.tab = tab; S.list = (const int*)WSP(WS_LIST) + (size_t)pass * 8 * LIST_CAP; S.npn = N13 / 256; S.rowbytes = D * 2;
                    pg8::Gemm g{(bf16*)WSP(WS_H2M), (bf16*)WSP(WS_WM13), D, D, D};
                    EpiSwiglu E{(bf16*)WSP(WS_ACTM)};
                    pg8::gemm_phase(ring, g, S, E); SEAM(pb + 8 + 2 * pass);
                }
#endif
#ifndef NO_MOE_DOWN
                if (IN(pb + 9 + 2 * pass)) {
                    KArgs ka = KA();
                    moe_tables(F, (unsigned*)WSP(WS_CTL), pass);
                    const LAS int* tab = (const LAS int*)(F.lds + TAB_OFF);
                    MoeOrder<false> S; S.so.init(tab[16], D / 256, F.G, F.bid); S.tab = tab; S.list = (const int*)WSP(WS_LIST) + (size_t)pass * 8 * LIST_CAP; S.npn = D / 256; S.rowbytes = 0;
                    pg8::Gemm g{(bf16*)WSP(WS_ACTM), (bf16*)WSP(WS_WM2), D_FF, D_FF, D_FF};
                    EpiMoeDown E{ka->out, MODL + 5 * D, (const float*)WSP(WS_TOPP), pass, tab, S.list};
                    pg8::gemm_phase(ring, g, S, E); SEAM(pb + 9 + 2 * pass);
                }
#endif
            }
            if (IN(pb + 12)) { KArgs ka = KA(); p_final_norm(F, ka->out, ka->in[25]); }
        }
    }
#undef IN
#undef SEAM
}

extern "C" void kernel_launch(void* const* d_in, const int* in_sizes, int n_in, void* d_out, int out_size, void* d_ws, size_t ws_size, hipStream_t stream) {
    static int grid = 0;
    if (grid == 0) {
        if (n_in != 26 || in_sizes[0] != M * D || out_size != M * D || ws_size < WS_NEED) { fprintf(stderr, "kernel_launch: unexpected shapes / workspace (n_in %d, ws %zu, need %zu); nothing launched\n", n_in, ws_size, (size_t)WS_NEED); grid = -1; return; }
        int dev = 0, cus = 0, per_cu = 0;
        if (hipGetDevice(&dev) != hipSuccess || hipDeviceGetAttribute(&cus, hipDeviceAttributeMultiprocessorCount, dev) != hipSuccess) { grid = -1; return; }
        if (hipFuncSetAttribute((const void*)fwd, hipFuncAttributeMaxDynamicSharedMemorySize, LDS_BYTES) != hipSuccess) { fprintf(stderr, "kernel_launch: hipFuncSetAttribute failed\n"); grid = -1; return; }
        if (hipOccupancyMaxActiveBlocksPerMultiprocessor(&per_cu, (const void*)fwd, NT, LDS_BYTES) != hipSuccess || per_cu < 1) fprintf(stderr, "kernel_launch: occupancy query reports %d\n", per_cu);
        (void)hipGetLastError();
        grid = cus;
    }
    if (grid < 0) return;
    if (hipMemsetAsync((char*)d_ws + WS_CTL, 0, CTL_ZERO_BYTES, stream) != hipSuccess) return;
    Args a{};
    for (int i = 0; i < 26; ++i) a.in[i] = (const float*)d_in[i];
    a.out = (float*)d_out; a.ws = (unsigned char*)d_ws;
#if MK_PER_PHASE
    for (int p = 0; p < NPHASE; ++p) {
        if (p >= 1 + 10 && p <= 1 + 12) continue;
        a.ph_lo = p; a.ph_hi = p + 1;
        hipLaunchKernelGGL(fwd, dim3(grid), dim3(NT), LDS_BYTES, stream, a);
    }
#else
    a.ph_lo = 0; a.ph_hi = NPHASE;
    hipLaunchKernelGGL(fwd, dim3(grid), dim3(NT), LDS_BYTES, stream, a);
#endif
}
```

```cpp
#include <hip/hip_runtime.h>
#include <cstdio>
#include <cstdint>

#ifndef PROBE_DUP
#define PROBE_DUP 0
#endif
#ifndef PROBE_REPS
#define PROBE_REPS 2
#endif
#define REPS(k) ((PROBE_DUP == (k)) ? PROBE_REPS : 1)
#ifndef MK_PER_PHASE
#define MK_PER_PHASE 0
#endif

namespace pg8 {
#define PG8_LAS __attribute__((address_space(3)))
typedef unsigned short bf16_t;
typedef short bf16x8 __attribute__((ext_vector_type(8)));
typedef float f32x4 __attribute__((ext_vector_type(4)));
typedef unsigned u32x4 __attribute__((ext_vector_type(4)));
constexpr int BM = 256, BK = 64, HALF = 128, HTB = HALF * BK * 2, STAGE_BYTES = 8 * HTB, NXCD = 8, WGM = 8;

__host__ __device__ __forceinline__ int lds_byte(int r, int c) { const int st = (r >> 4) * 2 + (c >> 5), rr = r & 15, cc = c & 31, ob = rr * 64 + cc * 2; return st * 1024 + (ob ^ (((ob >> 9) & 1) << 5)); }
__host__ __device__ __forceinline__ void stage_rc(int b, int& R, int& C) { const int st = b / 1024, sb = b % 1024, swz = sb ^ (((sb >> 9) & 1) << 5); R = (st >> 1) * 16 + swz / 64; C = (st & 1) * 32 + (swz % 64) / 2; }
__host__ __device__ __forceinline__ int perm32(int rho) { const int n = rho >> 4, i = rho & 15; return 8 * (i >> 2) + 4 * n + (i & 3); }

struct Unit { int pm, pn, pb; };
struct Gemm { const bf16_t* A; const bf16_t* Bt; int lda, ldb, K; };

struct StaticOrder {
    static constexpr bool GATHER = false;
    int nM, nN, nwg, G, c;
    __device__ __forceinline__ void init(int nM_, int nN_, int G_, int c_) { nM = nM_; nN = nN_; nwg = nM * nN; G = G_; c = c_; }
    __device__ __forceinline__ bool next(int i, Unit& u) const {
        const long L = (long)i * G + c; if (L >= nwg) return false;
        int wgid = (int)L; { const int q = nwg / NXCD, r = nwg % NXCD, xcd = wgid % NXCD, off = wgid / NXCD; wgid = (xcd < r ? xcd * (q + 1) : r * (q + 1) + (xcd - r) * q) + off; }
        const int nig = WGM * nN, gid = wgid / nig, fm = gid * WGM, gsz = (nM - fm) < WGM ? (nM - fm) : WGM;
        u.pm = fm + ((wgid % nig) % gsz); u.pn = (wgid % nig) / gsz; u.pb = u.pn; return true;
    }
    __device__ __forceinline__ unsigned a_row_off(const Unit&, int) const { return 0u; }
};

__device__ __forceinline__ unsigned cvt_pk_bf16(float lo, float hi) { unsigned r; asm volatile("v_cvt_pk_bf16_f32 %0, %1, %2" : "=v"(r) : "v"(lo), "v"(hi)); return r; }

struct EpiBf16 {
    static constexpr bool PERM = true;
    bf16_t* O; int ldc;
    __device__ __forceinline__ void operator()(const f32x4 (&acc)[2][2][4][2], const Unit& u, int wr, int wc, int fr, int fq) const {
        const int row0 = u.pm * BM + wr * 64 + fr, col0 = u.pn * BM + wc * 32 + 8 * fq;
#pragma unroll
        for (int ai = 0; ai < 2; ++ai)
#pragma unroll
            for (int m = 0; m < 4; ++m) { bf16_t* rowp = O + (size_t)(row0 + ai * HALF + m * 16) * ldc + col0;
#pragma unroll
                for (int bj = 0; bj < 2; ++bj) { const f32x4 v0 = acc[ai][bj][m][0], v1 = acc[ai][bj][m][1];
                    u32x4 w; w.x = cvt_pk_bf16(v0[0], v0[1]); w.y = cvt_pk_bf16(v0[2], v0[3]); w.z = cvt_pk_bf16(v1[0], v1[1]); w.w = cvt_pk_bf16(v1[2], v1[3]);
                    *(u32x4*)(rowp + bj * HALF) = w; } }
    }
};

template <class Epi, class Sched>
__device__ __forceinline__ void gemm_phase(PG8_LAS unsigned char* lds, const Gemm g, const Sched& S, const Epi& E) {
    constexpr bool GATHER = Sched::GATHER;
    int tid_ = threadIdx.x; asm volatile("" : "+v"(tid_));
    const int tid = tid_, wid = __builtin_amdgcn_readfirstlane(tid >> 6), lane = tid & 63, wr = wid >> 2, wc = wid & 3, fr = lane & 15, fq = lane >> 4;
    const int K = g.K, nt = K / BK;
    unsigned voffB[2], vA0[2], vA1[2], nA0[2], nA1[2];
#pragma unroll
    for (int i = 0; i < 2; ++i) { int R, C; stage_rc(tid * 16 + i * 8192, R, C); const int Rb = Epi::PERM ? ((R & ~31) + perm32(R & 31)) : R;
        voffB[i] = (unsigned)(Rb * g.ldb + C) * 2u;
        vA0[i] = (unsigned)(R * g.lda + C) * 2u; vA1[i] = vA0[i]; nA0[i] = vA0[i]; nA1[i] = vA0[i]; }
    const size_t kstep = (size_t)(BK * 2);
    const size_t hstepB = (size_t)HALF * g.ldb * 2, tstepB = 2 * hstepB, tstepA = (size_t)BM * g.lda * 2;
    const size_t hstepA = GATHER ? (size_t)0 : (size_t)HALF * g.lda * 2;
    const unsigned ldsw = (unsigned)wid * 1024u;
    const int aoff = lds_byte(wr * 64 + fr, fq * 8), boff = lds_byte(wc * 32 + fr, fq * 8);
#define PG8_SA(b, h) (((b) * 2 + (h)) * HTB)
#define PG8_SB(b, h) ((4 + (b) * 2 + (h)) * HTB)
#define PG8_STAGE(bufoff, gbase, voff) do { _Pragma("unroll") for (int _i = 0; _i < 2; ++_i) \
        __builtin_amdgcn_global_load_lds((const unsigned*)((const char*)(gbase) + (voff)[_i]), (PG8_LAS unsigned*)(lds + (bufoff) + ldsw + _i * 8192), 16, 0, 0); } while (0)
#define PG8_LDA(dst, b, h) do { _Pragma("unroll") for (int m = 0; m < 4; ++m) _Pragma("unroll") for (int k = 0; k < 2; ++k) dst[m][k] = *(const PG8_LAS bf16x8*)(lds + PG8_SA(b, h) + aoff + m * 2048 + k * 1024); } while (0)
#define PG8_LDB(dst, b, h) do { _Pragma("unroll") for (int n = 0; n < 2; ++n) _Pragma("unroll") for (int k = 0; k < 2; ++k) dst[n][k] = *(const PG8_LAS bf16x8*)(lds + PG8_SB(b, h) + boff + n * 2048 + k * 1024); } while (0)
#define PG8_MMA(ai, bj, At, Bt) do { __builtin_amdgcn_s_setprio(1); _Pragma("unroll") for (int m = 0; m < 4; ++m) _Pragma("unroll") for (int n = 0; n < 2; ++n) _Pragma("unroll") for (int k = 0; k < 2; ++k) \
        acc[ai][bj][m][n] = __builtin_amdgcn_mfma_f32_16x16x32_bf16(Bt[n][k], At[m][k], acc[ai][bj][m][n], 0, 0, 0); __builtin_amdgcn_s_setprio(0); } while (0)
#define PG8_WAIT_V(n) asm volatile("s_waitcnt vmcnt(" #n ")" ::: "memory")
#define PG8_WAIT_L(n) asm volatile("s_waitcnt lgkmcnt(" #n ")" ::: "memory")
#define PG8_BAR __builtin_amdgcn_s_barrier()
#define PG8_SCHED __builtin_amdgcn_sched_barrier(0)
#define PG8_GOFF(unit, d0, d1) do { _Pragma("unroll") for (int _i = 0; _i < 2; ++_i) { int R_, C_; stage_rc(tid * 16 + _i * 8192, R_, C_); \
        d0[_i] = S.a_row_off(unit, R_) + (unsigned)C_ * 2u; d1[_i] = S.a_row_off(unit, R_ + HALF) + (unsigned)C_ * 2u; } } while (0)
    Unit cur, nxt; int ui = 0;
    if (!S.next(0, cur)) return;
    f32x4 acc[2][2][4][2];
#pragma unroll
    for (int a = 0; a < 2; ++a)
#pragma unroll
        for (int b = 0; b < 2; ++b)
#pragma unroll
            for (int m = 0; m < 4; ++m)
#pragma unroll
                for (int n = 0; n < 2; ++n) acc[a][b][m][n] = (f32x4){0.f, 0.f, 0.f, 0.f};
    bf16x8 At[4][2], B0[2][2], B1[2][2];
    if constexpr (GATHER) { PG8_GOFF(cur, vA0, vA1); }
    const char* cA = GATHER ? (const char*)g.A : (const char*)g.A + (size_t)cur.pm * tstepA; const char* cB = (const char*)g.Bt + (size_t)cur.pb * tstepB;
    PG8_STAGE(PG8_SB(0, 0), cB, voffB); PG8_STAGE(PG8_SB(0, 1), cB + hstepB, voffB); PG8_STAGE(PG8_SA(0, 0), cA, vA0); PG8_STAGE(PG8_SA(0, 1), cA + hstepA, vA1);
    if (wr == 1) PG8_BAR;
    PG8_WAIT_V(2); PG8_BAR;
    PG8_STAGE(PG8_SB(1, 0), cB + kstep, voffB); PG8_STAGE(PG8_SA(1, 0), cA + kstep, vA0); PG8_STAGE(PG8_SB(1, 1), cB + hstepB + kstep, voffB);
    PG8_WAIT_V(6); PG8_BAR;
    for (;;) {
        const bool has_next = S.next(ui + 1, nxt);
        const char* nA = GATHER ? (const char*)g.A : (has_next ? (const char*)g.A + (size_t)nxt.pm * tstepA : cA); const char* nB = has_next ? (const char*)g.Bt + (size_t)nxt.pb * tstepB : cB;
        if constexpr (GATHER) { if (has_next) { PG8_GOFF(nxt, nA0, nA1); } else {
#pragma unroll
            for (int i = 0; i < 2; ++i) { nA0[i] = vA0[i]; nA1[i] = vA1[i]; } } }
        for (int t = 0; t < nt; t += 2) {
            const bool last = (t == nt - 2);
            const char* a1 = cA + (size_t)(t + 1) * kstep;
            const char* a2 = last ? nA : cA + (size_t)(t + 2) * kstep; const char* b2 = last ? nB : cB + (size_t)(t + 2) * kstep;
            const char* a3 = a2 + kstep; const char* b3 = b2 + kstep;
            unsigned s0[2], s1[2];
#pragma unroll
            for (int i = 0; i < 2; ++i) { s0[i] = (GATHER && last) ? nA0[i] : vA0[i]; s1[i] = GATHER ? (last ? nA1[i] : vA1[i]) : vA0[i]; }
            PG8_LDB(B0, 0, 0); PG8_LDB(B1, 0, 1); PG8_SCHED; PG8_LDA(At, 0, 0); PG8_STAGE(PG8_SA(1, 1), a1 + hstepA, vA1);
            PG8_WAIT_V(8); PG8_WAIT_L(0); PG8_BAR; PG8_MMA(0, 0, At, B0); PG8_MMA(0, 1, At, B1); PG8_BAR; PG8_SCHED;
            PG8_LDA(At, 0, 1); PG8_STAGE(PG8_SB(0, 0), b2, voffB); PG8_STAGE(PG8_SB(0, 1), b2 + hstepB, voffB); PG8_STAGE(PG8_SA(0, 0), a2, s0);
            PG8_WAIT_V(8); PG8_WAIT_L(0); PG8_BAR; PG8_MMA(1, 0, At, B0); PG8_MMA(1, 1, At, B1); PG8_BAR; PG8_SCHED;
            PG8_LDB(B0, 1, 0); PG8_LDB(B1, 1, 1); PG8_SCHED; PG8_LDA(At, 1, 0); PG8_STAGE(PG8_SA(0, 1), a2 + hstepA, s1);
            PG8_WAIT_V(8); PG8_WAIT_L(0); PG8_BAR; PG8_MMA(0, 0, At, B0); PG8_MMA(0, 1, At, B1); PG8_BAR; PG8_SCHED;
            PG8_LDA(At, 1, 1); PG8_STAGE(PG8_SB(1, 0), b3, voffB); PG8_STAGE(PG8_SB(1, 1), b3 + hstepB, voffB); PG8_STAGE(PG8_SA(1, 0), a3, s0);
            PG8_WAIT_V(8); PG8_WAIT_L(0); PG8_BAR; PG8_MMA(1, 0, At, B0); PG8_MMA(1, 1, At, B1); PG8_BAR; PG8_SCHED;
        }
        if (wr == 0) PG8_BAR;
        E(acc, cur, wr, wc, fr, fq);
        if (!has_next) break;
#pragma unroll
        for (int a = 0; a < 2; ++a)
#pragma unroll
            for (int b = 0; b < 2; ++b)
#pragma unroll
                for (int m = 0; m < 4; ++m)
#pragma unroll
                    for (int n = 0; n < 2; ++n) acc[a][b][m][n] = (f32x4){0.f, 0.f, 0.f, 0.f};
        cur = nxt; cA = nA; cB = nB; ++ui;
        if constexpr (GATHER) {
#pragma unroll
            for (int i = 0; i < 2; ++i) { vA0[i] = nA0[i]; vA1[i] = nA1[i]; } }
        if (wr == 1) PG8_BAR;
    }
    PG8_WAIT_V(0);
    PG8_BAR;
#undef PG8_SA
#undef PG8_SB
#undef PG8_STAGE
#undef PG8_LDA
#undef PG8_LDB
#undef PG8_MMA
#undef PG8_WAIT_V
#undef PG8_WAIT_L
#undef PG8_BAR
#undef PG8_SCHED
#undef PG8_GOFF
}
}

constexpr int D = 1024, BATCH = 8, SEQ = 4096, M = BATCH * SEQ, DEPTH = 2;
constexpr int D_A = 512, D_BK = 512, D_BV = 512, D_C = 512, H_B = 4;
constexpr int N_IN = 7680, N_BCA = 4608, N_G = 3072;
constexpr int D_FF = 2816, NE = 8, N13 = 2 * D_FF;
constexpr int MOD_LD = 6 * D;
constexpr float EPS = 1e-6f;
constexpr int LIST_CAP = M;
constexpr int MOE_ROWS = M + NE * 256;

constexpr size_t MiB = 1u << 20;
constexpr size_t WS_CTL = 0, CTL_ZERO_BYTES = 1 * MiB;
constexpr size_t WS_MOD = 1 * MiB;
constexpr size_t WS_TOPP = 2 * MiB;
constexpr size_t WS_LIST = 3 * MiB;
constexpr size_t WS_WMIX = 6 * MiB, WMIX_STRIDE = 20 * MiB;
constexpr size_t WS_W13 = 46 * MiB, WS_W2 = 57 * MiB;
constexpr size_t WS_BIG = 64 * MiB;
constexpr size_t WS_H = WS_BIG;
constexpr size_t WS_P1 = WS_BIG + 64 * MiB;
constexpr size_t WS_PG = WS_P1;
constexpr size_t WS_MRG = WS_P1 + 192 * MiB;
constexpr size_t WS_YA = WS_P1 + 288 * MiB, WS_YB = WS_YA + 32 * MiB, WS_YC = WS_YB + 32 * MiB;
constexpr size_t WS_ACT = WS_P1;
constexpr size_t WS_HU = WS_YC + 32 * MiB;
constexpr size_t WS_HD = WS_HU + 16 * MiB;
constexpr size_t WS_MIX_END = WS_HD + 1 * MiB;
constexpr size_t WS_WM13 = 6 * MiB;
constexpr size_t WS_WM2 = WS_WM13 + 88 * MiB;
constexpr size_t WS_H2M = WS_WM2 + 44 * MiB;
constexpr size_t WS_ACTM = WS_H2M + 64 * MiB;
constexpr size_t WS_MOE_END = WS_ACTM + (size_t)MOE_ROWS * D_FF * 2;
constexpr size_t WS_NEED = WS_MIX_END > WS_MOE_END ? WS_MIX_END : WS_MOE_END;
static_assert(WS_W2 + (size_t)D * D_FF * 2 <= WS_BIG && WS_WMIX + 2 * WMIX_STRIDE <= WS_W13, "ws map");
constexpr int CW_BAR = 4096;
constexpr int CW_CNT = 16384;

constexpr int LDS_BYTES = 147456;
constexpr int SCR_BYTES = 139264;
constexpr int TAB_OFF = SCR_BYTES;
constexpr int MISC_OFF = TAB_OFF + 4096;
static_assert(MISC_OFF + 128 <= LDS_BYTES, "LDS map");
constexpr int NWAVES = 8, NT = 512;

#define GAS __attribute__((address_space(1)))
#define LAS __attribute__((address_space(3)))
typedef unsigned short bf16;
typedef unsigned v4u __attribute__((ext_vector_type(4)));
typedef float f32x4 __attribute__((ext_vector_type(4)));
#define LDS_WAIT() asm volatile("s_waitcnt lgkmcnt(0)" ::: "memory")

typedef float f32x2_t __attribute__((ext_vector_type(2)));
typedef __bf16 bf16x2_t __attribute__((ext_vector_type(2)));
__device__ __forceinline__ unsigned pk2(float lo, float hi) { f32x2_t v = {lo, hi}; bf16x2_t b = __builtin_convertvector(v, bf16x2_t); return __builtin_bit_cast(unsigned, b); }
__device__ __forceinline__ float bf_lo(unsigned u) { return __uint_as_float(u << 16); }
__device__ __forceinline__ float bf_hi(unsigned u) { return __uint_as_float(u & 0xffff0000u); }
__device__ __forceinline__ void unpack8(const v4u w, float (&f)[8]) { f[0] = bf_lo(w.x); f[1] = bf_hi(w.x); f[2] = bf_lo(w.y); f[3] = bf_hi(w.y); f[4] = bf_lo(w.z); f[5] = bf_hi(w.z); f[6] = bf_lo(w.w); f[7] = bf_hi(w.w); }
__device__ __forceinline__ v4u pack8(const float (&f)[8]) { v4u w; w.x = pk2(f[0], f[1]); w.y = pk2(f[2], f[3]); w.z = pk2(f[4], f[5]); w.w = pk2(f[6], f[7]); return w; }
__device__ __forceinline__ float sigmoidf_(float x) { return __builtin_amdgcn_rcpf(1.0f + __expf(-x)); }
__device__ __forceinline__ float siluf_(float x) { return x * sigmoidf_(x); }
__device__ __forceinline__ float wave_sum(float v) {
#pragma unroll
    for (int o = 1; o < 64; o <<= 1) v += __shfl_xor(v, o);
    return v;
}

#define XB_TMO      128
#define XB_XCNT(j)  (256  + 64 * (j))
#define XB_XSUB(j)  (1280 + 64 * (j))
#define XB_XGEN(j)  (2304 + 64 * (j))
#define XB_TOP      3328
#define XB_TOPGEN   3392
#define XCD_BAR_WORDS 3456
#define XB_SPIN_CAP (1u << 18)

__device__ __forceinline__ unsigned xb_ld(unsigned* p)              { return __hip_atomic_load(p, __ATOMIC_RELAXED, __HIP_MEMORY_SCOPE_AGENT); }
__device__ __forceinline__ unsigned xb_add(unsigned* p, unsigned v) { return __hip_atomic_fetch_add(p, v, __ATOMIC_RELAXED, __HIP_MEMORY_SCOPE_AGENT); }
__device__ __forceinline__ unsigned xb_xcc_id() { return (unsigned)__builtin_amdgcn_s_getreg((3 << 11) | 20) & 0xFu; }
#define XB_SPIN(cond, bar) do { unsigned _sp = 0; while (cond) { __builtin_amdgcn_s_sleep(1); \
    if ((++_sp & 255u) == 0u) { if (xb_ld(&(bar)[XB_TMO])) break; if (_sp > XB_SPIN_CAP) { atomicAdd(&(bar)[XB_TMO], 1u); break; } } } } while (0)

struct XcdBarrier { unsigned* bar; unsigned x; volatile LAS unsigned* st; };

__device__ __forceinline__ XcdBarrier xcd_barrier_post(unsigned* bar, volatile LAS unsigned* st) {
    XcdBarrier b; b.bar = bar; b.x = xb_xcc_id(); b.st = st;
    if (threadIdx.x == 0) (void)xb_add(&bar[XB_XCNT(b.x)], 1u);
    return b;
}
__device__ __forceinline__ void xcd_barrier_complete(unsigned* bar, unsigned x, unsigned& nloc, unsigned& nx) {
    const unsigned G = gridDim.x * gridDim.y * gridDim.z;
    unsigned sum, cnt, mine, sp = 0u;
    for (;;) {
        sum = 0u; cnt = 0u; mine = 0u;
#pragma unroll
        for (unsigned j = 0; j < 16; ++j) { const unsigned c = xb_ld(&bar[XB_XCNT(j)]); sum += c; cnt += (c > 0u) ? 1u : 0u; mine = (j == x) ? c : mine; }
        if (sum == G) break;
        __builtin_amdgcn_s_sleep(1);
        if ((++sp & 255u) == 0u) { if (xb_ld(&bar[XB_TMO])) break; if (sp > XB_SPIN_CAP) { atomicAdd(&bar[XB_TMO], 1u); break; } }
    }
    nloc = mine > 0u ? mine : 1u; nx = cnt > 0u ? cnt : 1u;
}
__device__ __forceinline__ void xcd_barrier(const XcdBarrier& b) {
    asm volatile("s_waitcnt vmcnt(0)" ::: "memory");
    __syncthreads();
    if (threadIdx.x == 0) {
        unsigned* bar = b.bar;
        __builtin_amdgcn_s_waitcnt(0);
        unsigned nloc = b.st[0], nx = b.st[1];
        if (nloc == 0u) { xcd_barrier_complete(bar, b.x, nloc, nx); b.st[0] = nloc; b.st[1] = nx; }
        const unsigned old = xb_add(&bar[XB_XSUB(b.x)], 1u);
        const unsigned gen = old / nloc;
        if (old + 1u == (gen + 1u) * nloc) {
            __builtin_amdgcn_fence(__ATOMIC_RELEASE, "agent");
            asm volatile("s_waitcnt vmcnt(0)" ::: "memory");
            const unsigned og = xb_add(&bar[XB_TOP], 1u);
            const unsigned tg = og / nx;
            if (og + 1u == (tg + 1u) * nx) xb_add(&bar[XB_TOPGEN], 1u);
            else XB_SPIN(xb_ld(&bar[XB_TOPGEN]) == tg, bar);
            __builtin_amdgcn_fence(__ATOMIC_ACQUIRE, "agent");
            xb_add(&bar[XB_XGEN(b.x)], 1u);
            asm volatile("s_waitcnt vmcnt(0)" ::: "memory");
        } else {
            XB_SPIN(xb_ld(&bar[XB_XGEN(b.x)]) == gen, bar);
            __builtin_amdgcn_fence(__ATOMIC_ACQUIRE, "agent");
            asm volatile("s_waitcnt vmcnt(0)" ::: "memory");
        }
    }
    __syncthreads();
}

struct Args { const float* in[26]; float* out; unsigned char* ws; int ph_lo, ph_hi; };
typedef const Args __attribute__((address_space(4)))* KArgs;
#define KA() ({ KArgs p_ = (KArgs)__builtin_amdgcn_kernarg_segment_ptr(); asm volatile("" : "+s"(p_)); p_; })
struct Frame {
    LAS unsigned char* lds;
    int tid, lane, wave, G, bid;
};

template <int MAP>
__device__ __forceinline__ void transpose_item(const float* W, int K, int N, bf16* WT, int row_off, LAS float* scr, int item, int lane) {
    const int nblk = N / 32, kb = item / nblk, nb = item % nblk, k0 = 64 * kb, n0 = 32 * nb;
#pragma unroll 8
    for (int i = 0; i < 32; ++i) { const int kk = 2 * i + (lane >> 5); scr[kk * 33 + (lane & 31)] = W[(size_t)(k0 + kk) * N + n0 + (lane & 31)]; }
    LDS_WAIT(); asm volatile("" ::: "memory");
    const int c = lane & 7;
#pragma unroll
    for (int j = 0; j < 4; ++j) { const int n = (lane >> 3) + 8 * j; const LAS float* s = scr + (8 * c) * 33 + n;
        v4u o; o.x = pk2(s[0 * 33], s[1 * 33]); o.y = pk2(s[2 * 33], s[3 * 33]); o.z = pk2(s[4 * 33], s[5 * 33]); o.w = pk2(s[6 * 33], s[7 * 33]);
        const int nn = n0 + n; const int row = (MAP == 0) ? (row_off + nn) : ((nn >> 7) * 256 + row_off + (nn & 127));
        *(v4u*)(WT + (size_t)row * K + k0 + 8 * c) = o; }
    LDS_WAIT(); asm volatile("" ::: "memory");
}

__device__ __forceinline__ void p_prologue(Frame& F, KArgs ka) {
    const float* c = ka->in[1]; const float* ada_w = ka->in[2]; const float* ada_b = ka->in[3];
    unsigned char* aws = ka->ws; float* mod = (float*)(aws + WS_MOD);
    LAS float* cact = (LAS float*)F.lds;
    LAS float* red = cact + 8192;
    for (int i = F.tid; i < BATCH * D; i += NT) cact[i] = siluf_(c[i]);
    __syncthreads();
    for (int chunk = F.bid; chunk < 256; chunk += F.G) {
        const int l = chunk >> 7, n0 = (chunk & 127) * 48;
        if (F.tid < 480) {
            const int kg = F.tid / 48, col = F.tid % 48;
            float acc[8];
#pragma unroll
            for (int b = 0; b < 8; ++b) acc[b] = 0.f;
            const float* wp = ada_w + (size_t)l * D * MOD_LD + n0 + col;
            for (int k = kg; k < D; k += 10) { const float w = wp[(size_t)k * MOD_LD];
#pragma unroll
                for (int b = 0; b < 8; ++b) acc[b] += cact[b * D + k] * w; }
#pragma unroll
            for (int b = 0; b < 8; ++b) red[(kg * 48 + col) * 8 + b] = acc[b];
        }
        __syncthreads();
        if (F.tid < 384) {
            const int col = F.tid >> 3, b = F.tid & 7; float s = 0.f;
#pragma unroll
            for (int kg = 0; kg < 10; ++kg) s += red[(kg * 48 + col) * 8 + b];
            mod[(size_t)(l * 8 + b) * MOD_LD + n0 + col] = s + ada_b[l * MOD_LD + n0 + col];
        }
        __syncthreads();
    }
    LAS float* scr = (LAS float*)(F.lds + F.wave * 16384);
    const int gw = F.bid * NWAVES + F.wave, NGW = F.G * NWAVES;
    constexpr int I_IN = (D / 64) * (N_IN / 32), I_BR = (512 / 64) * (D / 32), I_O = (D / 64) * (D / 32), I_L = I_IN + 3 * I_BR + I_O;
    constexpr int I_F1 = (D / 64) * (D_FF / 32), I_F2 = (D_FF / 64) * (D / 32);
    constexpr int NITEMS = 2 * I_L + 2 * I_F1 + I_F2;
    for (int it = gw; it < NITEMS; it += NGW) {
        int r = it;
        if (r < 2 * I_L) {
            const int l = r / I_L; r -= l * I_L;
            bf16* base = (bf16*)(aws + WS_WMIX + (size_t)l * WMIX_STRIDE);
            if (r < I_IN) { transpose_item<0>(ka->in[6] + (size_t)l * D * N_IN, D, N_IN, base, 0, scr, r, F.lane); continue; } r -= I_IN;
            if (r < I_BR) { transpose_item<0>(ka->in[13] + (size_t)l * 512 * D, 512, D, base + (size_t)N_IN * D, 0, scr, r, F.lane); continue; } r -= I_BR;
            if (r < I_BR) { transpose_item<0>(ka->in[14] + (size_t)l * 512 * D, 512, D, base + (size_t)N_IN * D + 512 * 1024, 0, scr, r, F.lane); continue; } r -= I_BR;
            if (r < I_BR) { transpose_item<0>(ka->in[15] + (size_t)l * 512 * D, 512, D, base + (size_t)N_IN * D + 2 * 512 * 1024, 0, scr, r, F.lane); continue; } r -= I_BR;
            transpose_item<0>(ka->in[16] + (size_t)l * D * D, D, D, base + (size_t)N_IN * D + 3 * 512 * 1024, 0, scr, r, F.lane); continue;
        }
        r -= 2 * I_L;
        if (r < I_F1) { transpose_item<1>(ka->in[17], D, D_FF, (bf16*)(aws + WS_W13), 0, scr, r, F.lane); continue; } r -= I_F1;
        if (r < I_F1) { transpose_item<1>(ka->in[18], D, D_FF, (bf16*)(aws + WS_W13), 128, scr, r, F.lane); continue; } r -= I_F1;
        transpose_item<0>(ka->in[19], D_FF, D, (bf16*)(aws + WS_W2), 0, scr, r, F.lane);
    }
}
__device__ __forceinline__ void p_moe_weights(Frame& F, KArgs ka) {
    unsigned char* aws = ka->ws;
    LAS float* scr = (LAS float*)(F.lds + F.wave * 16384);
    const int gw = F.bid * NWAVES + F.wave, NGW = F.G * NWAVES;
    constexpr int I_F1 = (D / 64) * (D_FF / 32), I_F2 = (D_FF / 64) * (D / 32), I_E = 2 * I_F1 + I_F2;
    for (int it = gw; it < NE * I_E; it += NGW) {
        const int e = it / I_E; int r = it - e * I_E;
        bf16* w13 = (bf16*)(aws + WS_WM13) + (size_t)e * N13 * D; bf16* w2 = (bf16*)(aws + WS_WM2) + (size_t)e * D * D_FF;
        if (r < I_F1) { transpose_item<1>(ka->in[22] + (size_t)e * D * D_FF, D, D_FF, w13, 0, scr, r, F.lane); continue; } r -= I_F1;
        if (r < I_F1) { transpose_item<1>(ka->in[23] + (size_t)e * D * D_FF, D, D_FF, w13, 128, scr, r, F.lane); continue; } r -= I_F1;
        transpose_item<0>(ka->in[24] + (size_t)e * D_FF * D, D_FF, D, w2, 0, scr, r, F.lane);
    }
}

__device__ __forceinline__ void norm_row(const float* xrow, const float* w, const float* sc, const float* sh, int lane, f32x4 (&o)[4]) {
    const f32x4* xr = (const f32x4*)xrow + lane;
    f32x4 v[4]; float s = 0.f;
#pragma unroll
    for (int j = 0; j < 4; ++j) { v[j] = xr[64 * j]; s += (v[j].x * v[j].x + v[j].y * v[j].y) + (v[j].z * v[j].z + v[j].w * v[j].w); }
    const float rstd = 1.0f / sqrtf(wave_sum(s) * (1.0f / D) + EPS);
#pragma unroll
    for (int j = 0; j < 4; ++j) { const f32x4 wv = ((const f32x4*)w)[lane + 64 * j], scv = ((const f32x4*)sc)[lane + 64 * j], shv = ((const f32x4*)sh)[lane + 64 * j];
        o[j] = v[j] * rstd * wv * (scv + 1.0f) + shv; }
}
__device__ __forceinline__ void store_row_bf16(bf16* orow, int lane, const f32x4 (&o)[4]) {
    unsigned long long* o8 = (unsigned long long*)orow + lane;
#pragma unroll
    for (int j = 0; j < 4; ++j) o8[64 * j] = (unsigned long long)pk2(o[j].x, o[j].y) | ((unsigned long long)pk2(o[j].z, o[j].w) << 32);
}
__device__ __forceinline__ void p_norm(Frame& F, const float* xin, const float* w, const float* mod_l, int sc_off, int sh_off, bf16* hout) {
    const int gw = F.bid * NWAVES + F.wave, NGW = F.G * NWAVES;
    for (int row = gw; row < M; row += NGW) {
        const float* mb = mod_l + (size_t)(row >> 12) * MOD_LD;
        f32x4 o[4]; norm_row(xin + (size_t)row * D, w, mb + sc_off, mb + sh_off, F.lane, o);
        store_row_bf16(hout + (size_t)row * D, F.lane, o);
    }
}

__device__ __forceinline__ void p_conv(Frame& F, const bf16* P1, const float* conv_w, bf16* ya) {
    const int gt = F.bid * NT + F.tid, NGT = F.G * NT;
    for (int it = gt; it < M * 64; it += NGT) {
        const int row = it >> 6, c8 = (it & 63) * 8, pos = row & (SEQ - 1);
        const bf16* p = P1 + (size_t)row * N_BCA + c8;
        float ab[8], ac[8], ah[8], z1[8], z2[8], y[8];
        unpack8(*(const v4u*)p, ab); unpack8(*(const v4u*)(p + 512), ac); unpack8(*(const v4u*)(p + 1024), ah);
#pragma unroll
        for (int i = 0; i < 8; ++i) { z1[i] = 0.f; z2[i] = 0.f; }
        if (pos >= 1) { float c1[8], h1[8]; unpack8(*(const v4u*)(p - N_BCA + 512), c1); unpack8(*(const v4u*)(p - N_BCA + 1024), h1);
#pragma unroll
            for (int i = 0; i < 8; ++i) z1[i] = c1[i] * h1[i]; }
        if (pos >= 2) { float c2[8], h2[8]; unpack8(*(const v4u*)(p - 2 * N_BCA + 512), c2); unpack8(*(const v4u*)(p - 2 * N_BCA + 1024), h2);
#pragma unroll
            for (int i = 0; i < 8; ++i) z2[i] = c2[i] * h2[i]; }
#pragma unroll
        for (int i = 0; i < 8; ++i) y[i] = ab[i] * (conv_w[c8 + i] * (ac[i] * ah[i]) + conv_w[512 + c8 + i] * z1[i] + conv_w[1024 + c8 + i] * z2[i]);
        *(v4u*)(ya + (size_t)row * 512 + c8) = pack8(y);
    }
}

typedef short v4i16_t __attribute__((ext_vector_type(4)));
typedef short bf16x8_t __attribute__((ext_vector_type(8)));
typedef unsigned v2u __attribute__((ext_vector_type(2)));
constexpr int HRS = 272;
constexpr int H_RAWQ = 0, H_RAWF = 8704, H_V = 17408, H_QH = 26112, H_KT = 34816, H_KH = 43520, H_DL = 52224, H_OB = 52736, H_OBS = 132;
constexpr int HSEG = 512, HNSEG = SEQ / HSEG, HCH = 32;
__device__ __forceinline__ v4i16_t tr_read(LAS unsigned char* p) { return __builtin_amdgcn_ds_read_tr16_b64_v4i16((LAS v4i16_t*)p); }
__device__ __forceinline__ bf16x8_t cat4(v4i16_t lo, v4i16_t hi) { return __builtin_shufflevector(lo, hi, 0, 1, 2, 3, 4, 5, 6, 7); }
__device__ __forceinline__ bf16x8_t pack_acc(const f32x4 a, const f32x4 b) { v4u w; w.x = pk2(a[0], a[1]); w.y = pk2(a[2], a[3]); w.z = pk2(b[0], b[1]); w.w = pk2(b[2], b[3]); return __builtin_bit_cast(bf16x8_t, w); }
__device__ __forceinline__ unsigned short bf1(float x) { return (unsigned short)(pk2(x, x) & 0xffffu); }
template <int PASS>
__device__ __forceinline__ void p_hgrn(Frame& F, const bf16* P1, const float* lb_logits, int layer, const float* norm_w, bf16* yb, float* ust, float* dst) {
    LAS unsigned char* L = F.lds;
    const int lane = F.lane, w = F.wave, g = lane >> 4, n = lane & 15, q_ = n >> 2, p_ = n & 3;
    const int pt = F.tid >> 4, pc8 = (F.tid & 15) * 8;
    for (int u = F.bid; u < BATCH * H_B * HNSEG; u += F.G) {
        const int seg = u & (HNSEG - 1), bh = u / HNSEG, b = bh >> 2, h = bh & 3;
        const int d = 16 * w + n;
        float lb; { const int ch = h * 128 + d; const float l0 = lb_logits[ch], l1 = lb_logits[512 + ch]; const float mx = fmaxf(l0, l1);
            const float e0 = expf(l0 - mx), e1 = expf(l1 - mx); const float p0 = e0 / (e0 + e1), p1 = e1 / (e0 + e1);
            const float lbx = (layer == 0) ? (p0 - p0) : ((p0 + p1) - p0); lb = fminf(fmaxf(lbx, 0.f), 1.f); }
        const float lbf = fmaxf(lb, 1e-30f), oml = 1.0f - lb;
        f32x4 S[8];
#pragma unroll
        for (int kt = 0; kt < 8; ++kt) S[kt] = (f32x4){0.f, 0.f, 0.f, 0.f};
        if (PASS == 2) {
            for (int j = 0; j < seg; ++j) { const int uj = u - seg + j;
#pragma unroll
                for (int kt = 0; kt < 8; ++kt) { const f32x4 dj = *(const f32x4*)(dst + (size_t)uj * 128 + 16 * kt + 4 * g); const f32x4 uu = *(const f32x4*)(ust + ((((size_t)uj * 8 + w) * 8 + kt) * 64 + lane) * 4);
                    S[kt] = dj * S[kt] + uu; } }
        }
        float nw8[8];
        if (PASS == 2) {
#pragma unroll
            for (int i = 0; i < 8; ++i) nw8[i] = norm_w[h * 128 + pc8 + i]; }
        float bsum = 0.f;
        const bf16* gp = P1 + ((size_t)b * SEQ + (size_t)seg * HSEG + pt) * N_BCA + 1536 + h * 128 + pc8;
        v4u rq, rf, rv, rg;
        rf = *(const v4u*)(gp + 512); rv = *(const v4u*)(gp + 1024);
        if (PASS == 2) { rq = *(const v4u*)gp; rg = *(const v4u*)(gp + 1536); }
        for (int c = 0; c < HSEG / HCH; ++c) {
            *(LAS v4u*)(L + H_RAWF + pt * HRS + pc8 * 2) = rf; *(LAS v4u*)(L + H_V + pt * HRS + pc8 * 2) = rv;
            if (PASS == 2) *(LAS v4u*)(L + H_RAWQ + pt * HRS + pc8 * 2) = rq;
            v4u cg; if (PASS == 2) cg = rg;
            __syncthreads();
            if (c + 1 < HSEG / HCH) { const bf16* np = gp + (size_t)(c + 1) * HCH * N_BCA; rf = *(const v4u*)(np + 512); rv = *(const v4u*)(np + 1024);
                if (PASS == 2) { rq = *(const v4u*)np; rg = *(const v4u*)(np + 1536); } }
            { float lf[8], kk[8];
#pragma unroll
              for (int i = 0; i < 8; ++i) { const float fr = __uint_as_float((unsigned)(*(const LAS unsigned short*)(L + H_RAWF + (8 * g + i) * HRS + 2 * d)) << 16);
                  const float sg = __builtin_amdgcn_rcpf(1.0f + __expf(-fr)); const float f = lbf + oml * sg; lf[i] = __logf(f); kk[i] = oml * (1.0f - sg); }
              float cs = 0.f;
#pragma unroll
              for (int i = 0; i < 8; ++i) { cs += lf[i]; lf[i] = cs; }
              const float s1 = __shfl(cs, n), s2 = __shfl(cs, 16 + n), s3 = __shfl(cs, 32 + n), s4 = __shfl(cs, 48 + n);
              const float pre = (g > 0 ? s1 : 0.f) + (g > 1 ? s2 : 0.f) + (g > 2 ? s3 : 0.f);
              const float blast = ((s1 + s2) + s3) + s4;
#pragma unroll
              for (int i = 0; i < 8; ++i) { const float bb = pre + lf[i]; const int t = 8 * g + i;
                  *(LAS unsigned short*)(L + H_KH + t * HRS + 2 * d) = bf1(kk[i] * __expf(blast - bb));
                  if (PASS == 2) { const float qv = __uint_as_float((unsigned)(*(const LAS unsigned short*)(L + H_RAWQ + t * HRS + 2 * d)) << 16);
                      *(LAS unsigned short*)(L + H_QH + t * HRS + 2 * d) = bf1(siluf_(qv) * __expf(bb));
                      *(LAS unsigned short*)(L + H_KT + t * HRS + 2 * d) = bf1(kk[i] * __expf(fminf(-bb, 80.0f))); } }
              if (g == 0) *(LAS float*)(L + H_DL + 4 * d) = __expf(blast);
              bsum += blast; }
            __syncthreads();
            const bf16x8_t bV = cat4(tr_read(L + H_V + (4 * g + q_) * HRS + 32 * w + 8 * p_), tr_read(L + H_V + (16 + 4 * g + q_) * HRS + 32 * w + 8 * p_));
            if (PASS == 2) {
                f32x4 o[2], pt00 = {0.f, 0.f, 0.f, 0.f}, pt01 = {0.f, 0.f, 0.f, 0.f}, pt11 = {0.f, 0.f, 0.f, 0.f};
                o[0] = (f32x4){0.f, 0.f, 0.f, 0.f}; o[1] = (f32x4){0.f, 0.f, 0.f, 0.f};
#pragma unroll
                for (int ks = 0; ks < 4; ++ks) {
                    const bf16x8_t sb = pack_acc(S[2 * ks], S[2 * ks + 1]);
#pragma unroll
                    for (int tm = 0; tm < 2; ++tm) { const v2u lo = *(const LAS v2u*)(L + H_QH + (16 * tm + n) * HRS + (32 * ks + 4 * g) * 2), hi = *(const LAS v2u*)(L + H_QH + (16 * tm + n) * HRS + (32 * ks + 16 + 4 * g) * 2);
                        v4u aw; aw.x = lo.x; aw.y = lo.y; aw.z = hi.x; aw.w = hi.y;
                        o[tm] = __builtin_amdgcn_mfma_f32_16x16x32_bf16(__builtin_bit_cast(bf16x8_t, aw), sb, o[tm], 0, 0, 0); }
                    const bf16x8_t aK0 = *(const LAS bf16x8_t*)(L + H_KT + n * HRS + (32 * ks + 8 * g) * 2), aK1 = *(const LAS bf16x8_t*)(L + H_KT + (16 + n) * HRS + (32 * ks + 8 * g) * 2);
                    const bf16x8_t bQ0 = *(const LAS bf16x8_t*)(L + H_QH + n * HRS + (32 * ks + 8 * g) * 2), bQ1 = *(const LAS bf16x8_t*)(L + H_QH + (16 + n) * HRS + (32 * ks + 8 * g) * 2);
                    pt00 = __builtin_amdgcn_mfma_f32_16x16x32_bf16(aK0, bQ0, pt00, 0, 0, 0);
                    pt01 = __builtin_amdgcn_mfma_f32_16x16x32_bf16(aK0, bQ1, pt01, 0, 0, 0);
                    pt11 = __builtin_amdgcn_mfma_f32_16x16x32_bf16(aK1, bQ1, pt11, 0, 0, 0);
                }
#pragma unroll
                for (int j = 0; j < 4; ++j) if (4 * g + j > n) { pt00[j] = 0.f; pt11[j] = 0.f; }
                const f32x4 z4 = {0.f, 0.f, 0.f, 0.f};
                o[0] = __builtin_amdgcn_mfma_f32_16x16x32_bf16(pack_acc(pt00, z4), bV, o[0], 0, 0, 0);
                o[1] = __builtin_amdgcn_mfma_f32_16x16x32_bf16(pack_acc(pt01, pt11), bV, o[1], 0, 0, 0);
#pragma unroll
                for (int tm = 0; tm < 2; ++tm)
#pragma unroll
                    for (int j = 0; j < 4; ++j) *(LAS float*)(L + H_OB + ((16 * tm + 4 * g + j) * H_OBS + 16 * w + n) * 4) = o[tm][j];
            }
#pragma unroll
            for (int kt = 0; kt < 8; ++kt) { const f32x4 dl4 = *(const LAS f32x4*)(L + H_DL + (16 * kt + 4 * g) * 4);
                const bf16x8_t aKh = cat4(tr_read(L + H_KH + (4 * g + q_) * HRS + 32 * kt + 8 * p_), tr_read(L + H_KH + (16 + 4 * g + q_) * HRS + 32 * kt + 8 * p_));
                S[kt] = __builtin_amdgcn_mfma_f32_16x16x32_bf16(aKh, bV, S[kt] * dl4, 0, 0, 0); }
            __syncthreads();
            if (PASS == 2) {
                const f32x4 o0 = *(const LAS f32x4*)(L + H_OB + (pt * H_OBS + pc8) * 4), o1 = *(const LAS f32x4*)(L + H_OB + (pt * H_OBS + pc8 + 4) * 4);
                const float o8[8] = {o0.x, o0.y, o0.z, o0.w, o1.x, o1.y, o1.z, o1.w};
                float ss = 0.f;
#pragma unroll
                for (int i = 0; i < 8; ++i) ss += o8[i] * o8[i];
                ss += __shfl_xor(ss, 1); ss += __shfl_xor(ss, 2); ss += __shfl_xor(ss, 4); ss += __shfl_xor(ss, 8);
                const float rs = 1.0f / sqrtf(ss * (1.0f / 128.0f) + EPS);
                float g8[8], y[8]; unpack8(cg, g8);
#pragma unroll
                for (int i = 0; i < 8; ++i) y[i] = o8[i] * rs * nw8[i] * siluf_(g8[i]);
                *(v4u*)(yb + ((size_t)b * SEQ + (size_t)seg * HSEG + (size_t)c * HCH + pt) * 512 + h * 128 + pc8) = pack8(y);
            }
        }
        if (PASS == 1) {
#pragma unroll
            for (int kt = 0; kt < 8; ++kt) *(f32x4*)(ust + ((((size_t)u * 8 + w) * 8 + kt) * 64 + lane) * 4) = S[kt];
            if (g == 0) dst[(size_t)u * 128 + d] = __expf(bsum);
        }
        __syncthreads();
    }
}


constexpr int SG_V = 0, SG_OB = 34816, SG_OBS = 132, SG_RS = SG_OB + 128 * SG_OBS * 4;
__device__ __forceinline__ void p_sgu(Frame& F, const bf16* P1, const float* norm_w, const float* sgu_w, const float* sgu_b, bf16* yc) {
    LAS unsigned char* L = F.lds;
    const int lane = F.lane, w = F.wave, gq = lane >> 4, n = lane & 15, q_ = n >> 2, p_ = n & 3;
    const int sr = F.tid >> 4, c8 = (F.tid & 15) * 8;
    for (int u = F.bid; u < M / 128; u += F.G) {
        const size_t row0 = (size_t)u * 128;
        v4u rv[4][4]; float ssj[4] = {0.f, 0.f, 0.f, 0.f};
#pragma unroll
        for (int g = 0; g < 4; ++g)
#pragma unroll
            for (int j = 0; j < 4; ++j) { rv[g][j] = *(const v4u*)(P1 + (row0 + sr + 32 * j) * N_BCA + 4096 + g * 128 + c8); float f[8]; unpack8(rv[g][j], f);
#pragma unroll
                for (int i = 0; i < 8; ++i) ssj[j] += f[i] * f[i]; }
#pragma unroll
        for (int j = 0; j < 4; ++j) { float ss = ssj[j]; ss += __shfl_xor(ss, 1); ss += __shfl_xor(ss, 2); ss += __shfl_xor(ss, 4); ss += __shfl_xor(ss, 8);
            if (n == 0) *(LAS float*)(L + SG_RS + 4 * (sr + 32 * j)) = 1.0f / sqrtf(ss * (1.0f / 512.0f) + EPS); }
#pragma unroll
        for (int g = 0; g < 4; ++g) {
#pragma unroll
            for (int j = 0; j < 4; ++j) *(LAS v4u*)(L + SG_V + (sr + 32 * j) * HRS + c8 * 2) = rv[g][j];
            __syncthreads();
            const int kmax = w >> 1, t = 16 * w + n;
            bf16x8_t aW[4];
#pragma unroll
            for (int ks = 0; ks < 4; ++ks) { if (ks <= kmax) { const int s0 = 32 * ks + 8 * gq; const float* wp = sgu_w + ((size_t)g * 128 + t) * 128 + s0;
                    const f32x4 w0 = *(const f32x4*)wp, w1 = *(const f32x4*)(wp + 4); const f32x4 r0 = *(const LAS f32x4*)(L + SG_RS + 4 * s0), r1 = *(const LAS f32x4*)(L + SG_RS + 4 * (s0 + 4));
                    float a8[8] = {w0.x * r0.x, w0.y * r0.y, w0.z * r0.z, w0.w * r0.w, w1.x * r1.x, w1.y * r1.y, w1.z * r1.z, w1.w * r1.w};
#pragma unroll
                    for (int i = 0; i < 8; ++i) if (s0 + i > t) a8[i] = 0.f;
                    aW[ks] = __builtin_bit_cast(bf16x8_t, pack8(a8)); } else aW[ks] = (bf16x8_t){0, 0, 0, 0, 0, 0, 0, 0}; }
            f32x4 acc[8];
#pragma unroll
            for (int ct = 0; ct < 8; ++ct) acc[ct] = (f32x4){0.f, 0.f, 0.f, 0.f};
#pragma unroll
            for (int ks = 0; ks < 4; ++ks) { if (ks <= kmax) {
#pragma unroll
                for (int ct = 0; ct < 8; ++ct) { const bf16x8_t bV = cat4(tr_read(L + SG_V + (32 * ks + 8 * gq + q_) * HRS + 32 * ct + 8 * p_), tr_read(L + SG_V + (32 * ks + 8 * gq + 4 + q_) * HRS + 32 * ct + 8 * p_));
                    acc[ct] = __builtin_amdgcn_mfma_f32_16x16x32_bf16(aW[ks], bV, acc[ct], 0, 0, 0); } } }
#pragma unroll
            for (int ct = 0; ct < 8; ++ct) { const float nw = norm_w[g * 128 + 16 * ct + n];
#pragma unroll
                for (int j = 0; j < 4; ++j) *(LAS float*)(L + SG_OB + ((16 * w + 4 * gq + j) * SG_OBS + 16 * ct + n) * 4) = acc[ct][j] * nw; }
            __syncthreads();
#pragma unroll
            for (int j = 0; j < 4; ++j) { const int tt = sr + 32 * j; const float bias = sgu_b[g * 128 + tt];
                const f32x4 o0 = *(const LAS f32x4*)(L + SG_OB + (tt * SG_OBS + c8) * 4), o1 = *(const LAS f32x4*)(L + SG_OB + (tt * SG_OBS + c8 + 4) * 4);
                float uu[8], y[8]; unpack8(*(const v4u*)(P1 + (row0 + tt) * N_BCA + 3584 + g * 128 + c8), uu);
                y[0] = (o0.x + bias) * uu[0]; y[1] = (o0.y + bias) * uu[1]; y[2] = (o0.z + bias) * uu[2]; y[3] = (o0.w + bias) * uu[3];
                y[4] = (o1.x + bias) * uu[4]; y[5] = (o1.y + bias) * uu[5]; y[6] = (o1.z + bias) * uu[6]; y[7] = (o1.w + bias) * uu[7];
                *(v4u*)(yc + (row0 + tt) * 512 + g * 128 + c8) = pack8(y); }
        }
        __syncthreads();
    }
}

__device__ __forceinline__ void p_norm_router(Frame& F, KArgs ka, const float* x, const float* w, const float* mod_l, bf16* h2) {
    const float* rw = ka->in[20]; const float* rb = ka->in[21]; unsigned* ctl = (unsigned*)(ka->ws + WS_CTL);
    float* topp = (float*)(ka->ws + WS_TOPP); int* list = (int*)(ka->ws + WS_LIST);
    LAS float* RWt = (LAS float*)F.lds;
    LAS int* lcnt = (LAS int*)(RWt + 8192);
    LAS int* lbase = lcnt + 16;
    LAS int* sel = lbase + 16;
    LAS int* rnk = sel + 128;
    for (int i = F.tid; i < D * NE; i += NT) { const int k = i >> 3, e = i & 7; RWt[e * D + k] = rw[i]; }
    __syncthreads();
    for (int batch = F.bid; batch < M / 128; batch += F.G) {
        const int row0 = batch * 128;
        if (F.tid < 16) lcnt[F.tid] = 0;
        __syncthreads();
        for (int rr = 0; rr < 16; ++rr) {
            const int r = F.wave * 16 + rr, row = row0 + r;
            const float* mb = mod_l + (size_t)(row >> 12) * MOD_LD;
            f32x4 o[4]; norm_row(x + (size_t)row * D, w, mb + 4 * D, mb + 3 * D, F.lane, o);
            store_row_bf16(h2 + (size_t)row * D, F.lane, o);
            float lg[8];
#pragma unroll
            for (int e = 0; e < 8; ++e) { float s = 0.f;
#pragma unroll
                for (int j = 0; j < 4; ++j) { const f32x4 r4 = *(const LAS f32x4*)(RWt + e * D + 4 * F.lane + 256 * j); s += (o[j].x * r4.x + o[j].y * r4.y) + (o[j].z * r4.z + o[j].w * r4.w); }
                lg[e] = wave_sum(s) + rb[e]; }
            int i0 = 0; float v0 = lg[0];
#pragma unroll
            for (int e = 1; e < 8; ++e) if (lg[e] > v0) { v0 = lg[e]; i0 = e; }
            int i1 = -1; float v1 = -3.0e38f;
#pragma unroll
            for (int e = 0; e < 8; ++e) if (e != i0 && lg[e] > v1) { v1 = lg[e]; i1 = e; }
            if (F.lane == 0) {
                const float p0 = 1.0f / (1.0f + expf(v1 - v0));
                topp[(size_t)row * 2] = p0; topp[(size_t)row * 2 + 1] = 1.0f - p0;
                const int rk0 = __hip_atomic_fetch_add(lcnt + i0, 1, __ATOMIC_RELAXED, __HIP_MEMORY_SCOPE_WORKGROUP), rk1 = __hip_atomic_fetch_add(lcnt + 8 + i1, 1, __ATOMIC_RELAXED, __HIP_MEMORY_SCOPE_WORKGROUP);
                sel[r] = i0 | (i1 << 8); rnk[r] = rk0 | (rk1 << 16);
            }
        }
        __syncthreads();
        if (F.tid < 16) lbase[F.tid] = (int)__hip_atomic_fetch_add(ctl + CW_CNT + 64 * F.tid, (unsigned)lcnt[F.tid], __ATOMIC_RELAXED, __HIP_MEMORY_SCOPE_AGENT);
        __syncthreads();
        if (F.tid < 128) { const int sv = sel[F.tid], rv = rnk[F.tid]; const int e0 = sv & 255, e1 = sv >> 8;
            list[(size_t)e0 * LIST_CAP + lbase[e0] + (rv & 0xffff)] = row0 + F.tid;
            list[(size_t)(8 + e1) * LIST_CAP + lbase[8 + e1] + (rv >> 16)] = row0 + F.tid; }
        __syncthreads();
    }
}
__device__ __forceinline__ void moe_tables(Frame& F, unsigned* ctl, int pass) {
    LAS int* tab = (LAS int*)(F.lds + TAB_OFF);
    __syncthreads();
    if (F.tid == 0) { int pb = 0;
        for (int e = 0; e < 8; ++e) { int c = (int)__hip_atomic_load(ctl + CW_CNT + 64 * (pass * 8 + e), __ATOMIC_RELAXED, __HIP_MEMORY_SCOPE_AGENT); if (c > LIST_CAP) c = LIST_CAP; if (c < 0) c = 0;
            const int np = (c + 255) >> 8; tab[e] = c; tab[8 + e] = pb; for (int p = 0; p < np; ++p) tab[32 + pb + p] = e; pb += np; }
        tab[16] = pb; }
    __syncthreads();
}
template <bool GATHER_>
struct MoeOrder {
    static constexpr bool GATHER = GATHER_;
    pg8::StaticOrder so; const LAS int* tab; const int* list; int npn; unsigned rowbytes;
    __device__ __forceinline__ bool next(int i, pg8::Unit& u) const { if (!so.next(i, u)) return false; u.pb = tab[32 + u.pm] * npn + u.pn; return true; }
    __device__ __forceinline__ int tok_of(int pm, int r) const { const int e = tab[32 + pm]; const int idx = (pm - tab[8 + e]) * 256 + r; return idx < tab[e] ? list[(size_t)e * LIST_CAP + idx] : -1; }
    __device__ __forceinline__ unsigned a_row_off(const pg8::Unit& u, int r) const { const int t = tok_of(u.pm, r); return (unsigned)(t < 0 ? 0 : t) * rowbytes; }
};

struct EpiBranch {
    static constexpr bool PERM = true;
    const bf16* gate; bf16* mrg; int first;
    __device__ __forceinline__ void operator()(const pg8::f32x4 (&acc)[2][2][4][2], const pg8::Unit& u, int wr, int wc, int fr, int fq) const {
        const int row0 = u.pm * 256 + wr * 64 + fr, col0 = u.pn * 256 + wc * 32 + 8 * fq;
#pragma unroll
        for (int ai = 0; ai < 2; ++ai)
#pragma unroll
            for (int m = 0; m < 4; ++m) { const size_t row = (size_t)(row0 + ai * 128 + m * 16);
#pragma unroll
                for (int bj = 0; bj < 2; ++bj) { const int col = col0 + bj * 128;
                    float gg[8], mm[8], o[8]; unpack8(*(const v4u*)(gate + row * N_G + col), gg);
                    if (first) {
#pragma unroll
                        for (int i = 0; i < 8; ++i) mm[i] = 0.f; } else unpack8(*(const v4u*)(mrg + row * D + col), mm);
                    const pg8::f32x4 v0 = acc[ai][bj][m][0], v1 = acc[ai][bj][m][1];
                    o[0] = mm[0] + sigmoidf_(gg[0]) * v0[0]; o[1] = mm[1] + sigmoidf_(gg[1]) * v0[1]; o[2] = mm[2] + sigmoidf_(gg[2]) * v0[2]; o[3] = mm[3] + sigmoidf_(gg[3]) * v0[3];
                    o[4] = mm[4] + sigmoidf_(gg[4]) * v1[0]; o[5] = mm[5] + sigmoidf_(gg[5]) * v1[1]; o[6] = mm[6] + sigmoidf_(gg[6]) * v1[2]; o[7] = mm[7] + sigmoidf_(gg[7]) * v1[3];
                    *(v4u*)(mrg + row * D + col) = pack8(o); }
                asm volatile("" ::: "memory"); }
    }
};
struct EpiResid {
    static constexpr bool PERM = false;
    const float* xin; float* xout; const float* gmod;
    __device__ __forceinline__ void operator()(const pg8::f32x4 (&acc)[2][2][4][2], const pg8::Unit& u, int wr, int wc, int fr, int fq) const {
        const int row0 = u.pm * 256 + wr * 64 + fr, col0 = u.pn * 256 + wc * 32 + 4 * fq;
        const float* gb = gmod + (size_t)((u.pm * 256) >> 12) * MOD_LD + col0;
        pg8::f32x4 gv[2][2];
#pragma unroll
        for (int bj = 0; bj < 2; ++bj)
#pragma unroll
            for (int n = 0; n < 2; ++n) gv[bj][n] = *(const pg8::f32x4*)(gb + bj * 128 + n * 16);
#pragma unroll
        for (int ai = 0; ai < 2; ++ai)
#pragma unroll
            for (int m = 0; m < 4; ++m) { const size_t off = (size_t)(row0 + ai * 128 + m * 16) * D + col0;
#pragma unroll
                for (int bj = 0; bj < 2; ++bj)
#pragma unroll
                    for (int n = 0; n < 2; ++n) { const pg8::f32x4 xv = *(const pg8::f32x4*)(xin + off + bj * 128 + n * 16);
                        *(pg8::f32x4*)(xout + off + bj * 128 + n * 16) = xv + gv[bj][n] * acc[ai][bj][m][n]; }
                asm volatile("" ::: "memory"); }
    }
};
struct EpiSwiglu {
    static constexpr bool PERM = true;
    bf16* act;
    __device__ __forceinline__ void operator()(const pg8::f32x4 (&acc)[2][2][4][2], const pg8::Unit& u, int wr, int wc, int fr, int fq) const {
        const int row0 = u.pm * 256 + wr * 64 + fr, col0 = u.pn * 128 + wc * 32 + 8 * fq;
#pragma unroll
        for (int ai = 0; ai < 2; ++ai)
#pragma unroll
            for (int m = 0; m < 4; ++m) { float o[8];
#pragma unroll
                for (int n = 0; n < 2; ++n)
#pragma unroll
                    for (int i = 0; i < 4; ++i) o[n * 4 + i] = siluf_(acc[ai][0][m][n][i]) * acc[ai][1][m][n][i];
                *(v4u*)(act + (size_t)(row0 + ai * 128 + m * 16) * D_FF + col0) = pack8(o); }
    }
};
struct EpiMoeDown {
    static constexpr bool PERM = false;
    float* x; const float* gmod; const float* topp; int pass; const LAS int* tab; const int* list;
    __device__ __forceinline__ int tok_of(int pm, int r) const { const int e = tab[32 + pm]; const int idx = (pm - tab[8 + e]) * 256 + r; return idx < tab[e] ? list[(size_t)e * LIST_CAP + idx] : -1; }
    __device__ __forceinline__ void operator()(const pg8::f32x4 (&acc)[2][2][4][2], const pg8::Unit& u, int wr, int wc, int fr, int fq) const {
        const int col0 = u.pn * 256 + wc * 32 + 4 * fq;
#pragma unroll
        for (int ai = 0; ai < 2; ++ai)
#pragma unroll
            for (int m = 0; m < 4; ++m) { const int tok = tok_of(u.pm, ai * 128 + wr * 64 + m * 16 + fr);
                if (tok >= 0) { const float p = topp[(size_t)tok * 2 + pass]; const float* gb = gmod + (size_t)(tok >> 12) * MOD_LD + col0; float* xr = x + (size_t)tok * D + col0;
#pragma unroll
                    for (int bj = 0; bj < 2; ++bj)
#pragma unroll
                        for (int n = 0; n < 2; ++n) { const pg8::f32x4 gv = *(const pg8::f32x4*)(gb + bj * 128 + n * 16); const pg8::f32x4 xv = *(const pg8::f32x4*)(xr + bj * 128 + n * 16);
                            *(pg8::f32x4*)(xr + bj * 128 + n * 16) = xv + gv * p * acc[ai][bj][m][n]; } }
                asm volatile("" ::: "memory"); }
    }
};

__device__ __forceinline__ void p_final_norm(Frame& F, float* x, const float* w) {
    const int gw = F.bid * NWAVES + F.wave, NGW = F.G * NWAVES;
    for (int row = gw; row < M; row += NGW) {
        f32x4* xr = (f32x4*)(x + (size_t)row * D) + F.lane;
        f32x4 v[4]; float s = 0.f;
#pragma unroll
        for (int j = 0; j < 4; ++j) { v[j] = xr[64 * j]; s += (v[j].x * v[j].x + v[j].y * v[j].y) + (v[j].z * v[j].z + v[j].w * v[j].w); }
        const float rstd = 1.0f / sqrtf(wave_sum(s) * (1.0f / D) + EPS);
#pragma unroll
        for (int j = 0; j < 4; ++j) xr[64 * j] = v[j] * rstd * ((const f32x4*)w)[F.lane + 64 * j];
    }
}

__device__ __forceinline__ bool fresh(Frame& F) {
    int t_ = threadIdx.x, b_ = blockIdx.x, g_ = gridDim.x; asm volatile("" : "+v"(t_), "+s"(b_), "+s"(g_));
    F.tid = t_; F.lane = t_ & 63; F.wave = __builtin_amdgcn_readfirstlane(t_ >> 6); F.bid = b_; F.G = g_; return true;
}
constexpr int NPL = 13, NPHASE = 1 + DEPTH * NPL;
__global__ void __launch_bounds__(NT, 2) fwd(Args args) {
    extern __shared__ __attribute__((aligned(16))) unsigned char lds[];
    Frame F;
    F.lds = (LAS unsigned char*)lds;
    F.tid = threadIdx.x; F.lane = F.tid & 63; F.wave = __builtin_amdgcn_readfirstlane(F.tid >> 6);
    F.G = gridDim.x; F.bid = blockIdx.x;
    volatile LAS unsigned* MISC = (volatile LAS unsigned*)(F.lds + MISC_OFF);
    if (F.tid < 32) MISC[F.tid] = 0u;
    __syncthreads();
#if MK_PER_PHASE
#define GRID_BAR() do { } while (0)
#else
    XcdBarrier bar = xcd_barrier_post((unsigned*)(KA()->ws + WS_CTL) + CW_BAR, MISC + 8);
#define GRID_BAR() xcd_barrier(bar)
#endif
    const int lo = KA()->ph_lo, hi = KA()->ph_hi;
#ifdef ONLY_REL
#define IN(k) (fresh(F) && ((k) == 0 ? 100 : ((k) - 1) % NPL) == ONLY_REL && (ONLY_L < 0 || ((k) - 1) / NPL == ONLY_L) && lo <= (k) && (k) < hi)
#else
#define IN(k) (lo <= (k) && (k) < hi && fresh(F))
#endif
#define SEAM(k) do { if ((k) + 1 < hi) GRID_BAR(); } while (0)
    PG8_LAS unsigned char* ring = (PG8_LAS unsigned char*)lds;

    if (IN(0)) {
#pragma unroll 1
        for (int rep = 0; rep < REPS(5); ++rep) { __syncthreads(); p_prologue(F, KA()); }
        SEAM(0); }

#ifdef UNROLL_L
#pragma unroll
#else
#pragma unroll 1
#endif
    for (int l = 0; l < DEPTH; ++l) {
        const int pb = 1 + l * NPL;
#define WSP(off) (ka->ws + (off))
#define MODL ((const float*)WSP(WS_MOD) + (size_t)l * BATCH * MOD_LD)
#define WMIXL ((bf16*)WSP(WS_WMIX + (size_t)l * WMIX_STRIDE))
        if (IN(pb + 0)) {
#pragma unroll 1
          for (int rep = 0; rep < REPS(7); ++rep) { KArgs ka = KA(); p_norm(F, l == 0 ? ka->in[0] : (const float*)ka->out, ka->in[4] + l * D, MODL, 1 * D, 0, (bf16*)WSP(WS_H)); }
          SEAM(pb + 0); }
        if (IN(pb + 1)) {
            KArgs ka = KA();
            pg8::Gemm g{(bf16*)WSP(WS_H), WMIXL, D, D, D}; pg8::StaticOrder S; S.init(M / 256, N_BCA / 256, F.G, F.bid);
            pg8::EpiBf16 E{(bf16*)WSP(WS_P1), N_BCA};
#pragma unroll 1
            for (int rep = 0; rep < REPS(3); ++rep)
            pg8::gemm_phase(ring, g, S, E); SEAM(pb + 1);
        }
        if (IN(pb + 2)) {
#pragma unroll 1
          for (int rep = 0; rep < REPS(1); ++rep) {
            __syncthreads();
            { KArgs ka = KA(); p_hgrn<1>(F, (const bf16*)WSP(WS_P1), ka->in[8], l, ka->in[9] + l * D_BV, (bf16*)WSP(WS_YB), (float*)WSP(WS_HU), (float*)WSP(WS_HD)); }
            __syncthreads();
            { KArgs ka = KA(); p_sgu(F, (const bf16*)WSP(WS_P1), ka->in[10] + l * D_C, ka->in[11] + (size_t)l * 4 * 128 * 128, ka->in[12] + l * 4 * 128, (bf16*)WSP(WS_YC)); }
            { KArgs ka = KA(); p_conv(F, (const bf16*)WSP(WS_P1), ka->in[7] + l * 3 * D_A, (bf16*)WSP(WS_YA)); }
          }
            SEAM(pb + 2);
        }
        if (IN(pb + 3)) {
#pragma unroll 1
          for (int rep = 0; rep < REPS(2); ++rep)
            { KArgs ka = KA(); p_hgrn<2>(F, (const bf16*)WSP(WS_P1), ka->in[8], l, ka->in[9] + l * D_BV, (bf16*)WSP(WS_YB), (float*)WSP(WS_HU), (float*)WSP(WS_HD)); }
            SEAM(pb + 3);
        }
        if (IN(pb + 4)) {
            KArgs ka = KA();
            pg8::Gemm g{(bf16*)WSP(WS_H), WMIXL + (size_t)N_BCA * D, D, D, D}; pg8::StaticOrder S; S.init(M / 256, N_G / 256, F.G, F.bid);
            pg8::EpiBf16 E{(bf16*)WSP(WS_PG), N_G};
            pg8::gemm_phase(ring, g, S, E); SEAM(pb + 4);
        }
        if (IN(pb + 5)) {
#pragma unroll 1
            for (int br = 0; br < 3; ++br) {
                KArgs ka = KA();
                pg8::Gemm g{(bf16*)WSP(WS_YA + (size_t)br * 32 * MiB), WMIXL + (size_t)N_IN * D + (size_t)br * 512 * 1024, 512, 512, 512}; pg8::StaticOrder S; S.init(M / 256, D / 256, F.G, F.bid);
                EpiBranch E{(const bf16*)WSP(WS_PG) + br * D, (bf16*)WSP(WS_MRG), br == 0 ? 1 : 0};
                pg8::gemm_phase(ring, g, S, E);
            }
            SEAM(pb + 5);
        }
        if (IN(pb + 6)) {
            KArgs ka = KA();
            pg8::Gemm g{(bf16*)WSP(WS_MRG), WMIXL + (size_t)N_IN * D + 3 * 512 * 1024, D, D, D}; pg8::StaticOrder S; S.init(M / 256, D / 256, F.G, F.bid);
            EpiResid E{l == 0 ? ka->in[0] : (const float*)ka->out, ka->out, MODL + 2 * D};
            pg8::gemm_phase(ring, g, S, E); SEAM(pb + 6);
        }
        if (l == 0) {
            if (IN(pb + 7)) { KArgs ka = KA(); p_norm(F, ka->out, ka->in[5] + l * D, MODL, 4 * D, 3 * D, (bf16*)WSP(WS_H)); SEAM(pb + 7); }
            if (IN(pb + 8)) {
                KArgs ka = KA();
                pg8::Gemm g{(bf16*)WSP(WS_H), (bf16*)WSP(WS_W13), D, D, D}; pg8::StaticOrder S; S.init(M / 256, N13 / 256, F.G, F.bid);
                EpiSwiglu E{(bf16*)WSP(WS_ACT)};
                pg8::gemm_phase(ring, g, S, E); SEAM(pb + 8);
            }
            if (IN(pb + 9)) {
                KArgs ka = KA();
                pg8::Gemm g{(bf16*)WSP(WS_ACT), (bf16*)WSP(WS_W2), D_FF, D_FF, D_FF}; pg8::StaticOrder S; S.init(M / 256, D / 256, F.G, F.bid);
                EpiResid E{ka->out, ka->out, MODL + 5 * D};
                pg8::gemm_phase(ring, g, S, E); SEAM(pb + 9);
            }
        } else {
            if (IN(pb + 7)) {
#pragma unroll 1
                for (int rep = 0; rep < REPS(6); ++rep) { __syncthreads(); p_moe_weights(F, KA()); }
                __syncthreads(); { KArgs ka = KA(); p_norm_router(F, ka, ka->out, ka->in[5] + l * D, MODL, (bf16*)WSP(WS_H2M)); } SEAM(pb + 7); }
#pragma unroll 1
            for (int pass = 0; pass < 2; ++pass) {
#ifndef NO_MOE_UP
                if (IN(pb + 8 + 2 * pass)) {
                    KArgs ka = KA();
                    moe_tables(F, (unsigned*)WSP(WS_CTL), pass);
                    const LAS int* tab = (const LAS int*)(F.lds + TAB_OFF);
                    MoeOrder<true> S; S.so.init(tab[16], N13 / 256, F.G, F.bid); S.tab = tab; S.list = (const int*)WSP(WS_LIST) + (size_t)pass * 8 * LIST_CAP; S.npn = N13 / 256; S.rowbytes = D * 2;
                    pg8::Gemm g{(bf16*)WSP(WS_H2M), (bf16*)WSP(WS_WM13), D, D, D};
                    EpiSwiglu E{(bf16*)WSP(WS_ACTM)};
#pragma unroll 1
                    for (int rep = 0; rep < REPS(4); ++rep)
                    pg8::gemm_phase(ring, g, S, E); SEAM(pb + 8 + 2 * pass);
                }
#endif
#ifndef NO_MOE_DOWN
                if (IN(pb + 9 + 2 * pass)) {
                    KArgs ka = KA();
                    moe_tables(F, (unsigned*)WSP(WS_CTL), pass);
                    const LAS int* tab = (const LAS int*)(F.lds + TAB_OFF);
                    MoeOrder<false> S; S.so.init(tab[16], D / 256, F.G, F.bid); S.tab = tab; S.list = (const int*)WSP(WS_LIST) + (size_t)pass * 8 * LIST_CAP; S.npn = D / 256; S.rowbytes = 0;
                    pg8::Gemm g{(bf16*)WSP(WS_ACTM), (bf16*)WSP(WS_WM2), D_FF, D_FF, D_FF};
                    EpiMoeDown E{ka->out, MODL + 5 * D, (const float*)WSP(WS_TOPP), pass, tab, S.list};
                    pg8::gemm_phase(ring, g, S, E); SEAM(pb + 9 + 2 * pass);
                }
#endif
            }
            if (IN(pb + 12)) { KArgs ka = KA(); p_final_norm(F, ka->out, ka->in[25]); }
        }
    }
#undef IN
#undef SEAM
}

extern "C" void kernel_launch(void* const* d_in, const int* in_sizes, int n_in, void* d_out, int out_size, void* d_ws, size_t ws_size, hipStream_t stream) {
    static int grid = 0;
    if (grid == 0) {
        if (n_in != 26 || in_sizes[0] != M * D || out_size != M * D || ws_size < WS_NEED) { fprintf(stderr, "kernel_launch: unexpected shapes / workspace (n_in %d, ws %zu, need %zu); nothing launched\n", n_in, ws_size, (size_t)WS_NEED); grid = -1; return; }
        int dev = 0, cus = 0, per_cu = 0;
        if (hipGetDevice(&dev) != hipSuccess || hipDeviceGetAttribute(&cus, hipDeviceAttributeMultiprocessorCount, dev) != hipSuccess) { grid = -1; return; }
        if (hipFuncSetAttribute((const void*)fwd, hipFuncAttributeMaxDynamicSharedMemorySize, LDS_BYTES) != hipSuccess) { fprintf(stderr, "kernel_launch: hipFuncSetAttribute failed\n"); grid = -1; return; }
        if (hipOccupancyMaxActiveBlocksPerMultiprocessor(&per_cu, (const void*)fwd, NT, LDS_BYTES) != hipSuccess || per_cu < 1) fprintf(stderr, "kernel_launch: occupancy query reports %d\n", per_cu);
        (void)hipGetLastError();
        grid = cus;
    }
    if (grid < 0) return;
    if (hipMemsetAsync((char*)d_ws + WS_CTL, 0, CTL_ZERO_BYTES, stream) != hipSuccess) return;
    Args a{};
    for (int i = 0; i < 26; ++i) a.in[i] = (const float*)d_in[i];
    a.out = (float*)d_out; a.ws = (unsigned char*)d_ws;
#if MK_PER_PHASE
    for (int p = 0; p < NPHASE; ++p) {
        if (p >= 1 + 10 && p <= 1 + 12) continue;
        a.ph_lo = p; a.ph_hi = p + 1;
        hipLaunchKernelGGL(fwd, dim3(grid), dim3(NT), LDS_BYTES, stream, a);
    }
#else
    a.ph_lo = 0; a.ph_hi = NPHASE;
    hipLaunchKernelGGL(fwd, dim3(grid), dim3(NT), LDS_BYTES, stream, a);
#endif
}
```

```cpp
#include <hip/hip_runtime.h>
#include <cstdio>
#include <cstdint>

#ifndef PROBE_DUP
#define PROBE_DUP 0
#endif
#ifndef PROBE_REPS
#define PROBE_REPS 2
#endif
#define REPS(k) ((PROBE_DUP == (k)) ? PROBE_REPS : 1)
#ifndef MK_PER_PHASE
#define MK_PER_PHASE 0
#endif

namespace pg8 {
#define PG8_LAS __attribute__((address_space(3)))
typedef unsigned short bf16_t;
typedef short bf16x8 __attribute__((ext_vector_type(8)));
typedef float f32x4 __attribute__((ext_vector_type(4)));
typedef unsigned u32x4 __attribute__((ext_vector_type(4)));
constexpr int BM = 256, BK = 64, HALF = 128, HTB = HALF * BK * 2, STAGE_BYTES = 8 * HTB, NXCD = 8, WGM = 8;

__host__ __device__ __forceinline__ int lds_byte(int r, int c) { const int st = (r >> 4) * 2 + (c >> 5), rr = r & 15, cc = c & 31, ob = rr * 64 + cc * 2; return st * 1024 + (ob ^ (((ob >> 9) & 1) << 5)); }
__host__ __device__ __forceinline__ void stage_rc(int b, int& R, int& C) { const int st = b / 1024, sb = b % 1024, swz = sb ^ (((sb >> 9) & 1) << 5); R = (st >> 1) * 16 + swz / 64; C = (st & 1) * 32 + (swz % 64) / 2; }
__host__ __device__ __forceinline__ int perm32(int rho) { const int n = rho >> 4, i = rho & 15; return 8 * (i >> 2) + 4 * n + (i & 3); }

struct Unit { int pm, pn, pb; };
struct Gemm { const bf16_t* A; const bf16_t* Bt; int lda, ldb, K; };

struct StaticOrder {
    static constexpr bool GATHER = false;
    int nM, nN, nwg, G, c;
    __device__ __forceinline__ void init(int nM_, int nN_, int G_, int c_) { nM = nM_; nN = nN_; nwg = nM * nN; G = G_; c = c_; }
    __device__ __forceinline__ bool next(int i, Unit& u) const {
        const long L = (long)i * G + c; if (L >= nwg) return false;
        int wgid = (int)L; { const int q = nwg / NXCD, r = nwg % NXCD, xcd = wgid % NXCD, off = wgid / NXCD; wgid = (xcd < r ? xcd * (q + 1) : r * (q + 1) + (xcd - r) * q) + off; }
        const int nig = WGM * nN, gid = wgid / nig, fm = gid * WGM, gsz = (nM - fm) < WGM ? (nM - fm) : WGM;
        u.pm = fm + ((wgid % nig) % gsz); u.pn = (wgid % nig) / gsz; u.pb = u.pn; return true;
    }
    __device__ __forceinline__ unsigned a_row_off(const Unit&, int) const { return 0u; }
};

__device__ __forceinline__ unsigned cvt_pk_bf16(float lo, float hi) { unsigned r; asm volatile("v_cvt_pk_bf16_f32 %0, %1, %2" : "=v"(r) : "v"(lo), "v"(hi)); return r; }

struct EpiBf16 {
    static constexpr bool PERM = true;
    bf16_t* O; int ldc; float scale;
    __device__ __forceinline__ void operator()(const f32x4 (&acc)[2][2][4][2], const Unit& u, int wr, int wc, int fr, int fq) const {
        const int row0 = u.pm * BM + wr * 64 + fr, col0 = u.pn * BM + wc * 32 + 8 * fq;
#pragma unroll
        for (int ai = 0; ai < 2; ++ai)
#pragma unroll
            for (int m = 0; m < 4; ++m) { bf16_t* rowp = O + (size_t)(row0 + ai * HALF + m * 16) * ldc + col0;
#pragma unroll
                for (int bj = 0; bj < 2; ++bj) { const f32x4 v0 = acc[ai][bj][m][0] * scale, v1 = acc[ai][bj][m][1] * scale;
                    u32x4 w; w.x = cvt_pk_bf16(v0[0], v0[1]); w.y = cvt_pk_bf16(v0[2], v0[3]); w.z = cvt_pk_bf16(v1[0], v1[1]); w.w = cvt_pk_bf16(v1[2], v1[3]);
                    *(u32x4*)(rowp + bj * HALF) = w; } }
    }
};

template <int KREP = 1, class Epi, class Sched>
__device__ __forceinline__ void gemm_phase(PG8_LAS unsigned char* lds, const Gemm g, const Sched& S, const Epi& E) {
    constexpr bool GATHER = Sched::GATHER;
    int tid_ = threadIdx.x; asm volatile("" : "+v"(tid_));
    const int tid = tid_, wid = __builtin_amdgcn_readfirstlane(tid >> 6), lane = tid & 63, wr = wid >> 2, wc = wid & 3, fr = lane & 15, fq = lane >> 4;
    const int K = g.K, nt = K / BK;
    unsigned voffB[2], vA0[2], vA1[2], nA0[2], nA1[2];
#pragma unroll
    for (int i = 0; i < 2; ++i) { int R, C; stage_rc(tid * 16 + i * 8192, R, C); const int Rb = Epi::PERM ? ((R & ~31) + perm32(R & 31)) : R;
        voffB[i] = (unsigned)(Rb * g.ldb + C) * 2u;
        vA0[i] = (unsigned)(R * g.lda + C) * 2u; vA1[i] = vA0[i]; nA0[i] = vA0[i]; nA1[i] = vA0[i]; }
    const size_t kstep = (size_t)(BK * 2);
    const size_t hstepB = (size_t)HALF * g.ldb * 2, tstepB = 2 * hstepB, tstepA = (size_t)BM * g.lda * 2;
    const size_t hstepA = GATHER ? (size_t)0 : (size_t)HALF * g.lda * 2;
    const unsigned ldsw = (unsigned)wid * 1024u;
    const int aoff = lds_byte(wr * 64 + fr, fq * 8), boff = lds_byte(wc * 32 + fr, fq * 8);
#define PG8_SA(b, h) (((b) * 2 + (h)) * HTB)
#define PG8_SB(b, h) ((4 + (b) * 2 + (h)) * HTB)
#define PG8_STAGE(bufoff, gbase, voff) do { _Pragma("unroll") for (int _i = 0; _i < 2; ++_i) \
        __builtin_amdgcn_global_load_lds((const unsigned*)((const char*)(gbase) + (voff)[_i]), (PG8_LAS unsigned*)(lds + (bufoff) + ldsw + _i * 8192), 16, 0, 0); } while (0)
#define PG8_LDA(dst, b, h) do { _Pragma("unroll") for (int m = 0; m < 4; ++m) _Pragma("unroll") for (int k = 0; k < 2; ++k) dst[m][k] = *(const PG8_LAS bf16x8*)(lds + PG8_SA(b, h) + aoff + m * 2048 + k * 1024); } while (0)
#define PG8_LDB(dst, b, h) do { _Pragma("unroll") for (int n = 0; n < 2; ++n) _Pragma("unroll") for (int k = 0; k < 2; ++k) dst[n][k] = *(const PG8_LAS bf16x8*)(lds + PG8_SB(b, h) + boff + n * 2048 + k * 1024); } while (0)
#define PG8_MMA(ai, bj, At, Bt) do { __builtin_amdgcn_s_setprio(1); _Pragma("unroll") for (int m = 0; m < 4; ++m) _Pragma("unroll") for (int n = 0; n < 2; ++n) _Pragma("unroll") for (int k = 0; k < 2; ++k) \
        acc[ai][bj][m][n] = __builtin_amdgcn_mfma_f32_16x16x32_bf16(Bt[n][k], At[m][k], acc[ai][bj][m][n], 0, 0, 0); __builtin_amdgcn_s_setprio(0); } while (0)
#define PG8_WAIT_V(n) asm volatile("s_waitcnt vmcnt(" #n ")" ::: "memory")
#define PG8_WAIT_L(n) asm volatile("s_waitcnt lgkmcnt(" #n ")" ::: "memory")
#define PG8_BAR __builtin_amdgcn_s_barrier()
#define PG8_SCHED __builtin_amdgcn_sched_barrier(0)
#define PG8_GOFF(unit, d0, d1) do { _Pragma("unroll") for (int _i = 0; _i < 2; ++_i) { int R_, C_; stage_rc(tid * 16 + _i * 8192, R_, C_); \
        d0[_i] = S.a_row_off(unit, R_) + (unsigned)C_ * 2u; d1[_i] = S.a_row_off(unit, R_ + HALF) + (unsigned)C_ * 2u; } } while (0)
    Unit cur, nxt; int ui = 0;
    if (!S.next(0, cur)) return;
    f32x4 acc[2][2][4][2];
#pragma unroll
    for (int a = 0; a < 2; ++a)
#pragma unroll
        for (int b = 0; b < 2; ++b)
#pragma unroll
            for (int m = 0; m < 4; ++m)
#pragma unroll
                for (int n = 0; n < 2; ++n) acc[a][b][m][n] = (f32x4){0.f, 0.f, 0.f, 0.f};
    bf16x8 At[4][2], B0[2][2], B1[2][2];
    if constexpr (GATHER) { PG8_GOFF(cur, vA0, vA1); }
    const char* cA = GATHER ? (const char*)g.A : (const char*)g.A + (size_t)cur.pm * tstepA; const char* cB = (const char*)g.Bt + (size_t)cur.pb * tstepB;
    PG8_STAGE(PG8_SB(0, 0), cB, voffB); PG8_STAGE(PG8_SB(0, 1), cB + hstepB, voffB); PG8_STAGE(PG8_SA(0, 0), cA, vA0); PG8_STAGE(PG8_SA(0, 1), cA + hstepA, vA1);
    if (wr == 1) PG8_BAR;
    PG8_WAIT_V(2); PG8_BAR;
    PG8_STAGE(PG8_SB(1, 0), cB + kstep, voffB); PG8_STAGE(PG8_SA(1, 0), cA + kstep, vA0); PG8_STAGE(PG8_SB(1, 1), cB + hstepB + kstep, voffB);
    PG8_WAIT_V(6); PG8_BAR;
    for (;;) {
        const bool has_next = S.next(ui + 1, nxt);
        const char* nA = GATHER ? (const char*)g.A : (has_next ? (const char*)g.A + (size_t)nxt.pm * tstepA : cA); const char* nB = has_next ? (const char*)g.Bt + (size_t)nxt.pb * tstepB : cB;
        if constexpr (GATHER) { if (has_next) { PG8_GOFF(nxt, nA0, nA1); } else {
#pragma unroll
            for (int i = 0; i < 2; ++i) { nA0[i] = vA0[i]; nA1[i] = vA1[i]; } } }
        for (int t = 0; t < nt * KREP; t += 2) {
            const bool last = (t == nt * KREP - 2);
            const int t1 = (KREP == 1) ? t + 1 : ((t + 1) & (nt - 1)), t2 = (KREP == 1) ? t + 2 : ((t + 2) & (nt - 1));
            const char* a1 = cA + (size_t)t1 * kstep;
            const char* a2 = last ? nA : cA + (size_t)t2 * kstep; const char* b2 = last ? nB : cB + (size_t)t2 * kstep;
            const char* a3 = a2 + kstep; const char* b3 = b2 + kstep;
            unsigned s0[2], s1[2];
#pragma unroll
            for (int i = 0; i < 2; ++i) { s0[i] = (GATHER && last) ? nA0[i] : vA0[i]; s1[i] = GATHER ? (last ? nA1[i] : vA1[i]) : vA0[i]; }
            PG8_LDB(B0, 0, 0); PG8_LDB(B1, 0, 1); PG8_SCHED; PG8_LDA(At, 0, 0); PG8_STAGE(PG8_SA(1, 1), a1 + hstepA, vA1);
            PG8_WAIT_V(8); PG8_WAIT_L(0); PG8_BAR; PG8_MMA(0, 0, At, B0); PG8_MMA(0, 1, At, B1); PG8_BAR; PG8_SCHED;
            PG8_LDA(At, 0, 1); PG8_STAGE(PG8_SB(0, 0), b2, voffB); PG8_STAGE(PG8_SB(0, 1), b2 + hstepB, voffB); PG8_STAGE(PG8_SA(0, 0), a2, s0);
            PG8_WAIT_V(8); PG8_WAIT_L(0); PG8_BAR; PG8_MMA(1, 0, At, B0); PG8_MMA(1, 1, At, B1); PG8_BAR; PG8_SCHED;
            PG8_LDB(B0, 1, 0); PG8_LDB(B1, 1, 1); PG8_SCHED; PG8_LDA(At, 1, 0); PG8_STAGE(PG8_SA(0, 1), a2 + hstepA, s1);
            PG8_WAIT_V(8); PG8_WAIT_L(0); PG8_BAR; PG8_MMA(0, 0, At, B0); PG8_MMA(0, 1, At, B1); PG8_BAR; PG8_SCHED;
            PG8_LDA(At, 1, 1); PG8_STAGE(PG8_SB(1, 0), b3, voffB); PG8_STAGE(PG8_SB(1, 1), b3 + hstepB, voffB); PG8_STAGE(PG8_SA(1, 0), a3, s0);
            PG8_WAIT_V(8); PG8_WAIT_L(0); PG8_BAR; PG8_MMA(1, 0, At, B0); PG8_MMA(1, 1, At, B1); PG8_BAR; PG8_SCHED;
        }
        if (wr == 0) PG8_BAR;
        E(acc, cur, wr, wc, fr, fq);
        if (!has_next) break;
#pragma unroll
        for (int a = 0; a < 2; ++a)
#pragma unroll
            for (int b = 0; b < 2; ++b)
#pragma unroll
                for (int m = 0; m < 4; ++m)
#pragma unroll
                    for (int n = 0; n < 2; ++n) acc[a][b][m][n] = (f32x4){0.f, 0.f, 0.f, 0.f};
        cur = nxt; cA = nA; cB = nB; ++ui;
        if constexpr (GATHER) {
#pragma unroll
            for (int i = 0; i < 2; ++i) { vA0[i] = nA0[i]; vA1[i] = nA1[i]; } }
        if (wr == 1) PG8_BAR;
    }
    PG8_WAIT_V(0);
    PG8_BAR;
#undef PG8_SA
#undef PG8_SB
#undef PG8_STAGE
#undef PG8_LDA
#undef PG8_LDB
#undef PG8_MMA
#undef PG8_WAIT_V
#undef PG8_WAIT_L
#undef PG8_BAR
#undef PG8_SCHED
#undef PG8_GOFF
}
}

constexpr int D = 1024, BATCH = 8, SEQ = 4096, M = BATCH * SEQ, DEPTH = 2;
constexpr int D_A = 512, D_BK = 512, D_BV = 512, D_C = 512, H_B = 4;
constexpr int N_IN = 7680, N_BCA = 4608, N_G = 3072;
constexpr int D_FF = 2816, NE = 8, N13 = 2 * D_FF;
constexpr int MOD_LD = 6 * D;
constexpr float EPS = 1e-6f;
constexpr int LIST_CAP = M;
constexpr int MOE_ROWS = M + NE * 256;

constexpr size_t MiB = 1u << 20;
constexpr size_t WS_CTL = 0, CTL_ZERO_BYTES = 1 * MiB;
constexpr size_t WS_MOD = 1 * MiB;
constexpr size_t WS_TOPP = 2 * MiB;
constexpr size_t WS_LIST = 3 * MiB;
constexpr size_t WS_WMIX = 6 * MiB, WMIX_STRIDE = 20 * MiB;
constexpr size_t WS_W13 = 46 * MiB, WS_W2 = 57 * MiB;
constexpr size_t WS_BIG = 64 * MiB;
constexpr size_t WS_H = WS_BIG;
constexpr size_t WS_P1 = WS_BIG + 64 * MiB;
constexpr size_t WS_PG = WS_P1;
constexpr size_t WS_MRG = WS_P1 + 192 * MiB;
constexpr size_t WS_YA = WS_P1 + 288 * MiB, WS_YB = WS_YA + 32 * MiB, WS_YC = WS_YB + 32 * MiB;
constexpr size_t WS_ACT = WS_P1;
constexpr size_t WS_HU = WS_YC + 32 * MiB;
constexpr size_t WS_HD = WS_HU + 16 * MiB;
constexpr size_t WS_MIX_END = WS_HD + 1 * MiB;
constexpr size_t WS_WM13 = 6 * MiB;
constexpr size_t WS_WM2 = WS_WM13 + 88 * MiB;
constexpr size_t WS_H2M = WS_WM2 + 44 * MiB;
constexpr size_t WS_ACTM = WS_H2M + 64 * MiB;
constexpr size_t WS_MOE_END = WS_ACTM + (size_t)MOE_ROWS * D_FF * 2;
constexpr size_t WS_NEED = WS_MIX_END > WS_MOE_END ? WS_MIX_END : WS_MOE_END;
static_assert(WS_W2 + (size_t)D * D_FF * 2 <= WS_BIG && WS_WMIX + 2 * WMIX_STRIDE <= WS_W13, "ws map");
constexpr int CW_BAR = 4096;
constexpr int CW_CNT = 16384;

constexpr int LDS_BYTES = 147456;
constexpr int SCR_BYTES = 139264;
constexpr int TAB_OFF = SCR_BYTES;
constexpr int MISC_OFF = TAB_OFF + 4096;
static_assert(MISC_OFF + 128 <= LDS_BYTES, "LDS map");
constexpr int NWAVES = 8, NT = 512;

#define GAS __attribute__((address_space(1)))
#define LAS __attribute__((address_space(3)))
typedef unsigned short bf16;
typedef unsigned v4u __attribute__((ext_vector_type(4)));
typedef float f32x4 __attribute__((ext_vector_type(4)));
#define LDS_WAIT() asm volatile("s_waitcnt lgkmcnt(0)" ::: "memory")

typedef float f32x2_t __attribute__((ext_vector_type(2)));
typedef __bf16 bf16x2_t __attribute__((ext_vector_type(2)));
__device__ __forceinline__ unsigned pk2(float lo, float hi) { f32x2_t v = {lo, hi}; bf16x2_t b = __builtin_convertvector(v, bf16x2_t); return __builtin_bit_cast(unsigned, b); }
__device__ __forceinline__ float bf_lo(unsigned u) { return __uint_as_float(u << 16); }
__device__ __forceinline__ float bf_hi(unsigned u) { return __uint_as_float(u & 0xffff0000u); }
__device__ __forceinline__ void unpack8(const v4u w, float (&f)[8]) { f[0] = bf_lo(w.x); f[1] = bf_hi(w.x); f[2] = bf_lo(w.y); f[3] = bf_hi(w.y); f[4] = bf_lo(w.z); f[5] = bf_hi(w.z); f[6] = bf_lo(w.w); f[7] = bf_hi(w.w); }
__device__ __forceinline__ v4u pack8(const float (&f)[8]) { v4u w; w.x = pk2(f[0], f[1]); w.y = pk2(f[2], f[3]); w.z = pk2(f[4], f[5]); w.w = pk2(f[6], f[7]); return w; }
__device__ __forceinline__ float sigmoidf_(float x) { return __builtin_amdgcn_rcpf(1.0f + __expf(-x)); }
__device__ __forceinline__ float siluf_(float x) { return x * sigmoidf_(x); }
__device__ __forceinline__ float wave_sum(float v) {
#pragma unroll
    for (int o = 1; o < 64; o <<= 1) v += __shfl_xor(v, o);
    return v;
}

#define XB_TMO      128
#define XB_XCNT(j)  (256  + 64 * (j))
#define XB_XSUB(j)  (1280 + 64 * (j))
#define XB_XGEN(j)  (2304 + 64 * (j))
#define XB_TOP      3328
#define XB_TOPGEN   3392
#define XCD_BAR_WORDS 3456
#define XB_SPIN_CAP (1u << 18)

__device__ __forceinline__ unsigned xb_ld(unsigned* p)              { return __hip_atomic_load(p, __ATOMIC_RELAXED, __HIP_MEMORY_SCOPE_AGENT); }
__device__ __forceinline__ unsigned xb_add(unsigned* p, unsigned v) { return __hip_atomic_fetch_add(p, v, __ATOMIC_RELAXED, __HIP_MEMORY_SCOPE_AGENT); }
__device__ __forceinline__ unsigned xb_xcc_id() { return (unsigned)__builtin_amdgcn_s_getreg((3 << 11) | 20) & 0xFu; }
#define XB_SPIN(cond, bar) do { unsigned _sp = 0; while (cond) { __builtin_amdgcn_s_sleep(1); \
    if ((++_sp & 255u) == 0u) { if (xb_ld(&(bar)[XB_TMO])) break; if (_sp > XB_SPIN_CAP) { atomicAdd(&(bar)[XB_TMO], 1u); break; } } } } while (0)

struct XcdBarrier { unsigned* bar; unsigned x; volatile LAS unsigned* st; };

__device__ __forceinline__ XcdBarrier xcd_barrier_post(unsigned* bar, volatile LAS unsigned* st) {
    XcdBarrier b; b.bar = bar; b.x = xb_xcc_id(); b.st = st;
    if (threadIdx.x == 0) (void)xb_add(&bar[XB_XCNT(b.x)], 1u);
    return b;
}
__device__ __forceinline__ void xcd_barrier_complete(unsigned* bar, unsigned x, unsigned& nloc, unsigned& nx) {
    const unsigned G = gridDim.x * gridDim.y * gridDim.z;
    unsigned sum, cnt, mine, sp = 0u;
    for (;;) {
        sum = 0u; cnt = 0u; mine = 0u;
#pragma unroll
        for (unsigned j = 0; j < 16; ++j) { const unsigned c = xb_ld(&bar[XB_XCNT(j)]); sum += c; cnt += (c > 0u) ? 1u : 0u; mine = (j == x) ? c : mine; }
        if (sum == G) break;
        __builtin_amdgcn_s_sleep(1);
        if ((++sp & 255u) == 0u) { if (xb_ld(&bar[XB_TMO])) break; if (sp > XB_SPIN_CAP) { atomicAdd(&bar[XB_TMO], 1u); break; } }
    }
    nloc = mine > 0u ? mine : 1u; nx = cnt > 0u ? cnt : 1u;
}
__device__ __forceinline__ void xcd_barrier(const XcdBarrier& b) {
    asm volatile("s_waitcnt vmcnt(0)" ::: "memory");
    __syncthreads();
    if (threadIdx.x == 0) {
        unsigned* bar = b.bar;
        __builtin_amdgcn_s_waitcnt(0);
        unsigned nloc = b.st[0], nx = b.st[1];
        if (nloc == 0u) { xcd_barrier_complete(bar, b.x, nloc, nx); b.st[0] = nloc; b.st[1] = nx; }
        const unsigned old = xb_add(&bar[XB_XSUB(b.x)], 1u);
        const unsigned gen = old / nloc;
        if (old + 1u == (gen + 1u) * nloc) {
            __builtin_amdgcn_fence(__ATOMIC_RELEASE, "agent");
            asm volatile("s_waitcnt vmcnt(0)" ::: "memory");
            const unsigned og = xb_add(&bar[XB_TOP], 1u);
            const unsigned tg = og / nx;
            if (og + 1u == (tg + 1u) * nx) xb_add(&bar[XB_TOPGEN], 1u);
            else XB_SPIN(xb_ld(&bar[XB_TOPGEN]) == tg, bar);
            __builtin_amdgcn_fence(__ATOMIC_ACQUIRE, "agent");
            xb_add(&bar[XB_XGEN(b.x)], 1u);
            asm volatile("s_waitcnt vmcnt(0)" ::: "memory");
        } else {
            XB_SPIN(xb_ld(&bar[XB_XGEN(b.x)]) == gen, bar);
            __builtin_amdgcn_fence(__ATOMIC_ACQUIRE, "agent");
            asm volatile("s_waitcnt vmcnt(0)" ::: "memory");
        }
    }
    __syncthreads();
}

struct Args { const float* in[26]; float* out; unsigned char* ws; int ph_lo, ph_hi; };
typedef const Args __attribute__((address_space(4)))* KArgs;
#define KA() ({ KArgs p_ = (KArgs)__builtin_amdgcn_kernarg_segment_ptr(); asm volatile("" : "+s"(p_)); p_; })
struct Frame {
    LAS unsigned char* lds;
    int tid, lane, wave, G, bid;
};

template <int MAP>
__device__ __forceinline__ void transpose_item(const float* W, int K, int N, bf16* WT, int row_off, LAS float* scr, int item, int lane) {
    const int nblk = N / 32, kb = item / nblk, nb = item % nblk, k0 = 64 * kb, n0 = 32 * nb;
    float vld[32];
#pragma unroll
    for (int i = 0; i < 32; ++i) vld[i] = W[(size_t)(k0 + 2 * i + (lane >> 5)) * N + n0 + (lane & 31)];
    asm volatile("" ::: "memory");
#pragma unroll
    for (int i = 0; i < 32; ++i) scr[(2 * i + (lane >> 5)) * 33 + (lane & 31)] = vld[i];
    LDS_WAIT(); asm volatile("" ::: "memory");
    const int c = lane & 7;
#pragma unroll
    for (int j = 0; j < 4; ++j) { const int n = (lane >> 3) + 8 * j; const LAS float* s = scr + (8 * c) * 33 + n;
        v4u o; o.x = pk2(s[0 * 33], s[1 * 33]); o.y = pk2(s[2 * 33], s[3 * 33]); o.z = pk2(s[4 * 33], s[5 * 33]); o.w = pk2(s[6 * 33], s[7 * 33]);
        const int nn = n0 + n; const int row = (MAP == 0) ? (row_off + nn) : ((nn >> 7) * 256 + row_off + (nn & 127));
        *(v4u*)(WT + (size_t)row * K + k0 + 8 * c) = o; }
    LDS_WAIT(); asm volatile("" ::: "memory");
}

__device__ __forceinline__ void p_prologue(Frame& F, KArgs ka) {
    const float* c = ka->in[1]; const float* ada_w = ka->in[2]; const float* ada_b = ka->in[3];
    unsigned char* aws = ka->ws; float* mod = (float*)(aws + WS_MOD);
    LAS float* cact = (LAS float*)F.lds;
    LAS float* red = cact + 8192;
    for (int i = F.tid; i < BATCH * D; i += NT) cact[i] = siluf_(c[i]);
    __syncthreads();
    for (int chunk = F.bid; chunk < 256; chunk += F.G) {
        const int l = chunk >> 7, n0 = (chunk & 127) * 48;
        if (F.tid < 480) {
            const int kg = F.tid / 48, col = F.tid % 48;
            float acc[8];
#pragma unroll
            for (int b = 0; b < 8; ++b) acc[b] = 0.f;
            const float* wp = ada_w + (size_t)l * D * MOD_LD + n0 + col;
            for (int k = kg; k < D; k += 10) { const float w = wp[(size_t)k * MOD_LD];
#pragma unroll
                for (int b = 0; b < 8; ++b) acc[b] += cact[b * D + k] * w; }
#pragma unroll
            for (int b = 0; b < 8; ++b) red[(kg * 48 + col) * 8 + b] = acc[b];
        }
        __syncthreads();
        if (F.tid < 384) {
            const int col = F.tid >> 3, b = F.tid & 7; float s = 0.f;
#pragma unroll
            for (int kg = 0; kg < 10; ++kg) s += red[(kg * 48 + col) * 8 + b];
            mod[(size_t)(l * 8 + b) * MOD_LD + n0 + col] = s + ada_b[l * MOD_LD + n0 + col];
        }
        __syncthreads();
    }
    LAS float* scr = (LAS float*)(F.lds + F.wave * 16384);
    const int gw = F.bid * NWAVES + F.wave, NGW = F.G * NWAVES;
    constexpr int I_IN = (D / 64) * (N_IN / 32), I_BR = (512 / 64) * (D / 32), I_O = (D / 64) * (D / 32), I_L = I_IN + 3 * I_BR + I_O;
    constexpr int I_F1 = (D / 64) * (D_FF / 32), I_F2 = (D_FF / 64) * (D / 32);
    constexpr int NITEMS = 2 * I_L + 2 * I_F1 + I_F2;
    for (int it = gw; it < NITEMS; it += NGW) {
        int r = it;
        if (r < 2 * I_L) {
            const int l = r / I_L; r -= l * I_L;
            bf16* base = (bf16*)(aws + WS_WMIX + (size_t)l * WMIX_STRIDE);
            if (r < I_IN) { transpose_item<0>(ka->in[6] + (size_t)l * D * N_IN, D, N_IN, base, 0, scr, r, F.lane); continue; } r -= I_IN;
            if (r < I_BR) { transpose_item<0>(ka->in[13] + (size_t)l * 512 * D, 512, D, base + (size_t)N_IN * D, 0, scr, r, F.lane); continue; } r -= I_BR;
            if (r < I_BR) { transpose_item<0>(ka->in[14] + (size_t)l * 512 * D, 512, D, base + (size_t)N_IN * D + 512 * 1024, 0, scr, r, F.lane); continue; } r -= I_BR;
            if (r < I_BR) { transpose_item<0>(ka->in[15] + (size_t)l * 512 * D, 512, D, base + (size_t)N_IN * D + 2 * 512 * 1024, 0, scr, r, F.lane); continue; } r -= I_BR;
            transpose_item<0>(ka->in[16] + (size_t)l * D * D, D, D, base + (size_t)N_IN * D + 3 * 512 * 1024, 0, scr, r, F.lane); continue;
        }
        r -= 2 * I_L;
        if (r < I_F1) { transpose_item<1>(ka->in[17], D, D_FF, (bf16*)(aws + WS_W13), 0, scr, r, F.lane); continue; } r -= I_F1;
        if (r < I_F1) { transpose_item<1>(ka->in[18], D, D_FF, (bf16*)(aws + WS_W13), 128, scr, r, F.lane); continue; } r -= I_F1;
        transpose_item<0>(ka->in[19], D_FF, D, (bf16*)(aws + WS_W2), 0, scr, r, F.lane);
    }
}
__device__ __forceinline__ void p_moe_weights(Frame& F, KArgs ka) {
    unsigned char* aws = ka->ws;
    LAS float* scr = (LAS float*)(F.lds + F.wave * 16384);
    const int gw = F.bid * NWAVES + F.wave, NGW = F.G * NWAVES;
    constexpr int I_F1 = (D / 64) * (D_FF / 32), I_F2 = (D_FF / 64) * (D / 32), I_E = 2 * I_F1 + I_F2;
    for (int it = gw; it < NE * I_E; it += NGW) {
        const int e = it / I_E; int r = it - e * I_E;
        bf16* w13 = (bf16*)(aws + WS_WM13) + (size_t)e * N13 * D; bf16* w2 = (bf16*)(aws + WS_WM2) + (size_t)e * D * D_FF;
        if (r < I_F1) { transpose_item<1>(ka->in[22] + (size_t)e * D * D_FF, D, D_FF, w13, 0, scr, r, F.lane); continue; } r -= I_F1;
        if (r < I_F1) { transpose_item<1>(ka->in[23] + (size_t)e * D * D_FF, D, D_FF, w13, 128, scr, r, F.lane); continue; } r -= I_F1;
        transpose_item<0>(ka->in[24] + (size_t)e * D_FF * D, D_FF, D, w2, 0, scr, r, F.lane);
    }
}

__device__ __forceinline__ void norm_row(const float* xrow, const float* w, const float* sc, const float* sh, int lane, f32x4 (&o)[4]) {
    const f32x4* xr = (const f32x4*)xrow + lane;
    f32x4 v[4]; float s = 0.f;
#pragma unroll
    for (int j = 0; j < 4; ++j) { v[j] = xr[64 * j]; s += (v[j].x * v[j].x + v[j].y * v[j].y) + (v[j].z * v[j].z + v[j].w * v[j].w); }
    const float rstd = 1.0f / sqrtf(wave_sum(s) * (1.0f / D) + EPS);
#pragma unroll
    for (int j = 0; j < 4; ++j) { const f32x4 wv = ((const f32x4*)w)[lane + 64 * j], scv = ((const f32x4*)sc)[lane + 64 * j], shv = ((const f32x4*)sh)[lane + 64 * j];
        o[j] = v[j] * rstd * wv * (scv + 1.0f) + shv; }
}
__device__ __forceinline__ void store_row_bf16(bf16* orow, int lane, const f32x4 (&o)[4]) {
    unsigned long long* o8 = (unsigned long long*)orow + lane;
#pragma unroll
    for (int j = 0; j < 4; ++j) o8[64 * j] = (unsigned long long)pk2(o[j].x, o[j].y) | ((unsigned long long)pk2(o[j].z, o[j].w) << 32);
}
__device__ __forceinline__ void p_norm(Frame& F, const float* xin, const float* w, const float* mod_l, int sc_off, int sh_off, bf16* hout) {
    const int gw = F.bid * NWAVES + F.wave, NGW = F.G * NWAVES;
    for (int row = gw; row < M; row += NGW) {
        const float* mb = mod_l + (size_t)(row >> 12) * MOD_LD;
        f32x4 o[4]; norm_row(xin + (size_t)row * D, w, mb + sc_off, mb + sh_off, F.lane, o);
        store_row_bf16(hout + (size_t)row * D, F.lane, o);
    }
}

__device__ __forceinline__ void p_conv(Frame& F, const bf16* P1, const float* conv_w, bf16* ya) {
    const int gt = F.bid * NT + F.tid, NGT = F.G * NT;
    for (int it = gt; it < M * 64; it += NGT) {
        const int row = it >> 6, c8 = (it & 63) * 8, pos = row & (SEQ - 1);
        const bf16* p = P1 + (size_t)row * N_BCA + c8;
        float ab[8], ac[8], ah[8], z1[8], z2[8], y[8];
        unpack8(*(const v4u*)p, ab); unpack8(*(const v4u*)(p + 512), ac); unpack8(*(const v4u*)(p + 1024), ah);
#pragma unroll
        for (int i = 0; i < 8; ++i) { z1[i] = 0.f; z2[i] = 0.f; }
        if (pos >= 1) { float c1[8], h1[8]; unpack8(*(const v4u*)(p - N_BCA + 512), c1); unpack8(*(const v4u*)(p - N_BCA + 1024), h1);
#pragma unroll
            for (int i = 0; i < 8; ++i) z1[i] = c1[i] * h1[i]; }
        if (pos >= 2) { float c2[8], h2[8]; unpack8(*(const v4u*)(p - 2 * N_BCA + 512), c2); unpack8(*(const v4u*)(p - 2 * N_BCA + 1024), h2);
#pragma unroll
            for (int i = 0; i < 8; ++i) z2[i] = c2[i] * h2[i]; }
#pragma unroll
        for (int i = 0; i < 8; ++i) y[i] = ab[i] * (conv_w[c8 + i] * (ac[i] * ah[i]) + conv_w[512 + c8 + i] * z1[i] + conv_w[1024 + c8 + i] * z2[i]);
        *(v4u*)(ya + (size_t)row * 512 + c8) = pack8(y);
    }
}

typedef short v4i16_t __attribute__((ext_vector_type(4)));
typedef short bf16x8_t __attribute__((ext_vector_type(8)));
typedef unsigned v2u __attribute__((ext_vector_type(2)));
constexpr int HRS = 272;
constexpr int TRS = 80;
constexpr int H_RAWQ = 0, H_RAWF = 8704, H_V = 17408, H_QHT = 26112, H_KTT = 36352, H_KHT = 46592, H_DL = 56832, H_OB = 57344, H_OBS = 132;
constexpr int HSEG = 512, HNSEG = SEQ / HSEG, HCH = 32;
__device__ __forceinline__ v4i16_t tr_read(LAS unsigned char* p) { return __builtin_amdgcn_ds_read_tr16_b64_v4i16((LAS v4i16_t*)p); }
__device__ __forceinline__ bf16x8_t cat4(v4i16_t lo, v4i16_t hi) { return __builtin_shufflevector(lo, hi, 0, 1, 2, 3, 4, 5, 6, 7); }
__device__ __forceinline__ bf16x8_t pack_acc(const f32x4 a, const f32x4 b) { v4u w; w.x = pk2(a[0], a[1]); w.y = pk2(a[2], a[3]); w.z = pk2(b[0], b[1]); w.w = pk2(b[2], b[3]); return __builtin_bit_cast(bf16x8_t, w); }
__device__ __forceinline__ float bfs(short x) { return __uint_as_float((unsigned)(unsigned short)x << 16); }
template <int PASS>
__device__ __forceinline__ void p_hgrn(Frame& F, const bf16* P1, const float* lb_logits, int layer, const float* norm_w, bf16* yb, float* ust, float* dst) {
    LAS unsigned char* L = F.lds;
    const int lane = F.lane, w = F.wave, g = lane >> 4, n = lane & 15, q_ = n >> 2, p_ = n & 3;
    const int pt = F.tid >> 4, pc8 = (F.tid & 15) * 8;
    for (int u = F.bid; u < BATCH * H_B * HNSEG; u += F.G) {
        const int seg = u & (HNSEG - 1), bh = u / HNSEG, b = bh >> 2, h = bh & 3;
        const int d = 16 * w + n;
        float lb; { const int ch = h * 128 + d; const float l0 = lb_logits[ch], l1 = lb_logits[512 + ch]; const float mx = fmaxf(l0, l1);
            const float e0 = expf(l0 - mx), e1 = expf(l1 - mx); const float p0 = e0 / (e0 + e1), p1 = e1 / (e0 + e1);
            const float lbx = (layer == 0) ? (p0 - p0) : ((p0 + p1) - p0); lb = fminf(fmaxf(lbx, 0.f), 1.f); }
        const float lbf = fmaxf(lb, 1e-30f), oml = 1.0f - lb;
        f32x4 S[8];
#pragma unroll
        for (int kt = 0; kt < 8; ++kt) S[kt] = (f32x4){0.f, 0.f, 0.f, 0.f};
        if (PASS == 2) {
            for (int j = 0; j < seg; ++j) { const int uj = u - seg + j;
#pragma unroll
                for (int kt = 0; kt < 8; ++kt) { const f32x4 dj = *(const f32x4*)(dst + (size_t)uj * 128 + 16 * kt + 4 * g); const f32x4 uu = *(const f32x4*)(ust + ((((size_t)uj * 8 + w) * 8 + kt) * 64 + lane) * 4);
                    S[kt] = dj * S[kt] + uu; } }
        }
        float nw8[8];
        if (PASS == 2) {
#pragma unroll
            for (int i = 0; i < 8; ++i) nw8[i] = norm_w[h * 128 + pc8 + i]; }
        float dprod = 1.0f;
        const bf16* gp = P1 + ((size_t)b * SEQ + (size_t)seg * HSEG + pt) * N_BCA + 1536 + h * 128 + pc8;
        v4u rq, rf, rv, rg;
        rf = *(const v4u*)(gp + 512); rv = *(const v4u*)(gp + 1024);
        if (PASS == 2) { rq = *(const v4u*)gp; rg = *(const v4u*)(gp + 1536); }
        for (int c = 0; c < HSEG / HCH; ++c) {
            *(LAS v4u*)(L + H_RAWF + pt * HRS + pc8 * 2) = rf; *(LAS v4u*)(L + H_V + pt * HRS + pc8 * 2) = rv;
            if (PASS == 2) *(LAS v4u*)(L + H_RAWQ + pt * HRS + pc8 * 2) = rq;
            v4u cg; if (PASS == 2) cg = rg;
            __syncthreads();
            if (c + 1 < HSEG / HCH) { const bf16* np = gp + (size_t)(c + 1) * HCH * N_BCA; rf = *(const v4u*)(np + 512); rv = *(const v4u*)(np + 1024);
                if (PASS == 2) { rq = *(const v4u*)np; rg = *(const v4u*)(np + 1536); } }
            { const bf16x8_t f8 = cat4(tr_read(L + H_RAWF + (8 * g + q_) * HRS + 32 * w + 8 * p_), tr_read(L + H_RAWF + (8 * g + 4 + q_) * HRS + 32 * w + 8 * p_));
              float eb[8], kk[8]; float cp = 1.0f;
#pragma unroll
              for (int i = 0; i < 8; ++i) { const float sg = __builtin_amdgcn_rcpf(1.0f + __expf(-bfs(f8[i]))); const float f = lbf + oml * sg; kk[i] = oml * (1.0f - sg); cp *= f; eb[i] = cp; }
              const float s1 = __shfl(cp, n), s2 = __shfl(cp, 16 + n), s3 = __shfl(cp, 32 + n), s4 = __shfl(cp, 48 + n);
              const float pre = (g > 0 ? s1 : 1.0f) * (g > 1 ? s2 : 1.0f) * (g > 2 ? s3 : 1.0f);
              const float elast = ((s1 * s2) * s3) * s4;
              float kh[8], kt8[8];
#pragma unroll
              for (int i = 0; i < 8; ++i) { eb[i] *= pre; const float en = __builtin_amdgcn_rcpf(fmaxf(eb[i], 1e-30f)); kt8[i] = kk[i] * en; kh[i] = kt8[i] * elast; }
              *(LAS v4u*)(L + H_KHT + d * TRS + 16 * g) = pack8(kh);
              if (PASS == 2) { const bf16x8_t q8 = cat4(tr_read(L + H_RAWQ + (8 * g + q_) * HRS + 32 * w + 8 * p_), tr_read(L + H_RAWQ + (8 * g + 4 + q_) * HRS + 32 * w + 8 * p_));
                  float qh[8];
#pragma unroll
                  for (int i = 0; i < 8; ++i) qh[i] = siluf_(bfs(q8[i])) * eb[i];
                  *(LAS v4u*)(L + H_QHT + d * TRS + 16 * g) = pack8(qh); *(LAS v4u*)(L + H_KTT + d * TRS + 16 * g) = pack8(kt8); }
              if (g == 0) *(LAS float*)(L + H_DL + 4 * d) = elast;
              dprod *= elast; }
            __syncthreads();
            const bf16x8_t bVn = cat4(tr_read(L + H_V + (8 * g + q_) * HRS + 32 * w + 8 * p_), tr_read(L + H_V + (8 * g + 4 + q_) * HRS + 32 * w + 8 * p_));
            if (PASS == 2) {
                const bf16x8_t bVp = cat4(tr_read(L + H_V + (4 * g + q_) * HRS + 32 * w + 8 * p_), tr_read(L + H_V + (16 + 4 * g + q_) * HRS + 32 * w + 8 * p_));
                f32x4 o[2], pt00 = {0.f, 0.f, 0.f, 0.f}, pt01 = {0.f, 0.f, 0.f, 0.f}, pt11 = {0.f, 0.f, 0.f, 0.f};
                o[0] = (f32x4){0.f, 0.f, 0.f, 0.f}; o[1] = (f32x4){0.f, 0.f, 0.f, 0.f};
#pragma unroll
                for (int ks = 0; ks < 4; ++ks) {
                    const bf16x8_t sb = pack_acc(S[2 * ks], S[2 * ks + 1]);
#pragma unroll
                    for (int tm = 0; tm < 2; ++tm) {
                        const bf16x8_t aq = cat4(tr_read(L + H_QHT + (32 * ks + 4 * g + q_) * TRS + 32 * tm + 8 * p_), tr_read(L + H_QHT + (32 * ks + 16 + 4 * g + q_) * TRS + 32 * tm + 8 * p_));
                        o[tm] = __builtin_amdgcn_mfma_f32_16x16x32_bf16(aq, sb, o[tm], 0, 0, 0); }
                    const bf16x8_t aK0 = cat4(tr_read(L + H_KTT + (32 * ks + 8 * g + q_) * TRS + 8 * p_), tr_read(L + H_KTT + (32 * ks + 8 * g + 4 + q_) * TRS + 8 * p_));
                    const bf16x8_t aK1 = cat4(tr_read(L + H_KTT + (32 * ks + 8 * g + q_) * TRS + 32 + 8 * p_), tr_read(L + H_KTT + (32 * ks + 8 * g + 4 + q_) * TRS + 32 + 8 * p_));
                    const bf16x8_t bQ0 = cat4(tr_read(L + H_QHT + (32 * ks + 8 * g + q_) * TRS + 8 * p_), tr_read(L + H_QHT + (32 * ks + 8 * g + 4 + q_) * TRS + 8 * p_));
                    const bf16x8_t bQ1 = cat4(tr_read(L + H_QHT + (32 * ks + 8 * g + q_) * TRS + 32 + 8 * p_), tr_read(L + H_QHT + (32 * ks + 8 * g + 4 + q_) * TRS + 32 + 8 * p_));
                    pt00 = __builtin_amdgcn_mfma_f32_16x16x32_bf16(aK0, bQ0, pt00, 0, 0, 0);
                    pt01 = __builtin_amdgcn_mfma_f32_16x16x32_bf16(aK0, bQ1, pt01, 0, 0, 0);
                    pt11 = __builtin_amdgcn_mfma_f32_16x16x32_bf16(aK1, bQ1, pt11, 0, 0, 0);
                }
#pragma unroll
                for (int j = 0; j < 4; ++j) if (4 * g + j > n) { pt00[j] = 0.f; pt11[j] = 0.f; }
                const f32x4 z4 = {0.f, 0.f, 0.f, 0.f};
                o[0] = __builtin_amdgcn_mfma_f32_16x16x32_bf16(pack_acc(pt00, z4), bVp, o[0], 0, 0, 0);
                o[1] = __builtin_amdgcn_mfma_f32_16x16x32_bf16(pack_acc(pt01, pt11), bVp, o[1], 0, 0, 0);
#pragma unroll
                for (int tm = 0; tm < 2; ++tm)
#pragma unroll
                    for (int j = 0; j < 4; ++j) *(LAS float*)(L + H_OB + ((16 * tm + 4 * g + j) * H_OBS + 16 * w + n) * 4) = o[tm][j];
            }
#pragma unroll
            for (int kt = 0; kt < 8; ++kt) { const f32x4 dl4 = *(const LAS f32x4*)(L + H_DL + (16 * kt + 4 * g) * 4);
                const bf16x8_t aKh = *(const LAS bf16x8_t*)(L + H_KHT + (16 * kt + n) * TRS + 16 * g);
                S[kt] = __builtin_amdgcn_mfma_f32_16x16x32_bf16(aKh, bVn, S[kt] * dl4, 0, 0, 0); }
            __syncthreads();
            if (PASS == 2) {
                const f32x4 o0 = *(const LAS f32x4*)(L + H_OB + (pt * H_OBS + pc8) * 4), o1 = *(const LAS f32x4*)(L + H_OB + (pt * H_OBS + pc8 + 4) * 4);
                const float o8[8] = {o0.x, o0.y, o0.z, o0.w, o1.x, o1.y, o1.z, o1.w};
                float ss = 0.f;
#pragma unroll
                for (int i = 0; i < 8; ++i) ss += o8[i] * o8[i];
                ss += __shfl_xor(ss, 1); ss += __shfl_xor(ss, 2); ss += __shfl_xor(ss, 4); ss += __shfl_xor(ss, 8);
                const float rs = 1.0f / sqrtf(ss * (1.0f / 128.0f) + EPS);
                float g8[8], y[8]; unpack8(cg, g8);
#pragma unroll
                for (int i = 0; i < 8; ++i) y[i] = o8[i] * rs * nw8[i] * siluf_(g8[i]);
                *(v4u*)(yb + ((size_t)b * SEQ + (size_t)seg * HSEG + (size_t)c * HCH + pt) * 512 + h * 128 + pc8) = pack8(y);
            }
        }
        if (PASS == 1) {
#pragma unroll
            for (int kt = 0; kt < 8; ++kt) *(f32x4*)(ust + ((((size_t)u * 8 + w) * 8 + kt) * 64 + lane) * 4) = S[kt];
            if (g == 0) dst[(size_t)u * 128 + d] = dprod;
        }
        __syncthreads();
    }
}

constexpr int SG_V = 0, SG_OB = 34816, SG_OBS = 132, SG_RS = SG_OB + 128 * SG_OBS * 4;
__device__ __forceinline__ void p_sgu(Frame& F, const bf16* P1, const float* norm_w, const float* sgu_w, const float* sgu_b, bf16* yc) {
    LAS unsigned char* L = F.lds;
    const int lane = F.lane, w = F.wave, gq = lane >> 4, n = lane & 15, q_ = n >> 2, p_ = n & 3;
    const int sr = F.tid >> 4, c8 = (F.tid & 15) * 8;
    for (int u = F.bid; u < M / 128; u += F.G) {
        const size_t row0 = (size_t)u * 128;
        v4u rv[4][4]; float ssj[4] = {0.f, 0.f, 0.f, 0.f};
#pragma unroll
        for (int g = 0; g < 4; ++g)
#pragma unroll
            for (int j = 0; j < 4; ++j) { rv[g][j] = *(const v4u*)(P1 + (row0 + sr + 32 * j) * N_BCA + 4096 + g * 128 + c8); float f[8]; unpack8(rv[g][j], f);
#pragma unroll
                for (int i = 0; i < 8; ++i) ssj[j] += f[i] * f[i]; }
#pragma unroll
        for (int j = 0; j < 4; ++j) { float ss = ssj[j]; ss += __shfl_xor(ss, 1); ss += __shfl_xor(ss, 2); ss += __shfl_xor(ss, 4); ss += __shfl_xor(ss, 8);
            if (n == 0) *(LAS float*)(L + SG_RS + 4 * (sr + 32 * j)) = 1.0f / sqrtf(ss * (1.0f / 512.0f) + EPS); }
#pragma unroll
        for (int g = 0; g < 4; ++g) {
#pragma unroll
            for (int j = 0; j < 4; ++j) *(LAS v4u*)(L + SG_V + (sr + 32 * j) * HRS + c8 * 2) = rv[g][j];
            __syncthreads();
            const int kmax = w >> 1, t = 16 * w + n;
            bf16x8_t aW[4];
#pragma unroll
            for (int ks = 0; ks < 4; ++ks) { if (ks <= kmax) { const int s0 = 32 * ks + 8 * gq; const float* wp = sgu_w + ((size_t)g * 128 + t) * 128 + s0;
                    const f32x4 w0 = *(const f32x4*)wp, w1 = *(const f32x4*)(wp + 4); const f32x4 r0 = *(const LAS f32x4*)(L + SG_RS + 4 * s0), r1 = *(const LAS f32x4*)(L + SG_RS + 4 * (s0 + 4));
                    float a8[8] = {w0.x * r0.x, w0.y * r0.y, w0.z * r0.z, w0.w * r0.w, w1.x * r1.x, w1.y * r1.y, w1.z * r1.z, w1.w * r1.w};
#pragma unroll
                    for (int i = 0; i < 8; ++i) if (s0 + i > t) a8[i] = 0.f;
                    aW[ks] = __builtin_bit_cast(bf16x8_t, pack8(a8)); } else aW[ks] = (bf16x8_t){0, 0, 0, 0, 0, 0, 0, 0}; }
            f32x4 acc[8];
#pragma unroll
            for (int ct = 0; ct < 8; ++ct) acc[ct] = (f32x4){0.f, 0.f, 0.f, 0.f};
#pragma unroll
            for (int ks = 0; ks < 4; ++ks) { if (ks <= kmax) {
#pragma unroll
                for (int ct = 0; ct < 8; ++ct) { const bf16x8_t bV = cat4(tr_read(L + SG_V + (32 * ks + 8 * gq + q_) * HRS + 32 * ct + 8 * p_), tr_read(L + SG_V + (32 * ks + 8 * gq + 4 + q_) * HRS + 32 * ct + 8 * p_));
                    acc[ct] = __builtin_amdgcn_mfma_f32_16x16x32_bf16(aW[ks], bV, acc[ct], 0, 0, 0); } } }
#pragma unroll
            for (int ct = 0; ct < 8; ++ct) { const float nw = norm_w[g * 128 + 16 * ct + n];
#pragma unroll
                for (int j = 0; j < 4; ++j) *(LAS float*)(L + SG_OB + ((16 * w + 4 * gq + j) * SG_OBS + 16 * ct + n) * 4) = acc[ct][j] * nw; }
            __syncthreads();
#pragma unroll
            for (int j = 0; j < 4; ++j) { const int tt = sr + 32 * j; const float bias = sgu_b[g * 128 + tt];
                const f32x4 o0 = *(const LAS f32x4*)(L + SG_OB + (tt * SG_OBS + c8) * 4), o1 = *(const LAS f32x4*)(L + SG_OB + (tt * SG_OBS + c8 + 4) * 4);
                float uu[8], y[8]; unpack8(*(const v4u*)(P1 + (row0 + tt) * N_BCA + 3584 + g * 128 + c8), uu);
                y[0] = (o0.x + bias) * uu[0]; y[1] = (o0.y + bias) * uu[1]; y[2] = (o0.z + bias) * uu[2]; y[3] = (o0.w + bias) * uu[3];
                y[4] = (o1.x + bias) * uu[4]; y[5] = (o1.y + bias) * uu[5]; y[6] = (o1.z + bias) * uu[6]; y[7] = (o1.w + bias) * uu[7];
                *(v4u*)(yc + (row0 + tt) * 512 + g * 128 + c8) = pack8(y); }
        }
        __syncthreads();
    }
}

__device__ __forceinline__ void p_norm_router(Frame& F, KArgs ka, const float* x, const float* w, const float* mod_l, bf16* h2) {
    const float* rw = ka->in[20]; const float* rb = ka->in[21]; unsigned* ctl = (unsigned*)(ka->ws + WS_CTL);
    float* topp = (float*)(ka->ws + WS_TOPP); int* list = (int*)(ka->ws + WS_LIST);
    LAS float* RWt = (LAS float*)F.lds;
    LAS int* lcnt = (LAS int*)(RWt + 8192);
    LAS int* lbase = lcnt + 16;
    LAS int* sel = lbase + 16;
    LAS int* rnk = sel + 128;
    for (int i = F.tid; i < D * NE; i += NT) { const int k = i >> 3, e = i & 7; RWt[e * D + k] = rw[i]; }
    __syncthreads();
    for (int batch = F.bid; batch < M / 128; batch += F.G) {
        const int row0 = batch * 128;
        if (F.tid < 16) lcnt[F.tid] = 0;
        __syncthreads();
        for (int rr = 0; rr < 16; ++rr) {
            const int r = F.wave * 16 + rr, row = row0 + r;
            const float* mb = mod_l + (size_t)(row >> 12) * MOD_LD;
            f32x4 o[4]; norm_row(x + (size_t)row * D, w, mb + 4 * D, mb + 3 * D, F.lane, o);
            store_row_bf16(h2 + (size_t)row * D, F.lane, o);
            float lg[8];
#pragma unroll
            for (int e = 0; e < 8; ++e) { float s = 0.f;
#pragma unroll
                for (int j = 0; j < 4; ++j) { const f32x4 r4 = *(const LAS f32x4*)(RWt + e * D + 4 * F.lane + 256 * j); s += (o[j].x * r4.x + o[j].y * r4.y) + (o[j].z * r4.z + o[j].w * r4.w); }
                lg[e] = wave_sum(s) + rb[e]; }
            int i0 = 0; float v0 = lg[0];
#pragma unroll
            for (int e = 1; e < 8; ++e) if (lg[e] > v0) { v0 = lg[e]; i0 = e; }
            int i1 = -1; float v1 = -3.0e38f;
#pragma unroll
            for (int e = 0; e < 8; ++e) if (e != i0 && lg[e] > v1) { v1 = lg[e]; i1 = e; }
            if (F.lane == 0) {
                const float p0 = 1.0f / (1.0f + expf(v1 - v0));
                topp[(size_t)row * 2] = p0; topp[(size_t)row * 2 + 1] = 1.0f - p0;
                const int rk0 = __hip_atomic_fetch_add(lcnt + i0, 1, __ATOMIC_RELAXED, __HIP_MEMORY_SCOPE_WORKGROUP), rk1 = __hip_atomic_fetch_add(lcnt + 8 + i1, 1, __ATOMIC_RELAXED, __HIP_MEMORY_SCOPE_WORKGROUP);
                sel[r] = i0 | (i1 << 8); rnk[r] = rk0 | (rk1 << 16);
            }
        }
        __syncthreads();
        if (F.tid < 16) lbase[F.tid] = (int)__hip_atomic_fetch_add(ctl + CW_CNT + 64 * F.tid, (unsigned)lcnt[F.tid], __ATOMIC_RELAXED, __HIP_MEMORY_SCOPE_AGENT);
        __syncthreads();
        if (F.tid < 128) { const int sv = sel[F.tid], rv = rnk[F.tid]; const int e0 = sv & 255, e1 = sv >> 8;
            list[(size_t)e0 * LIST_CAP + lbase[e0] + (rv & 0xffff)] = row0 + F.tid;
            list[(size_t)(8 + e1) * LIST_CAP + lbase[8 + e1] + (rv >> 16)] = row0 + F.tid; }
        __syncthreads();
    }
}
__device__ __forceinline__ void moe_tables(Frame& F, unsigned* ctl, int pass) {
    LAS int* tab = (LAS int*)(F.lds + TAB_OFF);
    __syncthreads();
    if (F.tid == 0) { int pb = 0;
        for (int e = 0; e < 8; ++e) { int c = (int)__hip_atomic_load(ctl + CW_CNT + 64 * (pass * 8 + e), __ATOMIC_RELAXED, __HIP_MEMORY_SCOPE_AGENT); if (c > LIST_CAP) c = LIST_CAP; if (c < 0) c = 0;
            const int np = (c + 255) >> 8; tab[e] = c; tab[8 + e] = pb; for (int p = 0; p < np; ++p) tab[32 + pb + p] = e; pb += np; }
        tab[16] = pb; }
    __syncthreads();
}
template <bool GATHER_>
struct MoeOrder {
    static constexpr bool GATHER = GATHER_;
    pg8::StaticOrder so; const LAS int* tab; const int* list; int npn; unsigned rowbytes;
    __device__ __forceinline__ bool next(int i, pg8::Unit& u) const { if (!so.next(i, u)) return false; u.pb = tab[32 + u.pm] * npn + u.pn; return true; }
    __device__ __forceinline__ int tok_of(int pm, int r) const { const int e = tab[32 + pm]; const int idx = (pm - tab[8 + e]) * 256 + r; return idx < tab[e] ? list[(size_t)e * LIST_CAP + idx] : -1; }
    __device__ __forceinline__ unsigned a_row_off(const pg8::Unit& u, int r) const { const int t = tok_of(u.pm, r); return (unsigned)(t < 0 ? 0 : t) * rowbytes; }
};

struct EpiBranch {
    static constexpr bool PERM = true;
    const bf16* gate; bf16* mrg; int first;
    __device__ __forceinline__ void operator()(const pg8::f32x4 (&acc)[2][2][4][2], const pg8::Unit& u, int wr, int wc, int fr, int fq) const {
        const int row0 = u.pm * 256 + wr * 64 + fr, col0 = u.pn * 256 + wc * 32 + 8 * fq;
#pragma unroll
        for (int ai = 0; ai < 2; ++ai) {
            v4u gl[4][2], ml[4][2];
#pragma unroll
            for (int m = 0; m < 4; ++m)
#pragma unroll
                for (int bj = 0; bj < 2; ++bj) { const size_t row = (size_t)(row0 + ai * 128 + m * 16); const int col = col0 + bj * 128;
                    gl[m][bj] = *(const v4u*)(gate + row * N_G + col); ml[m][bj] = first ? (v4u){0u, 0u, 0u, 0u} : *(const v4u*)(mrg + row * D + col); }
            asm volatile("" ::: "memory");
#pragma unroll
            for (int m = 0; m < 4; ++m)
#pragma unroll
                for (int bj = 0; bj < 2; ++bj) { const size_t row = (size_t)(row0 + ai * 128 + m * 16); const int col = col0 + bj * 128;
                    float gg[8], mm[8], o[8]; unpack8(gl[m][bj], gg); unpack8(ml[m][bj], mm);
                    const pg8::f32x4 v0 = acc[ai][bj][m][0], v1 = acc[ai][bj][m][1];
                    o[0] = mm[0] + sigmoidf_(gg[0]) * v0[0]; o[1] = mm[1] + sigmoidf_(gg[1]) * v0[1]; o[2] = mm[2] + sigmoidf_(gg[2]) * v0[2]; o[3] = mm[3] + sigmoidf_(gg[3]) * v0[3];
                    o[4] = mm[4] + sigmoidf_(gg[4]) * v1[0]; o[5] = mm[5] + sigmoidf_(gg[5]) * v1[1]; o[6] = mm[6] + sigmoidf_(gg[6]) * v1[2]; o[7] = mm[7] + sigmoidf_(gg[7]) * v1[3];
                    *(v4u*)(mrg + row * D + col) = pack8(o); }
            asm volatile("" ::: "memory");
        }
    }
};
struct EpiResid {
    static constexpr bool PERM = false;
    const float* xin; float* xout; const float* gmod;
    __device__ __forceinline__ void operator()(const pg8::f32x4 (&acc)[2][2][4][2], const pg8::Unit& u, int wr, int wc, int fr, int fq) const {
        const int row0 = u.pm * 256 + wr * 64 + fr, col0 = u.pn * 256 + wc * 32 + 4 * fq;
        const float* gb = gmod + (size_t)((u.pm * 256) >> 12) * MOD_LD + col0;
        pg8::f32x4 gv[2][2];
#pragma unroll
        for (int bj = 0; bj < 2; ++bj)
#pragma unroll
            for (int n = 0; n < 2; ++n) gv[bj][n] = *(const pg8::f32x4*)(gb + bj * 128 + n * 16);
#pragma unroll
        for (int am = 0; am < 4; ++am) {
            const int ai = am >> 1, mb = (am & 1) * 2;
            pg8::f32x4 xl[2][2][2];
#pragma unroll
            for (int m = 0; m < 2; ++m)
#pragma unroll
                for (int bj = 0; bj < 2; ++bj)
#pragma unroll
                    for (int n = 0; n < 2; ++n) xl[m][bj][n] = *(const pg8::f32x4*)(xin + (size_t)(row0 + ai * 128 + (mb + m) * 16) * D + col0 + bj * 128 + n * 16);
            asm volatile("" ::: "memory");
#pragma unroll
            for (int m = 0; m < 2; ++m)
#pragma unroll
                for (int bj = 0; bj < 2; ++bj)
#pragma unroll
                    for (int n = 0; n < 2; ++n) *(pg8::f32x4*)(xout + (size_t)(row0 + ai * 128 + (mb + m) * 16) * D + col0 + bj * 128 + n * 16) = xl[m][bj][n] + gv[bj][n] * acc[ai][bj][mb + m][n];
            asm volatile("" ::: "memory");
        }
    }
};
struct EpiSwiglu {
    static constexpr bool PERM = true;
    bf16* act;
    __device__ __forceinline__ void operator()(const pg8::f32x4 (&acc)[2][2][4][2], const pg8::Unit& u, int wr, int wc, int fr, int fq) const {
        const int row0 = u.pm * 256 + wr * 64 + fr, col0 = u.pn * 128 + wc * 32 + 8 * fq;
#pragma unroll
        for (int ai = 0; ai < 2; ++ai)
#pragma unroll
            for (int m = 0; m < 4; ++m) { float o[8];
#pragma unroll
                for (int n = 0; n < 2; ++n)
#pragma unroll
                    for (int i = 0; i < 4; ++i) o[n * 4 + i] = siluf_(acc[ai][0][m][n][i]) * acc[ai][1][m][n][i];
                *(v4u*)(act + (size_t)(row0 + ai * 128 + m * 16) * D_FF + col0) = pack8(o); }
    }
};
struct EpiMoeDown {
    static constexpr bool PERM = false;
    float* x; const float* gmod; const float* topp; int pass; const LAS int* tab; const int* list;
    __device__ __forceinline__ int tok_of(int pm, int r) const { const int e = tab[32 + pm]; const int idx = (pm - tab[8 + e]) * 256 + r; return idx < tab[e] ? list[(size_t)e * LIST_CAP + idx] : -1; }
    __device__ __forceinline__ void operator()(const pg8::f32x4 (&acc)[2][2][4][2], const pg8::Unit& u, int wr, int wc, int fr, int fq) const {
        const int col0 = u.pn * 256 + wc * 32 + 4 * fq;
#pragma unroll
        for (int am = 0; am < 4; ++am) {
            const int ai = am >> 1, mb = (am & 1) * 2;
            pg8::f32x4 xl[2][2][2]; float pv[2]; int tok[2];
#pragma unroll
            for (int m = 0; m < 2; ++m) { tok[m] = tok_of(u.pm, ai * 128 + wr * 64 + (mb + m) * 16 + fr); const int t = tok[m] < 0 ? 0 : tok[m]; pv[m] = topp[(size_t)t * 2 + pass];
#pragma unroll
                for (int bj = 0; bj < 2; ++bj)
#pragma unroll
                    for (int n = 0; n < 2; ++n) xl[m][bj][n] = *(const pg8::f32x4*)(x + (size_t)t * D + col0 + bj * 128 + n * 16); }
            asm volatile("" ::: "memory");
#pragma unroll
            for (int m = 0; m < 2; ++m) { if (tok[m] >= 0) { const int t = tok[m]; const float* gb = gmod + (size_t)(t >> 12) * MOD_LD + col0;
#pragma unroll
                for (int bj = 0; bj < 2; ++bj)
#pragma unroll
                    for (int n = 0; n < 2; ++n) { const pg8::f32x4 gv = *(const pg8::f32x4*)(gb + bj * 128 + n * 16);
                        *(pg8::f32x4*)(x + (size_t)t * D + col0 + bj * 128 + n * 16) = xl[m][bj][n] + gv * pv[m] * acc[ai][bj][mb + m][n]; } } }
            asm volatile("" ::: "memory");
        }
    }
};

__device__ __forceinline__ void p_final_norm(Frame& F, float* x, const float* w) {
    const int gw = F.bid * NWAVES + F.wave, NGW = F.G * NWAVES;
    for (int row = gw; row < M; row += NGW) {
        f32x4* xr = (f32x4*)(x + (size_t)row * D) + F.lane;
        f32x4 v[4]; float s = 0.f;
#pragma unroll
        for (int j = 0; j < 4; ++j) { v[j] = xr[64 * j]; s += (v[j].x * v[j].x + v[j].y * v[j].y) + (v[j].z * v[j].z + v[j].w * v[j].w); }
        const float rstd = 1.0f / sqrtf(wave_sum(s) * (1.0f / D) + EPS);
#pragma unroll
        for (int j = 0; j < 4; ++j) xr[64 * j] = v[j] * rstd * ((const f32x4*)w)[F.lane + 64 * j];
    }
}

__device__ __forceinline__ bool fresh(Frame& F) {
    int t_ = threadIdx.x, b_ = blockIdx.x, g_ = gridDim.x; asm volatile("" : "+v"(t_), "+s"(b_), "+s"(g_));
    F.tid = t_; F.lane = t_ & 63; F.wave = __builtin_amdgcn_readfirstlane(t_ >> 6); F.bid = b_; F.G = g_; return true;
}
constexpr int NPL = 13, NPHASE = 1 + DEPTH * NPL;
__global__ void __launch_bounds__(NT, 2) fwd(Args args) {
    extern __shared__ __attribute__((aligned(16))) unsigned char lds[];
    Frame F;
    F.lds = (LAS unsigned char*)lds;
    F.tid = threadIdx.x; F.lane = F.tid & 63; F.wave = __builtin_amdgcn_readfirstlane(F.tid >> 6);
    F.G = gridDim.x; F.bid = blockIdx.x;
    volatile LAS unsigned* MISC = (volatile LAS unsigned*)(F.lds + MISC_OFF);
    if (F.tid < 32) MISC[F.tid] = 0u;
    __syncthreads();
#if MK_PER_PHASE
#define GRID_BAR() do { } while (0)
#else
    XcdBarrier bar = xcd_barrier_post((unsigned*)(KA()->ws + WS_CTL) + CW_BAR, MISC + 8);
#define GRID_BAR() xcd_barrier(bar)
#endif
    const int lo = KA()->ph_lo, hi = KA()->ph_hi;
#ifdef ONLY_REL
#define IN(k) (fresh(F) && ((k) == 0 ? 100 : ((k) - 1) % NPL) == ONLY_REL && (ONLY_L < 0 || ((k) - 1) / NPL == ONLY_L) && lo <= (k) && (k) < hi)
#else
#define IN(k) (lo <= (k) && (k) < hi && fresh(F))
#endif
#define SEAM(k) do { if ((k) + 1 < hi) GRID_BAR(); } while (0)
    PG8_LAS unsigned char* ring = (PG8_LAS unsigned char*)lds;

    if (IN(0)) {
#pragma unroll 1
        for (int rep = 0; rep < REPS(5); ++rep) { __syncthreads(); p_prologue(F, KA()); }
        SEAM(0); }

#ifdef UNROLL_L
#pragma unroll
#else
#pragma unroll 1
#endif
    for (int l = 0; l < DEPTH; ++l) {
        const int pb = 1 + l * NPL;
#define WSP(off) (ka->ws + (off))
#define MODL ((const float*)WSP(WS_MOD) + (size_t)l * BATCH * MOD_LD)
#define WMIXL ((bf16*)WSP(WS_WMIX + (size_t)l * WMIX_STRIDE))
        if (IN(pb + 0)) {
#pragma unroll 1
          for (int rep = 0; rep < REPS(7); ++rep) { KArgs ka = KA(); p_norm(F, l == 0 ? ka->in[0] : (const float*)ka->out, ka->in[4] + l * D, MODL, 1 * D, 0, (bf16*)WSP(WS_H)); }
          SEAM(pb + 0); }
        if (IN(pb + 1)) {
            KArgs ka = KA();
            pg8::Gemm g{(bf16*)WSP(WS_H), WMIXL, D, D, D}; pg8::StaticOrder S; S.init(M / 256, N_BCA / 256, F.G, F.bid);
            pg8::EpiBf16 E{(bf16*)WSP(WS_P1), N_BCA, 1.0f / (float)REPS(8)};
#pragma unroll 1
            for (int rep = 0; rep < REPS(3); ++rep)
            pg8::gemm_phase<REPS(8)>(ring, g, S, E); SEAM(pb + 1);
        }
        if (IN(pb + 2)) {
#pragma unroll 1
          for (int rep = 0; rep < REPS(1); ++rep) {
            __syncthreads();
            { KArgs ka = KA(); p_hgrn<1>(F, (const bf16*)WSP(WS_P1), ka->in[8], l, ka->in[9] + l * D_BV, (bf16*)WSP(WS_YB), (float*)WSP(WS_HU), (float*)WSP(WS_HD)); }
            __syncthreads();
            { KArgs ka = KA(); p_sgu(F, (const bf16*)WSP(WS_P1), ka->in[10] + l * D_C, ka->in[11] + (size_t)l * 4 * 128 * 128, ka->in[12] + l * 4 * 128, (bf16*)WSP(WS_YC)); }
            { KArgs ka = KA(); p_conv(F, (const bf16*)WSP(WS_P1), ka->in[7] + l * 3 * D_A, (bf16*)WSP(WS_YA)); }
          }
            SEAM(pb + 2);
        }
        if (IN(pb + 3)) {
#pragma unroll 1
          for (int rep = 0; rep < REPS(2); ++rep)
            { KArgs ka = KA(); p_hgrn<2>(F, (const bf16*)WSP(WS_P1), ka->in[8], l, ka->in[9] + l * D_BV, (bf16*)WSP(WS_YB), (float*)WSP(WS_HU), (float*)WSP(WS_HD)); }
            SEAM(pb + 3);
        }
        if (IN(pb + 4)) {
            KArgs ka = KA();
            pg8::Gemm g{(bf16*)WSP(WS_H), WMIXL + (size_t)N_BCA * D, D, D, D}; pg8::StaticOrder S; S.init(M / 256, N_G / 256, F.G, F.bid);
            pg8::EpiBf16 E{(bf16*)WSP(WS_PG), N_G, 1.0f};
            pg8::gemm_phase(ring, g, S, E); SEAM(pb + 4);
        }
        if (IN(pb + 5)) {
#pragma unroll 1
            for (int br = 0; br < 3; ++br) {
                KArgs ka = KA();
                pg8::Gemm g{(bf16*)WSP(WS_YA + (size_t)br * 32 * MiB), WMIXL + (size_t)N_IN * D + (size_t)br * 512 * 1024, 512, 512, 512}; pg8::StaticOrder S; S.init(M / 256, D / 256, F.G, F.bid);
                EpiBranch E{(const bf16*)WSP(WS_PG) + br * D, (bf16*)WSP(WS_MRG), br == 0 ? 1 : 0};
                pg8::gemm_phase(ring, g, S, E);
            }
            SEAM(pb + 5);
        }
        if (IN(pb + 6)) {
            KArgs ka = KA();
            pg8::Gemm g{(bf16*)WSP(WS_MRG), WMIXL + (size_t)N_IN * D + 3 * 512 * 1024, D, D, D}; pg8::StaticOrder S; S.init(M / 256, D / 256, F.G, F.bid);
            EpiResid E{l == 0 ? ka->in[0] : (const float*)ka->out, ka->out, MODL + 2 * D};
            pg8::gemm_phase(ring, g, S, E); SEAM(pb + 6);
        }
        if (l == 0) {
            if (IN(pb + 7)) { KArgs ka = KA(); p_norm(F, ka->out, ka->in[5] + l * D, MODL, 4 * D, 3 * D, (bf16*)WSP(WS_H)); SEAM(pb + 7); }
            if (IN(pb + 8)) {
                KArgs ka = KA();
                pg8::Gemm g{(bf16*)WSP(WS_H), (bf16*)WSP(WS_W13), D, D, D}; pg8::StaticOrder S; S.init(M / 256, N13 / 256, F.G, F.bid);
                EpiSwiglu E{(bf16*)WSP(WS_ACT)};
                pg8::gemm_phase(ring, g, S, E); SEAM(pb + 8);
            }
            if (IN(pb + 9)) {
                KArgs ka = KA();
                pg8::Gemm g{(bf16*)WSP(WS_ACT), (bf16*)WSP(WS_W2), D_FF, D_FF, D_FF}; pg8::StaticOrder S; S.init(M / 256, D / 256, F.G, F.bid);
                EpiResid E{ka->out, ka->out, MODL + 5 * D};
                pg8::gemm_phase(ring, g, S, E); SEAM(pb + 9);
            }
        } else {
            if (IN(pb + 7)) {
#pragma unroll 1
                for (int rep = 0; rep < REPS(6); ++rep) { __syncthreads(); p_moe_weights(F, KA()); }
                __syncthreads(); { KArgs ka = KA(); p_norm_router(F, ka, ka->out, ka->in[5] + l * D, MODL, (bf16*)WSP(WS_H2M)); } SEAM(pb + 7); }
#pragma unroll 1
            for (int pass = 0; pass < 2; ++pass) {
#ifndef NO_MOE_UP
                if (IN(pb + 8 + 2 * pass)) {
                    KArgs ka = KA();
                    moe_tables(F, (unsigned*)WSP(WS_CTL), pass);
                    const LAS int* tab = (const LAS int*)(F.lds + TAB_OFF);
                    MoeOrder<true> S; S.so.init(tab[16], N13 / 256, F.G, F.bid); S.tab = tab; S.list = (const int*)WSP(WS_LIST) + (size_t)pass * 8 * LIST_CAP; S.npn = N13 / 256; S.rowbytes = D * 2;
                    pg8::Gemm g{(bf16*)WSP(WS_H2M), (bf16*)WSP(WS_WM13), D, D, D};
                    EpiSwiglu E{(bf16*)WSP(WS_ACTM)};
#pragma unroll 1
                    for (int rep = 0; rep < REPS(4); ++rep)
                    pg8::gemm_phase(ring, g, S, E); SEAM(pb + 8 + 2 * pass);
                }
#endif
#ifndef NO_MOE_DOWN
                if (IN(pb + 9 + 2 * pass)) {
                    KArgs ka = KA();
                    moe_tables(F, (unsigned*)WSP(WS_CTL), pass);
                    const LAS int* tab = (const LAS int*)(F.lds + TAB_OFF);
                    MoeOrder<false> S; S.so.init(tab[16], D / 256, F.G, F.bid); S.tab = tab; S.list = (const int*)WSP(WS_LIST) + (size_t)pass * 8 * LIST_CAP; S.npn = D / 256; S.rowbytes = 0;
                    pg8::Gemm g{(bf16*)WSP(WS_ACTM), (bf16*)WSP(WS_WM2), D_FF, D_FF, D_FF};
                    EpiMoeDown E{ka->out, MODL + 5 * D, (const float*)WSP(WS_TOPP), pass, tab, S.list};
                    pg8::gemm_phase(ring, g, S, E); SEAM(pb + 9 + 2 * pass);
                }
#endif
            }
            if (IN(pb + 12)) { KArgs ka = KA(); p_final_norm(F, ka->out, ka->in[25]); }
        }
    }
#undef IN
#undef SEAM
}

extern "C" void kernel_launch(void* const* d_in, const int* in_sizes, int n_in, void* d_out, int out_size, void* d_ws, size_t ws_size, hipStream_t stream) {
    static int grid = 0;
    if (grid == 0) {
        if (n_in != 26 || in_sizes[0] != M * D || out_size != M * D || ws_size < WS_NEED) { fprintf(stderr, "kernel_launch: unexpected shapes / workspace (n_in %d, ws %zu, need %zu); nothing launched\n", n_in, ws_size, (size_t)WS_NEED); grid = -1; return; }
        int dev = 0, cus = 0, per_cu = 0;
        if (hipGetDevice(&dev) != hipSuccess || hipDeviceGetAttribute(&cus, hipDeviceAttributeMultiprocessorCount, dev) != hipSuccess) { grid = -1; return; }
        if (hipFuncSetAttribute((const void*)fwd, hipFuncAttributeMaxDynamicSharedMemorySize, LDS_BYTES) != hipSuccess) { fprintf(stderr, "kernel_launch: hipFuncSetAttribute failed\n"); grid = -1; return; }
        if (hipOccupancyMaxActiveBlocksPerMultiprocessor(&per_cu, (const void*)fwd, NT, LDS_BYTES) != hipSuccess || per_cu < 1) fprintf(stderr, "kernel_launch: occupancy query reports %d\n", per_cu);
        (void)hipGetLastError();
        grid = cus;
    }
    if (grid < 0) return;
    if (hipMemsetAsync((char*)d_ws + WS_CTL, 0, CTL_ZERO_BYTES, stream) != hipSuccess) return;
    Args a{};
    for (int i = 0; i < 26; ++i) a.in[i] = (const float*)d_in[i];
    a.out = (float*)d_out; a.ws = (unsigned char*)d_ws;
#if MK_PER_PHASE
    for (int p = 0; p < NPHASE; ++p) {
        if (p >= 1 + 10 && p <= 1 + 12) continue;
        a.ph_lo = p; a.ph_hi = p + 1;
        hipLaunchKernelGGL(fwd, dim3(grid), dim3(NT), LDS_BYTES, stream, a);
    }
#else
    a.ph_lo = 0; a.ph_hi = NPHASE;
    hipLaunchKernelGGL(fwd, dim3(grid), dim3(NT), LDS_BYTES, stream, a);
#endif
}
```

```cpp
#include <hip/hip_runtime.h>
#include <cstdio>
#include <cstdint>

#ifndef PROBE_DUP
#define PROBE_DUP 0
#endif
#ifndef PROBE_REPS
#define PROBE_REPS 2
#endif
#define REPS(k) ((PROBE_DUP == (k)) ? PROBE_REPS : 1)
#ifndef MK_PER_PHASE
#define MK_PER_PHASE 0
#endif

namespace pg8 {
#define PG8_LAS __attribute__((address_space(3)))
typedef unsigned short bf16_t;
typedef short bf16x8 __attribute__((ext_vector_type(8)));
typedef float f32x4 __attribute__((ext_vector_type(4)));
typedef unsigned u32x4 __attribute__((ext_vector_type(4)));
constexpr int BM = 256, BK = 64, HALF = 128, HTB = HALF * BK * 2, STAGE_BYTES = 8 * HTB, NXCD = 8, WGM = 8;

__host__ __device__ __forceinline__ int lds_byte(int r, int c) { const int st = (r >> 4) * 2 + (c >> 5), rr = r & 15, cc = c & 31, ob = rr * 64 + cc * 2; return st * 1024 + (ob ^ (((ob >> 9) & 1) << 5)); }
__host__ __device__ __forceinline__ void stage_rc(int b, int& R, int& C) { const int st = b / 1024, sb = b % 1024, swz = sb ^ (((sb >> 9) & 1) << 5); R = (st >> 1) * 16 + swz / 64; C = (st & 1) * 32 + (swz % 64) / 2; }
__host__ __device__ __forceinline__ int perm32(int rho) { const int n = rho >> 4, i = rho & 15; return 8 * (i >> 2) + 4 * n + (i & 3); }

struct Unit { int pm, pn, pb; };
struct Gemm { const bf16_t* A; const bf16_t* Bt; int lda, ldb, K; };

struct StaticOrder {
    static constexpr bool GATHER = false;
    int nM, nN, nwg, G, c;
    __device__ __forceinline__ void init(int nM_, int nN_, int G_, int c_) { nM = nM_; nN = nN_; nwg = nM * nN; G = G_; c = c_; }
    __device__ __forceinline__ bool next(int i, Unit& u) const {
        const long L = (long)i * G + c; if (L >= nwg) return false;
        int wgid = (int)L; { const int q = nwg / NXCD, r = nwg % NXCD, xcd = wgid % NXCD, off = wgid / NXCD; wgid = (xcd < r ? xcd * (q + 1) : r * (q + 1) + (xcd - r) * q) + off; }
        const int nig = WGM * nN, gid = wgid / nig, fm = gid * WGM, gsz = (nM - fm) < WGM ? (nM - fm) : WGM;
        u.pm = fm + ((wgid % nig) % gsz); u.pn = (wgid % nig) / gsz; u.pb = u.pn; return true;
    }
    __device__ __forceinline__ unsigned a_row_off(const Unit&, int) const { return 0u; }
};

__device__ __forceinline__ unsigned cvt_pk_bf16(float lo, float hi) { unsigned r; asm volatile("v_cvt_pk_bf16_f32 %0, %1, %2" : "=v"(r) : "v"(lo), "v"(hi)); return r; }

struct EpiBf16 {
    static constexpr bool PERM = true;
    bf16_t* O; int ldc; float scale;
    __device__ __forceinline__ void operator()(const f32x4 (&acc)[2][2][4][2], const Unit& u, int wr, int wc, int fr, int fq) const {
        const int row0 = u.pm * BM + wr * 64 + fr, col0 = u.pn * BM + wc * 32 + 8 * fq;
#pragma unroll
        for (int ai = 0; ai < 2; ++ai)
#pragma unroll
            for (int m = 0; m < 4; ++m) { bf16_t* rowp = O + (size_t)(row0 + ai * HALF + m * 16) * ldc + col0;
#pragma unroll
                for (int bj = 0; bj < 2; ++bj) { const f32x4 v0 = acc[ai][bj][m][0] * scale, v1 = acc[ai][bj][m][1] * scale;
                    u32x4 w; w.x = cvt_pk_bf16(v0[0], v0[1]); w.y = cvt_pk_bf16(v0[2], v0[3]); w.z = cvt_pk_bf16(v1[0], v1[1]); w.w = cvt_pk_bf16(v1[2], v1[3]);
                    *(u32x4*)(rowp + bj * HALF) = w; } }
    }
};

template <int KREP = 1, class Epi, class Sched>
__device__ __forceinline__ void gemm_phase(PG8_LAS unsigned char* lds, const Gemm g, const Sched& S, const Epi& E, int tid_in) {
    constexpr bool GATHER = Sched::GATHER;
    int tid_ = tid_in; asm volatile("" : "+v"(tid_));
    const int tid = tid_, wid = __builtin_amdgcn_readfirstlane(tid >> 6), lane = tid & 63, wr = wid >> 2, wc = wid & 3, fr = lane & 15, fq = lane >> 4;
    const int K = g.K, nt = K / BK;
    unsigned voffB[2], vA0[2], vA1[2], nA0[2], nA1[2];
#pragma unroll
    for (int i = 0; i < 2; ++i) { int R, C; stage_rc(tid * 16 + i * 8192, R, C); const int Rb = Epi::PERM ? ((R & ~31) + perm32(R & 31)) : R;
        voffB[i] = (unsigned)(Rb * g.ldb + C) * 2u;
        vA0[i] = (unsigned)(R * g.lda + C) * 2u; vA1[i] = vA0[i]; nA0[i] = vA0[i]; nA1[i] = vA0[i]; }
    const size_t kstep = (size_t)(BK * 2);
    const size_t hstepB = (size_t)HALF * g.ldb * 2, tstepB = 2 * hstepB, tstepA = (size_t)BM * g.lda * 2;
    const size_t hstepA = GATHER ? (size_t)0 : (size_t)HALF * g.lda * 2;
    const unsigned ldsw = (unsigned)wid * 1024u;
    const int aoff = lds_byte(wr * 64 + fr, fq * 8), boff = lds_byte(wc * 32 + fr, fq * 8);
#define PG8_SA(b, h) (((b) * 2 + (h)) * HTB)
#define PG8_SB(b, h) ((4 + (b) * 2 + (h)) * HTB)
#define PG8_STAGE(bufoff, gbase, voff) do { _Pragma("unroll") for (int _i = 0; _i < 2; ++_i) \
        __builtin_amdgcn_global_load_lds((const unsigned*)((const char*)(gbase) + (voff)[_i]), (PG8_LAS unsigned*)(lds + (bufoff) + ldsw + _i * 8192), 16, 0, 0); } while (0)
#define PG8_LDA(dst, b, h) do { _Pragma("unroll") for (int m = 0; m < 4; ++m) _Pragma("unroll") for (int k = 0; k < 2; ++k) dst[m][k] = *(const PG8_LAS bf16x8*)(lds + PG8_SA(b, h) + aoff + m * 2048 + k * 1024); } while (0)
#define PG8_LDB(dst, b, h) do { _Pragma("unroll") for (int n = 0; n < 2; ++n) _Pragma("unroll") for (int k = 0; k < 2; ++k) dst[n][k] = *(const PG8_LAS bf16x8*)(lds + PG8_SB(b, h) + boff + n * 2048 + k * 1024); } while (0)
#define PG8_MMA(ai, bj, At, Bt) do { __builtin_amdgcn_s_setprio(1); _Pragma("unroll") for (int m = 0; m < 4; ++m) _Pragma("unroll") for (int n = 0; n < 2; ++n) _Pragma("unroll") for (int k = 0; k < 2; ++k) \
        acc[ai][bj][m][n] = __builtin_amdgcn_mfma_f32_16x16x32_bf16(Bt[n][k], At[m][k], acc[ai][bj][m][n], 0, 0, 0); __builtin_amdgcn_s_setprio(0); } while (0)
#define PG8_WAIT_V(n) asm volatile("s_waitcnt vmcnt(" #n ")" ::: "memory")
#define PG8_WAIT_L(n) asm volatile("s_waitcnt lgkmcnt(" #n ")" ::: "memory")
#define PG8_BAR __builtin_amdgcn_s_barrier()
#define PG8_SCHED __builtin_amdgcn_sched_barrier(0)
#define PG8_GOFF(unit, d0, d1) do { _Pragma("unroll") for (int _i = 0; _i < 2; ++_i) { int R_, C_; stage_rc(tid * 16 + _i * 8192, R_, C_); \
        d0[_i] = S.a_row_off(unit, R_) + (unsigned)C_ * 2u; d1[_i] = S.a_row_off(unit, R_ + HALF) + (unsigned)C_ * 2u; } } while (0)
    Unit cur, nxt; int ui = 0;
    if (!S.next(0, cur)) return;
    f32x4 acc[2][2][4][2];
#pragma unroll
    for (int a = 0; a < 2; ++a)
#pragma unroll
        for (int b = 0; b < 2; ++b)
#pragma unroll
            for (int m = 0; m < 4; ++m)
#pragma unroll
                for (int n = 0; n < 2; ++n) acc[a][b][m][n] = (f32x4){0.f, 0.f, 0.f, 0.f};
    bf16x8 At[4][2], B0[2][2], B1[2][2];
    if constexpr (GATHER) { PG8_GOFF(cur, vA0, vA1); }
    const char* cA = GATHER ? (const char*)g.A : (const char*)g.A + (size_t)cur.pm * tstepA; const char* cB = (const char*)g.Bt + (size_t)cur.pb * tstepB;
    PG8_STAGE(PG8_SB(0, 0), cB, voffB); PG8_STAGE(PG8_SB(0, 1), cB + hstepB, voffB); PG8_STAGE(PG8_SA(0, 0), cA, vA0); PG8_STAGE(PG8_SA(0, 1), cA + hstepA, vA1);
    if (wr == 1) PG8_BAR;
    PG8_WAIT_V(2); PG8_BAR;
    PG8_STAGE(PG8_SB(1, 0), cB + kstep, voffB); PG8_STAGE(PG8_SA(1, 0), cA + kstep, vA0); PG8_STAGE(PG8_SB(1, 1), cB + hstepB + kstep, voffB);
    PG8_WAIT_V(6); PG8_BAR;
    for (;;) {
        const bool has_next = S.next(ui + 1, nxt);
        const char* nA = GATHER ? (const char*)g.A : (has_next ? (const char*)g.A + (size_t)nxt.pm * tstepA : cA); const char* nB = has_next ? (const char*)g.Bt + (size_t)nxt.pb * tstepB : cB;
        if constexpr (GATHER) { if (has_next) { PG8_GOFF(nxt, nA0, nA1); } else {
#pragma unroll
            for (int i = 0; i < 2; ++i) { nA0[i] = vA0[i]; nA1[i] = vA1[i]; } } }
        for (int t = 0; t < nt * KREP; t += 2) {
            const bool last = (t == nt * KREP - 2);
            const int t1 = (KREP == 1) ? t + 1 : ((t + 1) & (nt - 1)), t2 = (KREP == 1) ? t + 2 : ((t + 2) & (nt - 1));
            const char* a1 = cA + (size_t)t1 * kstep;
            const char* a2 = last ? nA : cA + (size_t)t2 * kstep; const char* b2 = last ? nB : cB + (size_t)t2 * kstep;
            const char* a3 = a2 + kstep; const char* b3 = b2 + kstep;
            unsigned s0[2], s1[2];
#pragma unroll
            for (int i = 0; i < 2; ++i) { s0[i] = (GATHER && last) ? nA0[i] : vA0[i]; s1[i] = GATHER ? (last ? nA1[i] : vA1[i]) : vA0[i]; }
            PG8_LDB(B0, 0, 0); PG8_LDB(B1, 0, 1); PG8_SCHED; PG8_LDA(At, 0, 0); PG8_STAGE(PG8_SA(1, 1), a1 + hstepA, vA1);
            PG8_WAIT_V(8); PG8_WAIT_L(0); PG8_BAR; PG8_MMA(0, 0, At, B0); PG8_MMA(0, 1, At, B1); PG8_BAR; PG8_SCHED;
            PG8_LDA(At, 0, 1); PG8_STAGE(PG8_SB(0, 0), b2, voffB); PG8_STAGE(PG8_SB(0, 1), b2 + hstepB, voffB); PG8_STAGE(PG8_SA(0, 0), a2, s0);
            PG8_WAIT_V(8); PG8_WAIT_L(0); PG8_BAR; PG8_MMA(1, 0, At, B0); PG8_MMA(1, 1, At, B1); PG8_BAR; PG8_SCHED;
            PG8_LDB(B0, 1, 0); PG8_LDB(B1, 1, 1); PG8_SCHED; PG8_LDA(At, 1, 0); PG8_STAGE(PG8_SA(0, 1), a2 + hstepA, s1);
            PG8_WAIT_V(8); PG8_WAIT_L(0); PG8_BAR; PG8_MMA(0, 0, At, B0); PG8_MMA(0, 1, At, B1); PG8_BAR; PG8_SCHED;
            PG8_LDA(At, 1, 1); PG8_STAGE(PG8_SB(1, 0), b3, voffB); PG8_STAGE(PG8_SB(1, 1), b3 + hstepB, voffB); PG8_STAGE(PG8_SA(1, 0), a3, s0);
            PG8_WAIT_V(8); PG8_WAIT_L(0); PG8_BAR; PG8_MMA(1, 0, At, B0); PG8_MMA(1, 1, At, B1); PG8_BAR; PG8_SCHED;
        }
        if (wr == 0) PG8_BAR;
        E(acc, cur, wr, wc, fr, fq);
        if (!has_next) break;
#pragma unroll
        for (int a = 0; a < 2; ++a)
#pragma unroll
            for (int b = 0; b < 2; ++b)
#pragma unroll
                for (int m = 0; m < 4; ++m)
#pragma unroll
                    for (int n = 0; n < 2; ++n) acc[a][b][m][n] = (f32x4){0.f, 0.f, 0.f, 0.f};
        cur = nxt; cA = nA; cB = nB; ++ui;
        if constexpr (GATHER) {
#pragma unroll
            for (int i = 0; i < 2; ++i) { vA0[i] = nA0[i]; vA1[i] = nA1[i]; } }
        if (wr == 1) PG8_BAR;
    }
    PG8_WAIT_V(0);
    PG8_BAR;
#undef PG8_SA
#undef PG8_SB
#undef PG8_STAGE
#undef PG8_LDA
#undef PG8_LDB
#undef PG8_MMA
#undef PG8_WAIT_V
#undef PG8_WAIT_L
#undef PG8_BAR
#undef PG8_SCHED
#undef PG8_GOFF
}
}

constexpr int D = 1024, BATCH = 8, SEQ = 4096, M = BATCH * SEQ, DEPTH = 2;
constexpr int D_A = 512, D_BK = 512, D_BV = 512, D_C = 512, H_B = 4;
constexpr int N_IN = 7680, N_BCA = 4608, N_G = 3072;
constexpr int D_FF = 2816, NE = 8, N13 = 2 * D_FF;
constexpr int MOD_LD = 6 * D;
constexpr float EPS = 1e-6f;
constexpr int LIST_CAP = M;
constexpr int MOE_ROWS = M + NE * 256;

constexpr size_t MiB = 1u << 20;
constexpr size_t WS_CTL = 0, CTL_ZERO_BYTES = 1 * MiB;
constexpr size_t WS_MOD = 1 * MiB;
constexpr size_t WS_TOPP = 2 * MiB;
constexpr size_t WS_LIST = 3 * MiB;
constexpr size_t WS_WMIX = 6 * MiB, WMIX_STRIDE = 20 * MiB;
constexpr size_t WS_W13 = 46 * MiB, WS_W2 = 57 * MiB;
constexpr size_t WS_BIG = 64 * MiB;
constexpr size_t WS_H = WS_BIG;
constexpr size_t WS_P1 = WS_BIG + 64 * MiB;
constexpr size_t WS_PG = WS_P1;
constexpr size_t WS_MRG = WS_P1 + 192 * MiB;
constexpr size_t WS_YA = WS_P1 + 288 * MiB, WS_YB = WS_YA + 32 * MiB, WS_YC = WS_YB + 32 * MiB;
constexpr size_t WS_ACT = WS_P1;
constexpr size_t WS_HU = WS_YC + 32 * MiB;
constexpr size_t WS_HD = WS_HU + 16 * MiB;
constexpr size_t WS_MIX_END = WS_HD + 1 * MiB;
constexpr size_t WS_WM13 = 6 * MiB;
constexpr size_t WS_WM2 = WS_WM13 + 88 * MiB;
constexpr size_t WS_H2M = WS_WM2 + 44 * MiB;
constexpr size_t WS_ACTM = WS_H2M + 64 * MiB;
constexpr size_t WS_MOE_END = WS_ACTM + (size_t)MOE_ROWS * D_FF * 2;
constexpr size_t WS_NEED = WS_MIX_END > WS_MOE_END ? WS_MIX_END : WS_MOE_END;
static_assert(WS_W2 + (size_t)D * D_FF * 2 <= WS_BIG && WS_WMIX + 2 * WMIX_STRIDE <= WS_W13, "ws map");
constexpr int CW_BAR = 4096;
constexpr int CW_CNT = 16384;

constexpr int LDS_BYTES = 147456;
constexpr int SCR_BYTES = 139264;
constexpr int TAB_OFF = SCR_BYTES;
constexpr int MISC_OFF = TAB_OFF + 4096;
static_assert(MISC_OFF + 128 <= LDS_BYTES, "LDS map");
constexpr int NWAVES = 8, NT = 512;

#define GAS __attribute__((address_space(1)))
#define LAS __attribute__((address_space(3)))
typedef unsigned short bf16;
typedef unsigned v4u __attribute__((ext_vector_type(4)));
typedef float f32x4 __attribute__((ext_vector_type(4)));
#define LDS_WAIT() asm volatile("s_waitcnt lgkmcnt(0)" ::: "memory")

typedef float f32x2_t __attribute__((ext_vector_type(2)));
typedef __bf16 bf16x2_t __attribute__((ext_vector_type(2)));
__device__ __forceinline__ unsigned pk2(float lo, float hi) { f32x2_t v = {lo, hi}; bf16x2_t b = __builtin_convertvector(v, bf16x2_t); return __builtin_bit_cast(unsigned, b); }
__device__ __forceinline__ float bf_lo(unsigned u) { return __uint_as_float(u << 16); }
__device__ __forceinline__ float bf_hi(unsigned u) { return __uint_as_float(u & 0xffff0000u); }
__device__ __forceinline__ void unpack8(const v4u w, float (&f)[8]) { f[0] = bf_lo(w.x); f[1] = bf_hi(w.x); f[2] = bf_lo(w.y); f[3] = bf_hi(w.y); f[4] = bf_lo(w.z); f[5] = bf_hi(w.z); f[6] = bf_lo(w.w); f[7] = bf_hi(w.w); }
__device__ __forceinline__ v4u pack8(const float (&f)[8]) { v4u w; w.x = pk2(f[0], f[1]); w.y = pk2(f[2], f[3]); w.z = pk2(f[4], f[5]); w.w = pk2(f[6], f[7]); return w; }
__device__ __forceinline__ float sigmoidf_(float x) { return __builtin_amdgcn_rcpf(1.0f + __expf(-x)); }
__device__ __forceinline__ float siluf_(float x) { return x * sigmoidf_(x); }
__device__ __forceinline__ float shx(float v, int mask, int lane) { return __int_as_float(__builtin_amdgcn_ds_bpermute((lane ^ mask) << 2, __float_as_int(v))); }
__device__ __forceinline__ float shl(float v, int src) { return __int_as_float(__builtin_amdgcn_ds_bpermute(src << 2, __float_as_int(v))); }
__device__ __forceinline__ float wave_sum(float v, int lane) {
#pragma unroll
    for (int o = 1; o < 64; o <<= 1) v += shx(v, o, lane);
    return v;
}

#define XB_TMO      128
#define XB_XCNT(j)  (256  + 64 * (j))
#define XB_XSUB(j)  (1280 + 64 * (j))
#define XB_XGEN(j)  (2304 + 64 * (j))
#define XB_TOP      3328
#define XB_TOPGEN   3392
#define XCD_BAR_WORDS 3456
#define XB_SPIN_CAP (1u << 18)

__device__ __forceinline__ unsigned xb_ld(unsigned* p)              { return __hip_atomic_load(p, __ATOMIC_RELAXED, __HIP_MEMORY_SCOPE_AGENT); }
__device__ __forceinline__ unsigned xb_add(unsigned* p, unsigned v) { return __hip_atomic_fetch_add(p, v, __ATOMIC_RELAXED, __HIP_MEMORY_SCOPE_AGENT); }
__device__ __forceinline__ unsigned xb_xcc_id() { return (unsigned)__builtin_amdgcn_s_getreg((3 << 11) | 20) & 0xFu; }
#define XB_SPIN(cond, bar) do { unsigned _sp = 0; while (cond) { __builtin_amdgcn_s_sleep(1); \
    if ((++_sp & 255u) == 0u) { if (xb_ld(&(bar)[XB_TMO])) break; if (_sp > XB_SPIN_CAP) { atomicAdd(&(bar)[XB_TMO], 1u); break; } } } } while (0)

struct XcdBarrier { unsigned* bar; unsigned x; volatile LAS unsigned* st; };

__device__ __forceinline__ XcdBarrier xcd_barrier_post(unsigned* bar, volatile LAS unsigned* st) {
    XcdBarrier b; b.bar = bar; b.x = xb_xcc_id(); b.st = st;
    if (threadIdx.x == 0) (void)xb_add(&bar[XB_XCNT(b.x)], 1u);
    return b;
}
__device__ __forceinline__ void xcd_barrier_complete(unsigned* bar, unsigned x, unsigned& nloc, unsigned& nx) {
    const unsigned G = gridDim.x * gridDim.y * gridDim.z;
    unsigned sum, cnt, mine, sp = 0u;
    for (;;) {
        sum = 0u; cnt = 0u; mine = 0u;
#pragma unroll
        for (unsigned j = 0; j < 16; ++j) { const unsigned c = xb_ld(&bar[XB_XCNT(j)]); sum += c; cnt += (c > 0u) ? 1u : 0u; mine = (j == x) ? c : mine; }
        if (sum == G) break;
        __builtin_amdgcn_s_sleep(1);
        if ((++sp & 255u) == 0u) { if (xb_ld(&bar[XB_TMO])) break; if (sp > XB_SPIN_CAP) { atomicAdd(&bar[XB_TMO], 1u); break; } }
    }
    nloc = mine > 0u ? mine : 1u; nx = cnt > 0u ? cnt : 1u;
}
__device__ __forceinline__ void xcd_barrier(const XcdBarrier& b) {
    asm volatile("s_waitcnt vmcnt(0)" ::: "memory");
    __syncthreads();
    if (threadIdx.x == 0) {
        unsigned* bar = b.bar;
        __builtin_amdgcn_s_waitcnt(0);
        unsigned nloc = b.st[0], nx = b.st[1];
        if (nloc == 0u) { xcd_barrier_complete(bar, b.x, nloc, nx); b.st[0] = nloc; b.st[1] = nx; }
        const unsigned old = xb_add(&bar[XB_XSUB(b.x)], 1u);
        const unsigned gen = old / nloc;
        if (old + 1u == (gen + 1u) * nloc) {
            __builtin_amdgcn_fence(__ATOMIC_RELEASE, "agent");
            asm volatile("s_waitcnt vmcnt(0)" ::: "memory");
            const unsigned og = xb_add(&bar[XB_TOP], 1u);
            const unsigned tg = og / nx;
            if (og + 1u == (tg + 1u) * nx) xb_add(&bar[XB_TOPGEN], 1u);
            else XB_SPIN(xb_ld(&bar[XB_TOPGEN]) == tg, bar);
            __builtin_amdgcn_fence(__ATOMIC_ACQUIRE, "agent");
            xb_add(&bar[XB_XGEN(b.x)], 1u);
            asm volatile("s_waitcnt vmcnt(0)" ::: "memory");
        } else {
            XB_SPIN(xb_ld(&bar[XB_XGEN(b.x)]) == gen, bar);
            __builtin_amdgcn_fence(__ATOMIC_ACQUIRE, "agent");
            asm volatile("s_waitcnt vmcnt(0)" ::: "memory");
        }
    }
    __syncthreads();
}

struct Args { const float* in[26]; float* out; unsigned char* ws; int ph_lo, ph_hi; };
typedef const Args __attribute__((address_space(4)))* KArgs;
#define KA() ({ KArgs p_ = (KArgs)__builtin_amdgcn_kernarg_segment_ptr(); asm volatile("" : "+s"(p_)); p_; })
struct Frame {
    LAS unsigned char* lds;
    int tid, lane, wave, G, bid;
    int w0;
};

template <int MAP>
__device__ __forceinline__ void transpose_item(const float* W, int K, int N, bf16* WT, int row_off, LAS float* scr, int item, int lane) {
    const int nblk = N / 32, kb = item / nblk, nb = item % nblk, k0 = 64 * kb, n0 = 32 * nb;
    float vld[32];
#pragma unroll
    for (int i = 0; i < 32; ++i) vld[i] = W[(size_t)(k0 + 2 * i + (lane >> 5)) * N + n0 + (lane & 31)];
    asm volatile("" ::: "memory");
#pragma unroll
    for (int i = 0; i < 32; ++i) scr[(2 * i + (lane >> 5)) * 33 + (lane & 31)] = vld[i];
    LDS_WAIT(); asm volatile("" ::: "memory");
    const int c = lane & 7;
#pragma unroll
    for (int j = 0; j < 4; ++j) { const int n = (lane >> 3) + 8 * j; const LAS float* s = scr + (8 * c) * 33 + n;
        v4u o; o.x = pk2(s[0 * 33], s[1 * 33]); o.y = pk2(s[2 * 33], s[3 * 33]); o.z = pk2(s[4 * 33], s[5 * 33]); o.w = pk2(s[6 * 33], s[7 * 33]);
        const int nn = n0 + n; const int row = (MAP == 0) ? (row_off + nn) : ((nn >> 7) * 256 + row_off + (nn & 127));
        *(v4u*)(WT + (size_t)row * K + k0 + 8 * c) = o; }
    LDS_WAIT(); asm volatile("" ::: "memory");
}

__device__ __forceinline__ void p_prologue(Frame& F, KArgs ka) {
    const float* c = ka->in[1]; const float* ada_w = ka->in[2]; const float* ada_b = ka->in[3];
    unsigned char* aws = ka->ws; float* mod = (float*)(aws + WS_MOD);
    LAS float* cact = (LAS float*)F.lds;
    LAS float* red = cact + 8192;
    for (int i = F.tid; i < BATCH * D; i += NT) cact[i] = siluf_(c[i]);
    __syncthreads();
    for (int chunk = F.bid; chunk < 256; chunk += F.G) {
        const int l = chunk >> 7, n0 = (chunk & 127) * 48;
        if (F.tid < 480) {
            const int kg = F.tid / 48, col = F.tid % 48;
            float acc[8];
#pragma unroll
            for (int b = 0; b < 8; ++b) acc[b] = 0.f;
            const float* wp = ada_w + (size_t)l * D * MOD_LD + n0 + col;
            for (int k = kg; k < D; k += 10) { const float w = wp[(size_t)k * MOD_LD];
#pragma unroll
                for (int b = 0; b < 8; ++b) acc[b] += cact[b * D + k] * w; }
#pragma unroll
            for (int b = 0; b < 8; ++b) red[(kg * 48 + col) * 8 + b] = acc[b];
        }
        __syncthreads();
        if (F.tid < 384) {
            const int col = F.tid >> 3, b = F.tid & 7; float s = 0.f;
#pragma unroll
            for (int kg = 0; kg < 10; ++kg) s += red[(kg * 48 + col) * 8 + b];
            mod[(size_t)(l * 8 + b) * MOD_LD + n0 + col] = s + ada_b[l * MOD_LD + n0 + col];
        }
        __syncthreads();
    }
    LAS float* scr = (LAS float*)(F.lds + F.wave * 16384);
    const int gw = F.bid * NWAVES + F.wave, NGW = F.G * NWAVES;
    constexpr int I_IN = (D / 64) * (N_IN / 32), I_BR = (512 / 64) * (D / 32), I_O = (D / 64) * (D / 32), I_L = I_IN + 3 * I_BR + I_O;
    constexpr int I_F1 = (D / 64) * (D_FF / 32), I_F2 = (D_FF / 64) * (D / 32);
    constexpr int NITEMS = 2 * I_L + 2 * I_F1 + I_F2;
    for (int it = gw; it < NITEMS; it += NGW) {
        int r = it;
        if (r < 2 * I_L) {
            const int l = r / I_L; r -= l * I_L;
            bf16* base = (bf16*)(aws + WS_WMIX + (size_t)l * WMIX_STRIDE);
            if (r < I_IN) { transpose_item<0>(ka->in[6] + (size_t)l * D * N_IN, D, N_IN, base, 0, scr, r, F.lane); continue; } r -= I_IN;
            if (r < I_BR) { transpose_item<0>(ka->in[13] + (size_t)l * 512 * D, 512, D, base + (size_t)N_IN * D, 0, scr, r, F.lane); continue; } r -= I_BR;
            if (r < I_BR) { transpose_item<0>(ka->in[14] + (size_t)l * 512 * D, 512, D, base + (size_t)N_IN * D + 512 * 1024, 0, scr, r, F.lane); continue; } r -= I_BR;
            if (r < I_BR) { transpose_item<0>(ka->in[15] + (size_t)l * 512 * D, 512, D, base + (size_t)N_IN * D + 2 * 512 * 1024, 0, scr, r, F.lane); continue; } r -= I_BR;
            transpose_item<0>(ka->in[16] + (size_t)l * D * D, D, D, base + (size_t)N_IN * D + 3 * 512 * 1024, 0, scr, r, F.lane); continue;
        }
        r -= 2 * I_L;
        if (r < I_F1) { transpose_item<1>(ka->in[17], D, D_FF, (bf16*)(aws + WS_W13), 0, scr, r, F.lane); continue; } r -= I_F1;
        if (r < I_F1) { transpose_item<1>(ka->in[18], D, D_FF, (bf16*)(aws + WS_W13), 128, scr, r, F.lane); continue; } r -= I_F1;
        transpose_item<0>(ka->in[19], D_FF, D, (bf16*)(aws + WS_W2), 0, scr, r, F.lane);
    }
}
__device__ __forceinline__ void p_moe_weights(Frame& F, KArgs ka) {
    unsigned char* aws = ka->ws;
    LAS float* scr = (LAS float*)(F.lds + F.wave * 16384);
    const int gw = F.bid * NWAVES + F.wave, NGW = F.G * NWAVES;
    constexpr int I_F1 = (D / 64) * (D_FF / 32), I_F2 = (D_FF / 64) * (D / 32), I_E = 2 * I_F1 + I_F2;
    for (int it = gw; it < NE * I_E; it += NGW) {
        const int e = it / I_E; int r = it - e * I_E;
        bf16* w13 = (bf16*)(aws + WS_WM13) + (size_t)e * N13 * D; bf16* w2 = (bf16*)(aws + WS_WM2) + (size_t)e * D * D_FF;
        if (r < I_F1) { transpose_item<1>(ka->in[22] + (size_t)e * D * D_FF, D, D_FF, w13, 0, scr, r, F.lane); continue; } r -= I_F1;
        if (r < I_F1) { transpose_item<1>(ka->in[23] + (size_t)e * D * D_FF, D, D_FF, w13, 128, scr, r, F.lane); continue; } r -= I_F1;
        transpose_item<0>(ka->in[24] + (size_t)e * D_FF * D, D_FF, D, w2, 0, scr, r, F.lane);
    }
}

__device__ __forceinline__ void norm_row(const float* xrow, const float* w, const float* sc, const float* sh, int lane, f32x4 (&o)[4]) {
    const f32x4* xr = (const f32x4*)xrow + lane;
    f32x4 v[4]; float s = 0.f;
#pragma unroll
    for (int j = 0; j < 4; ++j) { v[j] = xr[64 * j]; s += (v[j].x * v[j].x + v[j].y * v[j].y) + (v[j].z * v[j].z + v[j].w * v[j].w); }
    const float rstd = 1.0f / sqrtf(wave_sum(s, lane) * (1.0f / D) + EPS);
#pragma unroll
    for (int j = 0; j < 4; ++j) { const f32x4 wv = ((const f32x4*)w)[lane + 64 * j], scv = ((const f32x4*)sc)[lane + 64 * j], shv = ((const f32x4*)sh)[lane + 64 * j];
        o[j] = v[j] * rstd * wv * (scv + 1.0f) + shv; }
}
__device__ __forceinline__ void store_row_bf16(bf16* orow, int lane, const f32x4 (&o)[4]) {
    unsigned long long* o8 = (unsigned long long*)orow + lane;
#pragma unroll
    for (int j = 0; j < 4; ++j) o8[64 * j] = (unsigned long long)pk2(o[j].x, o[j].y) | ((unsigned long long)pk2(o[j].z, o[j].w) << 32);
}
__device__ __forceinline__ void p_norm(Frame& F, const float* xin, const float* w, const float* mod_l, int sc_off, int sh_off, bf16* hout) {
    const int gw = F.bid * NWAVES + F.wave, NGW = F.G * NWAVES, lane = F.lane;
    f32x4 wv[4];
#pragma unroll
    for (int j = 0; j < 4; ++j) wv[j] = ((const f32x4*)w)[lane + 64 * j];
    for (int r0 = gw * 4; r0 < M; r0 += NGW * 4) {
        const float* mb = mod_l + (size_t)(r0 >> 12) * MOD_LD;
        f32x4 v[4][4], scv[4], shv[4];
#pragma unroll
        for (int r = 0; r < 4; ++r)
#pragma unroll
            for (int j = 0; j < 4; ++j) v[r][j] = ((const f32x4*)(xin + (size_t)(r0 + r) * D))[lane + 64 * j];
#pragma unroll
        for (int j = 0; j < 4; ++j) { scv[j] = ((const f32x4*)(mb + sc_off))[lane + 64 * j]; shv[j] = ((const f32x4*)(mb + sh_off))[lane + 64 * j]; }
        asm volatile("" ::: "memory");
#pragma unroll
        for (int j = 0; j < 4; ++j) scv[j] = wv[j] * (scv[j] + 1.0f);
#pragma unroll
        for (int r = 0; r < 4; ++r) { float s = 0.f;
#pragma unroll
            for (int j = 0; j < 4; ++j) s += (v[r][j].x * v[r][j].x + v[r][j].y * v[r][j].y) + (v[r][j].z * v[r][j].z + v[r][j].w * v[r][j].w);
            const float rstd = 1.0f / sqrtf(wave_sum(s, lane) * (1.0f / D) + EPS);
            f32x4 o[4];
#pragma unroll
            for (int j = 0; j < 4; ++j) o[j] = v[r][j] * rstd * scv[j] + shv[j];
            store_row_bf16(hout + (size_t)(r0 + r) * D, lane, o); }
    }
}

__device__ __forceinline__ void p_conv(Frame& F, const bf16* P1, const float* conv_w, bf16* ya) {
    const int gt = F.bid * NT + F.tid, NGT = F.G * NT;
    for (int it = gt; it < M * 64; it += NGT) {
        const int row = it >> 6, c8 = (it & 63) * 8, pos = row & (SEQ - 1);
        const bf16* p = P1 + (size_t)row * N_BCA + c8;
        float ab[8], ac[8], ah[8], z1[8], z2[8], y[8];
        unpack8(*(const v4u*)p, ab); unpack8(*(const v4u*)(p + 512), ac); unpack8(*(const v4u*)(p + 1024), ah);
#pragma unroll
        for (int i = 0; i < 8; ++i) { z1[i] = 0.f; z2[i] = 0.f; }
        if (pos >= 1) { float c1[8], h1[8]; unpack8(*(const v4u*)(p - N_BCA + 512), c1); unpack8(*(const v4u*)(p - N_BCA + 1024), h1);
#pragma unroll
            for (int i = 0; i < 8; ++i) z1[i] = c1[i] * h1[i]; }
        if (pos >= 2) { float c2[8], h2[8]; unpack8(*(const v4u*)(p - 2 * N_BCA + 512), c2); unpack8(*(const v4u*)(p - 2 * N_BCA + 1024), h2);
#pragma unroll
            for (int i = 0; i < 8; ++i) z2[i] = c2[i] * h2[i]; }
#pragma unroll
        for (int i = 0; i < 8; ++i) y[i] = ab[i] * (conv_w[c8 + i] * (ac[i] * ah[i]) + conv_w[512 + c8 + i] * z1[i] + conv_w[1024 + c8 + i] * z2[i]);
        *(v4u*)(ya + (size_t)row * 512 + c8) = pack8(y);
    }
}

typedef short v4i16_t __attribute__((ext_vector_type(4)));
typedef short bf16x8_t __attribute__((ext_vector_type(8)));
typedef unsigned v2u __attribute__((ext_vector_type(2)));
constexpr int HRS = 272;
constexpr int TRS = 80;
constexpr int H_RAWQ = 0, H_RAWF = 8704, H_V = 17408, H_QHT = 26112, H_KTT = 36352, H_KHT = 46592, H_DL = 56832, H_OB = 57344, H_OBS = 132;
constexpr int HSEG = 512, HNSEG = SEQ / HSEG, HCH = 32;
__device__ __forceinline__ v4i16_t tr_read(LAS unsigned char* p) { return __builtin_amdgcn_ds_read_tr16_b64_v4i16((LAS v4i16_t*)p); }
__device__ __forceinline__ bf16x8_t cat4(v4i16_t lo, v4i16_t hi) { return __builtin_shufflevector(lo, hi, 0, 1, 2, 3, 4, 5, 6, 7); }
__device__ __forceinline__ bf16x8_t pack_acc(const f32x4 a, const f32x4 b) { v4u w; w.x = pk2(a[0], a[1]); w.y = pk2(a[2], a[3]); w.z = pk2(b[0], b[1]); w.w = pk2(b[2], b[3]); return __builtin_bit_cast(bf16x8_t, w); }
__device__ __forceinline__ float bfs(short x) { return __uint_as_float((unsigned)(unsigned short)x << 16); }
template <int PASS>
__device__ __forceinline__ void p_hgrn(Frame& F, const bf16* P1, const float* lb_logits, int layer, const float* norm_w, bf16* yb, float* ust, float* dst) {
    LAS unsigned char* L = F.lds;
    const int lane = F.lane, w = F.wave, g = lane >> 4, n = lane & 15, q_ = n >> 2, p_ = n & 3;
    const int pt = F.tid >> 4, pc8 = (F.tid & 15) * 8;
    for (int u = F.bid; u < BATCH * H_B * HNSEG; u += F.G) {
        const int seg = u & (HNSEG - 1), bh = u / HNSEG, b = bh >> 2, h = bh & 3;
        const int d = 16 * w + n;
        float lb; { const int ch = h * 128 + d; const float l0 = lb_logits[ch], l1 = lb_logits[512 + ch]; const float mx = fmaxf(l0, l1);
            const float e0 = expf(l0 - mx), e1 = expf(l1 - mx); const float p0 = e0 / (e0 + e1), p1 = e1 / (e0 + e1);
            const float lbx = (layer == 0) ? (p0 - p0) : ((p0 + p1) - p0); lb = fminf(fmaxf(lbx, 0.f), 1.f); }
        const float lbf = fmaxf(lb, 1e-30f), oml = 1.0f - lb;
        f32x4 S[8];
#pragma unroll
        for (int kt = 0; kt < 8; ++kt) S[kt] = (f32x4){0.f, 0.f, 0.f, 0.f};
        if (PASS == 2) {
            for (int j = 0; j < seg; ++j) { const int uj = u - seg + j;
#pragma unroll
                for (int kt = 0; kt < 8; ++kt) { const f32x4 dj = *(const f32x4*)(dst + (size_t)uj * 128 + 16 * kt + 4 * g); const f32x4 uu = *(const f32x4*)(ust + ((((size_t)uj * 8 + w) * 8 + kt) * 64 + lane) * 4);
                    S[kt] = dj * S[kt] + uu; } }
        }
        float nw8[8];
        if (PASS == 2) {
#pragma unroll
            for (int i = 0; i < 8; ++i) nw8[i] = norm_w[h * 128 + pc8 + i]; }
        float dprod = 1.0f;
        const bf16* gp = P1 + ((size_t)b * SEQ + (size_t)seg * HSEG + pt) * N_BCA + 1536 + h * 128 + pc8;
        v4u rq, rf, rv, rg;
        rf = *(const v4u*)(gp + 512); rv = *(const v4u*)(gp + 1024);
        if (PASS == 2) { rq = *(const v4u*)gp; rg = *(const v4u*)(gp + 1536); }
        for (int c = 0; c < HSEG / HCH; ++c) {
            *(LAS v4u*)(L + H_RAWF + pt * HRS + pc8 * 2) = rf; *(LAS v4u*)(L + H_V + pt * HRS + pc8 * 2) = rv;
            if (PASS == 2) *(LAS v4u*)(L + H_RAWQ + pt * HRS + pc8 * 2) = rq;
            v4u cg; if (PASS == 2) cg = rg;
            __syncthreads();
            if (c + 1 < HSEG / HCH) { const bf16* np = gp + (size_t)(c + 1) * HCH * N_BCA; rf = *(const v4u*)(np + 512); rv = *(const v4u*)(np + 1024);
                if (PASS == 2) { rq = *(const v4u*)np; rg = *(const v4u*)(np + 1536); } }
            { const bf16x8_t f8 = cat4(tr_read(L + H_RAWF + (8 * g + q_) * HRS + 32 * w + 8 * p_), tr_read(L + H_RAWF + (8 * g + 4 + q_) * HRS + 32 * w + 8 * p_));
              float eb[8], kk[8]; float cp = 1.0f;
#pragma unroll
              for (int i = 0; i < 8; ++i) { const float sg = __builtin_amdgcn_rcpf(1.0f + __expf(-bfs(f8[i]))); const float f = lbf + oml * sg; kk[i] = oml * (1.0f - sg); cp *= f; eb[i] = cp; }
              const float s1 = shl(cp, n), s2 = shl(cp, 16 + n), s3 = shl(cp, 32 + n), s4 = shl(cp, 48 + n);
              const float pre = (g > 0 ? s1 : 1.0f) * (g > 1 ? s2 : 1.0f) * (g > 2 ? s3 : 1.0f);
              const float elast = ((s1 * s2) * s3) * s4;
              float kh[8], kt8[8];
#pragma unroll
              for (int i = 0; i < 8; ++i) { eb[i] *= pre; const float en = __builtin_amdgcn_rcpf(fmaxf(eb[i], 1e-30f)); kt8[i] = kk[i] * en; kh[i] = kt8[i] * elast; }
              *(LAS v4u*)(L + H_KHT + d * TRS + 16 * g) = pack8(kh);
              if (PASS == 2) { const bf16x8_t q8 = cat4(tr_read(L + H_RAWQ + (8 * g + q_) * HRS + 32 * w + 8 * p_), tr_read(L + H_RAWQ + (8 * g + 4 + q_) * HRS + 32 * w + 8 * p_));
                  float qh[8];
#pragma unroll
                  for (int i = 0; i < 8; ++i) qh[i] = siluf_(bfs(q8[i])) * eb[i];
                  *(LAS v4u*)(L + H_QHT + d * TRS + 16 * g) = pack8(qh); *(LAS v4u*)(L + H_KTT + d * TRS + 16 * g) = pack8(kt8); }
              if (g == 0) *(LAS float*)(L + H_DL + 4 * d) = elast;
              dprod *= elast; }
            __syncthreads();
            const bf16x8_t bVn = cat4(tr_read(L + H_V + (8 * g + q_) * HRS + 32 * w + 8 * p_), tr_read(L + H_V + (8 * g + 4 + q_) * HRS + 32 * w + 8 * p_));
            if (PASS == 2) {
                const bf16x8_t bVp = cat4(tr_read(L + H_V + (4 * g + q_) * HRS + 32 * w + 8 * p_), tr_read(L + H_V + (16 + 4 * g + q_) * HRS + 32 * w + 8 * p_));
                f32x4 o[2], pt00 = {0.f, 0.f, 0.f, 0.f}, pt01 = {0.f, 0.f, 0.f, 0.f}, pt11 = {0.f, 0.f, 0.f, 0.f};
                o[0] = (f32x4){0.f, 0.f, 0.f, 0.f}; o[1] = (f32x4){0.f, 0.f, 0.f, 0.f};
#pragma unroll
                for (int ks = 0; ks < 4; ++ks) {
                    const bf16x8_t sb = pack_acc(S[2 * ks], S[2 * ks + 1]);
#pragma unroll
                    for (int tm = 0; tm < 2; ++tm) {
                        const bf16x8_t aq = cat4(tr_read(L + H_QHT + (32 * ks + 4 * g + q_) * TRS + 32 * tm + 8 * p_), tr_read(L + H_QHT + (32 * ks + 16 + 4 * g + q_) * TRS + 32 * tm + 8 * p_));
                        o[tm] = __builtin_amdgcn_mfma_f32_16x16x32_bf16(aq, sb, o[tm], 0, 0, 0); }
                    const bf16x8_t aK0 = cat4(tr_read(L + H_KTT + (32 * ks + 8 * g + q_) * TRS + 8 * p_), tr_read(L + H_KTT + (32 * ks + 8 * g + 4 + q_) * TRS + 8 * p_));
                    const bf16x8_t aK1 = cat4(tr_read(L + H_KTT + (32 * ks + 8 * g + q_) * TRS + 32 + 8 * p_), tr_read(L + H_KTT + (32 * ks + 8 * g + 4 + q_) * TRS + 32 + 8 * p_));
                    const bf16x8_t bQ0 = cat4(tr_read(L + H_QHT + (32 * ks + 8 * g + q_) * TRS + 8 * p_), tr_read(L + H_QHT + (32 * ks + 8 * g + 4 + q_) * TRS + 8 * p_));
                    const bf16x8_t bQ1 = cat4(tr_read(L + H_QHT + (32 * ks + 8 * g + q_) * TRS + 32 + 8 * p_), tr_read(L + H_QHT + (32 * ks + 8 * g + 4 + q_) * TRS + 32 + 8 * p_));
                    pt00 = __builtin_amdgcn_mfma_f32_16x16x32_bf16(aK0, bQ0, pt00, 0, 0, 0);
                    pt01 = __builtin_amdgcn_mfma_f32_16x16x32_bf16(aK0, bQ1, pt01, 0, 0, 0);
                    pt11 = __builtin_amdgcn_mfma_f32_16x16x32_bf16(aK1, bQ1, pt11, 0, 0, 0);
                }
#pragma unroll
                for (int j = 0; j < 4; ++j) if (4 * g + j > n) { pt00[j] = 0.f; pt11[j] = 0.f; }
                const f32x4 z4 = {0.f, 0.f, 0.f, 0.f};
                o[0] = __builtin_amdgcn_mfma_f32_16x16x32_bf16(pack_acc(pt00, z4), bVp, o[0], 0, 0, 0);
                o[1] = __builtin_amdgcn_mfma_f32_16x16x32_bf16(pack_acc(pt01, pt11), bVp, o[1], 0, 0, 0);
#pragma unroll
                for (int tm = 0; tm < 2; ++tm)
#pragma unroll
                    for (int j = 0; j < 4; ++j) *(LAS float*)(L + H_OB + ((16 * tm + 4 * g + j) * H_OBS + 16 * w + n) * 4) = o[tm][j];
            }
#pragma unroll
            for (int kt = 0; kt < 8; ++kt) { const f32x4 dl4 = *(const LAS f32x4*)(L + H_DL + (16 * kt + 4 * g) * 4);
                const bf16x8_t aKh = *(const LAS bf16x8_t*)(L + H_KHT + (16 * kt + n) * TRS + 16 * g);
                S[kt] = __builtin_amdgcn_mfma_f32_16x16x32_bf16(aKh, bVn, S[kt] * dl4, 0, 0, 0); }
            __syncthreads();
            if (PASS == 2) {
                const f32x4 o0 = *(const LAS f32x4*)(L + H_OB + (pt * H_OBS + pc8) * 4), o1 = *(const LAS f32x4*)(L + H_OB + (pt * H_OBS + pc8 + 4) * 4);
                const float o8[8] = {o0.x, o0.y, o0.z, o0.w, o1.x, o1.y, o1.z, o1.w};
                float ss = 0.f;
#pragma unroll
                for (int i = 0; i < 8; ++i) ss += o8[i] * o8[i];
                ss += shx(ss, 1, lane); ss += shx(ss, 2, lane); ss += shx(ss, 4, lane); ss += shx(ss, 8, lane);
                const float rs = 1.0f / sqrtf(ss * (1.0f / 128.0f) + EPS);
                float g8[8], y[8]; unpack8(cg, g8);
#pragma unroll
                for (int i = 0; i < 8; ++i) y[i] = o8[i] * rs * nw8[i] * siluf_(g8[i]);
                *(v4u*)(yb + ((size_t)b * SEQ + (size_t)seg * HSEG + (size_t)c * HCH + pt) * 512 + h * 128 + pc8) = pack8(y);
            }
        }
        if (PASS == 1) {
#pragma unroll
            for (int kt = 0; kt < 8; ++kt) *(f32x4*)(ust + ((((size_t)u * 8 + w) * 8 + kt) * 64 + lane) * 4) = S[kt];
            if (g == 0) dst[(size_t)u * 128 + d] = dprod;
        }
        __syncthreads();
    }
}

constexpr int SG_V = 0, SG_OB = 34816, SG_OBS = 132, SG_RS = SG_OB + 128 * SG_OBS * 4;
__device__ __forceinline__ void p_sgu(Frame& F, const bf16* P1, const float* norm_w, const float* sgu_w, const float* sgu_b, bf16* yc) {
    LAS unsigned char* L = F.lds;
    const int lane = F.lane, w = F.wave, gq = lane >> 4, n = lane & 15, q_ = n >> 2, p_ = n & 3;
    const int sr = F.tid >> 4, c8 = (F.tid & 15) * 8;
    for (int u = F.bid; u < M / 128; u += F.G) {
        const size_t row0 = (size_t)u * 128;
        v4u rv[4][4]; float ssj[4] = {0.f, 0.f, 0.f, 0.f};
#pragma unroll
        for (int g = 0; g < 4; ++g)
#pragma unroll
            for (int j = 0; j < 4; ++j) { rv[g][j] = *(const v4u*)(P1 + (row0 + sr + 32 * j) * N_BCA + 4096 + g * 128 + c8); float f[8]; unpack8(rv[g][j], f);
#pragma unroll
                for (int i = 0; i < 8; ++i) ssj[j] += f[i] * f[i]; }
#pragma unroll
        for (int j = 0; j < 4; ++j) { float ss = ssj[j]; ss += shx(ss, 1, lane); ss += shx(ss, 2, lane); ss += shx(ss, 4, lane); ss += shx(ss, 8, lane);
            if (n == 0) *(LAS float*)(L + SG_RS + 4 * (sr + 32 * j)) = 1.0f / sqrtf(ss * (1.0f / 512.0f) + EPS); }
#pragma unroll
        for (int g = 0; g < 4; ++g) {
#pragma unroll
            for (int j = 0; j < 4; ++j) *(LAS v4u*)(L + SG_V + (sr + 32 * j) * HRS + c8 * 2) = rv[g][j];
            __syncthreads();
            float nwv[8];
            const int kmax = w >> 1, t = 16 * w + n;
            bf16x8_t aW[4];
            { f32x4 wl[4][2]; float nwl[8];
#pragma unroll
              for (int ks = 0; ks < 4; ++ks) { const float* wp = sgu_w + ((size_t)g * 128 + t) * 128 + 32 * ks + 8 * gq; wl[ks][0] = *(const f32x4*)wp; wl[ks][1] = *(const f32x4*)(wp + 4); }
#pragma unroll
              for (int ct = 0; ct < 8; ++ct) nwl[ct] = norm_w[g * 128 + 16 * ct + n];
              asm volatile("" ::: "memory");
#pragma unroll
              for (int ct = 0; ct < 8; ++ct) nwv[ct] = nwl[ct];
#pragma unroll
              for (int ks = 0; ks < 4; ++ks) { const int s0 = 32 * ks + 8 * gq;
                    const f32x4 w0 = wl[ks][0], w1 = wl[ks][1]; const f32x4 r0 = *(const LAS f32x4*)(L + SG_RS + 4 * s0), r1 = *(const LAS f32x4*)(L + SG_RS + 4 * (s0 + 4));
                    float a8[8] = {w0.x * r0.x, w0.y * r0.y, w0.z * r0.z, w0.w * r0.w, w1.x * r1.x, w1.y * r1.y, w1.z * r1.z, w1.w * r1.w};
#pragma unroll
                    for (int i = 0; i < 8; ++i) if (s0 + i > t) a8[i] = 0.f;
                    aW[ks] = __builtin_bit_cast(bf16x8_t, pack8(a8)); } }
            f32x4 acc[8];
#pragma unroll
            for (int ct = 0; ct < 8; ++ct) acc[ct] = (f32x4){0.f, 0.f, 0.f, 0.f};
#pragma unroll
            for (int ks = 0; ks < 4; ++ks) { if (ks <= kmax) {
#pragma unroll
                for (int ct = 0; ct < 8; ++ct) { const bf16x8_t bV = cat4(tr_read(L + SG_V + (32 * ks + 8 * gq + q_) * HRS + 32 * ct + 8 * p_), tr_read(L + SG_V + (32 * ks + 8 * gq + 4 + q_) * HRS + 32 * ct + 8 * p_));
                    acc[ct] = __builtin_amdgcn_mfma_f32_16x16x32_bf16(aW[ks], bV, acc[ct], 0, 0, 0); } } }
#pragma unroll
            for (int ct = 0; ct < 8; ++ct) { const float nw = nwv[ct];
#pragma unroll
                for (int j = 0; j < 4; ++j) *(LAS float*)(L + SG_OB + ((16 * w + 4 * gq + j) * SG_OBS + 16 * ct + n) * 4) = acc[ct][j] * nw; }
            __syncthreads();
            v4u ul[4]; float bl[4];
#pragma unroll
            for (int j = 0; j < 4; ++j) { ul[j] = *(const v4u*)(P1 + (row0 + sr + 32 * j) * N_BCA + 3584 + g * 128 + c8); bl[j] = sgu_b[g * 128 + sr + 32 * j]; }
            asm volatile("" ::: "memory");
#pragma unroll
            for (int j = 0; j < 4; ++j) { const int tt = sr + 32 * j; const float bias = bl[j];
                const f32x4 o0 = *(const LAS f32x4*)(L + SG_OB + (tt * SG_OBS + c8) * 4), o1 = *(const LAS f32x4*)(L + SG_OB + (tt * SG_OBS + c8 + 4) * 4);
                float uu[8], y[8]; unpack8(ul[j], uu);
                y[0] = (o0.x + bias) * uu[0]; y[1] = (o0.y + bias) * uu[1]; y[2] = (o0.z + bias) * uu[2]; y[3] = (o0.w + bias) * uu[3];
                y[4] = (o1.x + bias) * uu[4]; y[5] = (o1.y + bias) * uu[5]; y[6] = (o1.z + bias) * uu[6]; y[7] = (o1.w + bias) * uu[7];
                *(v4u*)(yc + (row0 + tt) * 512 + g * 128 + c8) = pack8(y); }
        }
        __syncthreads();
    }
}

__device__ __forceinline__ void p_norm_router(Frame& F, KArgs ka, const float* x, const float* w, const float* mod_l, bf16* h2) {
    const float* rw = ka->in[20]; const float* rb = ka->in[21]; unsigned* ctl = (unsigned*)(ka->ws + WS_CTL);
    float* topp = (float*)(ka->ws + WS_TOPP); int* list = (int*)(ka->ws + WS_LIST);
    LAS float* RWt = (LAS float*)F.lds;
    LAS int* lcnt = (LAS int*)(RWt + 8192);
    LAS int* lbase = lcnt + 16;
    LAS int* sel = lbase + 16;
    LAS int* rnk = sel + 128;
    for (int i = F.tid; i < D * NE; i += NT) { const int k = i >> 3, e = i & 7; RWt[e * D + k] = rw[i]; }
    __syncthreads();
    for (int batch = F.bid; batch < M / 128; batch += F.G) {
        const int row0 = batch * 128;
        if (F.tid < 16) lcnt[F.tid] = 0;
        __syncthreads();
        for (int rr = 0; rr < 16; ++rr) {
            const int r = F.wave * 16 + rr, row = row0 + r;
            const float* mb = mod_l + (size_t)(row >> 12) * MOD_LD;
            f32x4 o[4]; norm_row(x + (size_t)row * D, w, mb + 4 * D, mb + 3 * D, F.lane, o);
            store_row_bf16(h2 + (size_t)row * D, F.lane, o);
            float lg[8];
#pragma unroll
            for (int e = 0; e < 8; ++e) { float s = 0.f;
#pragma unroll
                for (int j = 0; j < 4; ++j) { const f32x4 r4 = *(const LAS f32x4*)(RWt + e * D + 4 * F.lane + 256 * j); s += (o[j].x * r4.x + o[j].y * r4.y) + (o[j].z * r4.z + o[j].w * r4.w); }
                lg[e] = wave_sum(s, F.lane) + rb[e]; }
            int i0 = 0; float v0 = lg[0];
#pragma unroll
            for (int e = 1; e < 8; ++e) if (lg[e] > v0) { v0 = lg[e]; i0 = e; }
            int i1 = -1; float v1 = -3.0e38f;
#pragma unroll
            for (int e = 0; e < 8; ++e) if (e != i0 && lg[e] > v1) { v1 = lg[e]; i1 = e; }
            if (F.lane == 0) {
                const float p0 = 1.0f / (1.0f + expf(v1 - v0));
                topp[(size_t)row * 2] = p0; topp[(size_t)row * 2 + 1] = 1.0f - p0;
                const int rk0 = __hip_atomic_fetch_add(lcnt + i0, 1, __ATOMIC_RELAXED, __HIP_MEMORY_SCOPE_WORKGROUP), rk1 = __hip_atomic_fetch_add(lcnt + 8 + i1, 1, __ATOMIC_RELAXED, __HIP_MEMORY_SCOPE_WORKGROUP);
                sel[r] = i0 | (i1 << 8); rnk[r] = rk0 | (rk1 << 16);
            }
        }
        __syncthreads();
        if (F.tid < 16) lbase[F.tid] = (int)__hip_atomic_fetch_add(ctl + CW_CNT + 64 * F.tid, (unsigned)lcnt[F.tid], __ATOMIC_RELAXED, __HIP_MEMORY_SCOPE_AGENT);
        __syncthreads();
        if (F.tid < 128) { const int sv = sel[F.tid], rv = rnk[F.tid]; const int e0 = sv & 255, e1 = sv >> 8;
            list[(size_t)e0 * LIST_CAP + lbase[e0] + (rv & 0xffff)] = row0 + F.tid;
            list[(size_t)(8 + e1) * LIST_CAP + lbase[8 + e1] + (rv >> 16)] = row0 + F.tid; }
        __syncthreads();
    }
}
__device__ __forceinline__ void moe_tables(Frame& F, unsigned* ctl, int pass) {
    LAS int* tab = (LAS int*)(F.lds + TAB_OFF);
    __syncthreads();
    if (F.tid == 0) { int pb = 0;
        for (int e = 0; e < 8; ++e) { int c = (int)__hip_atomic_load(ctl + CW_CNT + 64 * (pass * 8 + e), __ATOMIC_RELAXED, __HIP_MEMORY_SCOPE_AGENT); if (c > LIST_CAP) c = LIST_CAP; if (c < 0) c = 0;
            const int np = (c + 255) >> 8; tab[e] = c; tab[8 + e] = pb; for (int p = 0; p < np; ++p) tab[32 + pb + p] = e; pb += np; }
        tab[16] = pb; }
    __syncthreads();
}
template <bool GATHER_>
struct MoeOrder {
    static constexpr bool GATHER = GATHER_;
    pg8::StaticOrder so; const LAS int* tab; const int* list; int npn; unsigned rowbytes;
    __device__ __forceinline__ bool next(int i, pg8::Unit& u) const { if (!so.next(i, u)) return false; u.pb = tab[32 + u.pm] * npn + u.pn; return true; }
    __device__ __forceinline__ int tok_of(int pm, int r) const { const int e = tab[32 + pm]; const int idx = (pm - tab[8 + e]) * 256 + r; return idx < tab[e] ? list[(size_t)e * LIST_CAP + idx] : -1; }
    __device__ __forceinline__ unsigned a_row_off(const pg8::Unit& u, int r) const { const int t = tok_of(u.pm, r); return (unsigned)(t < 0 ? 0 : t) * rowbytes; }
};

struct EpiBranch {
    static constexpr bool PERM = true;
    const bf16* gate; bf16* mrg; int first;
    __device__ __forceinline__ void operator()(const pg8::f32x4 (&acc)[2][2][4][2], const pg8::Unit& u, int wr, int wc, int fr, int fq) const {
        const int row0 = u.pm * 256 + wr * 64 + fr, col0 = u.pn * 256 + wc * 32 + 8 * fq;
#pragma unroll
        for (int ai = 0; ai < 2; ++ai) {
            v4u gl[4][2], ml[4][2];
#pragma unroll
            for (int m = 0; m < 4; ++m)
#pragma unroll
                for (int bj = 0; bj < 2; ++bj) { const size_t row = (size_t)(row0 + ai * 128 + m * 16); const int col = col0 + bj * 128;
                    gl[m][bj] = *(const v4u*)(gate + row * N_G + col); ml[m][bj] = first ? (v4u){0u, 0u, 0u, 0u} : *(const v4u*)(mrg + row * D + col); }
            asm volatile("" ::: "memory");
#pragma unroll
            for (int m = 0; m < 4; ++m)
#pragma unroll
                for (int bj = 0; bj < 2; ++bj) { const size_t row = (size_t)(row0 + ai * 128 + m * 16); const int col = col0 + bj * 128;
                    float gg[8], mm[8], o[8]; unpack8(gl[m][bj], gg); unpack8(ml[m][bj], mm);
                    const pg8::f32x4 v0 = acc[ai][bj][m][0], v1 = acc[ai][bj][m][1];
                    o[0] = mm[0] + sigmoidf_(gg[0]) * v0[0]; o[1] = mm[1] + sigmoidf_(gg[1]) * v0[1]; o[2] = mm[2] + sigmoidf_(gg[2]) * v0[2]; o[3] = mm[3] + sigmoidf_(gg[3]) * v0[3];
                    o[4] = mm[4] + sigmoidf_(gg[4]) * v1[0]; o[5] = mm[5] + sigmoidf_(gg[5]) * v1[1]; o[6] = mm[6] + sigmoidf_(gg[6]) * v1[2]; o[7] = mm[7] + sigmoidf_(gg[7]) * v1[3];
                    *(v4u*)(mrg + row * D + col) = pack8(o); }
            asm volatile("" ::: "memory");
        }
    }
};
struct EpiResid {
    static constexpr bool PERM = false;
    const float* xin; float* xout; const float* gmod;
    __device__ __forceinline__ void operator()(const pg8::f32x4 (&acc)[2][2][4][2], const pg8::Unit& u, int wr, int wc, int fr, int fq) const {
        const int row0 = u.pm * 256 + wr * 64 + fr, col0 = u.pn * 256 + wc * 32 + 4 * fq;
        const float* gb = gmod + (size_t)((u.pm * 256) >> 12) * MOD_LD + col0;
        pg8::f32x4 gv[2][2];
#pragma unroll
        for (int bj = 0; bj < 2; ++bj)
#pragma unroll
            for (int n = 0; n < 2; ++n) gv[bj][n] = *(const pg8::f32x4*)(gb + bj * 128 + n * 16);
#pragma unroll
        for (int am = 0; am < 4; ++am) {
            const int ai = am >> 1, mb = (am & 1) * 2;
            pg8::f32x4 xl[2][2][2];
#pragma unroll
            for (int m = 0; m < 2; ++m)
#pragma unroll
                for (int bj = 0; bj < 2; ++bj)
#pragma unroll
                    for (int n = 0; n < 2; ++n) xl[m][bj][n] = *(const pg8::f32x4*)(xin + (size_t)(row0 + ai * 128 + (mb + m) * 16) * D + col0 + bj * 128 + n * 16);
            asm volatile("" ::: "memory");
#pragma unroll
            for (int m = 0; m < 2; ++m)
#pragma unroll
                for (int bj = 0; bj < 2; ++bj)
#pragma unroll
                    for (int n = 0; n < 2; ++n) *(pg8::f32x4*)(xout + (size_t)(row0 + ai * 128 + (mb + m) * 16) * D + col0 + bj * 128 + n * 16) = xl[m][bj][n] + gv[bj][n] * acc[ai][bj][mb + m][n];
            asm volatile("" ::: "memory");
        }
    }
};
struct EpiSwiglu {
    static constexpr bool PERM = true;
    bf16* act;
    __device__ __forceinline__ void operator()(const pg8::f32x4 (&acc)[2][2][4][2], const pg8::Unit& u, int wr, int wc, int fr, int fq) const {
        const int row0 = u.pm * 256 + wr * 64 + fr, col0 = u.pn * 128 + wc * 32 + 8 * fq;
#pragma unroll
        for (int ai = 0; ai < 2; ++ai)
#pragma unroll
            for (int m = 0; m < 4; ++m) { float o[8];
#pragma unroll
                for (int n = 0; n < 2; ++n)
#pragma unroll
                    for (int i = 0; i < 4; ++i) o[n * 4 + i] = siluf_(acc[ai][0][m][n][i]) * acc[ai][1][m][n][i];
                *(v4u*)(act + (size_t)(row0 + ai * 128 + m * 16) * D_FF + col0) = pack8(o); }
    }
};
struct EpiMoeDown {
    static constexpr bool PERM = false;
    float* x; const float* gmod; const float* topp; int pass; const LAS int* tab; const int* list;
    __device__ __forceinline__ int tok_of(int pm, int r) const { const int e = tab[32 + pm]; const int idx = (pm - tab[8 + e]) * 256 + r; return idx < tab[e] ? list[(size_t)e * LIST_CAP + idx] : -1; }
    __device__ __forceinline__ void operator()(const pg8::f32x4 (&acc)[2][2][4][2], const pg8::Unit& u, int wr, int wc, int fr, int fq) const {
        const int col0 = u.pn * 256 + wc * 32 + 4 * fq;
#pragma unroll
        for (int am = 0; am < 4; ++am) {
            const int ai = am >> 1, mb = (am & 1) * 2;
            pg8::f32x4 xl[2][2][2]; float pv[2]; int tok[2];
#pragma unroll
            for (int m = 0; m < 2; ++m) { tok[m] = tok_of(u.pm, ai * 128 + wr * 64 + (mb + m) * 16 + fr); const int t = tok[m] < 0 ? 0 : tok[m]; pv[m] = topp[(size_t)t * 2 + pass];
#pragma unroll
                for (int bj = 0; bj < 2; ++bj)
#pragma unroll
                    for (int n = 0; n < 2; ++n) xl[m][bj][n] = *(const pg8::f32x4*)(x + (size_t)t * D + col0 + bj * 128 + n * 16); }
            asm volatile("" ::: "memory");
#pragma unroll
            for (int m = 0; m < 2; ++m) { if (tok[m] >= 0) { const int t = tok[m]; const float* gb = gmod + (size_t)(t >> 12) * MOD_LD + col0;
#pragma unroll
                for (int bj = 0; bj < 2; ++bj)
#pragma unroll
                    for (int n = 0; n < 2; ++n) { const pg8::f32x4 gv = *(const pg8::f32x4*)(gb + bj * 128 + n * 16);
                        *(pg8::f32x4*)(x + (size_t)t * D + col0 + bj * 128 + n * 16) = xl[m][bj][n] + gv * pv[m] * acc[ai][bj][mb + m][n]; } } }
            asm volatile("" ::: "memory");
        }
    }
};

__device__ __forceinline__ void p_final_norm(Frame& F, float* x, const float* w) {
    const int gw = F.bid * NWAVES + F.wave, NGW = F.G * NWAVES, lane = F.lane;
    f32x4 wv[4];
#pragma unroll
    for (int j = 0; j < 4; ++j) wv[j] = ((const f32x4*)w)[lane + 64 * j];
    for (int r0 = gw * 4; r0 < M; r0 += NGW * 4) {
        f32x4 v[4][4];
#pragma unroll
        for (int r = 0; r < 4; ++r)
#pragma unroll
            for (int j = 0; j < 4; ++j) v[r][j] = ((const f32x4*)(x + (size_t)(r0 + r) * D))[lane + 64 * j];
        asm volatile("" ::: "memory");
#pragma unroll
        for (int r = 0; r < 4; ++r) { float s = 0.f;
#pragma unroll
            for (int j = 0; j < 4; ++j) s += (v[r][j].x * v[r][j].x + v[r][j].y * v[r][j].y) + (v[r][j].z * v[r][j].z + v[r][j].w * v[r][j].w);
            const float rstd = 1.0f / sqrtf(wave_sum(s, lane) * (1.0f / D) + EPS);
#pragma unroll
            for (int j = 0; j < 4; ++j) ((f32x4*)(x + (size_t)(r0 + r) * D))[lane + 64 * j] = v[r][j] * rstd * wv[j]; }
    }
}
__device__ __forceinline__ bool fresh(Frame& F) {
    int w_ = F.w0, b_ = blockIdx.x, g_ = gridDim.x; asm volatile("" : "+s"(w_), "+s"(b_), "+s"(g_));
    int l_; asm volatile("v_mbcnt_lo_u32_b32 %0, -1, 0\n\tv_mbcnt_hi_u32_b32 %0, -1, %0" : "=v"(l_));
    int t_ = w_ * 64 + l_;
    F.tid = t_; F.lane = t_ & 63; F.wave = __builtin_amdgcn_readfirstlane(t_ >> 6); F.bid = b_; F.G = g_; return true;
}
constexpr int NPL = 13, NPHASE = 1 + DEPTH * NPL;
#if MK_PER_PHASE
#define GRID_BAR() do { } while (0)
#else
#define GRID_BAR() do { XcdBarrier b2_ = bar; asm volatile("" : "+s"(b2_.bar)); xcd_barrier(b2_); } while (0)
#endif
#ifdef ONLY_REL
#define IN(k) (KA()->ph_lo <= (k) && (k) < KA()->ph_hi && fresh(F) && ((k) == 0 ? 100 : ((k) - 1) % NPL) == ONLY_REL && (ONLY_L < 0 || ((k) - 1) / NPL == ONLY_L))
#else
#define IN(k) (KA()->ph_lo <= (k) && (k) < KA()->ph_hi && fresh(F))
#endif
#define SEAM(k) do { if ((k) + 1 < KA()->ph_hi) GRID_BAR(); } while (0)
template <int l>
__device__ __forceinline__ void layer_program(Frame& F, const XcdBarrier& bar, PG8_LAS unsigned char* ring) {
        const int pb = 1 + l * NPL;
#define WSP(off) (ka->ws + (off))
#define MODL ((const float*)WSP(WS_MOD) + (size_t)l * BATCH * MOD_LD)
#define WMIXL ((bf16*)WSP(WS_WMIX + (size_t)l * WMIX_STRIDE))
        if (IN(pb + 0)) {
#pragma unroll 1
          for (int rep = 0; rep < REPS(7); ++rep) { KArgs ka = KA(); p_norm(F, l == 0 ? ka->in[0] : (const float*)ka->out, ka->in[4] + l * D, MODL, 1 * D, 0, (bf16*)WSP(WS_H)); }
          SEAM(pb + 0); }
        if (IN(pb + 1)) {
            KArgs ka = KA();
            pg8::Gemm g{(bf16*)WSP(WS_H), WMIXL, D, D, D}; pg8::StaticOrder S; S.init(M / 256, N_BCA / 256, F.G, F.bid);
            pg8::EpiBf16 E{(bf16*)WSP(WS_P1), N_BCA, 1.0f / (float)REPS(8)};
#pragma unroll 1
            for (int rep = 0; rep < REPS(3); ++rep)
            pg8::gemm_phase<REPS(8)>(ring, g, S, E, F.tid); SEAM(pb + 1);
        }
        if (IN(pb + 2)) {
#pragma unroll 1
          for (int rep = 0; rep < REPS(1); ++rep) {
            __syncthreads();
            { KArgs ka = KA(); p_hgrn<1>(F, (const bf16*)WSP(WS_P1), ka->in[8], l, ka->in[9] + l * D_BV, (bf16*)WSP(WS_YB), (float*)WSP(WS_HU), (float*)WSP(WS_HD)); }
            __syncthreads();
            { KArgs ka = KA(); p_sgu(F, (const bf16*)WSP(WS_P1), ka->in[10] + l * D_C, ka->in[11] + (size_t)l * 4 * 128 * 128, ka->in[12] + l * 4 * 128, (bf16*)WSP(WS_YC)); }
            { KArgs ka = KA(); p_conv(F, (const bf16*)WSP(WS_P1), ka->in[7] + l * 3 * D_A, (bf16*)WSP(WS_YA)); }
          }
            SEAM(pb + 2);
        }
        if (IN(pb + 3)) {
#pragma unroll 1
          for (int rep = 0; rep < REPS(2); ++rep)
            { KArgs ka = KA(); p_hgrn<2>(F, (const bf16*)WSP(WS_P1), ka->in[8], l, ka->in[9] + l * D_BV, (bf16*)WSP(WS_YB), (float*)WSP(WS_HU), (float*)WSP(WS_HD)); }
            SEAM(pb + 3);
        }
        if (IN(pb + 4)) {
            KArgs ka = KA();
            pg8::Gemm g{(bf16*)WSP(WS_H), WMIXL + (size_t)N_BCA * D, D, D, D}; pg8::StaticOrder S; S.init(M / 256, N_G / 256, F.G, F.bid);
            pg8::EpiBf16 E{(bf16*)WSP(WS_PG), N_G, 1.0f};
            pg8::gemm_phase(ring, g, S, E, F.tid); SEAM(pb + 4);
        }
        if (IN(pb + 5)) {
#pragma unroll 1
            for (int br = 0; br < 3; ++br) {
                KArgs ka = KA();
                pg8::Gemm g{(bf16*)WSP(WS_YA + (size_t)br * 32 * MiB), WMIXL + (size_t)N_IN * D + (size_t)br * 512 * 1024, 512, 512, 512}; pg8::StaticOrder S; S.init(M / 256, D / 256, F.G, F.bid);
                EpiBranch E{(const bf16*)WSP(WS_PG) + br * D, (bf16*)WSP(WS_MRG), br == 0 ? 1 : 0};
                pg8::gemm_phase(ring, g, S, E, F.tid);
            }
            SEAM(pb + 5);
        }
        if (IN(pb + 6)) {
            KArgs ka = KA();
            pg8::Gemm g{(bf16*)WSP(WS_MRG), WMIXL + (size_t)N_IN * D + 3 * 512 * 1024, D, D, D}; pg8::StaticOrder S; S.init(M / 256, D / 256, F.G, F.bid);
            EpiResid E{l == 0 ? ka->in[0] : (const float*)ka->out, ka->out, MODL + 2 * D};
            pg8::gemm_phase(ring, g, S, E, F.tid); SEAM(pb + 6);
        }
        if (l == 0) {
            if (IN(pb + 7)) { KArgs ka = KA(); p_norm(F, ka->out, ka->in[5] + l * D, MODL, 4 * D, 3 * D, (bf16*)WSP(WS_H)); SEAM(pb + 7); }
            if (IN(pb + 8)) {
                KArgs ka = KA();
                pg8::Gemm g{(bf16*)WSP(WS_H), (bf16*)WSP(WS_W13), D, D, D}; pg8::StaticOrder S; S.init(M / 256, N13 / 256, F.G, F.bid);
                EpiSwiglu E{(bf16*)WSP(WS_ACT)};
                pg8::gemm_phase(ring, g, S, E, F.tid); SEAM(pb + 8);
            }
            if (IN(pb + 9)) {
                KArgs ka = KA();
                pg8::Gemm g{(bf16*)WSP(WS_ACT), (bf16*)WSP(WS_W2), D_FF, D_FF, D_FF}; pg8::StaticOrder S; S.init(M / 256, D / 256, F.G, F.bid);
                EpiResid E{ka->out, ka->out, MODL + 5 * D};
                pg8::gemm_phase(ring, g, S, E, F.tid); SEAM(pb + 9);
            }
        } else {
            if (IN(pb + 7)) {
#pragma unroll 1
                for (int rep = 0; rep < REPS(6); ++rep) { __syncthreads(); p_moe_weights(F, KA()); }
                __syncthreads(); { KArgs ka = KA(); p_norm_router(F, ka, ka->out, ka->in[5] + l * D, MODL, (bf16*)WSP(WS_H2M)); } SEAM(pb + 7); }
#pragma unroll 1
            for (int pass = 0; pass < 2; ++pass) {
#ifndef NO_MOE_UP
                if (IN(pb + 8 + 2 * pass)) {
                    KArgs ka = KA();
                    moe_tables(F, (unsigned*)WSP(WS_CTL), pass);
                    const LAS int* tab = (const LAS int*)(F.lds + TAB_OFF);
                    MoeOrder<true> S; S.so.init(tab[16], N13 / 256, F.G, F.bid); S.tab = tab; S.list = (const int*)WSP(WS_LIST) + (size_t)pass * 8 * LIST_CAP; S.npn = N13 / 256; S.rowbytes = D * 2;
                    pg8::Gemm g{(bf16*)WSP(WS_H2M), (bf16*)WSP(WS_WM13), D, D, D};
                    EpiSwiglu E{(bf16*)WSP(WS_ACTM)};
#pragma unroll 1
                    for (int rep = 0; rep < REPS(4); ++rep)
                    pg8::gemm_phase(ring, g, S, E, F.tid); SEAM(pb + 8 + 2 * pass);
                }
#endif
#ifndef NO_MOE_DOWN
                if (IN(pb + 9 + 2 * pass)) {
                    KArgs ka = KA();
                    moe_tables(F, (unsigned*)WSP(WS_CTL), pass);
                    const LAS int* tab = (const LAS int*)(F.lds + TAB_OFF);
                    MoeOrder<false> S; S.so.init(tab[16], D / 256, F.G, F.bid); S.tab = tab; S.list = (const int*)WSP(WS_LIST) + (size_t)pass * 8 * LIST_CAP; S.npn = D / 256; S.rowbytes = 0;
                    pg8::Gemm g{(bf16*)WSP(WS_ACTM), (bf16*)WSP(WS_WM2), D_FF, D_FF, D_FF};
                    EpiMoeDown E{ka->out, MODL + 5 * D, (const float*)WSP(WS_TOPP), pass, tab, S.list};
                    pg8::gemm_phase(ring, g, S, E, F.tid); SEAM(pb + 9 + 2 * pass);
                }
#endif
            }
            if (IN(pb + 12)) { KArgs ka = KA(); p_final_norm(F, ka->out, ka->in[25]); }
        }
}
__global__ void __launch_bounds__(NT, 2) fwd(Args args) {
    extern __shared__ __attribute__((aligned(16))) unsigned char lds[];
    Frame F;
    F.lds = (LAS unsigned char*)lds;
    F.tid = threadIdx.x; F.lane = F.tid & 63; F.wave = __builtin_amdgcn_readfirstlane(F.tid >> 6); F.w0 = F.wave;
    F.G = gridDim.x; F.bid = blockIdx.x;
    volatile LAS unsigned* MISC = (volatile LAS unsigned*)(F.lds + MISC_OFF);
    if (F.tid < 32) MISC[F.tid] = 0u;
    __syncthreads();
#if !MK_PER_PHASE
    XcdBarrier bar = xcd_barrier_post((unsigned*)(KA()->ws + WS_CTL) + CW_BAR, MISC + 8);
#else
    XcdBarrier bar; bar.bar = nullptr; bar.x = 0; bar.st = nullptr;
#endif
    PG8_LAS unsigned char* ring = (PG8_LAS unsigned char*)lds;

    if (IN(0)) {
#pragma unroll 1
        for (int rep = 0; rep < REPS(5); ++rep) { __syncthreads(); p_prologue(F, KA()); }
        SEAM(0); }

    layer_program<0>(F, bar, ring);
    layer_program<1>(F, bar, ring);
#undef IN
#undef SEAM
}

extern "C" void kernel_launch(void* const* d_in, const int* in_sizes, int n_in, void* d_out, int out_size, void* d_ws, size_t ws_size, hipStream_t stream) {
    static int grid = 0;
    if (grid == 0) {
        if (n_in != 26 || in_sizes[0] != M * D || out_size != M * D || ws_size < WS_NEED) { fprintf(stderr, "kernel_launch: unexpected shapes / workspace (n_in %d, ws %zu, need %zu); nothing launched\n", n_in, ws_size, (size_t)WS_NEED); grid = -1; return; }
        int dev = 0, cus = 0, per_cu = 0;
        if (hipGetDevice(&dev) != hipSuccess || hipDeviceGetAttribute(&cus, hipDeviceAttributeMultiprocessorCount, dev) != hipSuccess) { grid = -1; return; }
        if (hipFuncSetAttribute((const void*)fwd, hipFuncAttributeMaxDynamicSharedMemorySize, LDS_BYTES) != hipSuccess) { fprintf(stderr, "kernel_launch: hipFuncSetAttribute failed\n"); grid = -1; return; }
        if (hipOccupancyMaxActiveBlocksPerMultiprocessor(&per_cu, (const void*)fwd, NT, LDS_BYTES) != hipSuccess || per_cu < 1) fprintf(stderr, "kernel_launch: occupancy query reports %d\n", per_cu);
        (void)hipGetLastError();
        grid = cus;
    }
    if (grid < 0) return;
    if (hipMemsetAsync((char*)d_ws + WS_CTL, 0, CTL_ZERO_BYTES, stream) != hipSuccess) return;
    Args a{};
    for (int i = 0; i < 26; ++i) a.in[i] = (const float*)d_in[i];
    a.out = (float*)d_out; a.ws = (unsigned char*)d_ws;
#if MK_PER_PHASE
    for (int p = 0; p < NPHASE; ++p) {
        if (p >= 1 + 10 && p <= 1 + 12) continue;
        a.ph_lo = p; a.ph_hi = p + 1;
        hipLaunchKernelGGL(fwd, dim3(grid), dim3(NT), LDS_BYTES, stream, a);
    }
#else
    a.ph_lo = 0; a.ph_hi = NPHASE;
    hipLaunchKernelGGL(fwd, dim3(grid), dim3(NT), LDS_BYTES, stream, a);
#endif
}
```

```cpp
#include <hip/hip_runtime.h>
#include <cstdio>
#include <cstdint>

#ifndef PROBE_DUP
#define PROBE_DUP 0
#endif
#ifndef PROBE_REPS
#define PROBE_REPS 2
#endif
#define REPS(k) ((PROBE_DUP == (k)) ? PROBE_REPS : 1)
#ifndef MK_PER_PHASE
#define MK_PER_PHASE 0
#endif

namespace pg8 {
#define PG8_LAS __attribute__((address_space(3)))
typedef unsigned short bf16_t;
typedef short bf16x8 __attribute__((ext_vector_type(8)));
typedef float f32x4 __attribute__((ext_vector_type(4)));
typedef unsigned u32x4 __attribute__((ext_vector_type(4)));
constexpr int BM = 256, BK = 64, HALF = 128, HTB = HALF * BK * 2, STAGE_BYTES = 8 * HTB, NXCD = 8, WGM = 8;

__host__ __device__ __forceinline__ int lds_byte(int r, int c) { const int st = (r >> 4) * 2 + (c >> 5), rr = r & 15, cc = c & 31, ob = rr * 64 + cc * 2; return st * 1024 + (ob ^ (((ob >> 9) & 1) << 5)); }
__host__ __device__ __forceinline__ void stage_rc(int b, int& R, int& C) { const int st = b / 1024, sb = b % 1024, swz = sb ^ (((sb >> 9) & 1) << 5); R = (st >> 1) * 16 + swz / 64; C = (st & 1) * 32 + (swz % 64) / 2; }
__host__ __device__ __forceinline__ int perm32(int rho) { const int n = rho >> 4, i = rho & 15; return 8 * (i >> 2) + 4 * n + (i & 3); }

struct Unit { int pm, pn, pb; };
struct Gemm { const bf16_t* A; const bf16_t* Bt; int lda, ldb, K; };

struct StaticOrder {
    static constexpr bool GATHER = false;
    int nM, nN, nwg, G, c;
    __device__ __forceinline__ void init(int nM_, int nN_, int G_, int c_) { nM = nM_; nN = nN_; nwg = nM * nN; G = G_; c = c_; }
    __device__ __forceinline__ bool next(int i, Unit& u) const {
        const long L = (long)i * G + c; if (L >= nwg) return false;
        int wgid = (int)L; { const int q = nwg / NXCD, r = nwg % NXCD, xcd = wgid % NXCD, off = wgid / NXCD; wgid = (xcd < r ? xcd * (q + 1) : r * (q + 1) + (xcd - r) * q) + off; }
        const int nig = WGM * nN, gid = wgid / nig, fm = gid * WGM, gsz = (nM - fm) < WGM ? (nM - fm) : WGM;
        u.pm = fm + ((wgid % nig) % gsz); u.pn = (wgid % nig) / gsz; u.pb = u.pn; return true;
    }
    __device__ __forceinline__ unsigned a_row_off(const Unit&, int) const { return 0u; }
};

__device__ __forceinline__ unsigned cvt_pk_bf16(float lo, float hi) { unsigned r; asm volatile("v_cvt_pk_bf16_f32 %0, %1, %2" : "=v"(r) : "v"(lo), "v"(hi)); return r; }

struct EpiBf16 {
    static constexpr bool PERM = true;
    bf16_t* O; int ldc; float scale;
    __device__ __forceinline__ void operator()(const f32x4 (&acc)[2][2][4][2], const Unit& u, int wr, int wc, int fr, int fq) const {
        const int row0 = u.pm * BM + wr * 64 + fr, col0 = u.pn * BM + wc * 32 + 8 * fq;
#pragma unroll
        for (int ai = 0; ai < 2; ++ai)
#pragma unroll
            for (int m = 0; m < 4; ++m) { bf16_t* rowp = O + (size_t)(row0 + ai * HALF + m * 16) * ldc + col0;
#pragma unroll
                for (int bj = 0; bj < 2; ++bj) { const f32x4 v0 = acc[ai][bj][m][0] * scale, v1 = acc[ai][bj][m][1] * scale;
                    u32x4 w; w.x = cvt_pk_bf16(v0[0], v0[1]); w.y = cvt_pk_bf16(v0[2], v0[3]); w.z = cvt_pk_bf16(v1[0], v1[1]); w.w = cvt_pk_bf16(v1[2], v1[3]);
                    *(u32x4*)(rowp + bj * HALF) = w; } }
    }
};

template <int KREP = 1, class Epi, class Sched>
__device__ __forceinline__ void gemm_phase(PG8_LAS unsigned char* lds, const Gemm g, const Sched& S, const Epi& E, int tid_in) {
    constexpr bool GATHER = Sched::GATHER;
    int tid_ = tid_in; asm volatile("" : "+v"(tid_));
    const int tid = tid_, wid = __builtin_amdgcn_readfirstlane(tid >> 6), lane = tid & 63, wr = wid >> 2, wc = wid & 3, fr = lane & 15, fq = lane >> 4;
    const int K = g.K, nt = K / BK;
    unsigned voffB[2], vA0[2], vA1[2], nA0[2], nA1[2];
#pragma unroll
    for (int i = 0; i < 2; ++i) { int R, C; stage_rc(tid * 16 + i * 8192, R, C); const int Rb = Epi::PERM ? ((R & ~31) + perm32(R & 31)) : R;
        voffB[i] = (unsigned)(Rb * g.ldb + C) * 2u;
        vA0[i] = (unsigned)(R * g.lda + C) * 2u; vA1[i] = vA0[i]; nA0[i] = vA0[i]; nA1[i] = vA0[i]; }
    const size_t kstep = (size_t)(BK * 2);
    const size_t hstepB = (size_t)HALF * g.ldb * 2, tstepB = 2 * hstepB, tstepA = (size_t)BM * g.lda * 2;
    const size_t hstepA = GATHER ? (size_t)0 : (size_t)HALF * g.lda * 2;
    const unsigned ldsw = (unsigned)wid * 1024u;
    const int aoff = lds_byte(wr * 64 + fr, fq * 8), boff = lds_byte(wc * 32 + fr, fq * 8);
#define PG8_SA(b, h) (((b) * 2 + (h)) * HTB)
#define PG8_SB(b, h) ((4 + (b) * 2 + (h)) * HTB)
#define PG8_STAGE(bufoff, gbase, voff) do { _Pragma("unroll") for (int _i = 0; _i < 2; ++_i) \
        __builtin_amdgcn_global_load_lds((const unsigned*)((const char*)(gbase) + (voff)[_i]), (PG8_LAS unsigned*)(lds + (bufoff) + ldsw + _i * 8192), 16, 0, 0); } while (0)
#define PG8_LDA(dst, b, h) do { _Pragma("unroll") for (int m = 0; m < 4; ++m) _Pragma("unroll") for (int k = 0; k < 2; ++k) dst[m][k] = *(const PG8_LAS bf16x8*)(lds + PG8_SA(b, h) + aoff + m * 2048 + k * 1024); } while (0)
#define PG8_LDB(dst, b, h) do { _Pragma("unroll") for (int n = 0; n < 2; ++n) _Pragma("unroll") for (int k = 0; k < 2; ++k) dst[n][k] = *(const PG8_LAS bf16x8*)(lds + PG8_SB(b, h) + boff + n * 2048 + k * 1024); } while (0)
#define PG8_MMA(ai, bj, At, Bt) do { __builtin_amdgcn_s_setprio(1); _Pragma("unroll") for (int m = 0; m < 4; ++m) _Pragma("unroll") for (int n = 0; n < 2; ++n) _Pragma("unroll") for (int k = 0; k < 2; ++k) \
        acc[ai][bj][m][n] = __builtin_amdgcn_mfma_f32_16x16x32_bf16(Bt[n][k], At[m][k], acc[ai][bj][m][n], 0, 0, 0); __builtin_amdgcn_s_setprio(0); } while (0)
#define PG8_WAIT_V(n) asm volatile("s_waitcnt vmcnt(" #n ")" ::: "memory")
#define PG8_WAIT_L(n) asm volatile("s_waitcnt lgkmcnt(" #n ")" ::: "memory")
#define PG8_BAR __builtin_amdgcn_s_barrier()
#define PG8_SCHED __builtin_amdgcn_sched_barrier(0)
#define PG8_GOFF(unit, d0, d1) do { _Pragma("unroll") for (int _i = 0; _i < 2; ++_i) { int R_, C_; stage_rc(tid * 16 + _i * 8192, R_, C_); \
        d0[_i] = S.a_row_off(unit, R_) + (unsigned)C_ * 2u; d1[_i] = S.a_row_off(unit, R_ + HALF) + (unsigned)C_ * 2u; } } while (0)
    Unit cur, nxt; int ui = 0;
    if (!S.next(0, cur)) return;
    f32x4 acc[2][2][4][2];
#pragma unroll
    for (int a = 0; a < 2; ++a)
#pragma unroll
        for (int b = 0; b < 2; ++b)
#pragma unroll
            for (int m = 0; m < 4; ++m)
#pragma unroll
                for (int n = 0; n < 2; ++n) acc[a][b][m][n] = (f32x4){0.f, 0.f, 0.f, 0.f};
    bf16x8 At[4][2], B0[2][2], B1[2][2];
    if constexpr (GATHER) { PG8_GOFF(cur, vA0, vA1); }
    const char* cA = GATHER ? (const char*)g.A : (const char*)g.A + (size_t)cur.pm * tstepA; const char* cB = (const char*)g.Bt + (size_t)cur.pb * tstepB;
    PG8_STAGE(PG8_SB(0, 0), cB, voffB); PG8_STAGE(PG8_SB(0, 1), cB + hstepB, voffB); PG8_STAGE(PG8_SA(0, 0), cA, vA0); PG8_STAGE(PG8_SA(0, 1), cA + hstepA, vA1);
    if (wr == 1) PG8_BAR;
    PG8_WAIT_V(2); PG8_BAR;
    PG8_STAGE(PG8_SB(1, 0), cB + kstep, voffB); PG8_STAGE(PG8_SA(1, 0), cA + kstep, vA0); PG8_STAGE(PG8_SB(1, 1), cB + hstepB + kstep, voffB);
    PG8_WAIT_V(6); PG8_BAR;
    for (;;) {
        const bool has_next = S.next(ui + 1, nxt);
        const char* nA = GATHER ? (const char*)g.A : (has_next ? (const char*)g.A + (size_t)nxt.pm * tstepA : cA); const char* nB = has_next ? (const char*)g.Bt + (size_t)nxt.pb * tstepB : cB;
        if constexpr (GATHER) { if (has_next) { PG8_GOFF(nxt, nA0, nA1); } else {
#pragma unroll
            for (int i = 0; i < 2; ++i) { nA0[i] = vA0[i]; nA1[i] = vA1[i]; } } }
        for (int t = 0; t < nt * KREP; t += 2) {
            const bool last = (t == nt * KREP - 2);
            const int t1 = (KREP == 1) ? t + 1 : ((t + 1) & (nt - 1)), t2 = (KREP == 1) ? t + 2 : ((t + 2) & (nt - 1));
            const char* a1 = cA + (size_t)t1 * kstep;
            const char* a2 = last ? nA : cA + (size_t)t2 * kstep; const char* b2 = last ? nB : cB + (size_t)t2 * kstep;
            const char* a3 = a2 + kstep; const char* b3 = b2 + kstep;
            unsigned s0[2], s1[2];
#pragma unroll
            for (int i = 0; i < 2; ++i) { s0[i] = (GATHER && last) ? nA0[i] : vA0[i]; s1[i] = GATHER ? (last ? nA1[i] : vA1[i]) : vA0[i]; }
            PG8_LDB(B0, 0, 0); PG8_LDB(B1, 0, 1); PG8_SCHED; PG8_LDA(At, 0, 0); PG8_STAGE(PG8_SA(1, 1), a1 + hstepA, vA1);
            PG8_WAIT_V(8); PG8_WAIT_L(0); PG8_BAR; PG8_MMA(0, 0, At, B0); PG8_MMA(0, 1, At, B1); PG8_BAR; PG8_SCHED;
            PG8_LDA(At, 0, 1); PG8_STAGE(PG8_SB(0, 0), b2, voffB); PG8_STAGE(PG8_SB(0, 1), b2 + hstepB, voffB); PG8_STAGE(PG8_SA(0, 0), a2, s0);
            PG8_WAIT_V(8); PG8_WAIT_L(0); PG8_BAR; PG8_MMA(1, 0, At, B0); PG8_MMA(1, 1, At, B1); PG8_BAR; PG8_SCHED;
            PG8_LDB(B0, 1, 0); PG8_LDB(B1, 1, 1); PG8_SCHED; PG8_LDA(At, 1, 0); PG8_STAGE(PG8_SA(0, 1), a2 + hstepA, s1);
            PG8_WAIT_V(8); PG8_WAIT_L(0); PG8_BAR; PG8_MMA(0, 0, At, B0); PG8_MMA(0, 1, At, B1); PG8_BAR; PG8_SCHED;
            PG8_LDA(At, 1, 1); PG8_STAGE(PG8_SB(1, 0), b3, voffB); PG8_STAGE(PG8_SB(1, 1), b3 + hstepB, voffB); PG8_STAGE(PG8_SA(1, 0), a3, s0);
            PG8_WAIT_V(8); PG8_WAIT_L(0); PG8_BAR; PG8_MMA(1, 0, At, B0); PG8_MMA(1, 1, At, B1); PG8_BAR; PG8_SCHED;
        }
        if (wr == 0) PG8_BAR;
        E(acc, cur, wr, wc, fr, fq);
        if (!has_next) break;
#pragma unroll
        for (int a = 0; a < 2; ++a)
#pragma unroll
            for (int b = 0; b < 2; ++b)
#pragma unroll
                for (int m = 0; m < 4; ++m)
#pragma unroll
                    for (int n = 0; n < 2; ++n) acc[a][b][m][n] = (f32x4){0.f, 0.f, 0.f, 0.f};
        cur = nxt; cA = nA; cB = nB; ++ui;
        if constexpr (GATHER) {
#pragma unroll
            for (int i = 0; i < 2; ++i) { vA0[i] = nA0[i]; vA1[i] = nA1[i]; } }
        if (wr == 1) PG8_BAR;
    }
    PG8_WAIT_V(0);
    PG8_BAR;
#undef PG8_SA
#undef PG8_SB
#undef PG8_STAGE
#undef PG8_LDA
#undef PG8_LDB
#undef PG8_MMA
#undef PG8_WAIT_V
#undef PG8_WAIT_L
#undef PG8_BAR
#undef PG8_SCHED
#undef PG8_GOFF
}
}

constexpr int D = 1024, BATCH = 8, SEQ = 4096, M = BATCH * SEQ, DEPTH = 2;
constexpr int D_A = 512, D_BK = 512, D_BV = 512, D_C = 512, H_B = 4;
constexpr int N_IN = 7680, N_BCA = 4608, N_G = 3072;
constexpr int D_FF = 2816, NE = 8, N13 = 2 * D_FF;
constexpr int MOD_LD = 6 * D;
constexpr float EPS = 1e-6f;
constexpr int LIST_CAP = M;
constexpr int MOE_ROWS = M + NE * 256;

constexpr size_t MiB = 1u << 20;
constexpr size_t WS_CTL = 0, CTL_ZERO_BYTES = 1 * MiB;
constexpr size_t WS_MOD = 1 * MiB;
constexpr size_t WS_TOPP = 2 * MiB;
constexpr size_t WS_LIST = 3 * MiB;
constexpr size_t WS_WMIX = 6 * MiB, WMIX_STRIDE = 20 * MiB;
constexpr size_t WS_W13 = 46 * MiB, WS_W2 = 57 * MiB;
constexpr size_t WS_BIG = 64 * MiB;
constexpr size_t WS_H = WS_BIG;
constexpr size_t WS_P1 = WS_BIG + 64 * MiB;
constexpr size_t WS_PG = WS_P1;
constexpr size_t WS_MRG = WS_P1 + 192 * MiB;
constexpr size_t WS_YA = WS_P1 + 288 * MiB, WS_YB = WS_YA + 32 * MiB, WS_YC = WS_YB + 32 * MiB;
constexpr size_t WS_ACT = WS_P1;
constexpr size_t WS_HU = WS_YC + 32 * MiB;
constexpr size_t WS_HD = WS_HU + 16 * MiB;
constexpr size_t WS_MIX_END = WS_HD + 1 * MiB;
constexpr size_t WS_WM13 = 6 * MiB;
constexpr size_t WS_WM2 = WS_WM13 + 88 * MiB;
constexpr size_t WS_H2M = WS_WM2 + 44 * MiB;
constexpr size_t WS_ACTM = WS_H2M + 64 * MiB;
constexpr size_t WS_MOE_END = WS_ACTM + (size_t)MOE_ROWS * D_FF * 2;
constexpr size_t WS_NEED = WS_MIX_END > WS_MOE_END ? WS_MIX_END : WS_MOE_END;
static_assert(WS_W2 + (size_t)D * D_FF * 2 <= WS_BIG && WS_WMIX + 2 * WMIX_STRIDE <= WS_W13, "ws map");
constexpr int CW_BAR = 4096;
constexpr int CW_CNT = 16384;

constexpr int LDS_BYTES = 147456;
constexpr int SCR_BYTES = 139264;
constexpr int TAB_OFF = SCR_BYTES;
constexpr int MISC_OFF = TAB_OFF + 4096;
static_assert(MISC_OFF + 128 <= LDS_BYTES, "LDS map");
constexpr int NWAVES = 8, NT = 512;

#define GAS __attribute__((address_space(1)))
#define LAS __attribute__((address_space(3)))
typedef unsigned short bf16;
typedef unsigned v4u __attribute__((ext_vector_type(4)));
typedef float f32x4 __attribute__((ext_vector_type(4)));
#define LDS_WAIT() asm volatile("s_waitcnt lgkmcnt(0)" ::: "memory")

typedef float f32x2_t __attribute__((ext_vector_type(2)));
typedef __bf16 bf16x2_t __attribute__((ext_vector_type(2)));
__device__ __forceinline__ unsigned pk2(float lo, float hi) { f32x2_t v = {lo, hi}; bf16x2_t b = __builtin_convertvector(v, bf16x2_t); return __builtin_bit_cast(unsigned, b); }
__device__ __forceinline__ float bf_lo(unsigned u) { return __uint_as_float(u << 16); }
__device__ __forceinline__ float bf_hi(unsigned u) { return __uint_as_float(u & 0xffff0000u); }
__device__ __forceinline__ void unpack8(const v4u w, float (&f)[8]) { f[0] = bf_lo(w.x); f[1] = bf_hi(w.x); f[2] = bf_lo(w.y); f[3] = bf_hi(w.y); f[4] = bf_lo(w.z); f[5] = bf_hi(w.z); f[6] = bf_lo(w.w); f[7] = bf_hi(w.w); }
__device__ __forceinline__ v4u pack8(const float (&f)[8]) { v4u w; w.x = pk2(f[0], f[1]); w.y = pk2(f[2], f[3]); w.z = pk2(f[4], f[5]); w.w = pk2(f[6], f[7]); return w; }
__device__ __forceinline__ float sigmoidf_(float x) { return __builtin_amdgcn_rcpf(1.0f + __expf(-x)); }
__device__ __forceinline__ float siluf_(float x) { return x * sigmoidf_(x); }
__device__ __forceinline__ float shx(float v, int mask, int lane) { return __int_as_float(__builtin_amdgcn_ds_bpermute((lane ^ mask) << 2, __float_as_int(v))); }
__device__ __forceinline__ float shl(float v, int src) { return __int_as_float(__builtin_amdgcn_ds_bpermute(src << 2, __float_as_int(v))); }
__device__ __forceinline__ float wave_sum(float v, int lane) {
#pragma unroll
    for (int o = 1; o < 64; o <<= 1) v += shx(v, o, lane);
    return v;
}

#define XB_TMO      128
#define XB_XCNT(j)  (256  + 64 * (j))
#define XB_XSUB(j)  (1280 + 64 * (j))
#define XB_XGEN(j)  (2304 + 64 * (j))
#define XB_TOP      3328
#define XB_TOPGEN   3392
#define XCD_BAR_WORDS 3456
#define XB_SPIN_CAP (1u << 18)

__device__ __forceinline__ unsigned xb_ld(unsigned* p)              { return __hip_atomic_load(p, __ATOMIC_RELAXED, __HIP_MEMORY_SCOPE_AGENT); }
__device__ __forceinline__ unsigned xb_add(unsigned* p, unsigned v) { return __hip_atomic_fetch_add(p, v, __ATOMIC_RELAXED, __HIP_MEMORY_SCOPE_AGENT); }
__device__ __forceinline__ unsigned xb_xcc_id() { return (unsigned)__builtin_amdgcn_s_getreg((3 << 11) | 20) & 0xFu; }
#define XB_SPIN(cond, bar) do { unsigned _sp = 0; while (cond) { __builtin_amdgcn_s_sleep(1); \
    if ((++_sp & 255u) == 0u) { if (xb_ld(&(bar)[XB_TMO])) break; if (_sp > XB_SPIN_CAP) { atomicAdd(&(bar)[XB_TMO], 1u); break; } } } } while (0)

struct XcdBarrier { unsigned* bar; unsigned x; volatile LAS unsigned* st; };

__device__ __forceinline__ XcdBarrier xcd_barrier_post(unsigned* bar, volatile LAS unsigned* st) {
    XcdBarrier b; b.bar = bar; b.x = xb_xcc_id(); b.st = st;
    if (threadIdx.x == 0) (void)xb_add(&bar[XB_XCNT(b.x)], 1u);
    return b;
}
__device__ __forceinline__ void xcd_barrier_complete(unsigned* bar, unsigned x, unsigned& nloc, unsigned& nx) {
    const unsigned G = gridDim.x * gridDim.y * gridDim.z;
    unsigned sum, cnt, mine, sp = 0u;
    for (;;) {
        sum = 0u; cnt = 0u; mine = 0u;
        unsigned cv[16];
#pragma unroll
        for (unsigned j = 0; j < 16; ++j) cv[j] = xb_ld(&bar[XB_XCNT(j)]);
        asm volatile("" ::: "memory");
#pragma unroll
        for (unsigned j = 0; j < 16; ++j) { const unsigned c = cv[j]; sum += c; cnt += (c > 0u) ? 1u : 0u; mine = (j == x) ? c : mine; }
        if (sum == G) break;
        __builtin_amdgcn_s_sleep(1);
        if ((++sp & 255u) == 0u) { if (xb_ld(&bar[XB_TMO])) break; if (sp > XB_SPIN_CAP) { atomicAdd(&bar[XB_TMO], 1u); break; } }
    }
    nloc = mine > 0u ? mine : 1u; nx = cnt > 0u ? cnt : 1u;
}
__device__ __forceinline__ void xcd_barrier(const XcdBarrier& b) {
    asm volatile("s_waitcnt vmcnt(0)" ::: "memory");
    __syncthreads();
    if (threadIdx.x == 0) {
        unsigned* bar = b.bar;
        __builtin_amdgcn_s_waitcnt(0);
        unsigned nloc = b.st[0], nx = b.st[1];
        if (nloc == 0u) { xcd_barrier_complete(bar, b.x, nloc, nx); b.st[0] = nloc; b.st[1] = nx; }
        const unsigned old = xb_add(&bar[XB_XSUB(b.x)], 1u);
        const unsigned gen = old / nloc;
        if (old + 1u == (gen + 1u) * nloc) {
            __builtin_amdgcn_fence(__ATOMIC_RELEASE, "agent");
            asm volatile("s_waitcnt vmcnt(0)" ::: "memory");
            const unsigned og = xb_add(&bar[XB_TOP], 1u);
            const unsigned tg = og / nx;
            if (og + 1u == (tg + 1u) * nx) xb_add(&bar[XB_TOPGEN], 1u);
            else XB_SPIN(xb_ld(&bar[XB_TOPGEN]) == tg, bar);
            __builtin_amdgcn_fence(__ATOMIC_ACQUIRE, "agent");
            xb_add(&bar[XB_XGEN(b.x)], 1u);
            asm volatile("s_waitcnt vmcnt(0)" ::: "memory");
        } else {
            XB_SPIN(xb_ld(&bar[XB_XGEN(b.x)]) == gen, bar);
            __builtin_amdgcn_fence(__ATOMIC_ACQUIRE, "agent");
            asm volatile("s_waitcnt vmcnt(0)" ::: "memory");
        }
    }
    __syncthreads();
}

struct Args { const float* in[26]; float* out; unsigned char* ws; int ph_lo, ph_hi; };
typedef const Args __attribute__((address_space(4)))* KArgs;
#define KA() ({ KArgs p_ = (KArgs)__builtin_amdgcn_kernarg_segment_ptr(); asm volatile("" : "+s"(p_)); p_; })
struct Frame {
    LAS unsigned char* lds;
    int tid, lane, wave, G, bid;
    int w0;
};

template <int MAP>
__device__ __forceinline__ void transpose_item(const float* W, int K, int N, bf16* WT, int row_off, LAS float* scr, int item, int lane) {
    const int nblk = N / 32, kb = item / nblk, nb = item % nblk, k0 = 64 * kb, n0 = 32 * nb;
    float vld[32];
#pragma unroll
    for (int i = 0; i < 32; ++i) vld[i] = W[(size_t)(k0 + 2 * i + (lane >> 5)) * N + n0 + (lane & 31)];
    asm volatile("" ::: "memory");
#pragma unroll
    for (int i = 0; i < 32; ++i) scr[(2 * i + (lane >> 5)) * 33 + (lane & 31)] = vld[i];
    LDS_WAIT(); asm volatile("" ::: "memory");
    const int c = lane & 7;
#pragma unroll
    for (int j = 0; j < 4; ++j) { const int n = (lane >> 3) + 8 * j; const LAS float* s = scr + (8 * c) * 33 + n;
        v4u o; o.x = pk2(s[0 * 33], s[1 * 33]); o.y = pk2(s[2 * 33], s[3 * 33]); o.z = pk2(s[4 * 33], s[5 * 33]); o.w = pk2(s[6 * 33], s[7 * 33]);
        const int nn = n0 + n; const int row = (MAP == 0) ? (row_off + nn) : ((nn >> 7) * 256 + row_off + (nn & 127));
        *(v4u*)(WT + (size_t)row * K + k0 + 8 * c) = o; }
    LDS_WAIT(); asm volatile("" ::: "memory");
}

__device__ __forceinline__ void p_prologue(Frame& F, KArgs ka) {
    const float* c = ka->in[1]; const float* ada_w = ka->in[2]; const float* ada_b = ka->in[3];
    unsigned char* aws = ka->ws; float* mod = (float*)(aws + WS_MOD);
    LAS float* cact = (LAS float*)F.lds;
    LAS float* red = cact + 8192;
    for (int i = F.tid; i < BATCH * D; i += NT) cact[i] = siluf_(c[i]);
    __syncthreads();
    for (int chunk = F.bid; chunk < 256; chunk += F.G) {
        const int l = chunk >> 7, n0 = (chunk & 127) * 48;
        if (F.tid < 480) {
            const int kg = F.tid / 48, col = F.tid % 48;
            float acc[8];
#pragma unroll
            for (int b = 0; b < 8; ++b) acc[b] = 0.f;
            const float* wp = ada_w + (size_t)l * D * MOD_LD + n0 + col;
            for (int k = kg; k < D; k += 10) { const float w = wp[(size_t)k * MOD_LD];
#pragma unroll
                for (int b = 0; b < 8; ++b) acc[b] += cact[b * D + k] * w; }
#pragma unroll
            for (int b = 0; b < 8; ++b) red[(kg * 48 + col) * 8 + b] = acc[b];
        }
        __syncthreads();
        if (F.tid < 384) {
            const int col = F.tid >> 3, b = F.tid & 7; float s = 0.f;
#pragma unroll
            for (int kg = 0; kg < 10; ++kg) s += red[(kg * 48 + col) * 8 + b];
            mod[(size_t)(l * 8 + b) * MOD_LD + n0 + col] = s + ada_b[l * MOD_LD + n0 + col];
        }
        __syncthreads();
    }
    LAS float* scr = (LAS float*)(F.lds + F.wave * 16384);
    const int gw = F.bid * NWAVES + F.wave, NGW = F.G * NWAVES;
    constexpr int I_IN = (D / 64) * (N_IN / 32), I_BR = (512 / 64) * (D / 32), I_O = (D / 64) * (D / 32), I_L = I_IN + 3 * I_BR + I_O;
    constexpr int I_F1 = (D / 64) * (D_FF / 32), I_F2 = (D_FF / 64) * (D / 32);
    constexpr int NITEMS = 2 * I_L + 2 * I_F1 + I_F2;
    for (int it = gw; it < NITEMS; it += NGW) {
        int r = it;
        if (r < 2 * I_L) {
            const int l = r / I_L; r -= l * I_L;
            bf16* base = (bf16*)(aws + WS_WMIX + (size_t)l * WMIX_STRIDE);
            if (r < I_IN) { transpose_item<0>(ka->in[6] + (size_t)l * D * N_IN, D, N_IN, base, 0, scr, r, F.lane); continue; } r -= I_IN;
            if (r < I_BR) { transpose_item<0>(ka->in[13] + (size_t)l * 512 * D, 512, D, base + (size_t)N_IN * D, 0, scr, r, F.lane); continue; } r -= I_BR;
            if (r < I_BR) { transpose_item<0>(ka->in[14] + (size_t)l * 512 * D, 512, D, base + (size_t)N_IN * D + 512 * 1024, 0, scr, r, F.lane); continue; } r -= I_BR;
            if (r < I_BR) { transpose_item<0>(ka->in[15] + (size_t)l * 512 * D, 512, D, base + (size_t)N_IN * D + 2 * 512 * 1024, 0, scr, r, F.lane); continue; } r -= I_BR;
            transpose_item<0>(ka->in[16] + (size_t)l * D * D, D, D, base + (size_t)N_IN * D + 3 * 512 * 1024, 0, scr, r, F.lane); continue;
        }
        r -= 2 * I_L;
        if (r < I_F1) { transpose_item<1>(ka->in[17], D, D_FF, (bf16*)(aws + WS_W13), 0, scr, r, F.lane); continue; } r -= I_F1;
        if (r < I_F1) { transpose_item<1>(ka->in[18], D, D_FF, (bf16*)(aws + WS_W13), 128, scr, r, F.lane); continue; } r -= I_F1;
        transpose_item<0>(ka->in[19], D_FF, D, (bf16*)(aws + WS_W2), 0, scr, r, F.lane);
    }
}
__device__ __forceinline__ void p_moe_weights(Frame& F, KArgs ka) {
    unsigned char* aws = ka->ws;
    LAS float* scr = (LAS float*)(F.lds + F.wave * 16384);
    const int gw = F.bid * NWAVES + F.wave, NGW = F.G * NWAVES;
    constexpr int I_F1 = (D / 64) * (D_FF / 32), I_F2 = (D_FF / 64) * (D / 32), I_E = 2 * I_F1 + I_F2;
    for (int it = gw; it < NE * I_E; it += NGW) {
        const int e = it / I_E; int r = it - e * I_E;
        bf16* w13 = (bf16*)(aws + WS_WM13) + (size_t)e * N13 * D; bf16* w2 = (bf16*)(aws + WS_WM2) + (size_t)e * D * D_FF;
        if (r < I_F1) { transpose_item<1>(ka->in[22] + (size_t)e * D * D_FF, D, D_FF, w13, 0, scr, r, F.lane); continue; } r -= I_F1;
        if (r < I_F1) { transpose_item<1>(ka->in[23] + (size_t)e * D * D_FF, D, D_FF, w13, 128, scr, r, F.lane); continue; } r -= I_F1;
        transpose_item<0>(ka->in[24] + (size_t)e * D_FF * D, D_FF, D, w2, 0, scr, r, F.lane);
    }
}

__device__ __forceinline__ void norm_row(const float* xrow, const float* w, const float* sc, const float* sh, int lane, f32x4 (&o)[4]) {
    const f32x4* xr = (const f32x4*)xrow + lane;
    f32x4 v[4]; float s = 0.f;
#pragma unroll
    for (int j = 0; j < 4; ++j) { v[j] = xr[64 * j]; s += (v[j].x * v[j].x + v[j].y * v[j].y) + (v[j].z * v[j].z + v[j].w * v[j].w); }
    const float rstd = 1.0f / sqrtf(wave_sum(s, lane) * (1.0f / D) + EPS);
#pragma unroll
    for (int j = 0; j < 4; ++j) { const f32x4 wv = ((const f32x4*)w)[lane + 64 * j], scv = ((const f32x4*)sc)[lane + 64 * j], shv = ((const f32x4*)sh)[lane + 64 * j];
        o[j] = v[j] * rstd * wv * (scv + 1.0f) + shv; }
}
__device__ __forceinline__ void store_row_bf16(bf16* orow, int lane, const f32x4 (&o)[4]) {
    unsigned long long* o8 = (unsigned long long*)orow + lane;
#pragma unroll
    for (int j = 0; j < 4; ++j) o8[64 * j] = (unsigned long long)pk2(o[j].x, o[j].y) | ((unsigned long long)pk2(o[j].z, o[j].w) << 32);
}
__device__ __forceinline__ void p_norm(Frame& F, const float* xin, const float* w, const float* mod_l, int sc_off, int sh_off, bf16* hout) {
    const int gw = F.bid * NWAVES + F.wave, NGW = F.G * NWAVES, lane = F.lane;
    f32x4 wv[4];
#pragma unroll
    for (int j = 0; j < 4; ++j) wv[j] = ((const f32x4*)w)[lane + 64 * j];
    for (int r0 = gw * 4; r0 < M; r0 += NGW * 4) {
        const float* mb = mod_l + (size_t)(r0 >> 12) * MOD_LD;
        f32x4 v[4][4], scv[4], shv[4];
#pragma unroll
        for (int r = 0; r < 4; ++r)
#pragma unroll
            for (int j = 0; j < 4; ++j) v[r][j] = ((const f32x4*)(xin + (size_t)(r0 + r) * D))[lane + 64 * j];
#pragma unroll
        for (int j = 0; j < 4; ++j) { scv[j] = ((const f32x4*)(mb + sc_off))[lane + 64 * j]; shv[j] = ((const f32x4*)(mb + sh_off))[lane + 64 * j]; }
        asm volatile("" ::: "memory");
#pragma unroll
        for (int j = 0; j < 4; ++j) scv[j] = wv[j] * (scv[j] + 1.0f);
#pragma unroll
        for (int r = 0; r < 4; ++r) { float s = 0.f;
#pragma unroll
            for (int j = 0; j < 4; ++j) s += (v[r][j].x * v[r][j].x + v[r][j].y * v[r][j].y) + (v[r][j].z * v[r][j].z + v[r][j].w * v[r][j].w);
            const float rstd = 1.0f / sqrtf(wave_sum(s, lane) * (1.0f / D) + EPS);
            f32x4 o[4];
#pragma unroll
            for (int j = 0; j < 4; ++j) o[j] = v[r][j] * rstd * scv[j] + shv[j];
            store_row_bf16(hout + (size_t)(r0 + r) * D, lane, o); }
    }
}

__device__ __forceinline__ void p_conv(Frame& F, const bf16* P1, const float* conv_w, bf16* ya) {
    const int gt = F.bid * NT + F.tid, NGT = F.G * NT;
    for (int it = gt; it < M * 64; it += NGT) {
        const int row = it >> 6, c8 = (it & 63) * 8, pos = row & (SEQ - 1);
        const bf16* p = P1 + (size_t)row * N_BCA + c8;
        float ab[8], ac[8], ah[8], z1[8], z2[8], y[8];
        unpack8(*(const v4u*)p, ab); unpack8(*(const v4u*)(p + 512), ac); unpack8(*(const v4u*)(p + 1024), ah);
#pragma unroll
        for (int i = 0; i < 8; ++i) { z1[i] = 0.f; z2[i] = 0.f; }
        if (pos >= 1) { float c1[8], h1[8]; unpack8(*(const v4u*)(p - N_BCA + 512), c1); unpack8(*(const v4u*)(p - N_BCA + 1024), h1);
#pragma unroll
            for (int i = 0; i < 8; ++i) z1[i] = c1[i] * h1[i]; }
        if (pos >= 2) { float c2[8], h2[8]; unpack8(*(const v4u*)(p - 2 * N_BCA + 512), c2); unpack8(*(const v4u*)(p - 2 * N_BCA + 1024), h2);
#pragma unroll
            for (int i = 0; i < 8; ++i) z2[i] = c2[i] * h2[i]; }
#pragma unroll
        for (int i = 0; i < 8; ++i) y[i] = ab[i] * (conv_w[c8 + i] * (ac[i] * ah[i]) + conv_w[512 + c8 + i] * z1[i] + conv_w[1024 + c8 + i] * z2[i]);
        *(v4u*)(ya + (size_t)row * 512 + c8) = pack8(y);
    }
}

typedef short v4i16_t __attribute__((ext_vector_type(4)));
typedef short bf16x8_t __attribute__((ext_vector_type(8)));
typedef unsigned v2u __attribute__((ext_vector_type(2)));
constexpr int HRS = 272;
constexpr int TRS = 80;
constexpr int H_RAWQ = 0, H_RAWF = 8704, H_V = 17408, H_QHT = 26112, H_KTT = 36352, H_KHT = 46592, H_DL = 56832, H_OB = 57344, H_OBS = 132;
constexpr int HSEG = 512, HNSEG = SEQ / HSEG, HCH = 32;
__device__ __forceinline__ v4i16_t tr_read(LAS unsigned char* p) { return __builtin_amdgcn_ds_read_tr16_b64_v4i16((LAS v4i16_t*)p); }
__device__ __forceinline__ bf16x8_t cat4(v4i16_t lo, v4i16_t hi) { return __builtin_shufflevector(lo, hi, 0, 1, 2, 3, 4, 5, 6, 7); }
__device__ __forceinline__ bf16x8_t pack_acc(const f32x4 a, const f32x4 b) { v4u w; w.x = pk2(a[0], a[1]); w.y = pk2(a[2], a[3]); w.z = pk2(b[0], b[1]); w.w = pk2(b[2], b[3]); return __builtin_bit_cast(bf16x8_t, w); }
__device__ __forceinline__ float bfs(short x) { return __uint_as_float((unsigned)(unsigned short)x << 16); }
template <int PASS>
__device__ __forceinline__ void p_hgrn(Frame& F, const bf16* P1, const float* lb_logits, int layer, const float* norm_w, bf16* yb, float* ust, float* dst) {
    LAS unsigned char* L = F.lds;
    const int lane = F.lane, w = F.wave, g = lane >> 4, n = lane & 15, q_ = n >> 2, p_ = n & 3;
    const int pt = F.tid >> 4, pc8 = (F.tid & 15) * 8;
    for (int u = F.bid; u < BATCH * H_B * HNSEG; u += F.G) {
        const int seg = u & (HNSEG - 1), bh = u / HNSEG, b = bh >> 2, h = bh & 3;
        const int d = 16 * w + n;
        float lb; { const int ch = h * 128 + d; const float l0 = lb_logits[ch], l1 = lb_logits[512 + ch]; const float mx = fmaxf(l0, l1);
            const float e0 = expf(l0 - mx), e1 = expf(l1 - mx); const float p0 = e0 / (e0 + e1), p1 = e1 / (e0 + e1);
            const float lbx = (layer == 0) ? (p0 - p0) : ((p0 + p1) - p0); lb = fminf(fmaxf(lbx, 0.f), 1.f); }
        const float lbf = fmaxf(lb, 1e-30f), oml = 1.0f - lb;
        f32x4 S[8];
#pragma unroll
        for (int kt = 0; kt < 8; ++kt) S[kt] = (f32x4){0.f, 0.f, 0.f, 0.f};
        if (PASS == 2) {
            for (int j = 0; j < seg; ++j) { const int uj = u - seg + j;
#pragma unroll
                for (int kt = 0; kt < 8; ++kt) { const f32x4 dj = *(const f32x4*)(dst + (size_t)uj * 128 + 16 * kt + 4 * g); const f32x4 uu = *(const f32x4*)(ust + ((((size_t)uj * 8 + w) * 8 + kt) * 64 + lane) * 4);
                    S[kt] = dj * S[kt] + uu; } }
        }
        float nw8[8];
        if (PASS == 2) {
#pragma unroll
            for (int i = 0; i < 8; ++i) nw8[i] = norm_w[h * 128 + pc8 + i]; }
        float dprod = 1.0f;
        const bf16* gp = P1 + ((size_t)b * SEQ + (size_t)seg * HSEG + pt) * N_BCA + 1536 + h * 128 + pc8;
        v4u rq, rf, rv, rg;
        rf = *(const v4u*)(gp + 512); rv = *(const v4u*)(gp + 1024);
        if (PASS == 2) { rq = *(const v4u*)gp; rg = *(const v4u*)(gp + 1536); }
        for (int c = 0; c < HSEG / HCH; ++c) {
            *(LAS v4u*)(L + H_RAWF + pt * HRS + pc8 * 2) = rf; *(LAS v4u*)(L + H_V + pt * HRS + pc8 * 2) = rv;
            if (PASS == 2) *(LAS v4u*)(L + H_RAWQ + pt * HRS + pc8 * 2) = rq;
            v4u cg; if (PASS == 2) cg = rg;
            __syncthreads();
            if (c + 1 < HSEG / HCH) { const bf16* np = gp + (size_t)(c + 1) * HCH * N_BCA; rf = *(const v4u*)(np + 512); rv = *(const v4u*)(np + 1024);
                if (PASS == 2) { rq = *(const v4u*)np; rg = *(const v4u*)(np + 1536); } }
            { const bf16x8_t f8 = cat4(tr_read(L + H_RAWF + (8 * g + q_) * HRS + 32 * w + 8 * p_), tr_read(L + H_RAWF + (8 * g + 4 + q_) * HRS + 32 * w + 8 * p_));
              float eb[8], kk[8]; float cp = 1.0f;
#pragma unroll
              for (int i = 0; i < 8; ++i) { const float sg = __builtin_amdgcn_rcpf(1.0f + __expf(-bfs(f8[i]))); const float f = lbf + oml * sg; kk[i] = oml * (1.0f - sg); cp *= f; eb[i] = cp; }
              const float s1 = shl(cp, n), s2 = shl(cp, 16 + n), s3 = shl(cp, 32 + n), s4 = shl(cp, 48 + n);
              const float pre = (g > 0 ? s1 : 1.0f) * (g > 1 ? s2 : 1.0f) * (g > 2 ? s3 : 1.0f);
              const float elast = ((s1 * s2) * s3) * s4;
              float kh[8], kt8[8];
#pragma unroll
              for (int i = 0; i < 8; ++i) { eb[i] *= pre; const float en = __builtin_amdgcn_rcpf(fmaxf(eb[i], 1e-30f)); kt8[i] = kk[i] * en; kh[i] = kt8[i] * elast; }
              *(LAS v4u*)(L + H_KHT + d * TRS + 16 * g) = pack8(kh);
              if (PASS == 2) { const bf16x8_t q8 = cat4(tr_read(L + H_RAWQ + (8 * g + q_) * HRS + 32 * w + 8 * p_), tr_read(L + H_RAWQ + (8 * g + 4 + q_) * HRS + 32 * w + 8 * p_));
                  float qh[8];
#pragma unroll
                  for (int i = 0; i < 8; ++i) qh[i] = siluf_(bfs(q8[i])) * eb[i];
                  *(LAS v4u*)(L + H_QHT + d * TRS + 16 * g) = pack8(qh); *(LAS v4u*)(L + H_KTT + d * TRS + 16 * g) = pack8(kt8); }
              if (g == 0) *(LAS float*)(L + H_DL + 4 * d) = elast;
              dprod *= elast; }
            __syncthreads();
            const bf16x8_t bVn = cat4(tr_read(L + H_V + (8 * g + q_) * HRS + 32 * w + 8 * p_), tr_read(L + H_V + (8 * g + 4 + q_) * HRS + 32 * w + 8 * p_));
            if (PASS == 2) {
                const bf16x8_t bVp = cat4(tr_read(L + H_V + (4 * g + q_) * HRS + 32 * w + 8 * p_), tr_read(L + H_V + (16 + 4 * g + q_) * HRS + 32 * w + 8 * p_));
                f32x4 o[2], pt00 = {0.f, 0.f, 0.f, 0.f}, pt01 = {0.f, 0.f, 0.f, 0.f}, pt11 = {0.f, 0.f, 0.f, 0.f};
                o[0] = (f32x4){0.f, 0.f, 0.f, 0.f}; o[1] = (f32x4){0.f, 0.f, 0.f, 0.f};
#pragma unroll
                for (int ks = 0; ks < 4; ++ks) {
                    const bf16x8_t sb = pack_acc(S[2 * ks], S[2 * ks + 1]);
#pragma unroll
                    for (int tm = 0; tm < 2; ++tm) {
                        const bf16x8_t aq = cat4(tr_read(L + H_QHT + (32 * ks + 4 * g + q_) * TRS + 32 * tm + 8 * p_), tr_read(L + H_QHT + (32 * ks + 16 + 4 * g + q_) * TRS + 32 * tm + 8 * p_));
                        o[tm] = __builtin_amdgcn_mfma_f32_16x16x32_bf16(aq, sb, o[tm], 0, 0, 0); }
                    const bf16x8_t aK0 = cat4(tr_read(L + H_KTT + (32 * ks + 8 * g + q_) * TRS + 8 * p_), tr_read(L + H_KTT + (32 * ks + 8 * g + 4 + q_) * TRS + 8 * p_));
                    const bf16x8_t aK1 = cat4(tr_read(L + H_KTT + (32 * ks + 8 * g + q_) * TRS + 32 + 8 * p_), tr_read(L + H_KTT + (32 * ks + 8 * g + 4 + q_) * TRS + 32 + 8 * p_));
                    const bf16x8_t bQ0 = cat4(tr_read(L + H_QHT + (32 * ks + 8 * g + q_) * TRS + 8 * p_), tr_read(L + H_QHT + (32 * ks + 8 * g + 4 + q_) * TRS + 8 * p_));
                    const bf16x8_t bQ1 = cat4(tr_read(L + H_QHT + (32 * ks + 8 * g + q_) * TRS + 32 + 8 * p_), tr_read(L + H_QHT + (32 * ks + 8 * g + 4 + q_) * TRS + 32 + 8 * p_));
                    pt00 = __builtin_amdgcn_mfma_f32_16x16x32_bf16(aK0, bQ0, pt00, 0, 0, 0);
                    pt01 = __builtin_amdgcn_mfma_f32_16x16x32_bf16(aK0, bQ1, pt01, 0, 0, 0);
                    pt11 = __builtin_amdgcn_mfma_f32_16x16x32_bf16(aK1, bQ1, pt11, 0, 0, 0);
                }
#pragma unroll
                for (int j = 0; j < 4; ++j) if (4 * g + j > n) { pt00[j] = 0.f; pt11[j] = 0.f; }
                const f32x4 z4 = {0.f, 0.f, 0.f, 0.f};
                o[0] = __builtin_amdgcn_mfma_f32_16x16x32_bf16(pack_acc(pt00, z4), bVp, o[0], 0, 0, 0);
                o[1] = __builtin_amdgcn_mfma_f32_16x16x32_bf16(pack_acc(pt01, pt11), bVp, o[1], 0, 0, 0);
#pragma unroll
                for (int tm = 0; tm < 2; ++tm)
#pragma unroll
                    for (int j = 0; j < 4; ++j) *(LAS float*)(L + H_OB + ((16 * tm + 4 * g + j) * H_OBS + 16 * w + n) * 4) = o[tm][j];
            }
#pragma unroll
            for (int kt = 0; kt < 8; ++kt) { const f32x4 dl4 = *(const LAS f32x4*)(L + H_DL + (16 * kt + 4 * g) * 4);
                const bf16x8_t aKh = *(const LAS bf16x8_t*)(L + H_KHT + (16 * kt + n) * TRS + 16 * g);
                S[kt] = __builtin_amdgcn_mfma_f32_16x16x32_bf16(aKh, bVn, S[kt] * dl4, 0, 0, 0); }
            __syncthreads();
            if (PASS == 2) {
                const f32x4 o0 = *(const LAS f32x4*)(L + H_OB + (pt * H_OBS + pc8) * 4), o1 = *(const LAS f32x4*)(L + H_OB + (pt * H_OBS + pc8 + 4) * 4);
                const float o8[8] = {o0.x, o0.y, o0.z, o0.w, o1.x, o1.y, o1.z, o1.w};
                float ss = 0.f;
#pragma unroll
                for (int i = 0; i < 8; ++i) ss += o8[i] * o8[i];
                ss += shx(ss, 1, lane); ss += shx(ss, 2, lane); ss += shx(ss, 4, lane); ss += shx(ss, 8, lane);
                const float rs = 1.0f / sqrtf(ss * (1.0f / 128.0f) + EPS);
                float g8[8], y[8]; unpack8(cg, g8);
#pragma unroll
                for (int i = 0; i < 8; ++i) y[i] = o8[i] * rs * nw8[i] * siluf_(g8[i]);
                *(v4u*)(yb + ((size_t)b * SEQ + (size_t)seg * HSEG + (size_t)c * HCH + pt) * 512 + h * 128 + pc8) = pack8(y);
            }
        }
        if (PASS == 1) {
#pragma unroll
            for (int kt = 0; kt < 8; ++kt) *(f32x4*)(ust + ((((size_t)u * 8 + w) * 8 + kt) * 64 + lane) * 4) = S[kt];
            if (g == 0) dst[(size_t)u * 128 + d] = dprod;
        }
        __syncthreads();
    }
}

constexpr int SG_V = 0, SG_OB = 34816, SG_OBS = 132, SG_RS = SG_OB + 128 * SG_OBS * 4;
__device__ __forceinline__ void p_sgu(Frame& F, const bf16* P1, const float* norm_w, const float* sgu_w, const float* sgu_b, bf16* yc) {
    LAS unsigned char* L = F.lds;
    const int lane = F.lane, w = F.wave, gq = lane >> 4, n = lane & 15, q_ = n >> 2, p_ = n & 3;
    const int sr = F.tid >> 4, c8 = (F.tid & 15) * 8;
    for (int u = F.bid; u < M / 128; u += F.G) {
        const size_t row0 = (size_t)u * 128;
        v4u rv[4][4]; float ssj[4] = {0.f, 0.f, 0.f, 0.f};
#pragma unroll
        for (int g = 0; g < 4; ++g)
#pragma unroll
            for (int j = 0; j < 4; ++j) { rv[g][j] = *(const v4u*)(P1 + (row0 + sr + 32 * j) * N_BCA + 4096 + g * 128 + c8); float f[8]; unpack8(rv[g][j], f);
#pragma unroll
                for (int i = 0; i < 8; ++i) ssj[j] += f[i] * f[i]; }
#pragma unroll
        for (int j = 0; j < 4; ++j) { float ss = ssj[j]; ss += shx(ss, 1, lane); ss += shx(ss, 2, lane); ss += shx(ss, 4, lane); ss += shx(ss, 8, lane);
            if (n == 0) *(LAS float*)(L + SG_RS + 4 * (sr + 32 * j)) = 1.0f / sqrtf(ss * (1.0f / 512.0f) + EPS); }
#pragma unroll
        for (int g = 0; g < 4; ++g) {
#pragma unroll
            for (int j = 0; j < 4; ++j) *(LAS v4u*)(L + SG_V + (sr + 32 * j) * HRS + c8 * 2) = rv[g][j];
            __syncthreads();
            float nwv[8];
            const int kmax = w >> 1, t = 16 * w + n;
            bf16x8_t aW[4];
            { f32x4 wl[4][2]; float nwl[8];
#pragma unroll
              for (int ks = 0; ks < 4; ++ks) { const float* wp = sgu_w + ((size_t)g * 128 + t) * 128 + 32 * ks + 8 * gq; wl[ks][0] = *(const f32x4*)wp; wl[ks][1] = *(const f32x4*)(wp + 4); }
#pragma unroll
              for (int ct = 0; ct < 8; ++ct) nwl[ct] = norm_w[g * 128 + 16 * ct + n];
              asm volatile("" ::: "memory");
#pragma unroll
              for (int ct = 0; ct < 8; ++ct) nwv[ct] = nwl[ct];
#pragma unroll
              for (int ks = 0; ks < 4; ++ks) { const int s0 = 32 * ks + 8 * gq;
                    const f32x4 w0 = wl[ks][0], w1 = wl[ks][1]; const f32x4 r0 = *(const LAS f32x4*)(L + SG_RS + 4 * s0), r1 = *(const LAS f32x4*)(L + SG_RS + 4 * (s0 + 4));
                    float a8[8] = {w0.x * r0.x, w0.y * r0.y, w0.z * r0.z, w0.w * r0.w, w1.x * r1.x, w1.y * r1.y, w1.z * r1.z, w1.w * r1.w};
#pragma unroll
                    for (int i = 0; i < 8; ++i) if (s0 + i > t) a8[i] = 0.f;
                    aW[ks] = __builtin_bit_cast(bf16x8_t, pack8(a8)); } }
            f32x4 acc[8];
#pragma unroll
            for (int ct = 0; ct < 8; ++ct) acc[ct] = (f32x4){0.f, 0.f, 0.f, 0.f};
#pragma unroll
            for (int ks = 0; ks < 4; ++ks) { if (ks <= kmax) {
#pragma unroll
                for (int ct = 0; ct < 8; ++ct) { const bf16x8_t bV = cat4(tr_read(L + SG_V + (32 * ks + 8 * gq + q_) * HRS + 32 * ct + 8 * p_), tr_read(L + SG_V + (32 * ks + 8 * gq + 4 + q_) * HRS + 32 * ct + 8 * p_));
                    acc[ct] = __builtin_amdgcn_mfma_f32_16x16x32_bf16(aW[ks], bV, acc[ct], 0, 0, 0); } } }
#pragma unroll
            for (int ct = 0; ct < 8; ++ct) { const float nw = nwv[ct];
#pragma unroll
                for (int j = 0; j < 4; ++j) *(LAS float*)(L + SG_OB + ((16 * w + 4 * gq + j) * SG_OBS + 16 * ct + n) * 4) = acc[ct][j] * nw; }
            __syncthreads();
            v4u ul[4]; float bl[4];
#pragma unroll
            for (int j = 0; j < 4; ++j) { ul[j] = *(const v4u*)(P1 + (row0 + sr + 32 * j) * N_BCA + 3584 + g * 128 + c8); bl[j] = sgu_b[g * 128 + sr + 32 * j]; }
            asm volatile("" ::: "memory");
#pragma unroll
            for (int j = 0; j < 4; ++j) { const int tt = sr + 32 * j; const float bias = bl[j];
                const f32x4 o0 = *(const LAS f32x4*)(L + SG_OB + (tt * SG_OBS + c8) * 4), o1 = *(const LAS f32x4*)(L + SG_OB + (tt * SG_OBS + c8 + 4) * 4);
                float uu[8], y[8]; unpack8(ul[j], uu);
                y[0] = (o0.x + bias) * uu[0]; y[1] = (o0.y + bias) * uu[1]; y[2] = (o0.z + bias) * uu[2]; y[3] = (o0.w + bias) * uu[3];
                y[4] = (o1.x + bias) * uu[4]; y[5] = (o1.y + bias) * uu[5]; y[6] = (o1.z + bias) * uu[6]; y[7] = (o1.w + bias) * uu[7];
                *(v4u*)(yc + (row0 + tt) * 512 + g * 128 + c8) = pack8(y); }
        }
        __syncthreads();
    }
}

__device__ __forceinline__ void p_norm_router(Frame& F, KArgs ka, const float* x, const float* w, const float* mod_l, bf16* h2) {
    const float* rw = ka->in[20]; const float* rb = ka->in[21]; unsigned* ctl = (unsigned*)(ka->ws + WS_CTL);
    float* topp = (float*)(ka->ws + WS_TOPP); int* list = (int*)(ka->ws + WS_LIST);
    LAS float* RWt = (LAS float*)F.lds;
    LAS int* lcnt = (LAS int*)(RWt + 8192);
    LAS int* lbase = lcnt + 16;
    LAS int* sel = lbase + 16;
    LAS int* rnk = sel + 128;
    for (int i = F.tid; i < D * NE; i += NT) { const int k = i >> 3, e = i & 7; RWt[e * D + k] = rw[i]; }
    __syncthreads();
    float rbv[8];
#pragma unroll
    for (int e = 0; e < 8; ++e) rbv[e] = rb[e];
    f32x4 wv[4];
#pragma unroll
    for (int j = 0; j < 4; ++j) wv[j] = ((const f32x4*)w)[F.lane + 64 * j];
    for (int batch = F.bid; batch < M / 128; batch += F.G) {
        const int row0 = batch * 128;
        if (F.tid < 16) lcnt[F.tid] = 0;
        const float* mb = mod_l + (size_t)(row0 >> 12) * MOD_LD;
        f32x4 scv[4], shv[4], xn[4];
#pragma unroll
        for (int j = 0; j < 4; ++j) { scv[j] = ((const f32x4*)(mb + 4 * D))[F.lane + 64 * j]; shv[j] = ((const f32x4*)(mb + 3 * D))[F.lane + 64 * j]; xn[j] = ((const f32x4*)(x + (size_t)(row0 + F.wave * 16) * D))[F.lane + 64 * j]; }
        asm volatile("" ::: "memory");
#pragma unroll
        for (int j = 0; j < 4; ++j) scv[j] = wv[j] * (scv[j] + 1.0f);
        __syncthreads();
        for (int rr = 0; rr < 16; ++rr) {
            const int r = F.wave * 16 + rr, row = row0 + r;
            f32x4 v[4];
#pragma unroll
            for (int j = 0; j < 4; ++j) v[j] = xn[j];
            if (rr + 1 < 16) {
#pragma unroll
                for (int j = 0; j < 4; ++j) xn[j] = ((const f32x4*)(x + (size_t)(row + 1) * D))[F.lane + 64 * j]; }
            float ssq = 0.f;
#pragma unroll
            for (int j = 0; j < 4; ++j) ssq += (v[j].x * v[j].x + v[j].y * v[j].y) + (v[j].z * v[j].z + v[j].w * v[j].w);
            const float rstd = 1.0f / sqrtf(wave_sum(ssq, F.lane) * (1.0f / D) + EPS);
            f32x4 o[4];
#pragma unroll
            for (int j = 0; j < 4; ++j) o[j] = v[j] * rstd * scv[j] + shv[j];
            store_row_bf16(h2 + (size_t)row * D, F.lane, o);
            float lg[8];
#pragma unroll
            for (int e = 0; e < 8; ++e) { float s = 0.f;
#pragma unroll
                for (int j = 0; j < 4; ++j) { const f32x4 r4 = *(const LAS f32x4*)(RWt + e * D + 4 * F.lane + 256 * j); s += (o[j].x * r4.x + o[j].y * r4.y) + (o[j].z * r4.z + o[j].w * r4.w); }
                lg[e] = wave_sum(s, F.lane) + rbv[e]; }
            int i0 = 0; float v0 = lg[0];
#pragma unroll
            for (int e = 1; e < 8; ++e) if (lg[e] > v0) { v0 = lg[e]; i0 = e; }
            int i1 = -1; float v1 = -3.0e38f;
#pragma unroll
            for (int e = 0; e < 8; ++e) if (e != i0 && lg[e] > v1) { v1 = lg[e]; i1 = e; }
            if (F.lane == 0) {
                const float p0 = 1.0f / (1.0f + expf(v1 - v0));
                topp[(size_t)row * 2] = p0; topp[(size_t)row * 2 + 1] = 1.0f - p0;
                const int rk0 = __hip_atomic_fetch_add(lcnt + i0, 1, __ATOMIC_RELAXED, __HIP_MEMORY_SCOPE_WORKGROUP), rk1 = __hip_atomic_fetch_add(lcnt + 8 + i1, 1, __ATOMIC_RELAXED, __HIP_MEMORY_SCOPE_WORKGROUP);
                sel[r] = i0 | (i1 << 8); rnk[r] = rk0 | (rk1 << 16);
            }
        }
        __syncthreads();
        if (F.tid < 16) lbase[F.tid] = (int)__hip_atomic_fetch_add(ctl + CW_CNT + 64 * F.tid, (unsigned)lcnt[F.tid], __ATOMIC_RELAXED, __HIP_MEMORY_SCOPE_AGENT);
        __syncthreads();
        if (F.tid < 128) { const int sv = sel[F.tid], rv = rnk[F.tid]; const int e0 = sv & 255, e1 = sv >> 8;
            list[(size_t)e0 * LIST_CAP + lbase[e0] + (rv & 0xffff)] = row0 + F.tid;
            list[(size_t)(8 + e1) * LIST_CAP + lbase[8 + e1] + (rv >> 16)] = row0 + F.tid; }
        __syncthreads();
    }
}
__device__ __forceinline__ void moe_tables(Frame& F, unsigned* ctl, int pass) {
    LAS int* tab = (LAS int*)(F.lds + TAB_OFF);
    __syncthreads();
    if (F.tid == 0) { int pb = 0;
        for (int e = 0; e < 8; ++e) { int c = (int)__hip_atomic_load(ctl + CW_CNT + 64 * (pass * 8 + e), __ATOMIC_RELAXED, __HIP_MEMORY_SCOPE_AGENT); if (c > LIST_CAP) c = LIST_CAP; if (c < 0) c = 0;
            const int np = (c + 255) >> 8; tab[e] = c; tab[8 + e] = pb; for (int p = 0; p < np; ++p) tab[32 + pb + p] = e; pb += np; }
        tab[16] = pb; }
    __syncthreads();
}
template <bool GATHER_>
struct MoeOrder {
    static constexpr bool GATHER = GATHER_;
    pg8::StaticOrder so; const LAS int* tab; const int* list; int npn; unsigned rowbytes;
    __device__ __forceinline__ bool next(int i, pg8::Unit& u) const { if (!so.next(i, u)) return false; u.pb = tab[32 + u.pm] * npn + u.pn; return true; }
    __device__ __forceinline__ int tok_of(int pm, int r) const { const int e = tab[32 + pm]; const int idx = (pm - tab[8 + e]) * 256 + r; return idx < tab[e] ? list[(size_t)e * LIST_CAP + idx] : -1; }
    __device__ __forceinline__ unsigned a_row_off(const pg8::Unit& u, int r) const { const int t = tok_of(u.pm, r); return (unsigned)(t < 0 ? 0 : t) * rowbytes; }
};

struct EpiBranch {
    static constexpr bool PERM = true;
    const bf16* gate; bf16* mrg; int first;
    __device__ __forceinline__ void operator()(const pg8::f32x4 (&acc)[2][2][4][2], const pg8::Unit& u, int wr, int wc, int fr, int fq) const {
        const int row0 = u.pm * 256 + wr * 64 + fr, col0 = u.pn * 256 + wc * 32 + 8 * fq;
#pragma unroll
        for (int ai = 0; ai < 2; ++ai) {
            v4u gl[4][2], ml[4][2];
#pragma unroll
            for (int m = 0; m < 4; ++m)
#pragma unroll
                for (int bj = 0; bj < 2; ++bj) { const size_t row = (size_t)(row0 + ai * 128 + m * 16); const int col = col0 + bj * 128;
                    gl[m][bj] = *(const v4u*)(gate + row * N_G + col); ml[m][bj] = first ? (v4u){0u, 0u, 0u, 0u} : *(const v4u*)(mrg + row * D + col); }
            asm volatile("" ::: "memory");
#pragma unroll
            for (int m = 0; m < 4; ++m)
#pragma unroll
                for (int bj = 0; bj < 2; ++bj) { const size_t row = (size_t)(row0 + ai * 128 + m * 16); const int col = col0 + bj * 128;
                    float gg[8], mm[8], o[8]; unpack8(gl[m][bj], gg); unpack8(ml[m][bj], mm);
                    const pg8::f32x4 v0 = acc[ai][bj][m][0], v1 = acc[ai][bj][m][1];
                    o[0] = mm[0] + sigmoidf_(gg[0]) * v0[0]; o[1] = mm[1] + sigmoidf_(gg[1]) * v0[1]; o[2] = mm[2] + sigmoidf_(gg[2]) * v0[2]; o[3] = mm[3] + sigmoidf_(gg[3]) * v0[3];
                    o[4] = mm[4] + sigmoidf_(gg[4]) * v1[0]; o[5] = mm[5] + sigmoidf_(gg[5]) * v1[1]; o[6] = mm[6] + sigmoidf_(gg[6]) * v1[2]; o[7] = mm[7] + sigmoidf_(gg[7]) * v1[3];
                    *(v4u*)(mrg + row * D + col) = pack8(o); }
            asm volatile("" ::: "memory");
        }
    }
};
struct EpiResid {
    static constexpr bool PERM = false;
    const float* xin; float* xout; const float* gmod;
    __device__ __forceinline__ void operator()(const pg8::f32x4 (&acc)[2][2][4][2], const pg8::Unit& u, int wr, int wc, int fr, int fq) const {
        const int row0 = u.pm * 256 + wr * 64 + fr, col0 = u.pn * 256 + wc * 32 + 4 * fq;
        const float* gb = gmod + (size_t)((u.pm * 256) >> 12) * MOD_LD + col0;
        pg8::f32x4 gv[2][2];
#pragma unroll
        for (int bj = 0; bj < 2; ++bj)
#pragma unroll
            for (int n = 0; n < 2; ++n) gv[bj][n] = *(const pg8::f32x4*)(gb + bj * 128 + n * 16);
#pragma unroll
        for (int ai = 0; ai < 2; ++ai) {
            pg8::f32x4 xl[4][2][2];
#pragma unroll
            for (int m = 0; m < 4; ++m)
#pragma unroll
                for (int bj = 0; bj < 2; ++bj)
#pragma unroll
                    for (int n = 0; n < 2; ++n) xl[m][bj][n] = *(const pg8::f32x4*)(xin + (size_t)(row0 + ai * 128 + m * 16) * D + col0 + bj * 128 + n * 16);
            asm volatile("" ::: "memory");
#pragma unroll
            for (int m = 0; m < 4; ++m)
#pragma unroll
                for (int bj = 0; bj < 2; ++bj)
#pragma unroll
                    for (int n = 0; n < 2; ++n) *(pg8::f32x4*)(xout + (size_t)(row0 + ai * 128 + m * 16) * D + col0 + bj * 128 + n * 16) = xl[m][bj][n] + gv[bj][n] * acc[ai][bj][m][n];
            asm volatile("" ::: "memory");
        }
    }
};
struct EpiSwiglu {
    static constexpr bool PERM = true;
    bf16* act;
    __device__ __forceinline__ void operator()(const pg8::f32x4 (&acc)[2][2][4][2], const pg8::Unit& u, int wr, int wc, int fr, int fq) const {
        const int row0 = u.pm * 256 + wr * 64 + fr, col0 = u.pn * 128 + wc * 32 + 8 * fq;
#pragma unroll
        for (int ai = 0; ai < 2; ++ai)
#pragma unroll
            for (int m = 0; m < 4; ++m) { float o[8];
#pragma unroll
                for (int n = 0; n < 2; ++n)
#pragma unroll
                    for (int i = 0; i < 4; ++i) o[n * 4 + i] = siluf_(acc[ai][0][m][n][i]) * acc[ai][1][m][n][i];
                *(v4u*)(act + (size_t)(row0 + ai * 128 + m * 16) * D_FF + col0) = pack8(o); }
    }
};
struct EpiMoeDown {
    static constexpr bool PERM = false;
    float* x; const float* gmod; const float* topp; int pass; const LAS int* tab; const int* list;
    __device__ __forceinline__ int tok_of(int pm, int r) const { const int e = tab[32 + pm]; const int idx = (pm - tab[8 + e]) * 256 + r; return idx < tab[e] ? list[(size_t)e * LIST_CAP + idx] : -1; }
    __device__ __forceinline__ void operator()(const pg8::f32x4 (&acc)[2][2][4][2], const pg8::Unit& u, int wr, int wc, int fr, int fq) const {
        const int col0 = u.pn * 256 + wc * 32 + 4 * fq;
        int tok[2][4];
#pragma unroll
        for (int ai = 0; ai < 2; ++ai)
#pragma unroll
            for (int m = 0; m < 4; ++m) tok[ai][m] = tok_of(u.pm, ai * 128 + wr * 64 + m * 16 + fr);
        asm volatile("" ::: "memory");
#pragma unroll
        for (int am = 0; am < 4; ++am) {
            const int ai = am >> 1, mb = (am & 1) * 2;
            pg8::f32x4 xl[2][2][2], gl[2][2][2]; float pv[2];
#pragma unroll
            for (int m = 0; m < 2; ++m) { const int t = tok[ai][mb + m] < 0 ? 0 : tok[ai][mb + m]; pv[m] = topp[(size_t)t * 2 + pass]; const float* gb = gmod + (size_t)(t >> 12) * MOD_LD + col0;
#pragma unroll
                for (int bj = 0; bj < 2; ++bj)
#pragma unroll
                    for (int n = 0; n < 2; ++n) { xl[m][bj][n] = *(const pg8::f32x4*)(x + (size_t)t * D + col0 + bj * 128 + n * 16); gl[m][bj][n] = *(const pg8::f32x4*)(gb + bj * 128 + n * 16); } }
            asm volatile("" ::: "memory");
#pragma unroll
            for (int m = 0; m < 2; ++m) { if (tok[ai][mb + m] >= 0) { const int t = tok[ai][mb + m];
#pragma unroll
                for (int bj = 0; bj < 2; ++bj)
#pragma unroll
                    for (int n = 0; n < 2; ++n) *(pg8::f32x4*)(x + (size_t)t * D + col0 + bj * 128 + n * 16) = xl[m][bj][n] + gl[m][bj][n] * pv[m] * acc[ai][bj][mb + m][n]; } }
            asm volatile("" ::: "memory");
        }
    }
};

__device__ __forceinline__ void p_final_norm(Frame& F, float* x, const float* w) {
    const int gw = F.bid * NWAVES + F.wave, NGW = F.G * NWAVES, lane = F.lane;
    f32x4 wv[4];
#pragma unroll
    for (int j = 0; j < 4; ++j) wv[j] = ((const f32x4*)w)[lane + 64 * j];
    for (int r0 = gw * 4; r0 < M; r0 += NGW * 4) {
        f32x4 v[4][4];
#pragma unroll
        for (int r = 0; r < 4; ++r)
#pragma unroll
            for (int j = 0; j < 4; ++j) v[r][j] = ((const f32x4*)(x + (size_t)(r0 + r) * D))[lane + 64 * j];
        asm volatile("" ::: "memory");
#pragma unroll
        for (int r = 0; r < 4; ++r) { float s = 0.f;
#pragma unroll
            for (int j = 0; j < 4; ++j) s += (v[r][j].x * v[r][j].x + v[r][j].y * v[r][j].y) + (v[r][j].z * v[r][j].z + v[r][j].w * v[r][j].w);
            const float rstd = 1.0f / sqrtf(wave_sum(s, lane) * (1.0f / D) + EPS);
#pragma unroll
            for (int j = 0; j < 4; ++j) ((f32x4*)(x + (size_t)(r0 + r) * D))[lane + 64 * j] = v[r][j] * rstd * wv[j]; }
    }
}
__device__ __forceinline__ bool fresh(Frame& F) {
    int w_ = F.w0, b_ = blockIdx.x, g_ = gridDim.x; asm volatile("" : "+s"(w_), "+s"(b_), "+s"(g_));
    int l_; asm volatile("v_mbcnt_lo_u32_b32 %0, -1, 0\n\tv_mbcnt_hi_u32_b32 %0, -1, %0" : "=v"(l_));
    int t_ = w_ * 64 + l_;
    F.tid = t_; F.lane = t_ & 63; F.wave = __builtin_amdgcn_readfirstlane(t_ >> 6); F.bid = b_; F.G = g_; return true;
}
constexpr int NPL = 13, NPHASE = 1 + DEPTH * NPL;
#if MK_PER_PHASE
#define GRID_BAR() do { } while (0)
#else
#define GRID_BAR() do { XcdBarrier b2_ = bar; asm volatile("" : "+s"(b2_.bar)); xcd_barrier(b2_); } while (0)
#endif
#ifdef ONLY_REL
#define IN(k) (KA()->ph_lo <= (k) && (k) < KA()->ph_hi && fresh(F) && ((k) == 0 ? 100 : ((k) - 1) % NPL) == ONLY_REL && (ONLY_L < 0 || ((k) - 1) / NPL == ONLY_L))
#else
#define IN(k) (KA()->ph_lo <= (k) && (k) < KA()->ph_hi && fresh(F))
#endif
#define SEAM(k) do { if ((k) + 1 < KA()->ph_hi) GRID_BAR(); } while (0)
template <int l>
__device__ __forceinline__ void layer_program(Frame& F, const XcdBarrier& bar, PG8_LAS unsigned char* ring) {
        const int pb = 1 + l * NPL;
#define WSP(off) (ka->ws + (off))
#define MODL ((const float*)WSP(WS_MOD) + (size_t)l * BATCH * MOD_LD)
#define WMIXL ((bf16*)WSP(WS_WMIX + (size_t)l * WMIX_STRIDE))
        if (IN(pb + 0)) {
#pragma unroll 1
          for (int rep = 0; rep < REPS(7); ++rep) { KArgs ka = KA(); p_norm(F, l == 0 ? ka->in[0] : (const float*)ka->out, ka->in[4] + l * D, MODL, 1 * D, 0, (bf16*)WSP(WS_H)); }
          SEAM(pb + 0); }
        if (IN(pb + 1)) {
            KArgs ka = KA();
            pg8::Gemm g{(bf16*)WSP(WS_H), WMIXL, D, D, D}; pg8::StaticOrder S; S.init(M / 256, N_BCA / 256, F.G, F.bid);
            pg8::EpiBf16 E{(bf16*)WSP(WS_P1), N_BCA, 1.0f / (float)REPS(8)};
#pragma unroll 1
            for (int rep = 0; rep < REPS(3); ++rep)
            pg8::gemm_phase<REPS(8)>(ring, g, S, E, F.tid); SEAM(pb + 1);
        }
        if (IN(pb + 2)) {
#pragma unroll 1
          for (int rep = 0; rep < REPS(1); ++rep) {
            __syncthreads();
            { KArgs ka = KA(); p_hgrn<1>(F, (const bf16*)WSP(WS_P1), ka->in[8], l, ka->in[9] + l * D_BV, (bf16*)WSP(WS_YB), (float*)WSP(WS_HU), (float*)WSP(WS_HD)); }
            __syncthreads();
            { KArgs ka = KA(); p_sgu(F, (const bf16*)WSP(WS_P1), ka->in[10] + l * D_C, ka->in[11] + (size_t)l * 4 * 128 * 128, ka->in[12] + l * 4 * 128, (bf16*)WSP(WS_YC)); }
            { KArgs ka = KA(); p_conv(F, (const bf16*)WSP(WS_P1), ka->in[7] + l * 3 * D_A, (bf16*)WSP(WS_YA)); }
          }
            SEAM(pb + 2);
        }
        if (IN(pb + 3)) {
#pragma unroll 1
          for (int rep = 0; rep < REPS(2); ++rep)
            { KArgs ka = KA(); p_hgrn<2>(F, (const bf16*)WSP(WS_P1), ka->in[8], l, ka->in[9] + l * D_BV, (bf16*)WSP(WS_YB), (float*)WSP(WS_HU), (float*)WSP(WS_HD)); }
            SEAM(pb + 3);
        }
        if (IN(pb + 4)) {
            KArgs ka = KA();
            pg8::Gemm g{(bf16*)WSP(WS_H), WMIXL + (size_t)N_BCA * D, D, D, D}; pg8::StaticOrder S; S.init(M / 256, N_G / 256, F.G, F.bid);
            pg8::EpiBf16 E{(bf16*)WSP(WS_PG), N_G, 1.0f};
            pg8::gemm_phase(ring, g, S, E, F.tid); SEAM(pb + 4);
        }
        if (IN(pb + 5)) {
#pragma unroll 1
            for (int br = 0; br < 3; ++br) {
                KArgs ka = KA();
                pg8::Gemm g{(bf16*)WSP(WS_YA + (size_t)br * 32 * MiB), WMIXL + (size_t)N_IN * D + (size_t)br * 512 * 1024, 512, 512, 512}; pg8::StaticOrder S; S.init(M / 256, D / 256, F.G, F.bid);
                EpiBranch E{(const bf16*)WSP(WS_PG) + br * D, (bf16*)WSP(WS_MRG), br == 0 ? 1 : 0};
                pg8::gemm_phase(ring, g, S, E, F.tid);
            }
            SEAM(pb + 5);
        }
        if (IN(pb + 6)) {
            KArgs ka = KA();
            pg8::Gemm g{(bf16*)WSP(WS_MRG), WMIXL + (size_t)N_IN * D + 3 * 512 * 1024, D, D, D}; pg8::StaticOrder S; S.init(M / 256, D / 256, F.G, F.bid);
            EpiResid E{l == 0 ? ka->in[0] : (const float*)ka->out, ka->out, MODL + 2 * D};
            pg8::gemm_phase(ring, g, S, E, F.tid); SEAM(pb + 6);
        }
        if (l == 0) {
            if (IN(pb + 7)) { KArgs ka = KA(); p_norm(F, ka->out, ka->in[5] + l * D, MODL, 4 * D, 3 * D, (bf16*)WSP(WS_H)); SEAM(pb + 7); }
            if (IN(pb + 8)) {
                KArgs ka = KA();
                pg8::Gemm g{(bf16*)WSP(WS_H), (bf16*)WSP(WS_W13), D, D, D}; pg8::StaticOrder S; S.init(M / 256, N13 / 256, F.G, F.bid);
                EpiSwiglu E{(bf16*)WSP(WS_ACT)};
                pg8::gemm_phase(ring, g, S, E, F.tid); SEAM(pb + 8);
            }
            if (IN(pb + 9)) {
                KArgs ka = KA();
                pg8::Gemm g{(bf16*)WSP(WS_ACT), (bf16*)WSP(WS_W2), D_FF, D_FF, D_FF}; pg8::StaticOrder S; S.init(M / 256, D / 256, F.G, F.bid);
                EpiResid E{ka->out, ka->out, MODL + 5 * D};
                pg8::gemm_phase(ring, g, S, E, F.tid); SEAM(pb + 9);
            }
        } else {
            if (IN(pb + 7)) {
#pragma unroll 1
                for (int rep = 0; rep < REPS(6); ++rep) { __syncthreads(); p_moe_weights(F, KA()); }
                __syncthreads(); { KArgs ka = KA(); p_norm_router(F, ka, ka->out, ka->in[5] + l * D, MODL, (bf16*)WSP(WS_H2M)); } SEAM(pb + 7); }
#pragma unroll 1
            for (int pass = 0; pass < 2; ++pass) {
#ifndef NO_MOE_UP
                if (IN(pb + 8 + 2 * pass)) {
                    KArgs ka = KA();
                    moe_tables(F, (unsigned*)WSP(WS_CTL), pass);
                    const LAS int* tab = (const LAS int*)(F.lds + TAB_OFF);
                    MoeOrder<true> S; S.so.init(tab[16], N13 / 256, F.G, F.bid); S.tab = tab; S.list = (const int*)WSP(WS_LIST) + (size_t)pass * 8 * LIST_CAP; S.npn = N13 / 256; S.rowbytes = D * 2;
                    pg8::Gemm g{(bf16*)WSP(WS_H2M), (bf16*)WSP(WS_WM13), D, D, D};
                    EpiSwiglu E{(bf16*)WSP(WS_ACTM)};
#pragma unroll 1
                    for (int rep = 0; rep < REPS(4); ++rep)
                    pg8::gemm_phase(ring, g, S, E, F.tid); SEAM(pb + 8 + 2 * pass);
                }
#endif
#ifndef NO_MOE_DOWN
                if (IN(pb + 9 + 2 * pass)) {
                    KArgs ka = KA();
                    moe_tables(F, (unsigned*)WSP(WS_CTL), pass);
                    const LAS int* tab = (const LAS int*)(F.lds + TAB_OFF);
                    MoeOrder<false> S; S.so.init(tab[16], D / 256, F.G, F.bid); S.tab = tab; S.list = (const int*)WSP(WS_LIST) + (size_t)pass * 8 * LIST_CAP; S.npn = D / 256; S.rowbytes = 0;
                    pg8::Gemm g{(bf16*)WSP(WS_ACTM), (bf16*)WSP(WS_WM2), D_FF, D_FF, D_FF};
                    EpiMoeDown E{ka->out, MODL + 5 * D, (const float*)WSP(WS_TOPP), pass, tab, S.list};
                    pg8::gemm_phase(ring, g, S, E, F.tid); SEAM(pb + 9 + 2 * pass);
                }
#endif
            }
            if (IN(pb + 12)) { KArgs ka = KA(); p_final_norm(F, ka->out, ka->in[25]); }
        }
}
__global__ void __launch_bounds__(NT, 2) fwd(Args args) {
    extern __shared__ __attribute__((aligned(16))) unsigned char lds[];
    Frame F;
    F.lds = (LAS unsigned char*)lds;
    F.tid = threadIdx.x; F.lane = F.tid & 63; F.wave = __builtin_amdgcn_readfirstlane(F.tid >> 6); F.w0 = F.wave;
    F.G = gridDim.x; F.bid = blockIdx.x;
    volatile LAS unsigned* MISC = (volatile LAS unsigned*)(F.lds + MISC_OFF);
    if (F.tid < 32) MISC[F.tid] = 0u;
    __syncthreads();
#if !MK_PER_PHASE
    XcdBarrier bar = xcd_barrier_post((unsigned*)(KA()->ws + WS_CTL) + CW_BAR, MISC + 8);
#else
    XcdBarrier bar; bar.bar = nullptr; bar.x = 0; bar.st = nullptr;
#endif
    PG8_LAS unsigned char* ring = (PG8_LAS unsigned char*)lds;

    if (IN(0)) {
#pragma unroll 1
        for (int rep = 0; rep < REPS(5); ++rep) { __syncthreads(); p_prologue(F, KA()); }
        SEAM(0); }

    layer_program<0>(F, bar, ring);
    layer_program<1>(F, bar, ring);
#undef IN
#undef SEAM
}

extern "C" void kernel_launch(void* const* d_in, const int* in_sizes, int n_in, void* d_out, int out_size, void* d_ws, size_t ws_size, hipStream_t stream) {
    static int grid = 0;
    if (grid == 0) {
        if (n_in != 26 || in_sizes[0] != M * D || out_size != M * D || ws_size < WS_NEED) { fprintf(stderr, "kernel_launch: unexpected shapes / workspace (n_in %d, ws %zu, need %zu); nothing launched\n", n_in, ws_size, (size_t)WS_NEED); grid = -1; return; }
        int dev = 0, cus = 0, per_cu = 0;
        if (hipGetDevice(&dev) != hipSuccess || hipDeviceGetAttribute(&cus, hipDeviceAttributeMultiprocessorCount, dev) != hipSuccess) { grid = -1; return; }
        if (hipFuncSetAttribute((const void*)fwd, hipFuncAttributeMaxDynamicSharedMemorySize, LDS_BYTES) != hipSuccess) { fprintf(stderr, "kernel_launch: hipFuncSetAttribute failed\n"); grid = -1; return; }
        if (hipOccupancyMaxActiveBlocksPerMultiprocessor(&per_cu, (const void*)fwd, NT, LDS_BYTES) != hipSuccess || per_cu < 1) fprintf(stderr, "kernel_launch: occupancy query reports %d\n", per_cu);
        (void)hipGetLastError();
        grid = cus;
    }
    if (grid < 0) return;
    if (hipMemsetAsync((char*)d_ws + WS_CTL, 0, CTL_ZERO_BYTES, stream) != hipSuccess) return;
    Args a{};
    for (int i = 0; i < 26; ++i) a.in[i] = (const float*)d_in[i];
    a.out = (float*)d_out; a.ws = (unsigned char*)d_ws;
#if MK_PER_PHASE
    for (int p = 0; p < NPHASE; ++p) {
        if (p >= 1 + 10 && p <= 1 + 12) continue;
        a.ph_lo = p; a.ph_hi = p + 1;
        hipLaunchKernelGGL(fwd, dim3(grid), dim3(NT), LDS_BYTES, stream, a);
    }
#else
    a.ph_lo = 0; a.ph_hi = NPHASE;
    hipLaunchKernelGGL(fwd, dim3(grid), dim3(NT), LDS_BYTES, stream, a);
#endif
}
```

```cpp
#include <hip/hip_runtime.h>
#include <cstdio>
#include <cstdint>

#ifndef PROBE_DUP
#define PROBE_DUP 0
#endif
#ifndef PROBE_REPS
#define PROBE_REPS 2
#endif
#define REPS(k) ((PROBE_DUP == (k)) ? PROBE_REPS : 1)
#ifndef MK_PER_PHASE
#define MK_PER_PHASE 0
#endif

namespace pg8 {
#define PG8_LAS __attribute__((address_space(3)))
typedef unsigned short bf16_t;
typedef short bf16x8 __attribute__((ext_vector_type(8)));
typedef float f32x4 __attribute__((ext_vector_type(4)));
typedef unsigned u32x4 __attribute__((ext_vector_type(4)));
constexpr int BM = 256, BK = 64, HALF = 128, HTB = HALF * BK * 2, STAGE_BYTES = 8 * HTB, NXCD = 8, WGM = 8;

__host__ __device__ __forceinline__ int lds_byte(int r, int c) { const int st = (r >> 4) * 2 + (c >> 5), rr = r & 15, cc = c & 31, ob = rr * 64 + cc * 2; return st * 1024 + (ob ^ (((ob >> 9) & 1) << 5)); }
__host__ __device__ __forceinline__ void stage_rc(int b, int& R, int& C) { const int st = b / 1024, sb = b % 1024, swz = sb ^ (((sb >> 9) & 1) << 5); R = (st >> 1) * 16 + swz / 64; C = (st & 1) * 32 + (swz % 64) / 2; }
__host__ __device__ __forceinline__ int perm32(int rho) { const int n = rho >> 4, i = rho & 15; return 8 * (i >> 2) + 4 * n + (i & 3); }

struct Unit { int pm, pn, pb; };
struct Gemm { const bf16_t* A; const bf16_t* Bt; int lda, ldb, K; };

struct StaticOrder {
    static constexpr bool GATHER = false;
    int nM, nN, nwg, G, c;
    __device__ __forceinline__ void init(int nM_, int nN_, int G_, int c_) { nM = nM_; nN = nN_; nwg = nM * nN; G = G_; c = c_; }
    __device__ __forceinline__ bool next(int i, Unit& u) const {
        const long L = (long)i * G + c; if (L >= nwg) return false;
        int wgid = (int)L; { const int q = nwg / NXCD, r = nwg % NXCD, xcd = wgid % NXCD, off = wgid / NXCD; wgid = (xcd < r ? xcd * (q + 1) : r * (q + 1) + (xcd - r) * q) + off; }
        const int nig = WGM * nN, gid = wgid / nig, fm = gid * WGM, gsz = (nM - fm) < WGM ? (nM - fm) : WGM;
        u.pm = fm + ((wgid % nig) % gsz); u.pn = (wgid % nig) / gsz; u.pb = u.pn; return true;
    }
    __device__ __forceinline__ unsigned a_row_off(const Unit&, int) const { return 0u; }
};

__device__ __forceinline__ unsigned cvt_pk_bf16(float lo, float hi) { unsigned r; asm volatile("v_cvt_pk_bf16_f32 %0, %1, %2" : "=v"(r) : "v"(lo), "v"(hi)); return r; }

struct EpiBf16 {
    static constexpr bool PERM = true;
    bf16_t* O; int ldc; float scale;
    __device__ __forceinline__ void operator()(const f32x4 (&acc)[2][2][4][2], const Unit& u, int wr, int wc, int fr, int fq) const {
        const int row0 = u.pm * BM + wr * 64 + fr, col0 = u.pn * BM + wc * 32 + 8 * fq;
#pragma unroll
        for (int ai = 0; ai < 2; ++ai)
#pragma unroll
            for (int m = 0; m < 4; ++m) { bf16_t* rowp = O + (size_t)(row0 + ai * HALF + m * 16) * ldc + col0;
#pragma unroll
                for (int bj = 0; bj < 2; ++bj) { const f32x4 v0 = acc[ai][bj][m][0] * scale, v1 = acc[ai][bj][m][1] * scale;
                    u32x4 w; w.x = cvt_pk_bf16(v0[0], v0[1]); w.y = cvt_pk_bf16(v0[2], v0[3]); w.z = cvt_pk_bf16(v1[0], v1[1]); w.w = cvt_pk_bf16(v1[2], v1[3]);
                    *(u32x4*)(rowp + bj * HALF) = w; } }
    }
};

typedef int v8i32 __attribute__((ext_vector_type(8)));
typedef int v4i32 __attribute__((ext_vector_type(4)));
template <int KREP = 1, bool FP8 = false, class Epi, class Sched>
__device__ __forceinline__ void gemm_phase(PG8_LAS unsigned char* lds, const Gemm g, const Sched& S, const Epi& E, int tid_in) {
    constexpr bool GATHER = Sched::GATHER;
    int tid_ = tid_in; asm volatile("" : "+v"(tid_));
    const int tid = tid_, wid = __builtin_amdgcn_readfirstlane(tid >> 6), lane = tid & 63, wr = wid >> 2, wc = wid & 3, fr = lane & 15, fq = lane >> 4;
    const int K = g.K, nt = K / BK;
    unsigned voffB[2], vA0[2], vA1[2], nA0[2], nA1[2];
#pragma unroll
    for (int i = 0; i < 2; ++i) { int R, C; stage_rc(tid * 16 + i * 8192, R, C); const int Rb = Epi::PERM ? ((R & ~31) + perm32(R & 31)) : R;
        voffB[i] = (unsigned)(Rb * g.ldb + C) * 2u;
        vA0[i] = (unsigned)(R * g.lda + C) * 2u; vA1[i] = vA0[i]; nA0[i] = vA0[i]; nA1[i] = vA0[i]; }
    const size_t kstep = (size_t)(BK * 2);
    const size_t hstepB = (size_t)HALF * g.ldb * 2, tstepB = 2 * hstepB, tstepA = (size_t)BM * g.lda * 2;
    const size_t hstepA = GATHER ? (size_t)0 : (size_t)HALF * g.lda * 2;
    const unsigned ldsw = (unsigned)wid * 1024u;
    const int aoff = lds_byte(wr * 64 + fr, fq * 8), boff = lds_byte(wc * 32 + fr, fq * 8);
    PG8_LAS unsigned char* aptr = lds + aoff; PG8_LAS unsigned char* bptr = lds + 4 * HTB + boff; asm volatile("" : "+v"(aptr), "+v"(bptr));
#define PG8_SA(b, h) (((b) * 2 + (h)) * HTB)
#define PG8_SB(b, h) ((4 + (b) * 2 + (h)) * HTB)
#define PG8_STAGE(bufoff, gbase, voff) do { _Pragma("unroll") for (int _i = 0; _i < 2; ++_i) \
        __builtin_amdgcn_global_load_lds((const unsigned*)((const char*)(gbase) + (voff)[_i]), (PG8_LAS unsigned*)(lds + (bufoff) + ldsw + _i * 8192), 16, 0, 0); } while (0)
#define PG8_CAT8(x0, x1) __builtin_shufflevector(__builtin_bit_cast(v4i32, x0), __builtin_bit_cast(v4i32, x1), 0, 1, 2, 3, 4, 5, 6, 7)
#define PG8_RDA(off) (*(const PG8_LAS bf16x8*)(aptr + (off)))
#define PG8_RDB(off) (*(const PG8_LAS bf16x8*)(bptr + (off)))
#define PG8_LDA(dst, b, h) do { if constexpr (FP8) { _Pragma("unroll") for (int m = 0; m < 4; ++m) dst##8[m] = PG8_CAT8(PG8_RDA(PG8_SA(b, h) + m * 2048), PG8_RDA(PG8_SA(b, h) + m * 2048 + 1024)); } \
        else { _Pragma("unroll") for (int m = 0; m < 4; ++m) _Pragma("unroll") for (int k = 0; k < 2; ++k) dst[m][k] = PG8_RDA(PG8_SA(b, h) + m * 2048 + k * 1024); } } while (0)
#define PG8_LDB(dst, b, h) do { if constexpr (FP8) { _Pragma("unroll") for (int n = 0; n < 2; ++n) dst##8[n] = PG8_CAT8(PG8_RDB(PG8_SB(b, h) - 4 * HTB + n * 2048), PG8_RDB(PG8_SB(b, h) - 4 * HTB + n * 2048 + 1024)); } \
        else { _Pragma("unroll") for (int n = 0; n < 2; ++n) _Pragma("unroll") for (int k = 0; k < 2; ++k) dst[n][k] = PG8_RDB(PG8_SB(b, h) - 4 * HTB + n * 2048 + k * 1024); } } while (0)
#define PG8_MMA(ai, bj, At, Bt) do { __builtin_amdgcn_s_setprio(1); \
        if constexpr (FP8) { _Pragma("unroll") for (int m = 0; m < 4; ++m) _Pragma("unroll") for (int n = 0; n < 2; ++n) \
            asm volatile("v_mfma_scale_f32_16x16x128_f8f6f4 %0, %1, %2, %0, %3, %3 op_sel_hi:[0,0,0]" : "+v"(acc[ai][bj][m][n]) : "v"(Bt##8[n]), "v"(At##8[m]), "v"(sc1)); } \
        else { _Pragma("unroll") for (int m = 0; m < 4; ++m) _Pragma("unroll") for (int n = 0; n < 2; ++n) _Pragma("unroll") for (int k = 0; k < 2; ++k) \
            acc[ai][bj][m][n] = __builtin_amdgcn_mfma_f32_16x16x32_bf16(Bt[n][k], At[m][k], acc[ai][bj][m][n], 0, 0, 0); } \
        __builtin_amdgcn_s_setprio(0); } while (0)
#define PG8_WAIT_V(n) asm volatile("s_waitcnt vmcnt(" #n ")" ::: "memory")
#define PG8_WAIT_L(n) asm volatile("s_waitcnt lgkmcnt(" #n ")" ::: "memory")
#define PG8_BAR __builtin_amdgcn_s_barrier()
#define PG8_SCHED __builtin_amdgcn_sched_barrier(0)
#define PG8_GOFF(unit, d0, d1) do { _Pragma("unroll") for (int _i = 0; _i < 2; ++_i) { int R_, C_; stage_rc(tid * 16 + _i * 8192, R_, C_); \
        d0[_i] = S.a_row_off(unit, R_) + (unsigned)C_ * 2u; d1[_i] = S.a_row_off(unit, R_ + HALF) + (unsigned)C_ * 2u; } } while (0)
    Unit cur, nxt; int ui = 0;
    if (!S.next(0, cur)) return;
    f32x4 acc[2][2][4][2];
#pragma unroll
    for (int a = 0; a < 2; ++a)
#pragma unroll
        for (int b = 0; b < 2; ++b)
#pragma unroll
            for (int m = 0; m < 4; ++m)
#pragma unroll
                for (int n = 0; n < 2; ++n) acc[a][b][m][n] = (f32x4){0.f, 0.f, 0.f, 0.f};
    bf16x8 At[4][2], B0[2][2], B1[2][2];
    v8i32 At8[4], B08[2], B18[2];
    const int sc1 = 0x7f7f7f7f;
    if constexpr (GATHER) { PG8_GOFF(cur, vA0, vA1); }
    const char* cA = GATHER ? (const char*)g.A : (const char*)g.A + (size_t)cur.pm * tstepA; const char* cB = (const char*)g.Bt + (size_t)cur.pb * tstepB;
    PG8_STAGE(PG8_SB(0, 0), cB, voffB); PG8_STAGE(PG8_SB(0, 1), cB + hstepB, voffB); PG8_STAGE(PG8_SA(0, 0), cA, vA0); PG8_STAGE(PG8_SA(0, 1), cA + hstepA, vA1);
    if (wr == 1) PG8_BAR;
    PG8_WAIT_V(2); PG8_BAR;
    PG8_STAGE(PG8_SB(1, 0), cB + kstep, voffB); PG8_STAGE(PG8_SA(1, 0), cA + kstep, vA0); PG8_STAGE(PG8_SB(1, 1), cB + hstepB + kstep, voffB);
    PG8_WAIT_V(6); PG8_BAR;
    for (;;) {
        const bool has_next = S.next(ui + 1, nxt);
        const char* nA = GATHER ? (const char*)g.A : (has_next ? (const char*)g.A + (size_t)nxt.pm * tstepA : cA); const char* nB = has_next ? (const char*)g.Bt + (size_t)nxt.pb * tstepB : cB;
        if constexpr (GATHER) { if (has_next) { PG8_GOFF(nxt, nA0, nA1); } else {
#pragma unroll
            for (int i = 0; i < 2; ++i) { nA0[i] = vA0[i]; nA1[i] = vA1[i]; } } }
#pragma unroll 1
        for (int t = 0; t < nt * KREP; t += 2) {
            const bool last = (t == nt * KREP - 2);
            const int t1 = (KREP == 1) ? t + 1 : ((t + 1) & (nt - 1)), t2 = (KREP == 1) ? t + 2 : ((t + 2) & (nt - 1));
            const char* a1 = cA + (size_t)t1 * kstep;
            const char* a2 = last ? nA : cA + (size_t)t2 * kstep; const char* b2 = last ? nB : cB + (size_t)t2 * kstep;
            const char* a3 = a2 + kstep; const char* b3 = b2 + kstep;
            unsigned s0[2], s1[2];
#pragma unroll
            for (int i = 0; i < 2; ++i) { s0[i] = (GATHER && last) ? nA0[i] : vA0[i]; s1[i] = GATHER ? (last ? nA1[i] : vA1[i]) : vA0[i]; }
            PG8_LDB(B0, 0, 0); PG8_LDB(B1, 0, 1); PG8_SCHED; PG8_LDA(At, 0, 0); PG8_STAGE(PG8_SA(1, 1), a1 + hstepA, vA1);
            PG8_WAIT_V(8); PG8_WAIT_L(0); PG8_BAR; PG8_MMA(0, 0, At, B0); PG8_MMA(0, 1, At, B1); PG8_BAR; PG8_SCHED;
            PG8_LDA(At, 0, 1); PG8_STAGE(PG8_SB(0, 0), b2, voffB); PG8_STAGE(PG8_SB(0, 1), b2 + hstepB, voffB); PG8_STAGE(PG8_SA(0, 0), a2, s0);
            PG8_WAIT_V(8); PG8_WAIT_L(0); PG8_BAR; PG8_MMA(1, 0, At, B0); PG8_MMA(1, 1, At, B1); PG8_BAR; PG8_SCHED;
            PG8_LDB(B0, 1, 0); PG8_LDB(B1, 1, 1); PG8_SCHED; PG8_LDA(At, 1, 0); PG8_STAGE(PG8_SA(0, 1), a2 + hstepA, s1);
            PG8_WAIT_V(8); PG8_WAIT_L(0); PG8_BAR; PG8_MMA(0, 0, At, B0); PG8_MMA(0, 1, At, B1); PG8_BAR; PG8_SCHED;
            PG8_LDA(At, 1, 1); PG8_STAGE(PG8_SB(1, 0), b3, voffB); PG8_STAGE(PG8_SB(1, 1), b3 + hstepB, voffB); PG8_STAGE(PG8_SA(1, 0), a3, s0);
            PG8_WAIT_V(8); PG8_WAIT_L(0); PG8_BAR; PG8_MMA(1, 0, At, B0); PG8_MMA(1, 1, At, B1); PG8_BAR; PG8_SCHED;
        }
        if (wr == 0) PG8_BAR;
        E(acc, cur, wr, wc, fr, fq);
        if (!has_next) break;
#pragma unroll
        for (int a = 0; a < 2; ++a)
#pragma unroll
            for (int b = 0; b < 2; ++b)
#pragma unroll
                for (int m = 0; m < 4; ++m)
#pragma unroll
                    for (int n = 0; n < 2; ++n) acc[a][b][m][n] = (f32x4){0.f, 0.f, 0.f, 0.f};
        cur = nxt; cA = nA; cB = nB; ++ui;
        if constexpr (GATHER) {
#pragma unroll
            for (int i = 0; i < 2; ++i) { vA0[i] = nA0[i]; vA1[i] = nA1[i]; } }
        if (wr == 1) PG8_BAR;
    }
    PG8_WAIT_V(0);
    PG8_BAR;
#undef PG8_SA
#undef PG8_SB
#undef PG8_STAGE
#undef PG8_LDA
#undef PG8_LDB
#undef PG8_MMA
#undef PG8_WAIT_V
#undef PG8_WAIT_L
#undef PG8_BAR
#undef PG8_SCHED
#undef PG8_GOFF
#undef PG8_CAT8
#undef PG8_RDA
#undef PG8_RDB
}
}

constexpr int D = 1024, BATCH = 8, SEQ = 4096, M = BATCH * SEQ, DEPTH = 2;
constexpr int D_A = 512, D_BK = 512, D_BV = 512, D_C = 512, H_B = 4;
constexpr int N_IN = 7680, N_BCA = 4608, N_G = 3072;
constexpr int D_FF = 2816, NE = 8, N13 = 2 * D_FF;
constexpr int MOD_LD = 6 * D;
constexpr float EPS = 1e-6f;
constexpr int LIST_CAP = M;
constexpr int MOE_ROWS = M + NE * 256;

constexpr size_t MiB = 1u << 20;
constexpr size_t WS_CTL = 0, CTL_ZERO_BYTES = 1 * MiB;
constexpr size_t WS_MOD = 1 * MiB;
constexpr size_t WS_TOPP = 2 * MiB;
constexpr size_t WS_LIST = 3 * MiB;
constexpr size_t WS_WMIX = 6 * MiB, WMIX_STRIDE = 20 * MiB;
constexpr size_t WS_W13 = 46 * MiB, WS_W2 = 57 * MiB;
constexpr size_t WS_BIG = 64 * MiB;
constexpr size_t WS_H = WS_BIG;
constexpr size_t WS_P1 = WS_BIG + 64 * MiB;
constexpr size_t WS_PG = WS_P1;
constexpr size_t WS_MRG = WS_P1 + 192 * MiB;
constexpr size_t WS_YA = WS_P1 + 288 * MiB, WS_YB = WS_YA + 32 * MiB, WS_YC = WS_YB + 32 * MiB;
constexpr size_t WS_ACT = WS_P1;
constexpr size_t WS_HU = WS_YC + 32 * MiB;
constexpr size_t WS_HD = WS_HU + 16 * MiB;
constexpr size_t WS_MIX_END = WS_HD + 1 * MiB;
#ifndef MOE_FP8
#define MOE_FP8 1
#endif
constexpr float F8_SA = 4.0f, F8_SW = 64.0f, F8_SACT = 8.0f;
constexpr int MOE_ES = MOE_FP8 ? 1 : 2;
constexpr size_t WS_WM13 = 6 * MiB;
constexpr size_t WS_WM2 = WS_WM13 + 88 * MiB;
constexpr size_t WS_H2M = WS_WM2 + 44 * MiB;
constexpr size_t WS_ACTM = WS_H2M + 64 * MiB;
constexpr size_t WS_MOE_END = WS_ACTM + (size_t)MOE_ROWS * D_FF * 2;
constexpr size_t WS_NEED = WS_MIX_END > WS_MOE_END ? WS_MIX_END : WS_MOE_END;
static_assert(WS_W2 + (size_t)D * D_FF * 2 <= WS_BIG && WS_WMIX + 2 * WMIX_STRIDE <= WS_W13, "ws map");
constexpr int CW_BAR = 4096;
constexpr int CW_CNT = 16384;

constexpr int LDS_BYTES = 147456;
constexpr int SCR_BYTES = 139264;
constexpr int TAB_OFF = SCR_BYTES;
constexpr int MISC_OFF = TAB_OFF + 4096;
static_assert(MISC_OFF + 128 <= LDS_BYTES, "LDS map");
constexpr int NWAVES = 8, NT = 512;

#define GAS __attribute__((address_space(1)))
#define LAS __attribute__((address_space(3)))
typedef unsigned short bf16;
typedef unsigned v4u __attribute__((ext_vector_type(4)));
typedef float f32x4 __attribute__((ext_vector_type(4)));
#define LDS_WAIT() asm volatile("s_waitcnt lgkmcnt(0)" ::: "memory")

typedef float f32x2_t __attribute__((ext_vector_type(2)));
typedef __bf16 bf16x2_t __attribute__((ext_vector_type(2)));
__device__ __forceinline__ unsigned pk2(float lo, float hi) { f32x2_t v = {lo, hi}; bf16x2_t b = __builtin_convertvector(v, bf16x2_t); return __builtin_bit_cast(unsigned, b); }
__device__ __forceinline__ float bf_lo(unsigned u) { return __uint_as_float(u << 16); }
__device__ __forceinline__ float bf_hi(unsigned u) { return __uint_as_float(u & 0xffff0000u); }
__device__ __forceinline__ void unpack8(const v4u w, float (&f)[8]) { f[0] = bf_lo(w.x); f[1] = bf_hi(w.x); f[2] = bf_lo(w.y); f[3] = bf_hi(w.y); f[4] = bf_lo(w.z); f[5] = bf_hi(w.z); f[6] = bf_lo(w.w); f[7] = bf_hi(w.w); }
__device__ __forceinline__ v4u pack8(const float (&f)[8]) { v4u w; w.x = pk2(f[0], f[1]); w.y = pk2(f[2], f[3]); w.z = pk2(f[4], f[5]); w.w = pk2(f[6], f[7]); return w; }
__device__ __forceinline__ float sigmoidf_(float x) { return __builtin_amdgcn_rcpf(1.0f + __expf(-x)); }
__device__ __forceinline__ float siluf_(float x) { return x * sigmoidf_(x); }
__device__ __forceinline__ float clamp_f8(float x) { return fminf(fmaxf(x, -448.0f), 448.0f); }
__device__ __forceinline__ unsigned pk4_f8(float a, float b, float c, float d) { int v = 0; v = __builtin_amdgcn_cvt_pk_fp8_f32(clamp_f8(a), clamp_f8(b), v, false); v = __builtin_amdgcn_cvt_pk_fp8_f32(clamp_f8(c), clamp_f8(d), v, true); return (unsigned)v; }
__device__ __forceinline__ float shx(float v, int mask, int lane) { return __int_as_float(__builtin_amdgcn_ds_bpermute((lane ^ mask) << 2, __float_as_int(v))); }
__device__ __forceinline__ float shl(float v, int src) { return __int_as_float(__builtin_amdgcn_ds_bpermute(src << 2, __float_as_int(v))); }
__device__ __forceinline__ float wave_sum(float v, int lane) {
#pragma unroll
    for (int o = 1; o < 64; o <<= 1) v += shx(v, o, lane);
    return v;
}

#define XB_TMO      128
#define XB_XCNT(j)  (256  + 64 * (j))
#define XB_XSUB(j)  (1280 + 64 * (j))
#define XB_XGEN(j)  (2304 + 64 * (j))
#define XB_TOP      3328
#define XB_TOPGEN   3392
#define XCD_BAR_WORDS 3456
#define XB_SPIN_CAP (1u << 18)

__device__ __forceinline__ unsigned xb_ld(unsigned* p)              { return __hip_atomic_load(p, __ATOMIC_RELAXED, __HIP_MEMORY_SCOPE_AGENT); }
__device__ __forceinline__ unsigned xb_add(unsigned* p, unsigned v) { return __hip_atomic_fetch_add(p, v, __ATOMIC_RELAXED, __HIP_MEMORY_SCOPE_AGENT); }
__device__ __forceinline__ unsigned xb_xcc_id() { return (unsigned)__builtin_amdgcn_s_getreg((3 << 11) | 20) & 0xFu; }
#define XB_SPIN(cond, bar) do { unsigned _sp = 0; while (cond) { __builtin_amdgcn_s_sleep(1); \
    if ((++_sp & 255u) == 0u) { if (xb_ld(&(bar)[XB_TMO])) break; if (_sp > XB_SPIN_CAP) { atomicAdd(&(bar)[XB_TMO], 1u); break; } } } } while (0)

struct XcdBarrier { unsigned* bar; unsigned x; volatile LAS unsigned* st; };

__device__ __forceinline__ XcdBarrier xcd_barrier_post(unsigned* bar, volatile LAS unsigned* st) {
    XcdBarrier b; b.bar = bar; b.x = xb_xcc_id(); b.st = st;
    if (threadIdx.x == 0) (void)xb_add(&bar[XB_XCNT(b.x)], 1u);
    return b;
}
__device__ __forceinline__ void xcd_barrier_complete(unsigned* bar, unsigned x, unsigned& nloc, unsigned& nx) {
    const unsigned G = gridDim.x * gridDim.y * gridDim.z;
    unsigned sum, cnt, mine, sp = 0u;
    for (;;) {
        sum = 0u; cnt = 0u; mine = 0u;
        unsigned cv[16];
#pragma unroll
        for (unsigned j = 0; j < 16; ++j) cv[j] = xb_ld(&bar[XB_XCNT(j)]);
        asm volatile("" ::: "memory");
#pragma unroll
        for (unsigned j = 0; j < 16; ++j) { const unsigned c = cv[j]; sum += c; cnt += (c > 0u) ? 1u : 0u; mine = (j == x) ? c : mine; }
        if (sum == G) break;
        __builtin_amdgcn_s_sleep(1);
        if ((++sp & 255u) == 0u) { if (xb_ld(&bar[XB_TMO])) break; if (sp > XB_SPIN_CAP) { atomicAdd(&bar[XB_TMO], 1u); break; } }
    }
    nloc = mine > 0u ? mine : 1u; nx = cnt > 0u ? cnt : 1u;
}
__device__ __forceinline__ void xcd_barrier(const XcdBarrier& b) {
    asm volatile("s_waitcnt vmcnt(0)" ::: "memory");
    __syncthreads();
    if (threadIdx.x == 0) {
        unsigned* bar = b.bar;
        __builtin_amdgcn_s_waitcnt(0);
        unsigned nloc = b.st[0], nx = b.st[1];
        if (nloc == 0u) { xcd_barrier_complete(bar, b.x, nloc, nx); b.st[0] = nloc; b.st[1] = nx; }
        const unsigned old = xb_add(&bar[XB_XSUB(b.x)], 1u);
        const unsigned gen = old / nloc;
        if (old + 1u == (gen + 1u) * nloc) {
            __builtin_amdgcn_fence(__ATOMIC_RELEASE, "agent");
            asm volatile("s_waitcnt vmcnt(0)" ::: "memory");
            const unsigned og = xb_add(&bar[XB_TOP], 1u);
            const unsigned tg = og / nx;
            if (og + 1u == (tg + 1u) * nx) xb_add(&bar[XB_TOPGEN], 1u);
            else XB_SPIN(xb_ld(&bar[XB_TOPGEN]) == tg, bar);
            __builtin_amdgcn_fence(__ATOMIC_ACQUIRE, "agent");
            xb_add(&bar[XB_XGEN(b.x)], 1u);
            asm volatile("s_waitcnt vmcnt(0)" ::: "memory");
        } else {
            XB_SPIN(xb_ld(&bar[XB_XGEN(b.x)]) == gen, bar);
            __builtin_amdgcn_fence(__ATOMIC_ACQUIRE, "agent");
            asm volatile("s_waitcnt vmcnt(0)" ::: "memory");
        }
    }
    __syncthreads();
}

struct Args { const float* in[26]; float* out; unsigned char* ws; int ph_lo, ph_hi; };
typedef const Args __attribute__((address_space(4)))* KArgs;
#define KA() ({ KArgs p_ = (KArgs)__builtin_amdgcn_kernarg_segment_ptr(); asm volatile("" : "+s"(p_)); p_; })
struct Frame {
    LAS unsigned char* lds;
    int tid, lane, wave, G, bid;
    int w0;
};

template <int MAP, bool F8 = false>
__device__ __forceinline__ void transpose_item(const float* W, int K, int N, bf16* WT, int row_off, LAS float* scr, int item, int lane) {
    const int nblk = N / 32, kb = item / nblk, nb = item % nblk, k0 = 64 * kb, n0 = 32 * nb;
    float vld[32];
#pragma unroll
    for (int i = 0; i < 32; ++i) vld[i] = W[(size_t)(k0 + 2 * i + (lane >> 5)) * N + n0 + (lane & 31)];
    asm volatile("" ::: "memory");
#pragma unroll
    for (int i = 0; i < 32; ++i) scr[(2 * i + (lane >> 5)) * 33 + (lane & 31)] = vld[i];
    LDS_WAIT(); asm volatile("" ::: "memory");
    const int c = lane & 7;
#pragma unroll
    for (int j = 0; j < 4; ++j) { const int n = (lane >> 3) + 8 * j; const LAS float* s = scr + (8 * c) * 33 + n;
        v4u o; o.x = pk2(s[0 * 33], s[1 * 33]); o.y = pk2(s[2 * 33], s[3 * 33]); o.z = pk2(s[4 * 33], s[5 * 33]); o.w = pk2(s[6 * 33], s[7 * 33]);
        const int nn = n0 + n; const int row = (MAP == 0) ? (row_off + nn) : ((nn >> 7) * 256 + row_off + (nn & 127));
        if constexpr (F8) { typedef unsigned v2u_ __attribute__((ext_vector_type(2))); v2u_ o8;
            o8.x = pk4_f8(s[0 * 33] * F8_SW, s[1 * 33] * F8_SW, s[2 * 33] * F8_SW, s[3 * 33] * F8_SW); o8.y = pk4_f8(s[4 * 33] * F8_SW, s[5 * 33] * F8_SW, s[6 * 33] * F8_SW, s[7 * 33] * F8_SW);
            *(v2u_*)((unsigned char*)WT + (size_t)row * K + k0 + 8 * c) = o8; }
        else *(v4u*)(WT + (size_t)row * K + k0 + 8 * c) = o; }
    LDS_WAIT(); asm volatile("" ::: "memory");
}

__device__ __forceinline__ void p_prologue(Frame& F, KArgs ka) {
    const float* c = ka->in[1]; const float* ada_w = ka->in[2]; const float* ada_b = ka->in[3];
    unsigned char* aws = ka->ws; float* mod = (float*)(aws + WS_MOD);
    LAS float* cact = (LAS float*)F.lds;
    LAS float* red = cact + 8192;
    for (int i = F.tid; i < BATCH * D; i += NT) cact[i] = siluf_(c[i]);
    __syncthreads();
    for (int chunk = F.bid; chunk < 256; chunk += F.G) {
        const int l = chunk >> 7, n0 = (chunk & 127) * 48;
        if (F.tid < 480) {
            const int kg = F.tid / 48, col = F.tid % 48;
            float acc[8];
#pragma unroll
            for (int b = 0; b < 8; ++b) acc[b] = 0.f;
            const float* wp = ada_w + (size_t)l * D * MOD_LD + n0 + col;
            for (int k = kg; k < D; k += 10) { const float w = wp[(size_t)k * MOD_LD];
#pragma unroll
                for (int b = 0; b < 8; ++b) acc[b] += cact[b * D + k] * w; }
#pragma unroll
            for (int b = 0; b < 8; ++b) red[(kg * 48 + col) * 8 + b] = acc[b];
        }
        __syncthreads();
        if (F.tid < 384) {
            const int col = F.tid >> 3, b = F.tid & 7; float s = 0.f;
#pragma unroll
            for (int kg = 0; kg < 10; ++kg) s += red[(kg * 48 + col) * 8 + b];
            mod[(size_t)(l * 8 + b) * MOD_LD + n0 + col] = s + ada_b[l * MOD_LD + n0 + col];
        }
        __syncthreads();
    }
    LAS float* scr = (LAS float*)(F.lds + F.wave * 16384);
    const int gw = F.bid * NWAVES + F.wave, NGW = F.G * NWAVES;
    constexpr int I_IN = (D / 64) * (N_IN / 32), I_BR = (512 / 64) * (D / 32), I_O = (D / 64) * (D / 32), I_L = I_IN + 3 * I_BR + I_O;
    constexpr int I_F1 = (D / 64) * (D_FF / 32), I_F2 = (D_FF / 64) * (D / 32);
    constexpr int NITEMS = 2 * I_L + 2 * I_F1 + I_F2;
    for (int it = gw; it < NITEMS; it += NGW) {
        int r = it;
        if (r < 2 * I_L) {
            const int l = r / I_L; r -= l * I_L;
            bf16* base = (bf16*)(aws + WS_WMIX + (size_t)l * WMIX_STRIDE);
            if (r < I_IN) { transpose_item<0>(ka->in[6] + (size_t)l * D * N_IN, D, N_IN, base, 0, scr, r, F.lane); continue; } r -= I_IN;
            if (r < I_BR) { transpose_item<0>(ka->in[13] + (size_t)l * 512 * D, 512, D, base + (size_t)N_IN * D, 0, scr, r, F.lane); continue; } r -= I_BR;
            if (r < I_BR) { transpose_item<0>(ka->in[14] + (size_t)l * 512 * D, 512, D, base + (size_t)N_IN * D + 512 * 1024, 0, scr, r, F.lane); continue; } r -= I_BR;
            if (r < I_BR) { transpose_item<0>(ka->in[15] + (size_t)l * 512 * D, 512, D, base + (size_t)N_IN * D + 2 * 512 * 1024, 0, scr, r, F.lane); continue; } r -= I_BR;
            transpose_item<0>(ka->in[16] + (size_t)l * D * D, D, D, base + (size_t)N_IN * D + 3 * 512 * 1024, 0, scr, r, F.lane); continue;
        }
        r -= 2 * I_L;
        if (r < I_F1) { transpose_item<1>(ka->in[17], D, D_FF, (bf16*)(aws + WS_W13), 0, scr, r, F.lane); continue; } r -= I_F1;
        if (r < I_F1) { transpose_item<1>(ka->in[18], D, D_FF, (bf16*)(aws + WS_W13), 128, scr, r, F.lane); continue; } r -= I_F1;
        transpose_item<0>(ka->in[19], D_FF, D, (bf16*)(aws + WS_W2), 0, scr, r, F.lane);
    }
}
__device__ __forceinline__ void p_moe_weights(Frame& F, KArgs ka) {
    unsigned char* aws = ka->ws;
    LAS float* scr = (LAS float*)(F.lds + F.wave * 16384);
    const int gw = F.bid * NWAVES + F.wave, NGW = F.G * NWAVES;
    constexpr int I_F1 = (D / 64) * (D_FF / 32), I_F2 = (D_FF / 64) * (D / 32), I_E = 2 * I_F1 + I_F2;
    for (int it = gw; it < NE * I_E; it += NGW) {
        const int e = it / I_E; int r = it - e * I_E;
        bf16* w13 = (bf16*)(aws + WS_WM13 + (size_t)e * N13 * D * MOE_ES); bf16* w2 = (bf16*)(aws + WS_WM2 + (size_t)e * D * D_FF * MOE_ES);
        if (r < I_F1) { transpose_item<1, MOE_FP8>(ka->in[22] + (size_t)e * D * D_FF, D, D_FF, w13, 0, scr, r, F.lane); continue; } r -= I_F1;
        if (r < I_F1) { transpose_item<1, MOE_FP8>(ka->in[23] + (size_t)e * D * D_FF, D, D_FF, w13, 128, scr, r, F.lane); continue; } r -= I_F1;
        transpose_item<0, MOE_FP8>(ka->in[24] + (size_t)e * D_FF * D, D_FF, D, w2, 0, scr, r, F.lane);
    }
}

__device__ __forceinline__ void norm_row(const float* xrow, const float* w, const float* sc, const float* sh, int lane, f32x4 (&o)[4]) {
    const f32x4* xr = (const f32x4*)xrow + lane;
    f32x4 v[4]; float s = 0.f;
#pragma unroll
    for (int j = 0; j < 4; ++j) { v[j] = xr[64 * j]; s += (v[j].x * v[j].x + v[j].y * v[j].y) + (v[j].z * v[j].z + v[j].w * v[j].w); }
    const float rstd = 1.0f / sqrtf(wave_sum(s, lane) * (1.0f / D) + EPS);
#pragma unroll
    for (int j = 0; j < 4; ++j) { const f32x4 wv = ((const f32x4*)w)[lane + 64 * j], scv = ((const f32x4*)sc)[lane + 64 * j], shv = ((const f32x4*)sh)[lane + 64 * j];
        o[j] = v[j] * rstd * wv * (scv + 1.0f) + shv; }
}
__device__ __forceinline__ void store_row_bf16(bf16* orow, int lane, const f32x4 (&o)[4]) {
    unsigned long long* o8 = (unsigned long long*)orow + lane;
#pragma unroll
    for (int j = 0; j < 4; ++j) o8[64 * j] = (unsigned long long)pk2(o[j].x, o[j].y) | ((unsigned long long)pk2(o[j].z, o[j].w) << 32);
}
__device__ __forceinline__ void p_norm(Frame& F, const float* xin, const float* w, const float* mod_l, int sc_off, int sh_off, bf16* hout) {
    const int gw = F.bid * NWAVES + F.wave, NGW = F.G * NWAVES, lane = F.lane;
    f32x4 wv[4];
#pragma unroll
    for (int j = 0; j < 4; ++j) wv[j] = ((const f32x4*)w)[lane + 64 * j];
    for (int r0 = gw * 4; r0 < M; r0 += NGW * 4) {
        const float* mb = mod_l + (size_t)(r0 >> 12) * MOD_LD;
        f32x4 v[4][4], scv[4], shv[4];
#pragma unroll
        for (int r = 0; r < 4; ++r)
#pragma unroll
            for (int j = 0; j < 4; ++j) v[r][j] = ((const f32x4*)(xin + (size_t)(r0 + r) * D))[lane + 64 * j];
#pragma unroll
        for (int j = 0; j < 4; ++j) { scv[j] = ((const f32x4*)(mb + sc_off))[lane + 64 * j]; shv[j] = ((const f32x4*)(mb + sh_off))[lane + 64 * j]; }
        asm volatile("" ::: "memory");
#pragma unroll
        for (int j = 0; j < 4; ++j) scv[j] = wv[j] * (scv[j] + 1.0f);
#pragma unroll
        for (int r = 0; r < 4; ++r) { float s = 0.f;
#pragma unroll
            for (int j = 0; j < 4; ++j) s += (v[r][j].x * v[r][j].x + v[r][j].y * v[r][j].y) + (v[r][j].z * v[r][j].z + v[r][j].w * v[r][j].w);
            const float rstd = 1.0f / sqrtf(wave_sum(s, lane) * (1.0f / D) + EPS);
            f32x4 o[4];
#pragma unroll
            for (int j = 0; j < 4; ++j) o[j] = v[r][j] * rstd * scv[j] + shv[j];
            store_row_bf16(hout + (size_t)(r0 + r) * D, lane, o); }
    }
}

__device__ __forceinline__ void p_conv(Frame& F, const bf16* P1, const float* conv_w, bf16* ya) {
    const int gt = F.bid * NT + F.tid, NGT = F.G * NT;
    for (int it = gt; it < M * 64; it += NGT) {
        const int row = it >> 6, c8 = (it & 63) * 8, pos = row & (SEQ - 1);
        const bf16* p = P1 + (size_t)row * N_BCA + c8;
        float ab[8], ac[8], ah[8], z1[8], z2[8], y[8];
        unpack8(*(const v4u*)p, ab); unpack8(*(const v4u*)(p + 512), ac); unpack8(*(const v4u*)(p + 1024), ah);
#pragma unroll
        for (int i = 0; i < 8; ++i) { z1[i] = 0.f; z2[i] = 0.f; }
        if (pos >= 1) { float c1[8], h1[8]; unpack8(*(const v4u*)(p - N_BCA + 512), c1); unpack8(*(const v4u*)(p - N_BCA + 1024), h1);
#pragma unroll
            for (int i = 0; i < 8; ++i) z1[i] = c1[i] * h1[i]; }
        if (pos >= 2) { float c2[8], h2[8]; unpack8(*(const v4u*)(p - 2 * N_BCA + 512), c2); unpack8(*(const v4u*)(p - 2 * N_BCA + 1024), h2);
#pragma unroll
            for (int i = 0; i < 8; ++i) z2[i] = c2[i] * h2[i]; }
#pragma unroll
        for (int i = 0; i < 8; ++i) y[i] = ab[i] * (conv_w[c8 + i] * (ac[i] * ah[i]) + conv_w[512 + c8 + i] * z1[i] + conv_w[1024 + c8 + i] * z2[i]);
        *(v4u*)(ya + (size_t)row * 512 + c8) = pack8(y);
    }
}

typedef short v4i16_t __attribute__((ext_vector_type(4)));
typedef short bf16x8_t __attribute__((ext_vector_type(8)));
typedef unsigned v2u __attribute__((ext_vector_type(2)));
constexpr int HRS = 272;
constexpr int TRS = 80;
constexpr int H_RAWQ = 0, H_RAWF = 8704, H_V = 17408, H_QHT = 26112, H_KTT = 36352, H_KHT = 46592, H_DL = 56832, H_OB = 57344, H_OBS = 132;
constexpr int HSEG = 512, HNSEG = SEQ / HSEG, HCH = 32;
__device__ __forceinline__ v4i16_t tr_read(LAS unsigned char* p) { return __builtin_amdgcn_ds_read_tr16_b64_v4i16((LAS v4i16_t*)p); }
__device__ __forceinline__ bf16x8_t cat4(v4i16_t lo, v4i16_t hi) { return __builtin_shufflevector(lo, hi, 0, 1, 2, 3, 4, 5, 6, 7); }
__device__ __forceinline__ bf16x8_t pack_acc(const f32x4 a, const f32x4 b) { v4u w; w.x = pk2(a[0], a[1]); w.y = pk2(a[2], a[3]); w.z = pk2(b[0], b[1]); w.w = pk2(b[2], b[3]); return __builtin_bit_cast(bf16x8_t, w); }
__device__ __forceinline__ float bfs(short x) { return __uint_as_float((unsigned)(unsigned short)x << 16); }
template <int PASS>
__device__ __forceinline__ void p_hgrn(Frame& F, const bf16* P1, const float* lb_logits, int layer, const float* norm_w, bf16* yb, float* ust, float* dst) {
    LAS unsigned char* L = F.lds;
    const int lane = F.lane, w = F.wave, g = lane >> 4, n = lane & 15, q_ = n >> 2, p_ = n & 3;
    const int pt = F.tid >> 4, pc8 = (F.tid & 15) * 8;
    for (int u = F.bid; u < BATCH * H_B * HNSEG; u += F.G) {
        const int seg = u & (HNSEG - 1), bh = u / HNSEG, b = bh >> 2, h = bh & 3;
        const int d = 16 * w + n;
        float lb; { const int ch = h * 128 + d; const float l0 = lb_logits[ch], l1 = lb_logits[512 + ch]; const float mx = fmaxf(l0, l1);
            const float e0 = expf(l0 - mx), e1 = expf(l1 - mx); const float p0 = e0 / (e0 + e1), p1 = e1 / (e0 + e1);
            const float lbx = (layer == 0) ? (p0 - p0) : ((p0 + p1) - p0); lb = fminf(fmaxf(lbx, 0.f), 1.f); }
        const float lbf = fmaxf(lb, 1e-30f), oml = 1.0f - lb;
        f32x4 S[8];
#pragma unroll
        for (int kt = 0; kt < 8; ++kt) S[kt] = (f32x4){0.f, 0.f, 0.f, 0.f};
        if (PASS == 2) {
            for (int j = 0; j < seg; ++j) { const int uj = u - seg + j;
#pragma unroll
                for (int kt = 0; kt < 8; ++kt) { const f32x4 dj = *(const f32x4*)(dst + (size_t)uj * 128 + 16 * kt + 4 * g); const f32x4 uu = *(const f32x4*)(ust + ((((size_t)uj * 8 + w) * 8 + kt) * 64 + lane) * 4);
                    S[kt] = dj * S[kt] + uu; } }
        }
        float nw8[8];
        if (PASS == 2) {
#pragma unroll
            for (int i = 0; i < 8; ++i) nw8[i] = norm_w[h * 128 + pc8 + i]; }
        float dprod = 1.0f;
        const bf16* gp = P1 + ((size_t)b * SEQ + (size_t)seg * HSEG + pt) * N_BCA + 1536 + h * 128 + pc8;
        v4u rq, rf, rv, rg;
        rf = *(const v4u*)(gp + 512); rv = *(const v4u*)(gp + 1024);
        if (PASS == 2) { rq = *(const v4u*)gp; rg = *(const v4u*)(gp + 1536); }
        for (int c = 0; c < HSEG / HCH; ++c) {
            *(LAS v4u*)(L + H_RAWF + pt * HRS + pc8 * 2) = rf; *(LAS v4u*)(L + H_V + pt * HRS + pc8 * 2) = rv;
            if (PASS == 2) *(LAS v4u*)(L + H_RAWQ + pt * HRS + pc8 * 2) = rq;
            v4u cg; if (PASS == 2) cg = rg;
            __syncthreads();
            if (c + 1 < HSEG / HCH) { const bf16* np = gp + (size_t)(c + 1) * HCH * N_BCA; rf = *(const v4u*)(np + 512); rv = *(const v4u*)(np + 1024);
                if (PASS == 2) { rq = *(const v4u*)np; rg = *(const v4u*)(np + 1536); } }
            { const bf16x8_t f8 = cat4(tr_read(L + H_RAWF + (8 * g + q_) * HRS + 32 * w + 8 * p_), tr_read(L + H_RAWF + (8 * g + 4 + q_) * HRS + 32 * w + 8 * p_));
              float eb[8], kk[8]; float cp = 1.0f;
#pragma unroll
              for (int i = 0; i < 8; ++i) { const float sg = __builtin_amdgcn_rcpf(1.0f + __expf(-bfs(f8[i]))); const float f = lbf + oml * sg; kk[i] = oml * (1.0f - sg); cp *= f; eb[i] = cp; }
              const float s1 = shl(cp, n), s2 = shl(cp, 16 + n), s3 = shl(cp, 32 + n), s4 = shl(cp, 48 + n);
              const float pre = (g > 0 ? s1 : 1.0f) * (g > 1 ? s2 : 1.0f) * (g > 2 ? s3 : 1.0f);
              const float elast = ((s1 * s2) * s3) * s4;
              float kh[8], kt8[8];
#pragma unroll
              for (int i = 0; i < 8; ++i) { eb[i] *= pre; const float en = __builtin_amdgcn_rcpf(fmaxf(eb[i], 1e-30f)); kt8[i] = kk[i] * en; kh[i] = kt8[i] * elast; }
              *(LAS v4u*)(L + H_KHT + d * TRS + 16 * g) = pack8(kh);
              if (PASS == 2) { const bf16x8_t q8 = cat4(tr_read(L + H_RAWQ + (8 * g + q_) * HRS + 32 * w + 8 * p_), tr_read(L + H_RAWQ + (8 * g + 4 + q_) * HRS + 32 * w + 8 * p_));
                  float qh[8];
#pragma unroll
                  for (int i = 0; i < 8; ++i) qh[i] = siluf_(bfs(q8[i])) * eb[i];
                  *(LAS v4u*)(L + H_QHT + d * TRS + 16 * g) = pack8(qh); *(LAS v4u*)(L + H_KTT + d * TRS + 16 * g) = pack8(kt8); }
              if (g == 0) *(LAS float*)(L + H_DL + 4 * d) = elast;
              dprod *= elast; }
            __syncthreads();
            const bf16x8_t bVn = cat4(tr_read(L + H_V + (8 * g + q_) * HRS + 32 * w + 8 * p_), tr_read(L + H_V + (8 * g + 4 + q_) * HRS + 32 * w + 8 * p_));
            if (PASS == 2) {
                const bf16x8_t bVp = cat4(tr_read(L + H_V + (4 * g + q_) * HRS + 32 * w + 8 * p_), tr_read(L + H_V + (16 + 4 * g + q_) * HRS + 32 * w + 8 * p_));
                f32x4 o[2], pt00 = {0.f, 0.f, 0.f, 0.f}, pt01 = {0.f, 0.f, 0.f, 0.f}, pt11 = {0.f, 0.f, 0.f, 0.f};
                o[0] = (f32x4){0.f, 0.f, 0.f, 0.f}; o[1] = (f32x4){0.f, 0.f, 0.f, 0.f};
#pragma unroll
                for (int ks = 0; ks < 4; ++ks) {
                    const bf16x8_t sb = pack_acc(S[2 * ks], S[2 * ks + 1]);
#pragma unroll
                    for (int tm = 0; tm < 2; ++tm) {
                        const bf16x8_t aq = cat4(tr_read(L + H_QHT + (32 * ks + 4 * g + q_) * TRS + 32 * tm + 8 * p_), tr_read(L + H_QHT + (32 * ks + 16 + 4 * g + q_) * TRS + 32 * tm + 8 * p_));
                        o[tm] = __builtin_amdgcn_mfma_f32_16x16x32_bf16(aq, sb, o[tm], 0, 0, 0); }
                    const bf16x8_t aK0 = cat4(tr_read(L + H_KTT + (32 * ks + 8 * g + q_) * TRS + 8 * p_), tr_read(L + H_KTT + (32 * ks + 8 * g + 4 + q_) * TRS + 8 * p_));
                    const bf16x8_t aK1 = cat4(tr_read(L + H_KTT + (32 * ks + 8 * g + q_) * TRS + 32 + 8 * p_), tr_read(L + H_KTT + (32 * ks + 8 * g + 4 + q_) * TRS + 32 + 8 * p_));
                    const bf16x8_t bQ0 = cat4(tr_read(L + H_QHT + (32 * ks + 8 * g + q_) * TRS + 8 * p_), tr_read(L + H_QHT + (32 * ks + 8 * g + 4 + q_) * TRS + 8 * p_));
                    const bf16x8_t bQ1 = cat4(tr_read(L + H_QHT + (32 * ks + 8 * g + q_) * TRS + 32 + 8 * p_), tr_read(L + H_QHT + (32 * ks + 8 * g + 4 + q_) * TRS + 32 + 8 * p_));
                    pt00 = __builtin_amdgcn_mfma_f32_16x16x32_bf16(aK0, bQ0, pt00, 0, 0, 0);
                    pt01 = __builtin_amdgcn_mfma_f32_16x16x32_bf16(aK0, bQ1, pt01, 0, 0, 0);
                    pt11 = __builtin_amdgcn_mfma_f32_16x16x32_bf16(aK1, bQ1, pt11, 0, 0, 0);
                }
#pragma unroll
                for (int j = 0; j < 4; ++j) if (4 * g + j > n) { pt00[j] = 0.f; pt11[j] = 0.f; }
                const f32x4 z4 = {0.f, 0.f, 0.f, 0.f};
                o[0] = __builtin_amdgcn_mfma_f32_16x16x32_bf16(pack_acc(pt00, z4), bVp, o[0], 0, 0, 0);
                o[1] = __builtin_amdgcn_mfma_f32_16x16x32_bf16(pack_acc(pt01, pt11), bVp, o[1], 0, 0, 0);
#pragma unroll
                for (int tm = 0; tm < 2; ++tm)
#pragma unroll
                    for (int j = 0; j < 4; ++j) *(LAS float*)(L + H_OB + ((16 * tm + 4 * g + j) * H_OBS + 16 * w + n) * 4) = o[tm][j];
            }
#pragma unroll
            for (int kt = 0; kt < 8; ++kt) { const f32x4 dl4 = *(const LAS f32x4*)(L + H_DL + (16 * kt + 4 * g) * 4);
                const bf16x8_t aKh = *(const LAS bf16x8_t*)(L + H_KHT + (16 * kt + n) * TRS + 16 * g);
                S[kt] = __builtin_amdgcn_mfma_f32_16x16x32_bf16(aKh, bVn, S[kt] * dl4, 0, 0, 0); }
            __syncthreads();
            if (PASS == 2) {
                const f32x4 o0 = *(const LAS f32x4*)(L + H_OB + (pt * H_OBS + pc8) * 4), o1 = *(const LAS f32x4*)(L + H_OB + (pt * H_OBS + pc8 + 4) * 4);
                const float o8[8] = {o0.x, o0.y, o0.z, o0.w, o1.x, o1.y, o1.z, o1.w};
                float ss = 0.f;
#pragma unroll
                for (int i = 0; i < 8; ++i) ss += o8[i] * o8[i];
                ss += shx(ss, 1, lane); ss += shx(ss, 2, lane); ss += shx(ss, 4, lane); ss += shx(ss, 8, lane);
                const float rs = 1.0f / sqrtf(ss * (1.0f / 128.0f) + EPS);
                float g8[8], y[8]; unpack8(cg, g8);
#pragma unroll
                for (int i = 0; i < 8; ++i) y[i] = o8[i] * rs * nw8[i] * siluf_(g8[i]);
                *(v4u*)(yb + ((size_t)b * SEQ + (size_t)seg * HSEG + (size_t)c * HCH + pt) * 512 + h * 128 + pc8) = pack8(y);
            }
        }
        if (PASS == 1) {
#pragma unroll
            for (int kt = 0; kt < 8; ++kt) *(f32x4*)(ust + ((((size_t)u * 8 + w) * 8 + kt) * 64 + lane) * 4) = S[kt];
            if (g == 0) dst[(size_t)u * 128 + d] = dprod;
        }
        __syncthreads();
    }
}

constexpr int SG_V = 0, SG_OB = 34816, SG_OBS = 132, SG_RS = SG_OB + 128 * SG_OBS * 4;
__device__ __forceinline__ void p_sgu(Frame& F, const bf16* P1, const float* norm_w, const float* sgu_w, const float* sgu_b, bf16* yc) {
    LAS unsigned char* L = F.lds;
    const int lane = F.lane, w = F.wave, gq = lane >> 4, n = lane & 15, q_ = n >> 2, p_ = n & 3;
    const int sr = F.tid >> 4, c8 = (F.tid & 15) * 8;
    for (int u = F.bid; u < M / 128; u += F.G) {
        const size_t row0 = (size_t)u * 128;
        v4u rv[4][4]; float ssj[4] = {0.f, 0.f, 0.f, 0.f};
#pragma unroll
        for (int g = 0; g < 4; ++g)
#pragma unroll
            for (int j = 0; j < 4; ++j) { rv[g][j] = *(const v4u*)(P1 + (row0 + sr + 32 * j) * N_BCA + 4096 + g * 128 + c8); float f[8]; unpack8(rv[g][j], f);
#pragma unroll
                for (int i = 0; i < 8; ++i) ssj[j] += f[i] * f[i]; }
#pragma unroll
        for (int j = 0; j < 4; ++j) { float ss = ssj[j]; ss += shx(ss, 1, lane); ss += shx(ss, 2, lane); ss += shx(ss, 4, lane); ss += shx(ss, 8, lane);
            if (n == 0) *(LAS float*)(L + SG_RS + 4 * (sr + 32 * j)) = 1.0f / sqrtf(ss * (1.0f / 512.0f) + EPS); }
#pragma unroll
        for (int g = 0; g < 4; ++g) {
#pragma unroll
            for (int j = 0; j < 4; ++j) *(LAS v4u*)(L + SG_V + (sr + 32 * j) * HRS + c8 * 2) = rv[g][j];
            __syncthreads();
            float nwv[8];
            const int kmax = w >> 1, t = 16 * w + n;
            bf16x8_t aW[4];
            { f32x4 wl[4][2]; float nwl[8];
#pragma unroll
              for (int ks = 0; ks < 4; ++ks) { const float* wp = sgu_w + ((size_t)g * 128 + t) * 128 + 32 * ks + 8 * gq; wl[ks][0] = *(const f32x4*)wp; wl[ks][1] = *(const f32x4*)(wp + 4); }
#pragma unroll
              for (int ct = 0; ct < 8; ++ct) nwl[ct] = norm_w[g * 128 + 16 * ct + n];
              asm volatile("" ::: "memory");
#pragma unroll
              for (int ct = 0; ct < 8; ++ct) nwv[ct] = nwl[ct];
#pragma unroll
              for (int ks = 0; ks < 4; ++ks) { const int s0 = 32 * ks + 8 * gq;
                    const f32x4 w0 = wl[ks][0], w1 = wl[ks][1]; const f32x4 r0 = *(const LAS f32x4*)(L + SG_RS + 4 * s0), r1 = *(const LAS f32x4*)(L + SG_RS + 4 * (s0 + 4));
                    float a8[8] = {w0.x * r0.x, w0.y * r0.y, w0.z * r0.z, w0.w * r0.w, w1.x * r1.x, w1.y * r1.y, w1.z * r1.z, w1.w * r1.w};
#pragma unroll
                    for (int i = 0; i < 8; ++i) if (s0 + i > t) a8[i] = 0.f;
                    aW[ks] = __builtin_bit_cast(bf16x8_t, pack8(a8)); } }
            f32x4 acc[8];
#pragma unroll
            for (int ct = 0; ct < 8; ++ct) acc[ct] = (f32x4){0.f, 0.f, 0.f, 0.f};
#pragma unroll
            for (int ks = 0; ks < 4; ++ks) { if (ks <= kmax) {
#pragma unroll
                for (int ct = 0; ct < 8; ++ct) { const bf16x8_t bV = cat4(tr_read(L + SG_V + (32 * ks + 8 * gq + q_) * HRS + 32 * ct + 8 * p_), tr_read(L + SG_V + (32 * ks + 8 * gq + 4 + q_) * HRS + 32 * ct + 8 * p_));
                    acc[ct] = __builtin_amdgcn_mfma_f32_16x16x32_bf16(aW[ks], bV, acc[ct], 0, 0, 0); } } }
#pragma unroll
            for (int ct = 0; ct < 8; ++ct) { const float nw = nwv[ct];
#pragma unroll
                for (int j = 0; j < 4; ++j) *(LAS float*)(L + SG_OB + ((16 * w + 4 * gq + j) * SG_OBS + 16 * ct + n) * 4) = acc[ct][j] * nw; }
            __syncthreads();
            v4u ul[4]; float bl[4];
#pragma unroll
            for (int j = 0; j < 4; ++j) { ul[j] = *(const v4u*)(P1 + (row0 + sr + 32 * j) * N_BCA + 3584 + g * 128 + c8); bl[j] = sgu_b[g * 128 + sr + 32 * j]; }
            asm volatile("" ::: "memory");
#pragma unroll
            for (int j = 0; j < 4; ++j) { const int tt = sr + 32 * j; const float bias = bl[j];
                const f32x4 o0 = *(const LAS f32x4*)(L + SG_OB + (tt * SG_OBS + c8) * 4), o1 = *(const LAS f32x4*)(L + SG_OB + (tt * SG_OBS + c8 + 4) * 4);
                float uu[8], y[8]; unpack8(ul[j], uu);
                y[0] = (o0.x + bias) * uu[0]; y[1] = (o0.y + bias) * uu[1]; y[2] = (o0.z + bias) * uu[2]; y[3] = (o0.w + bias) * uu[3];
                y[4] = (o1.x + bias) * uu[4]; y[5] = (o1.y + bias) * uu[5]; y[6] = (o1.z + bias) * uu[6]; y[7] = (o1.w + bias) * uu[7];
                *(v4u*)(yc + (row0 + tt) * 512 + g * 128 + c8) = pack8(y); }
        }
        __syncthreads();
    }
}

__device__ __forceinline__ void p_norm_router(Frame& F, KArgs ka, const float* x, const float* w, const float* mod_l, bf16* h2) {
    const float* rw = ka->in[20]; const float* rb = ka->in[21]; unsigned* ctl = (unsigned*)(ka->ws + WS_CTL);
    float* topp = (float*)(ka->ws + WS_TOPP); int* list = (int*)(ka->ws + WS_LIST);
    LAS float* RWt = (LAS float*)F.lds;
    LAS int* lcnt = (LAS int*)(RWt + 8192);
    LAS int* lbase = lcnt + 16;
    LAS int* sel = lbase + 16;
    LAS int* rnk = sel + 128;
    for (int i = F.tid; i < D * NE; i += NT) { const int k = i >> 3, e = i & 7; RWt[e * D + k] = rw[i]; }
    __syncthreads();
    float rbv[8];
#pragma unroll
    for (int e = 0; e < 8; ++e) rbv[e] = rb[e];
    f32x4 wv[4];
#pragma unroll
    for (int j = 0; j < 4; ++j) wv[j] = ((const f32x4*)w)[F.lane + 64 * j];
    for (int batch = F.bid; batch < M / 128; batch += F.G) {
        const int row0 = batch * 128;
        if (F.tid < 16) lcnt[F.tid] = 0;
        const float* mb = mod_l + (size_t)(row0 >> 12) * MOD_LD;
        f32x4 scv[4], shv[4], xn[4];
#pragma unroll
        for (int j = 0; j < 4; ++j) { scv[j] = ((const f32x4*)(mb + 4 * D))[F.lane + 64 * j]; shv[j] = ((const f32x4*)(mb + 3 * D))[F.lane + 64 * j]; xn[j] = ((const f32x4*)(x + (size_t)(row0 + F.wave * 16) * D))[F.lane + 64 * j]; }
        asm volatile("" ::: "memory");
#pragma unroll
        for (int j = 0; j < 4; ++j) scv[j] = wv[j] * (scv[j] + 1.0f);
        __syncthreads();
        for (int rr = 0; rr < 16; ++rr) {
            const int r = F.wave * 16 + rr, row = row0 + r;
            f32x4 v[4];
#pragma unroll
            for (int j = 0; j < 4; ++j) v[j] = xn[j];
            if (rr + 1 < 16) {
#pragma unroll
                for (int j = 0; j < 4; ++j) xn[j] = ((const f32x4*)(x + (size_t)(row + 1) * D))[F.lane + 64 * j]; }
            float ssq = 0.f;
#pragma unroll
            for (int j = 0; j < 4; ++j) ssq += (v[j].x * v[j].x + v[j].y * v[j].y) + (v[j].z * v[j].z + v[j].w * v[j].w);
            const float rstd = 1.0f / sqrtf(wave_sum(ssq, F.lane) * (1.0f / D) + EPS);
            f32x4 o[4];
#pragma unroll
            for (int j = 0; j < 4; ++j) o[j] = v[j] * rstd * scv[j] + shv[j];
            if (MOE_FP8) { unsigned* o4 = (unsigned*)((unsigned char*)h2 + (size_t)row * D) + F.lane;
#pragma unroll
                for (int j = 0; j < 4; ++j) o4[64 * j] = pk4_f8(o[j].x * F8_SA, o[j].y * F8_SA, o[j].z * F8_SA, o[j].w * F8_SA); }
            else store_row_bf16(h2 + (size_t)row * D, F.lane, o);
            float lg[8];
#pragma unroll
            for (int e = 0; e < 8; ++e) { float s = 0.f;
#pragma unroll
                for (int j = 0; j < 4; ++j) { const f32x4 r4 = *(const LAS f32x4*)(RWt + e * D + 4 * F.lane + 256 * j); s += (o[j].x * r4.x + o[j].y * r4.y) + (o[j].z * r4.z + o[j].w * r4.w); }
                lg[e] = wave_sum(s, F.lane) + rbv[e]; }
            int i0 = 0; float v0 = lg[0];
#pragma unroll
            for (int e = 1; e < 8; ++e) if (lg[e] > v0) { v0 = lg[e]; i0 = e; }
            int i1 = -1; float v1 = -3.0e38f;
#pragma unroll
            for (int e = 0; e < 8; ++e) if (e != i0 && lg[e] > v1) { v1 = lg[e]; i1 = e; }
            if (F.lane == 0) {
                const float p0 = 1.0f / (1.0f + expf(v1 - v0));
                topp[(size_t)row * 2] = p0; topp[(size_t)row * 2 + 1] = 1.0f - p0;
                const int rk0 = __hip_atomic_fetch_add(lcnt + i0, 1, __ATOMIC_RELAXED, __HIP_MEMORY_SCOPE_WORKGROUP), rk1 = __hip_atomic_fetch_add(lcnt + 8 + i1, 1, __ATOMIC_RELAXED, __HIP_MEMORY_SCOPE_WORKGROUP);
                sel[r] = i0 | (i1 << 8); rnk[r] = rk0 | (rk1 << 16);
            }
        }
        __syncthreads();
        if (F.tid < 16) lbase[F.tid] = (int)__hip_atomic_fetch_add(ctl + CW_CNT + 64 * F.tid, (unsigned)lcnt[F.tid], __ATOMIC_RELAXED, __HIP_MEMORY_SCOPE_AGENT);
        __syncthreads();
        if (F.tid < 128) { const int sv = sel[F.tid], rv = rnk[F.tid]; const int e0 = sv & 255, e1 = sv >> 8;
            list[(size_t)e0 * LIST_CAP + lbase[e0] + (rv & 0xffff)] = row0 + F.tid;
            list[(size_t)(8 + e1) * LIST_CAP + lbase[8 + e1] + (rv >> 16)] = row0 + F.tid; }
        __syncthreads();
    }
}
__device__ __forceinline__ void moe_tables(Frame& F, unsigned* ctl, int pass) {
    LAS int* tab = (LAS int*)(F.lds + TAB_OFF);
    __syncthreads();
    if (F.tid == 0) { int pb = 0;
        for (int e = 0; e < 8; ++e) { int c = (int)__hip_atomic_load(ctl + CW_CNT + 64 * (pass * 8 + e), __ATOMIC_RELAXED, __HIP_MEMORY_SCOPE_AGENT); if (c > LIST_CAP) c = LIST_CAP; if (c < 0) c = 0;
            const int np = (c + 255) >> 8; tab[e] = c; tab[8 + e] = pb; for (int p = 0; p < np; ++p) tab[32 + pb + p] = e; pb += np; }
        tab[16] = pb; }
    __syncthreads();
}
template <bool GATHER_>
struct MoeOrder {
    static constexpr bool GATHER = GATHER_;
    pg8::StaticOrder so; const LAS int* tab; const int* list; int npn; unsigned rowbytes;
    __device__ __forceinline__ bool next(int i, pg8::Unit& u) const { if (!so.next(i, u)) return false; u.pb = tab[32 + u.pm] * npn + u.pn; return true; }
    __device__ __forceinline__ int tok_of(int pm, int r) const { const int e = tab[32 + pm]; const int idx = (pm - tab[8 + e]) * 256 + r; return idx < tab[e] ? list[(size_t)e * LIST_CAP + idx] : -1; }
    __device__ __forceinline__ unsigned a_row_off(const pg8::Unit& u, int r) const { const int t = tok_of(u.pm, r); return (unsigned)(t < 0 ? 0 : t) * rowbytes; }
};

struct EpiBranch {
    static constexpr bool PERM = true;
    const bf16* gate; bf16* mrg; int first;
    __device__ __forceinline__ void operator()(const pg8::f32x4 (&acc)[2][2][4][2], const pg8::Unit& u, int wr, int wc, int fr, int fq) const {
        const int row0 = u.pm * 256 + wr * 64 + fr, col0 = u.pn * 256 + wc * 32 + 8 * fq;
#pragma unroll
        for (int ai = 0; ai < 2; ++ai) {
            v4u gl[4][2], ml[4][2];
#pragma unroll
            for (int m = 0; m < 4; ++m)
#pragma unroll
                for (int bj = 0; bj < 2; ++bj) { const size_t row = (size_t)(row0 + ai * 128 + m * 16); const int col = col0 + bj * 128;
                    gl[m][bj] = *(const v4u*)(gate + row * N_G + col); ml[m][bj] = first ? (v4u){0u, 0u, 0u, 0u} : *(const v4u*)(mrg + row * D + col); }
            asm volatile("" ::: "memory");
#pragma unroll
            for (int m = 0; m < 4; ++m)
#pragma unroll
                for (int bj = 0; bj < 2; ++bj) { const size_t row = (size_t)(row0 + ai * 128 + m * 16); const int col = col0 + bj * 128;
                    float gg[8], mm[8], o[8]; unpack8(gl[m][bj], gg); unpack8(ml[m][bj], mm);
                    const pg8::f32x4 v0 = acc[ai][bj][m][0], v1 = acc[ai][bj][m][1];
                    o[0] = mm[0] + sigmoidf_(gg[0]) * v0[0]; o[1] = mm[1] + sigmoidf_(gg[1]) * v0[1]; o[2] = mm[2] + sigmoidf_(gg[2]) * v0[2]; o[3] = mm[3] + sigmoidf_(gg[3]) * v0[3];
                    o[4] = mm[4] + sigmoidf_(gg[4]) * v1[0]; o[5] = mm[5] + sigmoidf_(gg[5]) * v1[1]; o[6] = mm[6] + sigmoidf_(gg[6]) * v1[2]; o[7] = mm[7] + sigmoidf_(gg[7]) * v1[3];
                    *(v4u*)(mrg + row * D + col) = pack8(o); }
            asm volatile("" ::: "memory");
        }
    }
};
struct EpiResid {
    static constexpr bool PERM = false;
    const float* xin; float* xout; const float* gmod;
    __device__ __forceinline__ void operator()(const pg8::f32x4 (&acc)[2][2][4][2], const pg8::Unit& u, int wr, int wc, int fr, int fq) const {
        const int row0 = u.pm * 256 + wr * 64 + fr, col0 = u.pn * 256 + wc * 32 + 4 * fq;
        const float* gb = gmod + (size_t)((u.pm * 256) >> 12) * MOD_LD + col0;
        pg8::f32x4 gv[2][2];
#pragma unroll
        for (int bj = 0; bj < 2; ++bj)
#pragma unroll
            for (int n = 0; n < 2; ++n) gv[bj][n] = *(const pg8::f32x4*)(gb + bj * 128 + n * 16);
#pragma unroll
        for (int ai = 0; ai < 2; ++ai) {
            pg8::f32x4 xl[4][2][2];
#pragma unroll
            for (int m = 0; m < 4; ++m)
#pragma unroll
                for (int bj = 0; bj < 2; ++bj)
#pragma unroll
                    for (int n = 0; n < 2; ++n) xl[m][bj][n] = *(const pg8::f32x4*)(xin + (size_t)(row0 + ai * 128 + m * 16) * D + col0 + bj * 128 + n * 16);
            asm volatile("" ::: "memory");
#pragma unroll
            for (int m = 0; m < 4; ++m)
#pragma unroll
                for (int bj = 0; bj < 2; ++bj)
#pragma unroll
                    for (int n = 0; n < 2; ++n) *(pg8::f32x4*)(xout + (size_t)(row0 + ai * 128 + m * 16) * D + col0 + bj * 128 + n * 16) = xl[m][bj][n] + gv[bj][n] * acc[ai][bj][m][n];
            asm volatile("" ::: "memory");
        }
    }
};
template <bool F8 = false>
struct EpiSwiglu {
    static constexpr bool PERM = true;
    bf16* act; float inv;
    __device__ __forceinline__ void operator()(const pg8::f32x4 (&acc)[2][2][4][2], const pg8::Unit& u, int wr, int wc, int fr, int fq) const {
        const int row0 = u.pm * 256 + wr * 64 + fr, col0 = u.pn * 128 + wc * 32 + 8 * fq;
#pragma unroll
        for (int ai = 0; ai < 2; ++ai)
#pragma unroll
            for (int m = 0; m < 4; ++m) { float o[8];
#pragma unroll
                for (int n = 0; n < 2; ++n)
#pragma unroll
                    for (int i = 0; i < 4; ++i) o[n * 4 + i] = F8 ? siluf_(acc[ai][0][m][n][i] * inv) * (acc[ai][1][m][n][i] * inv) * F8_SACT : siluf_(acc[ai][0][m][n][i]) * acc[ai][1][m][n][i];
                if constexpr (F8) { typedef unsigned v2u_ __attribute__((ext_vector_type(2))); v2u_ w8; w8.x = pk4_f8(o[0], o[1], o[2], o[3]); w8.y = pk4_f8(o[4], o[5], o[6], o[7]);
                    *(v2u_*)((unsigned char*)act + (size_t)(row0 + ai * 128 + m * 16) * D_FF + col0) = w8; }
                else *(v4u*)(act + (size_t)(row0 + ai * 128 + m * 16) * D_FF + col0) = pack8(o); }
    }
};
struct EpiMoeDown {
    static constexpr bool PERM = false;
    float* x; const float* gmod; const float* topp; int pass; const LAS int* tab; const int* list; float oscale;
    __device__ __forceinline__ int tok_of(int pm, int r) const { const int e = tab[32 + pm]; const int idx = (pm - tab[8 + e]) * 256 + r; return idx < tab[e] ? list[(size_t)e * LIST_CAP + idx] : -1; }
    __device__ __forceinline__ void operator()(const pg8::f32x4 (&acc)[2][2][4][2], const pg8::Unit& u, int wr, int wc, int fr, int fq) const {
        const int col0 = u.pn * 256 + wc * 32 + 4 * fq;
        int tok[2][4];
#pragma unroll
        for (int ai = 0; ai < 2; ++ai)
#pragma unroll
            for (int m = 0; m < 4; ++m) tok[ai][m] = tok_of(u.pm, ai * 128 + wr * 64 + m * 16 + fr);
        asm volatile("" ::: "memory");
#pragma unroll
        for (int am = 0; am < 4; ++am) {
            const int ai = am >> 1, mb = (am & 1) * 2;
            pg8::f32x4 xl[2][2][2], gl[2][2][2]; float pv[2];
#pragma unroll
            for (int m = 0; m < 2; ++m) { const int t = tok[ai][mb + m] < 0 ? 0 : tok[ai][mb + m]; pv[m] = topp[(size_t)t * 2 + pass] * oscale; const float* gb = gmod + (size_t)(t >> 12) * MOD_LD + col0;
#pragma unroll
                for (int bj = 0; bj < 2; ++bj)
#pragma unroll
                    for (int n = 0; n < 2; ++n) { xl[m][bj][n] = *(const pg8::f32x4*)(x + (size_t)t * D + col0 + bj * 128 + n * 16); gl[m][bj][n] = *(const pg8::f32x4*)(gb + bj * 128 + n * 16); } }
            asm volatile("" ::: "memory");
#pragma unroll
            for (int m = 0; m < 2; ++m) { if (tok[ai][mb + m] >= 0) { const int t = tok[ai][mb + m];
#pragma unroll
                for (int bj = 0; bj < 2; ++bj)
#pragma unroll
                    for (int n = 0; n < 2; ++n) *(pg8::f32x4*)(x + (size_t)t * D + col0 + bj * 128 + n * 16) = xl[m][bj][n] + gl[m][bj][n] * pv[m] * acc[ai][bj][mb + m][n]; } }
            asm volatile("" ::: "memory");
        }
    }
};

__device__ __forceinline__ void p_final_norm(Frame& F, float* x, const float* w) {
    const int gw = F.bid * NWAVES + F.wave, NGW = F.G * NWAVES, lane = F.lane;
    f32x4 wv[4];
#pragma unroll
    for (int j = 0; j < 4; ++j) wv[j] = ((const f32x4*)w)[lane + 64 * j];
    for (int r0 = gw * 4; r0 < M; r0 += NGW * 4) {
        f32x4 v[4][4];
#pragma unroll
        for (int r = 0; r < 4; ++r)
#pragma unroll
            for (int j = 0; j < 4; ++j) v[r][j] = ((const f32x4*)(x + (size_t)(r0 + r) * D))[lane + 64 * j];
        asm volatile("" ::: "memory");
#pragma unroll
        for (int r = 0; r < 4; ++r) { float s = 0.f;
#pragma unroll
            for (int j = 0; j < 4; ++j) s += (v[r][j].x * v[r][j].x + v[r][j].y * v[r][j].y) + (v[r][j].z * v[r][j].z + v[r][j].w * v[r][j].w);
            const float rstd = 1.0f / sqrtf(wave_sum(s, lane) * (1.0f / D) + EPS);
#pragma unroll
            for (int j = 0; j < 4; ++j) ((f32x4*)(x + (size_t)(r0 + r) * D))[lane + 64 * j] = v[r][j] * rstd * wv[j]; }
    }
}
__device__ __forceinline__ bool fresh(Frame& F) {
    int w_ = F.w0, b_ = blockIdx.x, g_ = gridDim.x; asm volatile("" : "+s"(w_), "+s"(b_), "+s"(g_));
    int l_; asm volatile("v_mbcnt_lo_u32_b32 %0, -1, 0\n\tv_mbcnt_hi_u32_b32 %0, -1, %0" : "=v"(l_));
    int t_ = w_ * 64 + l_;
    F.tid = t_; F.lane = t_ & 63; F.wave = __builtin_amdgcn_readfirstlane(t_ >> 6); F.bid = b_; F.G = g_; return true;
}
constexpr int NPL = 13, NPHASE = 1 + DEPTH * NPL;
#if MK_PER_PHASE
#define GRID_BAR() do { } while (0)
#else
#define GRID_BAR() do { XcdBarrier b2_ = bar; asm volatile("" : "+s"(b2_.bar)); xcd_barrier(b2_); } while (0)
#endif
#ifdef ONLY_REL
#define IN(k) (KA()->ph_lo <= (k) && (k) < KA()->ph_hi && fresh(F) && ((k) == 0 ? 100 : ((k) - 1) % NPL) == ONLY_REL && (ONLY_L < 0 || ((k) - 1) / NPL == ONLY_L))
#else
#define IN(k) (KA()->ph_lo <= (k) && (k) < KA()->ph_hi && fresh(F))
#endif
#define SEAM(k) do { if ((k) + 1 < KA()->ph_hi) GRID_BAR(); } while (0)
template <int l>
__device__ __forceinline__ void layer_program(Frame& F, const XcdBarrier& bar, PG8_LAS unsigned char* ring) {
        const int pb = 1 + l * NPL;
#define WSP(off) (ka->ws + (off))
#define MODL ((const float*)WSP(WS_MOD) + (size_t)l * BATCH * MOD_LD)
#define WMIXL ((bf16*)WSP(WS_WMIX + (size_t)l * WMIX_STRIDE))
        if (IN(pb + 0)) {
#pragma unroll 1
          for (int rep = 0; rep < REPS(7); ++rep) { KArgs ka = KA(); p_norm(F, l == 0 ? ka->in[0] : (const float*)ka->out, ka->in[4] + l * D, MODL, 1 * D, 0, (bf16*)WSP(WS_H)); }
          SEAM(pb + 0); }
        if (IN(pb + 1)) {
            KArgs ka = KA();
            pg8::Gemm g{(bf16*)WSP(WS_H), WMIXL, D, D, D}; pg8::StaticOrder S; S.init(M / 256, N_BCA / 256, F.G, F.bid);
            pg8::EpiBf16 E{(bf16*)WSP(WS_P1), N_BCA, 1.0f / (float)REPS(8)};
#pragma unroll 1
            for (int rep = 0; rep < REPS(3); ++rep)
            pg8::gemm_phase<REPS(8)>(ring, g, S, E, F.tid); SEAM(pb + 1);
        }
        if (IN(pb + 2)) {
#pragma unroll 1
          for (int rep = 0; rep < REPS(1); ++rep) {
            __syncthreads();
            { KArgs ka = KA(); p_hgrn<1>(F, (const bf16*)WSP(WS_P1), ka->in[8], l, ka->in[9] + l * D_BV, (bf16*)WSP(WS_YB), (float*)WSP(WS_HU), (float*)WSP(WS_HD)); }
            __syncthreads();
            { KArgs ka = KA(); p_sgu(F, (const bf16*)WSP(WS_P1), ka->in[10] + l * D_C, ka->in[11] + (size_t)l * 4 * 128 * 128, ka->in[12] + l * 4 * 128, (bf16*)WSP(WS_YC)); }
            { KArgs ka = KA(); p_conv(F, (const bf16*)WSP(WS_P1), ka->in[7] + l * 3 * D_A, (bf16*)WSP(WS_YA)); }
          }
            SEAM(pb + 2);
        }
        if (IN(pb + 3)) {
#pragma unroll 1
          for (int rep = 0; rep < REPS(2); ++rep)
            { KArgs ka = KA(); p_hgrn<2>(F, (const bf16*)WSP(WS_P1), ka->in[8], l, ka->in[9] + l * D_BV, (bf16*)WSP(WS_YB), (float*)WSP(WS_HU), (float*)WSP(WS_HD)); }
            SEAM(pb + 3);
        }
        if (IN(pb + 4)) {
            KArgs ka = KA();
            pg8::Gemm g{(bf16*)WSP(WS_H), WMIXL + (size_t)N_BCA * D, D, D, D}; pg8::StaticOrder S; S.init(M / 256, N_G / 256, F.G, F.bid);
            pg8::EpiBf16 E{(bf16*)WSP(WS_PG), N_G, 1.0f};
            pg8::gemm_phase(ring, g, S, E, F.tid); SEAM(pb + 4);
        }
        if (IN(pb + 5)) {
#pragma unroll 1
            for (int br = 0; br < 3; ++br) {
                KArgs ka = KA();
                pg8::Gemm g{(bf16*)WSP(WS_YA + (size_t)br * 32 * MiB), WMIXL + (size_t)N_IN * D + (size_t)br * 512 * 1024, 512, 512, 512}; pg8::StaticOrder S; S.init(M / 256, D / 256, F.G, F.bid);
                EpiBranch E{(const bf16*)WSP(WS_PG) + br * D, (bf16*)WSP(WS_MRG), br == 0 ? 1 : 0};
                pg8::gemm_phase(ring, g, S, E, F.tid);
            }
            SEAM(pb + 5);
        }
        if (IN(pb + 6)) {
            KArgs ka = KA();
            pg8::Gemm g{(bf16*)WSP(WS_MRG), WMIXL + (size_t)N_IN * D + 3 * 512 * 1024, D, D, D}; pg8::StaticOrder S; S.init(M / 256, D / 256, F.G, F.bid);
            EpiResid E{l == 0 ? ka->in[0] : (const float*)ka->out, ka->out, MODL + 2 * D};
            pg8::gemm_phase(ring, g, S, E, F.tid); SEAM(pb + 6);
        }
        if (l == 0) {
            if (IN(pb + 7)) { KArgs ka = KA(); p_norm(F, ka->out, ka->in[5] + l * D, MODL, 4 * D, 3 * D, (bf16*)WSP(WS_H)); SEAM(pb + 7); }
            if (IN(pb + 8)) {
                KArgs ka = KA();
                pg8::Gemm g{(bf16*)WSP(WS_H), (bf16*)WSP(WS_W13), D, D, D}; pg8::StaticOrder S; S.init(M / 256, N13 / 256, F.G, F.bid);
                EpiSwiglu<false> E{(bf16*)WSP(WS_ACT), 1.0f};
                pg8::gemm_phase(ring, g, S, E, F.tid); SEAM(pb + 8);
            }
            if (IN(pb + 9)) {
                KArgs ka = KA();
                pg8::Gemm g{(bf16*)WSP(WS_ACT), (bf16*)WSP(WS_W2), D_FF, D_FF, D_FF}; pg8::StaticOrder S; S.init(M / 256, D / 256, F.G, F.bid);
                EpiResid E{ka->out, ka->out, MODL + 5 * D};
                pg8::gemm_phase(ring, g, S, E, F.tid); SEAM(pb + 9);
            }
        } else {
            if (IN(pb + 7)) {
#pragma unroll 1
                for (int rep = 0; rep < REPS(6); ++rep) { __syncthreads(); p_moe_weights(F, KA()); }
                __syncthreads(); { KArgs ka = KA(); p_norm_router(F, ka, ka->out, ka->in[5] + l * D, MODL, (bf16*)WSP(WS_H2M)); } SEAM(pb + 7); }
#pragma unroll 1
            for (int pass = 0; pass < 2; ++pass) {
#ifndef NO_MOE_UP
                if (IN(pb + 8 + 2 * pass)) {
                    KArgs ka = KA();
                    moe_tables(F, (unsigned*)WSP(WS_CTL), pass);
                    const LAS int* tab = (const LAS int*)(F.lds + TAB_OFF);
                    MoeOrder<true> S; S.so.init(tab[16], N13 / 256, F.G, F.bid); S.tab = tab; S.list = (const int*)WSP(WS_LIST) + (size_t)pass * 8 * LIST_CAP; S.npn = N13 / 256; S.rowbytes = D * MOE_ES;
                    pg8::Gemm g{(bf16*)WSP(WS_H2M), (bf16*)WSP(WS_WM13), D * MOE_ES / 2, D * MOE_ES / 2, D * MOE_ES / 2};
                    EpiSwiglu<MOE_FP8> E{(bf16*)WSP(WS_ACTM), 1.0f / (F8_SA * F8_SW)};
#pragma unroll 1
                    for (int rep = 0; rep < REPS(4); ++rep)
                    pg8::gemm_phase<1, MOE_FP8>(ring, g, S, E, F.tid); SEAM(pb + 8 + 2 * pass);
                }
#endif
#ifndef NO_MOE_DOWN
                if (IN(pb + 9 + 2 * pass)) {
                    KArgs ka = KA();
                    moe_tables(F, (unsigned*)WSP(WS_CTL), pass);
                    const LAS int* tab = (const LAS int*)(F.lds + TAB_OFF);
                    MoeOrder<false> S; S.so.init(tab[16], D / 256, F.G, F.bid); S.tab = tab; S.list = (const int*)WSP(WS_LIST) + (size_t)pass * 8 * LIST_CAP; S.npn = D / 256; S.rowbytes = 0;
                    pg8::Gemm g{(bf16*)WSP(WS_ACTM), (bf16*)WSP(WS_WM2), D_FF * MOE_ES / 2, D_FF * MOE_ES / 2, D_FF * MOE_ES / 2};
                    EpiMoeDown E{ka->out, MODL + 5 * D, (const float*)WSP(WS_TOPP), pass, tab, S.list, MOE_FP8 ? 1.0f / (F8_SACT * F8_SW) : 1.0f};
                    pg8::gemm_phase<1, MOE_FP8>(ring, g, S, E, F.tid); SEAM(pb + 9 + 2 * pass);
                }
#endif
            }
            if (IN(pb + 12)) { KArgs ka = KA(); p_final_norm(F, ka->out, ka->in[25]); }
        }
}
__global__ void __launch_bounds__(NT, 2) fwd(Args args) {
    extern __shared__ __attribute__((aligned(16))) unsigned char lds[];
    Frame F;
    F.lds = (LAS unsigned char*)lds;
    F.tid = threadIdx.x; F.lane = F.tid & 63; F.wave = __builtin_amdgcn_readfirstlane(F.tid >> 6); F.w0 = F.wave;
    F.G = gridDim.x; F.bid = blockIdx.x;
    volatile LAS unsigned* MISC = (volatile LAS unsigned*)(F.lds + MISC_OFF);
    if (F.tid < 32) MISC[F.tid] = 0u;
    __syncthreads();
#if !MK_PER_PHASE
    XcdBarrier bar = xcd_barrier_post((unsigned*)(KA()->ws + WS_CTL) + CW_BAR, MISC + 8);
#else
    XcdBarrier bar; bar.bar = nullptr; bar.x = 0; bar.st = nullptr;
#endif
    PG8_LAS unsigned char* ring = (PG8_LAS unsigned char*)lds;

    if (IN(0)) {
#pragma unroll 1
        for (int rep = 0; rep < REPS(5); ++rep) { __syncthreads(); p_prologue(F, KA()); }
        SEAM(0); }

    layer_program<0>(F, bar, ring);
    layer_program<1>(F, bar, ring);
#undef IN
#undef SEAM
}

extern "C" void kernel_launch(void* const* d_in, const int* in_sizes, int n_in, void* d_out, int out_size, void* d_ws, size_t ws_size, hipStream_t stream) {
    static int grid = 0;
    if (grid == 0) {
        if (n_in != 26 || in_sizes[0] != M * D || out_size != M * D || ws_size < WS_NEED) { fprintf(stderr, "kernel_launch: unexpected shapes / workspace (n_in %d, ws %zu, need %zu); nothing launched\n", n_in, ws_size, (size_t)WS_NEED); grid = -1; return; }
        int dev = 0, cus = 0, per_cu = 0;
        if (hipGetDevice(&dev) != hipSuccess || hipDeviceGetAttribute(&cus, hipDeviceAttributeMultiprocessorCount, dev) != hipSuccess) { grid = -1; return; }
        if (hipFuncSetAttribute((const void*)fwd, hipFuncAttributeMaxDynamicSharedMemorySize, LDS_BYTES) != hipSuccess) { fprintf(stderr, "kernel_launch: hipFuncSetAttribute failed\n"); grid = -1; return; }
        if (hipOccupancyMaxActiveBlocksPerMultiprocessor(&per_cu, (const void*)fwd, NT, LDS_BYTES) != hipSuccess || per_cu < 1) fprintf(stderr, "kernel_launch: occupancy query reports %d\n", per_cu);
        (void)hipGetLastError();
        grid = cus;
    }
    if (grid < 0) return;
    if (hipMemsetAsync((char*)d_ws + WS_CTL, 0, CTL_ZERO_BYTES, stream) != hipSuccess) return;
    Args a{};
    for (int i = 0; i < 26; ++i) a.in[i] = (const float*)d_in[i];
    a.out = (float*)d_out; a.ws = (unsigned char*)d_ws;
#if MK_PER_PHASE
    for (int p = 0; p < NPHASE; ++p) {
        if (p >= 1 + 10 && p <= 1 + 12) continue;
        a.ph_lo = p; a.ph_hi = p + 1;
        hipLaunchKernelGGL(fwd, dim3(grid), dim3(NT), LDS_BYTES, stream, a);
    }
#else
    a.ph_lo = 0; a.ph_hi = NPHASE;
    hipLaunchKernelGGL(fwd, dim3(grid), dim3(NT), LDS_BYTES, stream, a);
#endif
}
```

```cpp
#include <hip/hip_runtime.h>
#include <cstdio>
#include <cstdint>

#ifndef PROBE_DUP
#define PROBE_DUP 0
#endif
#ifndef PROBE_REPS
#define PROBE_REPS 2
#endif
#define REPS(k) ((PROBE_DUP == (k)) ? PROBE_REPS : 1)
#ifndef MK_PER_PHASE
#define MK_PER_PHASE 0
#endif

namespace pg8 {
#define PG8_LAS __attribute__((address_space(3)))
typedef unsigned short bf16_t;
typedef short bf16x8 __attribute__((ext_vector_type(8)));
typedef float f32x4 __attribute__((ext_vector_type(4)));
typedef unsigned u32x4 __attribute__((ext_vector_type(4)));
constexpr int BM = 256, BK = 64, HALF = 128, HTB = HALF * BK * 2, STAGE_BYTES = 8 * HTB, NXCD = 8, WGM = 8;

__host__ __device__ __forceinline__ int lds_byte(int r, int c) { const int st = (r >> 4) * 2 + (c >> 5), rr = r & 15, cc = c & 31, ob = rr * 64 + cc * 2; return st * 1024 + (ob ^ (((ob >> 9) & 1) << 5)); }
__host__ __device__ __forceinline__ void stage_rc(int b, int& R, int& C) { const int st = b / 1024, sb = b % 1024, swz = sb ^ (((sb >> 9) & 1) << 5); R = (st >> 1) * 16 + swz / 64; C = (st & 1) * 32 + (swz % 64) / 2; }
__host__ __device__ __forceinline__ int perm32(int rho) { const int n = rho >> 4, i = rho & 15; return 8 * (i >> 2) + 4 * n + (i & 3); }

struct Unit { int pm, pn, pb; };
struct Gemm { const bf16_t* A; const bf16_t* Bt; int lda, ldb, K; };

struct StaticOrder {
    static constexpr bool GATHER = false;
    int nM, nN, nwg, G, c;
    __device__ __forceinline__ void init(int nM_, int nN_, int G_, int c_) { nM = nM_; nN = nN_; nwg = nM * nN; G = G_; c = c_; }
    __device__ __forceinline__ bool next(int i, Unit& u) const {
        const long L = (long)i * G + c; if (L >= nwg) return false;
        int wgid = (int)L; { const int q = nwg / NXCD, r = nwg % NXCD, xcd = wgid % NXCD, off = wgid / NXCD; wgid = (xcd < r ? xcd * (q + 1) : r * (q + 1) + (xcd - r) * q) + off; }
        const int nig = WGM * nN, gid = wgid / nig, fm = gid * WGM, gsz = (nM - fm) < WGM ? (nM - fm) : WGM;
        u.pm = fm + ((wgid % nig) % gsz); u.pn = (wgid % nig) / gsz; u.pb = u.pn; return true;
    }
    __device__ __forceinline__ unsigned a_row_off(const Unit&, int) const { return 0u; }
};

__device__ __forceinline__ unsigned cvt_pk_bf16(float lo, float hi) { unsigned r; asm volatile("v_cvt_pk_bf16_f32 %0, %1, %2" : "=v"(r) : "v"(lo), "v"(hi)); return r; }

struct EpiBf16 {
    static constexpr bool PERM = true;
    bf16_t* O; int ldc; float scale;
    __device__ __forceinline__ void operator()(const f32x4 (&acc)[2][2][4][2], const Unit& u, int wr, int wc, int fr, int fq) const {
        const int row0 = u.pm * BM + wr * 64 + fr, col0 = u.pn * BM + wc * 32 + 8 * fq;
#pragma unroll
        for (int ai = 0; ai < 2; ++ai)
#pragma unroll
            for (int m = 0; m < 4; ++m) { bf16_t* rowp = O + (size_t)(row0 + ai * HALF + m * 16) * ldc + col0;
#pragma unroll
                for (int bj = 0; bj < 2; ++bj) { const f32x4 v0 = acc[ai][bj][m][0] * scale, v1 = acc[ai][bj][m][1] * scale;
                    u32x4 w; w.x = cvt_pk_bf16(v0[0], v0[1]); w.y = cvt_pk_bf16(v0[2], v0[3]); w.z = cvt_pk_bf16(v1[0], v1[1]); w.w = cvt_pk_bf16(v1[2], v1[3]);
                    *(u32x4*)(rowp + bj * HALF) = w; } }
    }
};

typedef int v8i32 __attribute__((ext_vector_type(8)));
typedef int v4i32 __attribute__((ext_vector_type(4)));
template <int KREP = 1, bool FP8 = false, class Epi, class Sched>
__device__ __forceinline__ void gemm_phase(PG8_LAS unsigned char* lds, const Gemm g, const Sched& S, const Epi& E, int tid_in) {
    constexpr bool GATHER = Sched::GATHER;
    int tid_ = tid_in; asm volatile("" : "+v"(tid_));
    const int tid = tid_, wid = __builtin_amdgcn_readfirstlane(tid >> 6), lane = tid & 63, wr = wid >> 2, wc = wid & 3, fr = lane & 15, fq = lane >> 4;
    const int K = g.K, nt = K / BK;
    unsigned voffB[2], vA0[2], vA1[2], nA0[2], nA1[2];
#pragma unroll
    for (int i = 0; i < 2; ++i) { int R, C; stage_rc(tid * 16 + i * 8192, R, C); const int Rb = Epi::PERM ? ((R & ~31) + perm32(R & 31)) : R;
        voffB[i] = (unsigned)(Rb * g.ldb + C) * 2u;
        vA0[i] = (unsigned)(R * g.lda + C) * 2u; vA1[i] = vA0[i]; nA0[i] = vA0[i]; nA1[i] = vA0[i]; }
    const size_t kstep = (size_t)(BK * 2);
    const size_t hstepB = (size_t)HALF * g.ldb * 2, tstepB = 2 * hstepB, tstepA = (size_t)BM * g.lda * 2;
    const size_t hstepA = GATHER ? (size_t)0 : (size_t)HALF * g.lda * 2;
    const unsigned ldsw = (unsigned)wid * 1024u;
    const int aoff = lds_byte(wr * 64 + fr, fq * 8), boff = lds_byte(wc * 32 + fr, fq * 8);
    PG8_LAS unsigned char* aptr = lds + aoff; PG8_LAS unsigned char* bptr = lds + 4 * HTB + boff; asm volatile("" : "+v"(aptr), "+v"(bptr));
#define PG8_SA(b, h) (((b) * 2 + (h)) * HTB)
#define PG8_SB(b, h) ((4 + (b) * 2 + (h)) * HTB)
#define PG8_STAGE(bufoff, gbase, voff) do { _Pragma("unroll") for (int _i = 0; _i < 2; ++_i) \
        __builtin_amdgcn_global_load_lds((const unsigned*)((const char*)(gbase) + (voff)[_i]), (PG8_LAS unsigned*)(lds + (bufoff) + ldsw + _i * 8192), 16, 0, 0); } while (0)
#define PG8_CAT8(x0, x1) __builtin_shufflevector(__builtin_bit_cast(v4i32, x0), __builtin_bit_cast(v4i32, x1), 0, 1, 2, 3, 4, 5, 6, 7)
#define PG8_RDA(off) (*(const PG8_LAS bf16x8*)(aptr + (off)))
#define PG8_RDB(off) (*(const PG8_LAS bf16x8*)(bptr + (off)))
#define PG8_LDA(dst, b, h) do { if constexpr (FP8) { _Pragma("unroll") for (int m = 0; m < 4; ++m) dst##8[m] = PG8_CAT8(PG8_RDA(PG8_SA(b, h) + m * 2048), PG8_RDA(PG8_SA(b, h) + m * 2048 + 1024)); } \
        else { _Pragma("unroll") for (int m = 0; m < 4; ++m) _Pragma("unroll") for (int k = 0; k < 2; ++k) dst[m][k] = PG8_RDA(PG8_SA(b, h) + m * 2048 + k * 1024); } } while (0)
#define PG8_LDB(dst, b, h) do { if constexpr (FP8) { _Pragma("unroll") for (int n = 0; n < 2; ++n) dst##8[n] = PG8_CAT8(PG8_RDB(PG8_SB(b, h) - 4 * HTB + n * 2048), PG8_RDB(PG8_SB(b, h) - 4 * HTB + n * 2048 + 1024)); } \
        else { _Pragma("unroll") for (int n = 0; n < 2; ++n) _Pragma("unroll") for (int k = 0; k < 2; ++k) dst[n][k] = PG8_RDB(PG8_SB(b, h) - 4 * HTB + n * 2048 + k * 1024); } } while (0)
#define PG8_MMA(ai, bj, At, Bt) do { __builtin_amdgcn_s_setprio(1); \
        if constexpr (FP8) { _Pragma("unroll") for (int m = 0; m < 4; ++m) _Pragma("unroll") for (int n = 0; n < 2; ++n) \
            asm volatile("v_mfma_scale_f32_16x16x128_f8f6f4 %0, %1, %2, %0, %3, %3 op_sel_hi:[0,0,0]" : "+v"(acc[ai][bj][m][n]) : "v"(Bt##8[n]), "v"(At##8[m]), "v"(sc1)); } \
        else { _Pragma("unroll") for (int m = 0; m < 4; ++m) _Pragma("unroll") for (int n = 0; n < 2; ++n) _Pragma("unroll") for (int k = 0; k < 2; ++k) \
            acc[ai][bj][m][n] = __builtin_amdgcn_mfma_f32_16x16x32_bf16(Bt[n][k], At[m][k], acc[ai][bj][m][n], 0, 0, 0); } \
        __builtin_amdgcn_s_setprio(0); } while (0)
#define PG8_WAIT_V(n) asm volatile("s_waitcnt vmcnt(" #n ")" ::: "memory")
#define PG8_WAIT_L(n) asm volatile("s_waitcnt lgkmcnt(" #n ")" ::: "memory")
#define PG8_BAR __builtin_amdgcn_s_barrier()
#define PG8_SCHED __builtin_amdgcn_sched_barrier(0)
#define PG8_GOFF(unit, d0, d1) do { _Pragma("unroll") for (int _i = 0; _i < 2; ++_i) { int R_, C_; stage_rc(tid * 16 + _i * 8192, R_, C_); \
        d0[_i] = S.a_row_off(unit, R_) + (unsigned)C_ * 2u; d1[_i] = S.a_row_off(unit, R_ + HALF) + (unsigned)C_ * 2u; } } while (0)
    Unit cur, nxt; int ui = 0;
    if (!S.next(0, cur)) return;
    f32x4 acc[2][2][4][2];
#pragma unroll
    for (int a = 0; a < 2; ++a)
#pragma unroll
        for (int b = 0; b < 2; ++b)
#pragma unroll
            for (int m = 0; m < 4; ++m)
#pragma unroll
                for (int n = 0; n < 2; ++n) acc[a][b][m][n] = (f32x4){0.f, 0.f, 0.f, 0.f};
    bf16x8 At[4][2], B0[2][2], B1[2][2];
    v8i32 At8[4], B08[2], B18[2];
    const int sc1 = 0x7f7f7f7f;
    if constexpr (GATHER) { PG8_GOFF(cur, vA0, vA1); }
    const char* cA = GATHER ? (const char*)g.A : (const char*)g.A + (size_t)cur.pm * tstepA; const char* cB = (const char*)g.Bt + (size_t)cur.pb * tstepB;
    PG8_STAGE(PG8_SB(0, 0), cB, voffB); PG8_STAGE(PG8_SB(0, 1), cB + hstepB, voffB); PG8_STAGE(PG8_SA(0, 0), cA, vA0); PG8_STAGE(PG8_SA(0, 1), cA + hstepA, vA1);
    if (wr == 1) PG8_BAR;
    PG8_WAIT_V(2); PG8_BAR;
    PG8_STAGE(PG8_SB(1, 0), cB + kstep, voffB); PG8_STAGE(PG8_SA(1, 0), cA + kstep, vA0); PG8_STAGE(PG8_SB(1, 1), cB + hstepB + kstep, voffB);
    PG8_WAIT_V(6); PG8_BAR;
    for (;;) {
        const bool has_next = S.next(ui + 1, nxt);
        const char* nA = GATHER ? (const char*)g.A : (has_next ? (const char*)g.A + (size_t)nxt.pm * tstepA : cA); const char* nB = has_next ? (const char*)g.Bt + (size_t)nxt.pb * tstepB : cB;
        if constexpr (GATHER) { if (has_next) { PG8_GOFF(nxt, nA0, nA1); } else {
#pragma unroll
            for (int i = 0; i < 2; ++i) { nA0[i] = vA0[i]; nA1[i] = vA1[i]; } } }
#pragma unroll 1
        for (int t = 0; t < nt * KREP; t += 2) {
            const bool last = (t == nt * KREP - 2);
            const int t1 = (KREP == 1) ? t + 1 : ((t + 1) & (nt - 1)), t2 = (KREP == 1) ? t + 2 : ((t + 2) & (nt - 1));
            const char* a1 = cA + (size_t)t1 * kstep;
            const char* a2 = last ? nA : cA + (size_t)t2 * kstep; const char* b2 = last ? nB : cB + (size_t)t2 * kstep;
            const char* a3 = a2 + kstep; const char* b3 = b2 + kstep;
            unsigned s0[2], s1[2];
#pragma unroll
            for (int i = 0; i < 2; ++i) { s0[i] = (GATHER && last) ? nA0[i] : vA0[i]; s1[i] = GATHER ? (last ? nA1[i] : vA1[i]) : vA0[i]; }
            PG8_LDB(B0, 0, 0); PG8_LDB(B1, 0, 1); PG8_SCHED; PG8_LDA(At, 0, 0); PG8_STAGE(PG8_SA(1, 1), a1 + hstepA, vA1);
            PG8_WAIT_V(8); PG8_WAIT_L(0); PG8_BAR; PG8_MMA(0, 0, At, B0); PG8_MMA(0, 1, At, B1); PG8_BAR; PG8_SCHED;
            PG8_LDA(At, 0, 1); PG8_STAGE(PG8_SB(0, 0), b2, voffB); PG8_STAGE(PG8_SB(0, 1), b2 + hstepB, voffB); PG8_STAGE(PG8_SA(0, 0), a2, s0);
            PG8_WAIT_V(8); PG8_WAIT_L(0); PG8_BAR; PG8_MMA(1, 0, At, B0); PG8_MMA(1, 1, At, B1); PG8_BAR; PG8_SCHED;
            PG8_LDB(B0, 1, 0); PG8_LDB(B1, 1, 1); PG8_SCHED; PG8_LDA(At, 1, 0); PG8_STAGE(PG8_SA(0, 1), a2 + hstepA, s1);
            PG8_WAIT_V(8); PG8_WAIT_L(0); PG8_BAR; PG8_MMA(0, 0, At, B0); PG8_MMA(0, 1, At, B1); PG8_BAR; PG8_SCHED;
            PG8_LDA(At, 1, 1); PG8_STAGE(PG8_SB(1, 0), b3, voffB); PG8_STAGE(PG8_SB(1, 1), b3 + hstepB, voffB); PG8_STAGE(PG8_SA(1, 0), a3, s0);
            PG8_WAIT_V(8); PG8_WAIT_L(0); PG8_BAR; PG8_MMA(1, 0, At, B0); PG8_MMA(1, 1, At, B1); PG8_BAR; PG8_SCHED;
        }
        if (wr == 0) PG8_BAR;
        E(acc, cur, wr, wc, fr, fq);
        if (!has_next) break;
#pragma unroll
        for (int a = 0; a < 2; ++a)
#pragma unroll
            for (int b = 0; b < 2; ++b)
#pragma unroll
                for (int m = 0; m < 4; ++m)
#pragma unroll
                    for (int n = 0; n < 2; ++n) acc[a][b][m][n] = (f32x4){0.f, 0.f, 0.f, 0.f};
        cur = nxt; cA = nA; cB = nB; ++ui;
        if constexpr (GATHER) {
#pragma unroll
            for (int i = 0; i < 2; ++i) { vA0[i] = nA0[i]; vA1[i] = nA1[i]; } }
        if (wr == 1) PG8_BAR;
    }
    PG8_WAIT_V(0);
    PG8_BAR;
#undef PG8_SA
#undef PG8_SB
#undef PG8_STAGE
#undef PG8_LDA
#undef PG8_LDB
#undef PG8_MMA
#undef PG8_WAIT_V
#undef PG8_WAIT_L
#undef PG8_BAR
#undef PG8_SCHED
#undef PG8_GOFF
#undef PG8_CAT8
#undef PG8_RDA
#undef PG8_RDB
}
}

constexpr int D = 1024, BATCH = 8, SEQ = 4096, M = BATCH * SEQ, DEPTH = 2;
constexpr int D_A = 512, D_BK = 512, D_BV = 512, D_C = 512, H_B = 4;
constexpr int N_IN = 7680, N_BCA = 4608, N_G = 3072;
constexpr int D_FF = 2816, NE = 8, N13 = 2 * D_FF;
constexpr int MOD_LD = 6 * D;
constexpr float EPS = 1e-6f;
constexpr int LIST_CAP = M;
constexpr int MOE_ROWS = M + NE * 256;

constexpr size_t MiB = 1u << 20;
constexpr size_t WS_CTL = 0, CTL_ZERO_BYTES = 1 * MiB;
constexpr size_t WS_MOD = 1 * MiB;
constexpr size_t WS_TOPP = 2 * MiB;
constexpr size_t WS_LIST = 3 * MiB;
constexpr size_t WS_WMIX = 6 * MiB, WMIX_STRIDE = 20 * MiB;
constexpr size_t WS_W13 = 46 * MiB, WS_W2 = 57 * MiB;
constexpr size_t WS_BIG = 64 * MiB;
constexpr size_t WS_H = WS_BIG;
constexpr size_t WS_P1 = WS_BIG + 64 * MiB;
constexpr size_t WS_PG = WS_P1;
constexpr size_t WS_MRG = WS_P1 + 192 * MiB;
constexpr size_t WS_YA = WS_P1 + 288 * MiB, WS_YB = WS_YA + 32 * MiB, WS_YC = WS_YB + 32 * MiB;
constexpr size_t WS_ACT = WS_P1;
constexpr size_t WS_HU = WS_YC + 32 * MiB;
constexpr size_t WS_HD = WS_HU + 16 * MiB;
constexpr size_t WS_MIX_END = WS_HD + 1 * MiB;
#ifndef MOE_FP8
#define MOE_FP8 1
#endif
#ifndef FFN_FP8
#define FFN_FP8 1
#endif
constexpr float F8_SA = 4.0f, F8_SW = 64.0f, F8_SACT = 8.0f;
constexpr int MOE_ES = MOE_FP8 ? 1 : 2;
constexpr size_t WS_WM13 = 6 * MiB;
constexpr size_t WS_WM2 = WS_WM13 + 88 * MiB;
constexpr size_t WS_H2M = WS_WM2 + 44 * MiB;
constexpr size_t WS_ACTM = WS_H2M + 64 * MiB;
constexpr size_t WS_MOE_END = WS_ACTM + (size_t)MOE_ROWS * D_FF * 2;
constexpr size_t WS_NEED = WS_MIX_END > WS_MOE_END ? WS_MIX_END : WS_MOE_END;
static_assert(WS_W2 + (size_t)D * D_FF * 2 <= WS_BIG && WS_WMIX + 2 * WMIX_STRIDE <= WS_W13, "ws map");
constexpr int CW_BAR = 4096;
constexpr int CW_CNT = 16384;

constexpr int LDS_BYTES = 147456;
constexpr int SCR_BYTES = 139264;
constexpr int TAB_OFF = SCR_BYTES;
constexpr int MISC_OFF = TAB_OFF + 4096;
static_assert(MISC_OFF + 128 <= LDS_BYTES, "LDS map");
constexpr int NWAVES = 8, NT = 512;

#define GAS __attribute__((address_space(1)))
#define LAS __attribute__((address_space(3)))
typedef unsigned short bf16;
typedef unsigned v4u __attribute__((ext_vector_type(4)));
typedef float f32x4 __attribute__((ext_vector_type(4)));
#define LDS_WAIT() asm volatile("s_waitcnt lgkmcnt(0)" ::: "memory")

typedef float f32x2_t __attribute__((ext_vector_type(2)));
typedef __bf16 bf16x2_t __attribute__((ext_vector_type(2)));
__device__ __forceinline__ unsigned pk2(float lo, float hi) { f32x2_t v = {lo, hi}; bf16x2_t b = __builtin_convertvector(v, bf16x2_t); return __builtin_bit_cast(unsigned, b); }
__device__ __forceinline__ float bf_lo(unsigned u) { return __uint_as_float(u << 16); }
__device__ __forceinline__ float bf_hi(unsigned u) { return __uint_as_float(u & 0xffff0000u); }
__device__ __forceinline__ void unpack8(const v4u w, float (&f)[8]) { f[0] = bf_lo(w.x); f[1] = bf_hi(w.x); f[2] = bf_lo(w.y); f[3] = bf_hi(w.y); f[4] = bf_lo(w.z); f[5] = bf_hi(w.z); f[6] = bf_lo(w.w); f[7] = bf_hi(w.w); }
__device__ __forceinline__ v4u pack8(const float (&f)[8]) { v4u w; w.x = pk2(f[0], f[1]); w.y = pk2(f[2], f[3]); w.z = pk2(f[4], f[5]); w.w = pk2(f[6], f[7]); return w; }
__device__ __forceinline__ float sigmoidf_(float x) { return __builtin_amdgcn_rcpf(1.0f + __expf(-x)); }
__device__ __forceinline__ float siluf_(float x) { return x * sigmoidf_(x); }
__device__ __forceinline__ float clamp_f8(float x) { return fminf(fmaxf(x, -448.0f), 448.0f); }
__device__ __forceinline__ unsigned pk4_f8(float a, float b, float c, float d) { int v = 0; v = __builtin_amdgcn_cvt_pk_fp8_f32(clamp_f8(a), clamp_f8(b), v, false); v = __builtin_amdgcn_cvt_pk_fp8_f32(clamp_f8(c), clamp_f8(d), v, true); return (unsigned)v; }
__device__ __forceinline__ float shx(float v, int mask, int lane) { return __int_as_float(__builtin_amdgcn_ds_bpermute((lane ^ mask) << 2, __float_as_int(v))); }
__device__ __forceinline__ float shl(float v, int src) { return __int_as_float(__builtin_amdgcn_ds_bpermute(src << 2, __float_as_int(v))); }
__device__ __forceinline__ float wave_sum(float v, int lane) {
#pragma unroll
    for (int o = 1; o < 64; o <<= 1) v += shx(v, o, lane);
    return v;
}

#define XB_TMO      128
#define XB_XCNT(j)  (256  + 64 * (j))
#define XB_XSUB(j)  (1280 + 64 * (j))
#define XB_XGEN(j)  (2304 + 64 * (j))
#define XB_TOP      3328
#define XB_TOPGEN   3392
#define XCD_BAR_WORDS 3456
#define XB_SPIN_CAP (1u << 18)

__device__ __forceinline__ unsigned xb_ld(unsigned* p)              { return __hip_atomic_load(p, __ATOMIC_RELAXED, __HIP_MEMORY_SCOPE_AGENT); }
__device__ __forceinline__ unsigned xb_add(unsigned* p, unsigned v) { return __hip_atomic_fetch_add(p, v, __ATOMIC_RELAXED, __HIP_MEMORY_SCOPE_AGENT); }
__device__ __forceinline__ unsigned xb_xcc_id() { return (unsigned)__builtin_amdgcn_s_getreg((3 << 11) | 20) & 0xFu; }
#define XB_SPIN(cond, bar) do { unsigned _sp = 0; while (cond) { __builtin_amdgcn_s_sleep(1); \
    if ((++_sp & 255u) == 0u) { if (xb_ld(&(bar)[XB_TMO])) break; if (_sp > XB_SPIN_CAP) { atomicAdd(&(bar)[XB_TMO], 1u); break; } } } } while (0)

struct XcdBarrier { unsigned* bar; unsigned x; volatile LAS unsigned* st; };

__device__ __forceinline__ XcdBarrier xcd_barrier_post(unsigned* bar, volatile LAS unsigned* st) {
    XcdBarrier b; b.bar = bar; b.x = xb_xcc_id(); b.st = st;
    if (threadIdx.x == 0) (void)xb_add(&bar[XB_XCNT(b.x)], 1u);
    return b;
}
__device__ __forceinline__ void xcd_barrier_complete(unsigned* bar, unsigned x, unsigned& nloc, unsigned& nx) {
    const unsigned G = gridDim.x * gridDim.y * gridDim.z;
    unsigned sum, cnt, mine, sp = 0u;
    for (;;) {
        sum = 0u; cnt = 0u; mine = 0u;
        unsigned cv[16];
#pragma unroll
        for (unsigned j = 0; j < 16; ++j) cv[j] = xb_ld(&bar[XB_XCNT(j)]);
        asm volatile("" ::: "memory");
#pragma unroll
        for (unsigned j = 0; j < 16; ++j) { const unsigned c = cv[j]; sum += c; cnt += (c > 0u) ? 1u : 0u; mine = (j == x) ? c : mine; }
        if (sum == G) break;
        __builtin_amdgcn_s_sleep(1);
        if ((++sp & 255u) == 0u) { if (xb_ld(&bar[XB_TMO])) break; if (sp > XB_SPIN_CAP) { atomicAdd(&bar[XB_TMO], 1u); break; } }
    }
    nloc = mine > 0u ? mine : 1u; nx = cnt > 0u ? cnt : 1u;
}
__device__ __forceinline__ void xcd_barrier(const XcdBarrier& b) {
    asm volatile("s_waitcnt vmcnt(0)" ::: "memory");
    __syncthreads();
    if (threadIdx.x == 0) {
        unsigned* bar = b.bar;
        __builtin_amdgcn_s_waitcnt(0);
        unsigned nloc = b.st[0], nx = b.st[1];
        if (nloc == 0u) { xcd_barrier_complete(bar, b.x, nloc, nx); b.st[0] = nloc; b.st[1] = nx; }
        const unsigned old = xb_add(&bar[XB_XSUB(b.x)], 1u);
        const unsigned gen = old / nloc;
        if (old + 1u == (gen + 1u) * nloc) {
            __builtin_amdgcn_fence(__ATOMIC_RELEASE, "agent");
            asm volatile("s_waitcnt vmcnt(0)" ::: "memory");
            const unsigned og = xb_add(&bar[XB_TOP], 1u);
            const unsigned tg = og / nx;
            if (og + 1u == (tg + 1u) * nx) xb_add(&bar[XB_TOPGEN], 1u);
            else XB_SPIN(xb_ld(&bar[XB_TOPGEN]) == tg, bar);
            __builtin_amdgcn_fence(__ATOMIC_ACQUIRE, "agent");
            xb_add(&bar[XB_XGEN(b.x)], 1u);
            asm volatile("s_waitcnt vmcnt(0)" ::: "memory");
        } else {
            XB_SPIN(xb_ld(&bar[XB_XGEN(b.x)]) == gen, bar);
            __builtin_amdgcn_fence(__ATOMIC_ACQUIRE, "agent");
            asm volatile("s_waitcnt vmcnt(0)" ::: "memory");
        }
    }
    __syncthreads();
}

struct Args { const float* in[26]; float* out; unsigned char* ws; int ph_lo, ph_hi; };
typedef const Args __attribute__((address_space(4)))* KArgs;
#define KA() ({ KArgs p_ = (KArgs)__builtin_amdgcn_kernarg_segment_ptr(); asm volatile("" : "+s"(p_)); p_; })
struct Frame {
    LAS unsigned char* lds;
    int tid, lane, wave, G, bid;
    int w0;
};

template <int MAP, bool F8 = false>
__device__ __forceinline__ void transpose_item(const float* W, int K, int N, bf16* WT, int row_off, LAS float* scr, int item, int lane) {
    const int nblk = N / 32, kb = item / nblk, nb = item % nblk, k0 = 64 * kb, n0 = 32 * nb;
    float vld[32];
#pragma unroll
    for (int i = 0; i < 32; ++i) vld[i] = W[(size_t)(k0 + 2 * i + (lane >> 5)) * N + n0 + (lane & 31)];
    asm volatile("" ::: "memory");
#pragma unroll
    for (int i = 0; i < 32; ++i) scr[(2 * i + (lane >> 5)) * 33 + (lane & 31)] = vld[i];
    LDS_WAIT(); asm volatile("" ::: "memory");
    const int c = lane & 7;
#pragma unroll
    for (int j = 0; j < 4; ++j) { const int n = (lane >> 3) + 8 * j; const LAS float* s = scr + (8 * c) * 33 + n;
        v4u o; o.x = pk2(s[0 * 33], s[1 * 33]); o.y = pk2(s[2 * 33], s[3 * 33]); o.z = pk2(s[4 * 33], s[5 * 33]); o.w = pk2(s[6 * 33], s[7 * 33]);
        const int nn = n0 + n; const int row = (MAP == 0) ? (row_off + nn) : ((nn >> 7) * 256 + row_off + (nn & 127));
        if constexpr (F8) { typedef unsigned v2u_ __attribute__((ext_vector_type(2))); v2u_ o8;
            o8.x = pk4_f8(s[0 * 33] * F8_SW, s[1 * 33] * F8_SW, s[2 * 33] * F8_SW, s[3 * 33] * F8_SW); o8.y = pk4_f8(s[4 * 33] * F8_SW, s[5 * 33] * F8_SW, s[6 * 33] * F8_SW, s[7 * 33] * F8_SW);
            *(v2u_*)((unsigned char*)WT + (size_t)row * K + k0 + 8 * c) = o8; }
        else *(v4u*)(WT + (size_t)row * K + k0 + 8 * c) = o; }
    LDS_WAIT(); asm volatile("" ::: "memory");
}

__device__ __forceinline__ void p_prologue(Frame& F, KArgs ka) {
    const float* c = ka->in[1]; const float* ada_w = ka->in[2]; const float* ada_b = ka->in[3];
    unsigned char* aws = ka->ws; float* mod = (float*)(aws + WS_MOD);
    LAS float* cact = (LAS float*)F.lds;
    LAS float* red = cact + 8192;
    for (int i = F.tid; i < BATCH * D; i += NT) cact[i] = siluf_(c[i]);
    __syncthreads();
    for (int chunk = F.bid; chunk < 256; chunk += F.G) {
        const int l = chunk >> 7, n0 = (chunk & 127) * 48;
        if (F.tid < 480) {
            const int kg = F.tid / 48, col = F.tid % 48;
            float acc[8];
#pragma unroll
            for (int b = 0; b < 8; ++b) acc[b] = 0.f;
            const float* wp = ada_w + (size_t)l * D * MOD_LD + n0 + col;
            for (int k = kg; k < D; k += 10) { const float w = wp[(size_t)k * MOD_LD];
#pragma unroll
                for (int b = 0; b < 8; ++b) acc[b] += cact[b * D + k] * w; }
#pragma unroll
            for (int b = 0; b < 8; ++b) red[(kg * 48 + col) * 8 + b] = acc[b];
        }
        __syncthreads();
        if (F.tid < 384) {
            const int col = F.tid >> 3, b = F.tid & 7; float s = 0.f;
#pragma unroll
            for (int kg = 0; kg < 10; ++kg) s += red[(kg * 48 + col) * 8 + b];
            mod[(size_t)(l * 8 + b) * MOD_LD + n0 + col] = s + ada_b[l * MOD_LD + n0 + col];
        }
        __syncthreads();
    }
    LAS float* scr = (LAS float*)(F.lds + F.wave * 16384);
    const int gw = F.bid * NWAVES + F.wave, NGW = F.G * NWAVES;
    constexpr int I_IN = (D / 64) * (N_IN / 32), I_BR = (512 / 64) * (D / 32), I_O = (D / 64) * (D / 32), I_L = I_IN + 3 * I_BR + I_O;
    constexpr int I_F1 = (D / 64) * (D_FF / 32), I_F2 = (D_FF / 64) * (D / 32);
    constexpr int NITEMS = 2 * I_L + 2 * I_F1 + I_F2;
    for (int it = gw; it < NITEMS; it += NGW) {
        int r = it;
        if (r < 2 * I_L) {
            const int l = r / I_L; r -= l * I_L;
            bf16* base = (bf16*)(aws + WS_WMIX + (size_t)l * WMIX_STRIDE);
            if (r < I_IN) { transpose_item<0>(ka->in[6] + (size_t)l * D * N_IN, D, N_IN, base, 0, scr, r, F.lane); continue; } r -= I_IN;
            if (r < I_BR) { transpose_item<0>(ka->in[13] + (size_t)l * 512 * D, 512, D, base + (size_t)N_IN * D, 0, scr, r, F.lane); continue; } r -= I_BR;
            if (r < I_BR) { transpose_item<0>(ka->in[14] + (size_t)l * 512 * D, 512, D, base + (size_t)N_IN * D + 512 * 1024, 0, scr, r, F.lane); continue; } r -= I_BR;
            if (r < I_BR) { transpose_item<0>(ka->in[15] + (size_t)l * 512 * D, 512, D, base + (size_t)N_IN * D + 2 * 512 * 1024, 0, scr, r, F.lane); continue; } r -= I_BR;
            transpose_item<0>(ka->in[16] + (size_t)l * D * D, D, D, base + (size_t)N_IN * D + 3 * 512 * 1024, 0, scr, r, F.lane); continue;
        }
        r -= 2 * I_L;
        if (r < I_F1) { transpose_item<1, FFN_FP8>(ka->in[17], D, D_FF, (bf16*)(aws + WS_W13), 0, scr, r, F.lane); continue; } r -= I_F1;
        if (r < I_F1) { transpose_item<1, FFN_FP8>(ka->in[18], D, D_FF, (bf16*)(aws + WS_W13), 128, scr, r, F.lane); continue; } r -= I_F1;
        transpose_item<0, FFN_FP8>(ka->in[19], D_FF, D, (bf16*)(aws + WS_W2), 0, scr, r, F.lane);
    }
}
__device__ __forceinline__ void p_moe_weights(Frame& F, KArgs ka) {
    unsigned char* aws = ka->ws;
    LAS float* scr = (LAS float*)(F.lds + F.wave * 16384);
    const int gw = F.bid * NWAVES + F.wave, NGW = F.G * NWAVES;
    constexpr int I_F1 = (D / 64) * (D_FF / 32), I_F2 = (D_FF / 64) * (D / 32), I_E = 2 * I_F1 + I_F2;
    for (int it = gw; it < NE * I_E; it += NGW) {
        const int e = it / I_E; int r = it - e * I_E;
        bf16* w13 = (bf16*)(aws + WS_WM13 + (size_t)e * N13 * D * MOE_ES); bf16* w2 = (bf16*)(aws + WS_WM2 + (size_t)e * D * D_FF * MOE_ES);
        if (r < I_F1) { transpose_item<1, MOE_FP8>(ka->in[22] + (size_t)e * D * D_FF, D, D_FF, w13, 0, scr, r, F.lane); continue; } r -= I_F1;
        if (r < I_F1) { transpose_item<1, MOE_FP8>(ka->in[23] + (size_t)e * D * D_FF, D, D_FF, w13, 128, scr, r, F.lane); continue; } r -= I_F1;
        transpose_item<0, MOE_FP8>(ka->in[24] + (size_t)e * D_FF * D, D_FF, D, w2, 0, scr, r, F.lane);
    }
}

__device__ __forceinline__ void norm_row(const float* xrow, const float* w, const float* sc, const float* sh, int lane, f32x4 (&o)[4]) {
    const f32x4* xr = (const f32x4*)xrow + lane;
    f32x4 v[4]; float s = 0.f;
#pragma unroll
    for (int j = 0; j < 4; ++j) { v[j] = xr[64 * j]; s += (v[j].x * v[j].x + v[j].y * v[j].y) + (v[j].z * v[j].z + v[j].w * v[j].w); }
    const float rstd = 1.0f / sqrtf(wave_sum(s, lane) * (1.0f / D) + EPS);
#pragma unroll
    for (int j = 0; j < 4; ++j) { const f32x4 wv = ((const f32x4*)w)[lane + 64 * j], scv = ((const f32x4*)sc)[lane + 64 * j], shv = ((const f32x4*)sh)[lane + 64 * j];
        o[j] = v[j] * rstd * wv * (scv + 1.0f) + shv; }
}
__device__ __forceinline__ void store_row_bf16(bf16* orow, int lane, const f32x4 (&o)[4]) {
    unsigned long long* o8 = (unsigned long long*)orow + lane;
#pragma unroll
    for (int j = 0; j < 4; ++j) o8[64 * j] = (unsigned long long)pk2(o[j].x, o[j].y) | ((unsigned long long)pk2(o[j].z, o[j].w) << 32);
}
template <bool F8 = false>
__device__ __forceinline__ void p_norm(Frame& F, const float* xin, const float* w, const float* mod_l, int sc_off, int sh_off, bf16* hout) {
    const int gw = F.bid * NWAVES + F.wave, NGW = F.G * NWAVES, lane = F.lane;
    f32x4 wv[4];
#pragma unroll
    for (int j = 0; j < 4; ++j) wv[j] = ((const f32x4*)w)[lane + 64 * j];
    for (int r0 = gw * 4; r0 < M; r0 += NGW * 4) {
        const float* mb = mod_l + (size_t)(r0 >> 12) * MOD_LD;
        f32x4 v[4][4], scv[4], shv[4];
#pragma unroll
        for (int r = 0; r < 4; ++r)
#pragma unroll
            for (int j = 0; j < 4; ++j) v[r][j] = ((const f32x4*)(xin + (size_t)(r0 + r) * D))[lane + 64 * j];
#pragma unroll
        for (int j = 0; j < 4; ++j) { scv[j] = ((const f32x4*)(mb + sc_off))[lane + 64 * j]; shv[j] = ((const f32x4*)(mb + sh_off))[lane + 64 * j]; }
        asm volatile("" ::: "memory");
#pragma unroll
        for (int j = 0; j < 4; ++j) scv[j] = wv[j] * (scv[j] + 1.0f);
#pragma unroll
        for (int r = 0; r < 4; ++r) { float s = 0.f;
#pragma unroll
            for (int j = 0; j < 4; ++j) s += (v[r][j].x * v[r][j].x + v[r][j].y * v[r][j].y) + (v[r][j].z * v[r][j].z + v[r][j].w * v[r][j].w);
            const float rstd = 1.0f / sqrtf(wave_sum(s, lane) * (1.0f / D) + EPS);
            f32x4 o[4];
#pragma unroll
            for (int j = 0; j < 4; ++j) o[j] = v[r][j] * rstd * scv[j] + shv[j];
            if constexpr (F8) { unsigned* o4 = (unsigned*)((unsigned char*)hout + (size_t)(r0 + r) * D) + lane;
#pragma unroll
                for (int j = 0; j < 4; ++j) o4[64 * j] = pk4_f8(o[j].x * F8_SA, o[j].y * F8_SA, o[j].z * F8_SA, o[j].w * F8_SA); }
            else store_row_bf16(hout + (size_t)(r0 + r) * D, lane, o); }
    }
}

__device__ __forceinline__ void p_conv(Frame& F, const bf16* P1, const float* conv_w, bf16* ya) {
    const int gt = F.bid * NT + F.tid, NGT = F.G * NT;
    for (int it = gt; it < M * 64; it += NGT) {
        const int row = it >> 6, c8 = (it & 63) * 8, pos = row & (SEQ - 1);
        const bf16* p = P1 + (size_t)row * N_BCA + c8;
        float ab[8], ac[8], ah[8], z1[8], z2[8], y[8];
        unpack8(*(const v4u*)p, ab); unpack8(*(const v4u*)(p + 512), ac); unpack8(*(const v4u*)(p + 1024), ah);
#pragma unroll
        for (int i = 0; i < 8; ++i) { z1[i] = 0.f; z2[i] = 0.f; }
        if (pos >= 1) { float c1[8], h1[8]; unpack8(*(const v4u*)(p - N_BCA + 512), c1); unpack8(*(const v4u*)(p - N_BCA + 1024), h1);
#pragma unroll
            for (int i = 0; i < 8; ++i) z1[i] = c1[i] * h1[i]; }
        if (pos >= 2) { float c2[8], h2[8]; unpack8(*(const v4u*)(p - 2 * N_BCA + 512), c2); unpack8(*(const v4u*)(p - 2 * N_BCA + 1024), h2);
#pragma unroll
            for (int i = 0; i < 8; ++i) z2[i] = c2[i] * h2[i]; }
#pragma unroll
        for (int i = 0; i < 8; ++i) y[i] = ab[i] * (conv_w[c8 + i] * (ac[i] * ah[i]) + conv_w[512 + c8 + i] * z1[i] + conv_w[1024 + c8 + i] * z2[i]);
        *(v4u*)(ya + (size_t)row * 512 + c8) = pack8(y);
    }
}

typedef short v4i16_t __attribute__((ext_vector_type(4)));
typedef short bf16x8_t __attribute__((ext_vector_type(8)));
typedef unsigned v2u __attribute__((ext_vector_type(2)));
constexpr int HRS = 272;
constexpr int TRS = 80;
constexpr int H_RAWQ = 0, H_RAWF = 8704, H_V = 17408, H_QHT = 26112, H_KTT = 36352, H_KHT = 46592, H_DL = 56832, H_OB = 57344, H_OBS = 132;
constexpr int HSEG = 512, HNSEG = SEQ / HSEG, HCH = 32;
__device__ __forceinline__ v4i16_t tr_read(LAS unsigned char* p) { return __builtin_amdgcn_ds_read_tr16_b64_v4i16((LAS v4i16_t*)p); }
__device__ __forceinline__ bf16x8_t cat4(v4i16_t lo, v4i16_t hi) { return __builtin_shufflevector(lo, hi, 0, 1, 2, 3, 4, 5, 6, 7); }
__device__ __forceinline__ bf16x8_t pack_acc(const f32x4 a, const f32x4 b) { v4u w; w.x = pk2(a[0], a[1]); w.y = pk2(a[2], a[3]); w.z = pk2(b[0], b[1]); w.w = pk2(b[2], b[3]); return __builtin_bit_cast(bf16x8_t, w); }
__device__ __forceinline__ float bfs(short x) { return __uint_as_float((unsigned)(unsigned short)x << 16); }
template <int PASS>
__device__ __forceinline__ void p_hgrn(Frame& F, const bf16* P1, const float* lb_logits, int layer, const float* norm_w, bf16* yb, float* ust, float* dst) {
    LAS unsigned char* L = F.lds;
    const int lane = F.lane, w = F.wave, g = lane >> 4, n = lane & 15, q_ = n >> 2, p_ = n & 3;
    const int pt = F.tid >> 4, pc8 = (F.tid & 15) * 8;
    for (int u = F.bid; u < BATCH * H_B * HNSEG; u += F.G) {
        const int seg = u & (HNSEG - 1), bh = u / HNSEG, b = bh >> 2, h = bh & 3;
        const int d = 16 * w + n;
        float lb; { const int ch = h * 128 + d; const float l0 = lb_logits[ch], l1 = lb_logits[512 + ch]; const float mx = fmaxf(l0, l1);
            const float e0 = expf(l0 - mx), e1 = expf(l1 - mx); const float p0 = e0 / (e0 + e1), p1 = e1 / (e0 + e1);
            const float lbx = (layer == 0) ? (p0 - p0) : ((p0 + p1) - p0); lb = fminf(fmaxf(lbx, 0.f), 1.f); }
        const float lbf = fmaxf(lb, 1e-30f), oml = 1.0f - lb;
        f32x4 S[8];
#pragma unroll
        for (int kt = 0; kt < 8; ++kt) S[kt] = (f32x4){0.f, 0.f, 0.f, 0.f};
        if (PASS == 2) {
            for (int j = 0; j < seg; ++j) { const int uj = u - seg + j;
#pragma unroll
                for (int kt = 0; kt < 8; ++kt) { const f32x4 dj = *(const f32x4*)(dst + (size_t)uj * 128 + 16 * kt + 4 * g); const f32x4 uu = *(const f32x4*)(ust + ((((size_t)uj * 8 + w) * 8 + kt) * 64 + lane) * 4);
                    S[kt] = dj * S[kt] + uu; } }
        }
        float nw8[8];
        if (PASS == 2) {
#pragma unroll
            for (int i = 0; i < 8; ++i) nw8[i] = norm_w[h * 128 + pc8 + i]; }
        float dprod = 1.0f;
        const bf16* gp = P1 + ((size_t)b * SEQ + (size_t)seg * HSEG + pt) * N_BCA + 1536 + h * 128 + pc8;
        v4u rq, rf, rv, rg;
        rf = *(const v4u*)(gp + 512); rv = *(const v4u*)(gp + 1024);
        if (PASS == 2) { rq = *(const v4u*)gp; rg = *(const v4u*)(gp + 1536); }
        for (int c = 0; c < HSEG / HCH; ++c) {
            *(LAS v4u*)(L + H_RAWF + pt * HRS + pc8 * 2) = rf; *(LAS v4u*)(L + H_V + pt * HRS + pc8 * 2) = rv;
            if (PASS == 2) *(LAS v4u*)(L + H_RAWQ + pt * HRS + pc8 * 2) = rq;
            v4u cg; if (PASS == 2) cg = rg;
            __syncthreads();
            if (c + 1 < HSEG / HCH) { const bf16* np = gp + (size_t)(c + 1) * HCH * N_BCA; rf = *(const v4u*)(np + 512); rv = *(const v4u*)(np + 1024);
                if (PASS == 2) { rq = *(const v4u*)np; rg = *(const v4u*)(np + 1536); } }
            { const bf16x8_t f8 = cat4(tr_read(L + H_RAWF + (8 * g + q_) * HRS + 32 * w + 8 * p_), tr_read(L + H_RAWF + (8 * g + 4 + q_) * HRS + 32 * w + 8 * p_));
              float eb[8], kk[8]; float cp = 1.0f;
#pragma unroll
              for (int i = 0; i < 8; ++i) { const float sg = __builtin_amdgcn_rcpf(1.0f + __expf(-bfs(f8[i]))); const float f = lbf + oml * sg; kk[i] = oml * (1.0f - sg); cp *= f; eb[i] = cp; }
              const float s1 = shl(cp, n), s2 = shl(cp, 16 + n), s3 = shl(cp, 32 + n), s4 = shl(cp, 48 + n);
              const float pre = (g > 0 ? s1 : 1.0f) * (g > 1 ? s2 : 1.0f) * (g > 2 ? s3 : 1.0f);
              const float elast = ((s1 * s2) * s3) * s4;
              float kh[8], kt8[8];
#pragma unroll
              for (int i = 0; i < 8; ++i) { eb[i] *= pre; const float en = __builtin_amdgcn_rcpf(fmaxf(eb[i], 1e-30f)); kt8[i] = kk[i] * en; kh[i] = kt8[i] * elast; }
              *(LAS v4u*)(L + H_KHT + d * TRS + 16 * g) = pack8(kh);
              if (PASS == 2) { const bf16x8_t q8 = cat4(tr_read(L + H_RAWQ + (8 * g + q_) * HRS + 32 * w + 8 * p_), tr_read(L + H_RAWQ + (8 * g + 4 + q_) * HRS + 32 * w + 8 * p_));
                  float qh[8];
#pragma unroll
                  for (int i = 0; i < 8; ++i) qh[i] = siluf_(bfs(q8[i])) * eb[i];
                  *(LAS v4u*)(L + H_QHT + d * TRS + 16 * g) = pack8(qh); *(LAS v4u*)(L + H_KTT + d * TRS + 16 * g) = pack8(kt8); }
              if (g == 0) *(LAS float*)(L + H_DL + 4 * d) = elast;
              dprod *= elast; }
            __syncthreads();
            const bf16x8_t bVn = cat4(tr_read(L + H_V + (8 * g + q_) * HRS + 32 * w + 8 * p_), tr_read(L + H_V + (8 * g + 4 + q_) * HRS + 32 * w + 8 * p_));
            if (PASS == 2) {
                const bf16x8_t bVp = cat4(tr_read(L + H_V + (4 * g + q_) * HRS + 32 * w + 8 * p_), tr_read(L + H_V + (16 + 4 * g + q_) * HRS + 32 * w + 8 * p_));
                f32x4 o[2], pt00 = {0.f, 0.f, 0.f, 0.f}, pt01 = {0.f, 0.f, 0.f, 0.f}, pt11 = {0.f, 0.f, 0.f, 0.f};
                o[0] = (f32x4){0.f, 0.f, 0.f, 0.f}; o[1] = (f32x4){0.f, 0.f, 0.f, 0.f};
#pragma unroll
                for (int ks = 0; ks < 4; ++ks) {
                    const bf16x8_t sb = pack_acc(S[2 * ks], S[2 * ks + 1]);
#pragma unroll
                    for (int tm = 0; tm < 2; ++tm) {
                        const bf16x8_t aq = cat4(tr_read(L + H_QHT + (32 * ks + 4 * g + q_) * TRS + 32 * tm + 8 * p_), tr_read(L + H_QHT + (32 * ks + 16 + 4 * g + q_) * TRS + 32 * tm + 8 * p_));
                        o[tm] = __builtin_amdgcn_mfma_f32_16x16x32_bf16(aq, sb, o[tm], 0, 0, 0); }
                    const bf16x8_t aK0 = cat4(tr_read(L + H_KTT + (32 * ks + 8 * g + q_) * TRS + 8 * p_), tr_read(L + H_KTT + (32 * ks + 8 * g + 4 + q_) * TRS + 8 * p_));
                    const bf16x8_t aK1 = cat4(tr_read(L + H_KTT + (32 * ks + 8 * g + q_) * TRS + 32 + 8 * p_), tr_read(L + H_KTT + (32 * ks + 8 * g + 4 + q_) * TRS + 32 + 8 * p_));
                    const bf16x8_t bQ0 = cat4(tr_read(L + H_QHT + (32 * ks + 8 * g + q_) * TRS + 8 * p_), tr_read(L + H_QHT + (32 * ks + 8 * g + 4 + q_) * TRS + 8 * p_));
                    const bf16x8_t bQ1 = cat4(tr_read(L + H_QHT + (32 * ks + 8 * g + q_) * TRS + 32 + 8 * p_), tr_read(L + H_QHT + (32 * ks + 8 * g + 4 + q_) * TRS + 32 + 8 * p_));
                    pt00 = __builtin_amdgcn_mfma_f32_16x16x32_bf16(aK0, bQ0, pt00, 0, 0, 0);
                    pt01 = __builtin_amdgcn_mfma_f32_16x16x32_bf16(aK0, bQ1, pt01, 0, 0, 0);
                    pt11 = __builtin_amdgcn_mfma_f32_16x16x32_bf16(aK1, bQ1, pt11, 0, 0, 0);
                }
#pragma unroll
                for (int j = 0; j < 4; ++j) if (4 * g + j > n) { pt00[j] = 0.f; pt11[j] = 0.f; }
                const f32x4 z4 = {0.f, 0.f, 0.f, 0.f};
                o[0] = __builtin_amdgcn_mfma_f32_16x16x32_bf16(pack_acc(pt00, z4), bVp, o[0], 0, 0, 0);
                o[1] = __builtin_amdgcn_mfma_f32_16x16x32_bf16(pack_acc(pt01, pt11), bVp, o[1], 0, 0, 0);
#pragma unroll
                for (int tm = 0; tm < 2; ++tm)
#pragma unroll
                    for (int j = 0; j < 4; ++j) *(LAS float*)(L + H_OB + ((16 * tm + 4 * g + j) * H_OBS + 16 * w + n) * 4) = o[tm][j];
            }
#pragma unroll
            for (int kt = 0; kt < 8; ++kt) { const f32x4 dl4 = *(const LAS f32x4*)(L + H_DL + (16 * kt + 4 * g) * 4);
                const bf16x8_t aKh = *(const LAS bf16x8_t*)(L + H_KHT + (16 * kt + n) * TRS + 16 * g);
                S[kt] = __builtin_amdgcn_mfma_f32_16x16x32_bf16(aKh, bVn, S[kt] * dl4, 0, 0, 0); }
            __syncthreads();
            if (PASS == 2) {
                const f32x4 o0 = *(const LAS f32x4*)(L + H_OB + (pt * H_OBS + pc8) * 4), o1 = *(const LAS f32x4*)(L + H_OB + (pt * H_OBS + pc8 + 4) * 4);
                const float o8[8] = {o0.x, o0.y, o0.z, o0.w, o1.x, o1.y, o1.z, o1.w};
                float ss = 0.f;
#pragma unroll
                for (int i = 0; i < 8; ++i) ss += o8[i] * o8[i];
                ss += shx(ss, 1, lane); ss += shx(ss, 2, lane); ss += shx(ss, 4, lane); ss += shx(ss, 8, lane);
                const float rs = 1.0f / sqrtf(ss * (1.0f / 128.0f) + EPS);
                float g8[8], y[8]; unpack8(cg, g8);
#pragma unroll
                for (int i = 0; i < 8; ++i) y[i] = o8[i] * rs * nw8[i] * siluf_(g8[i]);
                *(v4u*)(yb + ((size_t)b * SEQ + (size_t)seg * HSEG + (size_t)c * HCH + pt) * 512 + h * 128 + pc8) = pack8(y);
            }
        }
        if (PASS == 1) {
#pragma unroll
            for (int kt = 0; kt < 8; ++kt) *(f32x4*)(ust + ((((size_t)u * 8 + w) * 8 + kt) * 64 + lane) * 4) = S[kt];
            if (g == 0) dst[(size_t)u * 128 + d] = dprod;
        }
        __syncthreads();
    }
}

constexpr int SG_V = 0, SG_OB = 34816, SG_OBS = 132, SG_RS = SG_OB + 128 * SG_OBS * 4;
__device__ __forceinline__ void p_sgu(Frame& F, const bf16* P1, const float* norm_w, const float* sgu_w, const float* sgu_b, bf16* yc) {
    LAS unsigned char* L = F.lds;
    const int lane = F.lane, w = F.wave, gq = lane >> 4, n = lane & 15, q_ = n >> 2, p_ = n & 3;
    const int sr = F.tid >> 4, c8 = (F.tid & 15) * 8;
    for (int u = F.bid; u < M / 128; u += F.G) {
        const size_t row0 = (size_t)u * 128;
        v4u rv[4][4]; float ssj[4] = {0.f, 0.f, 0.f, 0.f};
#pragma unroll
        for (int g = 0; g < 4; ++g)
#pragma unroll
            for (int j = 0; j < 4; ++j) { rv[g][j] = *(const v4u*)(P1 + (row0 + sr + 32 * j) * N_BCA + 4096 + g * 128 + c8); float f[8]; unpack8(rv[g][j], f);
#pragma unroll
                for (int i = 0; i < 8; ++i) ssj[j] += f[i] * f[i]; }
#pragma unroll
        for (int j = 0; j < 4; ++j) { float ss = ssj[j]; ss += shx(ss, 1, lane); ss += shx(ss, 2, lane); ss += shx(ss, 4, lane); ss += shx(ss, 8, lane);
            if (n == 0) *(LAS float*)(L + SG_RS + 4 * (sr + 32 * j)) = 1.0f / sqrtf(ss * (1.0f / 512.0f) + EPS); }
#pragma unroll
        for (int g = 0; g < 4; ++g) {
#pragma unroll
            for (int j = 0; j < 4; ++j) *(LAS v4u*)(L + SG_V + (sr + 32 * j) * HRS + c8 * 2) = rv[g][j];
            __syncthreads();
            float nwv[8];
            const int kmax = w >> 1, t = 16 * w + n;
            bf16x8_t aW[4];
            { f32x4 wl[4][2]; float nwl[8];
#pragma unroll
              for (int ks = 0; ks < 4; ++ks) { const float* wp = sgu_w + ((size_t)g * 128 + t) * 128 + 32 * ks + 8 * gq; wl[ks][0] = *(const f32x4*)wp; wl[ks][1] = *(const f32x4*)(wp + 4); }
#pragma unroll
              for (int ct = 0; ct < 8; ++ct) nwl[ct] = norm_w[g * 128 + 16 * ct + n];
              asm volatile("" ::: "memory");
#pragma unroll
              for (int ct = 0; ct < 8; ++ct) nwv[ct] = nwl[ct];
#pragma unroll
              for (int ks = 0; ks < 4; ++ks) { const int s0 = 32 * ks + 8 * gq;
                    const f32x4 w0 = wl[ks][0], w1 = wl[ks][1]; const f32x4 r0 = *(const LAS f32x4*)(L + SG_RS + 4 * s0), r1 = *(const LAS f32x4*)(L + SG_RS + 4 * (s0 + 4));
                    float a8[8] = {w0.x * r0.x, w0.y * r0.y, w0.z * r0.z, w0.w * r0.w, w1.x * r1.x, w1.y * r1.y, w1.z * r1.z, w1.w * r1.w};
#pragma unroll
                    for (int i = 0; i < 8; ++i) if (s0 + i > t) a8[i] = 0.f;
                    aW[ks] = __builtin_bit_cast(bf16x8_t, pack8(a8)); } }
            f32x4 acc[8];
#pragma unroll
            for (int ct = 0; ct < 8; ++ct) acc[ct] = (f32x4){0.f, 0.f, 0.f, 0.f};
#pragma unroll
            for (int ks = 0; ks < 4; ++ks) { if (ks <= kmax) {
#pragma unroll
                for (int ct = 0; ct < 8; ++ct) { const bf16x8_t bV = cat4(tr_read(L + SG_V + (32 * ks + 8 * gq + q_) * HRS + 32 * ct + 8 * p_), tr_read(L + SG_V + (32 * ks + 8 * gq + 4 + q_) * HRS + 32 * ct + 8 * p_));
                    acc[ct] = __builtin_amdgcn_mfma_f32_16x16x32_bf16(aW[ks], bV, acc[ct], 0, 0, 0); } } }
#pragma unroll
            for (int ct = 0; ct < 8; ++ct) { const float nw = nwv[ct];
#pragma unroll
                for (int j = 0; j < 4; ++j) *(LAS float*)(L + SG_OB + ((16 * w + 4 * gq + j) * SG_OBS + 16 * ct + n) * 4) = acc[ct][j] * nw; }
            __syncthreads();
            v4u ul[4]; float bl[4];
#pragma unroll
            for (int j = 0; j < 4; ++j) { ul[j] = *(const v4u*)(P1 + (row0 + sr + 32 * j) * N_BCA + 3584 + g * 128 + c8); bl[j] = sgu_b[g * 128 + sr + 32 * j]; }
            asm volatile("" ::: "memory");
#pragma unroll
            for (int j = 0; j < 4; ++j) { const int tt = sr + 32 * j; const float bias = bl[j];
                const f32x4 o0 = *(const LAS f32x4*)(L + SG_OB + (tt * SG_OBS + c8) * 4), o1 = *(const LAS f32x4*)(L + SG_OB + (tt * SG_OBS + c8 + 4) * 4);
                float uu[8], y[8]; unpack8(ul[j], uu);
                y[0] = (o0.x + bias) * uu[0]; y[1] = (o0.y + bias) * uu[1]; y[2] = (o0.z + bias) * uu[2]; y[3] = (o0.w + bias) * uu[3];
                y[4] = (o1.x + bias) * uu[4]; y[5] = (o1.y + bias) * uu[5]; y[6] = (o1.z + bias) * uu[6]; y[7] = (o1.w + bias) * uu[7];
                *(v4u*)(yc + (row0 + tt) * 512 + g * 128 + c8) = pack8(y); }
        }
        __syncthreads();
    }
}

__device__ __forceinline__ void p_norm_router(Frame& F, KArgs ka, const float* x, const float* w, const float* mod_l, bf16* h2) {
    const float* rw = ka->in[20]; const float* rb = ka->in[21]; unsigned* ctl = (unsigned*)(ka->ws + WS_CTL);
    float* topp = (float*)(ka->ws + WS_TOPP); int* list = (int*)(ka->ws + WS_LIST);
    LAS float* RWt = (LAS float*)F.lds;
    LAS int* lcnt = (LAS int*)(RWt + 8192);
    LAS int* lbase = lcnt + 16;
    LAS int* sel = lbase + 16;
    LAS int* rnk = sel + 128;
    for (int i = F.tid; i < D * NE; i += NT) { const int k = i >> 3, e = i & 7; RWt[e * D + k] = rw[i]; }
    __syncthreads();
    float rbv[8];
#pragma unroll
    for (int e = 0; e < 8; ++e) rbv[e] = rb[e];
    f32x4 wv[4];
#pragma unroll
    for (int j = 0; j < 4; ++j) wv[j] = ((const f32x4*)w)[F.lane + 64 * j];
    for (int batch = F.bid; batch < M / 128; batch += F.G) {
        const int row0 = batch * 128;
        if (F.tid < 16) lcnt[F.tid] = 0;
        const float* mb = mod_l + (size_t)(row0 >> 12) * MOD_LD;
        f32x4 scv[4], shv[4], xn[4];
#pragma unroll
        for (int j = 0; j < 4; ++j) { scv[j] = ((const f32x4*)(mb + 4 * D))[F.lane + 64 * j]; shv[j] = ((const f32x4*)(mb + 3 * D))[F.lane + 64 * j]; xn[j] = ((const f32x4*)(x + (size_t)(row0 + F.wave * 16) * D))[F.lane + 64 * j]; }
        asm volatile("" ::: "memory");
#pragma unroll
        for (int j = 0; j < 4; ++j) scv[j] = wv[j] * (scv[j] + 1.0f);
        __syncthreads();
        for (int rr = 0; rr < 16; ++rr) {
            const int r = F.wave * 16 + rr, row = row0 + r;
            f32x4 v[4];
#pragma unroll
            for (int j = 0; j < 4; ++j) v[j] = xn[j];
            if (rr + 1 < 16) {
#pragma unroll
                for (int j = 0; j < 4; ++j) xn[j] = ((const f32x4*)(x + (size_t)(row + 1) * D))[F.lane + 64 * j]; }
            float ssq = 0.f;
#pragma unroll
            for (int j = 0; j < 4; ++j) ssq += (v[j].x * v[j].x + v[j].y * v[j].y) + (v[j].z * v[j].z + v[j].w * v[j].w);
            const float rstd = 1.0f / sqrtf(wave_sum(ssq, F.lane) * (1.0f / D) + EPS);
            f32x4 o[4];
#pragma unroll
            for (int j = 0; j < 4; ++j) o[j] = v[j] * rstd * scv[j] + shv[j];
            if (MOE_FP8) { unsigned* o4 = (unsigned*)((unsigned char*)h2 + (size_t)row * D) + F.lane;
#pragma unroll
                for (int j = 0; j < 4; ++j) o4[64 * j] = pk4_f8(o[j].x * F8_SA, o[j].y * F8_SA, o[j].z * F8_SA, o[j].w * F8_SA); }
            else store_row_bf16(h2 + (size_t)row * D, F.lane, o);
            float lg[8];
#pragma unroll
            for (int e = 0; e < 8; ++e) { float s = 0.f;
#pragma unroll
                for (int j = 0; j < 4; ++j) { const f32x4 r4 = *(const LAS f32x4*)(RWt + e * D + 4 * F.lane + 256 * j); s += (o[j].x * r4.x + o[j].y * r4.y) + (o[j].z * r4.z + o[j].w * r4.w); }
                lg[e] = wave_sum(s, F.lane) + rbv[e]; }
            int i0 = 0; float v0 = lg[0];
#pragma unroll
            for (int e = 1; e < 8; ++e) if (lg[e] > v0) { v0 = lg[e]; i0 = e; }
            int i1 = -1; float v1 = -3.0e38f;
#pragma unroll
            for (int e = 0; e < 8; ++e) if (e != i0 && lg[e] > v1) { v1 = lg[e]; i1 = e; }
            if (F.lane == 0) {
                const float p0 = 1.0f / (1.0f + expf(v1 - v0));
                topp[(size_t)row * 2] = p0; topp[(size_t)row * 2 + 1] = 1.0f - p0;
                const int rk0 = __hip_atomic_fetch_add(lcnt + i0, 1, __ATOMIC_RELAXED, __HIP_MEMORY_SCOPE_WORKGROUP), rk1 = __hip_atomic_fetch_add(lcnt + 8 + i1, 1, __ATOMIC_RELAXED, __HIP_MEMORY_SCOPE_WORKGROUP);
                sel[r] = i0 | (i1 << 8); rnk[r] = rk0 | (rk1 << 16);
            }
        }
        __syncthreads();
        if (F.tid < 16) lbase[F.tid] = (int)__hip_atomic_fetch_add(ctl + CW_CNT + 64 * F.tid, (unsigned)lcnt[F.tid], __ATOMIC_RELAXED, __HIP_MEMORY_SCOPE_AGENT);
        __syncthreads();
        if (F.tid < 128) { const int sv = sel[F.tid], rv = rnk[F.tid]; const int e0 = sv & 255, e1 = sv >> 8;
            list[(size_t)e0 * LIST_CAP + lbase[e0] + (rv & 0xffff)] = row0 + F.tid;
            list[(size_t)(8 + e1) * LIST_CAP + lbase[8 + e1] + (rv >> 16)] = row0 + F.tid; }
        __syncthreads();
    }
}
__device__ __forceinline__ void moe_tables(Frame& F, unsigned* ctl, int pass) {
    LAS int* tab = (LAS int*)(F.lds + TAB_OFF);
    __syncthreads();
    if (F.tid == 0) { int pb = 0;
        for (int e = 0; e < 8; ++e) { int c = (int)__hip_atomic_load(ctl + CW_CNT + 64 * (pass * 8 + e), __ATOMIC_RELAXED, __HIP_MEMORY_SCOPE_AGENT); if (c > LIST_CAP) c = LIST_CAP; if (c < 0) c = 0;
            const int np = (c + 255) >> 8; tab[e] = c; tab[8 + e] = pb; for (int p = 0; p < np; ++p) tab[32 + pb + p] = e; pb += np; }
        tab[16] = pb; }
    __syncthreads();
}
template <bool GATHER_>
struct MoeOrder {
    static constexpr bool GATHER = GATHER_;
    pg8::StaticOrder so; const LAS int* tab; const int* list; int npn; unsigned rowbytes;
    __device__ __forceinline__ bool next(int i, pg8::Unit& u) const { if (!so.next(i, u)) return false; u.pb = tab[32 + u.pm] * npn + u.pn; return true; }
    __device__ __forceinline__ int tok_of(int pm, int r) const { const int e = tab[32 + pm]; const int idx = (pm - tab[8 + e]) * 256 + r; return idx < tab[e] ? list[(size_t)e * LIST_CAP + idx] : -1; }
    __device__ __forceinline__ unsigned a_row_off(const pg8::Unit& u, int r) const { const int t = tok_of(u.pm, r); return (unsigned)(t < 0 ? 0 : t) * rowbytes; }
};

struct EpiBranch {
    static constexpr bool PERM = true;
    const bf16* gate; bf16* mrg; int first;
    __device__ __forceinline__ void operator()(const pg8::f32x4 (&acc)[2][2][4][2], const pg8::Unit& u, int wr, int wc, int fr, int fq) const {
        const int row0 = u.pm * 256 + wr * 64 + fr, col0 = u.pn * 256 + wc * 32 + 8 * fq;
#pragma unroll
        for (int ai = 0; ai < 2; ++ai) {
            v4u gl[4][2], ml[4][2];
#pragma unroll
            for (int m = 0; m < 4; ++m)
#pragma unroll
                for (int bj = 0; bj < 2; ++bj) { const size_t row = (size_t)(row0 + ai * 128 + m * 16); const int col = col0 + bj * 128;
                    gl[m][bj] = *(const v4u*)(gate + row * N_G + col); ml[m][bj] = first ? (v4u){0u, 0u, 0u, 0u} : *(const v4u*)(mrg + row * D + col); }
            asm volatile("" ::: "memory");
#pragma unroll
            for (int m = 0; m < 4; ++m)
#pragma unroll
                for (int bj = 0; bj < 2; ++bj) { const size_t row = (size_t)(row0 + ai * 128 + m * 16); const int col = col0 + bj * 128;
                    float gg[8], mm[8], o[8]; unpack8(gl[m][bj], gg); unpack8(ml[m][bj], mm);
                    const pg8::f32x4 v0 = acc[ai][bj][m][0], v1 = acc[ai][bj][m][1];
                    o[0] = mm[0] + sigmoidf_(gg[0]) * v0[0]; o[1] = mm[1] + sigmoidf_(gg[1]) * v0[1]; o[2] = mm[2] + sigmoidf_(gg[2]) * v0[2]; o[3] = mm[3] + sigmoidf_(gg[3]) * v0[3];
                    o[4] = mm[4] + sigmoidf_(gg[4]) * v1[0]; o[5] = mm[5] + sigmoidf_(gg[5]) * v1[1]; o[6] = mm[6] + sigmoidf_(gg[6]) * v1[2]; o[7] = mm[7] + sigmoidf_(gg[7]) * v1[3];
                    *(v4u*)(mrg + row * D + col) = pack8(o); }
            asm volatile("" ::: "memory");
        }
    }
};
struct EpiResid {
    static constexpr bool PERM = false;
    const float* xin; float* xout; const float* gmod; float oscale;
    __device__ __forceinline__ void operator()(const pg8::f32x4 (&acc)[2][2][4][2], const pg8::Unit& u, int wr, int wc, int fr, int fq) const {
        const int row0 = u.pm * 256 + wr * 64 + fr, col0 = u.pn * 256 + wc * 32 + 4 * fq;
        const float* gb = gmod + (size_t)((u.pm * 256) >> 12) * MOD_LD + col0;
        pg8::f32x4 gv[2][2];
#pragma unroll
        for (int bj = 0; bj < 2; ++bj)
#pragma unroll
            for (int n = 0; n < 2; ++n) gv[bj][n] = *(const pg8::f32x4*)(gb + bj * 128 + n * 16) * oscale;
#pragma unroll
        for (int ai = 0; ai < 2; ++ai) {
            pg8::f32x4 xl[4][2][2];
#pragma unroll
            for (int m = 0; m < 4; ++m)
#pragma unroll
                for (int bj = 0; bj < 2; ++bj)
#pragma unroll
                    for (int n = 0; n < 2; ++n) xl[m][bj][n] = *(const pg8::f32x4*)(xin + (size_t)(row0 + ai * 128 + m * 16) * D + col0 + bj * 128 + n * 16);
            asm volatile("" ::: "memory");
#pragma unroll
            for (int m = 0; m < 4; ++m)
#pragma unroll
                for (int bj = 0; bj < 2; ++bj)
#pragma unroll
                    for (int n = 0; n < 2; ++n) *(pg8::f32x4*)(xout + (size_t)(row0 + ai * 128 + m * 16) * D + col0 + bj * 128 + n * 16) = xl[m][bj][n] + gv[bj][n] * acc[ai][bj][m][n];
            asm volatile("" ::: "memory");
        }
    }
};
template <bool F8 = false>
struct EpiSwiglu {
    static constexpr bool PERM = true;
    bf16* act; float inv;
    __device__ __forceinline__ void operator()(const pg8::f32x4 (&acc)[2][2][4][2], const pg8::Unit& u, int wr, int wc, int fr, int fq) const {
        const int row0 = u.pm * 256 + wr * 64 + fr, col0 = u.pn * 128 + wc * 32 + 8 * fq;
#pragma unroll
        for (int ai = 0; ai < 2; ++ai)
#pragma unroll
            for (int m = 0; m < 4; ++m) { float o[8];
#pragma unroll
                for (int n = 0; n < 2; ++n)
#pragma unroll
                    for (int i = 0; i < 4; ++i) o[n * 4 + i] = F8 ? siluf_(acc[ai][0][m][n][i] * inv) * (acc[ai][1][m][n][i] * inv) * F8_SACT : siluf_(acc[ai][0][m][n][i]) * acc[ai][1][m][n][i];
                if constexpr (F8) { typedef unsigned v2u_ __attribute__((ext_vector_type(2))); v2u_ w8; w8.x = pk4_f8(o[0], o[1], o[2], o[3]); w8.y = pk4_f8(o[4], o[5], o[6], o[7]);
                    *(v2u_*)((unsigned char*)act + (size_t)(row0 + ai * 128 + m * 16) * D_FF + col0) = w8; }
                else *(v4u*)(act + (size_t)(row0 + ai * 128 + m * 16) * D_FF + col0) = pack8(o); }
    }
};
struct EpiMoeDown {
    static constexpr bool PERM = false;
    float* x; const float* gmod; const float* topp; int pass; const LAS int* tab; const int* list; float oscale;
    __device__ __forceinline__ int tok_of(int pm, int r) const { const int e = tab[32 + pm]; const int idx = (pm - tab[8 + e]) * 256 + r; return idx < tab[e] ? list[(size_t)e * LIST_CAP + idx] : -1; }
    __device__ __forceinline__ void operator()(const pg8::f32x4 (&acc)[2][2][4][2], const pg8::Unit& u, int wr, int wc, int fr, int fq) const {
        const int col0 = u.pn * 256 + wc * 32 + 4 * fq;
        int tok[2][4];
#pragma unroll
        for (int ai = 0; ai < 2; ++ai)
#pragma unroll
            for (int m = 0; m < 4; ++m) tok[ai][m] = tok_of(u.pm, ai * 128 + wr * 64 + m * 16 + fr);
        asm volatile("" ::: "memory");
#pragma unroll
        for (int am = 0; am < 4; ++am) {
            const int ai = am >> 1, mb = (am & 1) * 2;
            pg8::f32x4 xl[2][2][2], gl[2][2][2]; float pv[2];
#pragma unroll
            for (int m = 0; m < 2; ++m) { const int t = tok[ai][mb + m] < 0 ? 0 : tok[ai][mb + m]; pv[m] = topp[(size_t)t * 2 + pass] * oscale; const float* gb = gmod + (size_t)(t >> 12) * MOD_LD + col0;
#pragma unroll
                for (int bj = 0; bj < 2; ++bj)
#pragma unroll
                    for (int n = 0; n < 2; ++n) { xl[m][bj][n] = *(const pg8::f32x4*)(x + (size_t)t * D + col0 + bj * 128 + n * 16); gl[m][bj][n] = *(const pg8::f32x4*)(gb + bj * 128 + n * 16); } }
            asm volatile("" ::: "memory");
#pragma unroll
            for (int m = 0; m < 2; ++m) { if (tok[ai][mb + m] >= 0) { const int t = tok[ai][mb + m];
#pragma unroll
                for (int bj = 0; bj < 2; ++bj)
#pragma unroll
                    for (int n = 0; n < 2; ++n) *(pg8::f32x4*)(x + (size_t)t * D + col0 + bj * 128 + n * 16) = xl[m][bj][n] + gl[m][bj][n] * pv[m] * acc[ai][bj][mb + m][n]; } }
            asm volatile("" ::: "memory");
        }
    }
};

__device__ __forceinline__ void p_final_norm(Frame& F, float* x, const float* w) {
    const int gw = F.bid * NWAVES + F.wave, NGW = F.G * NWAVES, lane = F.lane;
    f32x4 wv[4];
#pragma unroll
    for (int j = 0; j < 4; ++j) wv[j] = ((const f32x4*)w)[lane + 64 * j];
    for (int r0 = gw * 4; r0 < M; r0 += NGW * 4) {
        f32x4 v[4][4];
#pragma unroll
        for (int r = 0; r < 4; ++r)
#pragma unroll
            for (int j = 0; j < 4; ++j) v[r][j] = ((const f32x4*)(x + (size_t)(r0 + r) * D))[lane + 64 * j];
        asm volatile("" ::: "memory");
#pragma unroll
        for (int r = 0; r < 4; ++r) { float s = 0.f;
#pragma unroll
            for (int j = 0; j < 4; ++j) s += (v[r][j].x * v[r][j].x + v[r][j].y * v[r][j].y) + (v[r][j].z * v[r][j].z + v[r][j].w * v[r][j].w);
            const float rstd = 1.0f / sqrtf(wave_sum(s, lane) * (1.0f / D) + EPS);
#pragma unroll
            for (int j = 0; j < 4; ++j) ((f32x4*)(x + (size_t)(r0 + r) * D))[lane + 64 * j] = v[r][j] * rstd * wv[j]; }
    }
}
__device__ __forceinline__ bool fresh(Frame& F) {
    int w_ = F.w0, b_ = blockIdx.x, g_ = gridDim.x; asm volatile("" : "+s"(w_), "+s"(b_), "+s"(g_));
    int l_; asm volatile("v_mbcnt_lo_u32_b32 %0, -1, 0\n\tv_mbcnt_hi_u32_b32 %0, -1, %0" : "=v"(l_));
    int t_ = w_ * 64 + l_;
    F.tid = t_; F.lane = t_ & 63; F.wave = __builtin_amdgcn_readfirstlane(t_ >> 6); F.bid = b_; F.G = g_; return true;
}
constexpr int NPL = 13, NPHASE = 1 + DEPTH * NPL;
#if MK_PER_PHASE
#define GRID_BAR() do { } while (0)
#else
#define GRID_BAR() do { XcdBarrier b2_ = bar; asm volatile("" : "+s"(b2_.bar)); xcd_barrier(b2_); } while (0)
#endif
#ifdef ONLY_REL
#define IN(k) (KA()->ph_lo <= (k) && (k) < KA()->ph_hi && fresh(F) && ((k) == 0 ? 100 : ((k) - 1) % NPL) == ONLY_REL && (ONLY_L < 0 || ((k) - 1) / NPL == ONLY_L))
#else
#define IN(k) (KA()->ph_lo <= (k) && (k) < KA()->ph_hi && fresh(F))
#endif
#define SEAM(k) do { if ((k) + 1 < KA()->ph_hi) GRID_BAR(); } while (0)
template <int l>
__device__ __forceinline__ void layer_program(Frame& F, const XcdBarrier& bar, PG8_LAS unsigned char* ring) {
        const int pb = 1 + l * NPL;
#define WSP(off) (ka->ws + (off))
#define MODL ((const float*)WSP(WS_MOD) + (size_t)l * BATCH * MOD_LD)
#define WMIXL ((bf16*)WSP(WS_WMIX + (size_t)l * WMIX_STRIDE))
        if (IN(pb + 0)) {
#pragma unroll 1
          for (int rep = 0; rep < REPS(7); ++rep) { KArgs ka = KA(); p_norm(F, l == 0 ? ka->in[0] : (const float*)ka->out, ka->in[4] + l * D, MODL, 1 * D, 0, (bf16*)WSP(WS_H)); }
          SEAM(pb + 0); }
        if (IN(pb + 1)) {
            KArgs ka = KA();
            pg8::Gemm g{(bf16*)WSP(WS_H), WMIXL, D, D, D}; pg8::StaticOrder S; S.init(M / 256, N_BCA / 256, F.G, F.bid);
            pg8::EpiBf16 E{(bf16*)WSP(WS_P1), N_BCA, 1.0f / (float)REPS(8)};
#pragma unroll 1
            for (int rep = 0; rep < REPS(3); ++rep)
            pg8::gemm_phase<REPS(8)>(ring, g, S, E, F.tid); SEAM(pb + 1);
        }
        if (IN(pb + 2)) {
#pragma unroll 1
          for (int rep = 0; rep < REPS(1); ++rep) {
            __syncthreads();
            { KArgs ka = KA(); p_hgrn<1>(F, (const bf16*)WSP(WS_P1), ka->in[8], l, ka->in[9] + l * D_BV, (bf16*)WSP(WS_YB), (float*)WSP(WS_HU), (float*)WSP(WS_HD)); }
            __syncthreads();
            { KArgs ka = KA(); p_sgu(F, (const bf16*)WSP(WS_P1), ka->in[10] + l * D_C, ka->in[11] + (size_t)l * 4 * 128 * 128, ka->in[12] + l * 4 * 128, (bf16*)WSP(WS_YC)); }
            { KArgs ka = KA(); p_conv(F, (const bf16*)WSP(WS_P1), ka->in[7] + l * 3 * D_A, (bf16*)WSP(WS_YA)); }
          }
            SEAM(pb + 2);
        }
        if (IN(pb + 3)) {
#pragma unroll 1
          for (int rep = 0; rep < REPS(2); ++rep)
            { KArgs ka = KA(); p_hgrn<2>(F, (const bf16*)WSP(WS_P1), ka->in[8], l, ka->in[9] + l * D_BV, (bf16*)WSP(WS_YB), (float*)WSP(WS_HU), (float*)WSP(WS_HD)); }
            SEAM(pb + 3);
        }
        if (IN(pb + 4)) {
            KArgs ka = KA();
            pg8::Gemm g{(bf16*)WSP(WS_H), WMIXL + (size_t)N_BCA * D, D, D, D}; pg8::StaticOrder S; S.init(M / 256, N_G / 256, F.G, F.bid);
            pg8::EpiBf16 E{(bf16*)WSP(WS_PG), N_G, 1.0f};
            pg8::gemm_phase(ring, g, S, E, F.tid); SEAM(pb + 4);
        }
        if (IN(pb + 5)) {
#pragma unroll 1
            for (int br = 0; br < 3; ++br) {
                KArgs ka = KA();
                pg8::Gemm g{(bf16*)WSP(WS_YA + (size_t)br * 32 * MiB), WMIXL + (size_t)N_IN * D + (size_t)br * 512 * 1024, 512, 512, 512}; pg8::StaticOrder S; S.init(M / 256, D / 256, F.G, F.bid);
                EpiBranch E{(const bf16*)WSP(WS_PG) + br * D, (bf16*)WSP(WS_MRG), br == 0 ? 1 : 0};
                pg8::gemm_phase(ring, g, S, E, F.tid);
            }
            SEAM(pb + 5);
        }
        if (IN(pb + 6)) {
            KArgs ka = KA();
            pg8::Gemm g{(bf16*)WSP(WS_MRG), WMIXL + (size_t)N_IN * D + 3 * 512 * 1024, D, D, D}; pg8::StaticOrder S; S.init(M / 256, D / 256, F.G, F.bid);
            EpiResid E{l == 0 ? ka->in[0] : (const float*)ka->out, ka->out, MODL + 2 * D, 1.0f};
            pg8::gemm_phase(ring, g, S, E, F.tid); SEAM(pb + 6);
        }
        if (l == 0) {
            constexpr int FES = FFN_FP8 ? 1 : 2;
            if (IN(pb + 7)) { KArgs ka = KA(); p_norm<FFN_FP8>(F, ka->out, ka->in[5] + l * D, MODL, 4 * D, 3 * D, (bf16*)WSP(WS_H)); SEAM(pb + 7); }
            if (IN(pb + 8)) {
                KArgs ka = KA();
                pg8::Gemm g{(bf16*)WSP(WS_H), (bf16*)WSP(WS_W13), D * FES / 2, D * FES / 2, D * FES / 2}; pg8::StaticOrder S; S.init(M / 256, N13 / 256, F.G, F.bid);
                EpiSwiglu<FFN_FP8> E{(bf16*)WSP(WS_ACT), 1.0f / (F8_SA * F8_SW)};
                pg8::gemm_phase<1, FFN_FP8>(ring, g, S, E, F.tid); SEAM(pb + 8);
            }
            if (IN(pb + 9)) {
                KArgs ka = KA();
                pg8::Gemm g{(bf16*)WSP(WS_ACT), (bf16*)WSP(WS_W2), D_FF * FES / 2, D_FF * FES / 2, D_FF * FES / 2}; pg8::StaticOrder S; S.init(M / 256, D / 256, F.G, F.bid);
                EpiResid E{ka->out, ka->out, MODL + 5 * D, FFN_FP8 ? 1.0f / (F8_SACT * F8_SW) : 1.0f};
                pg8::gemm_phase<1, FFN_FP8>(ring, g, S, E, F.tid); SEAM(pb + 9);
            }
        } else {
            if (IN(pb + 7)) {
#pragma unroll 1
                for (int rep = 0; rep < REPS(6); ++rep) { __syncthreads(); p_moe_weights(F, KA()); }
                __syncthreads(); { KArgs ka = KA(); p_norm_router(F, ka, ka->out, ka->in[5] + l * D, MODL, (bf16*)WSP(WS_H2M)); } SEAM(pb + 7); }
#pragma unroll 1
            for (int pass = 0; pass < 2; ++pass) {
#ifndef NO_MOE_UP
                if (IN(pb + 8 + 2 * pass)) {
                    KArgs ka = KA();
                    moe_tables(F, (unsigned*)WSP(WS_CTL), pass);
                    const LAS int* tab = (const LAS int*)(F.lds + TAB_OFF);
                    MoeOrder<true> S; S.so.init(tab[16], N13 / 256, F.G, F.bid); S.tab = tab; S.list = (const int*)WSP(WS_LIST) + (size_t)pass * 8 * LIST_CAP; S.npn = N13 / 256; S.rowbytes = D * MOE_ES;
                    pg8::Gemm g{(bf16*)WSP(WS_H2M), (bf16*)WSP(WS_WM13), D * MOE_ES / 2, D * MOE_ES / 2, D * MOE_ES / 2};
                    EpiSwiglu<MOE_FP8> E{(bf16*)WSP(WS_ACTM), 1.0f / (F8_SA * F8_SW)};
#pragma unroll 1
                    for (int rep = 0; rep < REPS(4); ++rep)
                    pg8::gemm_phase<1, MOE_FP8>(ring, g, S, E, F.tid); SEAM(pb + 8 + 2 * pass);
                }
#endif
#ifndef NO_MOE_DOWN
                if (IN(pb + 9 + 2 * pass)) {
                    KArgs ka = KA();
                    moe_tables(F, (unsigned*)WSP(WS_CTL), pass);
                    const LAS int* tab = (const LAS int*)(F.lds + TAB_OFF);
                    MoeOrder<false> S; S.so.init(tab[16], D / 256, F.G, F.bid); S.tab = tab; S.list = (const int*)WSP(WS_LIST) + (size_t)pass * 8 * LIST_CAP; S.npn = D / 256; S.rowbytes = 0;
                    pg8::Gemm g{(bf16*)WSP(WS_ACTM), (bf16*)WSP(WS_WM2), D_FF * MOE_ES / 2, D_FF * MOE_ES / 2, D_FF * MOE_ES / 2};
                    EpiMoeDown E{ka->out, MODL + 5 * D, (const float*)WSP(WS_TOPP), pass, tab, S.list, MOE_FP8 ? 1.0f / (F8_SACT * F8_SW) : 1.0f};
                    pg8::gemm_phase<1, MOE_FP8>(ring, g, S, E, F.tid); SEAM(pb + 9 + 2 * pass);
                }
#endif
            }
            if (IN(pb + 12)) { KArgs ka = KA(); p_final_norm(F, ka->out, ka->in[25]); }
        }
}
__global__ void __launch_bounds__(NT, 2) fwd(Args args) {
    extern __shared__ __attribute__((aligned(16))) unsigned char lds[];
    Frame F;
    F.lds = (LAS unsigned char*)lds;
    F.tid = threadIdx.x; F.lane = F.tid & 63; F.wave = __builtin_amdgcn_readfirstlane(F.tid >> 6); F.w0 = F.wave;
    F.G = gridDim.x; F.bid = blockIdx.x;
    volatile LAS unsigned* MISC = (volatile LAS unsigned*)(F.lds + MISC_OFF);
    if (F.tid < 32) MISC[F.tid] = 0u;
    __syncthreads();
#if !MK_PER_PHASE
    XcdBarrier bar = xcd_barrier_post((unsigned*)(KA()->ws + WS_CTL) + CW_BAR, MISC + 8);
#else
    XcdBarrier bar; bar.bar = nullptr; bar.x = 0; bar.st = nullptr;
#endif
    PG8_LAS unsigned char* ring = (PG8_LAS unsigned char*)lds;

    if (IN(0)) {
#pragma unroll 1
        for (int rep = 0; rep < REPS(5); ++rep) { __syncthreads(); p_prologue(F, KA()); }
        SEAM(0); }

    layer_program<0>(F, bar, ring);
    layer_program<1>(F, bar, ring);
#undef IN
#undef SEAM
}

extern "C" void kernel_launch(void* const* d_in, const int* in_sizes, int n_in, void* d_out, int out_size, void* d_ws, size_t ws_size, hipStream_t stream) {
    static int grid = 0;
    if (grid == 0) {
        if (n_in != 26 || in_sizes[0] != M * D || out_size != M * D || ws_size < WS_NEED) { fprintf(stderr, "kernel_launch: unexpected shapes / workspace (n_in %d, ws %zu, need %zu); nothing launched\n", n_in, ws_size, (size_t)WS_NEED); grid = -1; return; }
        int dev = 0, cus = 0, per_cu = 0;
        if (hipGetDevice(&dev) != hipSuccess || hipDeviceGetAttribute(&cus, hipDeviceAttributeMultiprocessorCount, dev) != hipSuccess) { grid = -1; return; }
        if (hipFuncSetAttribute((const void*)fwd, hipFuncAttributeMaxDynamicSharedMemorySize, LDS_BYTES) != hipSuccess) { fprintf(stderr, "kernel_launch: hipFuncSetAttribute failed\n"); grid = -1; return; }
        if (hipOccupancyMaxActiveBlocksPerMultiprocessor(&per_cu, (const void*)fwd, NT, LDS_BYTES) != hipSuccess || per_cu < 1) fprintf(stderr, "kernel_launch: occupancy query reports %d\n", per_cu);
        (void)hipGetLastError();
        grid = cus;
    }
    if (grid < 0) return;
    if (hipMemsetAsync((char*)d_ws + WS_CTL, 0, CTL_ZERO_BYTES, stream) != hipSuccess) return;
    Args a{};
    for (int i = 0; i < 26; ++i) a.in[i] = (const float*)d_in[i];
    a.out = (float*)d_out; a.ws = (unsigned char*)d_ws;
#if MK_PER_PHASE
    for (int p = 0; p < NPHASE; ++p) {
        if (p >= 1 + 10 && p <= 1 + 12) continue;
        a.ph_lo = p; a.ph_hi = p + 1;
        hipLaunchKernelGGL(fwd, dim3(grid), dim3(NT), LDS_BYTES, stream, a);
    }
#else
    a.ph_lo = 0; a.ph_hi = NPHASE;
    hipLaunchKernelGGL(fwd, dim3(grid), dim3(NT), LDS_BYTES, stream, a);
#endif
}
```

```cpp
#include <hip/hip_runtime.h>
#include <cstdio>
#include <cstdint>

#ifndef PROBE_DUP
#define PROBE_DUP 0
#endif
#ifndef PROBE_REPS
#define PROBE_REPS 2
#endif
#define REPS(k) ((PROBE_DUP == (k)) ? PROBE_REPS : 1)
#ifndef Q_PROJ
#define Q_PROJ 2
#endif
#ifndef Q_GATE
#define Q_GATE 2
#endif
#ifndef Q_FUP
#define Q_FUP 2
#endif
#ifndef Q_FDN
#define Q_FDN 1
#endif
#ifndef Q_MUP
#define Q_MUP 2
#endif
#ifndef Q_MDN
#define Q_MDN 1
#endif
#ifndef MK_PER_PHASE
#define MK_PER_PHASE 0
#endif

namespace pg8 {
#define PG8_LAS __attribute__((address_space(3)))
typedef unsigned short bf16_t;
typedef short bf16x8 __attribute__((ext_vector_type(8)));
typedef float f32x4 __attribute__((ext_vector_type(4)));
typedef unsigned u32x4 __attribute__((ext_vector_type(4)));
typedef int v4i32_ __attribute__((ext_vector_type(4)));
constexpr int BM = 256, BK = 64, HALF = 128, HTB = HALF * BK * 2, STAGE_BYTES = 8 * HTB, NXCD = 8, WGM = 8;

__host__ __device__ __forceinline__ int lds_byte(int r, int c) { const int st = (r >> 4) * 2 + (c >> 5), rr = r & 15, cc = c & 31, ob = rr * 64 + cc * 2; return st * 1024 + (ob ^ (((ob >> 9) & 1) << 5)); }
__host__ __device__ __forceinline__ void stage_rc(int b, int& R, int& C) { const int st = b / 1024, sb = b % 1024, swz = sb ^ (((sb >> 9) & 1) << 5); R = (st >> 1) * 16 + swz / 64; C = (st & 1) * 32 + (swz % 64) / 2; }
__host__ __device__ __forceinline__ int perm32(int rho) { const int n = rho >> 4, i = rho & 15; return 8 * (i >> 2) + 4 * n + (i & 3); }

struct Unit { int pm, pn, pb, aux; };
struct Gemm { const bf16_t* A; const bf16_t* Bt; int lda, ldb, K; size_t astride = 0, bstride = 0; };

struct StaticOrder {
    static constexpr bool GATHER = false;
    int nM, nN, nwg, G, c;
    __device__ __forceinline__ void init(int nM_, int nN_, int G_, int c_) { nM = nM_; nN = nN_; nwg = nM * nN; G = G_; c = c_; }
    __device__ __forceinline__ bool next(int i, Unit& u) const { return unit_of((long)i * G + c, u); }
    __device__ __forceinline__ bool unit_of(long L, Unit& u) const {
        if (L >= nwg) return false;
        int wgid = (int)L; { const int q = nwg / NXCD, r = nwg % NXCD, xcd = wgid % NXCD, off = wgid / NXCD; wgid = (xcd < r ? xcd * (q + 1) : r * (q + 1) + (xcd - r) * q) + off; }
        const int nig = WGM * nN, gid = wgid / nig, fm = gid * WGM, gsz = (nM - fm) < WGM ? (nM - fm) : WGM;
        u.pm = fm + ((wgid % nig) % gsz); u.pn = (wgid % nig) / gsz; u.pb = u.pn; u.aux = 0; return true;
    }
    __device__ __forceinline__ unsigned a_row_off(const Unit&, int) const { return 0u; }
};

struct GateOrder {
    static constexpr bool GATHER = false;
    StaticOrder so;
    __device__ __forceinline__ bool next(int k, Unit& u) const { Unit b; if (!so.next(k / 3, b)) return false; u.pm = b.pm; u.pn = b.pn + 4 * (k % 3); u.pb = u.pn; u.aux = 0; return true; }
    __device__ __forceinline__ unsigned a_row_off(const Unit&, int) const { return 0u; }
};
struct BranchOrder {
    static constexpr bool GATHER = false;
    StaticOrder so;
    __device__ __forceinline__ bool next(int k, Unit& u) const { Unit b; if (!so.next(k / 3, b)) return false; u.pm = b.pm; u.pn = b.pn; u.pb = b.pn; u.aux = k % 3; return true; }
    __device__ __forceinline__ unsigned a_row_off(const Unit&, int) const { return 0u; }
};
__device__ __forceinline__ unsigned cvt_pk_bf16(float lo, float hi) { unsigned r; asm volatile("v_cvt_pk_bf16_f32 %0, %1, %2" : "=v"(r) : "v"(lo), "v"(hi)); return r; }

template <int Q = 0>
struct EpiBf16 {
    static constexpr bool PERM = true;
    bf16_t* O; int ldc; float scale;
    __device__ __forceinline__ void operator()(const f32x4 (&acc)[2][2][4][2], const Unit& u, int wr, int wc, int fr, int fq) const {
        const int row0 = u.pm * BM + wr * 64 + fr, col0 = u.pn * BM + wc * 32 + 8 * fq;
#pragma unroll 1
        for (int erep = 0; erep < REPS(9); ++erep)
#pragma unroll
        for (int ai = 0; ai < 2; ++ai)
#pragma unroll
            for (int m = 0; m < 4; ++m) { bf16_t* rowp = O + (size_t)(row0 + ai * HALF + m * 16) * ldc + col0;
#pragma unroll
                for (int bj = 0; bj < 2; ++bj) { f32x4 v0 = acc[ai][bj][m][0], v1 = acc[ai][bj][m][1];
                    if constexpr (Q == 2) { v0 = __builtin_convertvector(__builtin_bit_cast(v4i32_, v0), f32x4); v1 = __builtin_convertvector(__builtin_bit_cast(v4i32_, v1), f32x4); }
                    v0 *= scale; v1 *= scale;
                    u32x4 w; w.x = cvt_pk_bf16(v0[0], v0[1]); w.y = cvt_pk_bf16(v0[2], v0[3]); w.z = cvt_pk_bf16(v1[0], v1[1]); w.w = cvt_pk_bf16(v1[2], v1[3]);
                    *(u32x4*)(rowp + bj * HALF) = w; } }
    }
};

typedef int v8i32 __attribute__((ext_vector_type(8)));
typedef int v4i32 __attribute__((ext_vector_type(4)));
template <int KREP = 1, int Q = 0, class Epi, class Sched>
__device__ __forceinline__ void gemm_phase(PG8_LAS unsigned char* lds, const Gemm g, const Sched& S, const Epi& E, int tid_in) {
    constexpr bool GATHER = Sched::GATHER;
    int tid_ = tid_in; asm volatile("" : "+v"(tid_));
    const int tid = tid_, wid = __builtin_amdgcn_readfirstlane(tid >> 6), lane = tid & 63, wr = wid >> 2, wc = wid & 3, fr = lane & 15, fq = lane >> 4;
    const int K = g.K, nt = K / BK;
    unsigned voffB[2], vA0[2], vA1[2], nA0[2], nA1[2];
#pragma unroll
    for (int i = 0; i < 2; ++i) { int R, C; stage_rc(tid * 16 + i * 8192, R, C); const int Rb = Epi::PERM ? ((R & ~31) + perm32(R & 31)) : R;
        voffB[i] = (unsigned)(Rb * g.ldb + C) * 2u;
        vA0[i] = (unsigned)(R * g.lda + C) * 2u; vA1[i] = vA0[i]; nA0[i] = vA0[i]; nA1[i] = vA0[i]; }
    const size_t kstep = (size_t)(BK * 2);
    const size_t hstepB = (size_t)HALF * g.ldb * 2, tstepB = 2 * hstepB, tstepA = (size_t)BM * g.lda * 2;
    const size_t hstepA = GATHER ? (size_t)0 : (size_t)HALF * g.lda * 2;
    const unsigned ldsw = (unsigned)wid * 1024u;
    const int aoff = lds_byte(wr * 64 + fr, fq * 8), boff = lds_byte(wc * 32 + fr, fq * 8);
    PG8_LAS unsigned char* aptr = lds + aoff; PG8_LAS unsigned char* bptr = lds + 4 * HTB + boff; asm volatile("" : "+v"(aptr), "+v"(bptr));
#define PG8_SA(b, h) (((b) * 2 + (h)) * HTB)
#define PG8_SB(b, h) ((4 + (b) * 2 + (h)) * HTB)
#define PG8_STAGE(bufoff, gbase, voff) do { _Pragma("unroll") for (int _i = 0; _i < 2; ++_i) \
        __builtin_amdgcn_global_load_lds((const unsigned*)((const char*)(gbase) + (voff)[_i]), (PG8_LAS unsigned*)(lds + (bufoff) + ldsw + _i * 8192), 16, 0, 0); } while (0)
#define PG8_CAT8(x0, x1) __builtin_shufflevector(__builtin_bit_cast(v4i32, x0), __builtin_bit_cast(v4i32, x1), 0, 1, 2, 3, 4, 5, 6, 7)
#define PG8_RDA(off) (*(const PG8_LAS bf16x8*)(aptr + (off)))
#define PG8_RDB(off) (*(const PG8_LAS bf16x8*)(bptr + (off)))
#define PG8_LDA(dst, b, h) do { if constexpr (Q == 1) { _Pragma("unroll") for (int m = 0; m < 4; ++m) dst##8[m] = PG8_CAT8(PG8_RDA(PG8_SA(b, h) + m * 2048), PG8_RDA(PG8_SA(b, h) + m * 2048 + 1024)); } \
        else { _Pragma("unroll") for (int m = 0; m < 4; ++m) _Pragma("unroll") for (int k = 0; k < 2; ++k) dst[m][k] = PG8_RDA(PG8_SA(b, h) + m * 2048 + k * 1024); } } while (0)
#define PG8_LDB(dst, b, h) do { if constexpr (Q == 1) { _Pragma("unroll") for (int n = 0; n < 2; ++n) dst##8[n] = PG8_CAT8(PG8_RDB(PG8_SB(b, h) - 4 * HTB + n * 2048), PG8_RDB(PG8_SB(b, h) - 4 * HTB + n * 2048 + 1024)); } \
        else { _Pragma("unroll") for (int n = 0; n < 2; ++n) _Pragma("unroll") for (int k = 0; k < 2; ++k) dst[n][k] = PG8_RDB(PG8_SB(b, h) - 4 * HTB + n * 2048 + k * 1024); } } while (0)
#define PG8_MMA(ai, bj, At, Bt) do { __builtin_amdgcn_s_setprio(1); \
        if constexpr (Q == 2) { _Pragma("unroll") for (int m = 0; m < 4; ++m) _Pragma("unroll") for (int n = 0; n < 2; ++n) _Pragma("unroll") for (int k = 0; k < 2; ++k) \
            acc[ai][bj][m][n] = __builtin_bit_cast(f32x4, __builtin_amdgcn_mfma_i32_16x16x64_i8(__builtin_bit_cast(v4i32, Bt[n][k]), __builtin_bit_cast(v4i32, At[m][k]), __builtin_bit_cast(v4i32, acc[ai][bj][m][n]), 0, 0, 0)); } \
        else if constexpr (Q == 1) { _Pragma("unroll") for (int m = 0; m < 4; ++m) _Pragma("unroll") for (int n = 0; n < 2; ++n) \
            asm volatile("v_mfma_scale_f32_16x16x128_f8f6f4 %0, %1, %2, %0, %3, %3 op_sel_hi:[0,0,0]" : "+v"(acc[ai][bj][m][n]) : "v"(Bt##8[n]), "v"(At##8[m]), "v"(sc1)); } \
        else { _Pragma("unroll") for (int m = 0; m < 4; ++m) _Pragma("unroll") for (int n = 0; n < 2; ++n) _Pragma("unroll") for (int k = 0; k < 2; ++k) \
            acc[ai][bj][m][n] = __builtin_amdgcn_mfma_f32_16x16x32_bf16(Bt[n][k], At[m][k], acc[ai][bj][m][n], 0, 0, 0); } \
        __builtin_amdgcn_s_setprio(0); } while (0)
#define PG8_WAIT_V(n) asm volatile("s_waitcnt vmcnt(" #n ")" ::: "memory")
#define PG8_WAIT_L(n) asm volatile("s_waitcnt lgkmcnt(" #n ")" ::: "memory")
#define PG8_BAR __builtin_amdgcn_s_barrier()
#define PG8_SCHED __builtin_amdgcn_sched_barrier(0)
#define PG8_GOFF(unit, d0, d1) do { _Pragma("unroll") for (int _i = 0; _i < 2; ++_i) { int R_, C_; stage_rc(tid * 16 + _i * 8192, R_, C_); \
        d0[_i] = S.a_row_off(unit, R_) + (unsigned)C_ * 2u; d1[_i] = S.a_row_off(unit, R_ + HALF) + (unsigned)C_ * 2u; } } while (0)
    Unit cur, nxt; int ui = 0;
    if (!S.next(0, cur)) return;
    f32x4 acc[2][2][4][2];
#pragma unroll
    for (int a = 0; a < 2; ++a)
#pragma unroll
        for (int b = 0; b < 2; ++b)
#pragma unroll
            for (int m = 0; m < 4; ++m)
#pragma unroll
                for (int n = 0; n < 2; ++n) acc[a][b][m][n] = (f32x4){0.f, 0.f, 0.f, 0.f};
    bf16x8 At[4][2], B0[2][2], B1[2][2];
    v8i32 At8[4], B08[2], B18[2];
    const int sc1 = 0x7f7f7f7f;
    if constexpr (GATHER) { PG8_GOFF(cur, vA0, vA1); }
    const char* cA = GATHER ? (const char*)g.A : (const char*)g.A + (size_t)cur.aux * g.astride + (size_t)cur.pm * tstepA; const char* cB = (const char*)g.Bt + (size_t)cur.aux * g.bstride + (size_t)cur.pb * tstepB;
    PG8_STAGE(PG8_SB(0, 0), cB, voffB); PG8_STAGE(PG8_SB(0, 1), cB + hstepB, voffB); PG8_STAGE(PG8_SA(0, 0), cA, vA0); PG8_STAGE(PG8_SA(0, 1), cA + hstepA, vA1);
    if (wr == 1) PG8_BAR;
    PG8_WAIT_V(2); PG8_BAR;
    PG8_STAGE(PG8_SB(1, 0), cB + kstep, voffB); PG8_STAGE(PG8_SA(1, 0), cA + kstep, vA0); PG8_STAGE(PG8_SB(1, 1), cB + hstepB + kstep, voffB);
    PG8_WAIT_V(6); PG8_BAR;
    for (;;) {
        const bool has_next = S.next(ui + 1, nxt);
        const char* nA = GATHER ? (const char*)g.A : (has_next ? (const char*)g.A + (size_t)nxt.aux * g.astride + (size_t)nxt.pm * tstepA : cA); const char* nB = has_next ? (const char*)g.Bt + (size_t)nxt.aux * g.bstride + (size_t)nxt.pb * tstepB : cB;
        if constexpr (GATHER) { if (has_next) { PG8_GOFF(nxt, nA0, nA1); } else {
#pragma unroll
            for (int i = 0; i < 2; ++i) { nA0[i] = vA0[i]; nA1[i] = vA1[i]; } } }
#pragma unroll 1
        for (int t = 0; t < nt * KREP; t += 2) {
            const bool last = (t == nt * KREP - 2);
            const int t1 = (KREP == 1) ? t + 1 : ((t + 1) & (nt - 1)), t2 = (KREP == 1) ? t + 2 : ((t + 2) & (nt - 1));
            const char* a1 = cA + (size_t)t1 * kstep;
            const char* a2 = last ? nA : cA + (size_t)t2 * kstep; const char* b2 = last ? nB : cB + (size_t)t2 * kstep;
            const char* a3 = a2 + kstep; const char* b3 = b2 + kstep;
            unsigned s0[2], s1[2];
#pragma unroll
            for (int i = 0; i < 2; ++i) { s0[i] = (GATHER && last) ? nA0[i] : vA0[i]; s1[i] = GATHER ? (last ? nA1[i] : vA1[i]) : vA0[i]; }
            PG8_LDB(B0, 0, 0); PG8_LDB(B1, 0, 1); PG8_SCHED; PG8_LDA(At, 0, 0); PG8_STAGE(PG8_SA(1, 1), a1 + hstepA, vA1);
            PG8_WAIT_V(8); PG8_WAIT_L(0); PG8_BAR; PG8_MMA(0, 0, At, B0); PG8_MMA(0, 1, At, B1); PG8_BAR; PG8_SCHED;
            PG8_LDA(At, 0, 1); PG8_STAGE(PG8_SB(0, 0), b2, voffB); PG8_STAGE(PG8_SB(0, 1), b2 + hstepB, voffB); PG8_STAGE(PG8_SA(0, 0), a2, s0);
            PG8_WAIT_V(8); PG8_WAIT_L(0); PG8_BAR; PG8_MMA(1, 0, At, B0); PG8_MMA(1, 1, At, B1); PG8_BAR; PG8_SCHED;
            PG8_LDB(B0, 1, 0); PG8_LDB(B1, 1, 1); PG8_SCHED; PG8_LDA(At, 1, 0); PG8_STAGE(PG8_SA(0, 1), a2 + hstepA, s1);
            PG8_WAIT_V(8); PG8_WAIT_L(0); PG8_BAR; PG8_MMA(0, 0, At, B0); PG8_MMA(0, 1, At, B1); PG8_BAR; PG8_SCHED;
            PG8_LDA(At, 1, 1); PG8_STAGE(PG8_SB(1, 0), b3, voffB); PG8_STAGE(PG8_SB(1, 1), b3 + hstepB, voffB); PG8_STAGE(PG8_SA(1, 0), a3, s0);
            PG8_WAIT_V(8); PG8_WAIT_L(0); PG8_BAR; PG8_MMA(1, 0, At, B0); PG8_MMA(1, 1, At, B1); PG8_BAR; PG8_SCHED;
        }
        if (wr == 0) PG8_BAR;
        E(acc, cur, wr, wc, fr, fq);
        if (!has_next) break;
#pragma unroll
        for (int a = 0; a < 2; ++a)
#pragma unroll
            for (int b = 0; b < 2; ++b)
#pragma unroll
                for (int m = 0; m < 4; ++m)
#pragma unroll
                    for (int n = 0; n < 2; ++n) acc[a][b][m][n] = (f32x4){0.f, 0.f, 0.f, 0.f};
        cur = nxt; cA = nA; cB = nB; ++ui;
        if constexpr (GATHER) {
#pragma unroll
            for (int i = 0; i < 2; ++i) { vA0[i] = nA0[i]; vA1[i] = nA1[i]; } }
        if (wr == 1) PG8_BAR;
    }
    PG8_WAIT_V(0);
    PG8_BAR;
#undef PG8_SA
#undef PG8_SB
#undef PG8_STAGE
#undef PG8_LDA
#undef PG8_LDB
#undef PG8_MMA
#undef PG8_WAIT_V
#undef PG8_WAIT_L
#undef PG8_BAR
#undef PG8_SCHED
#undef PG8_GOFF
#undef PG8_CAT8
#undef PG8_RDA
#undef PG8_RDB
}
}

constexpr int D = 1024, BATCH = 8, SEQ = 4096, M = BATCH * SEQ, DEPTH = 2;
constexpr int D_A = 512, D_BK = 512, D_BV = 512, D_C = 512, H_B = 4;
constexpr int N_IN = 7680, N_BCA = 4608, N_G = 3072;
constexpr int D_FF = 2816, NE = 8, N13 = 2 * D_FF;
constexpr int MOD_LD = 6 * D;
constexpr float EPS = 1e-6f;
constexpr int XLD = 2 * D;
constexpr int LIST_CAP = M;
constexpr int MOE_ROWS = M + NE * 256;

constexpr size_t MiB = 1u << 20;
constexpr size_t WS_CTL = 0, CTL_ZERO_BYTES = 1 * MiB;
constexpr size_t WS_MOD = 1 * MiB;
constexpr size_t WS_TOPP = 2 * MiB;
constexpr size_t WS_QS = 2 * MiB + 768 * 1024;
constexpr size_t WS_LIST = 3 * MiB;
constexpr size_t WS_WMIX = 6 * MiB;
constexpr size_t WMIX_G8 = 9 * MiB;
constexpr size_t WS_W13 = 26 * MiB, WS_W2 = 37 * MiB;
constexpr size_t WS_BIG = 44 * MiB;
constexpr size_t WS_H = WS_BIG;
constexpr size_t WS_P1 = WS_BIG + 64 * MiB;
constexpr size_t WS_PG = WS_P1;
constexpr size_t WS_MRG = WS_P1 + 192 * MiB;
constexpr size_t WS_YA = WS_P1 + 288 * MiB, WS_YB = WS_YA + 32 * MiB, WS_YC = WS_YB + 32 * MiB;
constexpr size_t WS_ACT = WS_P1;
constexpr size_t WS_HU = WS_YC + 32 * MiB;
constexpr size_t WS_HD = WS_HU + 16 * MiB;
constexpr size_t WS_H8 = WS_HD + 1 * MiB;
constexpr size_t WS_MIX_END = WS_H8 + 32 * MiB;
static_assert((Q_PROJ == 0 || Q_GATE == 0 || Q_PROJ == Q_GATE) && Q_FDN != 2 && Q_MDN == 1 && Q_MUP != 0, "supported operand encodings");
constexpr int HQ_MIX = Q_PROJ ? Q_PROJ : Q_GATE;
constexpr bool H_BF = (Q_PROJ == 0 || Q_GATE == 0);
constexpr float F8_SW = 64.0f, F8_SACT = 8.0f, W_CLIP = 4.5f;
#ifndef CLIP_MIX0
#define CLIP_MIX0 6.0f
#endif
#ifndef CLIP_MIX1
#define CLIP_MIX1 6.0f
#endif
#ifndef CLIP_FFN
#define CLIP_FFN 6.0f
#endif
#ifndef CLIP_MOE
#define CLIP_MOE 6.0f
#endif
__host__ __device__ constexpr float sa_of(int q, float clip) { return q == 2 ? 127.0f / clip : 4.0f; }
enum { QS_IN = 0, QS_F13 = 1, QS_M13 = 3, QS_N = 8 };
constexpr int MOE_ES = 1;
constexpr size_t WS_WM13 = 6 * MiB;
constexpr size_t WS_WM2 = WS_WM13 + 88 * MiB;
constexpr size_t WS_H2M = WS_WM2 + 44 * MiB;
constexpr size_t WS_ACTM = WS_H2M + 64 * MiB;
constexpr size_t WS_MOE_END = WS_ACTM + 2 * (size_t)MOE_ROWS * D_FF * MOE_ES;
constexpr size_t WS_NEED = WS_MIX_END > WS_MOE_END ? WS_MIX_END : WS_MOE_END;
static_assert(WS_W2 + (size_t)D * D_FF * 2 <= WS_BIG && WS_WMIX + 20 * MiB <= WS_W13, "ws map");
constexpr int CW_BAR = 4096;
constexpr int CW_CNT = 16384;

constexpr int LDS_BYTES = 147456;
constexpr int SCR_BYTES = 139264;
constexpr int TAB_OFF = SCR_BYTES;
constexpr int MISC_OFF = TAB_OFF + 4096;
static_assert(MISC_OFF + 128 <= LDS_BYTES, "LDS map");
constexpr int NWAVES = 8, NT = 512;

#define GAS __attribute__((address_space(1)))
#define LAS __attribute__((address_space(3)))
typedef unsigned short bf16;
typedef unsigned v4u __attribute__((ext_vector_type(4)));
typedef float f32x4 __attribute__((ext_vector_type(4)));
#define LDS_WAIT() asm volatile("s_waitcnt lgkmcnt(0)" ::: "memory")
#define LDS_BARRIER() asm volatile("s_waitcnt lgkmcnt(0)\n\ts_barrier" ::: "memory")

typedef float f32x2_t __attribute__((ext_vector_type(2)));
typedef __bf16 bf16x2_t __attribute__((ext_vector_type(2)));
__device__ __forceinline__ unsigned pk2(float lo, float hi) { f32x2_t v = {lo, hi}; bf16x2_t b = __builtin_convertvector(v, bf16x2_t); return __builtin_bit_cast(unsigned, b); }
__device__ __forceinline__ float bf_lo(unsigned u) { return __uint_as_float(u << 16); }
__device__ __forceinline__ float bf_hi(unsigned u) { return __uint_as_float(u & 0xffff0000u); }
__device__ __forceinline__ void unpack8(const v4u w, float (&f)[8]) { f[0] = bf_lo(w.x); f[1] = bf_hi(w.x); f[2] = bf_lo(w.y); f[3] = bf_hi(w.y); f[4] = bf_lo(w.z); f[5] = bf_hi(w.z); f[6] = bf_lo(w.w); f[7] = bf_hi(w.w); }
__device__ __forceinline__ v4u pack8(const float (&f)[8]) { v4u w; w.x = pk2(f[0], f[1]); w.y = pk2(f[2], f[3]); w.z = pk2(f[4], f[5]); w.w = pk2(f[6], f[7]); return w; }
__device__ __forceinline__ float sigmoidf_(float x) { return __builtin_amdgcn_rcpf(1.0f + __expf(-x)); }
__device__ __forceinline__ float siluf_(float x) { return x * sigmoidf_(x); }
template <int Q> __device__ __forceinline__ float accf(float v) { return (Q == 2) ? (float)__float_as_int(v) : v; }
__device__ __forceinline__ float clamp_f8(float x) { return fminf(fmaxf(x, -448.0f), 448.0f); }
__device__ __forceinline__ unsigned q1_i8(float x) { return (unsigned)(int)rintf(fminf(fmaxf(x, -127.0f), 127.0f)) & 0xffu; }
template <int Q> __device__ __forceinline__ unsigned pk4_q(float a, float b, float c, float d) {
    if constexpr (Q == 2) return q1_i8(a) | (q1_i8(b) << 8) | (q1_i8(c) << 16) | (q1_i8(d) << 24);
    else { int v = 0; v = __builtin_amdgcn_cvt_pk_fp8_f32(clamp_f8(a), clamp_f8(b), v, false); v = __builtin_amdgcn_cvt_pk_fp8_f32(clamp_f8(c), clamp_f8(d), v, true); return (unsigned)v; } }
__device__ __forceinline__ float shx(float v, int mask, int lane) { return __int_as_float(__builtin_amdgcn_ds_bpermute((lane ^ mask) << 2, __float_as_int(v))); }
__device__ __forceinline__ float shl(float v, int src) { return __int_as_float(__builtin_amdgcn_ds_bpermute(src << 2, __float_as_int(v))); }
__device__ __forceinline__ float wave_sum(float v, int lane) {
#pragma unroll
    for (int o = 1; o < 64; o <<= 1) v += shx(v, o, lane);
    return v;
}

__device__ __forceinline__ f32x4 rot64(const f32x4 v, int lane) {
    const float a0 = v.x + v.y, a1 = v.x - v.y, a2 = v.z + v.w, a3 = v.z - v.w;
    f32x4 b = {a0 + a2, a1 + a3, a0 - a2, a1 - a3};
#pragma unroll
    for (int m = 1; m < 16; m <<= 1) { const f32x4 p = {shx(b.x, m, lane), shx(b.y, m, lane), shx(b.z, m, lane), shx(b.w, m, lane)}; b = (lane & m) ? p - b : b + p; }
    return b * 0.125f;
}

#define XB_TMO      128
#define XB_XCNT(j)  (256  + 64 * (j))
#define XB_XSUB(j)  (1280 + 64 * (j))
#define XB_XGEN(j)  (2304 + 64 * (j))
#define XB_TOP      3328
#define XB_TOPGEN   3392
#define XCD_BAR_WORDS 3456
#define XB_SPIN_CAP (1u << 18)

__device__ __forceinline__ unsigned xb_ld(unsigned* p)              { return __hip_atomic_load(p, __ATOMIC_RELAXED, __HIP_MEMORY_SCOPE_AGENT); }
__device__ __forceinline__ unsigned xb_add(unsigned* p, unsigned v) { return __hip_atomic_fetch_add(p, v, __ATOMIC_RELAXED, __HIP_MEMORY_SCOPE_AGENT); }
__device__ __forceinline__ unsigned xb_xcc_id() { return (unsigned)__builtin_amdgcn_s_getreg((3 << 11) | 20) & 0xFu; }
#define XB_SPIN(cond, bar) do { unsigned _sp = 0; while (cond) { __builtin_amdgcn_s_sleep(1); \
    if ((++_sp & 255u) == 0u) { if (xb_ld(&(bar)[XB_TMO])) break; if (_sp > XB_SPIN_CAP) { atomicAdd(&(bar)[XB_TMO], 1u); break; } } } } while (0)

struct XcdBarrier { unsigned* bar; unsigned x; volatile LAS unsigned* st; };

__device__ __forceinline__ XcdBarrier xcd_barrier_post(unsigned* bar, volatile LAS unsigned* st) {
    XcdBarrier b; b.bar = bar; b.x = xb_xcc_id(); b.st = st;
    if (threadIdx.x == 0) (void)xb_add(&bar[XB_XCNT(b.x)], 1u);
    return b;
}
__device__ __forceinline__ void xcd_barrier_complete(unsigned* bar, unsigned x, unsigned& nloc, unsigned& nx) {
    const unsigned G = gridDim.x * gridDim.y * gridDim.z;
    unsigned sum, cnt, mine, sp = 0u;
    for (;;) {
        sum = 0u; cnt = 0u; mine = 0u;
        unsigned cv[16];
#pragma unroll
        for (unsigned j = 0; j < 16; ++j) cv[j] = xb_ld(&bar[XB_XCNT(j)]);
        asm volatile("" ::: "memory");
#pragma unroll
        for (unsigned j = 0; j < 16; ++j) { const unsigned c = cv[j]; sum += c; cnt += (c > 0u) ? 1u : 0u; mine = (j == x) ? c : mine; }
        if (sum == G) break;
        __builtin_amdgcn_s_sleep(1);
        if ((++sp & 255u) == 0u) { if (xb_ld(&bar[XB_TMO])) break; if (sp > XB_SPIN_CAP) { atomicAdd(&bar[XB_TMO], 1u); break; } }
    }
    nloc = mine > 0u ? mine : 1u; nx = cnt > 0u ? cnt : 1u;
}
__device__ __forceinline__ void xcd_barrier(const XcdBarrier& b) {
    asm volatile("s_waitcnt vmcnt(0)" ::: "memory");
    __syncthreads();
    if (threadIdx.x == 0) {
        unsigned* bar = b.bar;
        __builtin_amdgcn_s_waitcnt(0);
        unsigned nloc = b.st[0], nx = b.st[1];
        if (nloc == 0u) { xcd_barrier_complete(bar, b.x, nloc, nx); b.st[0] = nloc; b.st[1] = nx; }
        const unsigned old = xb_add(&bar[XB_XSUB(b.x)], 1u);
        const unsigned gen = old / nloc;
        if (old + 1u == (gen + 1u) * nloc) {
            __builtin_amdgcn_fence(__ATOMIC_RELEASE, "agent");
            asm volatile("s_waitcnt vmcnt(0)" ::: "memory");
            const unsigned og = xb_add(&bar[XB_TOP], 1u);
            const unsigned tg = og / nx;
            if (og + 1u == (tg + 1u) * nx) xb_add(&bar[XB_TOPGEN], 1u);
            else XB_SPIN(xb_ld(&bar[XB_TOPGEN]) == tg, bar);
            __builtin_amdgcn_fence(__ATOMIC_ACQUIRE, "agent");
            xb_add(&bar[XB_XGEN(b.x)], 1u);
            asm volatile("s_waitcnt vmcnt(0)" ::: "memory");
        } else {
            XB_SPIN(xb_ld(&bar[XB_XGEN(b.x)]) == gen, bar);
            __builtin_amdgcn_fence(__ATOMIC_ACQUIRE, "agent");
            asm volatile("s_waitcnt vmcnt(0)" ::: "memory");
        }
    }
    __syncthreads();
}

struct Args { const float* in[26]; float* out; unsigned char* ws; int ph_lo, ph_hi; };
typedef const Args __attribute__((address_space(4)))* KArgs;
#define KA() ({ KArgs p_ = (KArgs)__builtin_amdgcn_kernarg_segment_ptr(); asm volatile("" : "+s"(p_)); p_; })
struct Frame {
    LAS unsigned char* lds;
    int tid, lane, wave, G, bid;
    int w0;
};

template <int MAP, int F8 = 0>
__device__ __forceinline__ void transpose_item(const float* W, int K, int N, bf16* WT, int row_off, LAS float* scr, int item, int lane, float wscale = F8_SW) {
    const int nblk = N / 32, kb = item / nblk, nb = item % nblk, k0 = 64 * kb, n0 = 32 * nb;
    float vld[32];
#pragma unroll
    for (int i = 0; i < 32; ++i) vld[i] = W[(size_t)(k0 + 2 * i + (lane >> 5)) * N + n0 + (lane & 31)];
    asm volatile("" ::: "memory");
    if constexpr (F8 == 2) {
#pragma unroll
        for (int t = 1; t < 32; t <<= 1)
#pragma unroll
            for (int i = 0; i < 32; ++i) if (!(i & t)) { const float a = vld[i], b = vld[i | t]; vld[i] = a + b; vld[i | t] = a - b; }
#pragma unroll
        for (int i = 0; i < 32; ++i) { const float pv = shx(vld[i], 32, lane); vld[i] = (lane & 32) ? pv - vld[i] : vld[i] + pv; }
        wscale *= 0.125f;
    }
#pragma unroll
    for (int i = 0; i < 32; ++i) scr[(2 * i + (lane >> 5)) * 33 + (lane & 31)] = vld[i];
    LDS_WAIT(); asm volatile("" ::: "memory");
    const int c = lane & 7;
#pragma unroll
    for (int j = 0; j < 4; ++j) { const int n = (lane >> 3) + 8 * j; const LAS float* s = scr + (8 * c) * 33 + n;
        v4u o; o.x = pk2(s[0 * 33], s[1 * 33]); o.y = pk2(s[2 * 33], s[3 * 33]); o.z = pk2(s[4 * 33], s[5 * 33]); o.w = pk2(s[6 * 33], s[7 * 33]);
        const int nn = n0 + n; const int row = (MAP == 0) ? (row_off + nn) : ((nn >> 7) * 256 + row_off + (nn & 127));
        if constexpr (F8) { typedef unsigned v2u_ __attribute__((ext_vector_type(2))); v2u_ o8;
            o8.x = pk4_q<F8>(s[0 * 33] * wscale, s[1 * 33] * wscale, s[2 * 33] * wscale, s[3 * 33] * wscale); o8.y = pk4_q<F8>(s[4 * 33] * wscale, s[5 * 33] * wscale, s[6 * 33] * wscale, s[7 * 33] * wscale);
            *(v2u_*)((unsigned char*)WT + (size_t)row * K + k0 + 8 * c) = o8; }
        else *(v4u*)(WT + (size_t)row * K + k0 + 8 * c) = o; }
    LDS_WAIT(); asm volatile("" ::: "memory");
}

__device__ __forceinline__ void p_prologue(Frame& F, KArgs ka) {
    const float* c = ka->in[1]; const float* ada_w = ka->in[2]; const float* ada_b = ka->in[3];
    unsigned char* aws = ka->ws; float* mod = (float*)(aws + WS_MOD);
    LAS float* cact = (LAS float*)F.lds;
    LAS float* red = cact + 8192;
    for (int i = F.tid; i < BATCH * D; i += NT) cact[i] = siluf_(c[i]);
    __syncthreads();
    for (int chunk = F.bid; chunk < 256; chunk += F.G) {
        const int l = chunk >> 7, n0 = (chunk & 127) * 48;
        if (F.tid < 480) {
            const int kg = F.tid / 48, col = F.tid % 48;
            float acc[8];
#pragma unroll
            for (int b = 0; b < 8; ++b) acc[b] = 0.f;
            const float* wp = ada_w + (size_t)l * D * MOD_LD + n0 + col;
            for (int k = kg; k < D; k += 10) { const float w = wp[(size_t)k * MOD_LD];
#pragma unroll
                for (int b = 0; b < 8; ++b) acc[b] += cact[b * D + k] * w; }
#pragma unroll
            for (int b = 0; b < 8; ++b) red[(kg * 48 + col) * 8 + b] = acc[b];
        }
        __syncthreads();
        if (F.tid < 384) {
            const int col = F.tid >> 3, b = F.tid & 7; float s = 0.f;
#pragma unroll
            for (int kg = 0; kg < 10; ++kg) s += red[(kg * 48 + col) * 8 + b];
            mod[(size_t)(l * 8 + b) * MOD_LD + n0 + col] = s + ada_b[l * MOD_LD + n0 + col];
        }
        __syncthreads();
    }
}
__device__ __forceinline__ float wscale_sample(const float* W, size_t n, int lane) {
    float ss = 0.f;
#pragma unroll 8
    for (int j = 0; j < 32; ++j) { const size_t idx = ((size_t)(lane + 64 * j) * 1000003ull) % n; const float v = W[idx]; ss += v * v; }
    ss = wave_sum(ss, lane);
    return 127.0f / (W_CLIP * sqrtf(ss * (1.0f / 2048.0f)) + 1e-30f);
}
__device__ __forceinline__ void p_convert_mixer(Frame& F, KArgs ka, int l, bool with_ffn) {
    unsigned char* aws = ka->ws;
    LAS float* scr = (LAS float*)(F.lds + F.wave * 16384);
    const int gw = F.bid * NWAVES + F.wave, NGW = F.G * NWAVES;
    constexpr int I_BCA = (D / 64) * (N_BCA / 32), I_G = (D / 64) * (N_G / 32), I_BR = (512 / 64) * (D / 32), I_O = (D / 64) * (D / 32), I_L = I_BCA + I_G + 3 * I_BR + I_O;
    constexpr int I_F1 = (D / 64) * (D_FF / 32), I_F2 = (D_FF / 64) * (D / 32);
    const int nitems = I_L + (with_ffn ? 2 * I_F1 + I_F2 : 0);
    bf16* base = (bf16*)(aws + WS_WMIX);
    LAS float* qsl = (LAS float*)(F.lds + TAB_OFF + 3072);
    __syncthreads();
    if (F.wave == 0) { const float v = wscale_sample(ka->in[6] + (size_t)l * D * N_IN, (size_t)D * N_IN, F.lane); if (F.lane == 0) qsl[0] = v; }
    if (F.wave == 1) { const float v = wscale_sample(ka->in[17], (size_t)D * D_FF, F.lane); if (F.lane == 0) qsl[1] = v; }
    if (F.wave == 2) { const float v = wscale_sample(ka->in[18], (size_t)D * D_FF, F.lane); if (F.lane == 0) qsl[2] = v; }
    __syncthreads();
    const float ws_in = qsl[0], ws_13 = (Q_FUP == 2) ? fminf(qsl[1], qsl[2]) : F8_SW;
    const float ws_p = (Q_PROJ == 2) ? ws_in : F8_SW, ws_g = (Q_GATE == 2) ? ws_in : F8_SW;
    if (F.bid == 0 && F.tid == 0) { float* qs = (float*)(aws + WS_QS); qs[QS_IN] = ws_in; if (with_ffn) qs[QS_F13] = ws_13; }
    for (int it = gw; it < nitems; it += NGW) {
        int r = it;
        if (r < I_BCA) { const int kb = r / (N_BCA / 32), nb = r % (N_BCA / 32);
            transpose_item<0, Q_PROJ>(ka->in[6] + (size_t)l * D * N_IN, D, N_IN, base, 0, scr, kb * (N_IN / 32) + nb, F.lane, ws_p); continue; } r -= I_BCA;
        if (r < I_G) { const int kb = r / (N_G / 32), nb = r % (N_G / 32) + N_BCA / 32;
            if (Q_GATE) transpose_item<0, Q_GATE>(ka->in[6] + (size_t)l * D * N_IN, D, N_IN, (bf16*)(aws + WS_WMIX + WMIX_G8), -N_BCA, scr, kb * (N_IN / 32) + nb, F.lane, ws_g);
            else transpose_item<0>(ka->in[6] + (size_t)l * D * N_IN, D, N_IN, base, 0, scr, kb * (N_IN / 32) + nb, F.lane);
            continue; } r -= I_G;
        if (r < I_BR) { transpose_item<0>(ka->in[13] + (size_t)l * 512 * D, 512, D, base + (size_t)N_IN * D, 0, scr, r, F.lane); continue; } r -= I_BR;
        if (r < I_BR) { transpose_item<0>(ka->in[14] + (size_t)l * 512 * D, 512, D, base + (size_t)N_IN * D + 512 * 1024, 0, scr, r, F.lane); continue; } r -= I_BR;
        if (r < I_BR) { transpose_item<0>(ka->in[15] + (size_t)l * 512 * D, 512, D, base + (size_t)N_IN * D + 2 * 512 * 1024, 0, scr, r, F.lane); continue; } r -= I_BR;
        if (r < I_O) { transpose_item<0>(ka->in[16] + (size_t)l * D * D, D, D, base + (size_t)N_IN * D + 3 * 512 * 1024, 0, scr, r, F.lane); continue; } r -= I_O;
        if (r < I_F1) { transpose_item<1, Q_FUP>(ka->in[17], D, D_FF, (bf16*)(aws + WS_W13), 0, scr, r, F.lane, ws_13); continue; } r -= I_F1;
        if (r < I_F1) { transpose_item<1, Q_FUP>(ka->in[18], D, D_FF, (bf16*)(aws + WS_W13), 128, scr, r, F.lane, ws_13); continue; } r -= I_F1;
        transpose_item<0, Q_FDN>(ka->in[19], D_FF, D, (bf16*)(aws + WS_W2), 0, scr, r, F.lane, F8_SW);
    }
}
__device__ __forceinline__ void p_moe_weights(Frame& F, KArgs ka) {
    unsigned char* aws = ka->ws;
    LAS float* scr = (LAS float*)(F.lds + F.wave * 16384);
    const int gw = F.bid * NWAVES + F.wave, NGW = F.G * NWAVES;
    constexpr int I_F1 = (D / 64) * (D_FF / 32), I_F2 = (D_FF / 64) * (D / 32), I_E = 2 * I_F1 + I_F2;
    LAS float* qsl = (LAS float*)(F.lds + TAB_OFF + 3072);
    __syncthreads();
    if (F.wave == 0) { const float v = wscale_sample(ka->in[22], (size_t)NE * D * D_FF, F.lane); if (F.lane == 0) qsl[0] = v; }
    if (F.wave == 1) { const float v = wscale_sample(ka->in[23], (size_t)NE * D * D_FF, F.lane); if (F.lane == 0) qsl[1] = v; }
    __syncthreads();
    const float ws_13 = (Q_MUP == 2) ? fminf(qsl[0], qsl[1]) : F8_SW;
    if (F.bid == 0 && F.tid == 0) { float* qs = (float*)(aws + WS_QS); qs[QS_M13] = ws_13; }
    for (int it = gw; it < NE * I_E; it += NGW) {
        const int e = it / I_E; int r = it - e * I_E;
        bf16* w13 = (bf16*)(aws + WS_WM13 + (size_t)e * N13 * D * MOE_ES); bf16* w2 = (bf16*)(aws + WS_WM2 + (size_t)e * D * D_FF * MOE_ES);
        if (r < I_F1) { transpose_item<1, Q_MUP>(ka->in[22] + (size_t)e * D * D_FF, D, D_FF, w13, 0, scr, r, F.lane, ws_13); continue; } r -= I_F1;
        if (r < I_F1) { transpose_item<1, Q_MUP>(ka->in[23] + (size_t)e * D * D_FF, D, D_FF, w13, 128, scr, r, F.lane, ws_13); continue; } r -= I_F1;
        transpose_item<0, Q_MDN>(ka->in[24] + (size_t)e * D_FF * D, D_FF, D, w2, 0, scr, r, F.lane, F8_SW);
    }
}

__device__ __forceinline__ void norm_row(const float* xrow, const float* w, const float* sc, const float* sh, int lane, f32x4 (&o)[4]) {
    const f32x4* xr = (const f32x4*)xrow + lane;
    f32x4 v[4]; float s = 0.f;
#pragma unroll
    for (int j = 0; j < 4; ++j) { v[j] = xr[64 * j]; s += (v[j].x * v[j].x + v[j].y * v[j].y) + (v[j].z * v[j].z + v[j].w * v[j].w); }
    const float rstd = 1.0f / sqrtf(wave_sum(s, lane) * (1.0f / D) + EPS);
#pragma unroll
    for (int j = 0; j < 4; ++j) { const f32x4 wv = ((const f32x4*)w)[lane + 64 * j], scv = ((const f32x4*)sc)[lane + 64 * j], shv = ((const f32x4*)sh)[lane + 64 * j];
        o[j] = v[j] * rstd * wv * (scv + 1.0f) + shv; }
}
template <bool XBF>
__device__ __forceinline__ f32x4 load_x4(const void* xbase, size_t row, int lane, int j) {
    if constexpr (XBF) { typedef unsigned v2u_ __attribute__((ext_vector_type(2))); const v2u_ w = ((const v2u_*)((const bf16*)xbase + row * XLD))[lane + 64 * j];
        return (f32x4){bf_lo(w.x), bf_hi(w.x), bf_lo(w.y), bf_hi(w.y)}; }
    else return ((const f32x4*)((const float*)xbase + row * D))[lane + 64 * j];
}
__device__ __forceinline__ void store_row_bf16(bf16* orow, int lane, const f32x4 (&o)[4]) {
    unsigned long long* o8 = (unsigned long long*)orow + lane;
#pragma unroll
    for (int j = 0; j < 4; ++j) o8[64 * j] = (unsigned long long)pk2(o[j].x, o[j].y) | ((unsigned long long)pk2(o[j].z, o[j].w) << 32);
}
template <int MODE = 0, bool XBF = true, int HQ = 2>
__device__ __forceinline__ void p_norm(Frame& F, const void* xin, const float* w, const float* mod_l, int sc_off, int sh_off, bf16* hout, unsigned char* hout8 = nullptr, float sa = 1.0f) {
    const int gw = F.bid * NWAVES + F.wave, NGW = F.G * NWAVES, lane = F.lane;
    f32x4 wv[4];
#pragma unroll
    for (int j = 0; j < 4; ++j) wv[j] = ((const f32x4*)w)[lane + 64 * j];
    for (int r0 = gw * 4; r0 < M; r0 += NGW * 4) {
        const float* mb = mod_l + (size_t)(r0 >> 12) * MOD_LD;
        f32x4 v[4][4], scv[4], shv[4];
#pragma unroll
        for (int r = 0; r < 4; ++r)
#pragma unroll
            for (int j = 0; j < 4; ++j) v[r][j] = load_x4<XBF>(xin, (size_t)(r0 + r), lane, j);
#pragma unroll
        for (int j = 0; j < 4; ++j) { scv[j] = ((const f32x4*)(mb + sc_off))[lane + 64 * j]; shv[j] = ((const f32x4*)(mb + sh_off))[lane + 64 * j]; }
        asm volatile("" ::: "memory");
#pragma unroll
        for (int j = 0; j < 4; ++j) scv[j] = wv[j] * (scv[j] + 1.0f);
#pragma unroll
        for (int r = 0; r < 4; ++r) { float s = 0.f;
#pragma unroll
            for (int j = 0; j < 4; ++j) s += (v[r][j].x * v[r][j].x + v[r][j].y * v[r][j].y) + (v[r][j].z * v[r][j].z + v[r][j].w * v[r][j].w);
            const float rstd = 1.0f / sqrtf(wave_sum(s, lane) * (1.0f / D) + EPS);
            f32x4 o[4];
#pragma unroll
            for (int j = 0; j < 4; ++j) o[j] = v[r][j] * rstd * scv[j] + shv[j];
            if constexpr (MODE != 0) { unsigned* o4 = (unsigned*)((MODE == 1 ? (unsigned char*)hout : hout8) + (size_t)(r0 + r) * D) + lane;
#pragma unroll
                for (int j = 0; j < 4; ++j) { const f32x4 q = (HQ == 2) ? rot64(o[j], lane) : o[j]; o4[64 * j] = pk4_q<HQ>(q.x * sa, q.y * sa, q.z * sa, q.w * sa); } }
            if constexpr (MODE != 1) store_row_bf16(hout + (size_t)(r0 + r) * D, lane, o); }
    }
}

__device__ __forceinline__ void p_conv(Frame& F, const bf16* P1, const float* conv_w, bf16* ya) {
    const int gt = F.bid * NT + F.tid, NGT = F.G * NT;
    for (int it = gt; it < M * 64; it += NGT) {
        const int row = it >> 6, c8 = (it & 63) * 8, pos = row & (SEQ - 1);
        const bf16* p = P1 + (size_t)row * N_BCA + c8;
        float ab[8], ac[8], ah[8], z1[8], z2[8], y[8];
        unpack8(*(const v4u*)p, ab); unpack8(*(const v4u*)(p + 512), ac); unpack8(*(const v4u*)(p + 1024), ah);
#pragma unroll
        for (int i = 0; i < 8; ++i) { z1[i] = 0.f; z2[i] = 0.f; }
        if (pos >= 1) { float c1[8], h1[8]; unpack8(*(const v4u*)(p - N_BCA + 512), c1); unpack8(*(const v4u*)(p - N_BCA + 1024), h1);
#pragma unroll
            for (int i = 0; i < 8; ++i) z1[i] = c1[i] * h1[i]; }
        if (pos >= 2) { float c2[8], h2[8]; unpack8(*(const v4u*)(p - 2 * N_BCA + 512), c2); unpack8(*(const v4u*)(p - 2 * N_BCA + 1024), h2);
#pragma unroll
            for (int i = 0; i < 8; ++i) z2[i] = c2[i] * h2[i]; }
#pragma unroll
        for (int i = 0; i < 8; ++i) y[i] = ab[i] * (conv_w[c8 + i] * (ac[i] * ah[i]) + conv_w[512 + c8 + i] * z1[i] + conv_w[1024 + c8 + i] * z2[i]);
        *(v4u*)(ya + (size_t)row * 512 + c8) = pack8(y);
    }
}

typedef short v4i16_t __attribute__((ext_vector_type(4)));
typedef short bf16x8_t __attribute__((ext_vector_type(8)));
typedef unsigned v2u __attribute__((ext_vector_type(2)));
constexpr int HRS = 272;
constexpr int TRS = 80;
constexpr int H_RAWQ = 0, H_RAWF = 8704, H_V = 17408, H_QHT = 26112, H_KTT = 36352, H_KHT = 46592, H_DL = 56832, H_OB = 57344, H_OBS = 132, H_V2 = 74240;
constexpr int HSEG = 512, HNSEG = SEQ / HSEG, HCH = 32;
__device__ __forceinline__ v4i16_t tr_read(LAS unsigned char* p) { return __builtin_amdgcn_ds_read_tr16_b64_v4i16((LAS v4i16_t*)p); }
__device__ __forceinline__ bf16x8_t cat4(v4i16_t lo, v4i16_t hi) { return __builtin_shufflevector(lo, hi, 0, 1, 2, 3, 4, 5, 6, 7); }
__device__ __forceinline__ bf16x8_t pack_acc(const f32x4 a, const f32x4 b) { v4u w; w.x = pk2(a[0], a[1]); w.y = pk2(a[2], a[3]); w.z = pk2(b[0], b[1]); w.w = pk2(b[2], b[3]); return __builtin_bit_cast(bf16x8_t, w); }
__device__ __forceinline__ float bfs(short x) { return __uint_as_float((unsigned)(unsigned short)x << 16); }
template <int PASS>
__device__ __forceinline__ void p_hgrn(Frame& F, const bf16* P1, const float* lb_logits, int layer, const float* norm_w, bf16* yb, float* ust, float* dst) {
    LAS unsigned char* L = F.lds;
    const int lane = F.lane, w = F.wave, g = lane >> 4, n = lane & 15, q_ = n >> 2, p_ = n & 3;
    const int pt = F.tid >> 4, pc8 = (F.tid & 15) * 8;
    for (int u = F.bid; u < BATCH * H_B * HNSEG; u += F.G) {
        const int seg = u & (HNSEG - 1), bh = u / HNSEG, b = bh >> 2, h = bh & 3;
        const int d = 16 * w + n;
        float lb; { const int ch = h * 128 + d; const float l0 = lb_logits[ch], l1 = lb_logits[512 + ch]; const float mx = fmaxf(l0, l1);
            const float e0 = expf(l0 - mx), e1 = expf(l1 - mx); const float p0 = e0 / (e0 + e1), p1 = e1 / (e0 + e1);
            const float lbx = (layer == 0) ? (p0 - p0) : ((p0 + p1) - p0); lb = fminf(fmaxf(lbx, 0.f), 1.f); }
        const float lbf = fmaxf(lb, 1e-30f), oml = 1.0f - lb;
        f32x4 S[8];
#pragma unroll
        for (int kt = 0; kt < 8; ++kt) S[kt] = (f32x4){0.f, 0.f, 0.f, 0.f};
        if (PASS == 2) {
            for (int j = 0; j < seg; ++j) { const int uj = u - seg + j;
#pragma unroll
                for (int kt = 0; kt < 8; ++kt) { const f32x4 dj = *(const f32x4*)(dst + (size_t)uj * 128 + 16 * kt + 4 * g); const f32x4 uu = *(const f32x4*)(ust + ((((size_t)uj * 8 + w) * 8 + kt) * 64 + lane) * 4);
                    S[kt] = dj * S[kt] + uu; } }
        }
        float nw8[8];
        if (PASS == 2) {
#pragma unroll
            for (int i = 0; i < 8; ++i) nw8[i] = norm_w[h * 128 + pc8 + i]; }
        float dprod = 1.0f;
        const bf16* gp = P1 + ((size_t)b * SEQ + (size_t)seg * HSEG + pt) * N_BCA + 1536 + h * 128 + pc8;
        constexpr int HPF = 4, NCH = HSEG / HCH;
        v4u rq[HPF], rf[HPF], rv[HPF], rg[HPF];
#pragma unroll
        for (int k = 0; k < HPF; ++k) { const bf16* np = gp + (size_t)k * HCH * N_BCA; rf[k] = *(const v4u*)(np + 512); rv[k] = *(const v4u*)(np + 1024);
            if (PASS == 2) { rq[k] = *(const v4u*)np; rg[k] = *(const v4u*)(np + 1536); } }
#define HG_WRITE(k_, vb_) do { *(LAS v4u*)(L + H_RAWF + pt * HRS + pc8 * 2) = rf[k_]; *(LAS v4u*)(L + ((vb_) ? H_V2 : H_V) + pt * HRS + pc8 * 2) = rv[k_]; \
            if (PASS == 2) *(LAS v4u*)(L + H_RAWQ + pt * HRS + pc8 * 2) = rq[k_]; } while (0)
#define HG_REFILL(k_, cn_) do { if ((cn_) < NCH) { const bf16* np = gp + (size_t)(cn_) * HCH * N_BCA; rf[k_] = *(const v4u*)(np + 512); rv[k_] = *(const v4u*)(np + 1024); \
            if (PASS == 2) { rq[k_] = *(const v4u*)np; rg[k_] = *(const v4u*)(np + 1536); } } } while (0)
        v4u cg, cgn;
        HG_WRITE(0, 0); if (PASS == 2) cg = rg[0];
        LDS_BARRIER();
        HG_REFILL(0, HPF);
            { const bf16x8_t f8 = cat4(tr_read(L + H_RAWF + (8 * g + q_) * HRS + 32 * w + 8 * p_), tr_read(L + H_RAWF + (8 * g + 4 + q_) * HRS + 32 * w + 8 * p_));
              float eb[8], kk[8]; float cp = 1.0f;
#pragma unroll
              for (int i = 0; i < 8; ++i) { const float sg = __builtin_amdgcn_rcpf(1.0f + __expf(-bfs(f8[i]))); const float f = lbf + oml * sg; kk[i] = oml * (1.0f - sg); cp *= f; eb[i] = cp; }
              const float s1 = shl(cp, n), s2 = shl(cp, 16 + n), s3 = shl(cp, 32 + n), s4 = shl(cp, 48 + n);
              const float pre = (g > 0 ? s1 : 1.0f) * (g > 1 ? s2 : 1.0f) * (g > 2 ? s3 : 1.0f);
              const float elast = ((s1 * s2) * s3) * s4;
              float kh[8], kt8[8];
#pragma unroll
              for (int i = 0; i < 8; ++i) { eb[i] *= pre; const float en = __builtin_amdgcn_rcpf(fmaxf(eb[i], 1e-30f)); kt8[i] = kk[i] * en; kh[i] = kt8[i] * elast; }
              *(LAS v4u*)(L + H_KHT + d * TRS + 16 * g) = pack8(kh);
              if (PASS == 2) { const bf16x8_t q8 = cat4(tr_read(L + H_RAWQ + (8 * g + q_) * HRS + 32 * w + 8 * p_), tr_read(L + H_RAWQ + (8 * g + 4 + q_) * HRS + 32 * w + 8 * p_));
                  float qh[8];
#pragma unroll
                  for (int i = 0; i < 8; ++i) qh[i] = siluf_(bfs(q8[i])) * eb[i];
                  *(LAS v4u*)(L + H_QHT + d * TRS + 16 * g) = pack8(qh); *(LAS v4u*)(L + H_KTT + d * TRS + 16 * g) = pack8(kt8); }
              if (g == 0) *(LAS float*)(L + H_DL + 4 * d) = elast;
              dprod *= elast; }
        LDS_BARRIER();
        for (int c0 = 0; c0 < NCH; c0 += HPF) {
#pragma unroll
          for (int k = 0; k < HPF; ++k) {
            const int c = c0 + k; const int vbuf = (k & 1) ? H_V2 : H_V;
            const bf16x8_t bVn = cat4(tr_read(L + vbuf + (8 * g + q_) * HRS + 32 * w + 8 * p_), tr_read(L + vbuf + (8 * g + 4 + q_) * HRS + 32 * w + 8 * p_));
            if (PASS == 2) {
                const bf16x8_t bVp = cat4(tr_read(L + vbuf + (4 * g + q_) * HRS + 32 * w + 8 * p_), tr_read(L + vbuf + (16 + 4 * g + q_) * HRS + 32 * w + 8 * p_));
                f32x4 o[2], pt00 = {0.f, 0.f, 0.f, 0.f}, pt01 = {0.f, 0.f, 0.f, 0.f}, pt11 = {0.f, 0.f, 0.f, 0.f};
                o[0] = (f32x4){0.f, 0.f, 0.f, 0.f}; o[1] = (f32x4){0.f, 0.f, 0.f, 0.f};
#pragma unroll
                for (int ks = 0; ks < 4; ++ks) {
                    const bf16x8_t sb = pack_acc(S[2 * ks], S[2 * ks + 1]);
#pragma unroll
                    for (int tm = 0; tm < 2; ++tm) {
                        const bf16x8_t aq = cat4(tr_read(L + H_QHT + (32 * ks + 4 * g + q_) * TRS + 32 * tm + 8 * p_), tr_read(L + H_QHT + (32 * ks + 16 + 4 * g + q_) * TRS + 32 * tm + 8 * p_));
                        o[tm] = __builtin_amdgcn_mfma_f32_16x16x32_bf16(aq, sb, o[tm], 0, 0, 0); }
                    const bf16x8_t aK0 = cat4(tr_read(L + H_KTT + (32 * ks + 8 * g + q_) * TRS + 8 * p_), tr_read(L + H_KTT + (32 * ks + 8 * g + 4 + q_) * TRS + 8 * p_));
                    const bf16x8_t aK1 = cat4(tr_read(L + H_KTT + (32 * ks + 8 * g + q_) * TRS + 32 + 8 * p_), tr_read(L + H_KTT + (32 * ks + 8 * g + 4 + q_) * TRS + 32 + 8 * p_));
                    const bf16x8_t bQ0 = cat4(tr_read(L + H_QHT + (32 * ks + 8 * g + q_) * TRS + 8 * p_), tr_read(L + H_QHT + (32 * ks + 8 * g + 4 + q_) * TRS + 8 * p_));
                    const bf16x8_t bQ1 = cat4(tr_read(L + H_QHT + (32 * ks + 8 * g + q_) * TRS + 32 + 8 * p_), tr_read(L + H_QHT + (32 * ks + 8 * g + 4 + q_) * TRS + 32 + 8 * p_));
                    pt00 = __builtin_amdgcn_mfma_f32_16x16x32_bf16(aK0, bQ0, pt00, 0, 0, 0);
                    pt01 = __builtin_amdgcn_mfma_f32_16x16x32_bf16(aK0, bQ1, pt01, 0, 0, 0);
                    pt11 = __builtin_amdgcn_mfma_f32_16x16x32_bf16(aK1, bQ1, pt11, 0, 0, 0);
                }
#pragma unroll
                for (int j = 0; j < 4; ++j) if (4 * g + j > n) { pt00[j] = 0.f; pt11[j] = 0.f; }
                const f32x4 z4 = {0.f, 0.f, 0.f, 0.f};
                o[0] = __builtin_amdgcn_mfma_f32_16x16x32_bf16(pack_acc(pt00, z4), bVp, o[0], 0, 0, 0);
                o[1] = __builtin_amdgcn_mfma_f32_16x16x32_bf16(pack_acc(pt01, pt11), bVp, o[1], 0, 0, 0);
#pragma unroll
                for (int tm = 0; tm < 2; ++tm)
#pragma unroll
                    for (int j = 0; j < 4; ++j) *(LAS float*)(L + H_OB + ((16 * tm + 4 * g + j) * H_OBS + 16 * w + n) * 4) = o[tm][j];
            }
#pragma unroll
            for (int kt = 0; kt < 8; ++kt) { const f32x4 dl4 = *(const LAS f32x4*)(L + H_DL + (16 * kt + 4 * g) * 4);
                const bf16x8_t aKh = *(const LAS bf16x8_t*)(L + H_KHT + (16 * kt + n) * TRS + 16 * g);
                S[kt] = __builtin_amdgcn_mfma_f32_16x16x32_bf16(aKh, bVn, S[kt] * dl4, 0, 0, 0); }
            if (c + 1 < NCH) { HG_WRITE((k + 1) % HPF, (k + 1) & 1); if (PASS == 2) cgn = rg[(k + 1) % HPF]; }
            LDS_BARRIER();
            if (c + 1 < NCH) HG_REFILL((k + 1) % HPF, c + 1 + HPF);
            if (PASS == 2) {
                const f32x4 o0 = *(const LAS f32x4*)(L + H_OB + (pt * H_OBS + pc8) * 4), o1 = *(const LAS f32x4*)(L + H_OB + (pt * H_OBS + pc8 + 4) * 4);
                const float o8[8] = {o0.x, o0.y, o0.z, o0.w, o1.x, o1.y, o1.z, o1.w};
                float ss = 0.f;
#pragma unroll
                for (int i = 0; i < 8; ++i) ss += o8[i] * o8[i];
                ss += shx(ss, 1, lane); ss += shx(ss, 2, lane); ss += shx(ss, 4, lane); ss += shx(ss, 8, lane);
                const float rs = 1.0f / sqrtf(ss * (1.0f / 128.0f) + EPS);
                float g8[8], y[8]; unpack8(cg, g8);
#pragma unroll
                for (int i = 0; i < 8; ++i) y[i] = o8[i] * rs * nw8[i] * siluf_(g8[i]);
                *(v4u*)(yb + ((size_t)b * SEQ + (size_t)seg * HSEG + (size_t)c * HCH + pt) * 512 + h * 128 + pc8) = pack8(y);
            }
            if (c + 1 < NCH)
            { const bf16x8_t f8 = cat4(tr_read(L + H_RAWF + (8 * g + q_) * HRS + 32 * w + 8 * p_), tr_read(L + H_RAWF + (8 * g + 4 + q_) * HRS + 32 * w + 8 * p_));
              float eb[8], kk[8]; float cp = 1.0f;
#pragma unroll
              for (int i = 0; i < 8; ++i) { const float sg = __builtin_amdgcn_rcpf(1.0f + __expf(-bfs(f8[i]))); const float f = lbf + oml * sg; kk[i] = oml * (1.0f - sg); cp *= f; eb[i] = cp; }
              const float s1 = shl(cp, n), s2 = shl(cp, 16 + n), s3 = shl(cp, 32 + n), s4 = shl(cp, 48 + n);
              const float pre = (g > 0 ? s1 : 1.0f) * (g > 1 ? s2 : 1.0f) * (g > 2 ? s3 : 1.0f);
              const float elast = ((s1 * s2) * s3) * s4;
              float kh[8], kt8[8];
#pragma unroll
              for (int i = 0; i < 8; ++i) { eb[i] *= pre; const float en = __builtin_amdgcn_rcpf(fmaxf(eb[i], 1e-30f)); kt8[i] = kk[i] * en; kh[i] = kt8[i] * elast; }
              *(LAS v4u*)(L + H_KHT + d * TRS + 16 * g) = pack8(kh);
              if (PASS == 2) { const bf16x8_t q8 = cat4(tr_read(L + H_RAWQ + (8 * g + q_) * HRS + 32 * w + 8 * p_), tr_read(L + H_RAWQ + (8 * g + 4 + q_) * HRS + 32 * w + 8 * p_));
                  float qh[8];
#pragma unroll
                  for (int i = 0; i < 8; ++i) qh[i] = siluf_(bfs(q8[i])) * eb[i];
                  *(LAS v4u*)(L + H_QHT + d * TRS + 16 * g) = pack8(qh); *(LAS v4u*)(L + H_KTT + d * TRS + 16 * g) = pack8(kt8); }
              if (g == 0) *(LAS float*)(L + H_DL + 4 * d) = elast;
              dprod *= elast; }
            LDS_BARRIER();
            if (PASS == 2) cg = cgn;
          }
        }
#undef HG_WRITE
#undef HG_REFILL
        if (PASS == 1) {
#pragma unroll
            for (int kt = 0; kt < 8; ++kt) *(f32x4*)(ust + ((((size_t)u * 8 + w) * 8 + kt) * 64 + lane) * 4) = S[kt];
            if (g == 0) dst[(size_t)u * 128 + d] = dprod;
        }
        __syncthreads();
    }
}

constexpr int SG_V = 0, SG_OB = 34816, SG_OBS = 132, SG_RS = SG_OB + 128 * SG_OBS * 4;
__device__ __forceinline__ void p_sgu(Frame& F, const bf16* P1, const float* norm_w, const float* sgu_w, const float* sgu_b, bf16* yc) {
    LAS unsigned char* L = F.lds;
    const int lane = F.lane, w = F.wave, gq = lane >> 4, n = lane & 15, q_ = n >> 2, p_ = n & 3;
    const int sr = F.tid >> 4, c8 = (F.tid & 15) * 8;
    for (int u = F.bid; u < M / 128; u += F.G) {
        const size_t row0 = (size_t)u * 128;
        v4u rv[4][4]; float ssj[4] = {0.f, 0.f, 0.f, 0.f};
#pragma unroll
        for (int g = 0; g < 4; ++g)
#pragma unroll
            for (int j = 0; j < 4; ++j) { rv[g][j] = *(const v4u*)(P1 + (row0 + sr + 32 * j) * N_BCA + 4096 + g * 128 + c8); float f[8]; unpack8(rv[g][j], f);
#pragma unroll
                for (int i = 0; i < 8; ++i) ssj[j] += f[i] * f[i]; }
#pragma unroll
        for (int j = 0; j < 4; ++j) { float ss = ssj[j]; ss += shx(ss, 1, lane); ss += shx(ss, 2, lane); ss += shx(ss, 4, lane); ss += shx(ss, 8, lane);
            if (n == 0) *(LAS float*)(L + SG_RS + 4 * (sr + 32 * j)) = 1.0f / sqrtf(ss * (1.0f / 512.0f) + EPS); }
#pragma unroll
        for (int g = 0; g < 4; ++g) {
#pragma unroll
            for (int j = 0; j < 4; ++j) *(LAS v4u*)(L + SG_V + (sr + 32 * j) * HRS + c8 * 2) = rv[g][j];
            LDS_BARRIER();
            float nwv[8];
            const int kmax = w >> 1, t = 16 * w + n;
            bf16x8_t aW[4];
            { f32x4 wl[4][2]; float nwl[8];
#pragma unroll
              for (int ks = 0; ks < 4; ++ks) { const float* wp = sgu_w + ((size_t)g * 128 + t) * 128 + 32 * ks + 8 * gq; wl[ks][0] = *(const f32x4*)wp; wl[ks][1] = *(const f32x4*)(wp + 4); }
#pragma unroll
              for (int ct = 0; ct < 8; ++ct) nwl[ct] = norm_w[g * 128 + 16 * ct + n];
              asm volatile("" ::: "memory");
#pragma unroll
              for (int ct = 0; ct < 8; ++ct) nwv[ct] = nwl[ct];
#pragma unroll
              for (int ks = 0; ks < 4; ++ks) { const int s0 = 32 * ks + 8 * gq;
                    const f32x4 w0 = wl[ks][0], w1 = wl[ks][1]; const f32x4 r0 = *(const LAS f32x4*)(L + SG_RS + 4 * s0), r1 = *(const LAS f32x4*)(L + SG_RS + 4 * (s0 + 4));
                    float a8[8] = {w0.x * r0.x, w0.y * r0.y, w0.z * r0.z, w0.w * r0.w, w1.x * r1.x, w1.y * r1.y, w1.z * r1.z, w1.w * r1.w};
#pragma unroll
                    for (int i = 0; i < 8; ++i) if (s0 + i > t) a8[i] = 0.f;
                    aW[ks] = __builtin_bit_cast(bf16x8_t, pack8(a8)); } }
            f32x4 acc[8];
#pragma unroll
            for (int ct = 0; ct < 8; ++ct) acc[ct] = (f32x4){0.f, 0.f, 0.f, 0.f};
#pragma unroll
            for (int ks = 0; ks < 4; ++ks) { if (ks <= kmax) {
#pragma unroll
                for (int ct = 0; ct < 8; ++ct) { const bf16x8_t bV = cat4(tr_read(L + SG_V + (32 * ks + 8 * gq + q_) * HRS + 32 * ct + 8 * p_), tr_read(L + SG_V + (32 * ks + 8 * gq + 4 + q_) * HRS + 32 * ct + 8 * p_));
                    acc[ct] = __builtin_amdgcn_mfma_f32_16x16x32_bf16(aW[ks], bV, acc[ct], 0, 0, 0); } } }
#pragma unroll
            for (int ct = 0; ct < 8; ++ct) { const float nw = nwv[ct];
#pragma unroll
                for (int j = 0; j < 4; ++j) *(LAS float*)(L + SG_OB + ((16 * w + 4 * gq + j) * SG_OBS + 16 * ct + n) * 4) = acc[ct][j] * nw; }
            LDS_BARRIER();
            v4u ul[4]; float bl[4];
#pragma unroll
            for (int j = 0; j < 4; ++j) { ul[j] = *(const v4u*)(P1 + (row0 + sr + 32 * j) * N_BCA + 3584 + g * 128 + c8); bl[j] = sgu_b[g * 128 + sr + 32 * j]; }
            asm volatile("" ::: "memory");
#pragma unroll
            for (int j = 0; j < 4; ++j) { const int tt = sr + 32 * j; const float bias = bl[j];
                const f32x4 o0 = *(const LAS f32x4*)(L + SG_OB + (tt * SG_OBS + c8) * 4), o1 = *(const LAS f32x4*)(L + SG_OB + (tt * SG_OBS + c8 + 4) * 4);
                float uu[8], y[8]; unpack8(ul[j], uu);
                y[0] = (o0.x + bias) * uu[0]; y[1] = (o0.y + bias) * uu[1]; y[2] = (o0.z + bias) * uu[2]; y[3] = (o0.w + bias) * uu[3];
                y[4] = (o1.x + bias) * uu[4]; y[5] = (o1.y + bias) * uu[5]; y[6] = (o1.z + bias) * uu[6]; y[7] = (o1.w + bias) * uu[7];
                *(v4u*)(yc + (row0 + tt) * 512 + g * 128 + c8) = pack8(y); }
        }
        __syncthreads();
    }
}

__device__ __forceinline__ void p_norm_router(Frame& F, KArgs ka, const void* x, const float* w, const float* mod_l, bf16* h2) {
    const float* rw = ka->in[20]; const float* rb = ka->in[21]; unsigned* ctl = (unsigned*)(ka->ws + WS_CTL);
    float* topp = (float*)(ka->ws + WS_TOPP); int* list = (int*)(ka->ws + WS_LIST);
    LAS float* RWt = (LAS float*)F.lds;
    LAS int* lcnt = (LAS int*)(RWt + 8192);
    LAS int* lbase = lcnt + 16;
    LAS int* sel = lbase + 16;
    LAS int* rnk = sel + 128;
    for (int i = F.tid; i < D * NE; i += NT) { const int k = i >> 3, e = i & 7; RWt[e * D + k] = rw[i]; }
    __syncthreads();
    float rbv[8];
#pragma unroll
    for (int e = 0; e < 8; ++e) rbv[e] = rb[e];
    f32x4 wv[4];
#pragma unroll
    for (int j = 0; j < 4; ++j) wv[j] = ((const f32x4*)w)[F.lane + 64 * j];
    for (int batch = F.bid; batch < M / 128; batch += F.G) {
        const int row0 = batch * 128;
        if (F.tid < 16) lcnt[F.tid] = 0;
        const float* mb = mod_l + (size_t)(row0 >> 12) * MOD_LD;
        f32x4 scv[4], shv[4], xn[4];
#pragma unroll
        for (int j = 0; j < 4; ++j) { scv[j] = ((const f32x4*)(mb + 4 * D))[F.lane + 64 * j]; shv[j] = ((const f32x4*)(mb + 3 * D))[F.lane + 64 * j]; xn[j] = load_x4<true>(x, (size_t)(row0 + F.wave * 16), F.lane, j); }
        asm volatile("" ::: "memory");
#pragma unroll
        for (int j = 0; j < 4; ++j) scv[j] = wv[j] * (scv[j] + 1.0f);
        __syncthreads();
        for (int rr = 0; rr < 16; ++rr) {
            const int r = F.wave * 16 + rr, row = row0 + r;
            f32x4 v[4];
#pragma unroll
            for (int j = 0; j < 4; ++j) v[j] = xn[j];
            if (rr + 1 < 16) {
#pragma unroll
                for (int j = 0; j < 4; ++j) xn[j] = load_x4<true>(x, (size_t)(row + 1), F.lane, j); }
            float ssq = 0.f;
#pragma unroll
            for (int j = 0; j < 4; ++j) ssq += (v[j].x * v[j].x + v[j].y * v[j].y) + (v[j].z * v[j].z + v[j].w * v[j].w);
            const float rstd = 1.0f / sqrtf(wave_sum(ssq, F.lane) * (1.0f / D) + EPS);
            f32x4 o[4];
#pragma unroll
            for (int j = 0; j < 4; ++j) o[j] = v[j] * rstd * scv[j] + shv[j];
            { unsigned* o4 = (unsigned*)((unsigned char*)h2 + (size_t)row * D) + F.lane;
#pragma unroll
                for (int j = 0; j < 4; ++j) { const f32x4 q = (Q_MUP == 2) ? rot64(o[j], F.lane) : o[j]; o4[64 * j] = pk4_q<Q_MUP>(q.x * sa_of(Q_MUP, CLIP_MOE), q.y * sa_of(Q_MUP, CLIP_MOE), q.z * sa_of(Q_MUP, CLIP_MOE), q.w * sa_of(Q_MUP, CLIP_MOE)); } }
            float lg[8];
#pragma unroll
            for (int e = 0; e < 8; ++e) { float s = 0.f;
#pragma unroll
                for (int j = 0; j < 4; ++j) { const f32x4 r4 = *(const LAS f32x4*)(RWt + e * D + 4 * F.lane + 256 * j); s += (o[j].x * r4.x + o[j].y * r4.y) + (o[j].z * r4.z + o[j].w * r4.w); }
                lg[e] = wave_sum(s, F.lane) + rbv[e]; }
            int i0 = 0; float v0 = lg[0];
#pragma unroll
            for (int e = 1; e < 8; ++e) if (lg[e] > v0) { v0 = lg[e]; i0 = e; }
            int i1 = -1; float v1 = -3.0e38f;
#pragma unroll
            for (int e = 0; e < 8; ++e) if (e != i0 && lg[e] > v1) { v1 = lg[e]; i1 = e; }
            if (F.lane == 0) {
                const float p0 = 1.0f / (1.0f + expf(v1 - v0));
                topp[(size_t)row * 2] = p0; topp[(size_t)row * 2 + 1] = 1.0f - p0;
                const int rk0 = __hip_atomic_fetch_add(lcnt + i0, 1, __ATOMIC_RELAXED, __HIP_MEMORY_SCOPE_WORKGROUP), rk1 = __hip_atomic_fetch_add(lcnt + 8 + i1, 1, __ATOMIC_RELAXED, __HIP_MEMORY_SCOPE_WORKGROUP);
                sel[r] = i0 | (i1 << 8); rnk[r] = rk0 | (rk1 << 16);
            }
        }
        __syncthreads();
        if (F.tid < 16) lbase[F.tid] = (int)__hip_atomic_fetch_add(ctl + CW_CNT + 64 * F.tid, (unsigned)lcnt[F.tid], __ATOMIC_RELAXED, __HIP_MEMORY_SCOPE_AGENT);
        __syncthreads();
        if (F.tid < 128) { const int sv = sel[F.tid], rv = rnk[F.tid]; const int e0 = sv & 255, e1 = sv >> 8;
            list[(size_t)e0 * LIST_CAP + lbase[e0] + (rv & 0xffff)] = row0 + F.tid;
            list[(size_t)(8 + e1) * LIST_CAP + lbase[8 + e1] + (rv >> 16)] = row0 + F.tid; }
        __syncthreads();
    }
}
__device__ __forceinline__ void moe_tables(Frame& F, unsigned* ctl, int pass) {
    LAS int* tab = (LAS int*)(F.lds + TAB_OFF) + pass * 256;
    __syncthreads();
    if (F.tid == 0) { int pb = 0;
        for (int e = 0; e < 8; ++e) { int c = (int)__hip_atomic_load(ctl + CW_CNT + 64 * (pass * 8 + e), __ATOMIC_RELAXED, __HIP_MEMORY_SCOPE_AGENT); if (c > LIST_CAP) c = LIST_CAP; if (c < 0) c = 0;
            const int np = (c + 255) >> 8; tab[e] = c; tab[8 + e] = pb; for (int p = 0; p < np; ++p) tab[32 + pb + p] = e; pb += np; }
        tab[16] = pb; }
    __syncthreads();
}
template <bool GATHER_>
struct MoeOrder {
    static constexpr bool GATHER = GATHER_;
    pg8::StaticOrder so; const LAS int* tab; const int* list; int npn; unsigned rowbytes;
    int T = 0, HC = 0;
    __device__ __forceinline__ bool next(int i, pg8::Unit& u) const {
        const int G = so.G, c = so.c; long L;
        if (T == 0) L = (long)i * G + c;
        else if (c >= T) L = (i < HC) ? (long)i * (G - T) + (c - T) : (long)HC * (G - T) + (long)(i - HC) * G + c;
        else L = (long)HC * (G - T) + (long)i * G + c;
        if (!so.unit_of(L, u)) return false; u.pb = tab[32 + u.pm] * npn + u.pn; return true; }
    __device__ __forceinline__ int tok_of(int pm, int r) const { const int e = tab[32 + pm]; const int idx = (pm - tab[8 + e]) * 256 + r; return idx < tab[e] ? list[(size_t)e * LIST_CAP + idx] : -1; }
    __device__ __forceinline__ unsigned a_row_off(const pg8::Unit& u, int r) const { const int t = tok_of(u.pm, r); return (unsigned)(t < 0 ? 0 : t) * rowbytes; }
};

template <bool GU8>
struct EpiBranch {
    static constexpr bool PERM = true;
    const bf16* gate; bf16* mrg;
    __device__ __forceinline__ void operator()(const pg8::f32x4 (&acc)[2][2][4][2], const pg8::Unit& u, int wr, int wc, int fr, int fq) const {
        typedef unsigned v2u_ __attribute__((ext_vector_type(2)));
        const int row0 = u.pm * 256 + wr * 64 + fr, col0 = u.pn * 256 + wc * 32 + 8 * fq + u.aux * D;
        const int first = (u.aux == 0), mshift = u.aux * D;
        v4u gl[2][2][2], ml[2][2][2];
#define EB_LOAD(q) do { _Pragma("unroll") for (int mm_ = 0; mm_ < 2; ++mm_) _Pragma("unroll") for (int bj = 0; bj < 2; ++bj) { \
            const size_t row = (size_t)(row0 + ((q) >> 1) * 128 + (((q) & 1) * 2 + mm_) * 16); const int col = col0 + bj * 128; \
            if constexpr (GU8) { const v2u_ g2 = *(const v2u_*)((const unsigned char*)gate + row * N_G + col); gl[(q) & 1][mm_][bj].x = g2.x; gl[(q) & 1][mm_][bj].y = g2.y; } else gl[(q) & 1][mm_][bj] = *(const v4u*)(gate + row * N_G + col); \
            ml[(q) & 1][mm_][bj] = first ? (v4u){0u, 0u, 0u, 0u} : *(const v4u*)(mrg + row * D + col - mshift); } asm volatile("" ::: "memory"); } while (0)
        EB_LOAD(0);
#pragma unroll
        for (int q = 0; q < 4; ++q) {
            if (q < 3) EB_LOAD(q + 1);
            const int ai = q >> 1;
#pragma unroll
            for (int mm_ = 0; mm_ < 2; ++mm_)
#pragma unroll
                for (int bj = 0; bj < 2; ++bj) { const int m = (q & 1) * 2 + mm_; const size_t row = (size_t)(row0 + ai * 128 + m * 16); const int col = col0 + bj * 128;
                    float gg[8], mm[8], o[8]; unpack8(ml[q & 1][mm_][bj], mm);
                    if constexpr (GU8) {
#pragma unroll
                        for (int i = 0; i < 4; ++i) { gg[i] = (float)((gl[q & 1][mm_][bj].x >> (8 * i)) & 0xffu) * (1.0f / 255.0f); gg[4 + i] = (float)((gl[q & 1][mm_][bj].y >> (8 * i)) & 0xffu) * (1.0f / 255.0f); } }
                    else { unpack8(gl[q & 1][mm_][bj], gg);
#pragma unroll
                        for (int i = 0; i < 8; ++i) gg[i] = sigmoidf_(gg[i]); }
                    const pg8::f32x4 v0 = acc[ai][bj][m][0], v1 = acc[ai][bj][m][1];
                    o[0] = mm[0] + gg[0] * v0[0]; o[1] = mm[1] + gg[1] * v0[1]; o[2] = mm[2] + gg[2] * v0[2]; o[3] = mm[3] + gg[3] * v0[3];
                    o[4] = mm[4] + gg[4] * v1[0]; o[5] = mm[5] + gg[5] * v1[1]; o[6] = mm[6] + gg[6] * v1[2]; o[7] = mm[7] + gg[7] * v1[3];
                    *(v4u*)(mrg + row * D + col - mshift) = pack8(o); }
            asm volatile("" ::: "memory");
        }
#undef EB_LOAD
    }
};
template <int Q>
struct EpiGateU8 {
    static constexpr bool PERM = true;
    unsigned char* O; float scale;
    __device__ __forceinline__ void operator()(const pg8::f32x4 (&acc)[2][2][4][2], const pg8::Unit& u, int wr, int wc, int fr, int fq) const {
        typedef unsigned v2u_ __attribute__((ext_vector_type(2)));
        const int row0 = u.pm * 256 + wr * 64 + fr, col0 = u.pn * 256 + wc * 32 + 8 * fq;
#pragma unroll
        for (int ai = 0; ai < 2; ++ai)
#pragma unroll
            for (int m = 0; m < 4; ++m) { unsigned char* rowp = O + (size_t)(row0 + ai * 128 + m * 16) * N_G + col0;
#pragma unroll
                for (int bj = 0; bj < 2; ++bj) { v2u_ w;
#pragma unroll
                    for (int n = 0; n < 2; ++n) { const pg8::f32x4 v = acc[ai][bj][m][n]; unsigned p = 0u;
#pragma unroll
                        for (int i = 0; i < 4; ++i) p |= (unsigned)(sigmoidf_(accf<Q>(v[i]) * scale) * 255.0f + 0.5f) << (8 * i);
                        if (n == 0) w.x = p; else w.y = p; }
                    *(v2u_*)(rowp + bj * 128) = w; } }
    }
};
template <bool IN_F32, int QI = 0>
struct EpiResid {
    static constexpr bool PERM = true;
    const void* xin; bf16* xout; const float* gmod; float oscale;
    __device__ __forceinline__ void operator()(const pg8::f32x4 (&acc)[2][2][4][2], const pg8::Unit& u, int wr, int wc, int fr, int fq) const {
        const int row0 = u.pm * 256 + wr * 64 + fr, col0 = u.pn * 256 + wc * 32 + 8 * fq;
        const float* gb = gmod + (size_t)((u.pm * 256) >> 12) * MOD_LD + col0;
        pg8::f32x4 gv[2][2];
#pragma unroll
        for (int bj = 0; bj < 2; ++bj)
#pragma unroll
            for (int n = 0; n < 2; ++n) gv[bj][n] = *(const pg8::f32x4*)(gb + bj * 128 + n * 4) * oscale;
        constexpr int NB = 2;
#pragma unroll
        for (int b = 0; b < NB; ++b) {
            pg8::f32x4 xl[2 / NB][4][2][2];
#pragma unroll
            for (int a = 0; a < 2 / NB; ++a)
#pragma unroll
            for (int m = 0; m < 4; ++m)
#pragma unroll
                for (int bj = 0; bj < 2; ++bj) { const int ai = b * (2 / NB) + a; const size_t row = (size_t)(row0 + ai * 128 + m * 16); const int col = col0 + bj * 128;
                    if constexpr (IN_F32) { xl[a][m][bj][0] = *(const pg8::f32x4*)((const float*)xin + row * D + col); xl[a][m][bj][1] = *(const pg8::f32x4*)((const float*)xin + row * D + col + 4); }
                    else { const v4u w = *(const v4u*)((const bf16*)xin + row * XLD + col); xl[a][m][bj][0] = __builtin_bit_cast(pg8::f32x4, w); } }
            asm volatile("" ::: "memory");
#pragma unroll
            for (int a = 0; a < 2 / NB; ++a)
#pragma unroll
            for (int m = 0; m < 4; ++m)
#pragma unroll
                for (int bj = 0; bj < 2; ++bj) { const int ai = b * (2 / NB) + a; const size_t row = (size_t)(row0 + ai * 128 + m * 16); const int col = col0 + bj * 128;
                    pg8::f32x4 x0, x1;
                    if constexpr (IN_F32) { x0 = xl[a][m][bj][0]; x1 = xl[a][m][bj][1]; }
                    else { const v4u w = __builtin_bit_cast(v4u, xl[a][m][bj][0]); x0 = (pg8::f32x4){bf_lo(w.x), bf_hi(w.x), bf_lo(w.y), bf_hi(w.y)}; x1 = (pg8::f32x4){bf_lo(w.z), bf_hi(w.z), bf_lo(w.w), bf_hi(w.w)}; }
                    pg8::f32x4 c0 = acc[ai][bj][m][0], c1 = acc[ai][bj][m][1];
                    if constexpr (QI == 2) {
#pragma unroll
                        for (int i = 0; i < 4; ++i) { c0[i] = (float)__float_as_int(c0[i]); c1[i] = (float)__float_as_int(c1[i]); } }
                    const pg8::f32x4 o0 = x0 + gv[bj][0] * c0, o1 = x1 + gv[bj][1] * c1;
                    v4u w; w.x = pk2(o0[0], o0[1]); w.y = pk2(o0[2], o0[3]); w.z = pk2(o1[0], o1[1]); w.w = pk2(o1[2], o1[3]);
                    *(v4u*)(xout + row * XLD + col) = w; }
            asm volatile("" ::: "memory");
        }
    }
};
template <int QIN = 0, int QOUT = 0>
struct EpiSwiglu {
    static constexpr bool PERM = true;
    bf16* act; float inv;
    __device__ __forceinline__ void operator()(const pg8::f32x4 (&acc)[2][2][4][2], const pg8::Unit& u, int wr, int wc, int fr, int fq) const {
        const int row0 = u.pm * 256 + wr * 64 + fr, col0 = u.pn * 128 + wc * 32 + 8 * fq;
#pragma unroll
        for (int ai = 0; ai < 2; ++ai)
#pragma unroll
            for (int m = 0; m < 4; ++m) { float o[8];
#pragma unroll
                for (int n = 0; n < 2; ++n)
#pragma unroll
                    for (int i = 0; i < 4; ++i) { const float a1 = QIN ? accf<QIN>(acc[ai][0][m][n][i]) * inv : acc[ai][0][m][n][i], a3 = QIN ? accf<QIN>(acc[ai][1][m][n][i]) * inv : acc[ai][1][m][n][i];
                        o[n * 4 + i] = siluf_(a1) * a3 * (QOUT ? F8_SACT : 1.0f); }
                if constexpr (QOUT != 0) { typedef unsigned v2u_ __attribute__((ext_vector_type(2))); v2u_ w8; w8.x = pk4_q<1>(o[0], o[1], o[2], o[3]); w8.y = pk4_q<1>(o[4], o[5], o[6], o[7]);
                    *(v2u_*)((unsigned char*)act + (size_t)(row0 + ai * 128 + m * 16) * D_FF + col0) = w8; }
                else *(v4u*)(act + (size_t)(row0 + ai * 128 + m * 16) * D_FF + col0) = pack8(o); }
    }
};
struct EpiMoeDown {
    static constexpr bool PERM = true;
    bf16* x; const float* gmod; const float* topp; int pass; const LAS int* tab; const int* list; float oscale;
    __device__ __forceinline__ int tok_of(int pm, int r) const { const int e = tab[32 + pm]; const int idx = (pm - tab[8 + e]) * 256 + r; return idx < tab[e] ? list[(size_t)e * LIST_CAP + idx] : -1; }
    __device__ __forceinline__ void operator()(const pg8::f32x4 (&acc)[2][2][4][2], const pg8::Unit& u, int wr, int wc, int fr, int fq) const {
        const int col0 = u.pn * 256 + wc * 32 + 8 * fq;
        int tok[2][4];
#pragma unroll
        for (int ai = 0; ai < 2; ++ai)
#pragma unroll
            for (int m = 0; m < 4; ++m) tok[ai][m] = tok_of(u.pm, ai * 128 + wr * 64 + m * 16 + fr);
        asm volatile("" ::: "memory");
#pragma unroll
        for (int am = 0; am < 4; ++am) {
            const int ai = am >> 1, mb = (am & 1) * 2;
            v4u xl[2][2]; pg8::f32x4 gl[2][2][2]; float pv[2];
#pragma unroll
            for (int m = 0; m < 2; ++m) { const int t = tok[ai][mb + m] < 0 ? 0 : tok[ai][mb + m]; pv[m] = topp[(size_t)t * 2 + pass] * oscale; const float* gb = gmod + (size_t)(t >> 12) * MOD_LD + col0;
#pragma unroll
                for (int bj = 0; bj < 2; ++bj) { xl[m][bj] = *(const v4u*)(x + (size_t)t * XLD + col0 + bj * 128);
#pragma unroll
                    for (int n = 0; n < 2; ++n) gl[m][bj][n] = *(const pg8::f32x4*)(gb + bj * 128 + n * 4); } }
            asm volatile("" ::: "memory");
#pragma unroll
            for (int m = 0; m < 2; ++m) { if (tok[ai][mb + m] >= 0) { const int t = tok[ai][mb + m];
#pragma unroll
                for (int bj = 0; bj < 2; ++bj) { const v4u w = xl[m][bj];
                    const pg8::f32x4 x0 = {bf_lo(w.x), bf_hi(w.x), bf_lo(w.y), bf_hi(w.y)}, x1 = {bf_lo(w.z), bf_hi(w.z), bf_lo(w.w), bf_hi(w.w)};
                    pg8::f32x4 c0 = acc[ai][bj][mb + m][0], c1 = acc[ai][bj][mb + m][1];
                    const pg8::f32x4 o0 = x0 + gl[m][bj][0] * pv[m] * c0, o1 = x1 + gl[m][bj][1] * pv[m] * c1;
                    v4u r; r.x = pk2(o0[0], o0[1]); r.y = pk2(o0[2], o0[3]); r.z = pk2(o1[0], o1[1]); r.w = pk2(o1[2], o1[3]);
                    *(v4u*)(x + (size_t)t * XLD + col0 + bj * 128) = r; } } }
            asm volatile("" ::: "memory");
        }
    }
};

__device__ __forceinline__ void p_final_norm(Frame& F, float* x, const float* w) {
    const int gw = F.bid * NWAVES + F.wave, NGW = F.G * NWAVES, lane = F.lane;
    f32x4 wv[4];
#pragma unroll
    for (int j = 0; j < 4; ++j) wv[j] = ((const f32x4*)w)[lane + 64 * j];
    for (int r0 = gw * 4; r0 < M; r0 += NGW * 4) {
        f32x4 v[4][4];
#pragma unroll
        for (int r = 0; r < 4; ++r)
#pragma unroll
            for (int j = 0; j < 4; ++j) v[r][j] = load_x4<true>(x, (size_t)(r0 + r), lane, j);
        asm volatile("s_waitcnt vmcnt(0)" ::: "memory");
#pragma unroll
        for (int r = 0; r < 4; ++r) { float s = 0.f;
#pragma unroll
            for (int j = 0; j < 4; ++j) s += (v[r][j].x * v[r][j].x + v[r][j].y * v[r][j].y) + (v[r][j].z * v[r][j].z + v[r][j].w * v[r][j].w);
            const float rstd = 1.0f / sqrtf(wave_sum(s, lane) * (1.0f / D) + EPS);
#pragma unroll
            for (int j = 0; j < 4; ++j) ((f32x4*)(x + (size_t)(r0 + r) * D))[lane + 64 * j] = v[r][j] * rstd * wv[j]; }
    }
}
__device__ __forceinline__ bool fresh(Frame& F) {
    int w_ = F.w0, b_ = blockIdx.x, g_ = gridDim.x; asm volatile("" : "+s"(w_), "+s"(b_), "+s"(g_));
    int l_; asm volatile("v_mbcnt_lo_u32_b32 %0, -1, 0\n\tv_mbcnt_hi_u32_b32 %0, -1, %0" : "=v"(l_));
    int t_ = w_ * 64 + l_;
    F.tid = t_; F.lane = t_ & 63; F.wave = __builtin_amdgcn_readfirstlane(t_ >> 6); F.bid = b_; F.G = g_; return true;
}
constexpr int NPL = 13, NPHASE = 1 + DEPTH * NPL;
#if MK_PER_PHASE
#define GRID_BAR() do { } while (0)
#else
#define GRID_BAR() do { XcdBarrier b2_ = bar; asm volatile("" : "+s"(b2_.bar)); xcd_barrier(b2_); } while (0)
#endif
#ifdef ONLY_REL
#define IN(k) (KA()->ph_lo <= (k) && (k) < KA()->ph_hi && fresh(F) && ((k) == 0 ? 100 : ((k) - 1) % NPL) == ONLY_REL && (ONLY_L < 0 || ((k) - 1) / NPL == ONLY_L))
#else
#define IN(k) (KA()->ph_lo <= (k) && (k) < KA()->ph_hi && fresh(F))
#endif
#define SEAM(k) do { if ((k) + 1 < KA()->ph_hi) GRID_BAR(); } while (0)
template <int l>
__device__ __forceinline__ void layer_program(Frame& F, const XcdBarrier& bar, PG8_LAS unsigned char* ring) {
        const int pb = 1 + l * NPL;
#define WSP(off) (ka->ws + (off))
#define MODL ((const float*)WSP(WS_MOD) + (size_t)l * BATCH * MOD_LD)
#define WMIXL ((bf16*)WSP(WS_WMIX))
        if (IN(pb + 0)) {
#pragma unroll 1
          for (int rep = 0; rep < REPS(7); ++rep) { KArgs ka = KA(); p_norm<HQ_MIX == 0 ? 0 : (H_BF ? 2 : 1), l != 0, HQ_MIX ? HQ_MIX : 2>(F, l == 0 ? (const void*)ka->in[0] : (const void*)ka->out, ka->in[4] + l * D, MODL, 1 * D, 0, (HQ_MIX && !H_BF) ? (bf16*)WSP(WS_H8) : (bf16*)WSP(WS_H), WSP(WS_H8), sa_of(HQ_MIX, l == 0 ? CLIP_MIX0 : CLIP_MIX1)); }
          SEAM(pb + 0); }
        if (IN(pb + 1)) {
            KArgs ka = KA();
            constexpr int KD = Q_PROJ ? D / 2 : D;
            pg8::Gemm g{Q_PROJ ? (bf16*)WSP(WS_H8) : (bf16*)WSP(WS_H), WMIXL, KD, KD, KD}; pg8::StaticOrder S; S.init(M / 256, N_BCA / 256, F.G, F.bid);
            pg8::EpiBf16<Q_PROJ> E{(bf16*)WSP(WS_P1), N_BCA, (Q_PROJ ? 1.0f / (sa_of(Q_PROJ, l == 0 ? CLIP_MIX0 : CLIP_MIX1) * (Q_PROJ == 2 ? ((const float*)WSP(WS_QS))[QS_IN] : F8_SW)) : 1.0f) / (float)REPS(8)};
#pragma unroll 1
            for (int rep = 0; rep < REPS(3); ++rep)
            pg8::gemm_phase<REPS(8), Q_PROJ>(ring, g, S, E, F.tid); SEAM(pb + 1);
        }
        if (IN(pb + 2)) {
#define THIN_H1() { KArgs ka = KA(); p_hgrn<1>(F, (const bf16*)WSP(WS_P1), ka->in[8], l, ka->in[9] + l * D_BV, (bf16*)WSP(WS_YB), (float*)WSP(WS_HU), (float*)WSP(WS_HD)); }
#define THIN_SC() { { KArgs ka = KA(); p_sgu(F, (const bf16*)WSP(WS_P1), ka->in[10] + l * D_C, ka->in[11] + (size_t)l * 4 * 128 * 128, ka->in[12] + l * 4 * 128, (bf16*)WSP(WS_YC)); } \
                    { KArgs ka = KA(); p_conv(F, (const bf16*)WSP(WS_P1), ka->in[7] + l * 3 * D_A, (bf16*)WSP(WS_YA)); } }
#pragma unroll 1
          for (int rep = 0; rep < REPS(1); ++rep) {
            __syncthreads();
            if ((F.bid >> 3) & 1) { THIN_H1(); __syncthreads(); fresh(F); THIN_SC(); }
            else { THIN_SC(); __syncthreads(); fresh(F); THIN_H1(); }
          }
#undef THIN_H1
#undef THIN_SC
            SEAM(pb + 2);
        }
        if (IN(pb + 3)) {
#pragma unroll 1
          for (int rep = 0; rep < REPS(2); ++rep)
            { KArgs ka = KA(); p_hgrn<2>(F, (const bf16*)WSP(WS_P1), ka->in[8], l, ka->in[9] + l * D_BV, (bf16*)WSP(WS_YB), (float*)WSP(WS_HU), (float*)WSP(WS_HD)); }
            SEAM(pb + 3);
        }
        if (IN(pb + 5)) {
            { KArgs ka = KA();
              pg8::GateOrder S; S.so.init(M / 256, D / 256, F.G, F.bid);
              if constexpr (Q_GATE != 0) { pg8::Gemm g{(bf16*)WSP(WS_H8), (bf16*)WSP(WS_WMIX + WMIX_G8), D / 2, D / 2, D / 2};
                  EpiGateU8<Q_GATE> E{(unsigned char*)WSP(WS_PG), 1.0f / (sa_of(Q_GATE, l == 0 ? CLIP_MIX0 : CLIP_MIX1) * (Q_GATE == 2 ? ((const float*)WSP(WS_QS))[QS_IN] : F8_SW))};
                  pg8::gemm_phase<1, Q_GATE>(ring, g, S, E, F.tid); }
              else { pg8::Gemm g{(bf16*)WSP(WS_H), WMIXL + (size_t)N_BCA * D, D, D, D};
                  pg8::EpiBf16<0> E{(bf16*)WSP(WS_PG), N_G, 1.0f};
                  pg8::gemm_phase(ring, g, S, E, F.tid); } }
            { KArgs ka = KA();
              pg8::Gemm g{(bf16*)WSP(WS_YA), WMIXL + (size_t)N_IN * D, 512, 512, 512, (size_t)32 * MiB, (size_t)512 * 1024 * 2}; pg8::BranchOrder S; S.so.init(M / 256, D / 256, F.G, F.bid);
              EpiBranch<Q_GATE != 0> E{(const bf16*)WSP(WS_PG), (bf16*)WSP(WS_MRG)};
              pg8::gemm_phase(ring, g, S, E, F.tid); }
            SEAM(pb + 5);
        }
        if (IN(pb + 6)) {
            KArgs ka = KA();
            pg8::Gemm g{(bf16*)WSP(WS_MRG), WMIXL + (size_t)N_IN * D + 3 * 512 * 1024, D, D, D}; pg8::StaticOrder S; S.init(M / 256, D / 256, F.G, F.bid);
            EpiResid<l == 0> E{l == 0 ? (const void*)ka->in[0] : (const void*)ka->out, (bf16*)ka->out, MODL + 2 * D, 1.0f};
            pg8::gemm_phase(ring, g, S, E, F.tid); SEAM(pb + 6);
        }
        if (l == 0) {
            constexpr int FES = Q_FUP ? 1 : 2, FDS = Q_FDN ? 1 : 2;
            if (IN(pb + 7)) { KArgs ka = KA(); p_norm<Q_FUP ? 1 : 0, true, Q_FUP ? Q_FUP : 2>(F, (const void*)ka->out, ka->in[5] + l * D, MODL, 4 * D, 3 * D, (bf16*)WSP(WS_H), nullptr, sa_of(Q_FUP, CLIP_FFN)); __syncthreads(); p_convert_mixer(F, KA(), 1, false);     SEAM(pb + 7); }
            if (IN(pb + 8)) {
                KArgs ka = KA();
                pg8::Gemm g{(bf16*)WSP(WS_H), (bf16*)WSP(WS_W13), D * FES / 2, D * FES / 2, D * FES / 2}; pg8::StaticOrder S; S.init(M / 256, N13 / 256, F.G, F.bid);
                EpiSwiglu<Q_FUP, Q_FDN> E{(bf16*)WSP(WS_ACT), 1.0f / (sa_of(Q_FUP, CLIP_FFN) * ((const float*)WSP(WS_QS))[QS_F13])};
                pg8::gemm_phase<1, Q_FUP>(ring, g, S, E, F.tid); SEAM(pb + 8);
            }
            if (IN(pb + 9)) {
                KArgs ka = KA();
                pg8::Gemm g{(bf16*)WSP(WS_ACT), (bf16*)WSP(WS_W2), D_FF * FDS / 2, D_FF * FDS / 2, D_FF * FDS / 2}; pg8::StaticOrder S; S.init(M / 256, D / 256, F.G, F.bid);
                EpiResid<false, Q_FDN> E{(const void*)ka->out, (bf16*)ka->out, MODL + 5 * D, Q_FDN ? 1.0f / (F8_SACT * F8_SW) : 1.0f};
                pg8::gemm_phase<1, Q_FDN>(ring, g, S, E, F.tid); SEAM(pb + 9);
            }
        } else {
            if (IN(pb + 7)) {
#pragma unroll 1
                for (int rep = 0; rep < REPS(6); ++rep) { __syncthreads(); p_moe_weights(F, KA()); }
                __syncthreads(); { KArgs ka = KA(); p_norm_router(F, ka, (const void*)ka->out, ka->in[5] + l * D, MODL, (bf16*)WSP(WS_H2M)); } SEAM(pb + 7); }
            constexpr size_t ACT_BYTES = (size_t)MOE_ROWS * D_FF * MOE_ES;
#define MOE_UP(pass_, T_, HC_) do { KArgs ka = KA(); \
                    const LAS int* tab = (const LAS int*)(F.lds + TAB_OFF) + (pass_) * 256; \
                    MoeOrder<true> S; S.so.init(tab[16], N13 / 256, F.G, F.bid); S.tab = tab; S.list = (const int*)WSP(WS_LIST) + (size_t)(pass_) * 8 * LIST_CAP; S.npn = N13 / 256; S.rowbytes = D * MOE_ES; S.T = (T_); S.HC = (HC_); \
                    pg8::Gemm g{(bf16*)WSP(WS_H2M), (bf16*)WSP(WS_WM13), D * MOE_ES / 2, D * MOE_ES / 2, D * MOE_ES / 2}; \
                    EpiSwiglu<Q_MUP, Q_MDN> E{(bf16*)WSP(WS_ACTM + (pass_) * ACT_BYTES), 1.0f / (sa_of(Q_MUP, CLIP_MOE) * ((const float*)WSP(WS_QS))[QS_M13])}; \
                    pg8::gemm_phase<1, Q_MUP>(ring, g, S, E, F.tid); } while (0)
#define MOE_DOWN(pass_) do { KArgs ka = KA(); \
                    const LAS int* tab = (const LAS int*)(F.lds + TAB_OFF) + (pass_) * 256; \
                    MoeOrder<false> S; S.so.init(tab[16], D / 256, F.G, F.bid); S.tab = tab; S.list = (const int*)WSP(WS_LIST) + (size_t)(pass_) * 8 * LIST_CAP; S.npn = D / 256; S.rowbytes = 0; \
                    pg8::Gemm g{(bf16*)WSP(WS_ACTM + (pass_) * ACT_BYTES), (bf16*)WSP(WS_WM2), D_FF * MOE_ES / 2, D_FF * MOE_ES / 2, D_FF * MOE_ES / 2}; \
                    EpiMoeDown E{(bf16*)ka->out, MODL + 5 * D, (const float*)WSP(WS_TOPP), (pass_), tab, S.list, 1.0f / (F8_SACT * F8_SW)}; \
                    pg8::gemm_phase<1, Q_MDN>(ring, g, S, E, F.tid); } while (0)
            if (IN(pb + 8)) { { KArgs ka = KA(); moe_tables(F, (unsigned*)WSP(WS_CTL), 0); } MOE_UP(0, 0, 0); SEAM(pb + 8); }
            if (IN(pb + 9)) {
                { KArgs ka = KA(); moe_tables(F, (unsigned*)WSP(WS_CTL), 0); moe_tables(F, (unsigned*)WSP(WS_CTL), 1); }
                MOE_DOWN(0);
                { const LAS int* tab0 = (const LAS int*)(F.lds + TAB_OFF); const int nd = tab0[16] * (D / 256);
                  MOE_UP(1, nd % F.G, 3); }
                SEAM(pb + 9);
            }
            if (IN(pb + 11)) { { KArgs ka = KA(); moe_tables(F, (unsigned*)WSP(WS_CTL), 1); } MOE_DOWN(1); SEAM(pb + 11); }
#undef MOE_UP
#undef MOE_DOWN
            if (IN(pb + 12)) { KArgs ka = KA(); p_final_norm(F, ka->out, ka->in[25]); }
        }
}
__global__ void __launch_bounds__(NT, 2) fwd(Args args) {
    extern __shared__ __attribute__((aligned(16))) unsigned char lds[];
    Frame F;
    F.lds = (LAS unsigned char*)lds;
    F.tid = threadIdx.x; F.lane = F.tid & 63; F.wave = __builtin_amdgcn_readfirstlane(F.tid >> 6); F.w0 = F.wave;
    F.G = gridDim.x; F.bid = blockIdx.x;
    volatile LAS unsigned* MISC = (volatile LAS unsigned*)(F.lds + MISC_OFF);
    if (F.tid < 32) MISC[F.tid] = 0u;
    __syncthreads();
#if !MK_PER_PHASE
    XcdBarrier bar = xcd_barrier_post((unsigned*)(KA()->ws + WS_CTL) + CW_BAR, MISC + 8);
#else
    XcdBarrier bar; bar.bar = nullptr; bar.x = 0; bar.st = nullptr;
#endif
    PG8_LAS unsigned char* ring = (PG8_LAS unsigned char*)lds;

    if (IN(0)) {
#pragma unroll 1
        for (int rep = 0; rep < REPS(5); ++rep) { __syncthreads(); p_prologue(F, KA()); __syncthreads(); p_convert_mixer(F, KA(), 0, true); }
        SEAM(0); }

    layer_program<0>(F, bar, ring);
    layer_program<1>(F, bar, ring);
#undef IN
#undef SEAM
}

extern "C" void kernel_launch(void* const* d_in, const int* in_sizes, int n_in, void* d_out, int out_size, void* d_ws, size_t ws_size, hipStream_t stream) {
    static int grid = 0;
    if (grid == 0) {
        if (n_in != 26 || in_sizes[0] != M * D || out_size != M * D || ws_size < WS_NEED) { fprintf(stderr, "kernel_launch: unexpected shapes / workspace (n_in %d, ws %zu, need %zu); nothing launched\n", n_in, ws_size, (size_t)WS_NEED); grid = -1; return; }
        int dev = 0, cus = 0, per_cu = 0;
        if (hipGetDevice(&dev) != hipSuccess || hipDeviceGetAttribute(&cus, hipDeviceAttributeMultiprocessorCount, dev) != hipSuccess) { grid = -1; return; }
        if (hipFuncSetAttribute((const void*)fwd, hipFuncAttributeMaxDynamicSharedMemorySize, LDS_BYTES) != hipSuccess) { fprintf(stderr, "kernel_launch: hipFuncSetAttribute failed\n"); grid = -1; return; }
        if (hipOccupancyMaxActiveBlocksPerMultiprocessor(&per_cu, (const void*)fwd, NT, LDS_BYTES) != hipSuccess || per_cu < 1) fprintf(stderr, "kernel_launch: occupancy query reports %d\n", per_cu);
        (void)hipGetLastError();
        grid = cus;
    }
    if (grid < 0) return;
    if (hipMemsetAsync((char*)d_ws + WS_CTL, 0, CTL_ZERO_BYTES, stream) != hipSuccess) return;
    Args a{};
    for (int i = 0; i < 26; ++i) a.in[i] = (const float*)d_in[i];
    a.out = (float*)d_out; a.ws = (unsigned char*)d_ws;
#if MK_PER_PHASE
    for (int p = 0; p < NPHASE; ++p) {
        if ((p >= 1 + 10 && p <= 1 + 12) || p == 1 + 4 || p == 1 + NPL + 4 || p == 1 + NPL + 10) continue;
        a.ph_lo = p; a.ph_hi = p + 1;
        hipLaunchKernelGGL(fwd, dim3(grid), dim3(NT), LDS_BYTES, stream, a);
    }
#else
    a.ph_lo = 0; a.ph_hi = NPHASE;
    hipLaunchKernelGGL(fwd, dim3(grid), dim3(NT), LDS_BYTES, stream, a);
#endif
}
```

```cpp
#include <hip/hip_runtime.h>
#include <cstdio>
#include <cstdint>

#ifndef PROBE_DUP
#define PROBE_DUP 0
#endif
#ifndef PROBE_REPS
#define PROBE_REPS 2
#endif
#define REPS(k) ((PROBE_DUP == (k)) ? PROBE_REPS : 1)
#ifndef Q_PROJ
#define Q_PROJ 2
#endif
#ifndef Q_GATE
#define Q_GATE 2
#endif
#ifndef Q_FUP
#define Q_FUP 2
#endif
#ifndef Q_FDN
#define Q_FDN 1
#endif
#ifndef Q_MUP
#define Q_MUP 2
#endif
#ifndef Q_MDN
#define Q_MDN 1
#endif
#ifndef MK_PER_PHASE
#define MK_PER_PHASE 0
#endif

namespace pg8 {
#define PG8_LAS __attribute__((address_space(3)))
typedef unsigned short bf16_t;
typedef short bf16x8 __attribute__((ext_vector_type(8)));
typedef float f32x4 __attribute__((ext_vector_type(4)));
typedef unsigned u32x4 __attribute__((ext_vector_type(4)));
typedef int v4i32_ __attribute__((ext_vector_type(4)));
constexpr int BM = 256, BK = 64, HALF = 128, HTB = HALF * BK * 2, STAGE_BYTES = 8 * HTB, NXCD = 8, WGM = 8;

__host__ __device__ __forceinline__ int lds_byte(int r, int c) { const int st = (r >> 4) * 2 + (c >> 5), rr = r & 15, cc = c & 31, ob = rr * 64 + cc * 2; return st * 1024 + (ob ^ (((ob >> 9) & 1) << 5)); }
__host__ __device__ __forceinline__ void stage_rc(int b, int& R, int& C) { const int st = b / 1024, sb = b % 1024, swz = sb ^ (((sb >> 9) & 1) << 5); R = (st >> 1) * 16 + swz / 64; C = (st & 1) * 32 + (swz % 64) / 2; }
__host__ __device__ __forceinline__ int perm32(int rho) { const int n = rho >> 4, i = rho & 15; return 8 * (i >> 2) + 4 * n + (i & 3); }

struct Unit { int pm, pn, pb, aux; };
struct Gemm { const bf16_t* A; const bf16_t* Bt; int lda, ldb, K; size_t astride = 0, bstride = 0; };

struct StaticOrder {
    static constexpr bool GATHER = false;
    int nM, nN, nwg, G, c;
    __device__ __forceinline__ void init(int nM_, int nN_, int G_, int c_) { nM = nM_; nN = nN_; nwg = nM * nN; G = G_; c = c_; }
    __device__ __forceinline__ bool next(int i, Unit& u) const { return unit_of((long)i * G + c, u); }
    __device__ __forceinline__ bool unit_of(long L, Unit& u) const {
        if (L >= nwg) return false;
        int wgid = (int)L; { const int q = nwg / NXCD, r = nwg % NXCD, xcd = wgid % NXCD, off = wgid / NXCD; wgid = (xcd < r ? xcd * (q + 1) : r * (q + 1) + (xcd - r) * q) + off; }
        const int nig = WGM * nN, gid = wgid / nig, fm = gid * WGM, gsz = (nM - fm) < WGM ? (nM - fm) : WGM;
        u.pm = fm + ((wgid % nig) % gsz); u.pn = (wgid % nig) / gsz; u.pb = u.pn; u.aux = 0; return true;
    }
    __device__ __forceinline__ unsigned a_row_off(const Unit&, int) const { return 0u; }
};

struct GateOrder {
    static constexpr bool GATHER = false;
    StaticOrder so;
    __device__ __forceinline__ bool next(int k, Unit& u) const { Unit b; if (!so.next(k / 3, b)) return false; u.pm = b.pm; u.pn = b.pn + 4 * (k % 3); u.pb = u.pn; u.aux = 0; return true; }
    __device__ __forceinline__ unsigned a_row_off(const Unit&, int) const { return 0u; }
};
struct BranchOrder {
    static constexpr bool GATHER = false;
    StaticOrder so;
    __device__ __forceinline__ bool next(int k, Unit& u) const { Unit b; if (!so.next(k / 3, b)) return false; u.pm = b.pm; u.pn = b.pn; u.pb = b.pn; u.aux = k % 3; return true; }
    __device__ __forceinline__ unsigned a_row_off(const Unit&, int) const { return 0u; }
};
__device__ __forceinline__ unsigned cvt_pk_bf16(float lo, float hi) { unsigned r; asm volatile("v_cvt_pk_bf16_f32 %0, %1, %2" : "=v"(r) : "v"(lo), "v"(hi)); return r; }

template <int Q = 0>
struct EpiBf16 {
    static constexpr bool PERM = true;
    bf16_t* O; int ldc; float scale;
    __device__ __forceinline__ void operator()(const f32x4 (&acc)[2][2][4][2], const Unit& u, int wr, int wc, int fr, int fq) const {
        const int row0 = u.pm * BM + wr * 64 + fr, col0 = u.pn * BM + wc * 32 + 8 * fq;
#pragma unroll 1
        for (int erep = 0; erep < REPS(9); ++erep)
#pragma unroll
        for (int ai = 0; ai < 2; ++ai)
#pragma unroll
            for (int m = 0; m < 4; ++m) { bf16_t* rowp = O + (size_t)(row0 + ai * HALF + m * 16) * ldc + col0;
#pragma unroll
                for (int bj = 0; bj < 2; ++bj) { f32x4 v0 = acc[ai][bj][m][0], v1 = acc[ai][bj][m][1];
                    if constexpr (Q == 2) { v0 = __builtin_convertvector(__builtin_bit_cast(v4i32_, v0), f32x4); v1 = __builtin_convertvector(__builtin_bit_cast(v4i32_, v1), f32x4); }
                    v0 *= scale; v1 *= scale;
                    u32x4 w; w.x = cvt_pk_bf16(v0[0], v0[1]); w.y = cvt_pk_bf16(v0[2], v0[3]); w.z = cvt_pk_bf16(v1[0], v1[1]); w.w = cvt_pk_bf16(v1[2], v1[3]);
                    *(u32x4*)(rowp + bj * HALF) = w; } }
    }
};

typedef int v8i32 __attribute__((ext_vector_type(8)));
typedef int v4i32 __attribute__((ext_vector_type(4)));
template <int KREP = 1, int Q = 0, class Epi, class Sched>
__device__ __forceinline__ void gemm_phase(PG8_LAS unsigned char* lds, const Gemm g, const Sched& S, const Epi& E, int tid_in) {
    constexpr bool GATHER = Sched::GATHER;
    int tid_ = tid_in; asm volatile("" : "+v"(tid_));
    const int tid = tid_, wid = __builtin_amdgcn_readfirstlane(tid >> 6), lane = tid & 63, wr = wid >> 2, wc = wid & 3, fr = lane & 15, fq = lane >> 4;
    const int K = g.K, nt = K / BK;
    unsigned voffB[2], vA0[2], vA1[2], nA0[2], nA1[2];
#pragma unroll
    for (int i = 0; i < 2; ++i) { int R, C; stage_rc(tid * 16 + i * 8192, R, C); const int Rb = Epi::PERM ? ((R & ~31) + perm32(R & 31)) : R;
        voffB[i] = (unsigned)(Rb * g.ldb + C) * 2u;
        vA0[i] = (unsigned)(R * g.lda + C) * 2u; vA1[i] = vA0[i]; nA0[i] = vA0[i]; nA1[i] = vA0[i]; }
    const size_t kstep = (size_t)(BK * 2);
    const size_t hstepB = (size_t)HALF * g.ldb * 2, tstepB = 2 * hstepB, tstepA = (size_t)BM * g.lda * 2;
    const size_t hstepA = GATHER ? (size_t)0 : (size_t)HALF * g.lda * 2;
    const unsigned ldsw = (unsigned)wid * 1024u;
    const int aoff = lds_byte(wr * 64 + fr, fq * 8), boff = lds_byte(wc * 32 + fr, fq * 8);
    PG8_LAS unsigned char* aptr = lds + aoff; PG8_LAS unsigned char* bptr = lds + 4 * HTB + boff; asm volatile("" : "+v"(aptr), "+v"(bptr));
#define PG8_SA(b, h) (((b) * 2 + (h)) * HTB)
#define PG8_SB(b, h) ((4 + (b) * 2 + (h)) * HTB)
#define PG8_STAGE(bufoff, gbase, voff) do { _Pragma("unroll") for (int _i = 0; _i < 2; ++_i) \
        __builtin_amdgcn_global_load_lds((const unsigned*)((const char*)(gbase) + (voff)[_i]), (PG8_LAS unsigned*)(lds + (bufoff) + ldsw + _i * 8192), 16, 0, 0); } while (0)
#define PG8_CAT8(x0, x1) __builtin_shufflevector(__builtin_bit_cast(v4i32, x0), __builtin_bit_cast(v4i32, x1), 0, 1, 2, 3, 4, 5, 6, 7)
#define PG8_RDA(off) (*(const PG8_LAS bf16x8*)(aptr + (off)))
#define PG8_RDB(off) (*(const PG8_LAS bf16x8*)(bptr + (off)))
#define PG8_LDA(dst, b, h) do { if constexpr (Q == 1) { _Pragma("unroll") for (int m = 0; m < 4; ++m) dst##8[m] = PG8_CAT8(PG8_RDA(PG8_SA(b, h) + m * 2048), PG8_RDA(PG8_SA(b, h) + m * 2048 + 1024)); } \
        else { _Pragma("unroll") for (int m = 0; m < 4; ++m) _Pragma("unroll") for (int k = 0; k < 2; ++k) dst[m][k] = PG8_RDA(PG8_SA(b, h) + m * 2048 + k * 1024); } } while (0)
#define PG8_LDB(dst, b, h) do { if constexpr (Q == 1) { _Pragma("unroll") for (int n = 0; n < 2; ++n) dst##8[n] = PG8_CAT8(PG8_RDB(PG8_SB(b, h) - 4 * HTB + n * 2048), PG8_RDB(PG8_SB(b, h) - 4 * HTB + n * 2048 + 1024)); } \
        else { _Pragma("unroll") for (int n = 0; n < 2; ++n) _Pragma("unroll") for (int k = 0; k < 2; ++k) dst[n][k] = PG8_RDB(PG8_SB(b, h) - 4 * HTB + n * 2048 + k * 1024); } } while (0)
#define PG8_MMA(ai, bj, At, Bt) do { __builtin_amdgcn_s_setprio(1); \
        if constexpr (Q == 2) { _Pragma("unroll") for (int m = 0; m < 4; ++m) _Pragma("unroll") for (int n = 0; n < 2; ++n) _Pragma("unroll") for (int k = 0; k < 2; ++k) \
            acc[ai][bj][m][n] = __builtin_bit_cast(f32x4, __builtin_amdgcn_mfma_i32_16x16x64_i8(__builtin_bit_cast(v4i32, Bt[n][k]), __builtin_bit_cast(v4i32, At[m][k]), __builtin_bit_cast(v4i32, acc[ai][bj][m][n]), 0, 0, 0)); } \
        else if constexpr (Q == 1) { _Pragma("unroll") for (int m = 0; m < 4; ++m) _Pragma("unroll") for (int n = 0; n < 2; ++n) \
            asm volatile("v_mfma_scale_f32_16x16x128_f8f6f4 %0, %1, %2, %0, %3, %3 op_sel_hi:[0,0,0]" : "+v"(acc[ai][bj][m][n]) : "v"(Bt##8[n]), "v"(At##8[m]), "v"(sc1)); } \
        else { _Pragma("unroll") for (int m = 0; m < 4; ++m) _Pragma("unroll") for (int n = 0; n < 2; ++n) _Pragma("unroll") for (int k = 0; k < 2; ++k) \
            acc[ai][bj][m][n] = __builtin_amdgcn_mfma_f32_16x16x32_bf16(Bt[n][k], At[m][k], acc[ai][bj][m][n], 0, 0, 0); } \
        __builtin_amdgcn_s_setprio(0); } while (0)
#define PG8_WAIT_V(n) asm volatile("s_waitcnt vmcnt(" #n ")" ::: "memory")
#define PG8_WAIT_L(n) asm volatile("s_waitcnt lgkmcnt(" #n ")" ::: "memory")
#define PG8_BAR __builtin_amdgcn_s_barrier()
#define PG8_SCHED __builtin_amdgcn_sched_barrier(0)
#define PG8_GOFF(unit, d0, d1) do { _Pragma("unroll") for (int _i = 0; _i < 2; ++_i) { int R_, C_; stage_rc(tid * 16 + _i * 8192, R_, C_); \
        d0[_i] = S.a_row_off(unit, R_) + (unsigned)C_ * 2u; d1[_i] = S.a_row_off(unit, R_ + HALF) + (unsigned)C_ * 2u; } } while (0)
    Unit cur, nxt; int ui = 0;
    if (!S.next(0, cur)) return;
    f32x4 acc[2][2][4][2];
#pragma unroll
    for (int a = 0; a < 2; ++a)
#pragma unroll
        for (int b = 0; b < 2; ++b)
#pragma unroll
            for (int m = 0; m < 4; ++m)
#pragma unroll
                for (int n = 0; n < 2; ++n) acc[a][b][m][n] = (f32x4){0.f, 0.f, 0.f, 0.f};
    bf16x8 At[4][2], B0[2][2], B1[2][2];
    v8i32 At8[4], B08[2], B18[2];
    const int sc1 = 0x7f7f7f7f;
    if constexpr (GATHER) { PG8_GOFF(cur, vA0, vA1); }
    const char* cA = GATHER ? (const char*)g.A : (const char*)g.A + (size_t)cur.aux * g.astride + (size_t)cur.pm * tstepA; const char* cB = (const char*)g.Bt + (size_t)cur.aux * g.bstride + (size_t)cur.pb * tstepB;
    PG8_STAGE(PG8_SB(0, 0), cB, voffB); PG8_STAGE(PG8_SB(0, 1), cB + hstepB, voffB); PG8_STAGE(PG8_SA(0, 0), cA, vA0); PG8_STAGE(PG8_SA(0, 1), cA + hstepA, vA1);
    if (wr == 1) PG8_BAR;
    PG8_WAIT_V(2); PG8_BAR;
    PG8_STAGE(PG8_SB(1, 0), cB + kstep, voffB); PG8_STAGE(PG8_SA(1, 0), cA + kstep, vA0); PG8_STAGE(PG8_SB(1, 1), cB + hstepB + kstep, voffB);
    PG8_WAIT_V(6); PG8_BAR;
    for (;;) {
        const bool has_next = S.next(ui + 1, nxt);
        const char* nA = GATHER ? (const char*)g.A : (has_next ? (const char*)g.A + (size_t)nxt.aux * g.astride + (size_t)nxt.pm * tstepA : cA); const char* nB = has_next ? (const char*)g.Bt + (size_t)nxt.aux * g.bstride + (size_t)nxt.pb * tstepB : cB;
        if constexpr (GATHER) { if (has_next) { PG8_GOFF(nxt, nA0, nA1); } else {
#pragma unroll
            for (int i = 0; i < 2; ++i) { nA0[i] = vA0[i]; nA1[i] = vA1[i]; } } }
#pragma unroll 1
        for (int t = 0; t < nt * KREP; t += 2) {
            const bool last = (t == nt * KREP - 2);
            const int t1 = (KREP == 1) ? t + 1 : ((t + 1) & (nt - 1)), t2 = (KREP == 1) ? t + 2 : ((t + 2) & (nt - 1));
            const char* a1 = cA + (size_t)t1 * kstep;
            const char* a2 = last ? nA : cA + (size_t)t2 * kstep; const char* b2 = last ? nB : cB + (size_t)t2 * kstep;
            const char* a3 = a2 + kstep; const char* b3 = b2 + kstep;
            unsigned s0[2], s1[2];
#pragma unroll
            for (int i = 0; i < 2; ++i) { s0[i] = (GATHER && last) ? nA0[i] : vA0[i]; s1[i] = GATHER ? (last ? nA1[i] : vA1[i]) : vA0[i]; }
            PG8_LDB(B0, 0, 0); PG8_LDB(B1, 0, 1); PG8_SCHED; PG8_LDA(At, 0, 0); PG8_STAGE(PG8_SA(1, 1), a1 + hstepA, vA1);
            PG8_WAIT_V(8); PG8_WAIT_L(0); PG8_BAR; PG8_MMA(0, 0, At, B0); PG8_MMA(0, 1, At, B1); PG8_BAR; PG8_SCHED;
            PG8_LDA(At, 0, 1); PG8_STAGE(PG8_SB(0, 0), b2, voffB); PG8_STAGE(PG8_SB(0, 1), b2 + hstepB, voffB); PG8_STAGE(PG8_SA(0, 0), a2, s0);
            PG8_WAIT_V(8); PG8_WAIT_L(0); PG8_BAR; PG8_MMA(1, 0, At, B0); PG8_MMA(1, 1, At, B1); PG8_BAR; PG8_SCHED;
            PG8_LDB(B0, 1, 0); PG8_LDB(B1, 1, 1); PG8_SCHED; PG8_LDA(At, 1, 0); PG8_STAGE(PG8_SA(0, 1), a2 + hstepA, s1);
            PG8_WAIT_V(8); PG8_WAIT_L(0); PG8_BAR; PG8_MMA(0, 0, At, B0); PG8_MMA(0, 1, At, B1); PG8_BAR; PG8_SCHED;
            PG8_LDA(At, 1, 1); PG8_STAGE(PG8_SB(1, 0), b3, voffB); PG8_STAGE(PG8_SB(1, 1), b3 + hstepB, voffB); PG8_STAGE(PG8_SA(1, 0), a3, s0);
            PG8_WAIT_V(8); PG8_WAIT_L(0); PG8_BAR; PG8_MMA(1, 0, At, B0); PG8_MMA(1, 1, At, B1); PG8_BAR; PG8_SCHED;
        }
        if (wr == 0) PG8_BAR;
        E(acc, cur, wr, wc, fr, fq);
        if (!has_next) break;
#pragma unroll
        for (int a = 0; a < 2; ++a)
#pragma unroll
            for (int b = 0; b < 2; ++b)
#pragma unroll
                for (int m = 0; m < 4; ++m)
#pragma unroll
                    for (int n = 0; n < 2; ++n) acc[a][b][m][n] = (f32x4){0.f, 0.f, 0.f, 0.f};
        cur = nxt; cA = nA; cB = nB; ++ui;
        if constexpr (GATHER) {
#pragma unroll
            for (int i = 0; i < 2; ++i) { vA0[i] = nA0[i]; vA1[i] = nA1[i]; } }
        if (wr == 1) PG8_BAR;
    }
    PG8_WAIT_V(0);
    PG8_BAR;
#undef PG8_SA
#undef PG8_SB
#undef PG8_STAGE
#undef PG8_LDA
#undef PG8_LDB
#undef PG8_MMA
#undef PG8_WAIT_V
#undef PG8_WAIT_L
#undef PG8_BAR
#undef PG8_SCHED
#undef PG8_GOFF
#undef PG8_CAT8
#undef PG8_RDA
#undef PG8_RDB
}
}

constexpr int D = 1024, BATCH = 8, SEQ = 4096, M = BATCH * SEQ, DEPTH = 2;
constexpr int D_A = 512, D_BK = 512, D_BV = 512, D_C = 512, H_B = 4;
constexpr int N_IN = 7680, N_BCA = 4608, N_G = 3072;
constexpr int D_FF = 2816, NE = 8, N13 = 2 * D_FF;
constexpr int MOD_LD = 6 * D;
constexpr float EPS = 1e-6f;
constexpr int XLD = 2 * D;
constexpr int LIST_CAP = M;
constexpr int MOE_ROWS = M + NE * 256;

constexpr size_t MiB = 1u << 20;
constexpr size_t WS_CTL = 0, CTL_ZERO_BYTES = 1 * MiB;
constexpr size_t WS_MOD = 1 * MiB;
constexpr size_t WS_TOPP = 2 * MiB;
constexpr size_t WS_QS = 2 * MiB + 768 * 1024;
constexpr size_t WS_LIST = 3 * MiB;
constexpr size_t WS_WMIX = 6 * MiB;
constexpr size_t WMIX_G8 = 9 * MiB;
constexpr size_t WS_W13 = 26 * MiB, WS_W2 = 37 * MiB;
constexpr size_t WS_BIG = 44 * MiB;
constexpr size_t WS_H = WS_BIG;
constexpr size_t WS_P1 = WS_BIG + 64 * MiB;
constexpr size_t WS_PG = WS_P1;
constexpr size_t WS_MRG = WS_P1 + 192 * MiB;
constexpr size_t WS_YA = WS_P1 + 288 * MiB, WS_YB = WS_YA + 32 * MiB, WS_YC = WS_YB + 32 * MiB;
constexpr size_t WS_ACT = WS_P1;
constexpr size_t WS_HU = WS_YC + 32 * MiB;
constexpr size_t WS_HD = WS_HU + 16 * MiB;
constexpr size_t WS_H8 = WS_HD + 1 * MiB;
constexpr size_t WS_MIX_END = WS_H8 + 32 * MiB;
static_assert((Q_PROJ == 0 || Q_GATE == 0 || Q_PROJ == Q_GATE) && Q_FDN != 2 && Q_MDN == 1 && Q_MUP != 0, "supported operand encodings");
constexpr int HQ_MIX = Q_PROJ ? Q_PROJ : Q_GATE;
constexpr bool H_BF = (Q_PROJ == 0 || Q_GATE == 0);
constexpr float F8_SW = 64.0f, F8_SACT = 8.0f, W_CLIP = 4.5f;
#ifndef CLIP_MIX0
#define CLIP_MIX0 6.0f
#endif
#ifndef CLIP_MIX1
#define CLIP_MIX1 6.0f
#endif
#ifndef CLIP_FFN
#define CLIP_FFN 6.0f
#endif
#ifndef CLIP_MOE
#define CLIP_MOE 6.0f
#endif
__host__ __device__ constexpr float sa_of(int q, float clip) { return q == 2 ? 127.0f / clip : 4.0f; }
enum { QS_IN = 0, QS_F13 = 1, QS_M13 = 3, QS_N = 8 };
constexpr int MOE_ES = 1;
constexpr size_t WS_WM13 = 6 * MiB;
constexpr size_t WS_WM2 = WS_WM13 + 88 * MiB;
constexpr size_t WS_H2M = WS_WM2 + 44 * MiB;
constexpr size_t WS_ACTM = WS_H2M + 64 * MiB;
constexpr size_t WS_MOE_END = WS_ACTM + 2 * (size_t)MOE_ROWS * D_FF * MOE_ES;
constexpr size_t WS_NEED = WS_MIX_END > WS_MOE_END ? WS_MIX_END : WS_MOE_END;
static_assert(WS_W2 + (size_t)D * D_FF * 2 <= WS_BIG && WS_WMIX + 20 * MiB <= WS_W13, "ws map");
constexpr int CW_BAR = 4096;
constexpr int CW_CNT = 16384;

constexpr int LDS_BYTES = 147456;
constexpr int SCR_BYTES = 139264;
constexpr int TAB_OFF = SCR_BYTES;
constexpr int MISC_OFF = TAB_OFF + 4096;
static_assert(MISC_OFF + 128 <= LDS_BYTES, "LDS map");
constexpr int NWAVES = 8, NT = 512;

#define GAS __attribute__((address_space(1)))
#define LAS __attribute__((address_space(3)))
typedef unsigned short bf16;
typedef unsigned v4u __attribute__((ext_vector_type(4)));
typedef float f32x4 __attribute__((ext_vector_type(4)));
#define LDS_WAIT() asm volatile("s_waitcnt lgkmcnt(0)" ::: "memory")
#define LDS_BARRIER() asm volatile("s_waitcnt lgkmcnt(0)\n\ts_barrier" ::: "memory")

typedef float f32x2_t __attribute__((ext_vector_type(2)));
typedef __bf16 bf16x2_t __attribute__((ext_vector_type(2)));
__device__ __forceinline__ unsigned pk2(float lo, float hi) { f32x2_t v = {lo, hi}; bf16x2_t b = __builtin_convertvector(v, bf16x2_t); return __builtin_bit_cast(unsigned, b); }
__device__ __forceinline__ float bf_lo(unsigned u) { return __uint_as_float(u << 16); }
__device__ __forceinline__ float bf_hi(unsigned u) { return __uint_as_float(u & 0xffff0000u); }
__device__ __forceinline__ void unpack8(const v4u w, float (&f)[8]) { f[0] = bf_lo(w.x); f[1] = bf_hi(w.x); f[2] = bf_lo(w.y); f[3] = bf_hi(w.y); f[4] = bf_lo(w.z); f[5] = bf_hi(w.z); f[6] = bf_lo(w.w); f[7] = bf_hi(w.w); }
__device__ __forceinline__ v4u pack8(const float (&f)[8]) { v4u w; w.x = pk2(f[0], f[1]); w.y = pk2(f[2], f[3]); w.z = pk2(f[4], f[5]); w.w = pk2(f[6], f[7]); return w; }
__device__ __forceinline__ float sigmoidf_(float x) { return __builtin_amdgcn_rcpf(1.0f + __expf(-x)); }
__device__ __forceinline__ float siluf_(float x) { return x * sigmoidf_(x); }
template <int Q> __device__ __forceinline__ float accf(float v) { return (Q == 2) ? (float)__float_as_int(v) : v; }
__device__ __forceinline__ float clamp_f8(float x) { return fminf(fmaxf(x, -448.0f), 448.0f); }
__device__ __forceinline__ unsigned q1_i8(float x) { return (unsigned)(int)rintf(fminf(fmaxf(x, -127.0f), 127.0f)) & 0xffu; }
template <int Q> __device__ __forceinline__ unsigned pk4_q(float a, float b, float c, float d) {
    if constexpr (Q == 2) return q1_i8(a) | (q1_i8(b) << 8) | (q1_i8(c) << 16) | (q1_i8(d) << 24);
    else { int v = 0; v = __builtin_amdgcn_cvt_pk_fp8_f32(clamp_f8(a), clamp_f8(b), v, false); v = __builtin_amdgcn_cvt_pk_fp8_f32(clamp_f8(c), clamp_f8(d), v, true); return (unsigned)v; } }
__device__ __forceinline__ float shx(float v, int mask, int lane) { return __int_as_float(__builtin_amdgcn_ds_bpermute((lane ^ mask) << 2, __float_as_int(v))); }
__device__ __forceinline__ float shl(float v, int src) { return __int_as_float(__builtin_amdgcn_ds_bpermute(src << 2, __float_as_int(v))); }
__device__ __forceinline__ float wave_sum(float v, int lane) {
#pragma unroll
    for (int o = 1; o < 64; o <<= 1) v += shx(v, o, lane);
    return v;
}

template <int CTRL> __device__ __forceinline__ float dppx(float x) { return __builtin_bit_cast(float, __builtin_amdgcn_mov_dpp(__builtin_bit_cast(int, x), CTRL, 0xf, 0xf, true)); }
__device__ __forceinline__ float dpp_xor4(float x) { const int xi = __builtin_bit_cast(int, x); int t = __builtin_amdgcn_update_dpp(xi, xi, 0x12C, 0xf, 0x5, false); t = __builtin_amdgcn_update_dpp(t, xi, 0x124, 0xf, 0xA, false); return __builtin_bit_cast(float, t); }
__device__ __forceinline__ f32x4 rot64(const f32x4 v, int lane) {
    const float a0 = v.x + v.y, a1 = v.x - v.y, a2 = v.z + v.w, a3 = v.z - v.w;
    f32x4 b = {a0 + a2, a1 + a3, a0 - a2, a1 - a3};
    const float s1 = (lane & 1) ? -1.0f : 1.0f, s2 = (lane & 2) ? -1.0f : 1.0f, s4 = (lane & 4) ? -1.0f : 1.0f, s8 = (lane & 8) ? -1.0f : 1.0f;
    b = (f32x4){dppx<0xB1>(b.x), dppx<0xB1>(b.y), dppx<0xB1>(b.z), dppx<0xB1>(b.w)} + b * s1;
    b = (f32x4){dppx<0x4E>(b.x), dppx<0x4E>(b.y), dppx<0x4E>(b.z), dppx<0x4E>(b.w)} + b * s2;
    b = (f32x4){dpp_xor4(b.x), dpp_xor4(b.y), dpp_xor4(b.z), dpp_xor4(b.w)} + b * s4;
    b = (f32x4){dppx<0x128>(b.x), dppx<0x128>(b.y), dppx<0x128>(b.z), dppx<0x128>(b.w)} + b * s8;
    return b * 0.125f;
}

#define XB_TMO      128
#define XB_XCNT(j)  (256  + 64 * (j))
#define XB_XSUB(j)  (1280 + 64 * (j))
#define XB_XGEN(j)  (2304 + 64 * (j))
#define XB_TOP      3328
#define XB_TOPGEN   3392
#define XCD_BAR_WORDS 3456
#define XB_SPIN_CAP (1u << 18)

__device__ __forceinline__ unsigned xb_ld(unsigned* p)              { return __hip_atomic_load(p, __ATOMIC_RELAXED, __HIP_MEMORY_SCOPE_AGENT); }
__device__ __forceinline__ unsigned xb_add(unsigned* p, unsigned v) { return __hip_atomic_fetch_add(p, v, __ATOMIC_RELAXED, __HIP_MEMORY_SCOPE_AGENT); }
__device__ __forceinline__ unsigned xb_xcc_id() { return (unsigned)__builtin_amdgcn_s_getreg((3 << 11) | 20) & 0xFu; }
#define XB_SPIN(cond, bar) do { unsigned _sp = 0; while (cond) { __builtin_amdgcn_s_sleep(1); \
    if ((++_sp & 255u) == 0u) { if (xb_ld(&(bar)[XB_TMO])) break; if (_sp > XB_SPIN_CAP) { atomicAdd(&(bar)[XB_TMO], 1u); break; } } } } while (0)

struct XcdBarrier { unsigned* bar; unsigned x; volatile LAS unsigned* st; };

__device__ __forceinline__ XcdBarrier xcd_barrier_post(unsigned* bar, volatile LAS unsigned* st) {
    XcdBarrier b; b.bar = bar; b.x = xb_xcc_id(); b.st = st;
    if (threadIdx.x == 0) (void)xb_add(&bar[XB_XCNT(b.x)], 1u);
    return b;
}
__device__ __forceinline__ void xcd_barrier_complete(unsigned* bar, unsigned x, unsigned& nloc, unsigned& nx) {
    const unsigned G = gridDim.x * gridDim.y * gridDim.z;
    unsigned sum, cnt, mine, sp = 0u;
    for (;;) {
        sum = 0u; cnt = 0u; mine = 0u;
        unsigned cv[16];
#pragma unroll
        for (unsigned j = 0; j < 16; ++j) cv[j] = xb_ld(&bar[XB_XCNT(j)]);
        asm volatile("" ::: "memory");
#pragma unroll
        for (unsigned j = 0; j < 16; ++j) { const unsigned c = cv[j]; sum += c; cnt += (c > 0u) ? 1u : 0u; mine = (j == x) ? c : mine; }
        if (sum == G) break;
        __builtin_amdgcn_s_sleep(1);
        if ((++sp & 255u) == 0u) { if (xb_ld(&bar[XB_TMO])) break; if (sp > XB_SPIN_CAP) { atomicAdd(&bar[XB_TMO], 1u); break; } }
    }
    nloc = mine > 0u ? mine : 1u; nx = cnt > 0u ? cnt : 1u;
}
__device__ __forceinline__ void xcd_barrier(const XcdBarrier& b) {
    asm volatile("s_waitcnt vmcnt(0)" ::: "memory");
    __syncthreads();
    if (threadIdx.x == 0) {
        unsigned* bar = b.bar;
        __builtin_amdgcn_s_waitcnt(0);
        unsigned nloc = b.st[0], nx = b.st[1];
        if (nloc == 0u) { xcd_barrier_complete(bar, b.x, nloc, nx); b.st[0] = nloc; b.st[1] = nx; }
        const unsigned old = xb_add(&bar[XB_XSUB(b.x)], 1u);
        const unsigned gen = old / nloc;
        if (old + 1u == (gen + 1u) * nloc) {
            __builtin_amdgcn_fence(__ATOMIC_RELEASE, "agent");
            asm volatile("s_waitcnt vmcnt(0)" ::: "memory");
            const unsigned og = xb_add(&bar[XB_TOP], 1u);
            const unsigned tg = og / nx;
            if (og + 1u == (tg + 1u) * nx) xb_add(&bar[XB_TOPGEN], 1u);
            else XB_SPIN(xb_ld(&bar[XB_TOPGEN]) == tg, bar);
            __builtin_amdgcn_fence(__ATOMIC_ACQUIRE, "agent");
            xb_add(&bar[XB_XGEN(b.x)], 1u);
            asm volatile("s_waitcnt vmcnt(0)" ::: "memory");
        } else {
            XB_SPIN(xb_ld(&bar[XB_XGEN(b.x)]) == gen, bar);
            __builtin_amdgcn_fence(__ATOMIC_ACQUIRE, "agent");
            asm volatile("s_waitcnt vmcnt(0)" ::: "memory");
        }
    }
    __syncthreads();
}

struct Args { const float* in[26]; float* out; unsigned char* ws; int ph_lo, ph_hi; };
typedef const Args __attribute__((address_space(4)))* KArgs;
#define KA() ({ KArgs p_ = (KArgs)__builtin_amdgcn_kernarg_segment_ptr(); asm volatile("" : "+s"(p_)); p_; })
struct Frame {
    LAS unsigned char* lds;
    int tid, lane, wave, G, bid;
    int w0;
};

template <int MAP, int F8 = 0>
__device__ __forceinline__ void transpose_item(const float* W, int K, int N, bf16* WT, int row_off, LAS float* scr, int item, int lane, float wscale = F8_SW) {
    const int nblk = N / 32, kb = item / nblk, nb = item % nblk, k0 = 64 * kb, n0 = 32 * nb;
    float vld[32];
#pragma unroll
    for (int i = 0; i < 32; ++i) vld[i] = W[(size_t)(k0 + 2 * i + (lane >> 5)) * N + n0 + (lane & 31)];
    asm volatile("" ::: "memory");
    if constexpr (F8 == 2) {
#pragma unroll
        for (int t = 1; t < 32; t <<= 1)
#pragma unroll
            for (int i = 0; i < 32; ++i) if (!(i & t)) { const float a = vld[i], b = vld[i | t]; vld[i] = a + b; vld[i | t] = a - b; }
#pragma unroll
        for (int i = 0; i < 32; ++i) { const float pv = shx(vld[i], 32, lane); vld[i] = (lane & 32) ? pv - vld[i] : vld[i] + pv; }
        wscale *= 0.125f;
    }
#pragma unroll
    for (int i = 0; i < 32; ++i) scr[(2 * i + (lane >> 5)) * 33 + (lane & 31)] = vld[i];
    LDS_WAIT(); asm volatile("" ::: "memory");
    const int c = lane & 7;
#pragma unroll
    for (int j = 0; j < 4; ++j) { const int n = (lane >> 3) + 8 * j; const LAS float* s = scr + (8 * c) * 33 + n;
        v4u o; o.x = pk2(s[0 * 33], s[1 * 33]); o.y = pk2(s[2 * 33], s[3 * 33]); o.z = pk2(s[4 * 33], s[5 * 33]); o.w = pk2(s[6 * 33], s[7 * 33]);
        const int nn = n0 + n; const int row = (MAP == 0) ? (row_off + nn) : ((nn >> 7) * 256 + row_off + (nn & 127));
        if constexpr (F8) { typedef unsigned v2u_ __attribute__((ext_vector_type(2))); v2u_ o8;
            o8.x = pk4_q<F8>(s[0 * 33] * wscale, s[1 * 33] * wscale, s[2 * 33] * wscale, s[3 * 33] * wscale); o8.y = pk4_q<F8>(s[4 * 33] * wscale, s[5 * 33] * wscale, s[6 * 33] * wscale, s[7 * 33] * wscale);
            *(v2u_*)((unsigned char*)WT + (size_t)row * K + k0 + 8 * c) = o8; }
        else *(v4u*)(WT + (size_t)row * K + k0 + 8 * c) = o; }
    LDS_WAIT(); asm volatile("" ::: "memory");
}

__device__ __forceinline__ void p_prologue(Frame& F, KArgs ka) {
    const float* c = ka->in[1]; const float* ada_w = ka->in[2]; const float* ada_b = ka->in[3];
    unsigned char* aws = ka->ws; float* mod = (float*)(aws + WS_MOD);
    LAS float* cact = (LAS float*)F.lds;
    LAS float* red = cact + 8192;
    for (int i = F.tid; i < BATCH * D; i += NT) cact[i] = siluf_(c[i]);
    __syncthreads();
    for (int chunk = F.bid; chunk < 256; chunk += F.G) {
        const int l = chunk >> 7, n0 = (chunk & 127) * 48;
        if (F.tid < 480) {
            const int kg = F.tid / 48, col = F.tid % 48;
            float acc[8];
#pragma unroll
            for (int b = 0; b < 8; ++b) acc[b] = 0.f;
            const float* wp = ada_w + (size_t)l * D * MOD_LD + n0 + col;
            for (int k = kg; k < D; k += 10) { const float w = wp[(size_t)k * MOD_LD];
#pragma unroll
                for (int b = 0; b < 8; ++b) acc[b] += cact[b * D + k] * w; }
#pragma unroll
            for (int b = 0; b < 8; ++b) red[(kg * 48 + col) * 8 + b] = acc[b];
        }
        __syncthreads();
        if (F.tid < 384) {
            const int col = F.tid >> 3, b = F.tid & 7; float s = 0.f;
#pragma unroll
            for (int kg = 0; kg < 10; ++kg) s += red[(kg * 48 + col) * 8 + b];
            mod[(size_t)(l * 8 + b) * MOD_LD + n0 + col] = s + ada_b[l * MOD_LD + n0 + col];
        }
        __syncthreads();
    }
}
__device__ __forceinline__ float wscale_sample(const float* W, size_t n, int lane) {
    float ss = 0.f;
#pragma unroll 8
    for (int j = 0; j < 32; ++j) { const size_t idx = ((size_t)(lane + 64 * j) * 1000003ull) % n; const float v = W[idx]; ss += v * v; }
    ss = wave_sum(ss, lane);
    return 127.0f / (W_CLIP * sqrtf(ss * (1.0f / 2048.0f)) + 1e-30f);
}
__device__ __forceinline__ void p_convert_mixer(Frame& F, KArgs ka, int l, bool with_ffn) {
    unsigned char* aws = ka->ws;
    LAS float* scr = (LAS float*)(F.lds + F.wave * 16384);
    const int gw = F.bid * NWAVES + F.wave, NGW = F.G * NWAVES;
    constexpr int I_BCA = (D / 64) * (N_BCA / 32), I_G = (D / 64) * (N_G / 32), I_BR = (512 / 64) * (D / 32), I_O = (D / 64) * (D / 32), I_L = I_BCA + I_G + 3 * I_BR + I_O;
    constexpr int I_F1 = (D / 64) * (D_FF / 32), I_F2 = (D_FF / 64) * (D / 32);
    const int nitems = I_L + (with_ffn ? 2 * I_F1 + I_F2 : 0);
    bf16* base = (bf16*)(aws + WS_WMIX);
    LAS float* qsl = (LAS float*)(F.lds + TAB_OFF + 3072);
    __syncthreads();
    if (F.wave == 0) { const float v = wscale_sample(ka->in[6] + (size_t)l * D * N_IN, (size_t)D * N_IN, F.lane); if (F.lane == 0) qsl[0] = v; }
    if (F.wave == 1) { const float v = wscale_sample(ka->in[17], (size_t)D * D_FF, F.lane); if (F.lane == 0) qsl[1] = v; }
    if (F.wave == 2) { const float v = wscale_sample(ka->in[18], (size_t)D * D_FF, F.lane); if (F.lane == 0) qsl[2] = v; }
    __syncthreads();
    const float ws_in = qsl[0], ws_13 = (Q_FUP == 2) ? fminf(qsl[1], qsl[2]) : F8_SW;
    const float ws_p = (Q_PROJ == 2) ? ws_in : F8_SW, ws_g = (Q_GATE == 2) ? ws_in : F8_SW;
    if (F.bid == 0 && F.tid == 0) { float* qs = (float*)(aws + WS_QS); qs[QS_IN] = ws_in; if (with_ffn) qs[QS_F13] = ws_13; }
    for (int it = gw; it < nitems; it += NGW) {
        int r = it;
        if (r < I_BCA) { const int kb = r / (N_BCA / 32), nb = r % (N_BCA / 32);
            transpose_item<0, Q_PROJ>(ka->in[6] + (size_t)l * D * N_IN, D, N_IN, base, 0, scr, kb * (N_IN / 32) + nb, F.lane, ws_p); continue; } r -= I_BCA;
        if (r < I_G) { const int kb = r / (N_G / 32), nb = r % (N_G / 32) + N_BCA / 32;
            if (Q_GATE) transpose_item<0, Q_GATE>(ka->in[6] + (size_t)l * D * N_IN, D, N_IN, (bf16*)(aws + WS_WMIX + WMIX_G8), -N_BCA, scr, kb * (N_IN / 32) + nb, F.lane, ws_g);
            else transpose_item<0>(ka->in[6] + (size_t)l * D * N_IN, D, N_IN, base, 0, scr, kb * (N_IN / 32) + nb, F.lane);
            continue; } r -= I_G;
        if (r < I_BR) { transpose_item<0>(ka->in[13] + (size_t)l * 512 * D, 512, D, base + (size_t)N_IN * D, 0, scr, r, F.lane); continue; } r -= I_BR;
        if (r < I_BR) { transpose_item<0>(ka->in[14] + (size_t)l * 512 * D, 512, D, base + (size_t)N_IN * D + 512 * 1024, 0, scr, r, F.lane); continue; } r -= I_BR;
        if (r < I_BR) { transpose_item<0>(ka->in[15] + (size_t)l * 512 * D, 512, D, base + (size_t)N_IN * D + 2 * 512 * 1024, 0, scr, r, F.lane); continue; } r -= I_BR;
        if (r < I_O) { transpose_item<0>(ka->in[16] + (size_t)l * D * D, D, D, base + (size_t)N_IN * D + 3 * 512 * 1024, 0, scr, r, F.lane); continue; } r -= I_O;
        if (r < I_F1) { transpose_item<1, Q_FUP>(ka->in[17], D, D_FF, (bf16*)(aws + WS_W13), 0, scr, r, F.lane, ws_13); continue; } r -= I_F1;
        if (r < I_F1) { transpose_item<1, Q_FUP>(ka->in[18], D, D_FF, (bf16*)(aws + WS_W13), 128, scr, r, F.lane, ws_13); continue; } r -= I_F1;
        transpose_item<0, Q_FDN>(ka->in[19], D_FF, D, (bf16*)(aws + WS_W2), 0, scr, r, F.lane, F8_SW);
    }
}
__device__ __forceinline__ void p_moe_weights(Frame& F, KArgs ka) {
    unsigned char* aws = ka->ws;
    LAS float* scr = (LAS float*)(F.lds + F.wave * 16384);
    const int gw = F.bid * NWAVES + F.wave, NGW = F.G * NWAVES;
    constexpr int I_F1 = (D / 64) * (D_FF / 32), I_F2 = (D_FF / 64) * (D / 32), I_E = 2 * I_F1 + I_F2;
    LAS float* qsl = (LAS float*)(F.lds + TAB_OFF + 3072);
    __syncthreads();
    if (F.wave == 0) { const float v = wscale_sample(ka->in[22], (size_t)NE * D * D_FF, F.lane); if (F.lane == 0) qsl[0] = v; }
    if (F.wave == 1) { const float v = wscale_sample(ka->in[23], (size_t)NE * D * D_FF, F.lane); if (F.lane == 0) qsl[1] = v; }
    __syncthreads();
    const float ws_13 = (Q_MUP == 2) ? fminf(qsl[0], qsl[1]) : F8_SW;
    if (F.bid == 0 && F.tid == 0) { float* qs = (float*)(aws + WS_QS); qs[QS_M13] = ws_13; }
    for (int it = gw; it < NE * I_E; it += NGW) {
        const int e = it / I_E; int r = it - e * I_E;
        bf16* w13 = (bf16*)(aws + WS_WM13 + (size_t)e * N13 * D * MOE_ES); bf16* w2 = (bf16*)(aws + WS_WM2 + (size_t)e * D * D_FF * MOE_ES);
        if (r < I_F1) { transpose_item<1, Q_MUP>(ka->in[22] + (size_t)e * D * D_FF, D, D_FF, w13, 0, scr, r, F.lane, ws_13); continue; } r -= I_F1;
        if (r < I_F1) { transpose_item<1, Q_MUP>(ka->in[23] + (size_t)e * D * D_FF, D, D_FF, w13, 128, scr, r, F.lane, ws_13); continue; } r -= I_F1;
        transpose_item<0, Q_MDN>(ka->in[24] + (size_t)e * D_FF * D, D_FF, D, w2, 0, scr, r, F.lane, F8_SW);
    }
}

__device__ __forceinline__ void norm_row(const float* xrow, const float* w, const float* sc, const float* sh, int lane, f32x4 (&o)[4]) {
    const f32x4* xr = (const f32x4*)xrow + lane;
    f32x4 v[4]; float s = 0.f;
#pragma unroll
    for (int j = 0; j < 4; ++j) { v[j] = xr[64 * j]; s += (v[j].x * v[j].x + v[j].y * v[j].y) + (v[j].z * v[j].z + v[j].w * v[j].w); }
    const float rstd = 1.0f / sqrtf(wave_sum(s, lane) * (1.0f / D) + EPS);
#pragma unroll
    for (int j = 0; j < 4; ++j) { const f32x4 wv = ((const f32x4*)w)[lane + 64 * j], scv = ((const f32x4*)sc)[lane + 64 * j], shv = ((const f32x4*)sh)[lane + 64 * j];
        o[j] = v[j] * rstd * wv * (scv + 1.0f) + shv; }
}
template <bool XBF>
__device__ __forceinline__ f32x4 load_x4(const void* xbase, size_t row, int lane, int j) {
    if constexpr (XBF) { typedef unsigned v2u_ __attribute__((ext_vector_type(2))); const v2u_ w = ((const v2u_*)((const bf16*)xbase + row * XLD))[lane + 64 * j];
        return (f32x4){bf_lo(w.x), bf_hi(w.x), bf_lo(w.y), bf_hi(w.y)}; }
    else return ((const f32x4*)((const float*)xbase + row * D))[lane + 64 * j];
}
__device__ __forceinline__ void store_row_bf16(bf16* orow, int lane, const f32x4 (&o)[4]) {
    unsigned long long* o8 = (unsigned long long*)orow + lane;
#pragma unroll
    for (int j = 0; j < 4; ++j) o8[64 * j] = (unsigned long long)pk2(o[j].x, o[j].y) | ((unsigned long long)pk2(o[j].z, o[j].w) << 32);
}
template <int MODE = 0, bool XBF = true, int HQ = 2>
__device__ __forceinline__ void p_norm(Frame& F, const void* xin, const float* w, const float* mod_l, int sc_off, int sh_off, bf16* hout, unsigned char* hout8 = nullptr, float sa = 1.0f) {
    const int gw = F.bid * NWAVES + F.wave, NGW = F.G * NWAVES, lane = F.lane;
    f32x4 wv[4];
#pragma unroll
    for (int j = 0; j < 4; ++j) wv[j] = ((const f32x4*)w)[lane + 64 * j];
    for (int r0 = gw * 4; r0 < M; r0 += NGW * 4) {
        const float* mb = mod_l + (size_t)(r0 >> 12) * MOD_LD;
        f32x4 v[4][4], scv[4], shv[4];
#pragma unroll
        for (int r = 0; r < 4; ++r)
#pragma unroll
            for (int j = 0; j < 4; ++j) v[r][j] = load_x4<XBF>(xin, (size_t)(r0 + r), lane, j);
#pragma unroll
        for (int j = 0; j < 4; ++j) { scv[j] = ((const f32x4*)(mb + sc_off))[lane + 64 * j]; shv[j] = ((const f32x4*)(mb + sh_off))[lane + 64 * j]; }
        asm volatile("" ::: "memory");
#pragma unroll
        for (int j = 0; j < 4; ++j) scv[j] = wv[j] * (scv[j] + 1.0f);
#pragma unroll
        for (int r = 0; r < 4; ++r) { float s = 0.f;
#pragma unroll
            for (int j = 0; j < 4; ++j) s += (v[r][j].x * v[r][j].x + v[r][j].y * v[r][j].y) + (v[r][j].z * v[r][j].z + v[r][j].w * v[r][j].w);
            const float rstd = 1.0f / sqrtf(wave_sum(s, lane) * (1.0f / D) + EPS);
            f32x4 o[4];
#pragma unroll
            for (int j = 0; j < 4; ++j) o[j] = v[r][j] * rstd * scv[j] + shv[j];
            if constexpr (MODE != 0) { unsigned* o4 = (unsigned*)((MODE == 1 ? (unsigned char*)hout : hout8) + (size_t)(r0 + r) * D) + lane;
#pragma unroll
                for (int j = 0; j < 4; ++j) { const f32x4 q = (HQ == 2) ? rot64(o[j], lane) : o[j]; o4[64 * j] = pk4_q<HQ>(q.x * sa, q.y * sa, q.z * sa, q.w * sa); } }
            if constexpr (MODE != 1) store_row_bf16(hout + (size_t)(r0 + r) * D, lane, o); }
    }
}

__device__ __forceinline__ void p_conv(Frame& F, const bf16* P1, const float* conv_w, bf16* ya) {
    const int gt = F.bid * NT + F.tid, NGT = F.G * NT;
    for (int it = gt; it < M * 64; it += NGT) {
        const int row = it >> 6, c8 = (it & 63) * 8, pos = row & (SEQ - 1);
        const bf16* p = P1 + (size_t)row * N_BCA + c8;
        float ab[8], ac[8], ah[8], z1[8], z2[8], y[8];
        unpack8(*(const v4u*)p, ab); unpack8(*(const v4u*)(p + 512), ac); unpack8(*(const v4u*)(p + 1024), ah);
#pragma unroll
        for (int i = 0; i < 8; ++i) { z1[i] = 0.f; z2[i] = 0.f; }
        if (pos >= 1) { float c1[8], h1[8]; unpack8(*(const v4u*)(p - N_BCA + 512), c1); unpack8(*(const v4u*)(p - N_BCA + 1024), h1);
#pragma unroll
            for (int i = 0; i < 8; ++i) z1[i] = c1[i] * h1[i]; }
        if (pos >= 2) { float c2[8], h2[8]; unpack8(*(const v4u*)(p - 2 * N_BCA + 512), c2); unpack8(*(const v4u*)(p - 2 * N_BCA + 1024), h2);
#pragma unroll
            for (int i = 0; i < 8; ++i) z2[i] = c2[i] * h2[i]; }
#pragma unroll
        for (int i = 0; i < 8; ++i) y[i] = ab[i] * (conv_w[c8 + i] * (ac[i] * ah[i]) + conv_w[512 + c8 + i] * z1[i] + conv_w[1024 + c8 + i] * z2[i]);
        *(v4u*)(ya + (size_t)row * 512 + c8) = pack8(y);
    }
}

typedef short v4i16_t __attribute__((ext_vector_type(4)));
typedef short bf16x8_t __attribute__((ext_vector_type(8)));
typedef unsigned v2u __attribute__((ext_vector_type(2)));
constexpr int HRS = 272;
constexpr int TRS = 80;
constexpr int H_RAWQ = 0, H_RAWF = 8704, H_V = 17408, H_QHT = 26112, H_KTT = 36352, H_KHT = 46592, H_DL = 56832, H_OB = 57344, H_OBS = 132, H_V2 = 74240;
constexpr int HSEG = 512, HNSEG = SEQ / HSEG, HCH = 32;
__device__ __forceinline__ v4i16_t tr_read(LAS unsigned char* p) { return __builtin_amdgcn_ds_read_tr16_b64_v4i16((LAS v4i16_t*)p); }
__device__ __forceinline__ bf16x8_t cat4(v4i16_t lo, v4i16_t hi) { return __builtin_shufflevector(lo, hi, 0, 1, 2, 3, 4, 5, 6, 7); }
__device__ __forceinline__ bf16x8_t pack_acc(const f32x4 a, const f32x4 b) { v4u w; w.x = pk2(a[0], a[1]); w.y = pk2(a[2], a[3]); w.z = pk2(b[0], b[1]); w.w = pk2(b[2], b[3]); return __builtin_bit_cast(bf16x8_t, w); }
__device__ __forceinline__ float bfs(short x) { return __uint_as_float((unsigned)(unsigned short)x << 16); }
template <int PASS>
__device__ __forceinline__ void p_hgrn(Frame& F, const bf16* P1, const float* lb_logits, int layer, const float* norm_w, bf16* yb, float* ust, float* dst) {
    LAS unsigned char* L = F.lds;
    const int lane = F.lane, w = F.wave, g = lane >> 4, n = lane & 15, q_ = n >> 2, p_ = n & 3;
    const int pt = F.tid >> 4, pc8 = (F.tid & 15) * 8;
    for (int u = F.bid; u < BATCH * H_B * HNSEG; u += F.G) {
        const int seg = u & (HNSEG - 1), bh = u / HNSEG, b = bh >> 2, h = bh & 3;
        const int d = 16 * w + n;
        float lb; { const int ch = h * 128 + d; const float l0 = lb_logits[ch], l1 = lb_logits[512 + ch]; const float mx = fmaxf(l0, l1);
            const float e0 = expf(l0 - mx), e1 = expf(l1 - mx); const float p0 = e0 / (e0 + e1), p1 = e1 / (e0 + e1);
            const float lbx = (layer == 0) ? (p0 - p0) : ((p0 + p1) - p0); lb = fminf(fmaxf(lbx, 0.f), 1.f); }
        const float lbf = fmaxf(lb, 1e-30f), oml = 1.0f - lb;
        f32x4 S[8];
#pragma unroll
        for (int kt = 0; kt < 8; ++kt) S[kt] = (f32x4){0.f, 0.f, 0.f, 0.f};
        if (PASS == 2) {
            for (int j = 0; j < seg; ++j) { const int uj = u - seg + j;
#pragma unroll
                for (int kt = 0; kt < 8; ++kt) { const f32x4 dj = *(const f32x4*)(dst + (size_t)uj * 128 + 16 * kt + 4 * g); const f32x4 uu = *(const f32x4*)(ust + ((((size_t)uj * 8 + w) * 8 + kt) * 64 + lane) * 4);
                    S[kt] = dj * S[kt] + uu; } }
        }
        float nw8[8];
        if (PASS == 2) {
#pragma unroll
            for (int i = 0; i < 8; ++i) nw8[i] = norm_w[h * 128 + pc8 + i]; }
        float dprod = 1.0f;
        const bf16* gp = P1 + ((size_t)b * SEQ + (size_t)seg * HSEG + pt) * N_BCA + 1536 + h * 128 + pc8;
        constexpr int HPF = 4, NCH = HSEG / HCH;
        v4u rq[HPF], rf[HPF], rv[HPF], rg[HPF];
#pragma unroll
        for (int k = 0; k < HPF; ++k) { const bf16* np = gp + (size_t)k * HCH * N_BCA; rf[k] = *(const v4u*)(np + 512); rv[k] = *(const v4u*)(np + 1024);
            if (PASS == 2) { rq[k] = *(const v4u*)np; rg[k] = *(const v4u*)(np + 1536); } }
#define HG_WRITE(k_, vb_) do { *(LAS v4u*)(L + H_RAWF + pt * HRS + pc8 * 2) = rf[k_]; *(LAS v4u*)(L + ((vb_) ? H_V2 : H_V) + pt * HRS + pc8 * 2) = rv[k_]; \
            if (PASS == 2) *(LAS v4u*)(L + H_RAWQ + pt * HRS + pc8 * 2) = rq[k_]; } while (0)
#define HG_REFILL(k_, cn_) do { if ((cn_) < NCH) { const bf16* np = gp + (size_t)(cn_) * HCH * N_BCA; rf[k_] = *(const v4u*)(np + 512); rv[k_] = *(const v4u*)(np + 1024); \
            if (PASS == 2) { rq[k_] = *(const v4u*)np; rg[k_] = *(const v4u*)(np + 1536); } } } while (0)
        v4u cg, cgn;
        HG_WRITE(0, 0); if (PASS == 2) cg = rg[0];
        LDS_BARRIER();
        HG_REFILL(0, HPF);
            { const bf16x8_t f8 = cat4(tr_read(L + H_RAWF + (8 * g + q_) * HRS + 32 * w + 8 * p_), tr_read(L + H_RAWF + (8 * g + 4 + q_) * HRS + 32 * w + 8 * p_));
              float eb[8], kk[8]; float cp = 1.0f;
#pragma unroll
              for (int i = 0; i < 8; ++i) { const float sg = __builtin_amdgcn_rcpf(1.0f + __expf(-bfs(f8[i]))); const float f = lbf + oml * sg; kk[i] = oml * (1.0f - sg); cp *= f; eb[i] = cp; }
              const float s1 = shl(cp, n), s2 = shl(cp, 16 + n), s3 = shl(cp, 32 + n), s4 = shl(cp, 48 + n);
              const float pre = (g > 0 ? s1 : 1.0f) * (g > 1 ? s2 : 1.0f) * (g > 2 ? s3 : 1.0f);
              const float elast = ((s1 * s2) * s3) * s4;
              float kh[8], kt8[8];
#pragma unroll
              for (int i = 0; i < 8; ++i) { eb[i] *= pre; const float en = __builtin_amdgcn_rcpf(fmaxf(eb[i], 1e-30f)); kt8[i] = kk[i] * en; kh[i] = kt8[i] * elast; }
              *(LAS v4u*)(L + H_KHT + d * TRS + 16 * g) = pack8(kh);
              if (PASS == 2) { const bf16x8_t q8 = cat4(tr_read(L + H_RAWQ + (8 * g + q_) * HRS + 32 * w + 8 * p_), tr_read(L + H_RAWQ + (8 * g + 4 + q_) * HRS + 32 * w + 8 * p_));
                  float qh[8];
#pragma unroll
                  for (int i = 0; i < 8; ++i) qh[i] = siluf_(bfs(q8[i])) * eb[i];
                  *(LAS v4u*)(L + H_QHT + d * TRS + 16 * g) = pack8(qh); *(LAS v4u*)(L + H_KTT + d * TRS + 16 * g) = pack8(kt8); }
              if (g == 0) *(LAS float*)(L + H_DL + 4 * d) = elast;
              dprod *= elast; }
        LDS_BARRIER();
        for (int c0 = 0; c0 < NCH; c0 += HPF) {
#pragma unroll
          for (int k = 0; k < HPF; ++k) {
            const int c = c0 + k; const int vbuf = (k & 1) ? H_V2 : H_V;
            const bf16x8_t bVn = cat4(tr_read(L + vbuf + (8 * g + q_) * HRS + 32 * w + 8 * p_), tr_read(L + vbuf + (8 * g + 4 + q_) * HRS + 32 * w + 8 * p_));
            if (PASS == 2) {
                const bf16x8_t bVp = cat4(tr_read(L + vbuf + (4 * g + q_) * HRS + 32 * w + 8 * p_), tr_read(L + vbuf + (16 + 4 * g + q_) * HRS + 32 * w + 8 * p_));
                f32x4 o[2], pt00 = {0.f, 0.f, 0.f, 0.f}, pt01 = {0.f, 0.f, 0.f, 0.f}, pt11 = {0.f, 0.f, 0.f, 0.f};
                o[0] = (f32x4){0.f, 0.f, 0.f, 0.f}; o[1] = (f32x4){0.f, 0.f, 0.f, 0.f};
#pragma unroll
                for (int ks = 0; ks < 4; ++ks) {
                    const bf16x8_t sb = pack_acc(S[2 * ks], S[2 * ks + 1]);
#pragma unroll
                    for (int tm = 0; tm < 2; ++tm) {
                        const bf16x8_t aq = cat4(tr_read(L + H_QHT + (32 * ks + 4 * g + q_) * TRS + 32 * tm + 8 * p_), tr_read(L + H_QHT + (32 * ks + 16 + 4 * g + q_) * TRS + 32 * tm + 8 * p_));
                        o[tm] = __builtin_amdgcn_mfma_f32_16x16x32_bf16(aq, sb, o[tm], 0, 0, 0); }
                    const bf16x8_t aK0 = cat4(tr_read(L + H_KTT + (32 * ks + 8 * g + q_) * TRS + 8 * p_), tr_read(L + H_KTT + (32 * ks + 8 * g + 4 + q_) * TRS + 8 * p_));
                    const bf16x8_t aK1 = cat4(tr_read(L + H_KTT + (32 * ks + 8 * g + q_) * TRS + 32 + 8 * p_), tr_read(L + H_KTT + (32 * ks + 8 * g + 4 + q_) * TRS + 32 + 8 * p_));
                    const bf16x8_t bQ0 = cat4(tr_read(L + H_QHT + (32 * ks + 8 * g + q_) * TRS + 8 * p_), tr_read(L + H_QHT + (32 * ks + 8 * g + 4 + q_) * TRS + 8 * p_));
                    const bf16x8_t bQ1 = cat4(tr_read(L + H_QHT + (32 * ks + 8 * g + q_) * TRS + 32 + 8 * p_), tr_read(L + H_QHT + (32 * ks + 8 * g + 4 + q_) * TRS + 32 + 8 * p_));
                    pt00 = __builtin_amdgcn_mfma_f32_16x16x32_bf16(aK0, bQ0, pt00, 0, 0, 0);
                    pt01 = __builtin_amdgcn_mfma_f32_16x16x32_bf16(aK0, bQ1, pt01, 0, 0, 0);
                    pt11 = __builtin_amdgcn_mfma_f32_16x16x32_bf16(aK1, bQ1, pt11, 0, 0, 0);
                }
#pragma unroll
                for (int j = 0; j < 4; ++j) if (4 * g + j > n) { pt00[j] = 0.f; pt11[j] = 0.f; }
                const f32x4 z4 = {0.f, 0.f, 0.f, 0.f};
                o[0] = __builtin_amdgcn_mfma_f32_16x16x32_bf16(pack_acc(pt00, z4), bVp, o[0], 0, 0, 0);
                o[1] = __builtin_amdgcn_mfma_f32_16x16x32_bf16(pack_acc(pt01, pt11), bVp, o[1], 0, 0, 0);
#pragma unroll
                for (int tm = 0; tm < 2; ++tm)
#pragma unroll
                    for (int j = 0; j < 4; ++j) *(LAS float*)(L + H_OB + ((16 * tm + 4 * g + j) * H_OBS + 16 * w + n) * 4) = o[tm][j];
            }
#pragma unroll
            for (int kt = 0; kt < 8; ++kt) { const f32x4 dl4 = *(const LAS f32x4*)(L + H_DL + (16 * kt + 4 * g) * 4);
                const bf16x8_t aKh = *(const LAS bf16x8_t*)(L + H_KHT + (16 * kt + n) * TRS + 16 * g);
                S[kt] = __builtin_amdgcn_mfma_f32_16x16x32_bf16(aKh, bVn, S[kt] * dl4, 0, 0, 0); }
            if (c + 1 < NCH) { HG_WRITE((k + 1) % HPF, (k + 1) & 1); if (PASS == 2) cgn = rg[(k + 1) % HPF]; }
            LDS_BARRIER();
            if (c + 1 < NCH) HG_REFILL((k + 1) % HPF, c + 1 + HPF);
            if (PASS == 2) {
                const f32x4 o0 = *(const LAS f32x4*)(L + H_OB + (pt * H_OBS + pc8) * 4), o1 = *(const LAS f32x4*)(L + H_OB + (pt * H_OBS + pc8 + 4) * 4);
                const float o8[8] = {o0.x, o0.y, o0.z, o0.w, o1.x, o1.y, o1.z, o1.w};
                float ss = 0.f;
#pragma unroll
                for (int i = 0; i < 8; ++i) ss += o8[i] * o8[i];
                ss += shx(ss, 1, lane); ss += shx(ss, 2, lane); ss += shx(ss, 4, lane); ss += shx(ss, 8, lane);
                const float rs = 1.0f / sqrtf(ss * (1.0f / 128.0f) + EPS);
                float g8[8], y[8]; unpack8(cg, g8);
#pragma unroll
                for (int i = 0; i < 8; ++i) y[i] = o8[i] * rs * nw8[i] * siluf_(g8[i]);
                *(v4u*)(yb + ((size_t)b * SEQ + (size_t)seg * HSEG + (size_t)c * HCH + pt) * 512 + h * 128 + pc8) = pack8(y);
            }
            if (c + 1 < NCH)
            { const bf16x8_t f8 = cat4(tr_read(L + H_RAWF + (8 * g + q_) * HRS + 32 * w + 8 * p_), tr_read(L + H_RAWF + (8 * g + 4 + q_) * HRS + 32 * w + 8 * p_));
              float eb[8], kk[8]; float cp = 1.0f;
#pragma unroll
              for (int i = 0; i < 8; ++i) { const float sg = __builtin_amdgcn_rcpf(1.0f + __expf(-bfs(f8[i]))); const float f = lbf + oml * sg; kk[i] = oml * (1.0f - sg); cp *= f; eb[i] = cp; }
              const float s1 = shl(cp, n), s2 = shl(cp, 16 + n), s3 = shl(cp, 32 + n), s4 = shl(cp, 48 + n);
              const float pre = (g > 0 ? s1 : 1.0f) * (g > 1 ? s2 : 1.0f) * (g > 2 ? s3 : 1.0f);
              const float elast = ((s1 * s2) * s3) * s4;
              float kh[8], kt8[8];
#pragma unroll
              for (int i = 0; i < 8; ++i) { eb[i] *= pre; const float en = __builtin_amdgcn_rcpf(fmaxf(eb[i], 1e-30f)); kt8[i] = kk[i] * en; kh[i] = kt8[i] * elast; }
              *(LAS v4u*)(L + H_KHT + d * TRS + 16 * g) = pack8(kh);
              if (PASS == 2) { const bf16x8_t q8 = cat4(tr_read(L + H_RAWQ + (8 * g + q_) * HRS + 32 * w + 8 * p_), tr_read(L + H_RAWQ + (8 * g + 4 + q_) * HRS + 32 * w + 8 * p_));
                  float qh[8];
#pragma unroll
                  for (int i = 0; i < 8; ++i) qh[i] = siluf_(bfs(q8[i])) * eb[i];
                  *(LAS v4u*)(L + H_QHT + d * TRS + 16 * g) = pack8(qh); *(LAS v4u*)(L + H_KTT + d * TRS + 16 * g) = pack8(kt8); }
              if (g == 0) *(LAS float*)(L + H_DL + 4 * d) = elast;
              dprod *= elast; }
            LDS_BARRIER();
            if (PASS == 2) cg = cgn;
          }
        }
#undef HG_WRITE
#undef HG_REFILL
        if (PASS == 1) {
#pragma unroll
            for (int kt = 0; kt < 8; ++kt) *(f32x4*)(ust + ((((size_t)u * 8 + w) * 8 + kt) * 64 + lane) * 4) = S[kt];
            if (g == 0) dst[(size_t)u * 128 + d] = dprod;
        }
        __syncthreads();
    }
}

constexpr int SG_V = 0, SG_OB = 34816, SG_OBS = 132, SG_RS = SG_OB + 128 * SG_OBS * 4;
__device__ __forceinline__ void p_sgu(Frame& F, const bf16* P1, const float* norm_w, const float* sgu_w, const float* sgu_b, bf16* yc) {
    LAS unsigned char* L = F.lds;
    const int lane = F.lane, w = F.wave, gq = lane >> 4, n = lane & 15, q_ = n >> 2, p_ = n & 3;
    const int sr = F.tid >> 4, c8 = (F.tid & 15) * 8;
    for (int u = F.bid; u < M / 128; u += F.G) {
        const size_t row0 = (size_t)u * 128;
        v4u rv[4][4]; float ssj[4] = {0.f, 0.f, 0.f, 0.f};
#pragma unroll
        for (int g = 0; g < 4; ++g)
#pragma unroll
            for (int j = 0; j < 4; ++j) { rv[g][j] = *(const v4u*)(P1 + (row0 + sr + 32 * j) * N_BCA + 4096 + g * 128 + c8); float f[8]; unpack8(rv[g][j], f);
#pragma unroll
                for (int i = 0; i < 8; ++i) ssj[j] += f[i] * f[i]; }
#pragma unroll
        for (int j = 0; j < 4; ++j) { float ss = ssj[j]; ss += shx(ss, 1, lane); ss += shx(ss, 2, lane); ss += shx(ss, 4, lane); ss += shx(ss, 8, lane);
            if (n == 0) *(LAS float*)(L + SG_RS + 4 * (sr + 32 * j)) = 1.0f / sqrtf(ss * (1.0f / 512.0f) + EPS); }
#pragma unroll
        for (int g = 0; g < 4; ++g) {
#pragma unroll
            for (int j = 0; j < 4; ++j) *(LAS v4u*)(L + SG_V + (sr + 32 * j) * HRS + c8 * 2) = rv[g][j];
            LDS_BARRIER();
            float nwv[8];
            const int kmax = w >> 1, t = 16 * w + n;
            bf16x8_t aW[4];
            { f32x4 wl[4][2]; float nwl[8];
#pragma unroll
              for (int ks = 0; ks < 4; ++ks) { const float* wp = sgu_w + ((size_t)g * 128 + t) * 128 + 32 * ks + 8 * gq; wl[ks][0] = *(const f32x4*)wp; wl[ks][1] = *(const f32x4*)(wp + 4); }
#pragma unroll
              for (int ct = 0; ct < 8; ++ct) nwl[ct] = norm_w[g * 128 + 16 * ct + n];
              asm volatile("" ::: "memory");
#pragma unroll
              for (int ct = 0; ct < 8; ++ct) nwv[ct] = nwl[ct];
#pragma unroll
              for (int ks = 0; ks < 4; ++ks) { const int s0 = 32 * ks + 8 * gq;
                    const f32x4 w0 = wl[ks][0], w1 = wl[ks][1]; const f32x4 r0 = *(const LAS f32x4*)(L + SG_RS + 4 * s0), r1 = *(const LAS f32x4*)(L + SG_RS + 4 * (s0 + 4));
                    float a8[8] = {w0.x * r0.x, w0.y * r0.y, w0.z * r0.z, w0.w * r0.w, w1.x * r1.x, w1.y * r1.y, w1.z * r1.z, w1.w * r1.w};
#pragma unroll
                    for (int i = 0; i < 8; ++i) if (s0 + i > t) a8[i] = 0.f;
                    aW[ks] = __builtin_bit_cast(bf16x8_t, pack8(a8)); } }
            f32x4 acc[8];
#pragma unroll
            for (int ct = 0; ct < 8; ++ct) acc[ct] = (f32x4){0.f, 0.f, 0.f, 0.f};
#pragma unroll
            for (int ks = 0; ks < 4; ++ks) { if (ks <= kmax) {
#pragma unroll
                for (int ct = 0; ct < 8; ++ct) { const bf16x8_t bV = cat4(tr_read(L + SG_V + (32 * ks + 8 * gq + q_) * HRS + 32 * ct + 8 * p_), tr_read(L + SG_V + (32 * ks + 8 * gq + 4 + q_) * HRS + 32 * ct + 8 * p_));
                    acc[ct] = __builtin_amdgcn_mfma_f32_16x16x32_bf16(aW[ks], bV, acc[ct], 0, 0, 0); } } }
#pragma unroll
            for (int ct = 0; ct < 8; ++ct) { const float nw = nwv[ct];
#pragma unroll
                for (int j = 0; j < 4; ++j) *(LAS float*)(L + SG_OB + ((16 * w + 4 * gq + j) * SG_OBS + 16 * ct + n) * 4) = acc[ct][j] * nw; }
            LDS_BARRIER();
            v4u ul[4]; float bl[4];
#pragma unroll
            for (int j = 0; j < 4; ++j) { ul[j] = *(const v4u*)(P1 + (row0 + sr + 32 * j) * N_BCA + 3584 + g * 128 + c8); bl[j] = sgu_b[g * 128 + sr + 32 * j]; }
            asm volatile("" ::: "memory");
#pragma unroll
            for (int j = 0; j < 4; ++j) { const int tt = sr + 32 * j; const float bias = bl[j];
                const f32x4 o0 = *(const LAS f32x4*)(L + SG_OB + (tt * SG_OBS + c8) * 4), o1 = *(const LAS f32x4*)(L + SG_OB + (tt * SG_OBS + c8 + 4) * 4);
                float uu[8], y[8]; unpack8(ul[j], uu);
                y[0] = (o0.x + bias) * uu[0]; y[1] = (o0.y + bias) * uu[1]; y[2] = (o0.z + bias) * uu[2]; y[3] = (o0.w + bias) * uu[3];
                y[4] = (o1.x + bias) * uu[4]; y[5] = (o1.y + bias) * uu[5]; y[6] = (o1.z + bias) * uu[6]; y[7] = (o1.w + bias) * uu[7];
                *(v4u*)(yc + (row0 + tt) * 512 + g * 128 + c8) = pack8(y); }
        }
        __syncthreads();
    }
}

__device__ __forceinline__ void p_norm_router(Frame& F, KArgs ka, const void* x, const float* w, const float* mod_l, bf16* h2) {
    const float* rw = ka->in[20]; const float* rb = ka->in[21]; unsigned* ctl = (unsigned*)(ka->ws + WS_CTL);
    float* topp = (float*)(ka->ws + WS_TOPP); int* list = (int*)(ka->ws + WS_LIST);
    LAS float* RWt = (LAS float*)F.lds;
    LAS int* lcnt = (LAS int*)(RWt + 8192);
    LAS int* lbase = lcnt + 16;
    LAS int* sel = lbase + 16;
    LAS int* rnk = sel + 128;
    for (int i = F.tid; i < D * NE; i += NT) { const int k = i >> 3, e = i & 7; RWt[e * D + k] = rw[i]; }
    __syncthreads();
    float rbv[8];
#pragma unroll
    for (int e = 0; e < 8; ++e) rbv[e] = rb[e];
    f32x4 wv[4];
#pragma unroll
    for (int j = 0; j < 4; ++j) wv[j] = ((const f32x4*)w)[F.lane + 64 * j];
    for (int batch = F.bid; batch < M / 128; batch += F.G) {
        const int row0 = batch * 128;
        if (F.tid < 16) lcnt[F.tid] = 0;
        const float* mb = mod_l + (size_t)(row0 >> 12) * MOD_LD;
        f32x4 scv[4], shv[4], xn[4];
#pragma unroll
        for (int j = 0; j < 4; ++j) { scv[j] = ((const f32x4*)(mb + 4 * D))[F.lane + 64 * j]; shv[j] = ((const f32x4*)(mb + 3 * D))[F.lane + 64 * j]; xn[j] = load_x4<true>(x, (size_t)(row0 + F.wave * 16), F.lane, j); }
        asm volatile("" ::: "memory");
#pragma unroll
        for (int j = 0; j < 4; ++j) scv[j] = wv[j] * (scv[j] + 1.0f);
        __syncthreads();
        for (int rr = 0; rr < 16; ++rr) {
            const int r = F.wave * 16 + rr, row = row0 + r;
            f32x4 v[4];
#pragma unroll
            for (int j = 0; j < 4; ++j) v[j] = xn[j];
            if (rr + 1 < 16) {
#pragma unroll
                for (int j = 0; j < 4; ++j) xn[j] = load_x4<true>(x, (size_t)(row + 1), F.lane, j); }
            float ssq = 0.f;
#pragma unroll
            for (int j = 0; j < 4; ++j) ssq += (v[j].x * v[j].x + v[j].y * v[j].y) + (v[j].z * v[j].z + v[j].w * v[j].w);
            const float rstd = 1.0f / sqrtf(wave_sum(ssq, F.lane) * (1.0f / D) + EPS);
            f32x4 o[4];
#pragma unroll
            for (int j = 0; j < 4; ++j) o[j] = v[j] * rstd * scv[j] + shv[j];
            { unsigned* o4 = (unsigned*)((unsigned char*)h2 + (size_t)row * D) + F.lane;
#pragma unroll
                for (int j = 0; j < 4; ++j) { const f32x4 q = (Q_MUP == 2) ? rot64(o[j], F.lane) : o[j]; o4[64 * j] = pk4_q<Q_MUP>(q.x * sa_of(Q_MUP, CLIP_MOE), q.y * sa_of(Q_MUP, CLIP_MOE), q.z * sa_of(Q_MUP, CLIP_MOE), q.w * sa_of(Q_MUP, CLIP_MOE)); } }
            float lg[8];
#pragma unroll
            for (int e = 0; e < 8; ++e) { float s = 0.f;
#pragma unroll
                for (int j = 0; j < 4; ++j) { const f32x4 r4 = *(const LAS f32x4*)(RWt + e * D + 4 * F.lane + 256 * j); s += (o[j].x * r4.x + o[j].y * r4.y) + (o[j].z * r4.z + o[j].w * r4.w); }
                lg[e] = wave_sum(s, F.lane) + rbv[e]; }
            int i0 = 0; float v0 = lg[0];
#pragma unroll
            for (int e = 1; e < 8; ++e) if (lg[e] > v0) { v0 = lg[e]; i0 = e; }
            int i1 = -1; float v1 = -3.0e38f;
#pragma unroll
            for (int e = 0; e < 8; ++e) if (e != i0 && lg[e] > v1) { v1 = lg[e]; i1 = e; }
            if (F.lane == 0) {
                const float p0 = 1.0f / (1.0f + expf(v1 - v0));
                topp[(size_t)row * 2] = p0; topp[(size_t)row * 2 + 1] = 1.0f - p0;
                const int rk0 = __hip_atomic_fetch_add(lcnt + i0, 1, __ATOMIC_RELAXED, __HIP_MEMORY_SCOPE_WORKGROUP), rk1 = __hip_atomic_fetch_add(lcnt + 8 + i1, 1, __ATOMIC_RELAXED, __HIP_MEMORY_SCOPE_WORKGROUP);
                sel[r] = i0 | (i1 << 8); rnk[r] = rk0 | (rk1 << 16);
            }
        }
        __syncthreads();
        if (F.tid < 16) lbase[F.tid] = (int)__hip_atomic_fetch_add(ctl + CW_CNT + 64 * F.tid, (unsigned)lcnt[F.tid], __ATOMIC_RELAXED, __HIP_MEMORY_SCOPE_AGENT);
        __syncthreads();
        if (F.tid < 128) { const int sv = sel[F.tid], rv = rnk[F.tid]; const int e0 = sv & 255, e1 = sv >> 8;
            list[(size_t)e0 * LIST_CAP + lbase[e0] + (rv & 0xffff)] = row0 + F.tid;
            list[(size_t)(8 + e1) * LIST_CAP + lbase[8 + e1] + (rv >> 16)] = row0 + F.tid; }
        __syncthreads();
    }
}
__device__ __forceinline__ void moe_tables(Frame& F, unsigned* ctl, int pass) {
    LAS int* tab = (LAS int*)(F.lds + TAB_OFF) + pass * 256;
    __syncthreads();
    if (F.tid == 0) { int pb = 0;
        for (int e = 0; e < 8; ++e) { int c = (int)__hip_atomic_load(ctl + CW_CNT + 64 * (pass * 8 + e), __ATOMIC_RELAXED, __HIP_MEMORY_SCOPE_AGENT); if (c > LIST_CAP) c = LIST_CAP; if (c < 0) c = 0;
            const int np = (c + 255) >> 8; tab[e] = c; tab[8 + e] = pb; for (int p = 0; p < np; ++p) tab[32 + pb + p] = e; pb += np; }
        tab[16] = pb; }
    __syncthreads();
}
template <bool GATHER_>
struct MoeOrder {
    static constexpr bool GATHER = GATHER_;
    pg8::StaticOrder so; const LAS int* tab; const int* list; int npn; unsigned rowbytes;
    int T = 0, HC = 0;
    __device__ __forceinline__ bool next(int i, pg8::Unit& u) const {
        const int G = so.G, c = so.c; long L;
        if (T == 0) L = (long)i * G + c;
        else if (c >= T) L = (i < HC) ? (long)i * (G - T) + (c - T) : (long)HC * (G - T) + (long)(i - HC) * G + c;
        else L = (long)HC * (G - T) + (long)i * G + c;
        if (!so.unit_of(L, u)) return false; u.pb = tab[32 + u.pm] * npn + u.pn; return true; }
    __device__ __forceinline__ int tok_of(int pm, int r) const { const int e = tab[32 + pm]; const int idx = (pm - tab[8 + e]) * 256 + r; return idx < tab[e] ? list[(size_t)e * LIST_CAP + idx] : -1; }
    __device__ __forceinline__ unsigned a_row_off(const pg8::Unit& u, int r) const { const int t = tok_of(u.pm, r); return (unsigned)(t < 0 ? 0 : t) * rowbytes; }
};

template <bool GU8>
struct EpiBranch {
    static constexpr bool PERM = true;
    const bf16* gate; bf16* mrg;
    __device__ __forceinline__ void operator()(const pg8::f32x4 (&acc)[2][2][4][2], const pg8::Unit& u, int wr, int wc, int fr, int fq) const {
        typedef unsigned v2u_ __attribute__((ext_vector_type(2)));
        const int row0 = u.pm * 256 + wr * 64 + fr, col0 = u.pn * 256 + wc * 32 + 8 * fq + u.aux * D;
        const int first = (u.aux == 0), mshift = u.aux * D;
        v4u gl[2][2][2], ml[2][2][2];
#define EB_LOAD(q) do { _Pragma("unroll") for (int mm_ = 0; mm_ < 2; ++mm_) _Pragma("unroll") for (int bj = 0; bj < 2; ++bj) { \
            const size_t row = (size_t)(row0 + ((q) >> 1) * 128 + (((q) & 1) * 2 + mm_) * 16); const int col = col0 + bj * 128; \
            if constexpr (GU8) { const v2u_ g2 = *(const v2u_*)((const unsigned char*)gate + row * N_G + col); gl[(q) & 1][mm_][bj].x = g2.x; gl[(q) & 1][mm_][bj].y = g2.y; } else gl[(q) & 1][mm_][bj] = *(const v4u*)(gate + row * N_G + col); \
            ml[(q) & 1][mm_][bj] = first ? (v4u){0u, 0u, 0u, 0u} : *(const v4u*)(mrg + row * D + col - mshift); } asm volatile("" ::: "memory"); } while (0)
        EB_LOAD(0);
#pragma unroll
        for (int q = 0; q < 4; ++q) {
            if (q < 3) EB_LOAD(q + 1);
            const int ai = q >> 1;
#pragma unroll
            for (int mm_ = 0; mm_ < 2; ++mm_)
#pragma unroll
                for (int bj = 0; bj < 2; ++bj) { const int m = (q & 1) * 2 + mm_; const size_t row = (size_t)(row0 + ai * 128 + m * 16); const int col = col0 + bj * 128;
                    float gg[8], mm[8], o[8]; unpack8(ml[q & 1][mm_][bj], mm);
                    if constexpr (GU8) {
#pragma unroll
                        for (int i = 0; i < 4; ++i) { gg[i] = (float)((gl[q & 1][mm_][bj].x >> (8 * i)) & 0xffu) * (1.0f / 255.0f); gg[4 + i] = (float)((gl[q & 1][mm_][bj].y >> (8 * i)) & 0xffu) * (1.0f / 255.0f); } }
                    else { unpack8(gl[q & 1][mm_][bj], gg);
#pragma unroll
                        for (int i = 0; i < 8; ++i) gg[i] = sigmoidf_(gg[i]); }
                    const pg8::f32x4 v0 = acc[ai][bj][m][0], v1 = acc[ai][bj][m][1];
                    o[0] = mm[0] + gg[0] * v0[0]; o[1] = mm[1] + gg[1] * v0[1]; o[2] = mm[2] + gg[2] * v0[2]; o[3] = mm[3] + gg[3] * v0[3];
                    o[4] = mm[4] + gg[4] * v1[0]; o[5] = mm[5] + gg[5] * v1[1]; o[6] = mm[6] + gg[6] * v1[2]; o[7] = mm[7] + gg[7] * v1[3];
                    *(v4u*)(mrg + row * D + col - mshift) = pack8(o); }
            asm volatile("" ::: "memory");
        }
#undef EB_LOAD
    }
};
template <int Q>
struct EpiGateU8 {
    static constexpr bool PERM = true;
    unsigned char* O; float scale;
    __device__ __forceinline__ void operator()(const pg8::f32x4 (&acc)[2][2][4][2], const pg8::Unit& u, int wr, int wc, int fr, int fq) const {
        typedef unsigned v2u_ __attribute__((ext_vector_type(2)));
        const int row0 = u.pm * 256 + wr * 64 + fr, col0 = u.pn * 256 + wc * 32 + 8 * fq;
#pragma unroll
        for (int ai = 0; ai < 2; ++ai)
#pragma unroll
            for (int m = 0; m < 4; ++m) { unsigned char* rowp = O + (size_t)(row0 + ai * 128 + m * 16) * N_G + col0;
#pragma unroll
                for (int bj = 0; bj < 2; ++bj) { v2u_ w;
#pragma unroll
                    for (int n = 0; n < 2; ++n) { const pg8::f32x4 v = acc[ai][bj][m][n]; unsigned p = 0u;
#pragma unroll
                        for (int i = 0; i < 4; ++i) p |= (unsigned)(sigmoidf_(accf<Q>(v[i]) * scale) * 255.0f + 0.5f) << (8 * i);
                        if (n == 0) w.x = p; else w.y = p; }
                    *(v2u_*)(rowp + bj * 128) = w; } }
    }
};
template <bool IN_F32, int QI = 0>
struct EpiResid {
    static constexpr bool PERM = true;
    const void* xin; bf16* xout; const float* gmod; float oscale;
    __device__ __forceinline__ void operator()(const pg8::f32x4 (&acc)[2][2][4][2], const pg8::Unit& u, int wr, int wc, int fr, int fq) const {
        const int row0 = u.pm * 256 + wr * 64 + fr, col0 = u.pn * 256 + wc * 32 + 8 * fq;
        const float* gb = gmod + (size_t)((u.pm * 256) >> 12) * MOD_LD + col0;
        pg8::f32x4 gv[2][2];
#pragma unroll
        for (int bj = 0; bj < 2; ++bj)
#pragma unroll
            for (int n = 0; n < 2; ++n) gv[bj][n] = *(const pg8::f32x4*)(gb + bj * 128 + n * 4) * oscale;
        constexpr int NB = 2;
#pragma unroll
        for (int b = 0; b < NB; ++b) {
            pg8::f32x4 xl[2 / NB][4][2][2];
#pragma unroll
            for (int a = 0; a < 2 / NB; ++a)
#pragma unroll
            for (int m = 0; m < 4; ++m)
#pragma unroll
                for (int bj = 0; bj < 2; ++bj) { const int ai = b * (2 / NB) + a; const size_t row = (size_t)(row0 + ai * 128 + m * 16); const int col = col0 + bj * 128;
                    if constexpr (IN_F32) { xl[a][m][bj][0] = *(const pg8::f32x4*)((const float*)xin + row * D + col); xl[a][m][bj][1] = *(const pg8::f32x4*)((const float*)xin + row * D + col + 4); }
                    else { const v4u w = *(const v4u*)((const bf16*)xin + row * XLD + col); xl[a][m][bj][0] = __builtin_bit_cast(pg8::f32x4, w); } }
            asm volatile("" ::: "memory");
#pragma unroll
            for (int a = 0; a < 2 / NB; ++a)
#pragma unroll
            for (int m = 0; m < 4; ++m)
#pragma unroll
                for (int bj = 0; bj < 2; ++bj) { const int ai = b * (2 / NB) + a; const size_t row = (size_t)(row0 + ai * 128 + m * 16); const int col = col0 + bj * 128;
                    pg8::f32x4 x0, x1;
                    if constexpr (IN_F32) { x0 = xl[a][m][bj][0]; x1 = xl[a][m][bj][1]; }
                    else { const v4u w = __builtin_bit_cast(v4u, xl[a][m][bj][0]); x0 = (pg8::f32x4){bf_lo(w.x), bf_hi(w.x), bf_lo(w.y), bf_hi(w.y)}; x1 = (pg8::f32x4){bf_lo(w.z), bf_hi(w.z), bf_lo(w.w), bf_hi(w.w)}; }
                    pg8::f32x4 c0 = acc[ai][bj][m][0], c1 = acc[ai][bj][m][1];
                    if constexpr (QI == 2) {
#pragma unroll
                        for (int i = 0; i < 4; ++i) { c0[i] = (float)__float_as_int(c0[i]); c1[i] = (float)__float_as_int(c1[i]); } }
                    const pg8::f32x4 o0 = x0 + gv[bj][0] * c0, o1 = x1 + gv[bj][1] * c1;
                    v4u w; w.x = pk2(o0[0], o0[1]); w.y = pk2(o0[2], o0[3]); w.z = pk2(o1[0], o1[1]); w.w = pk2(o1[2], o1[3]);
                    *(v4u*)(xout + row * XLD + col) = w; }
            asm volatile("" ::: "memory");
        }
    }
};
template <int QIN = 0, int QOUT = 0>
struct EpiSwiglu {
    static constexpr bool PERM = true;
    bf16* act; float inv;
    __device__ __forceinline__ void operator()(const pg8::f32x4 (&acc)[2][2][4][2], const pg8::Unit& u, int wr, int wc, int fr, int fq) const {
        const int row0 = u.pm * 256 + wr * 64 + fr, col0 = u.pn * 128 + wc * 32 + 8 * fq;
#pragma unroll
        for (int ai = 0; ai < 2; ++ai)
#pragma unroll
            for (int m = 0; m < 4; ++m) { float o[8];
#pragma unroll
                for (int n = 0; n < 2; ++n)
#pragma unroll
                    for (int i = 0; i < 4; ++i) { const float a1 = QIN ? accf<QIN>(acc[ai][0][m][n][i]) * inv : acc[ai][0][m][n][i], a3 = QIN ? accf<QIN>(acc[ai][1][m][n][i]) * inv : acc[ai][1][m][n][i];
                        o[n * 4 + i] = siluf_(a1) * a3 * (QOUT ? F8_SACT : 1.0f); }
                if constexpr (QOUT != 0) { typedef unsigned v2u_ __attribute__((ext_vector_type(2))); v2u_ w8; w8.x = pk4_q<1>(o[0], o[1], o[2], o[3]); w8.y = pk4_q<1>(o[4], o[5], o[6], o[7]);
                    *(v2u_*)((unsigned char*)act + (size_t)(row0 + ai * 128 + m * 16) * D_FF + col0) = w8; }
                else *(v4u*)(act + (size_t)(row0 + ai * 128 + m * 16) * D_FF + col0) = pack8(o); }
    }
};
struct EpiMoeDown {
    static constexpr bool PERM = true;
    bf16* x; const float* gmod; const float* topp; int pass; const LAS int* tab; const int* list; float oscale;
    __device__ __forceinline__ int tok_of(int pm, int r) const { const int e = tab[32 + pm]; const int idx = (pm - tab[8 + e]) * 256 + r; return idx < tab[e] ? list[(size_t)e * LIST_CAP + idx] : -1; }
    __device__ __forceinline__ void operator()(const pg8::f32x4 (&acc)[2][2][4][2], const pg8::Unit& u, int wr, int wc, int fr, int fq) const {
        const int col0 = u.pn * 256 + wc * 32 + 8 * fq;
        int tok[2][4];
#pragma unroll
        for (int ai = 0; ai < 2; ++ai)
#pragma unroll
            for (int m = 0; m < 4; ++m) tok[ai][m] = tok_of(u.pm, ai * 128 + wr * 64 + m * 16 + fr);
        asm volatile("" ::: "memory");
#pragma unroll
        for (int am = 0; am < 4; ++am) {
            const int ai = am >> 1, mb = (am & 1) * 2;
            v4u xl[2][2]; pg8::f32x4 gl[2][2][2]; float pv[2];
#pragma unroll
            for (int m = 0; m < 2; ++m) { const int t = tok[ai][mb + m] < 0 ? 0 : tok[ai][mb + m]; pv[m] = topp[(size_t)t * 2 + pass] * oscale; const float* gb = gmod + (size_t)(t >> 12) * MOD_LD + col0;
#pragma unroll
                for (int bj = 0; bj < 2; ++bj) { xl[m][bj] = *(const v4u*)(x + (size_t)t * XLD + col0 + bj * 128);
#pragma unroll
                    for (int n = 0; n < 2; ++n) gl[m][bj][n] = *(const pg8::f32x4*)(gb + bj * 128 + n * 4); } }
            asm volatile("" ::: "memory");
#pragma unroll
            for (int m = 0; m < 2; ++m) { if (tok[ai][mb + m] >= 0) { const int t = tok[ai][mb + m];
#pragma unroll
                for (int bj = 0; bj < 2; ++bj) { const v4u w = xl[m][bj];
                    const pg8::f32x4 x0 = {bf_lo(w.x), bf_hi(w.x), bf_lo(w.y), bf_hi(w.y)}, x1 = {bf_lo(w.z), bf_hi(w.z), bf_lo(w.w), bf_hi(w.w)};
                    pg8::f32x4 c0 = acc[ai][bj][mb + m][0], c1 = acc[ai][bj][mb + m][1];
                    const pg8::f32x4 o0 = x0 + gl[m][bj][0] * pv[m] * c0, o1 = x1 + gl[m][bj][1] * pv[m] * c1;
                    v4u r; r.x = pk2(o0[0], o0[1]); r.y = pk2(o0[2], o0[3]); r.z = pk2(o1[0], o1[1]); r.w = pk2(o1[2], o1[3]);
                    *(v4u*)(x + (size_t)t * XLD + col0 + bj * 128) = r; } } }
            asm volatile("" ::: "memory");
        }
    }
};

__device__ __forceinline__ void p_final_norm(Frame& F, float* x, const float* w) {
    const int gw = F.bid * NWAVES + F.wave, NGW = F.G * NWAVES, lane = F.lane;
    f32x4 wv[4];
#pragma unroll
    for (int j = 0; j < 4; ++j) wv[j] = ((const f32x4*)w)[lane + 64 * j];
    for (int r0 = gw * 4; r0 < M; r0 += NGW * 4) {
        f32x4 v[4][4];
#pragma unroll
        for (int r = 0; r < 4; ++r)
#pragma unroll
            for (int j = 0; j < 4; ++j) v[r][j] = load_x4<true>(x, (size_t)(r0 + r), lane, j);
        asm volatile("s_waitcnt vmcnt(0)" ::: "memory");
#pragma unroll
        for (int r = 0; r < 4; ++r) { float s = 0.f;
#pragma unroll
            for (int j = 0; j < 4; ++j) s += (v[r][j].x * v[r][j].x + v[r][j].y * v[r][j].y) + (v[r][j].z * v[r][j].z + v[r][j].w * v[r][j].w);
            const float rstd = 1.0f / sqrtf(wave_sum(s, lane) * (1.0f / D) + EPS);
#pragma unroll
            for (int j = 0; j < 4; ++j) ((f32x4*)(x + (size_t)(r0 + r) * D))[lane + 64 * j] = v[r][j] * rstd * wv[j]; }
    }
}
__device__ __forceinline__ bool fresh(Frame& F) {
    int w_ = F.w0, b_ = blockIdx.x, g_ = gridDim.x; asm volatile("" : "+s"(w_), "+s"(b_), "+s"(g_));
    int l_; asm volatile("v_mbcnt_lo_u32_b32 %0, -1, 0\n\tv_mbcnt_hi_u32_b32 %0, -1, %0" : "=v"(l_));
    int t_ = w_ * 64 + l_;
    F.tid = t_; F.lane = t_ & 63; F.wave = __builtin_amdgcn_readfirstlane(t_ >> 6); F.bid = b_; F.G = g_; return true;
}
constexpr int NPL = 13, NPHASE = 1 + DEPTH * NPL;
#if MK_PER_PHASE
#define GRID_BAR() do { } while (0)
#else
#define GRID_BAR() do { XcdBarrier b2_ = bar; asm volatile("" : "+s"(b2_.bar)); xcd_barrier(b2_); } while (0)
#endif
#ifdef ONLY_REL
#define IN(k) (KA()->ph_lo <= (k) && (k) < KA()->ph_hi && fresh(F) && ((k) == 0 ? 100 : ((k) - 1) % NPL) == ONLY_REL && (ONLY_L < 0 || ((k) - 1) / NPL == ONLY_L))
#else
#define IN(k) (KA()->ph_lo <= (k) && (k) < KA()->ph_hi && fresh(F))
#endif
#define SEAM(k) do { if ((k) + 1 < KA()->ph_hi) GRID_BAR(); } while (0)
template <int l>
__device__ __forceinline__ void layer_program(Frame& F, const XcdBarrier& bar, PG8_LAS unsigned char* ring) {
        const int pb = 1 + l * NPL;
#define WSP(off) (ka->ws + (off))
#define MODL ((const float*)WSP(WS_MOD) + (size_t)l * BATCH * MOD_LD)
#define WMIXL ((bf16*)WSP(WS_WMIX))
        if (IN(pb + 0)) {
#pragma unroll 1
          for (int rep = 0; rep < REPS(7); ++rep) { KArgs ka = KA(); p_norm<HQ_MIX == 0 ? 0 : (H_BF ? 2 : 1), l != 0, HQ_MIX ? HQ_MIX : 2>(F, l == 0 ? (const void*)ka->in[0] : (const void*)ka->out, ka->in[4] + l * D, MODL, 1 * D, 0, (HQ_MIX && !H_BF) ? (bf16*)WSP(WS_H8) : (bf16*)WSP(WS_H), WSP(WS_H8), sa_of(HQ_MIX, l == 0 ? CLIP_MIX0 : CLIP_MIX1)); }
          SEAM(pb + 0); }
        if (IN(pb + 1)) {
            KArgs ka = KA();
            constexpr int KD = Q_PROJ ? D / 2 : D;
            pg8::Gemm g{Q_PROJ ? (bf16*)WSP(WS_H8) : (bf16*)WSP(WS_H), WMIXL, KD, KD, KD}; pg8::StaticOrder S; S.init(M / 256, N_BCA / 256, F.G, F.bid);
            pg8::EpiBf16<Q_PROJ> E{(bf16*)WSP(WS_P1), N_BCA, (Q_PROJ ? 1.0f / (sa_of(Q_PROJ, l == 0 ? CLIP_MIX0 : CLIP_MIX1) * (Q_PROJ == 2 ? ((const float*)WSP(WS_QS))[QS_IN] : F8_SW)) : 1.0f) / (float)REPS(8)};
#pragma unroll 1
            for (int rep = 0; rep < REPS(3); ++rep)
            pg8::gemm_phase<REPS(8), Q_PROJ>(ring, g, S, E, F.tid); SEAM(pb + 1);
        }
        if (IN(pb + 2)) {
#define THIN_H1() { KArgs ka = KA(); p_hgrn<1>(F, (const bf16*)WSP(WS_P1), ka->in[8], l, ka->in[9] + l * D_BV, (bf16*)WSP(WS_YB), (float*)WSP(WS_HU), (float*)WSP(WS_HD)); }
#define THIN_SC() { { KArgs ka = KA(); p_sgu(F, (const bf16*)WSP(WS_P1), ka->in[10] + l * D_C, ka->in[11] + (size_t)l * 4 * 128 * 128, ka->in[12] + l * 4 * 128, (bf16*)WSP(WS_YC)); } \
                    { KArgs ka = KA(); p_conv(F, (const bf16*)WSP(WS_P1), ka->in[7] + l * 3 * D_A, (bf16*)WSP(WS_YA)); } }
#pragma unroll 1
          for (int rep = 0; rep < REPS(1); ++rep) {
            __syncthreads();
            if ((F.bid >> 3) & 1) { THIN_H1(); __syncthreads(); fresh(F); THIN_SC(); }
            else { THIN_SC(); __syncthreads(); fresh(F); THIN_H1(); }
          }
#undef THIN_H1
#undef THIN_SC
            SEAM(pb + 2);
        }
        if (IN(pb + 3)) {
#pragma unroll 1
          for (int rep = 0; rep < REPS(2); ++rep)
            { KArgs ka = KA(); p_hgrn<2>(F, (const bf16*)WSP(WS_P1), ka->in[8], l, ka->in[9] + l * D_BV, (bf16*)WSP(WS_YB), (float*)WSP(WS_HU), (float*)WSP(WS_HD)); }
            SEAM(pb + 3);
        }
        if (IN(pb + 5)) {
            { KArgs ka = KA();
              pg8::GateOrder S; S.so.init(M / 256, D / 256, F.G, F.bid);
              if constexpr (Q_GATE != 0) { pg8::Gemm g{(bf16*)WSP(WS_H8), (bf16*)WSP(WS_WMIX + WMIX_G8), D / 2, D / 2, D / 2};
                  EpiGateU8<Q_GATE> E{(unsigned char*)WSP(WS_PG), 1.0f / (sa_of(Q_GATE, l == 0 ? CLIP_MIX0 : CLIP_MIX1) * (Q_GATE == 2 ? ((const float*)WSP(WS_QS))[QS_IN] : F8_SW))};
                  pg8::gemm_phase<1, Q_GATE>(ring, g, S, E, F.tid); }
              else { pg8::Gemm g{(bf16*)WSP(WS_H), WMIXL + (size_t)N_BCA * D, D, D, D};
                  pg8::EpiBf16<0> E{(bf16*)WSP(WS_PG), N_G, 1.0f};
                  pg8::gemm_phase(ring, g, S, E, F.tid); } }
            { KArgs ka = KA();
              pg8::Gemm g{(bf16*)WSP(WS_YA), WMIXL + (size_t)N_IN * D, 512, 512, 512, (size_t)32 * MiB, (size_t)512 * 1024 * 2}; pg8::BranchOrder S; S.so.init(M / 256, D / 256, F.G, F.bid);
              EpiBranch<Q_GATE != 0> E{(const bf16*)WSP(WS_PG), (bf16*)WSP(WS_MRG)};
              pg8::gemm_phase(ring, g, S, E, F.tid); }
            SEAM(pb + 5);
        }
        if (IN(pb + 6)) {
            KArgs ka = KA();
            pg8::Gemm g{(bf16*)WSP(WS_MRG), WMIXL + (size_t)N_IN * D + 3 * 512 * 1024, D, D, D}; pg8::StaticOrder S; S.init(M / 256, D / 256, F.G, F.bid);
            EpiResid<l == 0> E{l == 0 ? (const void*)ka->in[0] : (const void*)ka->out, (bf16*)ka->out, MODL + 2 * D, 1.0f};
            pg8::gemm_phase(ring, g, S, E, F.tid); SEAM(pb + 6);
        }
        if (l == 0) {
            constexpr int FES = Q_FUP ? 1 : 2, FDS = Q_FDN ? 1 : 2;
            if (IN(pb + 7)) { KArgs ka = KA(); p_norm<Q_FUP ? 1 : 0, true, Q_FUP ? Q_FUP : 2>(F, (const void*)ka->out, ka->in[5] + l * D, MODL, 4 * D, 3 * D, (bf16*)WSP(WS_H), nullptr, sa_of(Q_FUP, CLIP_FFN)); __syncthreads(); p_convert_mixer(F, KA(), 1, false);     SEAM(pb + 7); }
            if (IN(pb + 8)) {
                KArgs ka = KA();
                pg8::Gemm g{(bf16*)WSP(WS_H), (bf16*)WSP(WS_W13), D * FES / 2, D * FES / 2, D * FES / 2}; pg8::StaticOrder S; S.init(M / 256, N13 / 256, F.G, F.bid);
                EpiSwiglu<Q_FUP, Q_FDN> E{(bf16*)WSP(WS_ACT), 1.0f / (sa_of(Q_FUP, CLIP_FFN) * ((const float*)WSP(WS_QS))[QS_F13])};
                pg8::gemm_phase<1, Q_FUP>(ring, g, S, E, F.tid); SEAM(pb + 8);
            }
            if (IN(pb + 9)) {
                KArgs ka = KA();
                pg8::Gemm g{(bf16*)WSP(WS_ACT), (bf16*)WSP(WS_W2), D_FF * FDS / 2, D_FF * FDS / 2, D_FF * FDS / 2}; pg8::StaticOrder S; S.init(M / 256, D / 256, F.G, F.bid);
                EpiResid<false, Q_FDN> E{(const void*)ka->out, (bf16*)ka->out, MODL + 5 * D, Q_FDN ? 1.0f / (F8_SACT * F8_SW) : 1.0f};
                pg8::gemm_phase<1, Q_FDN>(ring, g, S, E, F.tid); SEAM(pb + 9);
            }
        } else {
            if (IN(pb + 7)) {
#pragma unroll 1
                for (int rep = 0; rep < REPS(6); ++rep) { __syncthreads(); p_moe_weights(F, KA()); }
                __syncthreads(); { KArgs ka = KA(); p_norm_router(F, ka, (const void*)ka->out, ka->in[5] + l * D, MODL, (bf16*)WSP(WS_H2M)); } SEAM(pb + 7); }
            constexpr size_t ACT_BYTES = (size_t)MOE_ROWS * D_FF * MOE_ES;
#define MOE_UP(pass_, T_, HC_) do { KArgs ka = KA(); \
                    const LAS int* tab = (const LAS int*)(F.lds + TAB_OFF) + (pass_) * 256; \
                    MoeOrder<true> S; S.so.init(tab[16], N13 / 256, F.G, F.bid); S.tab = tab; S.list = (const int*)WSP(WS_LIST) + (size_t)(pass_) * 8 * LIST_CAP; S.npn = N13 / 256; S.rowbytes = D * MOE_ES; S.T = (T_); S.HC = (HC_); \
                    pg8::Gemm g{(bf16*)WSP(WS_H2M), (bf16*)WSP(WS_WM13), D * MOE_ES / 2, D * MOE_ES / 2, D * MOE_ES / 2}; \
                    EpiSwiglu<Q_MUP, Q_MDN> E{(bf16*)WSP(WS_ACTM + (pass_) * ACT_BYTES), 1.0f / (sa_of(Q_MUP, CLIP_MOE) * ((const float*)WSP(WS_QS))[QS_M13])}; \
                    pg8::gemm_phase<1, Q_MUP>(ring, g, S, E, F.tid); } while (0)
#define MOE_DOWN(pass_) do { KArgs ka = KA(); \
                    const LAS int* tab = (const LAS int*)(F.lds + TAB_OFF) + (pass_) * 256; \
                    MoeOrder<false> S; S.so.init(tab[16], D / 256, F.G, F.bid); S.tab = tab; S.list = (const int*)WSP(WS_LIST) + (size_t)(pass_) * 8 * LIST_CAP; S.npn = D / 256; S.rowbytes = 0; \
                    pg8::Gemm g{(bf16*)WSP(WS_ACTM + (pass_) * ACT_BYTES), (bf16*)WSP(WS_WM2), D_FF * MOE_ES / 2, D_FF * MOE_ES / 2, D_FF * MOE_ES / 2}; \
                    EpiMoeDown E{(bf16*)ka->out, MODL + 5 * D, (const float*)WSP(WS_TOPP), (pass_), tab, S.list, 1.0f / (F8_SACT * F8_SW)}; \
                    pg8::gemm_phase<1, Q_MDN>(ring, g, S, E, F.tid); } while (0)
            if (IN(pb + 8)) { { KArgs ka = KA(); moe_tables(F, (unsigned*)WSP(WS_CTL), 0); } MOE_UP(0, 0, 0); SEAM(pb + 8); }
            if (IN(pb + 9)) {
                { KArgs ka = KA(); moe_tables(F, (unsigned*)WSP(WS_CTL), 0); moe_tables(F, (unsigned*)WSP(WS_CTL), 1); }
                MOE_DOWN(0);
                { const LAS int* tab0 = (const LAS int*)(F.lds + TAB_OFF); const int nd = tab0[16] * (D / 256);
                  MOE_UP(1, nd % F.G, 3); }
                SEAM(pb + 9);
            }
            if (IN(pb + 11)) { { KArgs ka = KA(); moe_tables(F, (unsigned*)WSP(WS_CTL), 1); } MOE_DOWN(1); SEAM(pb + 11); }
#undef MOE_UP
#undef MOE_DOWN
            if (IN(pb + 12)) { KArgs ka = KA(); p_final_norm(F, ka->out, ka->in[25]); }
        }
}
__global__ void __launch_bounds__(NT, 2) fwd(Args args) {
    extern __shared__ __attribute__((aligned(16))) unsigned char lds[];
    Frame F;
    F.lds = (LAS unsigned char*)lds;
    F.tid = threadIdx.x; F.lane = F.tid & 63; F.wave = __builtin_amdgcn_readfirstlane(F.tid >> 6); F.w0 = F.wave;
    F.G = gridDim.x; F.bid = blockIdx.x;
    volatile LAS unsigned* MISC = (volatile LAS unsigned*)(F.lds + MISC_OFF);
    if (F.tid < 32) MISC[F.tid] = 0u;
    __syncthreads();
#if !MK_PER_PHASE
    XcdBarrier bar = xcd_barrier_post((unsigned*)(KA()->ws + WS_CTL) + CW_BAR, MISC + 8);
#else
    XcdBarrier bar; bar.bar = nullptr; bar.x = 0; bar.st = nullptr;
#endif
    PG8_LAS unsigned char* ring = (PG8_LAS unsigned char*)lds;

    if (IN(0)) {
#pragma unroll 1
        for (int rep = 0; rep < REPS(5); ++rep) { __syncthreads(); p_prologue(F, KA()); __syncthreads(); p_convert_mixer(F, KA(), 0, true); }
        SEAM(0); }

    layer_program<0>(F, bar, ring);
    layer_program<1>(F, bar, ring);
#undef IN
#undef SEAM
}

extern "C" void kernel_launch(void* const* d_in, const int* in_sizes, int n_in, void* d_out, int out_size, void* d_ws, size_t ws_size, hipStream_t stream) {
    static int grid = 0;
    if (grid == 0) {
        if (n_in != 26 || in_sizes[0] != M * D || out_size != M * D || ws_size < WS_NEED) { fprintf(stderr, "kernel_launch: unexpected shapes / workspace (n_in %d, ws %zu, need %zu); nothing launched\n", n_in, ws_size, (size_t)WS_NEED); grid = -1; return; }
        int dev = 0, cus = 0, per_cu = 0;
        if (hipGetDevice(&dev) != hipSuccess || hipDeviceGetAttribute(&cus, hipDeviceAttributeMultiprocessorCount, dev) != hipSuccess) { grid = -1; return; }
        if (hipFuncSetAttribute((const void*)fwd, hipFuncAttributeMaxDynamicSharedMemorySize, LDS_BYTES) != hipSuccess) { fprintf(stderr, "kernel_launch: hipFuncSetAttribute failed\n"); grid = -1; return; }
        if (hipOccupancyMaxActiveBlocksPerMultiprocessor(&per_cu, (const void*)fwd, NT, LDS_BYTES) != hipSuccess || per_cu < 1) fprintf(stderr, "kernel_launch: occupancy query reports %d\n", per_cu);
        (void)hipGetLastError();
        grid = cus;
    }
    if (grid < 0) return;
    if (hipMemsetAsync((char*)d_ws + WS_CTL, 0, CTL_ZERO_BYTES, stream) != hipSuccess) return;
    Args a{};
    for (int i = 0; i < 26; ++i) a.in[i] = (const float*)d_in[i];
    a.out = (float*)d_out; a.ws = (unsigned char*)d_ws;
#if MK_PER_PHASE
    for (int p = 0; p < NPHASE; ++p) {
        if ((p >= 1 + 10 && p <= 1 + 12) || p == 1 + 4 || p == 1 + NPL + 4 || p == 1 + NPL + 10) continue;
        a.ph_lo = p; a.ph_hi = p + 1;
        hipLaunchKernelGGL(fwd, dim3(grid), dim3(NT), LDS_BYTES, stream, a);
    }
#else
    a.ph_lo = 0; a.ph_hi = NPHASE;
    hipLaunchKernelGGL(fwd, dim3(grid), dim3(NT), LDS_BYTES, stream, a);
#endif
}
```

```cpp
#include <hip/hip_runtime.h>
#include <cstdio>
#include <cstdint>

#ifndef PROBE_DUP
#define PROBE_DUP 0
#endif
#ifndef PROBE_REPS
#define PROBE_REPS 2
#endif
#define REPS(k) ((PROBE_DUP == (k)) ? PROBE_REPS : 1)
#ifndef Q_PROJ
#define Q_PROJ 2
#endif
#ifndef Q_GATE
#define Q_GATE 2
#endif
#ifndef Q_FUP
#define Q_FUP 2
#endif
#ifndef Q_FDN
#define Q_FDN 2
#endif
#ifndef Q_MUP
#define Q_MUP 2
#endif
#ifndef Q_MDN
#define Q_MDN 2
#endif
#ifndef Q_BR
#define Q_BR 2
#endif
#ifndef Q_WO
#define Q_WO 2
#endif
#ifndef MK_PER_PHASE
#define MK_PER_PHASE 0
#endif

namespace pg8 {
#define PG8_LAS __attribute__((address_space(3)))
typedef unsigned short bf16_t;
typedef short bf16x8 __attribute__((ext_vector_type(8)));
typedef float f32x4 __attribute__((ext_vector_type(4)));
typedef unsigned u32x4 __attribute__((ext_vector_type(4)));
typedef int v4i32_ __attribute__((ext_vector_type(4)));
constexpr int BM = 256, BK = 64, HALF = 128, HTB = HALF * BK * 2, STAGE_BYTES = 8 * HTB, NXCD = 8, WGM = 8;

__host__ __device__ __forceinline__ int lds_byte(int r, int c) { const int st = (r >> 4) * 2 + (c >> 5), rr = r & 15, cc = c & 31, ob = rr * 64 + cc * 2; return st * 1024 + (ob ^ (((ob >> 9) & 1) << 5)); }
__host__ __device__ __forceinline__ void stage_rc(int b, int& R, int& C) { const int st = b / 1024, sb = b % 1024, swz = sb ^ (((sb >> 9) & 1) << 5); R = (st >> 1) * 16 + swz / 64; C = (st & 1) * 32 + (swz % 64) / 2; }
__host__ __device__ __forceinline__ int perm32(int rho) { const int n = rho >> 4, i = rho & 15; return 8 * (i >> 2) + 4 * n + (i & 3); }

struct Unit { int pm, pn, pb, aux; };
struct Gemm { const bf16_t* A; const bf16_t* Bt; int lda, ldb, K; size_t astride = 0, bstride = 0; };

struct StaticOrder {
    static constexpr bool GATHER = false;
    int nM, nN, nwg, G, c;
    __device__ __forceinline__ void init(int nM_, int nN_, int G_, int c_) { nM = nM_; nN = nN_; nwg = nM * nN; G = G_; c = c_; }
    __device__ __forceinline__ bool next(int i, Unit& u) const { return unit_of((long)i * G + c, u); }
    __device__ __forceinline__ bool unit_of(long L, Unit& u) const {
        if (L >= nwg) return false;
        int wgid = (int)L; { const int q = nwg / NXCD, r = nwg % NXCD, xcd = wgid % NXCD, off = wgid / NXCD; wgid = (xcd < r ? xcd * (q + 1) : r * (q + 1) + (xcd - r) * q) + off; }
        const int nig = WGM * nN, gid = wgid / nig, fm = gid * WGM, gsz = (nM - fm) < WGM ? (nM - fm) : WGM;
        u.pm = fm + ((wgid % nig) % gsz); u.pn = (wgid % nig) / gsz; u.pb = u.pn; u.aux = 0; return true;
    }
    __device__ __forceinline__ unsigned a_row_off(const Unit&, int) const { return 0u; }
};

struct GateOrder {
    static constexpr bool GATHER = false;
    StaticOrder so;
    __device__ __forceinline__ bool next(int k, Unit& u) const { Unit b; if (!so.next(k / 3, b)) return false; u.pm = b.pm; u.pn = b.pn + 4 * (k % 3); u.pb = u.pn; u.aux = 0; return true; }
    __device__ __forceinline__ unsigned a_row_off(const Unit&, int) const { return 0u; }
};
struct BranchOrder {
    static constexpr bool GATHER = false;
    StaticOrder so;
    __device__ __forceinline__ bool next(int k, Unit& u) const { Unit b; if (!so.next(k / 3, b)) return false; u.pm = b.pm; u.pn = b.pn; u.pb = b.pn; u.aux = k % 3; return true; }
    __device__ __forceinline__ unsigned a_row_off(const Unit&, int) const { return 0u; }
};
__device__ __forceinline__ unsigned cvt_pk_bf16(float lo, float hi) { unsigned r; asm volatile("v_cvt_pk_bf16_f32 %0, %1, %2" : "=v"(r) : "v"(lo), "v"(hi)); return r; }

template <int Q = 0>
struct EpiBf16 {
    static constexpr bool PERM = true;
    bf16_t* O; int ldc; float scale;
    __device__ __forceinline__ void operator()(const f32x4 (&acc)[2][2][4][2], const Unit& u, int wr, int wc, int fr, int fq) const {
        const int row0 = u.pm * BM + wr * 64 + fr, col0 = u.pn * BM + wc * 32 + 8 * fq;
#pragma unroll 1
        for (int erep = 0; erep < REPS(9); ++erep)
#pragma unroll
        for (int ai = 0; ai < 2; ++ai)
#pragma unroll
            for (int m = 0; m < 4; ++m) { bf16_t* rowp = O + (size_t)(row0 + ai * HALF + m * 16) * ldc + col0;
#pragma unroll
                for (int bj = 0; bj < 2; ++bj) { f32x4 v0 = acc[ai][bj][m][0], v1 = acc[ai][bj][m][1];
                    if constexpr (Q == 2) { v0 = __builtin_convertvector(__builtin_bit_cast(v4i32_, v0), f32x4); v1 = __builtin_convertvector(__builtin_bit_cast(v4i32_, v1), f32x4); }
                    v0 *= scale; v1 *= scale;
                    u32x4 w; w.x = cvt_pk_bf16(v0[0], v0[1]); w.y = cvt_pk_bf16(v0[2], v0[3]); w.z = cvt_pk_bf16(v1[0], v1[1]); w.w = cvt_pk_bf16(v1[2], v1[3]);
                    *(u32x4*)(rowp + bj * HALF) = w; } }
    }
};

typedef int v8i32 __attribute__((ext_vector_type(8)));
typedef int v4i32 __attribute__((ext_vector_type(4)));
template <int KREP = 1, int Q = 0, int MREP = 1, class Epi, class Sched>
__device__ __forceinline__ void gemm_phase(PG8_LAS unsigned char* lds, const Gemm g, const Sched& S, const Epi& E, int tid_in) {
    constexpr bool GATHER = Sched::GATHER;
    int tid_ = tid_in; asm volatile("" : "+v"(tid_));
    const int tid = tid_, wid = __builtin_amdgcn_readfirstlane(tid >> 6), lane = tid & 63, wr = wid >> 2, wc = wid & 3, fr = lane & 15, fq = lane >> 4;
    const int K = g.K, nt = K / BK;
    unsigned voffB[2], vA0[2], vA1[2], nA0[2], nA1[2];
#pragma unroll
    for (int i = 0; i < 2; ++i) { int R, C; stage_rc(tid * 16 + i * 8192, R, C); const int Rb = Epi::PERM ? ((R & ~31) + perm32(R & 31)) : R;
        voffB[i] = (unsigned)(Rb * g.ldb + C) * 2u;
        vA0[i] = (unsigned)(R * g.lda + C) * 2u; vA1[i] = vA0[i]; nA0[i] = vA0[i]; nA1[i] = vA0[i]; }
    const size_t kstep = (size_t)(BK * 2);
    const size_t hstepB = (size_t)HALF * g.ldb * 2, tstepB = 2 * hstepB, tstepA = (size_t)BM * g.lda * 2;
    const size_t hstepA = GATHER ? (size_t)0 : (size_t)HALF * g.lda * 2;
    const unsigned ldsw = (unsigned)wid * 1024u;
    const int aoff = lds_byte(wr * 64 + fr, fq * 8), boff = lds_byte(wc * 32 + fr, fq * 8);
    PG8_LAS unsigned char* aptr = lds + aoff; PG8_LAS unsigned char* bptr = lds + 4 * HTB + boff; asm volatile("" : "+v"(aptr), "+v"(bptr));
#define PG8_SA(b, h) (((b) * 2 + (h)) * HTB)
#define PG8_SB(b, h) ((4 + (b) * 2 + (h)) * HTB)
#define PG8_STAGE(bufoff, gbase, voff) do { _Pragma("unroll") for (int _i = 0; _i < 2; ++_i) \
        __builtin_amdgcn_global_load_lds((const unsigned*)((const char*)(gbase) + (voff)[_i]), (PG8_LAS unsigned*)(lds + (bufoff) + ldsw + _i * 8192), 16, 0, 0); } while (0)
#define PG8_CAT8(x0, x1) __builtin_shufflevector(__builtin_bit_cast(v4i32, x0), __builtin_bit_cast(v4i32, x1), 0, 1, 2, 3, 4, 5, 6, 7)
#define PG8_RDA(off) (*(const PG8_LAS bf16x8*)(aptr + (off)))
#define PG8_RDB(off) (*(const PG8_LAS bf16x8*)(bptr + (off)))
#define PG8_LDA(dst, b, h) do { if constexpr (Q == 1) { _Pragma("unroll") for (int m = 0; m < 4; ++m) dst##8[m] = PG8_CAT8(PG8_RDA(PG8_SA(b, h) + m * 2048), PG8_RDA(PG8_SA(b, h) + m * 2048 + 1024)); } \
        else { _Pragma("unroll") for (int m = 0; m < 4; ++m) _Pragma("unroll") for (int k = 0; k < 2; ++k) dst[m][k] = PG8_RDA(PG8_SA(b, h) + m * 2048 + k * 1024); } } while (0)
#define PG8_LDB(dst, b, h) do { if constexpr (Q == 1) { _Pragma("unroll") for (int n = 0; n < 2; ++n) dst##8[n] = PG8_CAT8(PG8_RDB(PG8_SB(b, h) - 4 * HTB + n * 2048), PG8_RDB(PG8_SB(b, h) - 4 * HTB + n * 2048 + 1024)); } \
        else { _Pragma("unroll") for (int n = 0; n < 2; ++n) _Pragma("unroll") for (int k = 0; k < 2; ++k) dst[n][k] = PG8_RDB(PG8_SB(b, h) - 4 * HTB + n * 2048 + k * 1024); } } while (0)
#define PG8_MMA(ai, bj, At, Bt) do { __builtin_amdgcn_s_setprio(1); _Pragma("unroll") for (int r_ = 0; r_ < MREP; ++r_) { \
        if constexpr (Q == 2) { _Pragma("unroll") for (int m = 0; m < 4; ++m) _Pragma("unroll") for (int n = 0; n < 2; ++n) _Pragma("unroll") for (int k = 0; k < 2; ++k) \
            acc[ai][bj][m][n] = __builtin_bit_cast(f32x4, __builtin_amdgcn_mfma_i32_16x16x64_i8(__builtin_bit_cast(v4i32, Bt[n][k]), __builtin_bit_cast(v4i32, At[m][k]), __builtin_bit_cast(v4i32, acc[ai][bj][m][n]), 0, 0, 0)); } \
        else if constexpr (Q == 1) { _Pragma("unroll") for (int m = 0; m < 4; ++m) _Pragma("unroll") for (int n = 0; n < 2; ++n) \
            asm volatile("v_mfma_scale_f32_16x16x128_f8f6f4 %0, %1, %2, %0, %3, %3 op_sel_hi:[0,0,0]" : "+v"(acc[ai][bj][m][n]) : "v"(Bt##8[n]), "v"(At##8[m]), "v"(sc1)); } \
        else { _Pragma("unroll") for (int m = 0; m < 4; ++m) _Pragma("unroll") for (int n = 0; n < 2; ++n) _Pragma("unroll") for (int k = 0; k < 2; ++k) \
            acc[ai][bj][m][n] = __builtin_amdgcn_mfma_f32_16x16x32_bf16(Bt[n][k], At[m][k], acc[ai][bj][m][n], 0, 0, 0); } } \
        __builtin_amdgcn_s_setprio(0); } while (0)
#define PG8_WAIT_V(n) asm volatile("s_waitcnt vmcnt(" #n ")" ::: "memory")
#define PG8_WAIT_L(n) asm volatile("s_waitcnt lgkmcnt(" #n ")" ::: "memory")
#define PG8_BAR __builtin_amdgcn_s_barrier()
#define PG8_SCHED __builtin_amdgcn_sched_barrier(0)
#define PG8_GOFF(unit, d0, d1) do { _Pragma("unroll") for (int _i = 0; _i < 2; ++_i) { int R_, C_; stage_rc(tid * 16 + _i * 8192, R_, C_); \
        d0[_i] = S.a_row_off(unit, R_) + (unsigned)C_ * 2u; d1[_i] = S.a_row_off(unit, R_ + HALF) + (unsigned)C_ * 2u; } } while (0)
    Unit cur, nxt; int ui = 0;
    if (!S.next(0, cur)) return;
    f32x4 acc[2][2][4][2];
#pragma unroll
    for (int a = 0; a < 2; ++a)
#pragma unroll
        for (int b = 0; b < 2; ++b)
#pragma unroll
            for (int m = 0; m < 4; ++m)
#pragma unroll
                for (int n = 0; n < 2; ++n) acc[a][b][m][n] = (f32x4){0.f, 0.f, 0.f, 0.f};
    bf16x8 At[4][2], B0[2][2], B1[2][2];
    v8i32 At8[4], B08[2], B18[2];
    const int sc1 = 0x7f7f7f7f;
    if constexpr (GATHER) { PG8_GOFF(cur, vA0, vA1); }
    const char* cA = GATHER ? (const char*)g.A : (const char*)g.A + (size_t)cur.aux * g.astride + (size_t)cur.pm * tstepA; const char* cB = (const char*)g.Bt + (size_t)cur.aux * g.bstride + (size_t)cur.pb * tstepB;
    PG8_STAGE(PG8_SB(0, 0), cB, voffB); PG8_STAGE(PG8_SB(0, 1), cB + hstepB, voffB); PG8_STAGE(PG8_SA(0, 0), cA, vA0); PG8_STAGE(PG8_SA(0, 1), cA + hstepA, vA1);
    if (wr == 1) PG8_BAR;
    PG8_WAIT_V(2); PG8_BAR;
    PG8_STAGE(PG8_SB(1, 0), cB + kstep, voffB); PG8_STAGE(PG8_SA(1, 0), cA + kstep, vA0); PG8_STAGE(PG8_SB(1, 1), cB + hstepB + kstep, voffB);
    PG8_WAIT_V(6); PG8_BAR;
    for (;;) {
        const bool has_next = S.next(ui + 1, nxt);
        const char* nA = GATHER ? (const char*)g.A : (has_next ? (const char*)g.A + (size_t)nxt.aux * g.astride + (size_t)nxt.pm * tstepA : cA); const char* nB = has_next ? (const char*)g.Bt + (size_t)nxt.aux * g.bstride + (size_t)nxt.pb * tstepB : cB;
        if constexpr (GATHER) { if (has_next) { PG8_GOFF(nxt, nA0, nA1); } else {
#pragma unroll
            for (int i = 0; i < 2; ++i) { nA0[i] = vA0[i]; nA1[i] = vA1[i]; } } }
#pragma unroll 1
        for (int t = 0; t < nt * KREP; t += 2) {
            const bool last = (t == nt * KREP - 2);
            const int t1 = (KREP == 1) ? t + 1 : ((t + 1) & (nt - 1)), t2 = (KREP == 1) ? t + 2 : ((t + 2) & (nt - 1));
            const char* a1 = cA + (size_t)t1 * kstep;
            const char* a2 = last ? nA : cA + (size_t)t2 * kstep; const char* b2 = last ? nB : cB + (size_t)t2 * kstep;
            const char* a3 = a2 + kstep; const char* b3 = b2 + kstep;
            unsigned s0[2], s1[2];
#pragma unroll
            for (int i = 0; i < 2; ++i) { s0[i] = (GATHER && last) ? nA0[i] : vA0[i]; s1[i] = GATHER ? (last ? nA1[i] : vA1[i]) : vA0[i]; }
            PG8_LDB(B0, 0, 0); PG8_LDB(B1, 0, 1); PG8_SCHED; PG8_LDA(At, 0, 0); PG8_STAGE(PG8_SA(1, 1), a1 + hstepA, vA1);
            PG8_WAIT_V(8); PG8_WAIT_L(0); PG8_BAR; PG8_MMA(0, 0, At, B0); PG8_MMA(0, 1, At, B1); PG8_BAR; PG8_SCHED;
            PG8_LDA(At, 0, 1); PG8_STAGE(PG8_SB(0, 0), b2, voffB); PG8_STAGE(PG8_SB(0, 1), b2 + hstepB, voffB); PG8_STAGE(PG8_SA(0, 0), a2, s0);
            PG8_WAIT_V(8); PG8_WAIT_L(0); PG8_BAR; PG8_MMA(1, 0, At, B0); PG8_MMA(1, 1, At, B1); PG8_BAR; PG8_SCHED;
            PG8_LDB(B0, 1, 0); PG8_LDB(B1, 1, 1); PG8_SCHED; PG8_LDA(At, 1, 0); PG8_STAGE(PG8_SA(0, 1), a2 + hstepA, s1);
            PG8_WAIT_V(8); PG8_WAIT_L(0); PG8_BAR; PG8_MMA(0, 0, At, B0); PG8_MMA(0, 1, At, B1); PG8_BAR; PG8_SCHED;
            PG8_LDA(At, 1, 1); PG8_STAGE(PG8_SB(1, 0), b3, voffB); PG8_STAGE(PG8_SB(1, 1), b3 + hstepB, voffB); PG8_STAGE(PG8_SA(1, 0), a3, s0);
            PG8_WAIT_V(8); PG8_WAIT_L(0); PG8_BAR; PG8_MMA(1, 0, At, B0); PG8_MMA(1, 1, At, B1); PG8_BAR; PG8_SCHED;
        }
        if (wr == 0) PG8_BAR;
        E(acc, cur, wr, wc, fr, fq);
        if (!has_next) break;
#pragma unroll
        for (int a = 0; a < 2; ++a)
#pragma unroll
            for (int b = 0; b < 2; ++b)
#pragma unroll
                for (int m = 0; m < 4; ++m)
#pragma unroll
                    for (int n = 0; n < 2; ++n) acc[a][b][m][n] = (f32x4){0.f, 0.f, 0.f, 0.f};
        cur = nxt; cA = nA; cB = nB; ++ui;
        if constexpr (GATHER) {
#pragma unroll
            for (int i = 0; i < 2; ++i) { vA0[i] = nA0[i]; vA1[i] = nA1[i]; } }
        if (wr == 1) PG8_BAR;
    }
    PG8_WAIT_V(0);
    PG8_BAR;
#undef PG8_SA
#undef PG8_SB
#undef PG8_STAGE
#undef PG8_LDA
#undef PG8_LDB
#undef PG8_MMA
#undef PG8_WAIT_V
#undef PG8_WAIT_L
#undef PG8_BAR
#undef PG8_SCHED
#undef PG8_GOFF
#undef PG8_CAT8
#undef PG8_RDA
#undef PG8_RDB
}
}

constexpr int D = 1024, BATCH = 8, SEQ = 4096, M = BATCH * SEQ, DEPTH = 2;
constexpr int D_A = 512, D_BK = 512, D_BV = 512, D_C = 512, H_B = 4;
constexpr int N_IN = 7680, N_BCA = 4608, N_G = 3072;
constexpr int D_FF = 2816, NE = 8, N13 = 2 * D_FF;
constexpr int MOD_LD = 6 * D;
constexpr float EPS = 1e-6f;
constexpr int XLD = 2 * D;
constexpr int LIST_CAP = M;
constexpr int MOE_ROWS = M + NE * 256;

constexpr size_t MiB = 1u << 20;
constexpr size_t WS_CTL = 0, CTL_ZERO_BYTES = 1 * MiB;
constexpr size_t WS_MOD = 1 * MiB;
constexpr size_t WS_TOPP = 2 * MiB;
constexpr size_t WS_QS = 2 * MiB + 768 * 1024;
constexpr size_t WS_LIST = 3 * MiB;
constexpr size_t WS_WMIX = 6 * MiB;
constexpr size_t WMIX_G8 = 9 * MiB;
constexpr size_t WS_W13 = 26 * MiB, WS_W2 = 37 * MiB;
constexpr size_t WS_BIG = 44 * MiB;
constexpr size_t WS_H = WS_BIG;
constexpr size_t WS_P1 = WS_BIG + 64 * MiB;
constexpr size_t WS_PG = WS_P1;
constexpr size_t WS_MRG = WS_P1 + 192 * MiB;
constexpr size_t WS_MRG8 = WS_P1 + 256 * MiB;
constexpr size_t WS_YA = WS_P1 + 288 * MiB, WS_YB = WS_YA + 32 * MiB, WS_YC = WS_YB + 32 * MiB;
constexpr size_t WS_ACT = WS_P1;
constexpr size_t WS_HU = WS_YC + 32 * MiB;
constexpr size_t WS_HD = WS_HU + 16 * MiB;
constexpr size_t WS_H8 = WS_HD + 1 * MiB;
constexpr size_t WS_MIX_END = WS_H8 + 32 * MiB;
static_assert((Q_PROJ == 0 || Q_GATE == 0 || Q_PROJ == Q_GATE) && Q_MDN != 0 && Q_MUP != 0, "supported operand encodings");
constexpr int HQ_MIX = Q_PROJ ? Q_PROJ : Q_GATE;
constexpr bool H_BF = (Q_PROJ == 0 || Q_GATE == 0);
constexpr float F8_SW = 64.0f, F8_SACT = 8.0f, W_CLIP = 4.0f;
#ifndef CLIP_MIX0
#define CLIP_MIX0 6.0f
#endif
#ifndef CLIP_MIX1
#define CLIP_MIX1 6.0f
#endif
#ifndef CLIP_FFN
#define CLIP_FFN 6.0f
#endif
#ifndef CLIP_MOE
#define CLIP_MOE 6.0f
#endif
#ifndef CLIP_YA
#define CLIP_YA 14.0f
#endif
#ifndef CLIP_YB
#define CLIP_YB 4.0f
#endif
#ifndef CLIP_YC
#define CLIP_YC 8.0f
#endif
#ifndef CLIP_ACT
#define CLIP_ACT 7.0f
#endif
#ifndef CLIP_MRG
#define CLIP_MRG 9.0f
#endif
__host__ __device__ constexpr float sa_of(int q, float clip) { return q == 2 ? 127.0f / clip : 4.0f; }
enum { QS_IN = 0, QS_F13 = 1, QS_F2 = 2, QS_M13 = 3, QS_BR = 4  , QS_WO = 7, QS_M2 = 8, QS_N = 16 };
constexpr int MOE_ES = 1;
constexpr size_t WS_WM13 = 6 * MiB;
constexpr size_t WS_WM2 = WS_WM13 + 88 * MiB;
constexpr size_t WS_H2M = WS_WM2 + 44 * MiB;
constexpr size_t WS_ACTM = WS_H2M + 64 * MiB;
constexpr size_t WS_MOE_END = WS_ACTM + 2 * (size_t)MOE_ROWS * D_FF * MOE_ES;
constexpr size_t WS_NEED = WS_MIX_END > WS_MOE_END ? WS_MIX_END : WS_MOE_END;
static_assert(WS_W2 + (size_t)D * D_FF * 2 <= WS_BIG && WS_WMIX + 20 * MiB <= WS_W13, "ws map");
constexpr int CW_BAR = 4096;
constexpr int CW_CNT = 16384;

constexpr int LDS_BYTES = 147456;
constexpr int SCR_BYTES = 139264;
constexpr int TAB_OFF = SCR_BYTES;
constexpr int MISC_OFF = TAB_OFF + 4096;
static_assert(MISC_OFF + 128 <= LDS_BYTES, "LDS map");
constexpr int NWAVES = 8, NT = 512;

#define GAS __attribute__((address_space(1)))
#define LAS __attribute__((address_space(3)))
typedef unsigned short bf16;
typedef unsigned v4u __attribute__((ext_vector_type(4)));
typedef float f32x4 __attribute__((ext_vector_type(4)));
#define LDS_WAIT() asm volatile("s_waitcnt lgkmcnt(0)" ::: "memory")
#define LDS_BARRIER() asm volatile("s_waitcnt lgkmcnt(0)\n\ts_barrier" ::: "memory")

typedef float f32x2_t __attribute__((ext_vector_type(2)));
typedef __bf16 bf16x2_t __attribute__((ext_vector_type(2)));
__device__ __forceinline__ unsigned pk2(float lo, float hi) { f32x2_t v = {lo, hi}; bf16x2_t b = __builtin_convertvector(v, bf16x2_t); return __builtin_bit_cast(unsigned, b); }
__device__ __forceinline__ float bf_lo(unsigned u) { return __uint_as_float(u << 16); }
__device__ __forceinline__ float bf_hi(unsigned u) { return __uint_as_float(u & 0xffff0000u); }
__device__ __forceinline__ void unpack8(const v4u w, float (&f)[8]) { f[0] = bf_lo(w.x); f[1] = bf_hi(w.x); f[2] = bf_lo(w.y); f[3] = bf_hi(w.y); f[4] = bf_lo(w.z); f[5] = bf_hi(w.z); f[6] = bf_lo(w.w); f[7] = bf_hi(w.w); }
__device__ __forceinline__ v4u pack8(const float (&f)[8]) { v4u w; w.x = pk2(f[0], f[1]); w.y = pk2(f[2], f[3]); w.z = pk2(f[4], f[5]); w.w = pk2(f[6], f[7]); return w; }
__device__ __forceinline__ float sigmoidf_(float x) { return __builtin_amdgcn_rcpf(1.0f + __expf(-x)); }
__device__ __forceinline__ float siluf_(float x) { return x * sigmoidf_(x); }
__device__ __forceinline__ float uni(float v) { return __int_as_float(__builtin_amdgcn_readfirstlane(__float_as_int(v))); }
template <int Q> __device__ __forceinline__ float accf(float v) { return (Q == 2) ? (float)__float_as_int(v) : v; }
__device__ __forceinline__ float clamp_f8(float x) { return fminf(fmaxf(x, -448.0f), 448.0f); }
__device__ __forceinline__ unsigned q1_i8(float x) { return (unsigned)(int)rintf(fminf(fmaxf(x, -127.0f), 127.0f)) & 0xffu; }
template <int Q> __device__ __forceinline__ unsigned pk4_q(float a, float b, float c, float d) {
    if constexpr (Q == 2) {
        constexpr float MG = 12582912.0f;
        const unsigned ua = __float_as_uint(__builtin_amdgcn_fmed3f(a + MG, MG - 127.0f, MG + 127.0f)), ub = __float_as_uint(__builtin_amdgcn_fmed3f(b + MG, MG - 127.0f, MG + 127.0f));
        const unsigned uc = __float_as_uint(__builtin_amdgcn_fmed3f(c + MG, MG - 127.0f, MG + 127.0f)), ud = __float_as_uint(__builtin_amdgcn_fmed3f(d + MG, MG - 127.0f, MG + 127.0f));
        return __builtin_amdgcn_perm(__builtin_amdgcn_perm(ud, uc, 0x0c0c0400u), __builtin_amdgcn_perm(ub, ua, 0x0c0c0400u), 0x05040100u); }
    else { int v = 0; v = __builtin_amdgcn_cvt_pk_fp8_f32(clamp_f8(a), clamp_f8(b), v, false); v = __builtin_amdgcn_cvt_pk_fp8_f32(clamp_f8(c), clamp_f8(d), v, true); return (unsigned)v; } }
__device__ __forceinline__ float shx(float v, int mask, int lane) { return __int_as_float(__builtin_amdgcn_ds_bpermute((lane ^ mask) << 2, __float_as_int(v))); }
__device__ __forceinline__ float shl(float v, int src) { return __int_as_float(__builtin_amdgcn_ds_bpermute(src << 2, __float_as_int(v))); }
__device__ __forceinline__ float wave_sum(float v, int lane) {
#pragma unroll
    for (int o = 1; o < 64; o <<= 1) v += shx(v, o, lane);
    return v;
}

template <int CTRL> __device__ __forceinline__ float dppx(float x) { return __builtin_bit_cast(float, __builtin_amdgcn_mov_dpp(__builtin_bit_cast(int, x), CTRL, 0xf, 0xf, true)); }
__device__ __forceinline__ float dpp_xor4(float x) { const int xi = __builtin_bit_cast(int, x); int t = __builtin_amdgcn_update_dpp(xi, xi, 0x12C, 0xf, 0x5, false); t = __builtin_amdgcn_update_dpp(t, xi, 0x124, 0xf, 0xA, false); return __builtin_bit_cast(float, t); }
__device__ __forceinline__ f32x4 rot64(const f32x4 v, int lane) {
    const float a0 = v.x + v.y, a1 = v.x - v.y, a2 = v.z + v.w, a3 = v.z - v.w;
    f32x4 b = {a0 + a2, a1 + a3, a0 - a2, a1 - a3};
    const float s1 = (lane & 1) ? -1.0f : 1.0f, s2 = (lane & 2) ? -1.0f : 1.0f, s4 = (lane & 4) ? -1.0f : 1.0f, s8 = (lane & 8) ? -1.0f : 1.0f;
    b = (f32x4){dppx<0xB1>(b.x), dppx<0xB1>(b.y), dppx<0xB1>(b.z), dppx<0xB1>(b.w)} + b * s1;
    b = (f32x4){dppx<0x4E>(b.x), dppx<0x4E>(b.y), dppx<0x4E>(b.z), dppx<0x4E>(b.w)} + b * s2;
    b = (f32x4){dpp_xor4(b.x), dpp_xor4(b.y), dpp_xor4(b.z), dpp_xor4(b.w)} + b * s4;
    b = (f32x4){dppx<0x128>(b.x), dppx<0x128>(b.y), dppx<0x128>(b.z), dppx<0x128>(b.w)} + b * s8;
    return b * 0.125f;
}

__device__ __forceinline__ void fwht8(float (&y)[8]) {
#pragma unroll
    for (int t = 1; t < 8; t <<= 1)
#pragma unroll
        for (int i = 0; i < 8; ++i) if (!(i & t)) { const float a = y[i], b = y[i | t]; y[i] = a + b; y[i | t] = a - b; }
}
__device__ __forceinline__ void rot64_8(float (&y)[8], int lane) {
    fwht8(y);
    const float s1 = (lane & 1) ? -1.0f : 1.0f, s2 = (lane & 2) ? -1.0f : 1.0f, s4 = (lane & 4) ? -1.0f : 1.0f;
#pragma unroll
    for (int i = 0; i < 8; ++i) y[i] = dppx<0xB1>(y[i]) + y[i] * s1;
#pragma unroll
    for (int i = 0; i < 8; ++i) y[i] = dppx<0x4E>(y[i]) + y[i] * s2;
#pragma unroll
    for (int i = 0; i < 8; ++i) y[i] = dpp_xor4(y[i]) + y[i] * s4;
}
template <int Q> __device__ __forceinline__ void store_y8(bf16* ybase, size_t elem, float (&y)[8], int lane, float clip) {
    if constexpr (Q == 2) { typedef unsigned v2u_ __attribute__((ext_vector_type(2)));
        rot64_8(y, lane); const float s = 0.125f * 127.0f / clip;
        v2u_ o8; o8.x = pk4_q<2>(y[0] * s, y[1] * s, y[2] * s, y[3] * s); o8.y = pk4_q<2>(y[4] * s, y[5] * s, y[6] * s, y[7] * s);
        *(v2u_*)((unsigned char*)ybase + elem) = o8; }
    else *(v4u*)(ybase + elem) = pack8(y);
}

#define XB_TMO      128
#define XB_XCNT(j)  (256  + 64 * (j))
#define XB_XSUB(j)  (1280 + 64 * (j))
#define XB_XGEN(j)  (2304 + 64 * (j))
#define XB_TOP      3328
#define XB_TOPGEN   3392
#define XCD_BAR_WORDS 3456
#define XB_SPIN_CAP (1u << 18)

__device__ __forceinline__ unsigned xb_ld(unsigned* p)              { return __hip_atomic_load(p, __ATOMIC_RELAXED, __HIP_MEMORY_SCOPE_AGENT); }
__device__ __forceinline__ unsigned xb_add(unsigned* p, unsigned v) { return __hip_atomic_fetch_add(p, v, __ATOMIC_RELAXED, __HIP_MEMORY_SCOPE_AGENT); }
__device__ __forceinline__ unsigned xb_xcc_id() { return (unsigned)__builtin_amdgcn_s_getreg((3 << 11) | 20) & 0xFu; }
#define XB_SPIN(cond, bar) do { unsigned _sp = 0; while (cond) { __builtin_amdgcn_s_sleep(1); \
    if ((++_sp & 255u) == 0u) { if (xb_ld(&(bar)[XB_TMO])) break; if (_sp > XB_SPIN_CAP) { atomicAdd(&(bar)[XB_TMO], 1u); break; } } } } while (0)

struct XcdBarrier { unsigned* bar; unsigned x; volatile LAS unsigned* st; };

__device__ __forceinline__ XcdBarrier xcd_barrier_post(unsigned* bar, volatile LAS unsigned* st) {
    XcdBarrier b; b.bar = bar; b.x = xb_xcc_id(); b.st = st;
    if (threadIdx.x == 0) (void)xb_add(&bar[XB_XCNT(b.x)], 1u);
    return b;
}
__device__ __forceinline__ void xcd_barrier_complete(unsigned* bar, unsigned x, unsigned& nloc, unsigned& nx) {
    const unsigned G = gridDim.x * gridDim.y * gridDim.z;
    unsigned sum, cnt, mine, sp = 0u;
    for (;;) {
        sum = 0u; cnt = 0u; mine = 0u;
        unsigned cv[16];
#pragma unroll
        for (unsigned j = 0; j < 16; ++j) cv[j] = xb_ld(&bar[XB_XCNT(j)]);
        asm volatile("" ::: "memory");
#pragma unroll
        for (unsigned j = 0; j < 16; ++j) { const unsigned c = cv[j]; sum += c; cnt += (c > 0u) ? 1u : 0u; mine = (j == x) ? c : mine; }
        if (sum == G) break;
        __builtin_amdgcn_s_sleep(1);
        if ((++sp & 255u) == 0u) { if (xb_ld(&bar[XB_TMO])) break; if (sp > XB_SPIN_CAP) { atomicAdd(&bar[XB_TMO], 1u); break; } }
    }
    nloc = mine > 0u ? mine : 1u; nx = cnt > 0u ? cnt : 1u;
}
__device__ __forceinline__ void xcd_barrier(const XcdBarrier& b) {
    asm volatile("s_waitcnt vmcnt(0)" ::: "memory");
    __syncthreads();
    if (threadIdx.x == 0) {
        unsigned* bar = b.bar;
        __builtin_amdgcn_s_waitcnt(0);
        unsigned nloc = b.st[0], nx = b.st[1];
        if (nloc == 0u) { xcd_barrier_complete(bar, b.x, nloc, nx); b.st[0] = nloc; b.st[1] = nx; }
        const unsigned old = xb_add(&bar[XB_XSUB(b.x)], 1u);
        const unsigned gen = old / nloc;
        if (old + 1u == (gen + 1u) * nloc) {
            __builtin_amdgcn_fence(__ATOMIC_RELEASE, "agent");
            asm volatile("s_waitcnt vmcnt(0)" ::: "memory");
            const unsigned og = xb_add(&bar[XB_TOP], 1u);
            const unsigned tg = og / nx;
            if (og + 1u == (tg + 1u) * nx) xb_add(&bar[XB_TOPGEN], 1u);
            else XB_SPIN(xb_ld(&bar[XB_TOPGEN]) == tg, bar);
            __builtin_amdgcn_fence(__ATOMIC_ACQUIRE, "agent");
            xb_add(&bar[XB_XGEN(b.x)], 1u);
            asm volatile("s_waitcnt vmcnt(0)" ::: "memory");
        } else {
            XB_SPIN(xb_ld(&bar[XB_XGEN(b.x)]) == gen, bar);
            __builtin_amdgcn_fence(__ATOMIC_ACQUIRE, "agent");
            asm volatile("s_waitcnt vmcnt(0)" ::: "memory");
        }
    }
    __syncthreads();
}

struct Args { const float* in[26]; float* out; unsigned char* ws; int ph_lo, ph_hi; };
typedef const Args __attribute__((address_space(4)))* KArgs;
#define KA() ({ KArgs p_ = (KArgs)__builtin_amdgcn_kernarg_segment_ptr(); asm volatile("" : "+s"(p_)); p_; })
struct Frame {
    LAS unsigned char* lds;
    int tid, lane, wave, G, bid;
    int w0;
};

template <int MAP, int F8 = 0, int RB = (F8 == 2 ? 64 : 0)>
__device__ __forceinline__ void transpose_item(const float* W, int K, int N, bf16* WT, int row_off, LAS float* scr, int item, int lane, float wscale = F8_SW) {
    const int nblk = N / 32, kb = item / nblk, nb = item % nblk, k0 = 64 * kb, n0 = 32 * nb;
    float vld[32];
#pragma unroll
    for (int i = 0; i < 32; ++i) vld[i] = W[(size_t)(k0 + 2 * i + (lane >> 5)) * N + n0 + (lane & 31)];
    asm volatile("" ::: "memory");
    if constexpr (RB != 0) {
#pragma unroll
        for (int t = 1; 2 * t < RB; t <<= 1)
#pragma unroll
            for (int i = 0; i < 32; ++i) if (!(i & t)) { const float a = vld[i], b = vld[i | t]; vld[i] = a + b; vld[i | t] = a - b; }
#pragma unroll
        for (int i = 0; i < 32; ++i) { const float pv = shx(vld[i], 32, lane); vld[i] = (lane & 32) ? pv - vld[i] : vld[i] + pv; }
        wscale *= (RB == 64 ? 0.125f : 0.35355339f);
    }
#pragma unroll
    for (int i = 0; i < 32; ++i) scr[(2 * i + (lane >> 5)) * 33 + (lane & 31)] = vld[i];
    LDS_WAIT(); asm volatile("" ::: "memory");
    const int c = lane & 7;
#pragma unroll
    for (int j = 0; j < 4; ++j) { const int n = (lane >> 3) + 8 * j; const LAS float* s = scr + (8 * c) * 33 + n;
        v4u o; o.x = pk2(s[0 * 33], s[1 * 33]); o.y = pk2(s[2 * 33], s[3 * 33]); o.z = pk2(s[4 * 33], s[5 * 33]); o.w = pk2(s[6 * 33], s[7 * 33]);
        const int nn = n0 + n; const int row = (MAP == 0) ? (row_off + nn) : ((nn >> 7) * 256 + row_off + (nn & 127));
        if constexpr (F8) { typedef unsigned v2u_ __attribute__((ext_vector_type(2))); v2u_ o8;
            o8.x = pk4_q<F8>(s[0 * 33] * wscale, s[1 * 33] * wscale, s[2 * 33] * wscale, s[3 * 33] * wscale); o8.y = pk4_q<F8>(s[4 * 33] * wscale, s[5 * 33] * wscale, s[6 * 33] * wscale, s[7 * 33] * wscale);
            *(v2u_*)((unsigned char*)WT + (size_t)row * K + k0 + 8 * c) = o8; }
        else *(v4u*)(WT + (size_t)row * K + k0 + 8 * c) = o; }
    LDS_WAIT(); asm volatile("" ::: "memory");
}

__device__ __forceinline__ void p_prologue(Frame& F, KArgs ka) {
    const float* c = ka->in[1]; const float* ada_w = ka->in[2]; const float* ada_b = ka->in[3];
    unsigned char* aws = ka->ws; float* mod = (float*)(aws + WS_MOD);
    LAS float* cact = (LAS float*)F.lds;
    LAS float* red = cact + 8192;
    for (int i = F.tid; i < BATCH * D; i += NT) cact[i] = siluf_(c[i]);
    __syncthreads();
    for (int chunk = F.bid; chunk < 256; chunk += F.G) {
        const int l = chunk >> 7, n0 = (chunk & 127) * 48;
        if (F.tid < 480) {
            const int kg = F.tid / 48, col = F.tid % 48;
            float acc[8];
#pragma unroll
            for (int b = 0; b < 8; ++b) acc[b] = 0.f;
            const float* wp = ada_w + (size_t)l * D * MOD_LD + n0 + col;
            for (int k = kg; k < D; k += 10) { const float w = wp[(size_t)k * MOD_LD];
#pragma unroll
                for (int b = 0; b < 8; ++b) acc[b] += cact[b * D + k] * w; }
#pragma unroll
            for (int b = 0; b < 8; ++b) red[(kg * 48 + col) * 8 + b] = acc[b];
        }
        __syncthreads();
        if (F.tid < 384) {
            const int col = F.tid >> 3, b = F.tid & 7; float s = 0.f;
#pragma unroll
            for (int kg = 0; kg < 10; ++kg) s += red[(kg * 48 + col) * 8 + b];
            mod[(size_t)(l * 8 + b) * MOD_LD + n0 + col] = s + ada_b[l * MOD_LD + n0 + col];
        }
        __syncthreads();
    }
}
__device__ __forceinline__ float wscale_sample(const float* W, size_t n, int lane) {
    float ss = 0.f;
#pragma unroll 8
    for (int j = 0; j < 32; ++j) { const size_t idx = ((size_t)(lane + 64 * j) * 1000003ull) % n; const float v = W[idx]; ss += v * v; }
    ss = wave_sum(ss, lane);
    return 127.0f / (W_CLIP * sqrtf(ss * (1.0f / 2048.0f)) + 1e-30f);
}
__device__ __forceinline__ void p_convert_mixer(Frame& F, KArgs ka, int l, bool with_ffn) {
    unsigned char* aws = ka->ws;
    LAS float* scr = (LAS float*)(F.lds + F.wave * 16384);
    const int gw = F.bid * NWAVES + F.wave, NGW = F.G * NWAVES;
    constexpr int I_BCA = (D / 64) * (N_BCA / 32), I_G = (D / 64) * (N_G / 32), I_BR = (512 / 64) * (D / 32), I_O = (D / 64) * (D / 32), I_L = I_BCA + I_G + 3 * I_BR + I_O;
    constexpr int I_F1 = (D / 64) * (D_FF / 32), I_F2 = (D_FF / 64) * (D / 32);
    const int nitems = I_L + (with_ffn ? 2 * I_F1 + I_F2 : 0);
    bf16* base = (bf16*)(aws + WS_WMIX);
    LAS float* qsl = (LAS float*)(F.lds + TAB_OFF + 3072);
    __syncthreads();
    if (F.wave == 0) { const float v = wscale_sample(ka->in[6] + (size_t)l * D * N_IN, (size_t)D * N_IN, F.lane); if (F.lane == 0) qsl[0] = v; }
    if (F.wave == 1) { const float v = wscale_sample(ka->in[17], (size_t)D * D_FF, F.lane); if (F.lane == 0) qsl[1] = v; }
    if (F.wave == 2) { const float v = wscale_sample(ka->in[18], (size_t)D * D_FF, F.lane); if (F.lane == 0) qsl[2] = v; }
    if (F.wave >= 3 && F.wave < 6) { const float v = wscale_sample(ka->in[13 + F.wave - 3] + (size_t)l * 512 * D, (size_t)512 * D, F.lane); if (F.lane == 0) qsl[F.wave] = v; }
    if (F.wave == 6) { const float v = wscale_sample(ka->in[16] + (size_t)l * D * D, (size_t)D * D, F.lane); if (F.lane == 0) qsl[6] = v; }
    if (F.wave == 7) { const float v = wscale_sample(ka->in[19], (size_t)D_FF * D, F.lane); if (F.lane == 0) qsl[7] = v; }
    __syncthreads();
    const float ws_in = qsl[0], ws_13 = (Q_FUP == 2) ? fminf(qsl[1], qsl[2]) : F8_SW;
    const float ws_p = (Q_PROJ == 2) ? ws_in : F8_SW, ws_g = (Q_GATE == 2) ? ws_in : F8_SW;
    const float ws_ba = qsl[3], ws_bb = qsl[4], ws_bc = qsl[5], ws_o = qsl[6], ws_2 = (Q_FDN == 2) ? qsl[7] : F8_SW;
    if (F.bid == 0 && F.tid == 0) { float* qs = (float*)(aws + WS_QS); qs[QS_IN] = ws_in; qs[QS_BR] = ws_ba; qs[QS_BR + 1] = ws_bb; qs[QS_BR + 2] = ws_bc; qs[QS_WO] = ws_o; if (with_ffn) { qs[QS_F13] = ws_13; qs[QS_F2] = ws_2; } }
    for (int it = gw; it < nitems; it += NGW) {
        int r = it;
        if (r < I_BCA) { const int kb = r / (N_BCA / 32), nb = r % (N_BCA / 32);
            transpose_item<0, Q_PROJ>(ka->in[6] + (size_t)l * D * N_IN, D, N_IN, base, 0, scr, kb * (N_IN / 32) + nb, F.lane, ws_p); continue; } r -= I_BCA;
        if (r < I_G) { const int kb = r / (N_G / 32), nb = r % (N_G / 32) + N_BCA / 32;
            if (Q_GATE) transpose_item<0, Q_GATE>(ka->in[6] + (size_t)l * D * N_IN, D, N_IN, (bf16*)(aws + WS_WMIX + WMIX_G8), -N_BCA, scr, kb * (N_IN / 32) + nb, F.lane, ws_g);
            else transpose_item<0>(ka->in[6] + (size_t)l * D * N_IN, D, N_IN, base, 0, scr, kb * (N_IN / 32) + nb, F.lane);
            continue; } r -= I_G;
        constexpr int BRS = Q_BR ? 512 * 1024 / 2 : 512 * 1024;
        if (r < I_BR) { transpose_item<0, Q_BR>(ka->in[13] + (size_t)l * 512 * D, 512, D, base + (size_t)N_IN * D, 0, scr, r, F.lane, ws_ba); continue; } r -= I_BR;
        if (r < I_BR) { transpose_item<0, Q_BR>(ka->in[14] + (size_t)l * 512 * D, 512, D, base + (size_t)N_IN * D + BRS, 0, scr, r, F.lane, ws_bb); continue; } r -= I_BR;
        if (r < I_BR) { transpose_item<0, Q_BR>(ka->in[15] + (size_t)l * 512 * D, 512, D, base + (size_t)N_IN * D + 2 * BRS, 0, scr, r, F.lane, ws_bc); continue; } r -= I_BR;
        if (r < I_O) { transpose_item<0, Q_WO, Q_WO ? 8 : 0>(ka->in[16] + (size_t)l * D * D, D, D, base + (size_t)N_IN * D + 3 * 512 * 1024, 0, scr, r, F.lane, ws_o); continue; } r -= I_O;
        if (r < I_F1) { transpose_item<1, Q_FUP>(ka->in[17], D, D_FF, (bf16*)(aws + WS_W13), 0, scr, r, F.lane, ws_13); continue; } r -= I_F1;
        if (r < I_F1) { transpose_item<1, Q_FUP>(ka->in[18], D, D_FF, (bf16*)(aws + WS_W13), 128, scr, r, F.lane, ws_13); continue; } r -= I_F1;
        transpose_item<0, Q_FDN, Q_FDN == 2 ? 8 : 0>(ka->in[19], D_FF, D, (bf16*)(aws + WS_W2), 0, scr, r, F.lane, ws_2);
    }
}
__device__ __forceinline__ void p_moe_weights(Frame& F, KArgs ka) {
    unsigned char* aws = ka->ws;
    LAS float* scr = (LAS float*)(F.lds + F.wave * 16384);
    const int gw = F.bid * NWAVES + F.wave, NGW = F.G * NWAVES;
    constexpr int I_F1 = (D / 64) * (D_FF / 32), I_F2 = (D_FF / 64) * (D / 32), I_E = 2 * I_F1 + I_F2;
    LAS float* qsl = (LAS float*)(F.lds + TAB_OFF + 3072);
    __syncthreads();
    if (F.wave == 0) { const float v = wscale_sample(ka->in[22], (size_t)NE * D * D_FF, F.lane); if (F.lane == 0) qsl[0] = v; }
    if (F.wave == 1) { const float v = wscale_sample(ka->in[23], (size_t)NE * D * D_FF, F.lane); if (F.lane == 0) qsl[1] = v; }
    if (F.wave == 2) { const float v = wscale_sample(ka->in[24], (size_t)NE * D_FF * D, F.lane); if (F.lane == 0) qsl[2] = v; }
    __syncthreads();
    const float ws_13 = (Q_MUP == 2) ? fminf(qsl[0], qsl[1]) : F8_SW, ws_2 = (Q_MDN == 2) ? qsl[2] : F8_SW;
    if (F.bid == 0 && F.tid == 0) { float* qs = (float*)(aws + WS_QS); qs[QS_M13] = ws_13; qs[QS_M2] = ws_2; }
    for (int it = gw; it < NE * I_E; it += NGW) {
        const int e = it / I_E; int r = it - e * I_E;
        bf16* w13 = (bf16*)(aws + WS_WM13 + (size_t)e * N13 * D * MOE_ES); bf16* w2 = (bf16*)(aws + WS_WM2 + (size_t)e * D * D_FF * MOE_ES);
        if (r < I_F1) { transpose_item<1, Q_MUP>(ka->in[22] + (size_t)e * D * D_FF, D, D_FF, w13, 0, scr, r, F.lane, ws_13); continue; } r -= I_F1;
        if (r < I_F1) { transpose_item<1, Q_MUP>(ka->in[23] + (size_t)e * D * D_FF, D, D_FF, w13, 128, scr, r, F.lane, ws_13); continue; } r -= I_F1;
        transpose_item<0, Q_MDN, Q_MDN == 2 ? 8 : 0>(ka->in[24] + (size_t)e * D_FF * D, D_FF, D, w2, 0, scr, r, F.lane, ws_2);
    }
}

__device__ __forceinline__ void norm_row(const float* xrow, const float* w, const float* sc, const float* sh, int lane, f32x4 (&o)[4]) {
    const f32x4* xr = (const f32x4*)xrow + lane;
    f32x4 v[4]; float s = 0.f;
#pragma unroll
    for (int j = 0; j < 4; ++j) { v[j] = xr[64 * j]; s += (v[j].x * v[j].x + v[j].y * v[j].y) + (v[j].z * v[j].z + v[j].w * v[j].w); }
    const float rstd = 1.0f / sqrtf(wave_sum(s, lane) * (1.0f / D) + EPS);
#pragma unroll
    for (int j = 0; j < 4; ++j) { const f32x4 wv = ((const f32x4*)w)[lane + 64 * j], scv = ((const f32x4*)sc)[lane + 64 * j], shv = ((const f32x4*)sh)[lane + 64 * j];
        o[j] = v[j] * rstd * wv * (scv + 1.0f) + shv; }
}
template <bool XBF>
__device__ __forceinline__ f32x4 load_x4(const void* xbase, size_t row, int lane, int j) {
    if constexpr (XBF) { typedef unsigned v2u_ __attribute__((ext_vector_type(2))); const v2u_ w = ((const v2u_*)((const bf16*)xbase + row * XLD))[lane + 64 * j];
        return (f32x4){bf_lo(w.x), bf_hi(w.x), bf_lo(w.y), bf_hi(w.y)}; }
    else return ((const f32x4*)((const float*)xbase + row * D))[lane + 64 * j];
}
__device__ __forceinline__ void store_row_bf16(bf16* orow, int lane, const f32x4 (&o)[4]) {
    unsigned long long* o8 = (unsigned long long*)orow + lane;
#pragma unroll
    for (int j = 0; j < 4; ++j) o8[64 * j] = (unsigned long long)pk2(o[j].x, o[j].y) | ((unsigned long long)pk2(o[j].z, o[j].w) << 32);
}
template <int MODE = 0, bool XBF = true, int HQ = 2>
__device__ __forceinline__ void p_norm(Frame& F, const void* xin, const float* w, const float* mod_l, int sc_off, int sh_off, bf16* hout, unsigned char* hout8 = nullptr, float sa = 1.0f) {
    const int gw = F.bid * NWAVES + F.wave, NGW = F.G * NWAVES, lane = F.lane;
    f32x4 wv[4];
#pragma unroll
    for (int j = 0; j < 4; ++j) wv[j] = ((const f32x4*)w)[lane + 64 * j];
    for (int r0 = gw * 4; r0 < M; r0 += NGW * 4) {
        const float* mb = mod_l + (size_t)(r0 >> 12) * MOD_LD;
        f32x4 v[4][4], scv[4], shv[4];
#pragma unroll
        for (int r = 0; r < 4; ++r)
#pragma unroll
            for (int j = 0; j < 4; ++j) v[r][j] = load_x4<XBF>(xin, (size_t)(r0 + r), lane, j);
#pragma unroll
        for (int j = 0; j < 4; ++j) { scv[j] = ((const f32x4*)(mb + sc_off))[lane + 64 * j]; shv[j] = ((const f32x4*)(mb + sh_off))[lane + 64 * j]; }
        asm volatile("" ::: "memory");
#pragma unroll
        for (int j = 0; j < 4; ++j) scv[j] = wv[j] * (scv[j] + 1.0f);
#pragma unroll
        for (int r = 0; r < 4; ++r) { float s = 0.f;
#pragma unroll
            for (int j = 0; j < 4; ++j) s += (v[r][j].x * v[r][j].x + v[r][j].y * v[r][j].y) + (v[r][j].z * v[r][j].z + v[r][j].w * v[r][j].w);
            const float rstd = 1.0f / sqrtf(wave_sum(s, lane) * (1.0f / D) + EPS);
            f32x4 o[4];
#pragma unroll
            for (int j = 0; j < 4; ++j) o[j] = v[r][j] * rstd * scv[j] + shv[j];
            if constexpr (MODE != 0) { unsigned* o4 = (unsigned*)((MODE == 1 ? (unsigned char*)hout : hout8) + (size_t)(r0 + r) * D) + lane;
#pragma unroll
                for (int j = 0; j < 4; ++j) { const f32x4 q = (HQ == 2) ? rot64(o[j], lane) : o[j]; o4[64 * j] = pk4_q<HQ>(q.x * sa, q.y * sa, q.z * sa, q.w * sa); } }
            if constexpr (MODE != 1) store_row_bf16(hout + (size_t)(r0 + r) * D, lane, o); }
    }
}

__device__ __forceinline__ void p_conv(Frame& F, const bf16* P1, const float* conv_w, bf16* ya) {
    const int gt = F.bid * NT + F.tid, NGT = F.G * NT;
    for (int it = gt; it < M * 64; it += NGT) {
        const int row = it >> 6, c8 = (it & 63) * 8, pos = row & (SEQ - 1);
        const bf16* p = P1 + (size_t)row * N_BCA + c8;
        float ab[8], ac[8], ah[8], z1[8], z2[8], y[8];
        unpack8(*(const v4u*)p, ab); unpack8(*(const v4u*)(p + 512), ac); unpack8(*(const v4u*)(p + 1024), ah);
#pragma unroll
        for (int i = 0; i < 8; ++i) { z1[i] = 0.f; z2[i] = 0.f; }
        if (pos >= 1) { float c1[8], h1[8]; unpack8(*(const v4u*)(p - N_BCA + 512), c1); unpack8(*(const v4u*)(p - N_BCA + 1024), h1);
#pragma unroll
            for (int i = 0; i < 8; ++i) z1[i] = c1[i] * h1[i]; }
        if (pos >= 2) { float c2[8], h2[8]; unpack8(*(const v4u*)(p - 2 * N_BCA + 512), c2); unpack8(*(const v4u*)(p - 2 * N_BCA + 1024), h2);
#pragma unroll
            for (int i = 0; i < 8; ++i) z2[i] = c2[i] * h2[i]; }
#pragma unroll
        for (int i = 0; i < 8; ++i) y[i] = ab[i] * (conv_w[c8 + i] * (ac[i] * ah[i]) + conv_w[512 + c8 + i] * z1[i] + conv_w[1024 + c8 + i] * z2[i]);
        store_y8<Q_BR>(ya, (size_t)row * 512 + c8, y, F.lane, CLIP_YA);
    }
}

typedef short v4i16_t __attribute__((ext_vector_type(4)));
typedef short bf16x8_t __attribute__((ext_vector_type(8)));
typedef unsigned v2u __attribute__((ext_vector_type(2)));
constexpr int HRS = 272;
constexpr int TRS = 80;
constexpr int H_RAWQ = 0, H_RAWF = 8704, H_V = 17408, H_QHT = 26112, H_KTT = 36352, H_KHT = 46592, H_DL = 56832, H_OB = 57344, H_OBS = 132, H_V2 = 74240;
constexpr int HSEG = 512, HNSEG = SEQ / HSEG, HCH = 32;
__device__ __forceinline__ v4i16_t tr_read(LAS unsigned char* p) { return __builtin_amdgcn_ds_read_tr16_b64_v4i16((LAS v4i16_t*)p); }
__device__ __forceinline__ bf16x8_t cat4(v4i16_t lo, v4i16_t hi) { return __builtin_shufflevector(lo, hi, 0, 1, 2, 3, 4, 5, 6, 7); }
__device__ __forceinline__ bf16x8_t pack_acc(const f32x4 a, const f32x4 b) { v4u w; w.x = pk2(a[0], a[1]); w.y = pk2(a[2], a[3]); w.z = pk2(b[0], b[1]); w.w = pk2(b[2], b[3]); return __builtin_bit_cast(bf16x8_t, w); }
__device__ __forceinline__ float bfs(short x) { return __uint_as_float((unsigned)(unsigned short)x << 16); }
template <int PASS>
__device__ __forceinline__ void p_hgrn(Frame& F, const bf16* P1, const float* lb_logits, int layer, const float* norm_w, bf16* yb, float* ust, float* dst) {
    LAS unsigned char* L = F.lds;
    const int lane = F.lane, w = F.wave, g = lane >> 4, n = lane & 15, q_ = n >> 2, p_ = n & 3;
    const int pt = F.tid >> 4, pc8 = (F.tid & 15) * 8;
    for (int u = F.bid; u < BATCH * H_B * HNSEG; u += F.G) {
        const int seg = u & (HNSEG - 1), bh = u / HNSEG, b = bh >> 2, h = bh & 3;
        const int d = 16 * w + n;
        float lb; { const int ch = h * 128 + d; const float l0 = lb_logits[ch], l1 = lb_logits[512 + ch]; const float mx = fmaxf(l0, l1);
            const float e0 = expf(l0 - mx), e1 = expf(l1 - mx); const float p0 = e0 / (e0 + e1), p1 = e1 / (e0 + e1);
            const float lbx = (layer == 0) ? (p0 - p0) : ((p0 + p1) - p0); lb = fminf(fmaxf(lbx, 0.f), 1.f); }
        const float lbf = fmaxf(lb, 1e-30f), oml = 1.0f - lb;
        f32x4 S[8];
#pragma unroll
        for (int kt = 0; kt < 8; ++kt) S[kt] = (f32x4){0.f, 0.f, 0.f, 0.f};
        if (PASS == 2) {
            for (int j = 0; j < seg; ++j) { const int uj = u - seg + j;
#pragma unroll
                for (int kt = 0; kt < 8; ++kt) { const f32x4 dj = *(const f32x4*)(dst + (size_t)uj * 128 + 16 * kt + 4 * g); const f32x4 uu = *(const f32x4*)(ust + ((((size_t)uj * 8 + w) * 8 + kt) * 64 + lane) * 4);
                    S[kt] = dj * S[kt] + uu; } }
        }
        float nw8[8];
        if (PASS == 2) {
#pragma unroll
            for (int i = 0; i < 8; ++i) nw8[i] = norm_w[h * 128 + pc8 + i]; }
        float dprod = 1.0f;
        const bf16* gp = P1 + ((size_t)b * SEQ + (size_t)seg * HSEG + pt) * N_BCA + 1536 + h * 128 + pc8;
        constexpr int HPF = 4, NCH = HSEG / HCH;
        v4u rq[HPF], rf[HPF], rv[HPF], rg[HPF];
#pragma unroll
        for (int k = 0; k < HPF; ++k) { const bf16* np = gp + (size_t)k * HCH * N_BCA; rf[k] = *(const v4u*)(np + 512); rv[k] = *(const v4u*)(np + 1024);
            if (PASS == 2) { rq[k] = *(const v4u*)np; rg[k] = *(const v4u*)(np + 1536); } }
#define HG_WRITE(k_, vb_) do { *(LAS v4u*)(L + H_RAWF + pt * HRS + pc8 * 2) = rf[k_]; *(LAS v4u*)(L + ((vb_) ? H_V2 : H_V) + pt * HRS + pc8 * 2) = rv[k_]; \
            if (PASS == 2) *(LAS v4u*)(L + H_RAWQ + pt * HRS + pc8 * 2) = rq[k_]; } while (0)
#define HG_REFILL(k_, cn_) do { if ((cn_) < NCH) { const bf16* np = gp + (size_t)(cn_) * HCH * N_BCA; rf[k_] = *(const v4u*)(np + 512); rv[k_] = *(const v4u*)(np + 1024); \
            if (PASS == 2) { rq[k_] = *(const v4u*)np; rg[k_] = *(const v4u*)(np + 1536); } } } while (0)
        v4u cg, cgn;
        HG_WRITE(0, 0); if (PASS == 2) cg = rg[0];
        LDS_BARRIER();
        HG_REFILL(0, HPF);
            { const bf16x8_t f8 = cat4(tr_read(L + H_RAWF + (8 * g + q_) * HRS + 32 * w + 8 * p_), tr_read(L + H_RAWF + (8 * g + 4 + q_) * HRS + 32 * w + 8 * p_));
              float eb[8], kk[8]; float cp = 1.0f;
#pragma unroll
              for (int i = 0; i < 8; ++i) { const float sg = __builtin_amdgcn_rcpf(1.0f + __expf(-bfs(f8[i]))); const float f = lbf + oml * sg; kk[i] = oml * (1.0f - sg); cp *= f; eb[i] = cp; }
              const float s1 = shl(cp, n), s2 = shl(cp, 16 + n), s3 = shl(cp, 32 + n), s4 = shl(cp, 48 + n);
              const float pre = (g > 0 ? s1 : 1.0f) * (g > 1 ? s2 : 1.0f) * (g > 2 ? s3 : 1.0f);
              const float elast = ((s1 * s2) * s3) * s4;
              float kh[8], kt8[8];
#pragma unroll
              for (int i = 0; i < 8; ++i) { eb[i] *= pre; const float en = __builtin_amdgcn_rcpf(fmaxf(eb[i], 1e-30f)); kt8[i] = kk[i] * en; kh[i] = kt8[i] * elast; }
              *(LAS v4u*)(L + H_KHT + d * TRS + 16 * g) = pack8(kh);
              if (PASS == 2) { const bf16x8_t q8 = cat4(tr_read(L + H_RAWQ + (8 * g + q_) * HRS + 32 * w + 8 * p_), tr_read(L + H_RAWQ + (8 * g + 4 + q_) * HRS + 32 * w + 8 * p_));
                  float qh[8];
#pragma unroll
                  for (int i = 0; i < 8; ++i) qh[i] = siluf_(bfs(q8[i])) * eb[i];
                  *(LAS v4u*)(L + H_QHT + d * TRS + 16 * g) = pack8(qh); *(LAS v4u*)(L + H_KTT + d * TRS + 16 * g) = pack8(kt8); }
              if (g == 0) *(LAS float*)(L + H_DL + 4 * d) = elast;
              dprod *= elast; }
        LDS_BARRIER();
        for (int c0 = 0; c0 < NCH; c0 += HPF) {
#pragma unroll
          for (int k = 0; k < HPF; ++k) {
            const int c = c0 + k; const int vbuf = (k & 1) ? H_V2 : H_V;
            const bf16x8_t bVn = cat4(tr_read(L + vbuf + (8 * g + q_) * HRS + 32 * w + 8 * p_), tr_read(L + vbuf + (8 * g + 4 + q_) * HRS + 32 * w + 8 * p_));
            if (PASS == 2) {
                const bf16x8_t bVp = cat4(tr_read(L + vbuf + (4 * g + q_) * HRS + 32 * w + 8 * p_), tr_read(L + vbuf + (16 + 4 * g + q_) * HRS + 32 * w + 8 * p_));
                f32x4 o[2], pt00 = {0.f, 0.f, 0.f, 0.f}, pt01 = {0.f, 0.f, 0.f, 0.f}, pt11 = {0.f, 0.f, 0.f, 0.f};
                o[0] = (f32x4){0.f, 0.f, 0.f, 0.f}; o[1] = (f32x4){0.f, 0.f, 0.f, 0.f};
#pragma unroll
                for (int ks = 0; ks < 4; ++ks) {
                    const bf16x8_t sb = pack_acc(S[2 * ks], S[2 * ks + 1]);
#pragma unroll
                    for (int tm = 0; tm < 2; ++tm) {
                        const bf16x8_t aq = cat4(tr_read(L + H_QHT + (32 * ks + 4 * g + q_) * TRS + 32 * tm + 8 * p_), tr_read(L + H_QHT + (32 * ks + 16 + 4 * g + q_) * TRS + 32 * tm + 8 * p_));
                        o[tm] = __builtin_amdgcn_mfma_f32_16x16x32_bf16(aq, sb, o[tm], 0, 0, 0); }
                    const bf16x8_t aK0 = cat4(tr_read(L + H_KTT + (32 * ks + 8 * g + q_) * TRS + 8 * p_), tr_read(L + H_KTT + (32 * ks + 8 * g + 4 + q_) * TRS + 8 * p_));
                    const bf16x8_t aK1 = cat4(tr_read(L + H_KTT + (32 * ks + 8 * g + q_) * TRS + 32 + 8 * p_), tr_read(L + H_KTT + (32 * ks + 8 * g + 4 + q_) * TRS + 32 + 8 * p_));
                    const bf16x8_t bQ0 = cat4(tr_read(L + H_QHT + (32 * ks + 8 * g + q_) * TRS + 8 * p_), tr_read(L + H_QHT + (32 * ks + 8 * g + 4 + q_) * TRS + 8 * p_));
                    const bf16x8_t bQ1 = cat4(tr_read(L + H_QHT + (32 * ks + 8 * g + q_) * TRS + 32 + 8 * p_), tr_read(L + H_QHT + (32 * ks + 8 * g + 4 + q_) * TRS + 32 + 8 * p_));
                    pt00 = __builtin_amdgcn_mfma_f32_16x16x32_bf16(aK0, bQ0, pt00, 0, 0, 0);
                    pt01 = __builtin_amdgcn_mfma_f32_16x16x32_bf16(aK0, bQ1, pt01, 0, 0, 0);
                    pt11 = __builtin_amdgcn_mfma_f32_16x16x32_bf16(aK1, bQ1, pt11, 0, 0, 0);
                }
#pragma unroll
                for (int j = 0; j < 4; ++j) if (4 * g + j > n) { pt00[j] = 0.f; pt11[j] = 0.f; }
                const f32x4 z4 = {0.f, 0.f, 0.f, 0.f};
                o[0] = __builtin_amdgcn_mfma_f32_16x16x32_bf16(pack_acc(pt00, z4), bVp, o[0], 0, 0, 0);
                o[1] = __builtin_amdgcn_mfma_f32_16x16x32_bf16(pack_acc(pt01, pt11), bVp, o[1], 0, 0, 0);
#pragma unroll
                for (int tm = 0; tm < 2; ++tm)
#pragma unroll
                    for (int j = 0; j < 4; ++j) *(LAS float*)(L + H_OB + ((16 * tm + 4 * g + j) * H_OBS + 16 * w + n) * 4) = o[tm][j];
            }
#pragma unroll
            for (int kt = 0; kt < 8; ++kt) { const f32x4 dl4 = *(const LAS f32x4*)(L + H_DL + (16 * kt + 4 * g) * 4);
                const bf16x8_t aKh = *(const LAS bf16x8_t*)(L + H_KHT + (16 * kt + n) * TRS + 16 * g);
                S[kt] = __builtin_amdgcn_mfma_f32_16x16x32_bf16(aKh, bVn, S[kt] * dl4, 0, 0, 0); }
            if (c + 1 < NCH) { HG_WRITE((k + 1) % HPF, (k + 1) & 1); if (PASS == 2) cgn = rg[(k + 1) % HPF]; }
            LDS_BARRIER();
            if (c + 1 < NCH) HG_REFILL((k + 1) % HPF, c + 1 + HPF);
            if (PASS == 2) {
                const f32x4 o0 = *(const LAS f32x4*)(L + H_OB + (pt * H_OBS + pc8) * 4), o1 = *(const LAS f32x4*)(L + H_OB + (pt * H_OBS + pc8 + 4) * 4);
                const float o8[8] = {o0.x, o0.y, o0.z, o0.w, o1.x, o1.y, o1.z, o1.w};
                float ss = 0.f;
#pragma unroll
                for (int i = 0; i < 8; ++i) ss += o8[i] * o8[i];
                ss += shx(ss, 1, lane); ss += shx(ss, 2, lane); ss += shx(ss, 4, lane); ss += shx(ss, 8, lane);
                const float rs = 1.0f / sqrtf(ss * (1.0f / 128.0f) + EPS);
                float g8[8], y[8]; unpack8(cg, g8);
#pragma unroll
                for (int i = 0; i < 8; ++i) y[i] = o8[i] * rs * nw8[i] * siluf_(g8[i]);
                store_y8<Q_BR>(yb, ((size_t)b * SEQ + (size_t)seg * HSEG + (size_t)c * HCH + pt) * 512 + h * 128 + pc8, y, lane, CLIP_YB);
            }
            if (c + 1 < NCH)
            { const bf16x8_t f8 = cat4(tr_read(L + H_RAWF + (8 * g + q_) * HRS + 32 * w + 8 * p_), tr_read(L + H_RAWF + (8 * g + 4 + q_) * HRS + 32 * w + 8 * p_));
              float eb[8], kk[8]; float cp = 1.0f;
#pragma unroll
              for (int i = 0; i < 8; ++i) { const float sg = __builtin_amdgcn_rcpf(1.0f + __expf(-bfs(f8[i]))); const float f = lbf + oml * sg; kk[i] = oml * (1.0f - sg); cp *= f; eb[i] = cp; }
              const float s1 = shl(cp, n), s2 = shl(cp, 16 + n), s3 = shl(cp, 32 + n), s4 = shl(cp, 48 + n);
              const float pre = (g > 0 ? s1 : 1.0f) * (g > 1 ? s2 : 1.0f) * (g > 2 ? s3 : 1.0f);
              const float elast = ((s1 * s2) * s3) * s4;
              float kh[8], kt8[8];
#pragma unroll
              for (int i = 0; i < 8; ++i) { eb[i] *= pre; const float en = __builtin_amdgcn_rcpf(fmaxf(eb[i], 1e-30f)); kt8[i] = kk[i] * en; kh[i] = kt8[i] * elast; }
              *(LAS v4u*)(L + H_KHT + d * TRS + 16 * g) = pack8(kh);
              if (PASS == 2) { const bf16x8_t q8 = cat4(tr_read(L + H_RAWQ + (8 * g + q_) * HRS + 32 * w + 8 * p_), tr_read(L + H_RAWQ + (8 * g + 4 + q_) * HRS + 32 * w + 8 * p_));
                  float qh[8];
#pragma unroll
                  for (int i = 0; i < 8; ++i) qh[i] = siluf_(bfs(q8[i])) * eb[i];
                  *(LAS v4u*)(L + H_QHT + d * TRS + 16 * g) = pack8(qh); *(LAS v4u*)(L + H_KTT + d * TRS + 16 * g) = pack8(kt8); }
              if (g == 0) *(LAS float*)(L + H_DL + 4 * d) = elast;
              dprod *= elast; }
            LDS_BARRIER();
            if (PASS == 2) cg = cgn;
          }
        }
#undef HG_WRITE
#undef HG_REFILL
        if (PASS == 1) {
#pragma unroll
            for (int kt = 0; kt < 8; ++kt) *(f32x4*)(ust + ((((size_t)u * 8 + w) * 8 + kt) * 64 + lane) * 4) = S[kt];
            if (g == 0) dst[(size_t)u * 128 + d] = dprod;
        }
        __syncthreads();
    }
}

constexpr int SG_V = 0, SG_OB = 34816, SG_OBS = 132, SG_RS = SG_OB + 128 * SG_OBS * 4;
__device__ __forceinline__ void p_sgu(Frame& F, const bf16* P1, const float* norm_w, const float* sgu_w, const float* sgu_b, bf16* yc) {
    LAS unsigned char* L = F.lds;
    const int lane = F.lane, w = F.wave, gq = lane >> 4, n = lane & 15, q_ = n >> 2, p_ = n & 3;
    const int sr = F.tid >> 4, c8 = (F.tid & 15) * 8;
    for (int u = F.bid; u < M / 128; u += F.G) {
        const size_t row0 = (size_t)u * 128;
        v4u rv[4][4]; float ssj[4] = {0.f, 0.f, 0.f, 0.f};
#pragma unroll
        for (int g = 0; g < 4; ++g)
#pragma unroll
            for (int j = 0; j < 4; ++j) { rv[g][j] = *(const v4u*)(P1 + (row0 + sr + 32 * j) * N_BCA + 4096 + g * 128 + c8); float f[8]; unpack8(rv[g][j], f);
#pragma unroll
                for (int i = 0; i < 8; ++i) ssj[j] += f[i] * f[i]; }
#pragma unroll
        for (int j = 0; j < 4; ++j) { float ss = ssj[j]; ss += shx(ss, 1, lane); ss += shx(ss, 2, lane); ss += shx(ss, 4, lane); ss += shx(ss, 8, lane);
            if (n == 0) *(LAS float*)(L + SG_RS + 4 * (sr + 32 * j)) = 1.0f / sqrtf(ss * (1.0f / 512.0f) + EPS); }
#pragma unroll
        for (int g = 0; g < 4; ++g) {
#pragma unroll
            for (int j = 0; j < 4; ++j) *(LAS v4u*)(L + SG_V + (sr + 32 * j) * HRS + c8 * 2) = rv[g][j];
            LDS_BARRIER();
            float nwv[8];
            const int kmax = w >> 1, t = 16 * w + n;
            bf16x8_t aW[4];
            { f32x4 wl[4][2]; float nwl[8];
#pragma unroll
              for (int ks = 0; ks < 4; ++ks) { const float* wp = sgu_w + ((size_t)g * 128 + t) * 128 + 32 * ks + 8 * gq; wl[ks][0] = *(const f32x4*)wp; wl[ks][1] = *(const f32x4*)(wp + 4); }
#pragma unroll
              for (int ct = 0; ct < 8; ++ct) nwl[ct] = norm_w[g * 128 + 16 * ct + n];
              asm volatile("" ::: "memory");
#pragma unroll
              for (int ct = 0; ct < 8; ++ct) nwv[ct] = nwl[ct];
#pragma unroll
              for (int ks = 0; ks < 4; ++ks) { const int s0 = 32 * ks + 8 * gq;
                    const f32x4 w0 = wl[ks][0], w1 = wl[ks][1]; const f32x4 r0 = *(const LAS f32x4*)(L + SG_RS + 4 * s0), r1 = *(const LAS f32x4*)(L + SG_RS + 4 * (s0 + 4));
                    float a8[8] = {w0.x * r0.x, w0.y * r0.y, w0.z * r0.z, w0.w * r0.w, w1.x * r1.x, w1.y * r1.y, w1.z * r1.z, w1.w * r1.w};
#pragma unroll
                    for (int i = 0; i < 8; ++i) if (s0 + i > t) a8[i] = 0.f;
                    aW[ks] = __builtin_bit_cast(bf16x8_t, pack8(a8)); } }
            f32x4 acc[8];
#pragma unroll
            for (int ct = 0; ct < 8; ++ct) acc[ct] = (f32x4){0.f, 0.f, 0.f, 0.f};
#pragma unroll
            for (int ks = 0; ks < 4; ++ks) { if (ks <= kmax) {
#pragma unroll
                for (int ct = 0; ct < 8; ++ct) { const bf16x8_t bV = cat4(tr_read(L + SG_V + (32 * ks + 8 * gq + q_) * HRS + 32 * ct + 8 * p_), tr_read(L + SG_V + (32 * ks + 8 * gq + 4 + q_) * HRS + 32 * ct + 8 * p_));
                    acc[ct] = __builtin_amdgcn_mfma_f32_16x16x32_bf16(aW[ks], bV, acc[ct], 0, 0, 0); } } }
#pragma unroll
            for (int ct = 0; ct < 8; ++ct) { const float nw = nwv[ct];
#pragma unroll
                for (int j = 0; j < 4; ++j) *(LAS float*)(L + SG_OB + ((16 * w + 4 * gq + j) * SG_OBS + 16 * ct + n) * 4) = acc[ct][j] * nw; }
            LDS_BARRIER();
            v4u ul[4]; float bl[4];
#pragma unroll
            for (int j = 0; j < 4; ++j) { ul[j] = *(const v4u*)(P1 + (row0 + sr + 32 * j) * N_BCA + 3584 + g * 128 + c8); bl[j] = sgu_b[g * 128 + sr + 32 * j]; }
            asm volatile("" ::: "memory");
#pragma unroll
            for (int j = 0; j < 4; ++j) { const int tt = sr + 32 * j; const float bias = bl[j];
                const f32x4 o0 = *(const LAS f32x4*)(L + SG_OB + (tt * SG_OBS + c8) * 4), o1 = *(const LAS f32x4*)(L + SG_OB + (tt * SG_OBS + c8 + 4) * 4);
                float uu[8], y[8]; unpack8(ul[j], uu);
                y[0] = (o0.x + bias) * uu[0]; y[1] = (o0.y + bias) * uu[1]; y[2] = (o0.z + bias) * uu[2]; y[3] = (o0.w + bias) * uu[3];
                y[4] = (o1.x + bias) * uu[4]; y[5] = (o1.y + bias) * uu[5]; y[6] = (o1.z + bias) * uu[6]; y[7] = (o1.w + bias) * uu[7];
                store_y8<Q_BR>(yc, (row0 + tt) * 512 + g * 128 + c8, y, lane, CLIP_YC); }
        }
        __syncthreads();
    }
}

__device__ __forceinline__ void p_norm_router(Frame& F, KArgs ka, const void* x, const float* w, const float* mod_l, bf16* h2) {
    const float* rw = ka->in[20]; const float* rb = ka->in[21]; unsigned* ctl = (unsigned*)(ka->ws + WS_CTL);
    float* topp = (float*)(ka->ws + WS_TOPP); int* list = (int*)(ka->ws + WS_LIST);
    LAS float* RWt = (LAS float*)F.lds;
    LAS int* lcnt = (LAS int*)(RWt + 8192);
    LAS int* lbase = lcnt + 16;
    LAS int* sel = lbase + 16;
    LAS int* rnk = sel + 128;
    for (int i = F.tid; i < D * NE; i += NT) { const int k = i >> 3, e = i & 7; RWt[e * D + k] = rw[i]; }
    __syncthreads();
    float rbv[8];
#pragma unroll
    for (int e = 0; e < 8; ++e) rbv[e] = rb[e];
    f32x4 wv[4];
#pragma unroll
    for (int j = 0; j < 4; ++j) wv[j] = ((const f32x4*)w)[F.lane + 64 * j];
    for (int batch = F.bid; batch < M / 128; batch += F.G) {
        const int row0 = batch * 128;
        if (F.tid < 16) lcnt[F.tid] = 0;
        const float* mb = mod_l + (size_t)(row0 >> 12) * MOD_LD;
        f32x4 scv[4], shv[4], xn[4];
#pragma unroll
        for (int j = 0; j < 4; ++j) { scv[j] = ((const f32x4*)(mb + 4 * D))[F.lane + 64 * j]; shv[j] = ((const f32x4*)(mb + 3 * D))[F.lane + 64 * j]; xn[j] = load_x4<true>(x, (size_t)(row0 + F.wave * 16), F.lane, j); }
        asm volatile("" ::: "memory");
#pragma unroll
        for (int j = 0; j < 4; ++j) scv[j] = wv[j] * (scv[j] + 1.0f);
        __syncthreads();
        for (int rr = 0; rr < 16; ++rr) {
            const int r = F.wave * 16 + rr, row = row0 + r;
            f32x4 v[4];
#pragma unroll
            for (int j = 0; j < 4; ++j) v[j] = xn[j];
            if (rr + 1 < 16) {
#pragma unroll
                for (int j = 0; j < 4; ++j) xn[j] = load_x4<true>(x, (size_t)(row + 1), F.lane, j); }
            float ssq = 0.f;
#pragma unroll
            for (int j = 0; j < 4; ++j) ssq += (v[j].x * v[j].x + v[j].y * v[j].y) + (v[j].z * v[j].z + v[j].w * v[j].w);
            const float rstd = 1.0f / sqrtf(wave_sum(ssq, F.lane) * (1.0f / D) + EPS);
            f32x4 o[4];
#pragma unroll
            for (int j = 0; j < 4; ++j) o[j] = v[j] * rstd * scv[j] + shv[j];
            { unsigned* o4 = (unsigned*)((unsigned char*)h2 + (size_t)row * D) + F.lane;
#pragma unroll
                for (int j = 0; j < 4; ++j) { const f32x4 q = (Q_MUP == 2) ? rot64(o[j], F.lane) : o[j]; o4[64 * j] = pk4_q<Q_MUP>(q.x * sa_of(Q_MUP, CLIP_MOE), q.y * sa_of(Q_MUP, CLIP_MOE), q.z * sa_of(Q_MUP, CLIP_MOE), q.w * sa_of(Q_MUP, CLIP_MOE)); } }
            float lg[8];
#pragma unroll
            for (int e = 0; e < 8; ++e) { float s = 0.f;
#pragma unroll
                for (int j = 0; j < 4; ++j) { const f32x4 r4 = *(const LAS f32x4*)(RWt + e * D + 4 * F.lane + 256 * j); s += (o[j].x * r4.x + o[j].y * r4.y) + (o[j].z * r4.z + o[j].w * r4.w); }
                lg[e] = wave_sum(s, F.lane) + rbv[e]; }
            int i0 = 0; float v0 = lg[0];
#pragma unroll
            for (int e = 1; e < 8; ++e) if (lg[e] > v0) { v0 = lg[e]; i0 = e; }
            int i1 = -1; float v1 = -3.0e38f;
#pragma unroll
            for (int e = 0; e < 8; ++e) if (e != i0 && lg[e] > v1) { v1 = lg[e]; i1 = e; }
            if (F.lane == 0) {
                const float p0 = 1.0f / (1.0f + expf(v1 - v0));
                topp[(size_t)row * 2] = p0; topp[(size_t)row * 2 + 1] = 1.0f - p0;
                const int rk0 = __hip_atomic_fetch_add(lcnt + i0, 1, __ATOMIC_RELAXED, __HIP_MEMORY_SCOPE_WORKGROUP), rk1 = __hip_atomic_fetch_add(lcnt + 8 + i1, 1, __ATOMIC_RELAXED, __HIP_MEMORY_SCOPE_WORKGROUP);
                sel[r] = i0 | (i1 << 8); rnk[r] = rk0 | (rk1 << 16);
            }
        }
        __syncthreads();
        if (F.tid < 16) lbase[F.tid] = (int)__hip_atomic_fetch_add(ctl + CW_CNT + 64 * F.tid, (unsigned)lcnt[F.tid], __ATOMIC_RELAXED, __HIP_MEMORY_SCOPE_AGENT);
        __syncthreads();
        if (F.tid < 128) { const int sv = sel[F.tid], rv = rnk[F.tid]; const int e0 = sv & 255, e1 = sv >> 8;
            list[(size_t)e0 * LIST_CAP + lbase[e0] + (rv & 0xffff)] = row0 + F.tid;
            list[(size_t)(8 + e1) * LIST_CAP + lbase[8 + e1] + (rv >> 16)] = row0 + F.tid; }
        __syncthreads();
    }
}
__device__ __forceinline__ void moe_tables(Frame& F, unsigned* ctl, int pass) {
    LAS int* tab = (LAS int*)(F.lds + TAB_OFF) + pass * 256;
    __syncthreads();
    if (F.tid == 0) { int pb = 0;
        for (int e = 0; e < 8; ++e) { int c = (int)__hip_atomic_load(ctl + CW_CNT + 64 * (pass * 8 + e), __ATOMIC_RELAXED, __HIP_MEMORY_SCOPE_AGENT); if (c > LIST_CAP) c = LIST_CAP; if (c < 0) c = 0;
            const int np = (c + 255) >> 8; tab[e] = c; tab[8 + e] = pb; for (int p = 0; p < np; ++p) tab[32 + pb + p] = e; pb += np; }
        tab[16] = pb; }
    __syncthreads();
}
template <bool GATHER_>
struct MoeOrder {
    static constexpr bool GATHER = GATHER_;
    pg8::StaticOrder so; const LAS int* tab; const int* list; int npn; unsigned rowbytes;
    int T = 0, HC = 0;
    __device__ __forceinline__ bool next(int i, pg8::Unit& u) const {
        const int G = so.G, c = so.c; long L;
        if (T == 0) L = (long)i * G + c;
        else if (c >= T) L = (i < HC) ? (long)i * (G - T) + (c - T) : (long)HC * (G - T) + (long)(i - HC) * G + c;
        else L = (long)HC * (G - T) + (long)i * G + c;
        if (!so.unit_of(L, u)) return false; u.pb = tab[32 + u.pm] * npn + u.pn; return true; }
    __device__ __forceinline__ int tok_of(int pm, int r) const { const int e = tab[32 + pm]; const int idx = (pm - tab[8 + e]) * 256 + r; return idx < tab[e] ? list[(size_t)e * LIST_CAP + idx] : -1; }
    __device__ __forceinline__ unsigned a_row_off(const pg8::Unit& u, int r) const { const int t = tok_of(u.pm, r); return (unsigned)(t < 0 ? 0 : t) * rowbytes; }
};

template <bool GU8, int QB = 0, int QM = 0>
struct EpiBranch {
    static constexpr bool PERM = true;
    const bf16* gate; bf16* mrg; const float* qsb; unsigned char* mrg8;
    __device__ __forceinline__ void operator()(const pg8::f32x4 (&acc)[2][2][4][2], const pg8::Unit& u, int wr, int wc, int fr, int fq) const {
        typedef unsigned v2u_ __attribute__((ext_vector_type(2)));
        const int row0 = u.pm * 256 + wr * 64 + fr, col0 = u.pn * 256 + wc * 32 + 8 * fq + u.aux * D;
        const int first = (u.aux == 0), mshift = u.aux * D;
        const float bsc = (u.aux == 0 ? CLIP_YA : (u.aux == 1 ? CLIP_YB : CLIP_YC)) / (127.0f * (QB == 2 ? qsb[u.aux] : 1.0f));
        v4u gl[2][2][2], ml[2][2][2];
#define EB_LOAD(q) do { _Pragma("unroll") for (int mm_ = 0; mm_ < 2; ++mm_) _Pragma("unroll") for (int bj = 0; bj < 2; ++bj) { \
            const size_t row = (size_t)(row0 + ((q) >> 1) * 128 + (((q) & 1) * 2 + mm_) * 16); const int col = col0 + bj * 128; \
            if constexpr (GU8) { const v2u_ g2 = *(const v2u_*)((const unsigned char*)gate + row * N_G + col); gl[(q) & 1][mm_][bj].x = g2.x; gl[(q) & 1][mm_][bj].y = g2.y; } else gl[(q) & 1][mm_][bj] = *(const v4u*)(gate + row * N_G + col); \
            ml[(q) & 1][mm_][bj] = first ? (v4u){0u, 0u, 0u, 0u} : *(const v4u*)(mrg + row * D + col - mshift); } asm volatile("" ::: "memory"); } while (0)
        EB_LOAD(0);
#pragma unroll
        for (int q = 0; q < 4; ++q) {
            if (q < 3) EB_LOAD(q + 1);
            const int ai = q >> 1;
#pragma unroll
            for (int mm_ = 0; mm_ < 2; ++mm_)
#pragma unroll
                for (int bj = 0; bj < 2; ++bj) { const int m = (q & 1) * 2 + mm_; const size_t row = (size_t)(row0 + ai * 128 + m * 16); const int col = col0 + bj * 128;
                    float gg[8], mm[8], o[8]; unpack8(ml[q & 1][mm_][bj], mm);
                    if constexpr (GU8) {
#pragma unroll
                        for (int i = 0; i < 4; ++i) { gg[i] = (float)((gl[q & 1][mm_][bj].x >> (8 * i)) & 0xffu) * (1.0f / 255.0f); gg[4 + i] = (float)((gl[q & 1][mm_][bj].y >> (8 * i)) & 0xffu) * (1.0f / 255.0f); } }
                    else { unpack8(gl[q & 1][mm_][bj], gg);
#pragma unroll
                        for (int i = 0; i < 8; ++i) gg[i] = sigmoidf_(gg[i]); }
                    pg8::f32x4 v0 = acc[ai][bj][m][0], v1 = acc[ai][bj][m][1];
                    if constexpr (QB == 2) { v0 = __builtin_convertvector(__builtin_bit_cast(pg8::v4i32_, v0), pg8::f32x4) * bsc; v1 = __builtin_convertvector(__builtin_bit_cast(pg8::v4i32_, v1), pg8::f32x4) * bsc; }
                    o[0] = mm[0] + gg[0] * v0[0]; o[1] = mm[1] + gg[1] * v0[1]; o[2] = mm[2] + gg[2] * v0[2]; o[3] = mm[3] + gg[3] * v0[3];
                    o[4] = mm[4] + gg[4] * v1[0]; o[5] = mm[5] + gg[5] * v1[1]; o[6] = mm[6] + gg[6] * v1[2]; o[7] = mm[7] + gg[7] * v1[3];
                    if (QM == 2 && u.aux == 2) { fwht8(o); constexpr float s = 0.35355339f * 127.0f / CLIP_MRG; v2u_ w8; w8.x = pk4_q<2>(o[0] * s, o[1] * s, o[2] * s, o[3] * s); w8.y = pk4_q<2>(o[4] * s, o[5] * s, o[6] * s, o[7] * s);
                        *(v2u_*)(mrg8 + row * D + col - mshift) = w8; }
                    else *(v4u*)(mrg + row * D + col - mshift) = pack8(o); }
            asm volatile("" ::: "memory");
        }
#undef EB_LOAD
    }
};
template <int Q>
struct EpiGateU8 {
    static constexpr bool PERM = true;
    unsigned char* O; float scale;
    __device__ __forceinline__ void operator()(const pg8::f32x4 (&acc)[2][2][4][2], const pg8::Unit& u, int wr, int wc, int fr, int fq) const {
        typedef unsigned v2u_ __attribute__((ext_vector_type(2)));
        const int row0 = u.pm * 256 + wr * 64 + fr, col0 = u.pn * 256 + wc * 32 + 8 * fq;
#pragma unroll
        for (int ai = 0; ai < 2; ++ai)
#pragma unroll
            for (int m = 0; m < 4; ++m) { unsigned char* rowp = O + (size_t)(row0 + ai * 128 + m * 16) * N_G + col0;
#pragma unroll
                for (int bj = 0; bj < 2; ++bj) { v2u_ w;
#pragma unroll
                    for (int n = 0; n < 2; ++n) { const pg8::f32x4 v = acc[ai][bj][m][n]; unsigned p = 0u;
#pragma unroll
                        for (int i = 0; i < 4; ++i) p |= (unsigned)(sigmoidf_(accf<Q>(v[i]) * scale) * 255.0f + 0.5f) << (8 * i);
                        if (n == 0) w.x = p; else w.y = p; }
                    *(v2u_*)(rowp + bj * 128) = w; } }
    }
};
template <bool IN_F32, int QI = 0>
struct EpiResid {
    static constexpr bool PERM = true;
    const void* xin; bf16* xout; const float* gmod; float onum, oden;
    __device__ __forceinline__ void operator()(const pg8::f32x4 (&acc)[2][2][4][2], const pg8::Unit& u, int wr, int wc, int fr, int fq) const {
        const int row0 = u.pm * 256 + wr * 64 + fr, col0 = u.pn * 256 + wc * 32 + 8 * fq;
        const float* gb = gmod + (size_t)((u.pm * 256) >> 12) * MOD_LD + col0;
        float od_ = oden; asm volatile("" : "+s"(od_)); const float oscale = onum / od_;
        pg8::f32x4 gv[2][2];
#pragma unroll
        for (int bj = 0; bj < 2; ++bj)
#pragma unroll
            for (int n = 0; n < 2; ++n) gv[bj][n] = *(const pg8::f32x4*)(gb + bj * 128 + n * 4) * oscale;
        constexpr int NB = 2;
#pragma unroll
        for (int b = 0; b < NB; ++b) {
            pg8::f32x4 xl[2 / NB][4][2][2];
#pragma unroll
            for (int a = 0; a < 2 / NB; ++a)
#pragma unroll
            for (int m = 0; m < 4; ++m)
#pragma unroll
                for (int bj = 0; bj < 2; ++bj) { const int ai = b * (2 / NB) + a; const size_t row = (size_t)(row0 + ai * 128 + m * 16); const int col = col0 + bj * 128;
                    if constexpr (IN_F32) { xl[a][m][bj][0] = *(const pg8::f32x4*)((const float*)xin + row * D + col); xl[a][m][bj][1] = *(const pg8::f32x4*)((const float*)xin + row * D + col + 4); }
                    else { const v4u w = *(const v4u*)((const bf16*)xin + row * XLD + col); xl[a][m][bj][0] = __builtin_bit_cast(pg8::f32x4, w); } }
            asm volatile("" ::: "memory");
#pragma unroll
            for (int a = 0; a < 2 / NB; ++a)
#pragma unroll
            for (int m = 0; m < 4; ++m)
#pragma unroll
                for (int bj = 0; bj < 2; ++bj) { const int ai = b * (2 / NB) + a; const size_t row = (size_t)(row0 + ai * 128 + m * 16); const int col = col0 + bj * 128;
                    pg8::f32x4 x0, x1;
                    if constexpr (IN_F32) { x0 = xl[a][m][bj][0]; x1 = xl[a][m][bj][1]; }
                    else { const v4u w = __builtin_bit_cast(v4u, xl[a][m][bj][0]); x0 = (pg8::f32x4){bf_lo(w.x), bf_hi(w.x), bf_lo(w.y), bf_hi(w.y)}; x1 = (pg8::f32x4){bf_lo(w.z), bf_hi(w.z), bf_lo(w.w), bf_hi(w.w)}; }
                    pg8::f32x4 c0 = acc[ai][bj][m][0], c1 = acc[ai][bj][m][1];
                    if constexpr (QI == 2) {
#pragma unroll
                        for (int i = 0; i < 4; ++i) { c0[i] = (float)__float_as_int(c0[i]); c1[i] = (float)__float_as_int(c1[i]); } }
                    const pg8::f32x4 o0 = x0 + gv[bj][0] * c0, o1 = x1 + gv[bj][1] * c1;
                    v4u w; w.x = pk2(o0[0], o0[1]); w.y = pk2(o0[2], o0[3]); w.z = pk2(o1[0], o1[1]); w.w = pk2(o1[2], o1[3]);
                    *(v4u*)(xout + row * XLD + col) = w; }
            asm volatile("" ::: "memory");
        }
    }
};
template <int QIN = 0, int QOUT = 0>
struct EpiSwiglu {
    static constexpr bool PERM = true;
    bf16* act; float inv;
    __device__ __forceinline__ void operator()(const pg8::f32x4 (&acc)[2][2][4][2], const pg8::Unit& u, int wr, int wc, int fr, int fq) const {
        const int row0 = u.pm * 256 + wr * 64 + fr, col0 = u.pn * 128 + wc * 32 + 8 * fq;
#pragma unroll
        for (int ai = 0; ai < 2; ++ai)
#pragma unroll
            for (int m = 0; m < 4; ++m) { float o[8];
#pragma unroll
                for (int n = 0; n < 2; ++n)
#pragma unroll
                    for (int i = 0; i < 4; ++i) { const float a1 = QIN ? accf<QIN>(acc[ai][0][m][n][i]) * inv : acc[ai][0][m][n][i], a3 = QIN ? accf<QIN>(acc[ai][1][m][n][i]) * inv : acc[ai][1][m][n][i];
                        o[n * 4 + i] = siluf_(a1) * a3; }
                if constexpr (QOUT != 0) { typedef unsigned v2u_ __attribute__((ext_vector_type(2))); v2u_ w8;
                    if constexpr (QOUT == 2) { fwht8(o); constexpr float s = 0.35355339f * 127.0f / CLIP_ACT; w8.x = pk4_q<2>(o[0] * s, o[1] * s, o[2] * s, o[3] * s); w8.y = pk4_q<2>(o[4] * s, o[5] * s, o[6] * s, o[7] * s); }
                    else { w8.x = pk4_q<1>(o[0] * F8_SACT, o[1] * F8_SACT, o[2] * F8_SACT, o[3] * F8_SACT); w8.y = pk4_q<1>(o[4] * F8_SACT, o[5] * F8_SACT, o[6] * F8_SACT, o[7] * F8_SACT); }
                    *(v2u_*)((unsigned char*)act + (size_t)(row0 + ai * 128 + m * 16) * D_FF + col0) = w8; }
                else *(v4u*)(act + (size_t)(row0 + ai * 128 + m * 16) * D_FF + col0) = pack8(o); }
    }
};
struct EpiMoeDown {
    static constexpr bool PERM = true;
    bf16* x; const float* gmod; const float* topp; int pass; const LAS int* tab; const int* list; float oscale;
    __device__ __forceinline__ int tok_of(int pm, int r) const { const int e = tab[32 + pm]; const int idx = (pm - tab[8 + e]) * 256 + r; return idx < tab[e] ? list[(size_t)e * LIST_CAP + idx] : -1; }
    __device__ __forceinline__ void operator()(const pg8::f32x4 (&acc)[2][2][4][2], const pg8::Unit& u, int wr, int wc, int fr, int fq) const {
        const int col0 = u.pn * 256 + wc * 32 + 8 * fq;
        int tok[2][4];
#pragma unroll
        for (int ai = 0; ai < 2; ++ai)
#pragma unroll
            for (int m = 0; m < 4; ++m) tok[ai][m] = tok_of(u.pm, ai * 128 + wr * 64 + m * 16 + fr);
        asm volatile("" ::: "memory");
#pragma unroll
        for (int am = 0; am < 4; ++am) {
            const int ai = am >> 1, mb = (am & 1) * 2;
            v4u xl[2][2]; pg8::f32x4 gl[2][2][2]; float pv[2];
#pragma unroll
            for (int m = 0; m < 2; ++m) { const int t = tok[ai][mb + m] < 0 ? 0 : tok[ai][mb + m]; pv[m] = topp[(size_t)t * 2 + pass] * oscale; const float* gb = gmod + (size_t)(t >> 12) * MOD_LD + col0;
#pragma unroll
                for (int bj = 0; bj < 2; ++bj) { xl[m][bj] = *(const v4u*)(x + (size_t)t * XLD + col0 + bj * 128);
#pragma unroll
                    for (int n = 0; n < 2; ++n) gl[m][bj][n] = *(const pg8::f32x4*)(gb + bj * 128 + n * 4); } }
            asm volatile("" ::: "memory");
#pragma unroll
            for (int m = 0; m < 2; ++m) { if (tok[ai][mb + m] >= 0) { const int t = tok[ai][mb + m];
#pragma unroll
                for (int bj = 0; bj < 2; ++bj) { const v4u w = xl[m][bj];
                    const pg8::f32x4 x0 = {bf_lo(w.x), bf_hi(w.x), bf_lo(w.y), bf_hi(w.y)}, x1 = {bf_lo(w.z), bf_hi(w.z), bf_lo(w.w), bf_hi(w.w)};
                    pg8::f32x4 c0 = acc[ai][bj][mb + m][0], c1 = acc[ai][bj][mb + m][1];
                    if constexpr (Q_MDN == 2) { c0 = __builtin_convertvector(__builtin_bit_cast(pg8::v4i32_, c0), pg8::f32x4); c1 = __builtin_convertvector(__builtin_bit_cast(pg8::v4i32_, c1), pg8::f32x4); }
                    const pg8::f32x4 o0 = x0 + gl[m][bj][0] * pv[m] * c0, o1 = x1 + gl[m][bj][1] * pv[m] * c1;
                    v4u r; r.x = pk2(o0[0], o0[1]); r.y = pk2(o0[2], o0[3]); r.z = pk2(o1[0], o1[1]); r.w = pk2(o1[2], o1[3]);
                    *(v4u*)(x + (size_t)t * XLD + col0 + bj * 128) = r; } } }
            asm volatile("" ::: "memory");
        }
    }
};

__device__ __forceinline__ void p_final_norm(Frame& F, float* x, const float* w) {
    const int gw = F.bid * NWAVES + F.wave, NGW = F.G * NWAVES, lane = F.lane;
    f32x4 wv[4];
#pragma unroll
    for (int j = 0; j < 4; ++j) wv[j] = ((const f32x4*)w)[lane + 64 * j];
    for (int r0 = gw * 4; r0 < M; r0 += NGW * 4) {
        f32x4 v[4][4];
#pragma unroll
        for (int r = 0; r < 4; ++r)
#pragma unroll
            for (int j = 0; j < 4; ++j) v[r][j] = load_x4<true>(x, (size_t)(r0 + r), lane, j);
        asm volatile("s_waitcnt vmcnt(0)" ::: "memory");
#pragma unroll
        for (int r = 0; r < 4; ++r) { float s = 0.f;
#pragma unroll
            for (int j = 0; j < 4; ++j) s += (v[r][j].x * v[r][j].x + v[r][j].y * v[r][j].y) + (v[r][j].z * v[r][j].z + v[r][j].w * v[r][j].w);
            const float rstd = 1.0f / sqrtf(wave_sum(s, lane) * (1.0f / D) + EPS);
#pragma unroll
            for (int j = 0; j < 4; ++j) ((f32x4*)(x + (size_t)(r0 + r) * D))[lane + 64 * j] = v[r][j] * rstd * wv[j]; }
    }
}
__device__ __forceinline__ bool fresh(Frame& F) {
    int w_ = F.w0, b_ = blockIdx.x, g_ = gridDim.x; asm volatile("" : "+s"(w_), "+s"(b_), "+s"(g_));
    int l_; asm volatile("v_mbcnt_lo_u32_b32 %0, -1, 0\n\tv_mbcnt_hi_u32_b32 %0, -1, %0" : "=v"(l_));
    int t_ = w_ * 64 + l_;
    F.tid = t_; F.lane = t_ & 63; F.wave = __builtin_amdgcn_readfirstlane(t_ >> 6); F.bid = b_; F.G = g_; return true;
}
constexpr int NPL = 13, NPHASE = 1 + DEPTH * NPL;
#if MK_PER_PHASE
#define GRID_BAR() do { } while (0)
#else
#define GRID_BAR() do { XcdBarrier b2_ = bar; asm volatile("" : "+s"(b2_.bar)); xcd_barrier(b2_); } while (0)
#endif
#ifdef ONLY_REL
#define IN(k) (KA()->ph_lo <= (k) && (k) < KA()->ph_hi && fresh(F) && ((k) == 0 ? 100 : ((k) - 1) % NPL) == ONLY_REL && (ONLY_L < 0 || ((k) - 1) / NPL == ONLY_L))
#else
#define IN(k) (KA()->ph_lo <= (k) && (k) < KA()->ph_hi && fresh(F))
#endif
#define SEAM(k) do { if ((k) + 1 < KA()->ph_hi) GRID_BAR(); } while (0)
template <int l>
__device__ __forceinline__ void layer_program(Frame& F, const XcdBarrier& bar, PG8_LAS unsigned char* ring) {
        const int pb = 1 + l * NPL;
#define WSP(off) (ka->ws + (off))
#define QSV(slot) (((const float*)WSP(WS_QS))[slot])
#define MODL ((const float*)WSP(WS_MOD) + (size_t)l * BATCH * MOD_LD)
#define WMIXL ((bf16*)WSP(WS_WMIX))
        if (IN(pb + 0)) {
#pragma unroll 1
          for (int rep = 0; rep < REPS(7); ++rep) { KArgs ka = KA(); p_norm<HQ_MIX == 0 ? 0 : (H_BF ? 2 : 1), l != 0, HQ_MIX ? HQ_MIX : 2>(F, l == 0 ? (const void*)ka->in[0] : (const void*)ka->out, ka->in[4] + l * D, MODL, 1 * D, 0, (HQ_MIX && !H_BF) ? (bf16*)WSP(WS_H8) : (bf16*)WSP(WS_H), WSP(WS_H8), sa_of(HQ_MIX, l == 0 ? CLIP_MIX0 : CLIP_MIX1)); }
          SEAM(pb + 0); }
        if (IN(pb + 1)) {
            KArgs ka = KA();
            constexpr int KD = Q_PROJ ? D / 2 : D;
            pg8::Gemm g{Q_PROJ ? (bf16*)WSP(WS_H8) : (bf16*)WSP(WS_H), WMIXL, KD, KD, KD}; pg8::StaticOrder S; S.init(M / 256, N_BCA / 256, F.G, F.bid);
            pg8::EpiBf16<Q_PROJ> E{(bf16*)WSP(WS_P1), N_BCA, uni((Q_PROJ ? 1.0f / (sa_of(Q_PROJ, l == 0 ? CLIP_MIX0 : CLIP_MIX1) * (Q_PROJ == 2 ? QSV(QS_IN) : F8_SW)) : 1.0f) / (float)REPS(8) / (float)REPS(15))};
#pragma unroll 1
            for (int rep = 0; rep < REPS(3); ++rep)
            pg8::gemm_phase<REPS(8), Q_PROJ, REPS(15)>(ring, g, S, E, F.tid); SEAM(pb + 1);
        }
        if (IN(pb + 2)) {
#define THIN_H1() { KArgs ka = KA(); p_hgrn<1>(F, (const bf16*)WSP(WS_P1), ka->in[8], l, ka->in[9] + l * D_BV, (bf16*)WSP(WS_YB), (float*)WSP(WS_HU), (float*)WSP(WS_HD)); }
#define THIN_SC() { { KArgs ka = KA(); p_sgu(F, (const bf16*)WSP(WS_P1), ka->in[10] + l * D_C, ka->in[11] + (size_t)l * 4 * 128 * 128, ka->in[12] + l * 4 * 128, (bf16*)WSP(WS_YC)); } \
                    { KArgs ka = KA(); p_conv(F, (const bf16*)WSP(WS_P1), ka->in[7] + l * 3 * D_A, (bf16*)WSP(WS_YA)); } }
#pragma unroll 1
          for (int rep = 0; rep < REPS(1); ++rep) {
            __syncthreads();
            if ((F.bid >> 3) & 1) { THIN_H1(); __syncthreads(); fresh(F); THIN_SC(); }
            else { THIN_SC(); __syncthreads(); fresh(F); THIN_H1(); }
          }
#undef THIN_H1
#undef THIN_SC
            SEAM(pb + 2);
        }
        if (IN(pb + 3)) {
#pragma unroll 1
          for (int rep = 0; rep < REPS(2); ++rep)
            { KArgs ka = KA(); p_hgrn<2>(F, (const bf16*)WSP(WS_P1), ka->in[8], l, ka->in[9] + l * D_BV, (bf16*)WSP(WS_YB), (float*)WSP(WS_HU), (float*)WSP(WS_HD)); }
            SEAM(pb + 3);
        }
        if (IN(pb + 5)) {
            { KArgs ka = KA();
              pg8::GateOrder S; S.so.init(M / 256, D / 256, F.G, F.bid);
              if constexpr (Q_GATE != 0) { pg8::Gemm g{(bf16*)WSP(WS_H8), (bf16*)WSP(WS_WMIX + WMIX_G8), D / 2, D / 2, D / 2};
                  EpiGateU8<Q_GATE> E{(unsigned char*)WSP(WS_PG), uni(1.0f / (sa_of(Q_GATE, l == 0 ? CLIP_MIX0 : CLIP_MIX1) * (Q_GATE == 2 ? QSV(QS_IN) : F8_SW)))};
                  pg8::gemm_phase<1, Q_GATE>(ring, g, S, E, F.tid); }
              else { pg8::Gemm g{(bf16*)WSP(WS_H), WMIXL + (size_t)N_BCA * D, D, D, D};
                  pg8::EpiBf16<0> E{(bf16*)WSP(WS_PG), N_G, 1.0f};
                  pg8::gemm_phase(ring, g, S, E, F.tid); } }
            { KArgs ka = KA();
              constexpr int KB = Q_BR ? 256 : 512;
              pg8::Gemm g{(bf16*)WSP(WS_YA), WMIXL + (size_t)N_IN * D, KB, KB, KB, (size_t)32 * MiB, (size_t)512 * 1024 * (Q_BR ? 1 : 2)}; pg8::BranchOrder S; S.so.init(M / 256, D / 256, F.G, F.bid);
              EpiBranch<Q_GATE != 0, Q_BR, Q_WO> E{(const bf16*)WSP(WS_PG), (bf16*)WSP(WS_MRG), (const float*)WSP(WS_QS) + QS_BR, WSP(WS_MRG8)};
              pg8::gemm_phase<1, Q_BR>(ring, g, S, E, F.tid); }
            SEAM(pb + 5);
        }
        if (IN(pb + 6)) {
            KArgs ka = KA();
            constexpr int KO = Q_WO ? D / 2 : D;
            pg8::Gemm g{Q_WO ? (bf16*)WSP(WS_MRG8) : (bf16*)WSP(WS_MRG), WMIXL + (size_t)N_IN * D + 3 * 512 * 1024, KO, KO, KO}; pg8::StaticOrder S; S.init(M / 256, D / 256, F.G, F.bid);
            EpiResid<l == 0, Q_WO> E{l == 0 ? (const void*)ka->in[0] : (const void*)ka->out, (bf16*)ka->out, MODL + 2 * D, Q_WO == 2 ? CLIP_MRG / 127.0f : 1.0f, Q_WO == 2 ? uni(QSV(QS_WO)) : 1.0f};
            pg8::gemm_phase<1, Q_WO>(ring, g, S, E, F.tid); SEAM(pb + 6);
        }
        if (l == 0) {
            constexpr int FES = Q_FUP ? 1 : 2, FDS = Q_FDN ? 1 : 2;
            if (IN(pb + 7)) { KArgs ka = KA(); p_norm<Q_FUP ? 1 : 0, true, Q_FUP ? Q_FUP : 2>(F, (const void*)ka->out, ka->in[5] + l * D, MODL, 4 * D, 3 * D, (bf16*)WSP(WS_H), nullptr, sa_of(Q_FUP, CLIP_FFN)); __syncthreads(); p_convert_mixer(F, KA(), 1, false);     SEAM(pb + 7); }
            if (IN(pb + 8)) {
                KArgs ka = KA();
                pg8::Gemm g{(bf16*)WSP(WS_H), (bf16*)WSP(WS_W13), D * FES / 2, D * FES / 2, D * FES / 2}; pg8::StaticOrder S; S.init(M / 256, N13 / 256, F.G, F.bid);
                EpiSwiglu<Q_FUP, Q_FDN> E{(bf16*)WSP(WS_ACT), uni(1.0f / (sa_of(Q_FUP, CLIP_FFN) * QSV(QS_F13)))};
                pg8::gemm_phase<1, Q_FUP>(ring, g, S, E, F.tid); SEAM(pb + 8);
            }
            if (IN(pb + 9)) {
                KArgs ka = KA();
                pg8::Gemm g{(bf16*)WSP(WS_ACT), (bf16*)WSP(WS_W2), D_FF * FDS / 2, D_FF * FDS / 2, D_FF * FDS / 2}; pg8::StaticOrder S; S.init(M / 256, D / 256, F.G, F.bid);
                EpiResid<false, Q_FDN> E{(const void*)ka->out, (bf16*)ka->out, MODL + 5 * D, Q_FDN == 2 ? CLIP_ACT / 127.0f : (Q_FDN ? 1.0f / (F8_SACT * F8_SW) : 1.0f), Q_FDN == 2 ? uni(QSV(QS_F2)) : 1.0f};
                pg8::gemm_phase<1, Q_FDN>(ring, g, S, E, F.tid); SEAM(pb + 9);
            }
        } else {
            if (IN(pb + 7)) {
#pragma unroll 1
                for (int rep = 0; rep < REPS(6); ++rep) { __syncthreads(); p_moe_weights(F, KA()); }
                __syncthreads(); { KArgs ka = KA(); p_norm_router(F, ka, (const void*)ka->out, ka->in[5] + l * D, MODL, (bf16*)WSP(WS_H2M)); } SEAM(pb + 7); }
            constexpr size_t ACT_BYTES = (size_t)MOE_ROWS * D_FF * MOE_ES;
#define MOE_UP(pass_, T_, HC_) do { KArgs ka = KA(); \
                    const LAS int* tab = (const LAS int*)(F.lds + TAB_OFF) + (pass_) * 256; \
                    MoeOrder<true> S; S.so.init(tab[16], N13 / 256, F.G, F.bid); S.tab = tab; S.list = (const int*)WSP(WS_LIST) + (size_t)(pass_) * 8 * LIST_CAP; S.npn = N13 / 256; S.rowbytes = D * MOE_ES; S.T = (T_); S.HC = (HC_); \
                    pg8::Gemm g{(bf16*)WSP(WS_H2M), (bf16*)WSP(WS_WM13), D * MOE_ES / 2, D * MOE_ES / 2, D * MOE_ES / 2}; \
                    EpiSwiglu<Q_MUP, Q_MDN> E{(bf16*)WSP(WS_ACTM + (pass_) * ACT_BYTES), uni(1.0f / (sa_of(Q_MUP, CLIP_MOE) * QSV(QS_M13)))}; \
                    pg8::gemm_phase<1, Q_MUP>(ring, g, S, E, F.tid); } while (0)
#define MOE_DOWN(pass_) do { KArgs ka = KA(); \
                    const LAS int* tab = (const LAS int*)(F.lds + TAB_OFF) + (pass_) * 256; \
                    MoeOrder<false> S; S.so.init(tab[16], D / 256, F.G, F.bid); S.tab = tab; S.list = (const int*)WSP(WS_LIST) + (size_t)(pass_) * 8 * LIST_CAP; S.npn = D / 256; S.rowbytes = 0; \
                    pg8::Gemm g{(bf16*)WSP(WS_ACTM + (pass_) * ACT_BYTES), (bf16*)WSP(WS_WM2), D_FF * MOE_ES / 2, D_FF * MOE_ES / 2, D_FF * MOE_ES / 2}; \
                    EpiMoeDown E{(bf16*)ka->out, MODL + 5 * D, (const float*)WSP(WS_TOPP), (pass_), tab, S.list, Q_MDN == 2 ? uni(CLIP_ACT / (127.0f * QSV(QS_M2))) : 1.0f / (F8_SACT * F8_SW)}; \
                    pg8::gemm_phase<1, Q_MDN>(ring, g, S, E, F.tid); } while (0)
            if (IN(pb + 8)) { { KArgs ka = KA(); moe_tables(F, (unsigned*)WSP(WS_CTL), 0); } MOE_UP(0, 0, 0); SEAM(pb + 8); }
            if (IN(pb + 9)) {
                { KArgs ka = KA(); moe_tables(F, (unsigned*)WSP(WS_CTL), 0); moe_tables(F, (unsigned*)WSP(WS_CTL), 1); }
                MOE_DOWN(0);
                { const LAS int* tab0 = (const LAS int*)(F.lds + TAB_OFF); const int nd = tab0[16] * (D / 256);
                  MOE_UP(1, nd % F.G, 3); }
                SEAM(pb + 9);
            }
            if (IN(pb + 11)) { { KArgs ka = KA(); moe_tables(F, (unsigned*)WSP(WS_CTL), 1); } MOE_DOWN(1); SEAM(pb + 11); }
#undef MOE_UP
#undef MOE_DOWN
            if (IN(pb + 12)) { KArgs ka = KA(); p_final_norm(F, ka->out, ka->in[25]); }
        }
}
__global__ void __launch_bounds__(NT, 2) fwd(Args args) {
    extern __shared__ __attribute__((aligned(16))) unsigned char lds[];
    Frame F;
    F.lds = (LAS unsigned char*)lds;
    F.tid = threadIdx.x; F.lane = F.tid & 63; F.wave = __builtin_amdgcn_readfirstlane(F.tid >> 6); F.w0 = F.wave;
    F.G = gridDim.x; F.bid = blockIdx.x;
    volatile LAS unsigned* MISC = (volatile LAS unsigned*)(F.lds + MISC_OFF);
    if (F.tid < 32) MISC[F.tid] = 0u;
    __syncthreads();
#if !MK_PER_PHASE
    XcdBarrier bar = xcd_barrier_post((unsigned*)(KA()->ws + WS_CTL) + CW_BAR, MISC + 8);
#else
    XcdBarrier bar; bar.bar = nullptr; bar.x = 0; bar.st = nullptr;
#endif
    PG8_LAS unsigned char* ring = (PG8_LAS unsigned char*)lds;

    if (IN(0)) {
#pragma unroll 1
        for (int rep = 0; rep < REPS(5); ++rep) { __syncthreads(); p_prologue(F, KA()); __syncthreads(); p_convert_mixer(F, KA(), 0, true); }
        SEAM(0); }

    layer_program<0>(F, bar, ring);
    layer_program<1>(F, bar, ring);
#undef IN
#undef SEAM
}

extern "C" void kernel_launch(void* const* d_in, const int* in_sizes, int n_in, void* d_out, int out_size, void* d_ws, size_t ws_size, hipStream_t stream) {
    static int grid = 0;
    if (grid == 0) {
        if (n_in != 26 || in_sizes[0] != M * D || out_size != M * D || ws_size < WS_NEED) { fprintf(stderr, "kernel_launch: unexpected shapes / workspace (n_in %d, ws %zu, need %zu); nothing launched\n", n_in, ws_size, (size_t)WS_NEED); grid = -1; return; }
        int dev = 0, cus = 0, per_cu = 0;
        if (hipGetDevice(&dev) != hipSuccess || hipDeviceGetAttribute(&cus, hipDeviceAttributeMultiprocessorCount, dev) != hipSuccess) { grid = -1; return; }
        if (hipFuncSetAttribute((const void*)fwd, hipFuncAttributeMaxDynamicSharedMemorySize, LDS_BYTES) != hipSuccess) { fprintf(stderr, "kernel_launch: hipFuncSetAttribute failed\n"); grid = -1; return; }
        if (hipOccupancyMaxActiveBlocksPerMultiprocessor(&per_cu, (const void*)fwd, NT, LDS_BYTES) != hipSuccess || per_cu < 1) fprintf(stderr, "kernel_launch: occupancy query reports %d\n", per_cu);
        (void)hipGetLastError();
        grid = cus;
    }
    if (grid < 0) return;
    if (hipMemsetAsync((char*)d_ws + WS_CTL, 0, CTL_ZERO_BYTES, stream) != hipSuccess) return;
    Args a{};
    for (int i = 0; i < 26; ++i) a.in[i] = (const float*)d_in[i];
    a.out = (float*)d_out; a.ws = (unsigned char*)d_ws;
#if MK_PER_PHASE
    for (int p = 0; p < NPHASE; ++p) {
        if ((p >= 1 + 10 && p <= 1 + 12) || p == 1 + 4 || p == 1 + NPL + 4 || p == 1 + NPL + 10) continue;
        a.ph_lo = p; a.ph_hi = p + 1;
        hipLaunchKernelGGL(fwd, dim3(grid), dim3(NT), LDS_BYTES, stream, a);
    }
#else
    a.ph_lo = 0; a.ph_hi = NPHASE;
    hipLaunchKernelGGL(fwd, dim3(grid), dim3(NT), LDS_BYTES, stream, a);
#endif
}
```

```cpp
#include <hip/hip_runtime.h>
#include <cstdio>
#include <cstdint>

#ifndef PROBE_DUP
#define PROBE_DUP 0
#endif
#ifndef PROBE_REPS
#define PROBE_REPS 2
#endif
#define REPS(k) ((PROBE_DUP == (k)) ? PROBE_REPS : 1)
#ifndef Q_PROJ
#define Q_PROJ 2
#endif
#ifndef Q_GATE
#define Q_GATE 2
#endif
#ifndef Q_FUP
#define Q_FUP 2
#endif
#ifndef Q_FDN
#define Q_FDN 2
#endif
#ifndef Q_MUP
#define Q_MUP 2
#endif
#ifndef Q_MDN
#define Q_MDN 2
#endif
#ifndef Q_BR
#define Q_BR 2
#endif
#ifndef Q_WO
#define Q_WO 2
#endif
#ifndef MK_PER_PHASE
#define MK_PER_PHASE 0
#endif

namespace pg8 {
#define PG8_LAS __attribute__((address_space(3)))
typedef unsigned short bf16_t;
typedef short bf16x8 __attribute__((ext_vector_type(8)));
typedef float f32x4 __attribute__((ext_vector_type(4)));
typedef unsigned u32x4 __attribute__((ext_vector_type(4)));
typedef int v4i32_ __attribute__((ext_vector_type(4)));
constexpr int BM = 256, BK = 64, HALF = 128, HTB = HALF * BK * 2, STAGE_BYTES = 8 * HTB, NXCD = 8, WGM = 8;

__host__ __device__ __forceinline__ int lds_byte(int r, int c) { const int st = (r >> 4) * 2 + (c >> 5), rr = r & 15, cc = c & 31, ob = rr * 64 + cc * 2; return st * 1024 + (ob ^ (((ob >> 9) & 1) << 5)); }
__host__ __device__ __forceinline__ void stage_rc(int b, int& R, int& C) { const int st = b / 1024, sb = b % 1024, swz = sb ^ (((sb >> 9) & 1) << 5); R = (st >> 1) * 16 + swz / 64; C = (st & 1) * 32 + (swz % 64) / 2; }
__host__ __device__ __forceinline__ int perm32(int rho) { const int n = rho >> 4, i = rho & 15; return 8 * (i >> 2) + 4 * n + (i & 3); }

struct Unit { int pm, pn, pb, aux; };
struct Gemm { const bf16_t* A; const bf16_t* Bt; int lda, ldb, K; size_t astride = 0, bstride = 0; };

struct StaticOrder {
    static constexpr bool GATHER = false;
    int nM, nN, nwg, G, c;
    __device__ __forceinline__ void init(int nM_, int nN_, int G_, int c_) { nM = nM_; nN = nN_; nwg = nM * nN; G = G_; c = c_; }
    __device__ __forceinline__ bool next(int i, Unit& u) const { return unit_of((long)i * G + c, u); }
    __device__ __forceinline__ bool unit_of(long L, Unit& u) const {
        if (L >= nwg) return false;
        int wgid = (int)L; { const int q = nwg / NXCD, r = nwg % NXCD, xcd = wgid % NXCD, off = wgid / NXCD; wgid = (xcd < r ? xcd * (q + 1) : r * (q + 1) + (xcd - r) * q) + off; }
        const int nig = WGM * nN, gid = wgid / nig, fm = gid * WGM, gsz = (nM - fm) < WGM ? (nM - fm) : WGM;
        u.pm = fm + ((wgid % nig) % gsz); u.pn = (wgid % nig) / gsz; u.pb = u.pn; u.aux = 0; return true;
    }
    __device__ __forceinline__ unsigned a_row_off(const Unit&, int) const { return 0u; }
};

struct GateOrder {
    static constexpr bool GATHER = false;
    StaticOrder so;
    __device__ __forceinline__ bool next(int k, Unit& u) const { Unit b; if (!so.next(k / 3, b)) return false; u.pm = b.pm; u.pn = b.pn + 4 * (k % 3); u.pb = u.pn; u.aux = 0; return true; }
    __device__ __forceinline__ unsigned a_row_off(const Unit&, int) const { return 0u; }
};
struct BranchOrder {
    static constexpr bool GATHER = false;
    StaticOrder so;
    __device__ __forceinline__ bool next(int k, Unit& u) const { Unit b; if (!so.next(k / 3, b)) return false; u.pm = b.pm; u.pn = b.pn; u.pb = b.pn; u.aux = (k % 3 + 1) % 3; return true; }
    __device__ __forceinline__ unsigned a_row_off(const Unit&, int) const { return 0u; }
};
__device__ __forceinline__ unsigned cvt_pk_bf16(float lo, float hi) { unsigned r; asm volatile("v_cvt_pk_bf16_f32 %0, %1, %2" : "=v"(r) : "v"(lo), "v"(hi)); return r; }

template <int Q = 0>
struct EpiBf16 {
    static constexpr bool PERM = true;
    bf16_t* O; int ldc; float scale;
    __device__ __forceinline__ void operator()(const f32x4 (&acc)[2][2][4][2], const Unit& u, int wr, int wc, int fr, int fq) const {
        const int row0 = u.pm * BM + wr * 64 + fr, col0 = u.pn * BM + wc * 32 + 8 * fq;
#pragma unroll 1
        for (int erep = 0; erep < REPS(9); ++erep)
#pragma unroll
        for (int ai = 0; ai < 2; ++ai)
#pragma unroll
            for (int m = 0; m < 4; ++m) { bf16_t* rowp = O + (size_t)(row0 + ai * HALF + m * 16) * ldc + col0;
#pragma unroll
                for (int bj = 0; bj < 2; ++bj) { f32x4 v0 = acc[ai][bj][m][0], v1 = acc[ai][bj][m][1];
                    if constexpr (Q == 2) { v0 = __builtin_convertvector(__builtin_bit_cast(v4i32_, v0), f32x4); v1 = __builtin_convertvector(__builtin_bit_cast(v4i32_, v1), f32x4); }
                    v0 *= scale; v1 *= scale;
                    u32x4 w; w.x = cvt_pk_bf16(v0[0], v0[1]); w.y = cvt_pk_bf16(v0[2], v0[3]); w.z = cvt_pk_bf16(v1[0], v1[1]); w.w = cvt_pk_bf16(v1[2], v1[3]);
                    *(u32x4*)(rowp + bj * HALF) = w; } }
    }
};

typedef int v8i32 __attribute__((ext_vector_type(8)));
typedef int v4i32 __attribute__((ext_vector_type(4)));
template <int KREP = 1, int Q = 0, int MREP = 1, class Epi, class Sched>
__device__ __forceinline__ void gemm_phase(PG8_LAS unsigned char* lds, const Gemm g, const Sched& S, const Epi& E, int tid_in) {
    constexpr bool GATHER = Sched::GATHER;
    int tid_ = tid_in; asm volatile("" : "+v"(tid_));
    const int tid = tid_, wid = __builtin_amdgcn_readfirstlane(tid >> 6), lane = tid & 63, wr = wid >> 2, wc = wid & 3, fr = lane & 15, fq = lane >> 4;
    const int K = g.K, nt = K / BK;
    unsigned voffB[2], vA0[2], vA1[2], nA0[2], nA1[2];
#pragma unroll
    for (int i = 0; i < 2; ++i) { int R, C; stage_rc(tid * 16 + i * 8192, R, C); const int Rb = Epi::PERM ? ((R & ~31) + perm32(R & 31)) : R;
        voffB[i] = (unsigned)(Rb * g.ldb + C) * 2u;
        vA0[i] = (unsigned)(R * g.lda + C) * 2u; vA1[i] = vA0[i]; nA0[i] = vA0[i]; nA1[i] = vA0[i]; }
    const size_t kstep = (size_t)(BK * 2);
    const size_t hstepB = (size_t)HALF * g.ldb * 2, tstepB = 2 * hstepB, tstepA = (size_t)BM * g.lda * 2;
    const size_t hstepA = GATHER ? (size_t)0 : (size_t)HALF * g.lda * 2;
    const unsigned ldsw = (unsigned)wid * 1024u;
    const int aoff = lds_byte(wr * 64 + fr, fq * 8), boff = lds_byte(wc * 32 + fr, fq * 8);
    PG8_LAS unsigned char* aptr = lds + aoff; PG8_LAS unsigned char* bptr = lds + 4 * HTB + boff; asm volatile("" : "+v"(aptr), "+v"(bptr));
#define PG8_SA(b, h) (((b) * 2 + (h)) * HTB)
#define PG8_SB(b, h) ((4 + (b) * 2 + (h)) * HTB)
#define PG8_STAGE(bufoff, gbase, voff) do { _Pragma("unroll") for (int _i = 0; _i < 2; ++_i) \
        __builtin_amdgcn_global_load_lds((const unsigned*)((const char*)(gbase) + (voff)[_i]), (PG8_LAS unsigned*)(lds + (bufoff) + ldsw + _i * 8192), 16, 0, 0); } while (0)
#define PG8_CAT8(x0, x1) __builtin_shufflevector(__builtin_bit_cast(v4i32, x0), __builtin_bit_cast(v4i32, x1), 0, 1, 2, 3, 4, 5, 6, 7)
#define PG8_RDA(off) (*(const PG8_LAS bf16x8*)(aptr + (off)))
#define PG8_RDB(off) (*(const PG8_LAS bf16x8*)(bptr + (off)))
#define PG8_LDA(dst, b, h) do { if constexpr (Q == 1) { _Pragma("unroll") for (int m = 0; m < 4; ++m) dst##8[m] = PG8_CAT8(PG8_RDA(PG8_SA(b, h) + m * 2048), PG8_RDA(PG8_SA(b, h) + m * 2048 + 1024)); } \
        else { _Pragma("unroll") for (int m = 0; m < 4; ++m) _Pragma("unroll") for (int k = 0; k < 2; ++k) dst[m][k] = PG8_RDA(PG8_SA(b, h) + m * 2048 + k * 1024); } } while (0)
#define PG8_LDB(dst, b, h) do { if constexpr (Q == 1) { _Pragma("unroll") for (int n = 0; n < 2; ++n) dst##8[n] = PG8_CAT8(PG8_RDB(PG8_SB(b, h) - 4 * HTB + n * 2048), PG8_RDB(PG8_SB(b, h) - 4 * HTB + n * 2048 + 1024)); } \
        else { _Pragma("unroll") for (int n = 0; n < 2; ++n) _Pragma("unroll") for (int k = 0; k < 2; ++k) dst[n][k] = PG8_RDB(PG8_SB(b, h) - 4 * HTB + n * 2048 + k * 1024); } } while (0)
#define PG8_MMA(ai, bj, At, Bt) do { __builtin_amdgcn_s_setprio(1); _Pragma("unroll") for (int r_ = 0; r_ < MREP; ++r_) { \
        if constexpr (Q == 2) { _Pragma("unroll") for (int m = 0; m < 4; ++m) _Pragma("unroll") for (int n = 0; n < 2; ++n) _Pragma("unroll") for (int k = 0; k < 2; ++k) \
            acc[ai][bj][m][n] = __builtin_bit_cast(f32x4, __builtin_amdgcn_mfma_i32_16x16x64_i8(__builtin_bit_cast(v4i32, Bt[n][k]), __builtin_bit_cast(v4i32, At[m][k]), __builtin_bit_cast(v4i32, acc[ai][bj][m][n]), 0, 0, 0)); } \
        else if constexpr (Q == 1) { _Pragma("unroll") for (int m = 0; m < 4; ++m) _Pragma("unroll") for (int n = 0; n < 2; ++n) \
            asm volatile("v_mfma_scale_f32_16x16x128_f8f6f4 %0, %1, %2, %0, %3, %3 op_sel_hi:[0,0,0]" : "+v"(acc[ai][bj][m][n]) : "v"(Bt##8[n]), "v"(At##8[m]), "v"(sc1)); } \
        else { _Pragma("unroll") for (int m = 0; m < 4; ++m) _Pragma("unroll") for (int n = 0; n < 2; ++n) _Pragma("unroll") for (int k = 0; k < 2; ++k) \
            acc[ai][bj][m][n] = __builtin_amdgcn_mfma_f32_16x16x32_bf16(Bt[n][k], At[m][k], acc[ai][bj][m][n], 0, 0, 0); } } \
        __builtin_amdgcn_s_setprio(0); } while (0)
#define PG8_WAIT_V(n) asm volatile("s_waitcnt vmcnt(" #n ")" ::: "memory")
#define PG8_WAIT_L(n) asm volatile("s_waitcnt lgkmcnt(" #n ")" ::: "memory")
#define PG8_BAR __builtin_amdgcn_s_barrier()
#define PG8_SCHED __builtin_amdgcn_sched_barrier(0)
#define PG8_GOFF(unit, d0, d1) do { _Pragma("unroll") for (int _i = 0; _i < 2; ++_i) { int R_, C_; stage_rc(tid * 16 + _i * 8192, R_, C_); \
        d0[_i] = S.a_row_off(unit, R_) + (unsigned)C_ * 2u; d1[_i] = S.a_row_off(unit, R_ + HALF) + (unsigned)C_ * 2u; } } while (0)
    Unit cur, nxt; int ui = 0;
    if (!S.next(0, cur)) return;
    f32x4 acc[2][2][4][2];
#pragma unroll
    for (int a = 0; a < 2; ++a)
#pragma unroll
        for (int b = 0; b < 2; ++b)
#pragma unroll
            for (int m = 0; m < 4; ++m)
#pragma unroll
                for (int n = 0; n < 2; ++n) acc[a][b][m][n] = (f32x4){0.f, 0.f, 0.f, 0.f};
    bf16x8 At[4][2], B0[2][2], B1[2][2];
    v8i32 At8[4], B08[2], B18[2];
    const int sc1 = 0x7f7f7f7f;
    if constexpr (GATHER) { PG8_GOFF(cur, vA0, vA1); }
    const char* cA = GATHER ? (const char*)g.A : (const char*)g.A + (size_t)cur.aux * g.astride + (size_t)cur.pm * tstepA; const char* cB = (const char*)g.Bt + (size_t)cur.aux * g.bstride + (size_t)cur.pb * tstepB;
    PG8_STAGE(PG8_SB(0, 0), cB, voffB); PG8_STAGE(PG8_SB(0, 1), cB + hstepB, voffB); PG8_STAGE(PG8_SA(0, 0), cA, vA0); PG8_STAGE(PG8_SA(0, 1), cA + hstepA, vA1);
    if (wr == 1) PG8_BAR;
    PG8_WAIT_V(2); PG8_BAR;
    PG8_STAGE(PG8_SB(1, 0), cB + kstep, voffB); PG8_STAGE(PG8_SA(1, 0), cA + kstep, vA0); PG8_STAGE(PG8_SB(1, 1), cB + hstepB + kstep, voffB);
    PG8_WAIT_V(6); PG8_BAR;
    for (;;) {
        const bool has_next = S.next(ui + 1, nxt);
        const char* nA = GATHER ? (const char*)g.A : (has_next ? (const char*)g.A + (size_t)nxt.aux * g.astride + (size_t)nxt.pm * tstepA : cA); const char* nB = has_next ? (const char*)g.Bt + (size_t)nxt.aux * g.bstride + (size_t)nxt.pb * tstepB : cB;
        if constexpr (GATHER) { if (has_next) { PG8_GOFF(nxt, nA0, nA1); } else {
#pragma unroll
            for (int i = 0; i < 2; ++i) { nA0[i] = vA0[i]; nA1[i] = vA1[i]; } } }
#pragma unroll 1
        for (int t = 0; t < nt * KREP; t += 2) {
            const bool last = (t == nt * KREP - 2);
            const int t1 = (KREP == 1) ? t + 1 : ((t + 1) & (nt - 1)), t2 = (KREP == 1) ? t + 2 : ((t + 2) & (nt - 1));
            const char* a1 = cA + (size_t)t1 * kstep;
            const char* a2 = last ? nA : cA + (size_t)t2 * kstep; const char* b2 = last ? nB : cB + (size_t)t2 * kstep;
            const char* a3 = a2 + kstep; const char* b3 = b2 + kstep;
            unsigned s0[2], s1[2];
#pragma unroll
            for (int i = 0; i < 2; ++i) { s0[i] = (GATHER && last) ? nA0[i] : vA0[i]; s1[i] = GATHER ? (last ? nA1[i] : vA1[i]) : vA0[i]; }
            PG8_LDB(B0, 0, 0); PG8_LDB(B1, 0, 1); PG8_SCHED; PG8_LDA(At, 0, 0); PG8_STAGE(PG8_SA(1, 1), a1 + hstepA, vA1);
            PG8_WAIT_V(8); PG8_WAIT_L(0); PG8_BAR; PG8_MMA(0, 0, At, B0); PG8_MMA(0, 1, At, B1); PG8_BAR; PG8_SCHED;
            PG8_LDA(At, 0, 1); PG8_STAGE(PG8_SB(0, 0), b2, voffB); PG8_STAGE(PG8_SB(0, 1), b2 + hstepB, voffB); PG8_STAGE(PG8_SA(0, 0), a2, s0);
            PG8_WAIT_V(8); PG8_WAIT_L(0); PG8_BAR; PG8_MMA(1, 0, At, B0); PG8_MMA(1, 1, At, B1); PG8_BAR; PG8_SCHED;
            PG8_LDB(B0, 1, 0); PG8_LDB(B1, 1, 1); PG8_SCHED; PG8_LDA(At, 1, 0); PG8_STAGE(PG8_SA(0, 1), a2 + hstepA, s1);
            PG8_WAIT_V(8); PG8_WAIT_L(0); PG8_BAR; PG8_MMA(0, 0, At, B0); PG8_MMA(0, 1, At, B1); PG8_BAR; PG8_SCHED;
            PG8_LDA(At, 1, 1); PG8_STAGE(PG8_SB(1, 0), b3, voffB); PG8_STAGE(PG8_SB(1, 1), b3 + hstepB, voffB); PG8_STAGE(PG8_SA(1, 0), a3, s0);
            PG8_WAIT_V(8); PG8_WAIT_L(0); PG8_BAR; PG8_MMA(1, 0, At, B0); PG8_MMA(1, 1, At, B1); PG8_BAR; PG8_SCHED;
        }
        if (wr == 0) PG8_BAR;
        E(acc, cur, wr, wc, fr, fq);
        if (!has_next) break;
#pragma unroll
        for (int a = 0; a < 2; ++a)
#pragma unroll
            for (int b = 0; b < 2; ++b)
#pragma unroll
                for (int m = 0; m < 4; ++m)
#pragma unroll
                    for (int n = 0; n < 2; ++n) acc[a][b][m][n] = (f32x4){0.f, 0.f, 0.f, 0.f};
        cur = nxt; cA = nA; cB = nB; ++ui;
        if constexpr (GATHER) {
#pragma unroll
            for (int i = 0; i < 2; ++i) { vA0[i] = nA0[i]; vA1[i] = nA1[i]; } }
        if (wr == 1) PG8_BAR;
    }
    PG8_WAIT_V(0);
    PG8_BAR;
#undef PG8_SA
#undef PG8_SB
#undef PG8_STAGE
#undef PG8_LDA
#undef PG8_LDB
#undef PG8_MMA
#undef PG8_WAIT_V
#undef PG8_WAIT_L
#undef PG8_BAR
#undef PG8_SCHED
#undef PG8_GOFF
#undef PG8_CAT8
#undef PG8_RDA
#undef PG8_RDB
}
}

constexpr int D = 1024, BATCH = 8, SEQ = 4096, M = BATCH * SEQ, DEPTH = 2;
constexpr int D_A = 512, D_BK = 512, D_BV = 512, D_C = 512, H_B = 4;
constexpr int N_IN = 7680, N_BCA = 4608, N_G = 3072;
constexpr int P1_PITCH = 1536 + 4096 + 1024, P1_OB = 1536, P1_OC = 5632, P1E = P1_PITCH / 2;
#ifndef CLIP_P1
#define CLIP_P1 5.5f
#endif
constexpr int D_FF = 2816, NE = 8, N13 = 2 * D_FF;
constexpr int MOD_LD = 6 * D;
constexpr float EPS = 1e-6f;
constexpr int XLD = 2 * D;
constexpr int LIST_CAP = M;
constexpr int MOE_ROWS = M + NE * 256;

constexpr size_t MiB = 1u << 20;
constexpr size_t WS_CTL = 0, CTL_ZERO_BYTES = 1 * MiB;
constexpr size_t WS_MOD = 1 * MiB;
constexpr size_t WS_TOPP = 2 * MiB;
constexpr size_t WS_QS = 2 * MiB + 768 * 1024;
constexpr size_t WS_LIST = 3 * MiB;
constexpr size_t WS_WMIX = 6 * MiB;
constexpr size_t WMIX_G8 = 9 * MiB;
constexpr size_t WS_W13 = 26 * MiB, WS_W2 = 37 * MiB;
constexpr size_t WS_BIG = 44 * MiB;
constexpr size_t WS_H = WS_BIG;
constexpr size_t WS_P1 = WS_BIG + 64 * MiB;
constexpr size_t WS_PG = WS_P1;
constexpr size_t WS_MRG = WS_P1 + 192 * MiB;
constexpr size_t WS_MRG8 = WS_P1 + 256 * MiB;
constexpr size_t WS_YA = WS_P1 + 288 * MiB, WS_YB = WS_YA + 32 * MiB, WS_YC = WS_YB + 32 * MiB;
constexpr size_t WS_ACT = WS_P1;
constexpr size_t WS_HU = WS_YC + 32 * MiB;
constexpr size_t WS_HD = WS_HU + 16 * MiB;
constexpr size_t WS_H8 = WS_HD + 1 * MiB;
constexpr size_t WS_MIX_END = WS_H8 + 32 * MiB;
static_assert((Q_PROJ == 0 || Q_GATE == 0 || Q_PROJ == Q_GATE) && Q_MDN != 0 && Q_MUP != 0, "supported operand encodings");
constexpr int HQ_MIX = Q_PROJ ? Q_PROJ : Q_GATE;
constexpr bool H_BF = (Q_PROJ == 0 || Q_GATE == 0);
constexpr float F8_SW = 64.0f, F8_SACT = 8.0f, W_CLIP = 4.0f;
#ifndef CLIP_MIX0
#define CLIP_MIX0 5.5f
#endif
#ifndef CLIP_MIX1
#define CLIP_MIX1 5.5f
#endif
#ifndef CLIP_FFN
#define CLIP_FFN 5.5f
#endif
#ifndef CLIP_MOE
#define CLIP_MOE 5.5f
#endif
#ifndef CLIP_YA
#define CLIP_YA 14.0f
#endif
#ifndef CLIP_YB
#define CLIP_YB 5.5f
#endif
#ifndef CLIP_YC
#define CLIP_YC 10.0f
#endif
#ifndef CLIP_ACT
#define CLIP_ACT 7.0f
#endif
#ifndef CLIP_MRG
#define CLIP_MRG 9.0f
#endif
__host__ __device__ constexpr float sa_of(int q, float clip) { return q == 2 ? 127.0f / clip : 4.0f; }
enum { QS_IN = 0, QS_F13 = 1, QS_F2 = 2, QS_M13 = 3, QS_BR = 4  , QS_WO = 7, QS_M2 = 8, QS_N = 16 };
constexpr int MOE_ES = 1;
constexpr size_t WS_WM13 = 6 * MiB;
constexpr size_t WS_WM2 = WS_WM13 + 88 * MiB;
constexpr size_t WS_H2M = WS_WM2 + 44 * MiB;
constexpr size_t WS_ACTM = WS_H2M + 64 * MiB;
constexpr size_t WS_MOE_END = WS_ACTM + 2 * (size_t)MOE_ROWS * D_FF * MOE_ES;
constexpr size_t WS_Y1 = WS_MOE_END;
constexpr size_t WS_NEED = WS_MIX_END > WS_Y1 + (size_t)M * D * 2 ? WS_MIX_END : WS_Y1 + (size_t)M * D * 2;
constexpr size_t CTL_FLAG = 512 * 1024;
constexpr int MOE_XP = 128;
static_assert(WS_W2 + (size_t)D * D_FF * 2 <= WS_BIG && WS_WMIX + 20 * MiB <= WS_W13, "ws map");
constexpr int CW_BAR = 4096;
constexpr int CW_CNT = 16384;

constexpr int LDS_BYTES = 147456;
constexpr int SCR_BYTES = 139264;
constexpr int TAB_OFF = SCR_BYTES;
constexpr int MISC_OFF = TAB_OFF + 4096;
static_assert(MISC_OFF + 128 <= LDS_BYTES, "LDS map");
constexpr int NWAVES = 8, NT = 512;

#define GAS __attribute__((address_space(1)))
#define LAS __attribute__((address_space(3)))
typedef unsigned short bf16;
typedef unsigned v4u __attribute__((ext_vector_type(4)));
typedef float f32x4 __attribute__((ext_vector_type(4)));
#define LDS_WAIT() asm volatile("s_waitcnt lgkmcnt(0)" ::: "memory")
#define LDS_BARRIER() asm volatile("s_waitcnt lgkmcnt(0)\n\ts_barrier" ::: "memory")

typedef float f32x2_t __attribute__((ext_vector_type(2)));
typedef __bf16 bf16x2_t __attribute__((ext_vector_type(2)));
__device__ __forceinline__ unsigned pk2(float lo, float hi) { f32x2_t v = {lo, hi}; bf16x2_t b = __builtin_convertvector(v, bf16x2_t); return __builtin_bit_cast(unsigned, b); }
__device__ __forceinline__ float bf_lo(unsigned u) { return __uint_as_float(u << 16); }
__device__ __forceinline__ float bf_hi(unsigned u) { return __uint_as_float(u & 0xffff0000u); }
__device__ __forceinline__ void unpack8(const v4u w, float (&f)[8]) { f[0] = bf_lo(w.x); f[1] = bf_hi(w.x); f[2] = bf_lo(w.y); f[3] = bf_hi(w.y); f[4] = bf_lo(w.z); f[5] = bf_hi(w.z); f[6] = bf_lo(w.w); f[7] = bf_hi(w.w); }
typedef unsigned v2u_p1 __attribute__((ext_vector_type(2)));
__device__ __forceinline__ void decode8u(const v2u_p1 w, float (&f)[8]) {
    constexpr float a = CLIP_P1 / 127.0f, b = -128.0f * CLIP_P1 / 127.0f;
#pragma unroll
    for (int i = 0; i < 4; ++i) { f[i] = (float)((w.x >> (8 * i)) & 0xffu) * a + b; f[4 + i] = (float)((w.y >> (8 * i)) & 0xffu) * a + b; }
}
__device__ __forceinline__ v4u pack8(const float (&f)[8]) { v4u w; w.x = pk2(f[0], f[1]); w.y = pk2(f[2], f[3]); w.z = pk2(f[4], f[5]); w.w = pk2(f[6], f[7]); return w; }
__device__ __forceinline__ float sigmoidf_(float x) { return __builtin_amdgcn_rcpf(1.0f + __expf(-x)); }
__device__ __forceinline__ float siluf_(float x) { return x * sigmoidf_(x); }
__device__ __forceinline__ float uni(float v) { return __int_as_float(__builtin_amdgcn_readfirstlane(__float_as_int(v))); }
template <int Q> __device__ __forceinline__ float accf(float v) { return (Q == 2) ? (float)__float_as_int(v) : v; }
__device__ __forceinline__ float clamp_f8(float x) { return fminf(fmaxf(x, -448.0f), 448.0f); }
__device__ __forceinline__ unsigned q1_i8(float x) { return (unsigned)(int)rintf(fminf(fmaxf(x, -127.0f), 127.0f)) & 0xffu; }
template <int Q> __device__ __forceinline__ unsigned pk4_q(float a, float b, float c, float d) {
    if constexpr (Q == 2) {
        constexpr float MG = 12582912.0f;
        const unsigned ua = __float_as_uint(__builtin_amdgcn_fmed3f(a + MG, MG - 127.0f, MG + 127.0f)), ub = __float_as_uint(__builtin_amdgcn_fmed3f(b + MG, MG - 127.0f, MG + 127.0f));
        const unsigned uc = __float_as_uint(__builtin_amdgcn_fmed3f(c + MG, MG - 127.0f, MG + 127.0f)), ud = __float_as_uint(__builtin_amdgcn_fmed3f(d + MG, MG - 127.0f, MG + 127.0f));
        return __builtin_amdgcn_perm(__builtin_amdgcn_perm(ud, uc, 0x0c0c0400u), __builtin_amdgcn_perm(ub, ua, 0x0c0c0400u), 0x05040100u); }
    else { int v = 0; v = __builtin_amdgcn_cvt_pk_fp8_f32(clamp_f8(a), clamp_f8(b), v, false); v = __builtin_amdgcn_cvt_pk_fp8_f32(clamp_f8(c), clamp_f8(d), v, true); return (unsigned)v; } }
__device__ __forceinline__ float shx(float v, int mask, int lane) { return __int_as_float(__builtin_amdgcn_ds_bpermute((lane ^ mask) << 2, __float_as_int(v))); }
__device__ __forceinline__ float shl(float v, int src) { return __int_as_float(__builtin_amdgcn_ds_bpermute(src << 2, __float_as_int(v))); }
__device__ __forceinline__ float wave_sum(float v, int lane) {
#pragma unroll
    for (int o = 1; o < 64; o <<= 1) v += shx(v, o, lane);
    return v;
}

template <int CTRL> __device__ __forceinline__ float dppx(float x) { return __builtin_bit_cast(float, __builtin_amdgcn_mov_dpp(__builtin_bit_cast(int, x), CTRL, 0xf, 0xf, true)); }
__device__ __forceinline__ float dpp_xor4(float x) { const int xi = __builtin_bit_cast(int, x); int t = __builtin_amdgcn_update_dpp(xi, xi, 0x12C, 0xf, 0x5, false); t = __builtin_amdgcn_update_dpp(t, xi, 0x124, 0xf, 0xA, false); return __builtin_bit_cast(float, t); }
__device__ __forceinline__ f32x4 rot64(const f32x4 v, int lane) {
    const float a0 = v.x + v.y, a1 = v.x - v.y, a2 = v.z + v.w, a3 = v.z - v.w;
    f32x4 b = {a0 + a2, a1 + a3, a0 - a2, a1 - a3};
    const float s1 = (lane & 1) ? -1.0f : 1.0f, s2 = (lane & 2) ? -1.0f : 1.0f, s4 = (lane & 4) ? -1.0f : 1.0f, s8 = (lane & 8) ? -1.0f : 1.0f;
    b = (f32x4){dppx<0xB1>(b.x), dppx<0xB1>(b.y), dppx<0xB1>(b.z), dppx<0xB1>(b.w)} + b * s1;
    b = (f32x4){dppx<0x4E>(b.x), dppx<0x4E>(b.y), dppx<0x4E>(b.z), dppx<0x4E>(b.w)} + b * s2;
    b = (f32x4){dpp_xor4(b.x), dpp_xor4(b.y), dpp_xor4(b.z), dpp_xor4(b.w)} + b * s4;
    b = (f32x4){dppx<0x128>(b.x), dppx<0x128>(b.y), dppx<0x128>(b.z), dppx<0x128>(b.w)} + b * s8;
    return b * 0.125f;
}

__device__ __forceinline__ void fwht8(float (&y)[8]) {
#pragma unroll
    for (int t = 1; t < 8; t <<= 1)
#pragma unroll
        for (int i = 0; i < 8; ++i) if (!(i & t)) { const float a = y[i], b = y[i | t]; y[i] = a + b; y[i | t] = a - b; }
}
__device__ __forceinline__ void rot64_8(float (&y)[8], int lane) {
    fwht8(y);
    const float s1 = (lane & 1) ? -1.0f : 1.0f, s2 = (lane & 2) ? -1.0f : 1.0f, s4 = (lane & 4) ? -1.0f : 1.0f;
#pragma unroll
    for (int i = 0; i < 8; ++i) y[i] = dppx<0xB1>(y[i]) + y[i] * s1;
#pragma unroll
    for (int i = 0; i < 8; ++i) y[i] = dppx<0x4E>(y[i]) + y[i] * s2;
#pragma unroll
    for (int i = 0; i < 8; ++i) y[i] = dpp_xor4(y[i]) + y[i] * s4;
}
template <int Q, int RB = 64> __device__ __forceinline__ void store_y8(bf16* ybase, size_t elem, float (&y)[8], int lane, float clip) {
    if constexpr (Q == 2) { typedef unsigned v2u_ __attribute__((ext_vector_type(2)));
        if constexpr (RB == 8) fwht8(y); else rot64_8(y, lane);
        const float s = (RB == 8 ? 0.35355339f : 0.125f) * 127.0f / clip;
        v2u_ o8; o8.x = pk4_q<2>(y[0] * s, y[1] * s, y[2] * s, y[3] * s); o8.y = pk4_q<2>(y[4] * s, y[5] * s, y[6] * s, y[7] * s);
        *(v2u_*)((unsigned char*)ybase + elem) = o8; }
    else *(v4u*)(ybase + elem) = pack8(y);
}

#define XB_TMO      128
#define XB_XCNT(j)  (256  + 64 * (j))
#define XB_XSUB(j)  (1280 + 64 * (j))
#define XB_XGEN(j)  (2304 + 64 * (j))
#define XB_TOP      3328
#define XB_TOPGEN   3392
#define XCD_BAR_WORDS 3456
#define XB_SPIN_CAP (1u << 18)

__device__ __forceinline__ unsigned xb_ld(unsigned* p)              { return __hip_atomic_load(p, __ATOMIC_RELAXED, __HIP_MEMORY_SCOPE_AGENT); }
__device__ __forceinline__ unsigned xb_add(unsigned* p, unsigned v) { return __hip_atomic_fetch_add(p, v, __ATOMIC_RELAXED, __HIP_MEMORY_SCOPE_AGENT); }
__device__ __forceinline__ unsigned xb_xcc_id() { return (unsigned)__builtin_amdgcn_s_getreg((3 << 11) | 20) & 0xFu; }
#define XB_SPIN(cond, bar) do { unsigned _sp = 0; while (cond) { __builtin_amdgcn_s_sleep(1); \
    if ((++_sp & 255u) == 0u) { if (xb_ld(&(bar)[XB_TMO])) break; if (_sp > XB_SPIN_CAP) { atomicAdd(&(bar)[XB_TMO], 1u); break; } } } } while (0)

struct XcdBarrier { unsigned* bar; unsigned x; volatile LAS unsigned* st; };

__device__ __forceinline__ XcdBarrier xcd_barrier_post(unsigned* bar, volatile LAS unsigned* st) {
    XcdBarrier b; b.bar = bar; b.x = xb_xcc_id(); b.st = st;
    if (threadIdx.x == 0) (void)xb_add(&bar[XB_XCNT(b.x)], 1u);
    return b;
}
__device__ __forceinline__ void xcd_barrier_complete(unsigned* bar, unsigned x, unsigned& nloc, unsigned& nx) {
    const unsigned G = gridDim.x * gridDim.y * gridDim.z;
    unsigned sum, cnt, mine, sp = 0u;
    for (;;) {
        sum = 0u; cnt = 0u; mine = 0u;
        unsigned cv[16];
#pragma unroll
        for (unsigned j = 0; j < 16; ++j) cv[j] = xb_ld(&bar[XB_XCNT(j)]);
        asm volatile("" ::: "memory");
#pragma unroll
        for (unsigned j = 0; j < 16; ++j) { const unsigned c = cv[j]; sum += c; cnt += (c > 0u) ? 1u : 0u; mine = (j == x) ? c : mine; }
        if (sum == G) break;
        __builtin_amdgcn_s_sleep(1);
        if ((++sp & 255u) == 0u) { if (xb_ld(&bar[XB_TMO])) break; if (sp > XB_SPIN_CAP) { atomicAdd(&bar[XB_TMO], 1u); break; } }
    }
    nloc = mine > 0u ? mine : 1u; nx = cnt > 0u ? cnt : 1u;
}
__device__ __forceinline__ void xcd_barrier(const XcdBarrier& b) {
    asm volatile("s_waitcnt vmcnt(0)" ::: "memory");
    __syncthreads();
    if (threadIdx.x == 0) {
        unsigned* bar = b.bar;
        __builtin_amdgcn_s_waitcnt(0);
        unsigned nloc = b.st[0], nx = b.st[1];
        if (nloc == 0u) { xcd_barrier_complete(bar, b.x, nloc, nx); b.st[0] = nloc; b.st[1] = nx; }
        const unsigned old = xb_add(&bar[XB_XSUB(b.x)], 1u);
        const unsigned gen = old / nloc;
        if (old + 1u == (gen + 1u) * nloc) {
            __builtin_amdgcn_fence(__ATOMIC_RELEASE, "agent");
            asm volatile("s_waitcnt vmcnt(0)" ::: "memory");
            const unsigned og = xb_add(&bar[XB_TOP], 1u);
            const unsigned tg = og / nx;
            if (og + 1u == (tg + 1u) * nx) xb_add(&bar[XB_TOPGEN], 1u);
            else XB_SPIN(xb_ld(&bar[XB_TOPGEN]) == tg, bar);
            __builtin_amdgcn_fence(__ATOMIC_ACQUIRE, "agent");
            xb_add(&bar[XB_XGEN(b.x)], 1u);
            asm volatile("s_waitcnt vmcnt(0)" ::: "memory");
        } else {
            XB_SPIN(xb_ld(&bar[XB_XGEN(b.x)]) == gen, bar);
            __builtin_amdgcn_fence(__ATOMIC_ACQUIRE, "agent");
            asm volatile("s_waitcnt vmcnt(0)" ::: "memory");
        }
    }
    __syncthreads();
}

#ifndef STAGGER
#define STAGGER 0
#endif
__device__ __forceinline__ void stagger_wait(int bid, int us) {
    if (STAGGER && ((bid >> 3) & 1)) { const unsigned long long t0 = __builtin_amdgcn_s_memrealtime(); while (__builtin_amdgcn_s_memrealtime() - t0 < (unsigned long long)us * 100ull) __builtin_amdgcn_s_sleep(8); }
}
struct Args { const float* in[26]; float* out; unsigned char* ws; int ph_lo, ph_hi; };
typedef const Args __attribute__((address_space(4)))* KArgs;
#define KA() ({ KArgs p_ = (KArgs)__builtin_amdgcn_kernarg_segment_ptr(); asm volatile("" : "+s"(p_)); p_; })
struct Frame {
    LAS unsigned char* lds;
    int tid, lane, wave, G, bid;
    int w0;
};

template <int MAP, int F8 = 0, int RB = (F8 == 2 ? 64 : 0)>
__device__ __forceinline__ void transpose_item(const float* W, int K, int N, bf16* WT, int row_off, LAS float* scr, int item, int lane, float wscale = F8_SW) {
    const int nblk = N / 32, kb = item / nblk, nb = item % nblk, k0 = 64 * kb, n0 = 32 * nb;
    float vld[32];
#pragma unroll
    for (int i = 0; i < 32; ++i) vld[i] = W[(size_t)(k0 + 2 * i + (lane >> 5)) * N + n0 + (lane & 31)];
    asm volatile("" ::: "memory");
    if constexpr (RB != 0) {
#pragma unroll
        for (int t = 1; 2 * t < RB; t <<= 1)
#pragma unroll
            for (int i = 0; i < 32; ++i) if (!(i & t)) { const float a = vld[i], b = vld[i | t]; vld[i] = a + b; vld[i | t] = a - b; }
#pragma unroll
        for (int i = 0; i < 32; ++i) { const float pv = shx(vld[i], 32, lane); vld[i] = (lane & 32) ? pv - vld[i] : vld[i] + pv; }
        wscale *= (RB == 64 ? 0.125f : 0.35355339f);
    }
#pragma unroll
    for (int i = 0; i < 32; ++i) scr[(2 * i + (lane >> 5)) * 33 + (lane & 31)] = vld[i];
    LDS_WAIT(); asm volatile("" ::: "memory");
    const int c = lane & 7;
#pragma unroll
    for (int j = 0; j < 4; ++j) { const int n = (lane >> 3) + 8 * j; const LAS float* s = scr + (8 * c) * 33 + n;
        v4u o; o.x = pk2(s[0 * 33], s[1 * 33]); o.y = pk2(s[2 * 33], s[3 * 33]); o.z = pk2(s[4 * 33], s[5 * 33]); o.w = pk2(s[6 * 33], s[7 * 33]);
        const int nn = n0 + n; const int row = (MAP == 0) ? (row_off + nn) : ((nn >> 7) * 256 + row_off + (nn & 127));
        if constexpr (F8) { typedef unsigned v2u_ __attribute__((ext_vector_type(2))); v2u_ o8;
            o8.x = pk4_q<F8>(s[0 * 33] * wscale, s[1 * 33] * wscale, s[2 * 33] * wscale, s[3 * 33] * wscale); o8.y = pk4_q<F8>(s[4 * 33] * wscale, s[5 * 33] * wscale, s[6 * 33] * wscale, s[7 * 33] * wscale);
            *(v2u_*)((unsigned char*)WT + (size_t)row * K + k0 + 8 * c) = o8; }
        else *(v4u*)(WT + (size_t)row * K + k0 + 8 * c) = o; }
    LDS_WAIT(); asm volatile("" ::: "memory");
}

static_assert(Q_PROJ == 2 && Q_GATE == 2 && Q_BR == 2 && Q_WO == 2 && Q_FUP == 2 && Q_FDN == 2 && Q_MUP == 2 && Q_MDN == 2, "the pipelined conversion writes int8 rows only");
__device__ __forceinline__ void cv_load(const float* src, int N, int lane, float (&v)[32]) {
    const float* p = src + (size_t)(lane >> 5) * N + (lane & 31);
#pragma unroll
    for (int i = 0; i < 32; ++i) v[i] = p[(size_t)(2 * i) * N];
}
__device__ __forceinline__ void cv_store(float (&vld)[32], unsigned char* WTk, int K, int n0, int row_off, int fl, float wscale, LAS float* scr, int lane) {
#pragma unroll
    for (int t = 1; t < 4; t <<= 1)
#pragma unroll
        for (int i = 0; i < 32; ++i) if (!(i & t)) { const float a = vld[i], b = vld[i | t]; vld[i] = a + b; vld[i | t] = a - b; }
    if (fl & 2) {
#pragma unroll
        for (int t = 4; t < 32; t <<= 1)
#pragma unroll
            for (int i = 0; i < 32; ++i) if (!(i & t)) { const float a = vld[i], b = vld[i | t]; vld[i] = a + b; vld[i | t] = a - b; }
    }
#pragma unroll
    for (int i = 0; i < 32; ++i) { const float pv = shx(vld[i], 32, lane); vld[i] = (lane & 32) ? pv - vld[i] : vld[i] + pv; }
    wscale *= (fl & 2) ? 0.125f : 0.35355339f;
#pragma unroll
    for (int i = 0; i < 32; ++i) scr[(2 * i + (lane >> 5)) * 33 + (lane & 31)] = vld[i];
    LDS_WAIT(); asm volatile("" ::: "memory");
    const int c = lane & 7;
#pragma unroll
    for (int j = 0; j < 4; ++j) { const int n = (lane >> 3) + 8 * j; const LAS float* s = scr + (8 * c) * 33 + n;
        const int nn = n0 + n; const int row = (fl & 1) ? ((nn >> 7) * 256 + row_off + (nn & 127)) : (row_off + nn);
        typedef unsigned v2u_ __attribute__((ext_vector_type(2))); v2u_ o8;
        o8.x = pk4_q<2>(s[0 * 33] * wscale, s[1 * 33] * wscale, s[2 * 33] * wscale, s[3 * 33] * wscale); o8.y = pk4_q<2>(s[4 * 33] * wscale, s[5 * 33] * wscale, s[6 * 33] * wscale, s[7 * 33] * wscale);
        *(v2u_*)(WTk + (size_t)row * K + 8 * c) = o8; }
    LDS_WAIT(); asm volatile("" ::: "memory");
}
#define CV_PIPE(nitems_, DECODE) do { \
        float va[32]; int it = gw; const float* src_; int N_, K_, n0_, ro_, fl_; unsigned char* dst_; float ws_; \
        if (it < (nitems_)) { \
            DECODE(it); cv_load(src_, N_, F.lane, va); \
            unsigned char* cdst = dst_; int cK = K_, cn0 = n0_, cro = ro_, cfl = fl_; float cws = ws_; \
            for (int nx = it + NGW; nx < (nitems_); nx += NGW) {                   \
                float vb[32]; DECODE(nx); cv_load(src_, N_, F.lane, vb); \
                asm volatile("" ::: "memory"); \
                cv_store(va, cdst, cK, cn0, cro, cfl, cws, scr, F.lane); \
                _Pragma("unroll") for (int i = 0; i < 32; ++i) va[i] = vb[i]; \
                cdst = dst_; cK = K_; cn0 = n0_; cro = ro_; cfl = fl_; cws = ws_; } \
            cv_store(va, cdst, cK, cn0, cro, cfl, cws, scr, F.lane); } \
    } while (0)

__device__ __forceinline__ void p_prologue(Frame& F, KArgs ka) {
    const float* c = ka->in[1]; const float* ada_w = ka->in[2]; const float* ada_b = ka->in[3];
    unsigned char* aws = ka->ws; float* mod = (float*)(aws + WS_MOD);
    LAS float* cact = (LAS float*)F.lds;
    LAS float* red = cact + 8192;
    for (int i = F.tid; i < BATCH * D; i += NT) cact[i] = siluf_(c[i]);
    __syncthreads();
    for (int chunk = F.bid; chunk < 256; chunk += F.G) {
        const int l = chunk >> 7, n0 = (chunk & 127) * 48;
        if (F.tid < 480) {
            const int kg = F.tid / 48, col = F.tid % 48;
            float acc[8];
#pragma unroll
            for (int b = 0; b < 8; ++b) acc[b] = 0.f;
            const float* wp = ada_w + (size_t)l * D * MOD_LD + n0 + col;
            for (int kb = kg; kb < D; kb += 160) {
                float wv[16];
#pragma unroll
                for (int j = 0; j < 16; ++j) { const int k = kb + 10 * j; wv[j] = (k < D) ? wp[(size_t)k * MOD_LD] : 0.f; }
                asm volatile("" ::: "memory");
#pragma unroll
                for (int j = 0; j < 16; ++j) { const int k = kb + 10 * j; if (k < D) {
#pragma unroll
                    for (int b = 0; b < 8; ++b) acc[b] += cact[b * D + k] * wv[j]; } } }
#pragma unroll
            for (int b = 0; b < 8; ++b) red[(kg * 48 + col) * 8 + b] = acc[b];
        }
        __syncthreads();
        if (F.tid < 384) {
            const int col = F.tid >> 3, b = F.tid & 7; float s = 0.f;
#pragma unroll
            for (int kg = 0; kg < 10; ++kg) s += red[(kg * 48 + col) * 8 + b];
            mod[(size_t)(l * 8 + b) * MOD_LD + n0 + col] = s + ada_b[l * MOD_LD + n0 + col];
        }
        __syncthreads();
    }
}
__device__ __forceinline__ float wscale_sample(const float* W, size_t n, int lane) {
    float ss = 0.f;
#pragma unroll
    for (int j = 0; j < 32; ++j) { const size_t idx = ((size_t)(lane + 64 * j) * 1000003ull) % n; const float v = W[idx]; ss += v * v; }
    ss = wave_sum(ss, lane);
    return 127.0f / (W_CLIP * sqrtf(ss * (1.0f / 2048.0f)) + 1e-30f);
}
__device__ __forceinline__ void p_convert_mixer(Frame& F, KArgs ka, int l, bool with_ffn) {
    unsigned char* aws = ka->ws;
    LAS float* scr = (LAS float*)(F.lds + F.wave * 16384);
    const int gw = F.bid * NWAVES + F.wave, NGW = F.G * NWAVES;
    constexpr int I_BCA = (D / 64) * (N_BCA / 32), I_G = (D / 64) * (N_G / 32), I_BR = (512 / 64) * (D / 32), I_O = (D / 64) * (D / 32), I_L = I_BCA + I_G + 3 * I_BR + I_O;
    constexpr int I_F1 = (D / 64) * (D_FF / 32), I_F2 = (D_FF / 64) * (D / 32);
    const int nitems = I_L + (with_ffn ? 2 * I_F1 + I_F2 : 0);
    bf16* base = (bf16*)(aws + WS_WMIX);
    LAS float* qsl = (LAS float*)(F.lds + TAB_OFF + 3072);
    __syncthreads();
    if (F.wave == 0) { const float v = wscale_sample(ka->in[6] + (size_t)l * D * N_IN, (size_t)D * N_IN, F.lane); if (F.lane == 0) qsl[0] = v; }
    if (F.wave == 1) { const float v = wscale_sample(ka->in[17], (size_t)D * D_FF, F.lane); if (F.lane == 0) qsl[1] = v; }
    if (F.wave == 2) { const float v = wscale_sample(ka->in[18], (size_t)D * D_FF, F.lane); if (F.lane == 0) qsl[2] = v; }
    if (F.wave >= 3 && F.wave < 6) { const float v = wscale_sample(ka->in[13 + F.wave - 3] + (size_t)l * 512 * D, (size_t)512 * D, F.lane); if (F.lane == 0) qsl[F.wave] = v; }
    if (F.wave == 6) { const float v = wscale_sample(ka->in[16] + (size_t)l * D * D, (size_t)D * D, F.lane); if (F.lane == 0) qsl[6] = v; }
    if (F.wave == 7) { const float v = wscale_sample(ka->in[19], (size_t)D_FF * D, F.lane); if (F.lane == 0) qsl[7] = v; }
    __syncthreads();
    const float ws_in = qsl[0], ws_13 = (Q_FUP == 2) ? fminf(qsl[1], qsl[2]) : F8_SW;
    const float ws_p = (Q_PROJ == 2) ? ws_in : F8_SW, ws_g = (Q_GATE == 2) ? ws_in : F8_SW;
    const float ws_ba = qsl[3], ws_bb = qsl[4], ws_bc = qsl[5], ws_o = qsl[6], ws_2 = (Q_FDN == 2) ? qsl[7] : F8_SW;
    if (F.bid == 0 && F.tid == 0) { float* qs = (float*)(aws + WS_QS); qs[QS_IN] = ws_in; qs[QS_BR] = ws_ba; qs[QS_BR + 1] = ws_bb; qs[QS_BR + 2] = ws_bc; qs[QS_WO] = ws_o; if (with_ffn) { qs[QS_F13] = ws_13; qs[QS_F2] = ws_2; } }
    const float* in6 = ka->in[6] + (size_t)l * D * N_IN;
    constexpr int BRS = Q_BR ? 512 * 1024 / 2 : 512 * 1024;
#define CV_DEC_MIX(it_) do { int r = (it_); int kb, nb; const float* W; \
        if (r < I_BCA) { kb = r / (N_BCA / 32); nb = r % (N_BCA / 32); W = in6; K_ = D; N_ = N_IN; dst_ = (unsigned char*)base; ro_ = 0; fl_ = 2; ws_ = ws_p; }                         \
        else if ((r -= I_BCA) < I_G) { kb = r / (N_G / 32); nb = r % (N_G / 32) + N_BCA / 32; W = in6; K_ = D; N_ = N_IN; dst_ = aws + WS_WMIX + WMIX_G8; ro_ = -N_BCA; fl_ = 2; ws_ = ws_g; }     \
        else if ((r -= I_G) < 3 * I_BR) { const int b = r / I_BR; r -= b * I_BR; kb = r / (D / 32); nb = r % (D / 32); W = ka->in[13 + b] + (size_t)l * 512 * D; K_ = 512; N_ = D; dst_ = (unsigned char*)(base + (size_t)N_IN * D + (size_t)b * BRS); ro_ = 0; fl_ = (b == 0) ? 2 : 0; ws_ = (b == 0) ? ws_ba : (b == 1) ? ws_bb : ws_bc; }     \
        else if ((r -= 3 * I_BR) < I_O) { kb = r / (D / 32); nb = r % (D / 32); W = ka->in[16] + (size_t)l * D * D; K_ = D; N_ = D; dst_ = (unsigned char*)(base + (size_t)N_IN * D + 3 * 512 * 1024); ro_ = 0; fl_ = 0; ws_ = ws_o; } \
        else if ((r -= I_O) < 2 * I_F1) { const int h = r / I_F1; r -= h * I_F1; kb = r / (D_FF / 32); nb = r % (D_FF / 32); W = ka->in[17 + h]; K_ = D; N_ = D_FF; dst_ = aws + WS_W13; ro_ = 128 * h; fl_ = 3; ws_ = ws_13; } \
        else { r -= 2 * I_F1; kb = r / (D / 32); nb = r % (D / 32); W = ka->in[19]; K_ = D_FF; N_ = D; dst_ = aws + WS_W2; ro_ = 0; fl_ = 0; ws_ = ws_2; } \
        src_ = W + (size_t)(64 * kb) * N_ + 32 * nb; dst_ += 64 * kb; n0_ = 32 * nb; } while (0)
    CV_PIPE(nitems, CV_DEC_MIX);
#undef CV_DEC_MIX
}
__device__ __forceinline__ void p_moe_weights(Frame& F, KArgs ka) {
    unsigned char* aws = ka->ws;
    LAS float* scr = (LAS float*)(F.lds + F.wave * 16384);
    const int gw = F.bid * NWAVES + F.wave, NGW = F.G * NWAVES;
    constexpr int I_F1 = (D / 64) * (D_FF / 32), I_F2 = (D_FF / 64) * (D / 32), I_E = 2 * I_F1 + I_F2;
    LAS float* qsl = (LAS float*)(F.lds + TAB_OFF + 3072);
    __syncthreads();
    if (F.wave == 0) { const float v = wscale_sample(ka->in[22], (size_t)NE * D * D_FF, F.lane); if (F.lane == 0) qsl[0] = v; }
    if (F.wave == 1) { const float v = wscale_sample(ka->in[23], (size_t)NE * D * D_FF, F.lane); if (F.lane == 0) qsl[1] = v; }
    if (F.wave == 2) { const float v = wscale_sample(ka->in[24], (size_t)NE * D_FF * D, F.lane); if (F.lane == 0) qsl[2] = v; }
    __syncthreads();
    const float ws_13 = (Q_MUP == 2) ? fminf(qsl[0], qsl[1]) : F8_SW, ws_2 = (Q_MDN == 2) ? qsl[2] : F8_SW;
    if (F.bid == 0 && F.tid == 0) { float* qs = (float*)(aws + WS_QS); qs[QS_M13] = ws_13; qs[QS_M2] = ws_2; }
#define CV_DEC_MOE(it_) do { const int e = (it_) / I_E; int r = (it_) - e * I_E; int kb, nb; const float* W; \
        if (r < 2 * I_F1) { const int h = r / I_F1; r -= h * I_F1; kb = r / (D_FF / 32); nb = r % (D_FF / 32); W = ka->in[22 + h] + (size_t)e * D * D_FF; K_ = D; N_ = D_FF; dst_ = aws + WS_WM13 + (size_t)e * N13 * D * MOE_ES; ro_ = 128 * h; fl_ = 3; ws_ = ws_13; } \
        else { r -= 2 * I_F1; kb = r / (D / 32); nb = r % (D / 32); W = ka->in[24] + (size_t)e * D_FF * D; K_ = D_FF; N_ = D; dst_ = aws + WS_WM2 + (size_t)e * D * D_FF * MOE_ES; ro_ = 0; fl_ = 0; ws_ = ws_2; } \
        src_ = W + (size_t)(64 * kb) * N_ + 32 * nb; dst_ += 64 * kb; n0_ = 32 * nb; } while (0)
    CV_PIPE(NE * I_E, CV_DEC_MOE);
#undef CV_DEC_MOE
}

__device__ __forceinline__ void norm_row(const float* xrow, const float* w, const float* sc, const float* sh, int lane, f32x4 (&o)[4]) {
    const f32x4* xr = (const f32x4*)xrow + lane;
    f32x4 v[4]; float s = 0.f;
#pragma unroll
    for (int j = 0; j < 4; ++j) { v[j] = xr[64 * j]; s += (v[j].x * v[j].x + v[j].y * v[j].y) + (v[j].z * v[j].z + v[j].w * v[j].w); }
    const float rstd = 1.0f / sqrtf(wave_sum(s, lane) * (1.0f / D) + EPS);
#pragma unroll
    for (int j = 0; j < 4; ++j) { const f32x4 wv = ((const f32x4*)w)[lane + 64 * j], scv = ((const f32x4*)sc)[lane + 64 * j], shv = ((const f32x4*)sh)[lane + 64 * j];
        o[j] = v[j] * rstd * wv * (scv + 1.0f) + shv; }
}
template <bool XBF>
__device__ __forceinline__ f32x4 load_x4(const void* xbase, size_t row, int lane, int j) {
    if constexpr (XBF) { typedef unsigned v2u_ __attribute__((ext_vector_type(2))); const v2u_ w = ((const v2u_*)((const bf16*)xbase + row * XLD))[lane + 64 * j];
        return (f32x4){bf_lo(w.x), bf_hi(w.x), bf_lo(w.y), bf_hi(w.y)}; }
    else return ((const f32x4*)((const float*)xbase + row * D))[lane + 64 * j];
}
__device__ __forceinline__ void store_row_bf16(bf16* orow, int lane, const f32x4 (&o)[4]) {
    unsigned long long* o8 = (unsigned long long*)orow + lane;
#pragma unroll
    for (int j = 0; j < 4; ++j) o8[64 * j] = (unsigned long long)pk2(o[j].x, o[j].y) | ((unsigned long long)pk2(o[j].z, o[j].w) << 32);
}
template <int MODE = 0, bool XBF = true, int HQ = 2>
__device__ __forceinline__ void p_norm(Frame& F, const void* xin, const float* w, const float* mod_l, int sc_off, int sh_off, bf16* hout, unsigned char* hout8 = nullptr, float sa = 1.0f) {
    const int gw = F.bid * NWAVES + F.wave, NGW = F.G * NWAVES, lane = F.lane;
    f32x4 wv[4];
#pragma unroll
    for (int j = 0; j < 4; ++j) wv[j] = ((const f32x4*)w)[lane + 64 * j];
    for (int r0 = gw * 4; r0 < M; r0 += NGW * 4) {
        const float* mb = mod_l + (size_t)(r0 >> 12) * MOD_LD;
        f32x4 v[4][4], scv[4], shv[4];
#pragma unroll
        for (int r = 0; r < 4; ++r)
#pragma unroll
            for (int j = 0; j < 4; ++j) v[r][j] = load_x4<XBF>(xin, (size_t)(r0 + r), lane, j);
#pragma unroll
        for (int j = 0; j < 4; ++j) { scv[j] = ((const f32x4*)(mb + sc_off))[lane + 64 * j]; shv[j] = ((const f32x4*)(mb + sh_off))[lane + 64 * j]; }
        asm volatile("" ::: "memory");
#pragma unroll
        for (int j = 0; j < 4; ++j) scv[j] = wv[j] * (scv[j] + 1.0f);
#pragma unroll
        for (int r = 0; r < 4; ++r) { float s = 0.f;
#pragma unroll
            for (int j = 0; j < 4; ++j) s += (v[r][j].x * v[r][j].x + v[r][j].y * v[r][j].y) + (v[r][j].z * v[r][j].z + v[r][j].w * v[r][j].w);
            const float rstd = 1.0f / sqrtf(wave_sum(s, lane) * (1.0f / D) + EPS);
            f32x4 o[4];
#pragma unroll
            for (int j = 0; j < 4; ++j) o[j] = v[r][j] * rstd * scv[j] + shv[j];
            if constexpr (MODE != 0) { unsigned* o4 = (unsigned*)((MODE == 1 ? (unsigned char*)hout : hout8) + (size_t)(r0 + r) * D) + lane;
#pragma unroll
                for (int j = 0; j < 4; ++j) { const f32x4 q = (HQ == 2) ? rot64(o[j], lane) : o[j]; o4[64 * j] = pk4_q<HQ>(q.x * sa, q.y * sa, q.z * sa, q.w * sa); } }
            if constexpr (MODE != 1) store_row_bf16(hout + (size_t)(r0 + r) * D, lane, o); }
    }
}

constexpr int CONV_RUN = 16;
__device__ __forceinline__ void p_conv(Frame& F, const bf16* P1, const float* conv_w, bf16* ya) {
    const int gt = F.bid * NT + F.tid, NGT = F.G * NT;
    for (int run = gt >> 6; run < M / CONV_RUN; run += NGT >> 6) {
        const int c8 = (gt & 63) * 8, row0 = run * CONV_RUN, pos0 = row0 & (SEQ - 1);
        const unsigned char* p = (const unsigned char*)P1 + (size_t)row0 * P1_PITCH + c8;
        float w0[8], w1[8], w2[8], z1[8], z2[8];
#pragma unroll
        for (int i = 0; i < 8; ++i) { w0[i] = conv_w[c8 + i]; w1[i] = conv_w[512 + c8 + i]; w2[i] = conv_w[1024 + c8 + i]; z1[i] = 0.f; z2[i] = 0.f; }
        if (pos0 >= 2) {
            float c1[8], h1[8], c2[8], h2[8];
            decode8u(*(const v2u_p1*)(p - P1_PITCH + 512), c1); decode8u(*(const v2u_p1*)(p - P1_PITCH + 1024), h1);
            decode8u(*(const v2u_p1*)(p - 2 * P1_PITCH + 512), c2); decode8u(*(const v2u_p1*)(p - 2 * P1_PITCH + 1024), h2);
#pragma unroll
            for (int i = 0; i < 8; ++i) { z1[i] = c1[i] * h1[i]; z2[i] = c2[i] * h2[i]; } }
        v2u_p1 nb = *(const v2u_p1*)p, nc = *(const v2u_p1*)(p + 512), nh = *(const v2u_p1*)(p + 1024);
#pragma unroll 2
        for (int k = 0; k < CONV_RUN; ++k) {
            const v2u_p1 rb = nb, rc = nc, rh = nh;
            if (k + 1 < CONV_RUN) { const unsigned char* pn = p + (size_t)(k + 1) * P1_PITCH; nb = *(const v2u_p1*)pn; nc = *(const v2u_p1*)(pn + 512); nh = *(const v2u_p1*)(pn + 1024); }
            float ab[8], ac[8], ah[8], y[8];
            decode8u(rb, ab); decode8u(rc, ac); decode8u(rh, ah);
#pragma unroll
            for (int i = 0; i < 8; ++i) { const float z = ac[i] * ah[i]; y[i] = ab[i] * (w0[i] * z + w1[i] * z1[i] + w2[i] * z2[i]); z2[i] = z1[i]; z1[i] = z; }
            store_y8<Q_BR>(ya, (size_t)(row0 + k) * 512 + c8, y, F.lane, CLIP_YA);
        }
    }
}

typedef short v4i16_t __attribute__((ext_vector_type(4)));
typedef short bf16x8_t __attribute__((ext_vector_type(8)));
typedef unsigned v2u __attribute__((ext_vector_type(2)));
constexpr int HRS = 272;
constexpr int TRS = 80;
constexpr int H_RAWQ = 0, H_RAWF = 8704, H_V = 17408, H_QHT = 26112, H_KTT = 36352, H_KHT = 46592, H_DL = 56832, H_OB = 57344, H_OBS = 132, H_V2 = 74240;
constexpr int HSEG = 512, HNSEG = SEQ / HSEG, HCH = 32;
__device__ __forceinline__ v4i16_t tr_read(LAS unsigned char* p) { return __builtin_amdgcn_ds_read_tr16_b64_v4i16((LAS v4i16_t*)p); }
__device__ __forceinline__ bf16x8_t cat4(v4i16_t lo, v4i16_t hi) { return __builtin_shufflevector(lo, hi, 0, 1, 2, 3, 4, 5, 6, 7); }
__device__ __forceinline__ bf16x8_t pack_acc(const f32x4 a, const f32x4 b) { v4u w; w.x = pk2(a[0], a[1]); w.y = pk2(a[2], a[3]); w.z = pk2(b[0], b[1]); w.w = pk2(b[2], b[3]); return __builtin_bit_cast(bf16x8_t, w); }
__device__ __forceinline__ float bfs(short x) { return __uint_as_float((unsigned)(unsigned short)x << 16); }
template <int PASS>
__device__ __forceinline__ void p_hgrn(Frame& F, const bf16* P1, const float* lb_logits, int layer, const float* norm_w, bf16* yb, float* ust, float* dst) {
    LAS unsigned char* L = F.lds;
    const int lane = F.lane, w = F.wave, g = lane >> 4, n = lane & 15, q_ = n >> 2, p_ = n & 3;
    const int pt = F.tid >> 4, pc8 = (F.tid & 15) * 8;
    for (int u = F.bid; u < BATCH * H_B * HNSEG; u += F.G) {
        const int seg = u & (HNSEG - 1), bh = u / HNSEG, b = bh >> 2, h = bh & 3;
        const int d = 16 * w + n;
        float lb; { const int ch = h * 128 + d; const float l0 = lb_logits[ch], l1 = lb_logits[512 + ch]; const float mx = fmaxf(l0, l1);
            const float e0 = expf(l0 - mx), e1 = expf(l1 - mx); const float p0 = e0 / (e0 + e1), p1 = e1 / (e0 + e1);
            const float lbx = (layer == 0) ? (p0 - p0) : ((p0 + p1) - p0); lb = fminf(fmaxf(lbx, 0.f), 1.f); }
        const float lbf = fmaxf(lb, 1e-30f), oml = 1.0f - lb;
        f32x4 S[8];
#pragma unroll
        for (int kt = 0; kt < 8; ++kt) S[kt] = (f32x4){0.f, 0.f, 0.f, 0.f};
        if (PASS == 2) {
#pragma unroll 2
            for (int j = 0; j < seg; ++j) { const int uj = u - seg + j;
#pragma unroll
                for (int kt = 0; kt < 8; ++kt) { const f32x4 dj = *(const f32x4*)(dst + (size_t)uj * 128 + 16 * kt + 4 * g); const f32x4 uu = *(const f32x4*)(ust + ((((size_t)uj * 8 + w) * 8 + kt) * 64 + lane) * 4);
                    S[kt] = dj * S[kt] + uu; } }
        }
        float nw8[8];
        if (PASS == 2) {
#pragma unroll
            for (int i = 0; i < 8; ++i) nw8[i] = norm_w[h * 128 + pc8 + i]; }
        float dprod = 1.0f;
        const bf16* gp = P1 + ((size_t)b * SEQ + (size_t)seg * HSEG + pt) * P1E + P1_OB / 2 + h * 128 + pc8;
        constexpr int HPF = 4, NCH = HSEG / HCH;
        v4u rq[HPF], rf[HPF], rv[HPF], rg[HPF];
#pragma unroll
        for (int k = 0; k < HPF; ++k) { const bf16* np = gp + (size_t)k * HCH * P1E; rf[k] = *(const v4u*)(np + 512); rv[k] = *(const v4u*)(np + 1024);
            if (PASS == 2) { rq[k] = *(const v4u*)np; rg[k] = *(const v4u*)(np + 1536); } }
#define HG_WRITE(k_, vb_) do { *(LAS v4u*)(L + H_RAWF + pt * HRS + pc8 * 2) = rf[k_]; *(LAS v4u*)(L + ((vb_) ? H_V2 : H_V) + pt * HRS + pc8 * 2) = rv[k_]; \
            if (PASS == 2) *(LAS v4u*)(L + H_RAWQ + pt * HRS + pc8 * 2) = rq[k_]; } while (0)
#define HG_REFILL(k_, cn_) do { if ((cn_) < NCH) { const bf16* np = gp + (size_t)(cn_) * HCH * P1E; rf[k_] = *(const v4u*)(np + 512); rv[k_] = *(const v4u*)(np + 1024); \
            if (PASS == 2) { rq[k_] = *(const v4u*)np; rg[k_] = *(const v4u*)(np + 1536); } } } while (0)
        v4u cg, cgn;
        HG_WRITE(0, 0); if (PASS == 2) cg = rg[0];
        LDS_BARRIER();
        HG_REFILL(0, HPF);
            { const bf16x8_t f8 = cat4(tr_read(L + H_RAWF + (8 * g + q_) * HRS + 32 * w + 8 * p_), tr_read(L + H_RAWF + (8 * g + 4 + q_) * HRS + 32 * w + 8 * p_));
              float eb[8], kk[8]; float cp = 1.0f;
#pragma unroll
              for (int i = 0; i < 8; ++i) { const float sg = __builtin_amdgcn_rcpf(1.0f + __expf(-bfs(f8[i]))); const float f = lbf + oml * sg; kk[i] = oml * (1.0f - sg); cp *= f; eb[i] = cp; }
              const float s1 = shl(cp, n), s2 = shl(cp, 16 + n), s3 = shl(cp, 32 + n), s4 = shl(cp, 48 + n);
              const float pre = (g > 0 ? s1 : 1.0f) * (g > 1 ? s2 : 1.0f) * (g > 2 ? s3 : 1.0f);
              const float elast = ((s1 * s2) * s3) * s4;
              float kh[8], kt8[8];
#pragma unroll
              for (int i = 0; i < 8; ++i) { eb[i] *= pre; const float en = __builtin_amdgcn_rcpf(fmaxf(eb[i], 1e-30f)); kt8[i] = kk[i] * en; kh[i] = kt8[i] * elast; }
              *(LAS v4u*)(L + H_KHT + d * TRS + 16 * g) = pack8(kh);
              if (PASS == 2) { const bf16x8_t q8 = cat4(tr_read(L + H_RAWQ + (8 * g + q_) * HRS + 32 * w + 8 * p_), tr_read(L + H_RAWQ + (8 * g + 4 + q_) * HRS + 32 * w + 8 * p_));
                  float qh[8];
#pragma unroll
                  for (int i = 0; i < 8; ++i) qh[i] = siluf_(bfs(q8[i])) * eb[i];
                  *(LAS v4u*)(L + H_QHT + d * TRS + 16 * g) = pack8(qh); *(LAS v4u*)(L + H_KTT + d * TRS + 16 * g) = pack8(kt8); }
              if (g == 0) *(LAS float*)(L + H_DL + 4 * d) = elast;
              dprod *= elast; }
        LDS_BARRIER();
        for (int c0 = 0; c0 < NCH; c0 += HPF) {
#pragma unroll
          for (int k = 0; k < HPF; ++k) {
            const int c = c0 + k; const int vbuf = (k & 1) ? H_V2 : H_V;
            const bf16x8_t bVn = cat4(tr_read(L + vbuf + (8 * g + q_) * HRS + 32 * w + 8 * p_), tr_read(L + vbuf + (8 * g + 4 + q_) * HRS + 32 * w + 8 * p_));
            if (PASS == 2) {
                const bf16x8_t bVp = cat4(tr_read(L + vbuf + (4 * g + q_) * HRS + 32 * w + 8 * p_), tr_read(L + vbuf + (16 + 4 * g + q_) * HRS + 32 * w + 8 * p_));
                f32x4 o[2], pt00 = {0.f, 0.f, 0.f, 0.f}, pt01 = {0.f, 0.f, 0.f, 0.f}, pt11 = {0.f, 0.f, 0.f, 0.f};
                o[0] = (f32x4){0.f, 0.f, 0.f, 0.f}; o[1] = (f32x4){0.f, 0.f, 0.f, 0.f};
#pragma unroll
                for (int ks = 0; ks < 4; ++ks) {
                    const bf16x8_t sb = pack_acc(S[2 * ks], S[2 * ks + 1]);
#pragma unroll
                    for (int tm = 0; tm < 2; ++tm) {
                        const bf16x8_t aq = cat4(tr_read(L + H_QHT + (32 * ks + 4 * g + q_) * TRS + 32 * tm + 8 * p_), tr_read(L + H_QHT + (32 * ks + 16 + 4 * g + q_) * TRS + 32 * tm + 8 * p_));
                        o[tm] = __builtin_amdgcn_mfma_f32_16x16x32_bf16(aq, sb, o[tm], 0, 0, 0); }
                    const bf16x8_t aK0 = cat4(tr_read(L + H_KTT + (32 * ks + 8 * g + q_) * TRS + 8 * p_), tr_read(L + H_KTT + (32 * ks + 8 * g + 4 + q_) * TRS + 8 * p_));
                    const bf16x8_t aK1 = cat4(tr_read(L + H_KTT + (32 * ks + 8 * g + q_) * TRS + 32 + 8 * p_), tr_read(L + H_KTT + (32 * ks + 8 * g + 4 + q_) * TRS + 32 + 8 * p_));
                    const bf16x8_t bQ0 = cat4(tr_read(L + H_QHT + (32 * ks + 8 * g + q_) * TRS + 8 * p_), tr_read(L + H_QHT + (32 * ks + 8 * g + 4 + q_) * TRS + 8 * p_));
                    const bf16x8_t bQ1 = cat4(tr_read(L + H_QHT + (32 * ks + 8 * g + q_) * TRS + 32 + 8 * p_), tr_read(L + H_QHT + (32 * ks + 8 * g + 4 + q_) * TRS + 32 + 8 * p_));
                    pt00 = __builtin_amdgcn_mfma_f32_16x16x32_bf16(aK0, bQ0, pt00, 0, 0, 0);
                    pt01 = __builtin_amdgcn_mfma_f32_16x16x32_bf16(aK0, bQ1, pt01, 0, 0, 0);
                    pt11 = __builtin_amdgcn_mfma_f32_16x16x32_bf16(aK1, bQ1, pt11, 0, 0, 0);
                }
#pragma unroll
                for (int j = 0; j < 4; ++j) if (4 * g + j > n) { pt00[j] = 0.f; pt11[j] = 0.f; }
                const f32x4 z4 = {0.f, 0.f, 0.f, 0.f};
                o[0] = __builtin_amdgcn_mfma_f32_16x16x32_bf16(pack_acc(pt00, z4), bVp, o[0], 0, 0, 0);
                o[1] = __builtin_amdgcn_mfma_f32_16x16x32_bf16(pack_acc(pt01, pt11), bVp, o[1], 0, 0, 0);
#pragma unroll
                for (int tm = 0; tm < 2; ++tm)
#pragma unroll
                    for (int j = 0; j < 4; ++j) *(LAS float*)(L + H_OB + ((16 * tm + 4 * g + j) * H_OBS + 16 * w + n) * 4) = o[tm][j];
            }
#pragma unroll
            for (int kt = 0; kt < 8; ++kt) { const f32x4 dl4 = *(const LAS f32x4*)(L + H_DL + (16 * kt + 4 * g) * 4);
                const bf16x8_t aKh = *(const LAS bf16x8_t*)(L + H_KHT + (16 * kt + n) * TRS + 16 * g);
                S[kt] = __builtin_amdgcn_mfma_f32_16x16x32_bf16(aKh, bVn, S[kt] * dl4, 0, 0, 0); }
            if (c + 1 < NCH) { HG_WRITE((k + 1) % HPF, (k + 1) & 1); if (PASS == 2) cgn = rg[(k + 1) % HPF]; }
            LDS_BARRIER();
            if (c + 1 < NCH) HG_REFILL((k + 1) % HPF, c + 1 + HPF);
            if (PASS == 2) {
                const f32x4 o0 = *(const LAS f32x4*)(L + H_OB + (pt * H_OBS + pc8) * 4), o1 = *(const LAS f32x4*)(L + H_OB + (pt * H_OBS + pc8 + 4) * 4);
                const float o8[8] = {o0.x, o0.y, o0.z, o0.w, o1.x, o1.y, o1.z, o1.w};
                float ss = 0.f;
#pragma unroll
                for (int i = 0; i < 8; ++i) ss += o8[i] * o8[i];
                ss += shx(ss, 1, lane); ss += shx(ss, 2, lane); ss += shx(ss, 4, lane); ss += shx(ss, 8, lane);
                const float rs = 1.0f / sqrtf(ss * (1.0f / 128.0f) + EPS);
                float g8[8], y[8]; unpack8(cg, g8);
#pragma unroll
                for (int i = 0; i < 8; ++i) y[i] = o8[i] * rs * nw8[i] * siluf_(g8[i]);
                store_y8<Q_BR, 8>(yb, ((size_t)b * SEQ + (size_t)seg * HSEG + (size_t)c * HCH + pt) * 512 + h * 128 + pc8, y, lane, CLIP_YB);
            }
            if (c + 1 < NCH)
            { const bf16x8_t f8 = cat4(tr_read(L + H_RAWF + (8 * g + q_) * HRS + 32 * w + 8 * p_), tr_read(L + H_RAWF + (8 * g + 4 + q_) * HRS + 32 * w + 8 * p_));
              float eb[8], kk[8]; float cp = 1.0f;
#pragma unroll
              for (int i = 0; i < 8; ++i) { const float sg = __builtin_amdgcn_rcpf(1.0f + __expf(-bfs(f8[i]))); const float f = lbf + oml * sg; kk[i] = oml * (1.0f - sg); cp *= f; eb[i] = cp; }
              const float s1 = shl(cp, n), s2 = shl(cp, 16 + n), s3 = shl(cp, 32 + n), s4 = shl(cp, 48 + n);
              const float pre = (g > 0 ? s1 : 1.0f) * (g > 1 ? s2 : 1.0f) * (g > 2 ? s3 : 1.0f);
              const float elast = ((s1 * s2) * s3) * s4;
              float kh[8], kt8[8];
#pragma unroll
              for (int i = 0; i < 8; ++i) { eb[i] *= pre; const float en = __builtin_amdgcn_rcpf(fmaxf(eb[i], 1e-30f)); kt8[i] = kk[i] * en; kh[i] = kt8[i] * elast; }
              *(LAS v4u*)(L + H_KHT + d * TRS + 16 * g) = pack8(kh);
              if (PASS == 2) { const bf16x8_t q8 = cat4(tr_read(L + H_RAWQ + (8 * g + q_) * HRS + 32 * w + 8 * p_), tr_read(L + H_RAWQ + (8 * g + 4 + q_) * HRS + 32 * w + 8 * p_));
                  float qh[8];
#pragma unroll
                  for (int i = 0; i < 8; ++i) qh[i] = siluf_(bfs(q8[i])) * eb[i];
                  *(LAS v4u*)(L + H_QHT + d * TRS + 16 * g) = pack8(qh); *(LAS v4u*)(L + H_KTT + d * TRS + 16 * g) = pack8(kt8); }
              if (g == 0) *(LAS float*)(L + H_DL + 4 * d) = elast;
              dprod *= elast; }
            LDS_BARRIER();
            if (PASS == 2) cg = cgn;
          }
        }
#undef HG_WRITE
#undef HG_REFILL
        if (PASS == 1) {
#pragma unroll
            for (int kt = 0; kt < 8; ++kt) *(f32x4*)(ust + ((((size_t)u * 8 + w) * 8 + kt) * 64 + lane) * 4) = S[kt];
            if (g == 0) dst[(size_t)u * 128 + d] = dprod;
        }
        __syncthreads();
    }
}


constexpr int H1_G = 4, H1_RF = 0, H1_RV = H1_G * 8704, H1_KH = 2 * H1_G * 8704;
__device__ __forceinline__ void p_hgrn1(Frame& F, const bf16* P1, const float* lb_logits, int layer, float* ust, float* dst) {
    LAS unsigned char* L = F.lds;
    const int lane = F.lane, w = F.wave, g = lane >> 4, n = lane & 15, q_ = n >> 2, p_ = n & 3;
    const int pt = F.tid >> 4, pc8 = (F.tid & 15) * 8;
    constexpr int NCH = HSEG / HCH;
    for (int u = F.bid; u < BATCH * H_B * HNSEG; u += F.G) {
        const int seg = u & (HNSEG - 1), bh = u / HNSEG, b = bh >> 2, h = bh & 3;
        const int d = 16 * w + n;
        float lb; { const int ch = h * 128 + d; const float l0 = lb_logits[ch], l1 = lb_logits[512 + ch]; const float mx = fmaxf(l0, l1);
            const float e0 = expf(l0 - mx), e1 = expf(l1 - mx); const float p0 = e0 / (e0 + e1), p1 = e1 / (e0 + e1);
            const float lbx = (layer == 0) ? (p0 - p0) : ((p0 + p1) - p0); lb = fminf(fmaxf(lbx, 0.f), 1.f); }
        const float lbf = fmaxf(lb, 1e-30f), oml = 1.0f - lb;
        f32x4 S[8];
#pragma unroll
        for (int kt = 0; kt < 8; ++kt) S[kt] = (f32x4){0.f, 0.f, 0.f, 0.f};
        float R = 1.0f;
        const bf16* gp = P1 + ((size_t)b * SEQ + (size_t)seg * HSEG + pt) * P1E + P1_OB / 2 + h * 128 + pc8;
        v4u rf[H1_G], rv[H1_G];
#pragma unroll
        for (int j = 0; j < H1_G; ++j) { const bf16* np = gp + (size_t)(NCH - 1 - j) * HCH * P1E; rf[j] = *(const v4u*)(np + 512); rv[j] = *(const v4u*)(np + 1024); }
#pragma unroll 1
        for (int c0 = NCH - 1; c0 >= 0; c0 -= H1_G) {
#pragma unroll
            for (int j = 0; j < H1_G; ++j) { *(LAS v4u*)(L + H1_RF + j * 8704 + pt * HRS + pc8 * 2) = rf[j]; *(LAS v4u*)(L + H1_RV + j * 8704 + pt * HRS + pc8 * 2) = rv[j]; }
            LDS_BARRIER();
            if (c0 - H1_G >= 0) {
#pragma unroll
                for (int j = 0; j < H1_G; ++j) { const bf16* np = gp + (size_t)(c0 - H1_G - j) * HCH * P1E; rf[j] = *(const v4u*)(np + 512); rv[j] = *(const v4u*)(np + 1024); } }
#pragma unroll
            for (int j = 0; j < H1_G; ++j) {
                const bf16x8_t f8 = cat4(tr_read(L + H1_RF + j * 8704 + (8 * g + q_) * HRS + 32 * w + 8 * p_), tr_read(L + H1_RF + j * 8704 + (8 * g + 4 + q_) * HRS + 32 * w + 8 * p_));
                float eb[8], kk[8]; float cp = 1.0f;
#pragma unroll
                for (int i = 0; i < 8; ++i) { const float sg = __builtin_amdgcn_rcpf(1.0f + __expf(-bfs(f8[i]))); const float f = lbf + oml * sg; kk[i] = oml * (1.0f - sg); cp *= f; eb[i] = cp; }
                const float s1 = shl(cp, n), s2 = shl(cp, 16 + n), s3 = shl(cp, 32 + n), s4 = shl(cp, 48 + n);
                const float pre = (g > 0 ? s1 : 1.0f) * (g > 1 ? s2 : 1.0f) * (g > 2 ? s3 : 1.0f);
                const float elast = ((s1 * s2) * s3) * s4, er = elast * R;
                float kh[8];
#pragma unroll
                for (int i = 0; i < 8; ++i) { const float en = __builtin_amdgcn_rcpf(fmaxf(eb[i] * pre, 1e-30f)); kh[i] = (kk[i] * en) * er; }
                *(LAS v4u*)(L + H1_KH + j * 10240 + d * TRS + 16 * g) = pack8(kh);
                R = er; }
            LDS_BARRIER();
#pragma unroll
            for (int j = 0; j < H1_G; ++j) {
                const bf16x8_t bVn = cat4(tr_read(L + H1_RV + j * 8704 + (8 * g + q_) * HRS + 32 * w + 8 * p_), tr_read(L + H1_RV + j * 8704 + (8 * g + 4 + q_) * HRS + 32 * w + 8 * p_));
#pragma unroll
                for (int kt = 0; kt < 8; ++kt) { const bf16x8_t aKh = *(const LAS bf16x8_t*)(L + H1_KH + j * 10240 + (16 * kt + n) * TRS + 16 * g);
                    S[kt] = __builtin_amdgcn_mfma_f32_16x16x32_bf16(aKh, bVn, S[kt], 0, 0, 0); } }
            LDS_BARRIER();
        }
#pragma unroll
        for (int kt = 0; kt < 8; ++kt) *(f32x4*)(ust + ((((size_t)u * 8 + w) * 8 + kt) * 64 + lane) * 4) = S[kt];
        if (g == 0) dst[(size_t)u * 128 + d] = R;
        __syncthreads();
    }
}

constexpr int SG_V = 0, SG_OB = 34816, SG_OBS = 132, SG_RS = SG_OB + 128 * SG_OBS * 4;
__device__ __forceinline__ void p_sgu(Frame& F, const bf16* P1, const float* norm_w, const float* sgu_w, const float* sgu_b, bf16* yc) {
    LAS unsigned char* L = F.lds;
    const int lane = F.lane, w = F.wave, gq = lane >> 4, n = lane & 15, q_ = n >> 2, p_ = n & 3;
    const int sr = F.tid >> 4, c8 = (F.tid & 15) * 8;
    for (int u = F.bid; u < M / 128; u += F.G) {
        const size_t row0 = (size_t)u * 128;
        v2u_p1 rv[4][4]; float ssj[4] = {0.f, 0.f, 0.f, 0.f};
#pragma unroll
        for (int g = 0; g < 4; ++g)
#pragma unroll
            for (int j = 0; j < 4; ++j) { rv[g][j] = *(const v2u_p1*)((const unsigned char*)P1 + (row0 + sr + 32 * j) * P1_PITCH + P1_OC + 512 + g * 128 + c8); float f[8]; decode8u(rv[g][j], f);
#pragma unroll
                for (int i = 0; i < 8; ++i) ssj[j] += f[i] * f[i]; }
#pragma unroll
        for (int j = 0; j < 4; ++j) { float ss = ssj[j]; ss += shx(ss, 1, lane); ss += shx(ss, 2, lane); ss += shx(ss, 4, lane); ss += shx(ss, 8, lane);
            if (n == 0) *(LAS float*)(L + SG_RS + 4 * (sr + 32 * j)) = 1.0f / sqrtf(ss * (1.0f / 512.0f) + EPS); }
        const int kmax = w >> 1, t = 16 * w + n;
        f32x4 wl[4][2]; float nwl[8];
#define SG_WLOAD(g_) do { _Pragma("unroll") for (int ks = 0; ks < 4; ++ks) { const float* wp = sgu_w + ((size_t)(g_) * 128 + t) * 128 + 32 * ks + 8 * gq; wl[ks][0] = *(const f32x4*)wp; wl[ks][1] = *(const f32x4*)(wp + 4); } \
            _Pragma("unroll") for (int ct = 0; ct < 8; ++ct) nwl[ct] = norm_w[(g_) * 128 + 16 * ct + n]; asm volatile("" ::: "memory"); } while (0)

#pragma unroll
        for (int g = 0; g < 4; ++g) {
            SG_WLOAD(g);
            v2u_p1 ul[4]; float bl[4];
#pragma unroll
            for (int j = 0; j < 4; ++j) { ul[j] = *(const v2u_p1*)((const unsigned char*)P1 + (row0 + sr + 32 * j) * P1_PITCH + P1_OC + g * 128 + c8); bl[j] = sgu_b[g * 128 + sr + 32 * j]; }
            asm volatile("" ::: "memory");
#pragma unroll
            for (int j = 0; j < 4; ++j) { v2u_p1 rw = rv[g][j]; asm volatile("" : "+v"(rw.x), "+v"(rw.y));
                float f[8]; decode8u(rw, f); *(LAS v4u*)(L + SG_V + (sr + 32 * j) * HRS + c8 * 2) = pack8(f); }
            LDS_BARRIER();
            float nwv[8];
            bf16x8_t aW[4];
            {
#pragma unroll
              for (int ct = 0; ct < 8; ++ct) nwv[ct] = nwl[ct];
#pragma unroll
              for (int ks = 0; ks < 4; ++ks) { const int s0 = 32 * ks + 8 * gq;
                    const f32x4 w0 = wl[ks][0], w1 = wl[ks][1]; const f32x4 r0 = *(const LAS f32x4*)(L + SG_RS + 4 * s0), r1 = *(const LAS f32x4*)(L + SG_RS + 4 * (s0 + 4));
                    float a8[8] = {w0.x * r0.x, w0.y * r0.y, w0.z * r0.z, w0.w * r0.w, w1.x * r1.x, w1.y * r1.y, w1.z * r1.z, w1.w * r1.w};
#pragma unroll
                    for (int i = 0; i < 8; ++i) if (s0 + i > t) a8[i] = 0.f;
                    aW[ks] = __builtin_bit_cast(bf16x8_t, pack8(a8)); } }
            f32x4 acc[8];
#pragma unroll
            for (int ct = 0; ct < 8; ++ct) acc[ct] = (f32x4){0.f, 0.f, 0.f, 0.f};
#pragma unroll
            for (int ks = 0; ks < 4; ++ks) { if (ks <= kmax) {
#pragma unroll
                for (int ct = 0; ct < 8; ++ct) { const bf16x8_t bV = cat4(tr_read(L + SG_V + (32 * ks + 8 * gq + q_) * HRS + 32 * ct + 8 * p_), tr_read(L + SG_V + (32 * ks + 8 * gq + 4 + q_) * HRS + 32 * ct + 8 * p_));
                    acc[ct] = __builtin_amdgcn_mfma_f32_16x16x32_bf16(aW[ks], bV, acc[ct], 0, 0, 0); } } }
#pragma unroll
            for (int ct = 0; ct < 8; ++ct) { const float nw = nwv[ct];
#pragma unroll
                for (int j = 0; j < 4; ++j) *(LAS float*)(L + SG_OB + ((16 * w + 4 * gq + j) * SG_OBS + 16 * ct + n) * 4) = acc[ct][j] * nw; }
            LDS_BARRIER();
#pragma unroll
            for (int j = 0; j < 4; ++j) { const int tt = sr + 32 * j; const float bias = bl[j];
                const f32x4 o0 = *(const LAS f32x4*)(L + SG_OB + (tt * SG_OBS + c8) * 4), o1 = *(const LAS f32x4*)(L + SG_OB + (tt * SG_OBS + c8 + 4) * 4);
                float uu[8], y[8]; decode8u(ul[j], uu);
                y[0] = (o0.x + bias) * uu[0]; y[1] = (o0.y + bias) * uu[1]; y[2] = (o0.z + bias) * uu[2]; y[3] = (o0.w + bias) * uu[3];
                y[4] = (o1.x + bias) * uu[4]; y[5] = (o1.y + bias) * uu[5]; y[6] = (o1.z + bias) * uu[6]; y[7] = (o1.w + bias) * uu[7];
                store_y8<Q_BR, 8>(yc, (row0 + tt) * 512 + g * 128 + c8, y, lane, CLIP_YC); }
        }
        __syncthreads();
    }
#undef SG_WLOAD
}

__device__ __forceinline__ void p_norm_router(Frame& F, KArgs ka, const void* x, const float* w, const float* mod_l, bf16* h2) {
    const float* rw = ka->in[20]; const float* rb = ka->in[21]; unsigned* ctl = (unsigned*)(ka->ws + WS_CTL);
    float* topp = (float*)(ka->ws + WS_TOPP); int* list = (int*)(ka->ws + WS_LIST);
    LAS float* RWt = (LAS float*)F.lds;
    LAS int* lcnt = (LAS int*)(RWt + 8192);
    LAS int* lbase = lcnt + 16;
    LAS int* sel = lbase + 16;
    LAS int* rnk = sel + 128;
    for (int i = F.tid; i < D * NE; i += NT) { const int k = i >> 3, e = i & 7; RWt[e * D + k] = rw[i]; }
    __syncthreads();
    float rbv[8];
#pragma unroll
    for (int e = 0; e < 8; ++e) rbv[e] = rb[e];
    f32x4 wv[4];
#pragma unroll
    for (int j = 0; j < 4; ++j) wv[j] = ((const f32x4*)w)[F.lane + 64 * j];
    for (int batch = F.bid; batch < M / 128; batch += F.G) {
        const int row0 = batch * 128;
        if (F.tid < 16) lcnt[F.tid] = 0;
        const float* mb = mod_l + (size_t)(row0 >> 12) * MOD_LD;
        f32x4 scv[4], shv[4], xn[4];
#pragma unroll
        for (int j = 0; j < 4; ++j) { scv[j] = ((const f32x4*)(mb + 4 * D))[F.lane + 64 * j]; shv[j] = ((const f32x4*)(mb + 3 * D))[F.lane + 64 * j]; xn[j] = load_x4<true>(x, (size_t)(row0 + F.wave * 16), F.lane, j); }
        asm volatile("" ::: "memory");
#pragma unroll
        for (int j = 0; j < 4; ++j) scv[j] = wv[j] * (scv[j] + 1.0f);
        __syncthreads();
        for (int rr = 0; rr < 16; ++rr) {
            const int r = F.wave * 16 + rr, row = row0 + r;
            f32x4 v[4];
#pragma unroll
            for (int j = 0; j < 4; ++j) v[j] = xn[j];
            if (rr + 1 < 16) {
#pragma unroll
                for (int j = 0; j < 4; ++j) xn[j] = load_x4<true>(x, (size_t)(row + 1), F.lane, j); }
            float ssq = 0.f;
#pragma unroll
            for (int j = 0; j < 4; ++j) ssq += (v[j].x * v[j].x + v[j].y * v[j].y) + (v[j].z * v[j].z + v[j].w * v[j].w);
            const float rstd = 1.0f / sqrtf(wave_sum(ssq, F.lane) * (1.0f / D) + EPS);
            f32x4 o[4];
#pragma unroll
            for (int j = 0; j < 4; ++j) o[j] = v[j] * rstd * scv[j] + shv[j];
            { unsigned* o4 = (unsigned*)((unsigned char*)h2 + (size_t)row * D) + F.lane;
#pragma unroll
                for (int j = 0; j < 4; ++j) { const f32x4 q = (Q_MUP == 2) ? rot64(o[j], F.lane) : o[j]; o4[64 * j] = pk4_q<Q_MUP>(q.x * sa_of(Q_MUP, CLIP_MOE), q.y * sa_of(Q_MUP, CLIP_MOE), q.z * sa_of(Q_MUP, CLIP_MOE), q.w * sa_of(Q_MUP, CLIP_MOE)); } }
            float lg[8];
#pragma unroll
            for (int e = 0; e < 8; ++e) { float s = 0.f;
#pragma unroll
                for (int j = 0; j < 4; ++j) { const f32x4 r4 = *(const LAS f32x4*)(RWt + e * D + 4 * F.lane + 256 * j); s += (o[j].x * r4.x + o[j].y * r4.y) + (o[j].z * r4.z + o[j].w * r4.w); }
                lg[e] = wave_sum(s, F.lane) + rbv[e]; }
            int i0 = 0; float v0 = lg[0];
#pragma unroll
            for (int e = 1; e < 8; ++e) if (lg[e] > v0) { v0 = lg[e]; i0 = e; }
            int i1 = -1; float v1 = -3.0e38f;
#pragma unroll
            for (int e = 0; e < 8; ++e) if (e != i0 && lg[e] > v1) { v1 = lg[e]; i1 = e; }
            if (F.lane == 0) {
                const float p0 = 1.0f / (1.0f + expf(v1 - v0));
                topp[(size_t)row * 2] = p0; topp[(size_t)row * 2 + 1] = 1.0f - p0;
                const int rk0 = __hip_atomic_fetch_add(lcnt + i0, 1, __ATOMIC_RELAXED, __HIP_MEMORY_SCOPE_WORKGROUP), rk1 = __hip_atomic_fetch_add(lcnt + 8 + i1, 1, __ATOMIC_RELAXED, __HIP_MEMORY_SCOPE_WORKGROUP);
                sel[r] = i0 | (i1 << 8); rnk[r] = rk0 | (rk1 << 16);
            }
        }
        __syncthreads();
        if (F.tid < 16) lbase[F.tid] = (int)__hip_atomic_fetch_add(ctl + CW_CNT + 64 * F.tid, (unsigned)lcnt[F.tid], __ATOMIC_RELAXED, __HIP_MEMORY_SCOPE_AGENT);
        __syncthreads();
        if (F.tid < 128) { const int sv = sel[F.tid], rv = rnk[F.tid]; const int e0 = sv & 255, e1 = sv >> 8;
            list[(size_t)e0 * LIST_CAP + lbase[e0] + (rv & 0xffff)] = row0 + F.tid;
            list[(size_t)(8 + e1) * LIST_CAP + lbase[8 + e1] + (rv >> 16)] = row0 + F.tid; }
        __syncthreads();
    }
}
__device__ __forceinline__ void moe_tables(Frame& F, unsigned* ctl, int pass) {
    LAS int* tab = (LAS int*)(F.lds + TAB_OFF) + pass * 256;
    __syncthreads();
    if (F.tid < 8) { int c = (int)__hip_atomic_load(ctl + CW_CNT + 64 * (pass * 8 + F.tid), __ATOMIC_RELAXED, __HIP_MEMORY_SCOPE_AGENT); if (c > LIST_CAP) c = LIST_CAP; if (c < 0) c = 0; tab[F.tid] = c; }
    __syncthreads();
    if (F.tid == 0) { int pb = 0;
        for (int e = 0; e < 8; ++e) { const int c = tab[e]; const int np = (c + 255) >> 8; tab[8 + e] = pb; for (int p = 0; p < np; ++p) tab[32 + pb + p] = e; pb += np; }
        tab[16] = pb; }
    __syncthreads();
}
template <bool GATHER_>
struct MoeOrder {
    static constexpr bool GATHER = GATHER_;
    pg8::StaticOrder so; const LAS int* tab; const int* list; int npn; unsigned rowbytes;
    int pm0 = 0;
    int T = 0, HC = 0;
    __device__ __forceinline__ bool next(int i, pg8::Unit& u) const {
        const int G = so.G, c = so.c; long L;
        if (T == 0) L = (long)i * G + c;
        else if (c >= T) L = (i < HC) ? (long)i * (G - T) + (c - T) : (long)HC * (G - T) + (long)(i - HC) * G + c;
        else L = (long)HC * (G - T) + (long)i * G + c;
        if (!so.unit_of(L, u)) return false; u.pm += pm0; u.pb = tab[32 + u.pm] * npn + u.pn; return true; }
    __device__ __forceinline__ int tok_of(int pm, int r) const { const int e = tab[32 + pm]; const int idx = (pm - tab[8 + e]) * 256 + r; return idx < tab[e] ? list[(size_t)e * LIST_CAP + idx] : -1; }
    __device__ __forceinline__ unsigned a_row_off(const pg8::Unit& u, int r) const { const int t = tok_of(u.pm, r); return (unsigned)(t < 0 ? 0 : t) * rowbytes; }
};

#ifndef WIDE_ST
#define WIDE_ST 1
#endif
typedef unsigned v2u_t __attribute__((ext_vector_type(2)));
__device__ __forceinline__ v4u pair16(const v2u_t a, const v2u_t b) {
    const auto rx = __builtin_amdgcn_permlane16_swap(a.x, b.x, false, false); const auto ry = __builtin_amdgcn_permlane16_swap(a.y, b.y, false, false);
    return (v4u){rx[0], ry[0], rx[1], ry[1]};
}
template <int Q>
struct EpiP1 {
    static constexpr bool PERM = true;
    unsigned char* O; float scale;
    __device__ __forceinline__ void operator()(const pg8::f32x4 (&acc)[2][2][4][2], const pg8::Unit& u, int wr, int wc, int fr, int fq) const {
        const int row0 = u.pm * 256 + wr * 64 + fr, colt = u.pn * 256;
        if (u.pn >= 6 && u.pn < 14) {
            unsigned char* base = O + P1_OB + (size_t)(colt - 1536 + wc * 32 + 8 * fq) * 2;
#pragma unroll
            for (int ai = 0; ai < 2; ++ai)
#pragma unroll
                for (int m = 0; m < 4; ++m) { unsigned char* rowp = base + (size_t)(row0 + ai * 128 + m * 16) * P1_PITCH;
#pragma unroll
                    for (int bj = 0; bj < 2; ++bj) { pg8::f32x4 v0 = acc[ai][bj][m][0], v1 = acc[ai][bj][m][1];
                        if constexpr (Q == 2) { v0 = __builtin_convertvector(__builtin_bit_cast(pg8::v4i32_, v0), pg8::f32x4); v1 = __builtin_convertvector(__builtin_bit_cast(pg8::v4i32_, v1), pg8::f32x4); }
                        v0 *= scale; v1 *= scale;
                        v4u w; w.x = pk2(v0[0], v0[1]); w.y = pk2(v0[2], v0[3]); w.z = pk2(v1[0], v1[1]); w.w = pk2(v1[2], v1[3]);
                        *(v4u*)(rowp + bj * 256) = w; } }
        } else {
            unsigned char* base = O + (u.pn < 6 ? colt : P1_OC + colt - 3584) + wc * 32 + 8 * fq;
            const float qs = scale * (127.0f / CLIP_P1); constexpr float MGO = 12582912.0f + 128.0f;
#pragma unroll
            for (int ai = 0; ai < 2; ++ai)
#pragma unroll
                for (int m = 0; m < 4; ++m) { unsigned char* rowp = base + (size_t)(row0 + ai * 128 + m * 16) * P1_PITCH; v2u_t wb[2];
#pragma unroll
                    for (int bj = 0; bj < 2; ++bj)
#pragma unroll
                        for (int n = 0; n < 2; ++n) { const pg8::f32x4 v = acc[ai][bj][m][n]; unsigned ub[4];
#pragma unroll
                            for (int i = 0; i < 4; ++i) ub[i] = __float_as_uint(__builtin_amdgcn_fmed3f(accf<Q>(v[i]) * qs + MGO, MGO - 127.0f, MGO + 127.0f));
                            const unsigned pk = __builtin_amdgcn_perm(__builtin_amdgcn_perm(ub[3], ub[2], 0x0c0c0400u), __builtin_amdgcn_perm(ub[1], ub[0], 0x0c0c0400u), 0x05040100u);
                            if (n == 0) wb[bj].x = pk; else wb[bj].y = pk; }
                    *(v4u*)(rowp + ((fq & 1) ? 128 - 8 : 0)) = pair16(wb[0], wb[1]); } }
    }
};
template <bool GU8, int QB = 0, int QM = 0>
struct EpiBranch {
    static constexpr bool PERM = true;
    const bf16* gate; bf16* mrg; const float* qsb; unsigned char* mrg8;
    __device__ __forceinline__ void operator()(const pg8::f32x4 (&acc)[2][2][4][2], const pg8::Unit& u, int wr, int wc, int fr, int fq) const {
        typedef unsigned v2u_ __attribute__((ext_vector_type(2)));
        const int row0 = u.pm * 256 + wr * 64 + fr, col0 = u.pn * 256 + wc * 32 + 8 * fq + u.aux * D;
        const int first = (u.aux == 0), mshift = u.aux * D;
        const float bsc = (u.aux == 0 ? CLIP_YA : (u.aux == 1 ? CLIP_YB : CLIP_YC)) / (127.0f * (QB == 2 ? qsb[u.aux] : 1.0f));
        v4u gl[2][2][2], ml[2][2][2];
#define EB_LOAD(q) do { _Pragma("unroll") for (int mm_ = 0; mm_ < 2; ++mm_) _Pragma("unroll") for (int bj = 0; bj < 2; ++bj) { \
            const size_t row = (size_t)(row0 + ((q) >> 1) * 128 + (((q) & 1) * 2 + mm_) * 16); const int col = col0 + bj * 128; \
            if constexpr (GU8) { const v2u_ g2 = *(const v2u_*)((const unsigned char*)gate + row * N_G + col); gl[(q) & 1][mm_][bj].x = g2.x; gl[(q) & 1][mm_][bj].y = g2.y; } else gl[(q) & 1][mm_][bj] = *(const v4u*)(gate + row * N_G + col); \
            ml[(q) & 1][mm_][bj] = first ? (v4u){0u, 0u, 0u, 0u} : *(const v4u*)(mrg + row * D + col - mshift); } asm volatile("" ::: "memory"); } while (0)
        EB_LOAD(0);
#pragma unroll
        for (int q = 0; q < 4; ++q) {
            if (q < 3) EB_LOAD(q + 1);
            const int ai = q >> 1;
#pragma unroll
            for (int mm_ = 0; mm_ < 2; ++mm_)
#pragma unroll
                for (int bj = 0; bj < 2; ++bj) { const int m = (q & 1) * 2 + mm_; const size_t row = (size_t)(row0 + ai * 128 + m * 16); const int col = col0 + bj * 128;
                    float gg[8], mm[8], o[8]; unpack8(ml[q & 1][mm_][bj], mm);
                    if constexpr (GU8) {
#pragma unroll
                        for (int i = 0; i < 4; ++i) { gg[i] = (float)((gl[q & 1][mm_][bj].x >> (8 * i)) & 0xffu) * (1.0f / 255.0f); gg[4 + i] = (float)((gl[q & 1][mm_][bj].y >> (8 * i)) & 0xffu) * (1.0f / 255.0f); } }
                    else { unpack8(gl[q & 1][mm_][bj], gg);
#pragma unroll
                        for (int i = 0; i < 8; ++i) gg[i] = sigmoidf_(gg[i]); }
                    pg8::f32x4 v0 = acc[ai][bj][m][0], v1 = acc[ai][bj][m][1];
                    if constexpr (QB == 2) { v0 = __builtin_convertvector(__builtin_bit_cast(pg8::v4i32_, v0), pg8::f32x4) * bsc; v1 = __builtin_convertvector(__builtin_bit_cast(pg8::v4i32_, v1), pg8::f32x4) * bsc; }
                    o[0] = mm[0] + gg[0] * v0[0]; o[1] = mm[1] + gg[1] * v0[1]; o[2] = mm[2] + gg[2] * v0[2]; o[3] = mm[3] + gg[3] * v0[3];
                    o[4] = mm[4] + gg[4] * v1[0]; o[5] = mm[5] + gg[5] * v1[1]; o[6] = mm[6] + gg[6] * v1[2]; o[7] = mm[7] + gg[7] * v1[3];
                    if (QM == 2 && u.aux == 2) { fwht8(o); constexpr float s = 0.35355339f * 127.0f / CLIP_MRG; v2u_ w8; w8.x = pk4_q<2>(o[0] * s, o[1] * s, o[2] * s, o[3] * s); w8.y = pk4_q<2>(o[4] * s, o[5] * s, o[6] * s, o[7] * s);
                        *(v2u_*)(mrg8 + row * D + col - mshift) = w8; }
                    else *(v4u*)(mrg + row * D + col - mshift) = pack8(o); }
            asm volatile("" ::: "memory");
        }
#undef EB_LOAD
    }
};
#ifndef CLIP_PART1
#define CLIP_PART1 2.5f
#endif
#ifndef CLIP_PART2
#define CLIP_PART2 5.0f
#endif
__device__ __forceinline__ unsigned pk4_ob(float a, float b, float c, float d) {
    constexpr float MGO = 12582912.0f + 128.0f;
    const unsigned ua = __float_as_uint(__builtin_amdgcn_fmed3f(a + MGO, MGO - 127.0f, MGO + 127.0f)), ub = __float_as_uint(__builtin_amdgcn_fmed3f(b + MGO, MGO - 127.0f, MGO + 127.0f));
    const unsigned uc = __float_as_uint(__builtin_amdgcn_fmed3f(c + MGO, MGO - 127.0f, MGO + 127.0f)), ud = __float_as_uint(__builtin_amdgcn_fmed3f(d + MGO, MGO - 127.0f, MGO + 127.0f));
    return __builtin_amdgcn_perm(__builtin_amdgcn_perm(ud, uc, 0x0c0c0400u), __builtin_amdgcn_perm(ub, ua, 0x0c0c0400u), 0x05040100u);
}
template <int QB>
struct EpiBranch8 {
    static constexpr bool PERM = true;
    const unsigned char* gate; const float* qsb; unsigned char* mrg8;
    __device__ __forceinline__ void operator()(const pg8::f32x4 (&acc)[2][2][4][2], const pg8::Unit& u, int wr, int wc, int fr, int fq) const {
        const int row0 = u.pm * 256 + wr * 64 + fr, col0 = u.pn * 256 + wc * 32 + 8 * fq + u.aux * D;
        const int first = (u.aux == 1), last = (u.aux == 0), mshift = u.aux * D;
        const float bsc = (u.aux == 0 ? CLIP_YA : (u.aux == 1 ? CLIP_YB : CLIP_YC)) / (127.0f * (QB == 2 ? qsb[u.aux] : 1.0f));
        const float din = (u.aux == 2 ? CLIP_PART1 : CLIP_PART2) * (1.0f / 127.0f), dinb = -128.0f * din;
        const float sout = 127.0f / (u.aux == 1 ? CLIP_PART1 : CLIP_PART2);
        const int sto = (fq & 1) ? 128 - 8 : 0;
        v2u_t gl[2][2][2], ml[2][2][2];
#define EB_LOAD(q) do { _Pragma("unroll") for (int mm_ = 0; mm_ < 2; ++mm_) _Pragma("unroll") for (int bj = 0; bj < 2; ++bj) { \
            const size_t row = (size_t)(row0 + ((q) >> 1) * 128 + (((q) & 1) * 2 + mm_) * 16); const int col = col0 + bj * 128; \
            gl[(q) & 1][mm_][bj] = *(const v2u_t*)(gate + row * N_G + col); \
            ml[(q) & 1][mm_][bj] = first ? (v2u_t){0x80808080u, 0x80808080u} : *(const v2u_t*)(mrg8 + row * D + col - mshift); } asm volatile("" ::: "memory"); } while (0)
        EB_LOAD(0);
#pragma unroll
        for (int q = 0; q < 4; ++q) {
            if (q < 3) EB_LOAD(q + 1);
            const int ai = q >> 1;
#pragma unroll
            for (int mm_ = 0; mm_ < 2; ++mm_) { const int m = (q & 1) * 2 + mm_; const size_t row = (size_t)(row0 + ai * 128 + m * 16); v2u_t wb[2];
#pragma unroll
                for (int bj = 0; bj < 2; ++bj) { float gg[8], mm[8], o[8];
#pragma unroll
                    for (int i = 0; i < 4; ++i) { gg[i] = (float)((gl[q & 1][mm_][bj].x >> (8 * i)) & 0xffu) * (1.0f / 255.0f); gg[4 + i] = (float)((gl[q & 1][mm_][bj].y >> (8 * i)) & 0xffu) * (1.0f / 255.0f);
                        mm[i] = (float)((ml[q & 1][mm_][bj].x >> (8 * i)) & 0xffu) * din + dinb; mm[4 + i] = (float)((ml[q & 1][mm_][bj].y >> (8 * i)) & 0xffu) * din + dinb; }
                    pg8::f32x4 v0 = acc[ai][bj][m][0], v1 = acc[ai][bj][m][1];
                    if constexpr (QB == 2) { v0 = __builtin_convertvector(__builtin_bit_cast(pg8::v4i32_, v0), pg8::f32x4) * bsc; v1 = __builtin_convertvector(__builtin_bit_cast(pg8::v4i32_, v1), pg8::f32x4) * bsc; }
                    o[0] = mm[0] + gg[0] * v0[0]; o[1] = mm[1] + gg[1] * v0[1]; o[2] = mm[2] + gg[2] * v0[2]; o[3] = mm[3] + gg[3] * v0[3];
                    o[4] = mm[4] + gg[4] * v1[0]; o[5] = mm[5] + gg[5] * v1[1]; o[6] = mm[6] + gg[6] * v1[2]; o[7] = mm[7] + gg[7] * v1[3];
                    if (last) { fwht8(o); constexpr float s = 0.35355339f * 127.0f / CLIP_MRG; wb[bj].x = pk4_q<2>(o[0] * s, o[1] * s, o[2] * s, o[3] * s); wb[bj].y = pk4_q<2>(o[4] * s, o[5] * s, o[6] * s, o[7] * s); }
                    else { wb[bj].x = pk4_ob(o[0] * sout, o[1] * sout, o[2] * sout, o[3] * sout); wb[bj].y = pk4_ob(o[4] * sout, o[5] * sout, o[6] * sout, o[7] * sout); } }
                *(v4u*)(mrg8 + row * D + col0 - mshift + sto) = pair16(wb[0], wb[1]); }
            asm volatile("" ::: "memory");
        }
#undef EB_LOAD
    }
};
template <int Q>
struct EpiGateU8 {
    static constexpr bool PERM = true;
    unsigned char* O; float scale;
    __device__ __forceinline__ void operator()(const pg8::f32x4 (&acc)[2][2][4][2], const pg8::Unit& u, int wr, int wc, int fr, int fq) const {
        typedef unsigned v2u_ __attribute__((ext_vector_type(2)));
        const int row0 = u.pm * 256 + wr * 64 + fr, col0 = u.pn * 256 + wc * 32 + 8 * fq;
        const float nsl2 = -1.44269504f * scale;
#pragma unroll
        for (int ai = 0; ai < 2; ++ai)
#pragma unroll
            for (int m = 0; m < 4; ++m) { unsigned char* rowp = O + (size_t)(row0 + ai * 128 + m * 16) * N_G + col0;
                v2u_ wb[2];
#pragma unroll
                for (int bj = 0; bj < 2; ++bj) { v2u_ w;
#pragma unroll
                    for (int n = 0; n < 2; ++n) { const pg8::f32x4 v = acc[ai][bj][m][n]; unsigned ub[4];
#pragma unroll
                        for (int i = 0; i < 4; ++i) ub[i] = __float_as_uint(__builtin_amdgcn_rcpf(1.0f + __builtin_amdgcn_exp2f(accf<Q>(v[i]) * nsl2)) * 255.0f + 12582912.0f);
                        const unsigned p = __builtin_amdgcn_perm(__builtin_amdgcn_perm(ub[3], ub[2], 0x0c0c0400u), __builtin_amdgcn_perm(ub[1], ub[0], 0x0c0c0400u), 0x05040100u);
                        if (n == 0) w.x = p; else w.y = p; }
                    wb[bj] = w; }
                if (WIDE_ST) *(v4u*)(rowp + ((fq & 1) ? 128 - 8 : 0)) = pair16(wb[0], wb[1]);
                else { *(v2u_*)rowp = wb[0]; *(v2u_*)(rowp + 128) = wb[1]; } }
    }
};
template <bool IN_F32, int QI = 0>
struct EpiResid {
    static constexpr bool PERM = true;
    const void* xin; bf16* xout; const float* gmod; float onum, oden;
    __device__ __forceinline__ void operator()(const pg8::f32x4 (&acc)[2][2][4][2], const pg8::Unit& u, int wr, int wc, int fr, int fq) const {
        const int row0 = u.pm * 256 + wr * 64 + fr, col0 = u.pn * 256 + wc * 32 + 8 * fq;
        const float* gb = gmod + (size_t)((u.pm * 256) >> 12) * MOD_LD + col0;
        float od_ = oden; asm volatile("" : "+s"(od_)); const float oscale = onum / od_;
        pg8::f32x4 gv[2][2];
#pragma unroll
        for (int bj = 0; bj < 2; ++bj)
#pragma unroll
            for (int n = 0; n < 2; ++n) gv[bj][n] = *(const pg8::f32x4*)(gb + bj * 128 + n * 4) * oscale;
        constexpr int NB = 2;
#pragma unroll
        for (int b = 0; b < NB; ++b) {
            pg8::f32x4 xl[2 / NB][4][2][2];
#pragma unroll
            for (int a = 0; a < 2 / NB; ++a)
#pragma unroll
            for (int m = 0; m < 4; ++m)
#pragma unroll
                for (int bj = 0; bj < 2; ++bj) { const int ai = b * (2 / NB) + a; const size_t row = (size_t)(row0 + ai * 128 + m * 16); const int col = col0 + bj * 128;
                    if constexpr (IN_F32) { xl[a][m][bj][0] = *(const pg8::f32x4*)((const float*)xin + row * D + col); xl[a][m][bj][1] = *(const pg8::f32x4*)((const float*)xin + row * D + col + 4); }
                    else { const v4u w = *(const v4u*)((const bf16*)xin + row * XLD + col); xl[a][m][bj][0] = __builtin_bit_cast(pg8::f32x4, w); } }
            asm volatile("" ::: "memory");
#pragma unroll
            for (int a = 0; a < 2 / NB; ++a)
#pragma unroll
            for (int m = 0; m < 4; ++m)
#pragma unroll
                for (int bj = 0; bj < 2; ++bj) { const int ai = b * (2 / NB) + a; const size_t row = (size_t)(row0 + ai * 128 + m * 16); const int col = col0 + bj * 128;
                    pg8::f32x4 x0, x1;
                    if constexpr (IN_F32) { x0 = xl[a][m][bj][0]; x1 = xl[a][m][bj][1]; }
                    else { const v4u w = __builtin_bit_cast(v4u, xl[a][m][bj][0]); x0 = (pg8::f32x4){bf_lo(w.x), bf_hi(w.x), bf_lo(w.y), bf_hi(w.y)}; x1 = (pg8::f32x4){bf_lo(w.z), bf_hi(w.z), bf_lo(w.w), bf_hi(w.w)}; }
                    pg8::f32x4 c0 = acc[ai][bj][m][0], c1 = acc[ai][bj][m][1];
                    if constexpr (QI == 2) {
#pragma unroll
                        for (int i = 0; i < 4; ++i) { c0[i] = (float)__float_as_int(c0[i]); c1[i] = (float)__float_as_int(c1[i]); } }
                    const pg8::f32x4 o0 = x0 + gv[bj][0] * c0, o1 = x1 + gv[bj][1] * c1;
                    v4u w; w.x = pk2(o0[0], o0[1]); w.y = pk2(o0[2], o0[3]); w.z = pk2(o1[0], o1[1]); w.w = pk2(o1[2], o1[3]);
                    *(v4u*)(xout + row * XLD + col) = w; }
            asm volatile("" ::: "memory");
        }
    }
};
template <int QIN = 0, int QOUT = 0>
struct EpiSwiglu {
    static constexpr bool PERM = true;
    bf16* act; float inv;
    __device__ __forceinline__ void operator()(const pg8::f32x4 (&acc)[2][2][4][2], const pg8::Unit& u, int wr, int wc, int fr, int fq) const {
        const int row0 = u.pm * 256 + wr * 64 + fr, col0 = u.pn * 128 + wc * 32 + 8 * fq;
        v2u_t wprev = {0u, 0u};
        const float invq = QIN ? inv : 1.0f, inv2 = invq * invq, nil2 = -1.44269504f * invq;
#pragma unroll
        for (int ai = 0; ai < 2; ++ai)
#pragma unroll
            for (int m = 0; m < 4; ++m) { float o[8];
#pragma unroll
                for (int n = 0; n < 2; ++n)
#pragma unroll
                    for (int i = 0; i < 4; ++i) { const float c1 = accf<QIN>(acc[ai][0][m][n][i]), c3 = accf<QIN>(acc[ai][1][m][n][i]);
                        o[n * 4 + i] = (c1 * c3) * __builtin_amdgcn_rcpf(1.0f + __builtin_amdgcn_exp2f(c1 * nil2)); }
                if constexpr (QOUT != 0) { typedef unsigned v2u_ __attribute__((ext_vector_type(2))); v2u_ w8;
                    if constexpr (QOUT == 2) { fwht8(o); const float s = 0.35355339f * 127.0f / CLIP_ACT * inv2; w8.x = pk4_q<2>(o[0] * s, o[1] * s, o[2] * s, o[3] * s); w8.y = pk4_q<2>(o[4] * s, o[5] * s, o[6] * s, o[7] * s); }
                    else { const float s = F8_SACT * inv2; w8.x = pk4_q<1>(o[0] * s, o[1] * s, o[2] * s, o[3] * s); w8.y = pk4_q<1>(o[4] * s, o[5] * s, o[6] * s, o[7] * s); }
                    if (WIDE_ST) { if (m & 1) *(v4u*)((unsigned char*)act + (size_t)(row0 + ai * 128 + (m - 1 + (fq & 1)) * 16) * D_FF + col0 - (fq & 1) * 8) = pair16(wprev, w8);
                        else wprev = w8; }
                    else *(v2u_*)((unsigned char*)act + (size_t)(row0 + ai * 128 + m * 16) * D_FF + col0) = w8; }
                else {
#pragma unroll
                    for (int i = 0; i < 8; ++i) o[i] *= inv2;
                    *(v4u*)(act + (size_t)(row0 + ai * 128 + m * 16) * D_FF + col0) = pack8(o); } }
    }
};
struct EpiMoeDown {
    static constexpr bool PERM = true;
    bf16* x; const float* gmod; const float* topp; int pass; const LAS int* tab; const int* list; float oscale;
    bf16* y1; unsigned char* flag; int y1mode;
    __device__ __forceinline__ int tok_of(int pm, int r) const { const int e = tab[32 + pm]; const int idx = (pm - tab[8 + e]) * 256 + r; return idx < tab[e] ? list[(size_t)e * LIST_CAP + idx] : -1; }
    __device__ __forceinline__ void operator()(const pg8::f32x4 (&acc)[2][2][4][2], const pg8::Unit& u, int wr, int wc, int fr, int fq) const {
        const int col0 = u.pn * 256 + wc * 32 + 8 * fq;
        int tok[2][4];
#pragma unroll
        for (int ai = 0; ai < 2; ++ai)
#pragma unroll
            for (int m = 0; m < 4; ++m) tok[ai][m] = tok_of(u.pm, ai * 128 + wr * 64 + m * 16 + fr);
        asm volatile("" ::: "memory");
#pragma unroll
        for (int am = 0; am < 4; ++am) {
            const int ai = am >> 1, mb = (am & 1) * 2;
            v4u xl[2][2]; pg8::f32x4 gl[2][2][2]; float pv[2];
#pragma unroll
            for (int m = 0; m < 2; ++m) { const int t = tok[ai][mb + m] < 0 ? 0 : tok[ai][mb + m]; pv[m] = topp[(size_t)t * 2 + pass] * oscale; const float* gb = gmod + (size_t)(t >> 12) * MOD_LD + col0;
#pragma unroll
                for (int bj = 0; bj < 2; ++bj) { xl[m][bj] = *(const v4u*)(x + (size_t)t * XLD + col0 + bj * 128);
#pragma unroll
                    for (int n = 0; n < 2; ++n) gl[m][bj][n] = *(const pg8::f32x4*)(gb + bj * 128 + n * 4); } }
            asm volatile("" ::: "memory");
#pragma unroll
            for (int m = 0; m < 2; ++m) { if (tok[ai][mb + m] >= 0) { const int t = tok[ai][mb + m];
                if (y1mode) flag[t] = 1;
#pragma unroll
                for (int bj = 0; bj < 2; ++bj) { const v4u w = y1mode ? (v4u){0u, 0u, 0u, 0u} : xl[m][bj];
                    const pg8::f32x4 x0 = {bf_lo(w.x), bf_hi(w.x), bf_lo(w.y), bf_hi(w.y)}, x1 = {bf_lo(w.z), bf_hi(w.z), bf_lo(w.w), bf_hi(w.w)};
                    pg8::f32x4 c0 = acc[ai][bj][mb + m][0], c1 = acc[ai][bj][mb + m][1];
                    if constexpr (Q_MDN == 2) { c0 = __builtin_convertvector(__builtin_bit_cast(pg8::v4i32_, c0), pg8::f32x4); c1 = __builtin_convertvector(__builtin_bit_cast(pg8::v4i32_, c1), pg8::f32x4); }
                    const pg8::f32x4 o0 = x0 + gl[m][bj][0] * pv[m] * c0, o1 = x1 + gl[m][bj][1] * pv[m] * c1;
                    v4u r; r.x = pk2(o0[0], o0[1]); r.y = pk2(o0[2], o0[3]); r.z = pk2(o1[0], o1[1]); r.w = pk2(o1[2], o1[3]);
                    if (y1mode) *(v4u*)(y1 + (size_t)t * D + col0 + bj * 128) = r; else *(v4u*)(x + (size_t)t * XLD + col0 + bj * 128) = r; } } }
            asm volatile("" ::: "memory");
        }
    }
};

__device__ __forceinline__ void p_final_norm(Frame& F, float* x, const float* w, const bf16* y1, const unsigned char* flag) {
    const int gw = F.bid * NWAVES + F.wave, NGW = F.G * NWAVES, lane = F.lane;
    f32x4 wv[4];
#pragma unroll
    for (int j = 0; j < 4; ++j) wv[j] = ((const f32x4*)w)[lane + 64 * j];
    for (int r0 = gw * 4; r0 < M; r0 += NGW * 4) {
        f32x4 v[4][4];
#pragma unroll
        for (int r = 0; r < 4; ++r)
#pragma unroll
            for (int j = 0; j < 4; ++j) v[r][j] = load_x4<true>(x, (size_t)(r0 + r), lane, j);
#pragma unroll
        for (int r = 0; r < 4; ++r) if (flag[r0 + r]) {
#pragma unroll
            for (int j = 0; j < 4; ++j) { const v2u_p1 yw = ((const v2u_p1*)(y1 + (size_t)(r0 + r) * D))[lane + 64 * j]; v[r][j] += (f32x4){bf_lo(yw.x), bf_hi(yw.x), bf_lo(yw.y), bf_hi(yw.y)}; } }
        asm volatile("s_waitcnt vmcnt(0)" ::: "memory");
#pragma unroll
        for (int r = 0; r < 4; ++r) { float s = 0.f;
#pragma unroll
            for (int j = 0; j < 4; ++j) s += (v[r][j].x * v[r][j].x + v[r][j].y * v[r][j].y) + (v[r][j].z * v[r][j].z + v[r][j].w * v[r][j].w);
            const float rstd = 1.0f / sqrtf(wave_sum(s, lane) * (1.0f / D) + EPS);
#pragma unroll
            for (int j = 0; j < 4; ++j) ((f32x4*)(x + (size_t)(r0 + r) * D))[lane + 64 * j] = v[r][j] * rstd * wv[j]; }
    }
}
__device__ __forceinline__ bool fresh(Frame& F) {
    int w_ = F.w0, b_ = blockIdx.x, g_ = gridDim.x; asm volatile("" : "+s"(w_), "+s"(b_), "+s"(g_));
    int l_; asm volatile("v_mbcnt_lo_u32_b32 %0, -1, 0\n\tv_mbcnt_hi_u32_b32 %0, -1, %0" : "=v"(l_));
    int t_ = w_ * 64 + l_;
    F.tid = t_; F.lane = t_ & 63; F.wave = __builtin_amdgcn_readfirstlane(t_ >> 6); F.bid = b_; F.G = g_; return true;
}
constexpr int NPL = 13, NPHASE = 1 + DEPTH * NPL;
#if MK_PER_PHASE
#define GRID_BAR() do { } while (0)
#else
#define GRID_BAR() do { XcdBarrier b2_ = bar; asm volatile("" : "+s"(b2_.bar)); xcd_barrier(b2_); } while (0)
#endif
#ifdef ONLY_REL
#define IN(k) (KA()->ph_lo <= (k) && (k) < KA()->ph_hi && fresh(F) && ((k) == 0 ? 100 : ((k) - 1) % NPL) == ONLY_REL && (ONLY_L < 0 || ((k) - 1) / NPL == ONLY_L))
#else
#define IN(k) (KA()->ph_lo <= (k) && (k) < KA()->ph_hi && fresh(F))
#endif
#define SEAM(k) do { if ((k) + 1 < KA()->ph_hi) GRID_BAR(); } while (0)
template <int l>
__device__ __forceinline__ void layer_program(Frame& F, const XcdBarrier& bar, PG8_LAS unsigned char* ring) {
        const int pb = 1 + l * NPL;
#define WSP(off) (ka->ws + (off))
#define QSV(slot) (((const float*)WSP(WS_QS))[slot])
#define MODL ((const float*)WSP(WS_MOD) + (size_t)l * BATCH * MOD_LD)
#define WMIXL ((bf16*)WSP(WS_WMIX))
        if (IN(pb + 0)) {
#pragma unroll 1
          for (int rep = 0; rep < REPS(7); ++rep) { KArgs ka = KA(); p_norm<HQ_MIX == 0 ? 0 : (H_BF ? 2 : 1), l != 0, HQ_MIX ? HQ_MIX : 2>(F, l == 0 ? (const void*)ka->in[0] : (const void*)ka->out, ka->in[4] + l * D, MODL, 1 * D, 0, (HQ_MIX && !H_BF) ? (bf16*)WSP(WS_H8) : (bf16*)WSP(WS_H), WSP(WS_H8), sa_of(HQ_MIX, l == 0 ? CLIP_MIX0 : CLIP_MIX1)); }
          SEAM(pb + 0); }
        if (IN(pb + 1)) {
            KArgs ka = KA();
            constexpr int KD = Q_PROJ ? D / 2 : D;
            pg8::Gemm g{Q_PROJ ? (bf16*)WSP(WS_H8) : (bf16*)WSP(WS_H), WMIXL, KD, KD, KD}; pg8::StaticOrder S; S.init(M / 256, N_BCA / 256, F.G, F.bid);
            EpiP1<Q_PROJ> E{WSP(WS_P1), uni((Q_PROJ ? 1.0f / (sa_of(Q_PROJ, l == 0 ? CLIP_MIX0 : CLIP_MIX1) * (Q_PROJ == 2 ? QSV(QS_IN) : F8_SW)) : 1.0f) / (float)REPS(8) / (float)REPS(15))};
#pragma unroll 1
            for (int rep = 0; rep < REPS(3); ++rep)
            { stagger_wait(F.bid, 10); pg8::gemm_phase<REPS(8), Q_PROJ, REPS(15)>(ring, g, S, E, F.tid); } SEAM(pb + 1);
        }
        if (IN(pb + 2)) {
#define THIN_H1() { KArgs ka = KA(); p_hgrn1(F, (const bf16*)WSP(WS_P1), ka->in[8], l, (float*)WSP(WS_HU), (float*)WSP(WS_HD)); }
#define THIN_SC() { { KArgs ka = KA(); p_sgu(F, (const bf16*)WSP(WS_P1), ka->in[10] + l * D_C, ka->in[11] + (size_t)l * 4 * 128 * 128, ka->in[12] + l * 4 * 128, (bf16*)WSP(WS_YC)); } \
                    { KArgs ka = KA(); p_conv(F, (const bf16*)WSP(WS_P1), ka->in[7] + l * 3 * D_A, (bf16*)WSP(WS_YA)); } }
#pragma unroll 1
          for (int rep = 0; rep < REPS(1); ++rep) {
            __syncthreads();
            if ((F.bid >> 3) & 1) { THIN_H1(); __syncthreads(); fresh(F); THIN_SC(); }
            else { THIN_SC(); __syncthreads(); fresh(F); THIN_H1(); }
          }
#undef THIN_H1
#undef THIN_SC
            SEAM(pb + 2);
        }
        if (IN(pb + 3)) {
#pragma unroll 1
          for (int rep = 0; rep < REPS(2); ++rep)
            { KArgs ka = KA(); p_hgrn<2>(F, (const bf16*)WSP(WS_P1), ka->in[8], l, ka->in[9] + l * D_BV, (bf16*)WSP(WS_YB), (float*)WSP(WS_HU), (float*)WSP(WS_HD)); }
            SEAM(pb + 3);
        }
        if (IN(pb + 5)) {
            { KArgs ka = KA();
              pg8::GateOrder S; S.so.init(M / 256, D / 256, F.G, F.bid);
              if constexpr (Q_GATE != 0) { pg8::Gemm g{(bf16*)WSP(WS_H8), (bf16*)WSP(WS_WMIX + WMIX_G8), D / 2, D / 2, D / 2};
                  EpiGateU8<Q_GATE> E{(unsigned char*)WSP(WS_PG), uni(1.0f / (sa_of(Q_GATE, l == 0 ? CLIP_MIX0 : CLIP_MIX1) * (Q_GATE == 2 ? QSV(QS_IN) : F8_SW)))};
                  pg8::gemm_phase<1, Q_GATE>(ring, g, S, E, F.tid); }
              else { pg8::Gemm g{(bf16*)WSP(WS_H), WMIXL + (size_t)N_BCA * D, D, D, D};
                  pg8::EpiBf16<0> E{(bf16*)WSP(WS_PG), N_G, 1.0f};
                  pg8::gemm_phase(ring, g, S, E, F.tid); } }
            { KArgs ka = KA();
              constexpr int KB = Q_BR ? 256 : 512;
              pg8::Gemm g{(bf16*)WSP(WS_YA), WMIXL + (size_t)N_IN * D, KB, KB, KB, (size_t)32 * MiB, (size_t)512 * 1024 * (Q_BR ? 1 : 2)}; pg8::BranchOrder S; S.so.init(M / 256, D / 256, F.G, F.bid);
              static_assert(Q_GATE != 0 && Q_WO == 2, "the byte running sums need u8 gates and an int8 w_o GEMM");
              EpiBranch8<Q_BR> E{(const unsigned char*)WSP(WS_PG), (const float*)WSP(WS_QS) + QS_BR, WSP(WS_MRG8)};
              pg8::gemm_phase<1, Q_BR>(ring, g, S, E, F.tid); }
            SEAM(pb + 5);
        }
        if (IN(pb + 6)) {
            KArgs ka = KA();
            constexpr int KO = Q_WO ? D / 2 : D;
            pg8::Gemm g{Q_WO ? (bf16*)WSP(WS_MRG8) : (bf16*)WSP(WS_MRG), WMIXL + (size_t)N_IN * D + 3 * 512 * 1024, KO, KO, KO}; pg8::StaticOrder S; S.init(M / 256, D / 256, F.G, F.bid);
            EpiResid<l == 0, Q_WO> E{l == 0 ? (const void*)ka->in[0] : (const void*)ka->out, (bf16*)ka->out, MODL + 2 * D, Q_WO == 2 ? CLIP_MRG / 127.0f : 1.0f, Q_WO == 2 ? uni(QSV(QS_WO)) : 1.0f};
            pg8::gemm_phase<1, Q_WO>(ring, g, S, E, F.tid); SEAM(pb + 6);
        }
        if (l == 0) {
            constexpr int FES = Q_FUP ? 1 : 2, FDS = Q_FDN ? 1 : 2;
            if (IN(pb + 7)) { KArgs ka = KA(); p_norm<Q_FUP ? 1 : 0, true, Q_FUP ? Q_FUP : 2>(F, (const void*)ka->out, ka->in[5] + l * D, MODL, 4 * D, 3 * D, (bf16*)WSP(WS_H), nullptr, sa_of(Q_FUP, CLIP_FFN)); __syncthreads(); p_convert_mixer(F, KA(), 1, false);     SEAM(pb + 7); }
            if (IN(pb + 8)) {
                KArgs ka = KA();
                pg8::Gemm g{(bf16*)WSP(WS_H), (bf16*)WSP(WS_W13), D * FES / 2, D * FES / 2, D * FES / 2}; pg8::StaticOrder S; S.init(M / 256, N13 / 256, F.G, F.bid);
                EpiSwiglu<Q_FUP, Q_FDN> E{(bf16*)WSP(WS_ACT), uni(1.0f / (sa_of(Q_FUP, CLIP_FFN) * QSV(QS_F13)))};
                pg8::gemm_phase<1, Q_FUP>(ring, g, S, E, F.tid); SEAM(pb + 8);
            }
            if (IN(pb + 9)) {
                KArgs ka = KA();
                pg8::Gemm g{(bf16*)WSP(WS_ACT), (bf16*)WSP(WS_W2), D_FF * FDS / 2, D_FF * FDS / 2, D_FF * FDS / 2}; pg8::StaticOrder S; S.init(M / 256, D / 256, F.G, F.bid);
                EpiResid<false, Q_FDN> E{(const void*)ka->out, (bf16*)ka->out, MODL + 5 * D, Q_FDN == 2 ? CLIP_ACT / 127.0f : (Q_FDN ? 1.0f / (F8_SACT * F8_SW) : 1.0f), Q_FDN == 2 ? uni(QSV(QS_F2)) : 1.0f};
                pg8::gemm_phase<1, Q_FDN>(ring, g, S, E, F.tid); SEAM(pb + 9);
            }
        } else {
            if (IN(pb + 7)) {
#pragma unroll 1
                for (int rep = 0; rep < REPS(6); ++rep) { __syncthreads(); p_moe_weights(F, KA()); }
                __syncthreads(); { KArgs ka = KA(); p_norm_router(F, ka, (const void*)ka->out, ka->in[5] + l * D, MODL, (bf16*)WSP(WS_H2M)); } SEAM(pb + 7); }
            constexpr size_t ACT_BYTES = (size_t)MOE_ROWS * D_FF * MOE_ES;
#define MOE_UP(pass_, T_, HC_, pm0_, npan_) do { KArgs ka = KA(); \
                    const LAS int* tab = (const LAS int*)(F.lds + TAB_OFF) + (pass_) * 256; \
                    MoeOrder<true> S; S.so.init((npan_), N13 / 256, F.G, F.bid); S.pm0 = (pm0_); S.tab = tab; S.list = (const int*)WSP(WS_LIST) + (size_t)(pass_) * 8 * LIST_CAP; S.npn = N13 / 256; S.rowbytes = D * MOE_ES; S.T = (T_); S.HC = (HC_); \
                    pg8::Gemm g{(bf16*)WSP(WS_H2M), (bf16*)WSP(WS_WM13), D * MOE_ES / 2, D * MOE_ES / 2, D * MOE_ES / 2}; \
                    EpiSwiglu<Q_MUP, Q_MDN> E{(bf16*)WSP(WS_ACTM + (pass_) * ACT_BYTES), uni(1.0f / (sa_of(Q_MUP, CLIP_MOE) * QSV(QS_M13)))}; \
                    pg8::gemm_phase<1, Q_MUP>(ring, g, S, E, F.tid); } while (0)
#define MOE_DOWN(pass_, pm0_, npan_, y1m_, T_, HC_) do { KArgs ka = KA(); \
                    const LAS int* tab = (const LAS int*)(F.lds + TAB_OFF) + (pass_) * 256; \
                    MoeOrder<false> S; S.so.init((npan_), D / 256, F.G, F.bid); S.pm0 = (pm0_); S.T = (T_); S.HC = (HC_); S.tab = tab; S.list = (const int*)WSP(WS_LIST) + (size_t)(pass_) * 8 * LIST_CAP; S.npn = D / 256; S.rowbytes = 0; \
                    pg8::Gemm g{(bf16*)WSP(WS_ACTM + (pass_) * ACT_BYTES), (bf16*)WSP(WS_WM2), D_FF * MOE_ES / 2, D_FF * MOE_ES / 2, D_FF * MOE_ES / 2}; \
                    EpiMoeDown E{(bf16*)ka->out, MODL + 5 * D, (const float*)WSP(WS_TOPP), (pass_), tab, S.list, Q_MDN == 2 ? uni(CLIP_ACT / (127.0f * QSV(QS_M2))) : 1.0f / (F8_SACT * F8_SW), (bf16*)WSP(WS_Y1), (unsigned char*)WSP(WS_CTL + CTL_FLAG), (y1m_)}; \
                    pg8::gemm_phase<1, Q_MDN>(ring, g, S, E, F.tid); } while (0)
#define MOE_NP(pass_) (((const LAS int*)(F.lds + TAB_OFF))[(pass_) * 256 + 16])
            if (IN(pb + 8)) { { KArgs ka = KA(); moe_tables(F, (unsigned*)WSP(WS_CTL), 0); moe_tables(F, (unsigned*)WSP(WS_CTL), 1); }
                MOE_UP(0, 0, 0, 0, MOE_NP(0));
                { const int nx = MOE_NP(1) > MOE_XP ? MOE_NP(1) - MOE_XP : 0, nu0 = MOE_NP(0) * (N13 / 256);
                  MOE_UP(1, nu0 % F.G, 1, MOE_XP, nx); }
                SEAM(pb + 8); }
            if (IN(pb + 9)) {
                { KArgs ka = KA(); moe_tables(F, (unsigned*)WSP(WS_CTL), 0); moe_tables(F, (unsigned*)WSP(WS_CTL), 1); }
                MOE_DOWN(0, 0, MOE_NP(0), 0, 0, 0);
                { const int nx = MOE_NP(1) > MOE_XP ? MOE_NP(1) - MOE_XP : 0, nd0 = MOE_NP(0) * (D / 256);
                  MOE_DOWN(1, MOE_XP, nx, 1, nd0 % F.G, 1);
                  const int ndt = nd0 + nx * (D / 256);
                  MOE_UP(1, ndt % F.G, 3, 0, MOE_NP(1) < MOE_XP ? MOE_NP(1) : MOE_XP); }
                SEAM(pb + 9);
            }
            if (IN(pb + 11)) { { KArgs ka = KA(); moe_tables(F, (unsigned*)WSP(WS_CTL), 1); } MOE_DOWN(1, 0, MOE_NP(1) < MOE_XP ? MOE_NP(1) : MOE_XP, 0, 0, 0); SEAM(pb + 11); }
#undef MOE_NP
#undef MOE_UP
#undef MOE_DOWN
            if (IN(pb + 12)) { KArgs ka = KA(); p_final_norm(F, ka->out, ka->in[25], (const bf16*)WSP(WS_Y1), (const unsigned char*)WSP(WS_CTL + CTL_FLAG)); }
        }
}
__global__ void __launch_bounds__(NT, 2) fwd(Args args) {
    extern __shared__ __attribute__((aligned(16))) unsigned char lds[];
    Frame F;
    F.lds = (LAS unsigned char*)lds;
    F.tid = threadIdx.x; F.lane = F.tid & 63; F.wave = __builtin_amdgcn_readfirstlane(F.tid >> 6); F.w0 = F.wave;
    F.G = gridDim.x; F.bid = blockIdx.x;
    volatile LAS unsigned* MISC = (volatile LAS unsigned*)(F.lds + MISC_OFF);
    if (F.tid < 32) MISC[F.tid] = 0u;
    __syncthreads();
#if !MK_PER_PHASE
    XcdBarrier bar = xcd_barrier_post((unsigned*)(KA()->ws + WS_CTL) + CW_BAR, MISC + 8);
#else
    XcdBarrier bar; bar.bar = nullptr; bar.x = 0; bar.st = nullptr;
#endif
    PG8_LAS unsigned char* ring = (PG8_LAS unsigned char*)lds;

    if (IN(0)) {
#pragma unroll 1
        for (int rep = 0; rep < REPS(5); ++rep) { __syncthreads(); p_prologue(F, KA()); __syncthreads(); p_convert_mixer(F, KA(), 0, true); }
        SEAM(0); }

    layer_program<0>(F, bar, ring);
    layer_program<1>(F, bar, ring);
#undef IN
#undef SEAM
}

extern "C" void kernel_launch(void* const* d_in, const int* in_sizes, int n_in, void* d_out, int out_size, void* d_ws, size_t ws_size, hipStream_t stream) {
    static int grid = 0;
    if (grid == 0) {
        if (n_in != 26 || in_sizes[0] != M * D || out_size != M * D || ws_size < WS_NEED) { fprintf(stderr, "kernel_launch: unexpected shapes / workspace (n_in %d, ws %zu, need %zu); nothing launched\n", n_in, ws_size, (size_t)WS_NEED); grid = -1; return; }
        int dev = 0, cus = 0, per_cu = 0;
        if (hipGetDevice(&dev) != hipSuccess || hipDeviceGetAttribute(&cus, hipDeviceAttributeMultiprocessorCount, dev) != hipSuccess) { grid = -1; return; }
        if (hipFuncSetAttribute((const void*)fwd, hipFuncAttributeMaxDynamicSharedMemorySize, LDS_BYTES) != hipSuccess) { fprintf(stderr, "kernel_launch: hipFuncSetAttribute failed\n"); grid = -1; return; }
        if (hipOccupancyMaxActiveBlocksPerMultiprocessor(&per_cu, (const void*)fwd, NT, LDS_BYTES) != hipSuccess || per_cu < 1) fprintf(stderr, "kernel_launch: occupancy query reports %d\n", per_cu);
        (void)hipGetLastError();
        grid = cus;
    }
    if (grid < 0) return;
    if (hipMemsetAsync((char*)d_ws + WS_CTL, 0, CTL_ZERO_BYTES, stream) != hipSuccess) return;
    Args a{};
    for (int i = 0; i < 26; ++i) a.in[i] = (const float*)d_in[i];
    a.out = (float*)d_out; a.ws = (unsigned char*)d_ws;
#if MK_PER_PHASE
    for (int p = 0; p < NPHASE; ++p) {
        if ((p >= 1 + 10 && p <= 1 + 12) || p == 1 + 4 || p == 1 + NPL + 4 || p == 1 + NPL + 10) continue;
        a.ph_lo = p; a.ph_hi = p + 1;
        hipLaunchKernelGGL(fwd, dim3(grid), dim3(NT), LDS_BYTES, stream, a);
    }
#else
    a.ph_lo = 0; a.ph_hi = NPHASE;
    hipLaunchKernelGGL(fwd, dim3(grid), dim3(NT), LDS_BYTES, stream, a);
#endif
}
```

```cpp
#include <hip/hip_runtime.h>
#include <cstdio>
#include <cstdint>

#ifndef PROBE_DUP
#define PROBE_DUP 0
#endif
#ifndef PROBE_REPS
#define PROBE_REPS 2
#endif
#define REPS(k) ((PROBE_DUP == (k)) ? PROBE_REPS : 1)
#ifndef Q_PROJ
#define Q_PROJ 2
#endif
#ifndef Q_GATE
#define Q_GATE 2
#endif
#ifndef Q_FUP
#define Q_FUP 2
#endif
#ifndef Q_FDN
#define Q_FDN 2
#endif
#ifndef Q_MUP
#define Q_MUP 2
#endif
#ifndef Q_MDN
#define Q_MDN 2
#endif
#ifndef Q_BR
#define Q_BR 2
#endif
#ifndef Q_WO
#define Q_WO 2
#endif
#ifndef MK_PER_PHASE
#define MK_PER_PHASE 0
#endif

namespace pg8 {
#define PG8_LAS __attribute__((address_space(3)))
typedef unsigned short bf16_t;
typedef short bf16x8 __attribute__((ext_vector_type(8)));
typedef float f32x4 __attribute__((ext_vector_type(4)));
typedef unsigned u32x4 __attribute__((ext_vector_type(4)));
typedef int v4i32_ __attribute__((ext_vector_type(4)));
constexpr int BM = 256, BK = 64, HALF = 128, HTB = HALF * BK * 2, STAGE_BYTES = 8 * HTB, NXCD = 8, WGM = 8;

__host__ __device__ __forceinline__ int lds_byte(int r, int c) { const int st = (r >> 4) * 2 + (c >> 5), rr = r & 15, cc = c & 31, ob = rr * 64 + cc * 2; return st * 1024 + (ob ^ (((ob >> 9) & 1) << 5)); }
__host__ __device__ __forceinline__ void stage_rc(int b, int& R, int& C) { const int st = b / 1024, sb = b % 1024, swz = sb ^ (((sb >> 9) & 1) << 5); R = (st >> 1) * 16 + swz / 64; C = (st & 1) * 32 + (swz % 64) / 2; }
__host__ __device__ __forceinline__ int perm32(int rho) { const int n = rho >> 4, i = rho & 15; return 8 * (i >> 2) + 4 * n + (i & 3); }

struct Unit { int pm, pn, pb, aux; };
struct Gemm { const bf16_t* A; const bf16_t* Bt; int lda, ldb, K; size_t astride = 0, bstride = 0; };

struct StaticOrder {
    static constexpr bool GATHER = false;
    int nM, nN, nwg, G, c;
    __device__ __forceinline__ void init(int nM_, int nN_, int G_, int c_) { nM = nM_; nN = nN_; nwg = nM * nN; G = G_; c = c_; }
    __device__ __forceinline__ bool next(int i, Unit& u) const { return unit_of((long)i * G + c, u); }
    __device__ __forceinline__ bool unit_of(long L, Unit& u) const {
        if (L >= nwg) return false;
        int wgid = (int)L; { const int q = nwg / NXCD, r = nwg % NXCD, xcd = wgid % NXCD, off = wgid / NXCD; wgid = (xcd < r ? xcd * (q + 1) : r * (q + 1) + (xcd - r) * q) + off; }
        const int nig = WGM * nN, gid = wgid / nig, fm = gid * WGM, gsz = (nM - fm) < WGM ? (nM - fm) : WGM;
        u.pm = fm + ((wgid % nig) % gsz); u.pn = (wgid % nig) / gsz; u.pb = u.pn; u.aux = 0; return true;
    }
    __device__ __forceinline__ unsigned a_row_off(const Unit&, int) const { return 0u; }
};

struct GateOrder {
    static constexpr bool GATHER = false;
    StaticOrder so;
    __device__ __forceinline__ bool next(int k, Unit& u) const { Unit b; if (!so.next(k / 3, b)) return false; u.pm = b.pm; u.pn = b.pn + 4 * (k % 3); u.pb = u.pn; u.aux = 0; return true; }
    __device__ __forceinline__ unsigned a_row_off(const Unit&, int) const { return 0u; }
};
struct BranchOrder {
    static constexpr bool GATHER = false;
    StaticOrder so;
    __device__ __forceinline__ bool next(int k, Unit& u) const { Unit b; if (!so.next(k / 3, b)) return false; u.pm = b.pm; u.pn = b.pn; u.pb = b.pn; u.aux = (k % 3 + 1) % 3; return true; }
    __device__ __forceinline__ unsigned a_row_off(const Unit&, int) const { return 0u; }
};
__device__ __forceinline__ unsigned cvt_pk_bf16(float lo, float hi) { unsigned r; asm volatile("v_cvt_pk_bf16_f32 %0, %1, %2" : "=v"(r) : "v"(lo), "v"(hi)); return r; }

template <int Q = 0>
struct EpiBf16 {
    static constexpr bool PERM = true;
    bf16_t* O; int ldc; float scale;
    __device__ __forceinline__ void operator()(const f32x4 (&acc)[2][2][4][2], const Unit& u, int wr, int wc, int fr, int fq) const {
        const int row0 = u.pm * BM + wr * 64 + fr, col0 = u.pn * BM + wc * 32 + 8 * fq;
#pragma unroll 1
        for (int erep = 0; erep < REPS(9); ++erep)
#pragma unroll
        for (int ai = 0; ai < 2; ++ai)
#pragma unroll
            for (int m = 0; m < 4; ++m) { bf16_t* rowp = O + (size_t)(row0 + ai * HALF + m * 16) * ldc + col0;
#pragma unroll
                for (int bj = 0; bj < 2; ++bj) { f32x4 v0 = acc[ai][bj][m][0], v1 = acc[ai][bj][m][1];
                    if constexpr (Q == 2) { v0 = __builtin_convertvector(__builtin_bit_cast(v4i32_, v0), f32x4); v1 = __builtin_convertvector(__builtin_bit_cast(v4i32_, v1), f32x4); }
                    v0 *= scale; v1 *= scale;
                    u32x4 w; w.x = cvt_pk_bf16(v0[0], v0[1]); w.y = cvt_pk_bf16(v0[2], v0[3]); w.z = cvt_pk_bf16(v1[0], v1[1]); w.w = cvt_pk_bf16(v1[2], v1[3]);
                    *(u32x4*)(rowp + bj * HALF) = w; } }
    }
};

typedef int v8i32 __attribute__((ext_vector_type(8)));
typedef int v4i32 __attribute__((ext_vector_type(4)));
template <int KREP = 1, int Q = 0, int MREP = 1, class Epi, class Sched>
__device__ __forceinline__ void gemm_phase(PG8_LAS unsigned char* lds, const Gemm g, const Sched& S, const Epi& E, int tid_in) {
    constexpr bool GATHER = Sched::GATHER;
    int tid_ = tid_in; asm volatile("" : "+v"(tid_));
    const int tid = tid_, wid = __builtin_amdgcn_readfirstlane(tid >> 6), lane = tid & 63, wr = wid >> 2, wc = wid & 3, fr = lane & 15, fq = lane >> 4;
    const int K = g.K, nt = K / BK;
    unsigned voffB[2], vA0[2], vA1[2], nA0[2], nA1[2];
#pragma unroll
    for (int i = 0; i < 2; ++i) { int R, C; stage_rc(tid * 16 + i * 8192, R, C); const int Rb = Epi::PERM ? ((R & ~31) + perm32(R & 31)) : R;
        voffB[i] = (unsigned)(Rb * g.ldb + C) * 2u;
        vA0[i] = (unsigned)(R * g.lda + C) * 2u; vA1[i] = vA0[i]; nA0[i] = vA0[i]; nA1[i] = vA0[i]; }
    const size_t kstep = (size_t)(BK * 2);
    const size_t hstepB = (size_t)HALF * g.ldb * 2, tstepB = 2 * hstepB, tstepA = (size_t)BM * g.lda * 2;
    const size_t hstepA = GATHER ? (size_t)0 : (size_t)HALF * g.lda * 2;
    const unsigned ldsw = (unsigned)wid * 1024u;
    const int aoff = lds_byte(wr * 64 + fr, fq * 8), boff = lds_byte(wc * 32 + fr, fq * 8);
    PG8_LAS unsigned char* aptr = lds + aoff; PG8_LAS unsigned char* bptr = lds + 4 * HTB + boff; asm volatile("" : "+v"(aptr), "+v"(bptr));
#define PG8_SA(b, h) (((b) * 2 + (h)) * HTB)
#define PG8_SB(b, h) ((4 + (b) * 2 + (h)) * HTB)
#define PG8_STAGE(bufoff, gbase, voff) do { _Pragma("unroll") for (int _i = 0; _i < 2; ++_i) \
        __builtin_amdgcn_global_load_lds((const unsigned*)((const char*)(gbase) + (voff)[_i]), (PG8_LAS unsigned*)(lds + (bufoff) + ldsw + _i * 8192), 16, 0, 0); } while (0)
#define PG8_CAT8(x0, x1) __builtin_shufflevector(__builtin_bit_cast(v4i32, x0), __builtin_bit_cast(v4i32, x1), 0, 1, 2, 3, 4, 5, 6, 7)
#define PG8_RDA(off) (*(const PG8_LAS bf16x8*)(aptr + (off)))
#define PG8_RDB(off) (*(const PG8_LAS bf16x8*)(bptr + (off)))
#define PG8_LDA(dst, b, h) do { if constexpr (Q == 1) { _Pragma("unroll") for (int m = 0; m < 4; ++m) dst##8[m] = PG8_CAT8(PG8_RDA(PG8_SA(b, h) + m * 2048), PG8_RDA(PG8_SA(b, h) + m * 2048 + 1024)); } \
        else { _Pragma("unroll") for (int m = 0; m < 4; ++m) _Pragma("unroll") for (int k = 0; k < 2; ++k) dst[m][k] = PG8_RDA(PG8_SA(b, h) + m * 2048 + k * 1024); } } while (0)
#define PG8_LDB(dst, b, h) do { if constexpr (Q == 1) { _Pragma("unroll") for (int n = 0; n < 2; ++n) dst##8[n] = PG8_CAT8(PG8_RDB(PG8_SB(b, h) - 4 * HTB + n * 2048), PG8_RDB(PG8_SB(b, h) - 4 * HTB + n * 2048 + 1024)); } \
        else { _Pragma("unroll") for (int n = 0; n < 2; ++n) _Pragma("unroll") for (int k = 0; k < 2; ++k) dst[n][k] = PG8_RDB(PG8_SB(b, h) - 4 * HTB + n * 2048 + k * 1024); } } while (0)
#define PG8_MMA(ai, bj, At, Bt) do { __builtin_amdgcn_s_setprio(1); _Pragma("unroll") for (int r_ = 0; r_ < MREP; ++r_) { \
        if constexpr (Q == 2) { _Pragma("unroll") for (int m = 0; m < 4; ++m) _Pragma("unroll") for (int n = 0; n < 2; ++n) _Pragma("unroll") for (int k = 0; k < 2; ++k) \
            acc[ai][bj][m][n] = __builtin_bit_cast(f32x4, __builtin_amdgcn_mfma_i32_16x16x64_i8(__builtin_bit_cast(v4i32, Bt[n][k]), __builtin_bit_cast(v4i32, At[m][k]), __builtin_bit_cast(v4i32, acc[ai][bj][m][n]), 0, 0, 0)); } \
        else if constexpr (Q == 1) { _Pragma("unroll") for (int m = 0; m < 4; ++m) _Pragma("unroll") for (int n = 0; n < 2; ++n) \
            asm volatile("v_mfma_scale_f32_16x16x128_f8f6f4 %0, %1, %2, %0, %3, %3 op_sel_hi:[0,0,0]" : "+v"(acc[ai][bj][m][n]) : "v"(Bt##8[n]), "v"(At##8[m]), "v"(sc1)); } \
        else { _Pragma("unroll") for (int m = 0; m < 4; ++m) _Pragma("unroll") for (int n = 0; n < 2; ++n) _Pragma("unroll") for (int k = 0; k < 2; ++k) \
            acc[ai][bj][m][n] = __builtin_amdgcn_mfma_f32_16x16x32_bf16(Bt[n][k], At[m][k], acc[ai][bj][m][n], 0, 0, 0); } } \
        __builtin_amdgcn_s_setprio(0); } while (0)
#define PG8_WAIT_V(n) asm volatile("s_waitcnt vmcnt(" #n ")" ::: "memory")
#define PG8_WAIT_L(n) asm volatile("s_waitcnt lgkmcnt(" #n ")" ::: "memory")
#define PG8_BAR __builtin_amdgcn_s_barrier()
#define PG8_SCHED __builtin_amdgcn_sched_barrier(0)
#define PG8_GOFF(unit, d0, d1) do { _Pragma("unroll") for (int _i = 0; _i < 2; ++_i) { int R_, C_; stage_rc(tid * 16 + _i * 8192, R_, C_); \
        d0[_i] = S.a_row_off(unit, R_) + (unsigned)C_ * 2u; d1[_i] = S.a_row_off(unit, R_ + HALF) + (unsigned)C_ * 2u; } } while (0)
    Unit cur, nxt; int ui = 0;
    if (!S.next(0, cur)) return;
    f32x4 acc[2][2][4][2];
#pragma unroll
    for (int a = 0; a < 2; ++a)
#pragma unroll
        for (int b = 0; b < 2; ++b)
#pragma unroll
            for (int m = 0; m < 4; ++m)
#pragma unroll
                for (int n = 0; n < 2; ++n) acc[a][b][m][n] = (f32x4){0.f, 0.f, 0.f, 0.f};
    bf16x8 At[4][2], B0[2][2], B1[2][2];
    v8i32 At8[4], B08[2], B18[2];
    const int sc1 = 0x7f7f7f7f;
    if constexpr (GATHER) { PG8_GOFF(cur, vA0, vA1); }
    const char* cA = GATHER ? (const char*)g.A : (const char*)g.A + (size_t)cur.aux * g.astride + (size_t)cur.pm * tstepA; const char* cB = (const char*)g.Bt + (size_t)cur.aux * g.bstride + (size_t)cur.pb * tstepB;
    PG8_STAGE(PG8_SB(0, 0), cB, voffB); PG8_STAGE(PG8_SB(0, 1), cB + hstepB, voffB); PG8_STAGE(PG8_SA(0, 0), cA, vA0); PG8_STAGE(PG8_SA(0, 1), cA + hstepA, vA1);
    if (wr == 1) PG8_BAR;
    PG8_WAIT_V(2); PG8_BAR;
    PG8_STAGE(PG8_SB(1, 0), cB + kstep, voffB); PG8_STAGE(PG8_SA(1, 0), cA + kstep, vA0); PG8_STAGE(PG8_SB(1, 1), cB + hstepB + kstep, voffB);
    PG8_WAIT_V(6); PG8_BAR;
    for (;;) {
        const bool has_next = S.next(ui + 1, nxt);
        const char* nA = GATHER ? (const char*)g.A : (has_next ? (const char*)g.A + (size_t)nxt.aux * g.astride + (size_t)nxt.pm * tstepA : cA); const char* nB = has_next ? (const char*)g.Bt + (size_t)nxt.aux * g.bstride + (size_t)nxt.pb * tstepB : cB;
        if constexpr (GATHER) { if (has_next) { PG8_GOFF(nxt, nA0, nA1); } else {
#pragma unroll
            for (int i = 0; i < 2; ++i) { nA0[i] = vA0[i]; nA1[i] = vA1[i]; } } }
#pragma unroll 1
        for (int t = 0; t < nt * KREP; t += 2) {
            const bool last = (t == nt * KREP - 2);
            const int t1 = (KREP == 1) ? t + 1 : ((t + 1) & (nt - 1)), t2 = (KREP == 1) ? t + 2 : ((t + 2) & (nt - 1));
            const char* a1 = cA + (size_t)t1 * kstep;
            const char* a2 = last ? nA : cA + (size_t)t2 * kstep; const char* b2 = last ? nB : cB + (size_t)t2 * kstep;
            const char* a3 = a2 + kstep; const char* b3 = b2 + kstep;
            unsigned s0[2], s1[2];
#pragma unroll
            for (int i = 0; i < 2; ++i) { s0[i] = (GATHER && last) ? nA0[i] : vA0[i]; s1[i] = GATHER ? (last ? nA1[i] : vA1[i]) : vA0[i]; }
            PG8_LDB(B0, 0, 0); PG8_LDB(B1, 0, 1); PG8_SCHED; PG8_LDA(At, 0, 0); PG8_STAGE(PG8_SA(1, 1), a1 + hstepA, vA1);
            PG8_WAIT_V(8); PG8_WAIT_L(0); PG8_BAR; PG8_MMA(0, 0, At, B0); PG8_MMA(0, 1, At, B1); PG8_BAR; PG8_SCHED;
            PG8_LDA(At, 0, 1); PG8_STAGE(PG8_SB(0, 0), b2, voffB); PG8_STAGE(PG8_SB(0, 1), b2 + hstepB, voffB); PG8_STAGE(PG8_SA(0, 0), a2, s0);
            PG8_WAIT_V(8); PG8_WAIT_L(0); PG8_BAR; PG8_MMA(1, 0, At, B0); PG8_MMA(1, 1, At, B1); PG8_BAR; PG8_SCHED;
            PG8_LDB(B0, 1, 0); PG8_LDB(B1, 1, 1); PG8_SCHED; PG8_LDA(At, 1, 0); PG8_STAGE(PG8_SA(0, 1), a2 + hstepA, s1);
            PG8_WAIT_V(8); PG8_WAIT_L(0); PG8_BAR; PG8_MMA(0, 0, At, B0); PG8_MMA(0, 1, At, B1); PG8_BAR; PG8_SCHED;
            PG8_LDA(At, 1, 1); PG8_STAGE(PG8_SB(1, 0), b3, voffB); PG8_STAGE(PG8_SB(1, 1), b3 + hstepB, voffB); PG8_STAGE(PG8_SA(1, 0), a3, s0);
            PG8_WAIT_V(8); PG8_WAIT_L(0); PG8_BAR; PG8_MMA(1, 0, At, B0); PG8_MMA(1, 1, At, B1); PG8_BAR; PG8_SCHED;
        }
        if (wr == 0) PG8_BAR;
        E(acc, cur, wr, wc, fr, fq);
        if (!has_next) break;
#pragma unroll
        for (int a = 0; a < 2; ++a)
#pragma unroll
            for (int b = 0; b < 2; ++b)
#pragma unroll
                for (int m = 0; m < 4; ++m)
#pragma unroll
                    for (int n = 0; n < 2; ++n) acc[a][b][m][n] = (f32x4){0.f, 0.f, 0.f, 0.f};
        cur = nxt; cA = nA; cB = nB; ++ui;
        if constexpr (GATHER) {
#pragma unroll
            for (int i = 0; i < 2; ++i) { vA0[i] = nA0[i]; vA1[i] = nA1[i]; } }
        if (wr == 1) PG8_BAR;
    }
    PG8_WAIT_V(0);
    PG8_BAR;
#undef PG8_SA
#undef PG8_SB
#undef PG8_STAGE
#undef PG8_LDA
#undef PG8_LDB
#undef PG8_MMA
#undef PG8_WAIT_V
#undef PG8_WAIT_L
#undef PG8_BAR
#undef PG8_SCHED
#undef PG8_GOFF
#undef PG8_CAT8
#undef PG8_RDA
#undef PG8_RDB
}
}

constexpr int D = 1024, BATCH = 8, SEQ = 4096, M = BATCH * SEQ, DEPTH = 2;
constexpr int D_A = 512, D_BK = 512, D_BV = 512, D_C = 512, H_B = 4;
constexpr int N_IN = 7680, N_BCA = 4608, N_G = 3072;
constexpr int P1_PITCH = 1536 + 4096 + 1024, P1_OB = 1536, P1_OC = 5632, P1E = P1_PITCH / 2;
#ifndef CLIP_P1
#define CLIP_P1 5.5f
#endif
constexpr int D_FF = 2816, NE = 8, N13 = 2 * D_FF;
constexpr int MOD_LD = 6 * D;
constexpr float EPS = 1e-6f;
constexpr int XLD = 2 * D;
constexpr int LIST_CAP = M;
constexpr int MOE_ROWS = M + NE * 256;

constexpr size_t MiB = 1u << 20;
constexpr size_t WS_CTL = 0, CTL_ZERO_BYTES = 1 * MiB;
constexpr size_t WS_MOD = 1 * MiB;
constexpr size_t WS_TOPP = 2 * MiB;
constexpr size_t WS_QS = 2 * MiB + 768 * 1024;
constexpr size_t WS_LIST = 3 * MiB;
constexpr size_t WS_WMIX = 6 * MiB;
constexpr size_t WMIX_G8 = 9 * MiB;
constexpr size_t WS_W13 = 26 * MiB, WS_W2 = 37 * MiB;
constexpr size_t WS_BIG = 44 * MiB;
constexpr size_t WS_H = WS_BIG;
constexpr size_t WS_P1 = WS_BIG + 64 * MiB;
constexpr size_t WS_PG = WS_P1;
constexpr size_t WS_MRG = WS_P1 + 192 * MiB;
constexpr size_t WS_MRG8 = WS_P1 + 256 * MiB;
constexpr size_t WS_YA = WS_P1 + 288 * MiB, WS_YB = WS_YA + 32 * MiB, WS_YC = WS_YB + 32 * MiB;
constexpr size_t WS_ACT = WS_P1;
constexpr size_t WS_HU = WS_YC + 32 * MiB;
constexpr size_t WS_HD = WS_HU + 16 * MiB;
constexpr size_t WS_H8 = WS_HD + 1 * MiB;
constexpr size_t WS_MIX_END = WS_H8 + 32 * MiB;
static_assert((Q_PROJ == 0 || Q_GATE == 0 || Q_PROJ == Q_GATE) && Q_MDN != 0 && Q_MUP != 0, "supported operand encodings");
constexpr int HQ_MIX = Q_PROJ ? Q_PROJ : Q_GATE;
constexpr bool H_BF = (Q_PROJ == 0 || Q_GATE == 0);
constexpr float F8_SW = 64.0f, F8_SACT = 8.0f, W_CLIP = 4.0f;
#ifndef CLIP_MIX0
#define CLIP_MIX0 5.5f
#endif
#ifndef CLIP_MIX1
#define CLIP_MIX1 5.5f
#endif
#ifndef CLIP_FFN
#define CLIP_FFN 5.5f
#endif
#ifndef CLIP_MOE
#define CLIP_MOE 5.5f
#endif
#ifndef CLIP_YA
#define CLIP_YA 14.0f
#endif
#ifndef CLIP_YB
#define CLIP_YB 5.5f
#endif
#ifndef CLIP_YC
#define CLIP_YC 10.0f
#endif
#ifndef CLIP_ACT
#define CLIP_ACT 7.0f
#endif
#ifndef CLIP_MRG
#define CLIP_MRG 9.0f
#endif
__host__ __device__ constexpr float sa_of(int q, float clip) { return q == 2 ? 127.0f / clip : 4.0f; }
enum { QS_IN = 0, QS_F13 = 1, QS_F2 = 2, QS_M13 = 3, QS_BR = 4  , QS_WO = 7, QS_M2 = 8, QS_N = 16 };
constexpr int MOE_ES = 1;
constexpr size_t WS_WM13 = 6 * MiB;
constexpr size_t WS_WM2 = WS_WM13 + 88 * MiB;
constexpr size_t WS_H2M = WS_WM2 + 44 * MiB;
constexpr size_t WS_ACTM = WS_H2M + 64 * MiB;
constexpr size_t WS_MOE_END = WS_ACTM + 2 * (size_t)MOE_ROWS * D_FF * MOE_ES;
constexpr size_t WS_Y1 = WS_MOE_END;
constexpr size_t WS_NEED = WS_MIX_END > WS_Y1 + (size_t)M * D * 2 ? WS_MIX_END : WS_Y1 + (size_t)M * D * 2;
constexpr size_t CTL_FLAG = 512 * 1024;
constexpr int MOE_XP = 128;
static_assert(WS_W2 + (size_t)D * D_FF * 2 <= WS_BIG && WS_WMIX + 20 * MiB <= WS_W13, "ws map");
constexpr int CW_BAR = 4096;
constexpr int CW_CNT = 16384;

constexpr int LDS_BYTES = 147456;
constexpr int SCR_BYTES = 139264;
constexpr int TAB_OFF = SCR_BYTES;
constexpr int MISC_OFF = TAB_OFF + 4096;
static_assert(MISC_OFF + 128 <= LDS_BYTES, "LDS map");
constexpr int NWAVES = 8, NT = 512;

#define GAS __attribute__((address_space(1)))
#define LAS __attribute__((address_space(3)))
typedef unsigned short bf16;
typedef unsigned v4u __attribute__((ext_vector_type(4)));
typedef float f32x4 __attribute__((ext_vector_type(4)));
#define LDS_WAIT() asm volatile("s_waitcnt lgkmcnt(0)" ::: "memory")
#define LDS_BARRIER() asm volatile("s_waitcnt lgkmcnt(0)\n\ts_barrier" ::: "memory")

typedef float f32x2_t __attribute__((ext_vector_type(2)));
typedef __bf16 bf16x2_t __attribute__((ext_vector_type(2)));
__device__ __forceinline__ unsigned pk2(float lo, float hi) { f32x2_t v = {lo, hi}; bf16x2_t b = __builtin_convertvector(v, bf16x2_t); return __builtin_bit_cast(unsigned, b); }
__device__ __forceinline__ float bf_lo(unsigned u) { return __uint_as_float(u << 16); }
__device__ __forceinline__ float bf_hi(unsigned u) { return __uint_as_float(u & 0xffff0000u); }
__device__ __forceinline__ void unpack8(const v4u w, float (&f)[8]) { f[0] = bf_lo(w.x); f[1] = bf_hi(w.x); f[2] = bf_lo(w.y); f[3] = bf_hi(w.y); f[4] = bf_lo(w.z); f[5] = bf_hi(w.z); f[6] = bf_lo(w.w); f[7] = bf_hi(w.w); }
typedef unsigned v2u_p1 __attribute__((ext_vector_type(2)));
__device__ __forceinline__ void decode8u(const v2u_p1 w, float (&f)[8]) {
    constexpr float a = CLIP_P1 / 127.0f, b = -128.0f * CLIP_P1 / 127.0f;
#pragma unroll
    for (int i = 0; i < 4; ++i) { f[i] = (float)((w.x >> (8 * i)) & 0xffu) * a + b; f[4 + i] = (float)((w.y >> (8 * i)) & 0xffu) * a + b; }
}
__device__ __forceinline__ v4u pack8(const float (&f)[8]) { v4u w; w.x = pk2(f[0], f[1]); w.y = pk2(f[2], f[3]); w.z = pk2(f[4], f[5]); w.w = pk2(f[6], f[7]); return w; }
__device__ __forceinline__ float sigmoidf_(float x) { return __builtin_amdgcn_rcpf(1.0f + __expf(-x)); }
__device__ __forceinline__ float siluf_(float x) { return x * sigmoidf_(x); }
__device__ __forceinline__ float uni(float v) { return __int_as_float(__builtin_amdgcn_readfirstlane(__float_as_int(v))); }
template <int Q> __device__ __forceinline__ float accf(float v) { return (Q == 2) ? (float)__float_as_int(v) : v; }
__device__ __forceinline__ float clamp_f8(float x) { return fminf(fmaxf(x, -448.0f), 448.0f); }
__device__ __forceinline__ unsigned q1_i8(float x) { return (unsigned)(int)rintf(fminf(fmaxf(x, -127.0f), 127.0f)) & 0xffu; }
template <int Q> __device__ __forceinline__ unsigned pk4_q(float a, float b, float c, float d) {
    if constexpr (Q == 2) {
        constexpr float MG = 12582912.0f;
        const unsigned ua = __float_as_uint(__builtin_amdgcn_fmed3f(a + MG, MG - 127.0f, MG + 127.0f)), ub = __float_as_uint(__builtin_amdgcn_fmed3f(b + MG, MG - 127.0f, MG + 127.0f));
        const unsigned uc = __float_as_uint(__builtin_amdgcn_fmed3f(c + MG, MG - 127.0f, MG + 127.0f)), ud = __float_as_uint(__builtin_amdgcn_fmed3f(d + MG, MG - 127.0f, MG + 127.0f));
        return __builtin_amdgcn_perm(__builtin_amdgcn_perm(ud, uc, 0x0c0c0400u), __builtin_amdgcn_perm(ub, ua, 0x0c0c0400u), 0x05040100u); }
    else { int v = 0; v = __builtin_amdgcn_cvt_pk_fp8_f32(clamp_f8(a), clamp_f8(b), v, false); v = __builtin_amdgcn_cvt_pk_fp8_f32(clamp_f8(c), clamp_f8(d), v, true); return (unsigned)v; } }
__device__ __forceinline__ float shx(float v, int mask, int lane) { return __int_as_float(__builtin_amdgcn_ds_bpermute((lane ^ mask) << 2, __float_as_int(v))); }
__device__ __forceinline__ float shl(float v, int src) { return __int_as_float(__builtin_amdgcn_ds_bpermute(src << 2, __float_as_int(v))); }
__device__ __forceinline__ float wave_sum(float v, int lane) {
#pragma unroll
    for (int o = 1; o < 64; o <<= 1) v += shx(v, o, lane);
    return v;
}

template <int CTRL> __device__ __forceinline__ float dppx(float x) { return __builtin_bit_cast(float, __builtin_amdgcn_mov_dpp(__builtin_bit_cast(int, x), CTRL, 0xf, 0xf, true)); }
__device__ __forceinline__ float dpp_xor4(float x) { const int xi = __builtin_bit_cast(int, x); int t = __builtin_amdgcn_update_dpp(xi, xi, 0x12C, 0xf, 0x5, false); t = __builtin_amdgcn_update_dpp(t, xi, 0x124, 0xf, 0xA, false); return __builtin_bit_cast(float, t); }
__device__ __forceinline__ f32x4 rot64(const f32x4 v, int lane) {
    const float a0 = v.x + v.y, a1 = v.x - v.y, a2 = v.z + v.w, a3 = v.z - v.w;
    f32x4 b = {a0 + a2, a1 + a3, a0 - a2, a1 - a3};
    const float s1 = (lane & 1) ? -1.0f : 1.0f, s2 = (lane & 2) ? -1.0f : 1.0f, s4 = (lane & 4) ? -1.0f : 1.0f, s8 = (lane & 8) ? -1.0f : 1.0f;
    b = (f32x4){dppx<0xB1>(b.x), dppx<0xB1>(b.y), dppx<0xB1>(b.z), dppx<0xB1>(b.w)} + b * s1;
    b = (f32x4){dppx<0x4E>(b.x), dppx<0x4E>(b.y), dppx<0x4E>(b.z), dppx<0x4E>(b.w)} + b * s2;
    b = (f32x4){dpp_xor4(b.x), dpp_xor4(b.y), dpp_xor4(b.z), dpp_xor4(b.w)} + b * s4;
    b = (f32x4){dppx<0x128>(b.x), dppx<0x128>(b.y), dppx<0x128>(b.z), dppx<0x128>(b.w)} + b * s8;
    return b * 0.125f;
}

__device__ __forceinline__ void fwht8(float (&y)[8]) {
#pragma unroll
    for (int t = 1; t < 8; t <<= 1)
#pragma unroll
        for (int i = 0; i < 8; ++i) if (!(i & t)) { const float a = y[i], b = y[i | t]; y[i] = a + b; y[i | t] = a - b; }
}
__device__ __forceinline__ void rot64_8(float (&y)[8], int lane) {
    fwht8(y);
    const float s1 = (lane & 1) ? -1.0f : 1.0f, s2 = (lane & 2) ? -1.0f : 1.0f, s4 = (lane & 4) ? -1.0f : 1.0f;
#pragma unroll
    for (int i = 0; i < 8; ++i) y[i] = dppx<0xB1>(y[i]) + y[i] * s1;
#pragma unroll
    for (int i = 0; i < 8; ++i) y[i] = dppx<0x4E>(y[i]) + y[i] * s2;
#pragma unroll
    for (int i = 0; i < 8; ++i) y[i] = dpp_xor4(y[i]) + y[i] * s4;
}
template <int Q, int RB = 64> __device__ __forceinline__ void store_y8(bf16* ybase, size_t elem, float (&y)[8], int lane, float clip) {
    if constexpr (Q == 2) { typedef unsigned v2u_ __attribute__((ext_vector_type(2)));
        if constexpr (RB == 8) fwht8(y); else rot64_8(y, lane);
        const float s = (RB == 8 ? 0.35355339f : 0.125f) * 127.0f / clip;
        v2u_ o8; o8.x = pk4_q<2>(y[0] * s, y[1] * s, y[2] * s, y[3] * s); o8.y = pk4_q<2>(y[4] * s, y[5] * s, y[6] * s, y[7] * s);
        *(v2u_*)((unsigned char*)ybase + elem) = o8; }
    else *(v4u*)(ybase + elem) = pack8(y);
}

#define XB_TMO      128
#define XB_XCNT(j)  (256  + 64 * (j))
#define XB_XSUB(j)  (1280 + 64 * (j))
#define XB_XGEN(j)  (2304 + 64 * (j))
#define XB_TOP      3328
#define XB_TOPGEN   3392
#define XCD_BAR_WORDS 3456
#define XB_SPIN_CAP (1u << 18)

__device__ __forceinline__ unsigned xb_ld(unsigned* p)              { return __hip_atomic_load(p, __ATOMIC_RELAXED, __HIP_MEMORY_SCOPE_AGENT); }
__device__ __forceinline__ unsigned xb_add(unsigned* p, unsigned v) { return __hip_atomic_fetch_add(p, v, __ATOMIC_RELAXED, __HIP_MEMORY_SCOPE_AGENT); }
__device__ __forceinline__ unsigned xb_xcc_id() { return (unsigned)__builtin_amdgcn_s_getreg((3 << 11) | 20) & 0xFu; }
#define XB_SPIN(cond, bar) do { unsigned _sp = 0; while (cond) { __builtin_amdgcn_s_sleep(1); \
    if ((++_sp & 255u) == 0u) { if (xb_ld(&(bar)[XB_TMO])) break; if (_sp > XB_SPIN_CAP) { atomicAdd(&(bar)[XB_TMO], 1u); break; } } } } while (0)

struct XcdBarrier { unsigned* bar; unsigned x; volatile LAS unsigned* st; };

__device__ __forceinline__ XcdBarrier xcd_barrier_post(unsigned* bar, volatile LAS unsigned* st) {
    XcdBarrier b; b.bar = bar; b.x = xb_xcc_id(); b.st = st;
    if (threadIdx.x == 0) (void)xb_add(&bar[XB_XCNT(b.x)], 1u);
    return b;
}
__device__ __forceinline__ void xcd_barrier_complete(unsigned* bar, unsigned x, unsigned& nloc, unsigned& nx) {
    const unsigned G = gridDim.x * gridDim.y * gridDim.z;
    unsigned sum, cnt, mine, sp = 0u;
    for (;;) {
        sum = 0u; cnt = 0u; mine = 0u;
        unsigned cv[16];
#pragma unroll
        for (unsigned j = 0; j < 16; ++j) cv[j] = xb_ld(&bar[XB_XCNT(j)]);
        asm volatile("" ::: "memory");
#pragma unroll
        for (unsigned j = 0; j < 16; ++j) { const unsigned c = cv[j]; sum += c; cnt += (c > 0u) ? 1u : 0u; mine = (j == x) ? c : mine; }
        if (sum == G) break;
        __builtin_amdgcn_s_sleep(1);
        if ((++sp & 255u) == 0u) { if (xb_ld(&bar[XB_TMO])) break; if (sp > XB_SPIN_CAP) { atomicAdd(&bar[XB_TMO], 1u); break; } }
    }
    nloc = mine > 0u ? mine : 1u; nx = cnt > 0u ? cnt : 1u;
}
__device__ __forceinline__ void xcd_barrier(const XcdBarrier& b) {
    asm volatile("s_waitcnt vmcnt(0)" ::: "memory");
    __syncthreads();
    if (threadIdx.x == 0) {
        unsigned* bar = b.bar;
        __builtin_amdgcn_s_waitcnt(0);
        unsigned nloc = b.st[0], nx = b.st[1];
        if (nloc == 0u) { xcd_barrier_complete(bar, b.x, nloc, nx); b.st[0] = nloc; b.st[1] = nx; }
        const unsigned old = xb_add(&bar[XB_XSUB(b.x)], 1u);
        const unsigned gen = old / nloc;
        if (old + 1u == (gen + 1u) * nloc) {
            __builtin_amdgcn_fence(__ATOMIC_RELEASE, "agent");
            asm volatile("s_waitcnt vmcnt(0)" ::: "memory");
            const unsigned og = xb_add(&bar[XB_TOP], 1u);
            const unsigned tg = og / nx;
            if (og + 1u == (tg + 1u) * nx) xb_add(&bar[XB_TOPGEN], 1u);
            else XB_SPIN(xb_ld(&bar[XB_TOPGEN]) == tg, bar);
            __builtin_amdgcn_fence(__ATOMIC_ACQUIRE, "agent");
            xb_add(&bar[XB_XGEN(b.x)], 1u);
            asm volatile("s_waitcnt vmcnt(0)" ::: "memory");
        } else {
            XB_SPIN(xb_ld(&bar[XB_XGEN(b.x)]) == gen, bar);
            __builtin_amdgcn_fence(__ATOMIC_ACQUIRE, "agent");
            asm volatile("s_waitcnt vmcnt(0)" ::: "memory");
        }
    }
    __syncthreads();
}

#ifndef STAGGER
#define STAGGER 0
#endif
__device__ __forceinline__ void stagger_wait(int bid, int us) {
    if (STAGGER && ((bid >> 3) & 1)) { const unsigned long long t0 = __builtin_amdgcn_s_memrealtime(); while (__builtin_amdgcn_s_memrealtime() - t0 < (unsigned long long)us * 100ull) __builtin_amdgcn_s_sleep(8); }
}
struct Args { const float* in[26]; float* out; unsigned char* ws; int ph_lo, ph_hi; };
typedef const Args __attribute__((address_space(4)))* KArgs;
#define KA() ({ KArgs p_ = (KArgs)__builtin_amdgcn_kernarg_segment_ptr(); asm volatile("" : "+s"(p_)); p_; })
struct Frame {
    LAS unsigned char* lds;
    int tid, lane, wave, G, bid;
    int w0;
};

template <int MAP, int F8 = 0, int RB = (F8 == 2 ? 64 : 0)>
__device__ __forceinline__ void transpose_item(const float* W, int K, int N, bf16* WT, int row_off, LAS float* scr, int item, int lane, float wscale = F8_SW) {
    const int nblk = N / 32, kb = item / nblk, nb = item % nblk, k0 = 64 * kb, n0 = 32 * nb;
    float vld[32];
#pragma unroll
    for (int i = 0; i < 32; ++i) vld[i] = W[(size_t)(k0 + 2 * i + (lane >> 5)) * N + n0 + (lane & 31)];
    asm volatile("" ::: "memory");
    if constexpr (RB != 0) {
#pragma unroll
        for (int t = 1; 2 * t < RB; t <<= 1)
#pragma unroll
            for (int i = 0; i < 32; ++i) if (!(i & t)) { const float a = vld[i], b = vld[i | t]; vld[i] = a + b; vld[i | t] = a - b; }
#pragma unroll
        for (int i = 0; i < 32; ++i) { const float pv = shx(vld[i], 32, lane); vld[i] = (lane & 32) ? pv - vld[i] : vld[i] + pv; }
        wscale *= (RB == 64 ? 0.125f : 0.35355339f);
    }
#pragma unroll
    for (int i = 0; i < 32; ++i) scr[(2 * i + (lane >> 5)) * 33 + (lane & 31)] = vld[i];
    LDS_WAIT(); asm volatile("" ::: "memory");
    const int c = lane & 7;
#pragma unroll
    for (int j = 0; j < 4; ++j) { const int n = (lane >> 3) + 8 * j; const LAS float* s = scr + (8 * c) * 33 + n;
        v4u o; o.x = pk2(s[0 * 33], s[1 * 33]); o.y = pk2(s[2 * 33], s[3 * 33]); o.z = pk2(s[4 * 33], s[5 * 33]); o.w = pk2(s[6 * 33], s[7 * 33]);
        const int nn = n0 + n; const int row = (MAP == 0) ? (row_off + nn) : ((nn >> 7) * 256 + row_off + (nn & 127));
        if constexpr (F8) { typedef unsigned v2u_ __attribute__((ext_vector_type(2))); v2u_ o8;
            o8.x = pk4_q<F8>(s[0 * 33] * wscale, s[1 * 33] * wscale, s[2 * 33] * wscale, s[3 * 33] * wscale); o8.y = pk4_q<F8>(s[4 * 33] * wscale, s[5 * 33] * wscale, s[6 * 33] * wscale, s[7 * 33] * wscale);
            *(v2u_*)((unsigned char*)WT + (size_t)row * K + k0 + 8 * c) = o8; }
        else *(v4u*)(WT + (size_t)row * K + k0 + 8 * c) = o; }
    LDS_WAIT(); asm volatile("" ::: "memory");
}

static_assert(Q_PROJ == 2 && Q_GATE == 2 && Q_BR == 2 && Q_WO == 2 && Q_FUP == 2 && Q_FDN == 2 && Q_MUP == 2 && Q_MDN == 2, "the pipelined conversion writes int8 rows only");
__device__ __forceinline__ void cv_load(const float* src, int N, int lane, float (&v)[32]) {
    const float* p = src + (size_t)(lane >> 5) * N + (lane & 31);
#pragma unroll
    for (int i = 0; i < 32; ++i) v[i] = p[(size_t)(2 * i) * N];
}
__device__ __forceinline__ void cv_store(float (&vld)[32], unsigned char* WTk, int K, int n0, int row_off, int fl, float wscale, LAS float* scr, int lane) {
#pragma unroll
    for (int t = 1; t < 4; t <<= 1)
#pragma unroll
        for (int i = 0; i < 32; ++i) if (!(i & t)) { const float a = vld[i], b = vld[i | t]; vld[i] = a + b; vld[i | t] = a - b; }
    if (fl & 2) {
#pragma unroll
        for (int t = 4; t < 32; t <<= 1)
#pragma unroll
            for (int i = 0; i < 32; ++i) if (!(i & t)) { const float a = vld[i], b = vld[i | t]; vld[i] = a + b; vld[i | t] = a - b; }
    }
#pragma unroll
    for (int i = 0; i < 32; ++i) { const float pv = shx(vld[i], 32, lane); vld[i] = (lane & 32) ? pv - vld[i] : vld[i] + pv; }
    wscale *= (fl & 2) ? 0.125f : 0.35355339f;
#pragma unroll
    for (int i = 0; i < 32; ++i) scr[(2 * i + (lane >> 5)) * 33 + (lane & 31)] = vld[i];
    LDS_WAIT(); asm volatile("" ::: "memory");
    const int c = lane & 7;
#pragma unroll
    for (int j = 0; j < 4; ++j) { const int n = (lane >> 3) + 8 * j; const LAS float* s = scr + (8 * c) * 33 + n;
        const int nn = n0 + n; const int row = (fl & 1) ? ((nn >> 7) * 256 + row_off + (nn & 127)) : (row_off + nn);
        typedef unsigned v2u_ __attribute__((ext_vector_type(2))); v2u_ o8;
        o8.x = pk4_q<2>(s[0 * 33] * wscale, s[1 * 33] * wscale, s[2 * 33] * wscale, s[3 * 33] * wscale); o8.y = pk4_q<2>(s[4 * 33] * wscale, s[5 * 33] * wscale, s[6 * 33] * wscale, s[7 * 33] * wscale);
        *(v2u_*)(WTk + (size_t)row * K + 8 * c) = o8; }
    LDS_WAIT(); asm volatile("" ::: "memory");
}
#define CV_PIPE(start_, nitems_, DECODE) do { \
        float va[32]; int it = (start_); const float* src_; int N_, K_, n0_, ro_, fl_; unsigned char* dst_; float ws_; \
        if (it < (nitems_)) { DECODE(it); cv_load(src_, N_, F.lane, va); } \
        unsigned char* cdst = dst_; int cK = K_, cn0 = n0_, cro = ro_, cfl = fl_; float cws = ws_; \
        while (it < (nitems_)) { \
            const int nx = it + NGW; float vb[32]; \
            if (nx < (nitems_)) { DECODE(nx); cv_load(src_, N_, F.lane, vb); } \
            asm volatile("" ::: "memory"); \
            cv_store(va, cdst, cK, cn0, cro, cfl, cws, scr, F.lane); \
            _Pragma("unroll") for (int i = 0; i < 32; ++i) va[i] = vb[i]; \
            cdst = dst_; cK = K_; cn0 = n0_; cro = ro_; cfl = fl_; cws = ws_; it = nx; } \
    } while (0)

__device__ __forceinline__ void p_prologue(Frame& F, KArgs ka) {
    const float* c = ka->in[1]; const float* ada_w = ka->in[2]; const float* ada_b = ka->in[3];
    unsigned char* aws = ka->ws; float* mod = (float*)(aws + WS_MOD);
    LAS float* cact = (LAS float*)F.lds;
    LAS float* red = cact + 8192;
    for (int i = F.tid; i < BATCH * D; i += NT) cact[i] = siluf_(c[i]);
    __syncthreads();
    for (int chunk = F.bid; chunk < 256; chunk += F.G) {
        const int l = chunk >> 7, n0 = (chunk & 127) * 48;
        if (F.tid < 480) {
            const int kg = F.tid / 48, col = F.tid % 48;
            float acc[8];
#pragma unroll
            for (int b = 0; b < 8; ++b) acc[b] = 0.f;
            const float* wp = ada_w + (size_t)l * D * MOD_LD + n0 + col;
            for (int kb = kg; kb < D; kb += 160) {
                float wv[16];
#pragma unroll
                for (int j = 0; j < 16; ++j) { const int k = kb + 10 * j; wv[j] = (k < D) ? wp[(size_t)k * MOD_LD] : 0.f; }
                asm volatile("" ::: "memory");
#pragma unroll
                for (int j = 0; j < 16; ++j) { const int k = kb + 10 * j; if (k < D) {
#pragma unroll
                    for (int b = 0; b < 8; ++b) acc[b] += cact[b * D + k] * wv[j]; } } }
#pragma unroll
            for (int b = 0; b < 8; ++b) red[(kg * 48 + col) * 8 + b] = acc[b];
        }
        __syncthreads();
        if (F.tid < 384) {
            const int col = F.tid >> 3, b = F.tid & 7; float s = 0.f;
#pragma unroll
            for (int kg = 0; kg < 10; ++kg) s += red[(kg * 48 + col) * 8 + b];
            mod[(size_t)(l * 8 + b) * MOD_LD + n0 + col] = s + ada_b[l * MOD_LD + n0 + col];
        }
        __syncthreads();
    }
}
__device__ __forceinline__ float wscale_sample(const float* W, size_t n, int lane) {
    float ss = 0.f;
#pragma unroll
    for (int j = 0; j < 32; ++j) { const size_t idx = ((size_t)(lane + 64 * j) * 1000003ull) % n; const float v = W[idx]; ss += v * v; }
    ss = wave_sum(ss, lane);
    return 127.0f / (W_CLIP * sqrtf(ss * (1.0f / 2048.0f)) + 1e-30f);
}
__device__ __forceinline__ void p_convert_mixer(Frame& F, KArgs ka, int l, bool with_ffn) {
    unsigned char* aws = ka->ws;
    LAS float* scr = (LAS float*)(F.lds + F.wave * 16384);
    const int gw = F.bid * NWAVES + F.wave, NGW = F.G * NWAVES;
    constexpr int I_BCA = (D / 64) * (N_BCA / 32), I_G = (D / 64) * (N_G / 32), I_BR = (512 / 64) * (D / 32), I_O = (D / 64) * (D / 32), I_L = I_BCA + I_G + 3 * I_BR + I_O;
    constexpr int I_F1 = (D / 64) * (D_FF / 32), I_F2 = (D_FF / 64) * (D / 32);
    const int nitems = I_L + (with_ffn ? 2 * I_F1 + I_F2 : 0);
    bf16* base = (bf16*)(aws + WS_WMIX);
    LAS float* qsl = (LAS float*)(F.lds + TAB_OFF + 3072);
    __syncthreads();
    if (F.wave == 0) { const float v = wscale_sample(ka->in[6] + (size_t)l * D * N_IN, (size_t)D * N_IN, F.lane); if (F.lane == 0) qsl[0] = v; }
    if (F.wave == 1) { const float v = wscale_sample(ka->in[17], (size_t)D * D_FF, F.lane); if (F.lane == 0) qsl[1] = v; }
    if (F.wave == 2) { const float v = wscale_sample(ka->in[18], (size_t)D * D_FF, F.lane); if (F.lane == 0) qsl[2] = v; }
    if (F.wave >= 3 && F.wave < 6) { const float v = wscale_sample(ka->in[13 + F.wave - 3] + (size_t)l * 512 * D, (size_t)512 * D, F.lane); if (F.lane == 0) qsl[F.wave] = v; }
    if (F.wave == 6) { const float v = wscale_sample(ka->in[16] + (size_t)l * D * D, (size_t)D * D, F.lane); if (F.lane == 0) qsl[6] = v; }
    if (F.wave == 7) { const float v = wscale_sample(ka->in[19], (size_t)D_FF * D, F.lane); if (F.lane == 0) qsl[7] = v; }
    __syncthreads();
    const float ws_in = qsl[0], ws_13 = (Q_FUP == 2) ? fminf(qsl[1], qsl[2]) : F8_SW;
    const float ws_p = (Q_PROJ == 2) ? ws_in : F8_SW, ws_g = (Q_GATE == 2) ? ws_in : F8_SW;
    const float ws_ba = qsl[3], ws_bb = qsl[4], ws_bc = qsl[5], ws_o = qsl[6], ws_2 = (Q_FDN == 2) ? qsl[7] : F8_SW;
    if (F.bid == 0 && F.tid == 0) { float* qs = (float*)(aws + WS_QS); qs[QS_IN] = ws_in; qs[QS_BR] = ws_ba; qs[QS_BR + 1] = ws_bb; qs[QS_BR + 2] = ws_bc; qs[QS_WO] = ws_o; if (with_ffn) { qs[QS_F13] = ws_13; qs[QS_F2] = ws_2; } }
    const float* in6 = ka->in[6] + (size_t)l * D * N_IN;
    constexpr int BRS = Q_BR ? 512 * 1024 / 2 : 512 * 1024;
#define CV_DEC_MIX(it_) do { int r = (it_); int kb, nb; const float* W; \
        if (r < I_BCA) { kb = r / (N_BCA / 32); nb = r % (N_BCA / 32); W = in6; K_ = D; N_ = N_IN; dst_ = (unsigned char*)base; ro_ = 0; fl_ = 2; ws_ = ws_p; }                         \
        else if ((r -= I_BCA) < I_G) { kb = r / (N_G / 32); nb = r % (N_G / 32) + N_BCA / 32; W = in6; K_ = D; N_ = N_IN; dst_ = aws + WS_WMIX + WMIX_G8; ro_ = -N_BCA; fl_ = 2; ws_ = ws_g; }     \
        else if ((r -= I_G) < 3 * I_BR) { const int b = r / I_BR; r -= b * I_BR; kb = r / (D / 32); nb = r % (D / 32); W = ka->in[13 + b] + (size_t)l * 512 * D; K_ = 512; N_ = D; dst_ = (unsigned char*)(base + (size_t)N_IN * D + (size_t)b * BRS); ro_ = 0; fl_ = (b == 0) ? 2 : 0; ws_ = (b == 0) ? ws_ba : (b == 1) ? ws_bb : ws_bc; }     \
        else if ((r -= 3 * I_BR) < I_O) { kb = r / (D / 32); nb = r % (D / 32); W = ka->in[16] + (size_t)l * D * D; K_ = D; N_ = D; dst_ = (unsigned char*)(base + (size_t)N_IN * D + 3 * 512 * 1024); ro_ = 0; fl_ = 0; ws_ = ws_o; } \
        else if ((r -= I_O) < 2 * I_F1) { const int h = r / I_F1; r -= h * I_F1; kb = r / (D_FF / 32); nb = r % (D_FF / 32); W = ka->in[17 + h]; K_ = D; N_ = D_FF; dst_ = aws + WS_W13; ro_ = 128 * h; fl_ = 3; ws_ = ws_13; } \
        else { r -= 2 * I_F1; kb = r / (D / 32); nb = r % (D / 32); W = ka->in[19]; K_ = D_FF; N_ = D; dst_ = aws + WS_W2; ro_ = 0; fl_ = 0; ws_ = ws_2; } \
        src_ = W + (size_t)(64 * kb) * N_ + 32 * nb; dst_ += 64 * kb; n0_ = 32 * nb; } while (0)
    CV_PIPE(gw, nitems, CV_DEC_MIX);
#undef CV_DEC_MIX
}
__device__ __forceinline__ void p_moe_scales(Frame& F, KArgs ka) {
    LAS float* qsl = (LAS float*)(F.lds + TAB_OFF + 3072);
    __syncthreads();
    if (F.wave == 0) { const float v = wscale_sample(ka->in[22], (size_t)NE * D * D_FF, F.lane); if (F.lane == 0) qsl[0] = v; }
    if (F.wave == 1) { const float v = wscale_sample(ka->in[23], (size_t)NE * D * D_FF, F.lane); if (F.lane == 0) qsl[1] = v; }
    if (F.wave == 2) { const float v = wscale_sample(ka->in[24], (size_t)NE * D_FF * D, F.lane); if (F.lane == 0) qsl[2] = v; }
    __syncthreads();
    if (F.bid == 0 && F.tid == 0) { float* qs = (float*)(ka->ws + WS_QS); qs[QS_M13] = fminf(qsl[0], qsl[1]); qs[QS_M2] = qsl[2]; }
}
#define CV_DEC_MOE(it_) do { const int e = (it_) / I_E; int r = (it_) - e * I_E; int kb, nb; const float* W; \
        if (r < 2 * I_F1) { const int h = r / I_F1; r -= h * I_F1; kb = r / (D_FF / 32); nb = r % (D_FF / 32); W = ka->in[22 + h] + (size_t)e * D * D_FF; K_ = D; N_ = D_FF; dst_ = aws + WS_WM13 + (size_t)e * N13 * D * MOE_ES; ro_ = 128 * h; fl_ = 3; ws_ = ws_13; } \
        else { r -= 2 * I_F1; kb = r / (D / 32); nb = r % (D / 32); W = ka->in[24] + (size_t)e * D_FF * D; K_ = D_FF; N_ = D; dst_ = aws + WS_WM2 + (size_t)e * D * D_FF * MOE_ES; ro_ = 0; fl_ = 0; ws_ = ws_2; } \
        src_ = W + (size_t)(64 * kb) * N_ + 32 * nb; dst_ += 64 * kb; n0_ = 32 * nb; } while (0)

__device__ __forceinline__ void norm_row(const float* xrow, const float* w, const float* sc, const float* sh, int lane, f32x4 (&o)[4]) {
    const f32x4* xr = (const f32x4*)xrow + lane;
    f32x4 v[4]; float s = 0.f;
#pragma unroll
    for (int j = 0; j < 4; ++j) { v[j] = xr[64 * j]; s += (v[j].x * v[j].x + v[j].y * v[j].y) + (v[j].z * v[j].z + v[j].w * v[j].w); }
    const float rstd = 1.0f / sqrtf(wave_sum(s, lane) * (1.0f / D) + EPS);
#pragma unroll
    for (int j = 0; j < 4; ++j) { const f32x4 wv = ((const f32x4*)w)[lane + 64 * j], scv = ((const f32x4*)sc)[lane + 64 * j], shv = ((const f32x4*)sh)[lane + 64 * j];
        o[j] = v[j] * rstd * wv * (scv + 1.0f) + shv; }
}
template <bool XBF>
__device__ __forceinline__ f32x4 load_x4(const void* xbase, size_t row, int lane, int j) {
    if constexpr (XBF) { typedef unsigned v2u_ __attribute__((ext_vector_type(2))); const v2u_ w = ((const v2u_*)((const bf16*)xbase + row * XLD))[lane + 64 * j];
        return (f32x4){bf_lo(w.x), bf_hi(w.x), bf_lo(w.y), bf_hi(w.y)}; }
    else return ((const f32x4*)((const float*)xbase + row * D))[lane + 64 * j];
}
__device__ __forceinline__ void store_row_bf16(bf16* orow, int lane, const f32x4 (&o)[4]) {
    unsigned long long* o8 = (unsigned long long*)orow + lane;
#pragma unroll
    for (int j = 0; j < 4; ++j) o8[64 * j] = (unsigned long long)pk2(o[j].x, o[j].y) | ((unsigned long long)pk2(o[j].z, o[j].w) << 32);
}
template <int MODE = 0, bool XBF = true, int HQ = 2>
__device__ __forceinline__ void p_norm(Frame& F, const void* xin, const float* w, const float* mod_l, int sc_off, int sh_off, bf16* hout, unsigned char* hout8 = nullptr, float sa = 1.0f) {
    const int gw = F.bid * NWAVES + F.wave, NGW = F.G * NWAVES, lane = F.lane;
    f32x4 wv[4];
#pragma unroll
    for (int j = 0; j < 4; ++j) wv[j] = ((const f32x4*)w)[lane + 64 * j];
    for (int r0 = gw * 4; r0 < M; r0 += NGW * 4) {
        const float* mb = mod_l + (size_t)(r0 >> 12) * MOD_LD;
        f32x4 v[4][4], scv[4], shv[4];
#pragma unroll
        for (int r = 0; r < 4; ++r)
#pragma unroll
            for (int j = 0; j < 4; ++j) v[r][j] = load_x4<XBF>(xin, (size_t)(r0 + r), lane, j);
#pragma unroll
        for (int j = 0; j < 4; ++j) { scv[j] = ((const f32x4*)(mb + sc_off))[lane + 64 * j]; shv[j] = ((const f32x4*)(mb + sh_off))[lane + 64 * j]; }
        asm volatile("" ::: "memory");
#pragma unroll
        for (int j = 0; j < 4; ++j) scv[j] = wv[j] * (scv[j] + 1.0f);
#pragma unroll
        for (int r = 0; r < 4; ++r) { float s = 0.f;
#pragma unroll
            for (int j = 0; j < 4; ++j) s += (v[r][j].x * v[r][j].x + v[r][j].y * v[r][j].y) + (v[r][j].z * v[r][j].z + v[r][j].w * v[r][j].w);
            const float rstd = 1.0f / sqrtf(wave_sum(s, lane) * (1.0f / D) + EPS);
            f32x4 o[4];
#pragma unroll
            for (int j = 0; j < 4; ++j) o[j] = v[r][j] * rstd * scv[j] + shv[j];
            if constexpr (MODE != 0) { unsigned* o4 = (unsigned*)((MODE == 1 ? (unsigned char*)hout : hout8) + (size_t)(r0 + r) * D) + lane;
#pragma unroll
                for (int j = 0; j < 4; ++j) { const f32x4 q = (HQ == 2) ? rot64(o[j], lane) : o[j]; o4[64 * j] = pk4_q<HQ>(q.x * sa, q.y * sa, q.z * sa, q.w * sa); } }
            if constexpr (MODE != 1) store_row_bf16(hout + (size_t)(r0 + r) * D, lane, o); }
    }
}

constexpr int CONV_RUN = 16;
__device__ __forceinline__ void p_conv(Frame& F, const bf16* P1, const float* conv_w, bf16* ya) {
    const int gt = F.bid * NT + F.tid, NGT = F.G * NT;
    for (int run = gt >> 6; run < M / CONV_RUN; run += NGT >> 6) {
        const int c8 = (gt & 63) * 8, row0 = run * CONV_RUN, pos0 = row0 & (SEQ - 1);
        const unsigned char* p = (const unsigned char*)P1 + (size_t)row0 * P1_PITCH + c8;
        float w0[8], w1[8], w2[8], z1[8], z2[8];
#pragma unroll
        for (int i = 0; i < 8; ++i) { w0[i] = conv_w[c8 + i]; w1[i] = conv_w[512 + c8 + i]; w2[i] = conv_w[1024 + c8 + i]; z1[i] = 0.f; z2[i] = 0.f; }
        if (pos0 >= 2) {
            float c1[8], h1[8], c2[8], h2[8];
            decode8u(*(const v2u_p1*)(p - P1_PITCH + 512), c1); decode8u(*(const v2u_p1*)(p - P1_PITCH + 1024), h1);
            decode8u(*(const v2u_p1*)(p - 2 * P1_PITCH + 512), c2); decode8u(*(const v2u_p1*)(p - 2 * P1_PITCH + 1024), h2);
#pragma unroll
            for (int i = 0; i < 8; ++i) { z1[i] = c1[i] * h1[i]; z2[i] = c2[i] * h2[i]; } }
        v2u_p1 nb = *(const v2u_p1*)p, nc = *(const v2u_p1*)(p + 512), nh = *(const v2u_p1*)(p + 1024);
#pragma unroll 2
        for (int k = 0; k < CONV_RUN; ++k) {
            const v2u_p1 rb = nb, rc = nc, rh = nh;
            if (k + 1 < CONV_RUN) { const unsigned char* pn = p + (size_t)(k + 1) * P1_PITCH; nb = *(const v2u_p1*)pn; nc = *(const v2u_p1*)(pn + 512); nh = *(const v2u_p1*)(pn + 1024); }
            float ab[8], ac[8], ah[8], y[8];
            decode8u(rb, ab); decode8u(rc, ac); decode8u(rh, ah);
#pragma unroll
            for (int i = 0; i < 8; ++i) { const float z = ac[i] * ah[i]; y[i] = ab[i] * (w0[i] * z + w1[i] * z1[i] + w2[i] * z2[i]); z2[i] = z1[i]; z1[i] = z; }
            store_y8<Q_BR>(ya, (size_t)(row0 + k) * 512 + c8, y, F.lane, CLIP_YA);
        }
    }
}

typedef short v4i16_t __attribute__((ext_vector_type(4)));
typedef short bf16x8_t __attribute__((ext_vector_type(8)));
typedef unsigned v2u __attribute__((ext_vector_type(2)));
constexpr int HRS = 272;
constexpr int TRS = 80;
constexpr int H_RAWQ = 0, H_RAWF = 8704, H_V = 17408, H_QHT = 26112, H_KTT = 36352, H_KHT = 46592, H_DL = 56832, H_OB = 57344, H_OBS = 132, H_V2 = 74240;
constexpr int HSEG = 512, HNSEG = SEQ / HSEG, HCH = 32;
__device__ __forceinline__ v4i16_t tr_read(LAS unsigned char* p) { return __builtin_amdgcn_ds_read_tr16_b64_v4i16((LAS v4i16_t*)p); }
__device__ __forceinline__ bf16x8_t cat4(v4i16_t lo, v4i16_t hi) { return __builtin_shufflevector(lo, hi, 0, 1, 2, 3, 4, 5, 6, 7); }
__device__ __forceinline__ bf16x8_t pack_acc(const f32x4 a, const f32x4 b) { v4u w; w.x = pk2(a[0], a[1]); w.y = pk2(a[2], a[3]); w.z = pk2(b[0], b[1]); w.w = pk2(b[2], b[3]); return __builtin_bit_cast(bf16x8_t, w); }
__device__ __forceinline__ float bfs(short x) { return __uint_as_float((unsigned)(unsigned short)x << 16); }
template <int PASS>
__device__ __forceinline__ void p_hgrn(Frame& F, const bf16* P1, const float* lb_logits, int layer, const float* norm_w, bf16* yb, float* ust, float* dst) {
    LAS unsigned char* L = F.lds;
    const int lane = F.lane, w = F.wave, g = lane >> 4, n = lane & 15, q_ = n >> 2, p_ = n & 3;
    const int pt = F.tid >> 4, pc8 = (F.tid & 15) * 8;
    for (int u = F.bid; u < BATCH * H_B * HNSEG; u += F.G) {
        const int seg = u & (HNSEG - 1), bh = u / HNSEG, b = bh >> 2, h = bh & 3;
        const int d = 16 * w + n;
        float lb; { const int ch = h * 128 + d; const float l0 = lb_logits[ch], l1 = lb_logits[512 + ch]; const float mx = fmaxf(l0, l1);
            const float e0 = expf(l0 - mx), e1 = expf(l1 - mx); const float p0 = e0 / (e0 + e1), p1 = e1 / (e0 + e1);
            const float lbx = (layer == 0) ? (p0 - p0) : ((p0 + p1) - p0); lb = fminf(fmaxf(lbx, 0.f), 1.f); }
        const float lbf = fmaxf(lb, 1e-30f), oml = 1.0f - lb;
        f32x4 S[8];
#pragma unroll
        for (int kt = 0; kt < 8; ++kt) S[kt] = (f32x4){0.f, 0.f, 0.f, 0.f};
        if (PASS == 2) {
#pragma unroll 2
            for (int j = 0; j < seg; ++j) { const int uj = u - seg + j;
#pragma unroll
                for (int kt = 0; kt < 8; ++kt) { const f32x4 dj = *(const f32x4*)(dst + (size_t)uj * 128 + 16 * kt + 4 * g); const f32x4 uu = *(const f32x4*)(ust + ((((size_t)uj * 8 + w) * 8 + kt) * 64 + lane) * 4);
                    S[kt] = dj * S[kt] + uu; } }
        }
        float nw8[8];
        if (PASS == 2) {
#pragma unroll
            for (int i = 0; i < 8; ++i) nw8[i] = norm_w[h * 128 + pc8 + i]; }
        float dprod = 1.0f;
        const bf16* gp = P1 + ((size_t)b * SEQ + (size_t)seg * HSEG + pt) * P1E + P1_OB / 2 + h * 128 + pc8;
        constexpr int HPF = 4, NCH = HSEG / HCH;
        v4u rq[HPF], rf[HPF], rv[HPF], rg[HPF];
#pragma unroll
        for (int k = 0; k < HPF; ++k) { const bf16* np = gp + (size_t)k * HCH * P1E; rf[k] = *(const v4u*)(np + 512); rv[k] = *(const v4u*)(np + 1024);
            if (PASS == 2) { rq[k] = *(const v4u*)np; rg[k] = *(const v4u*)(np + 1536); } }
#define HG_WRITE(k_, vb_) do { *(LAS v4u*)(L + H_RAWF + pt * HRS + pc8 * 2) = rf[k_]; *(LAS v4u*)(L + ((vb_) ? H_V2 : H_V) + pt * HRS + pc8 * 2) = rv[k_]; \
            if (PASS == 2) *(LAS v4u*)(L + H_RAWQ + pt * HRS + pc8 * 2) = rq[k_]; } while (0)
#define HG_REFILL(k_, cn_) do { if ((cn_) < NCH) { const bf16* np = gp + (size_t)(cn_) * HCH * P1E; rf[k_] = *(const v4u*)(np + 512); rv[k_] = *(const v4u*)(np + 1024); \
            if (PASS == 2) { rq[k_] = *(const v4u*)np; rg[k_] = *(const v4u*)(np + 1536); } } } while (0)
        v4u cg, cgn;
        HG_WRITE(0, 0); if (PASS == 2) cg = rg[0];
        LDS_BARRIER();
        HG_REFILL(0, HPF);
            { const bf16x8_t f8 = cat4(tr_read(L + H_RAWF + (8 * g + q_) * HRS + 32 * w + 8 * p_), tr_read(L + H_RAWF + (8 * g + 4 + q_) * HRS + 32 * w + 8 * p_));
              float eb[8], kk[8]; float cp = 1.0f;
#pragma unroll
              for (int i = 0; i < 8; ++i) { const float sg = __builtin_amdgcn_rcpf(1.0f + __expf(-bfs(f8[i]))); const float f = lbf + oml * sg; kk[i] = oml * (1.0f - sg); cp *= f; eb[i] = cp; }
              const float s1 = shl(cp, n), s2 = shl(cp, 16 + n), s3 = shl(cp, 32 + n), s4 = shl(cp, 48 + n);
              const float pre = (g > 0 ? s1 : 1.0f) * (g > 1 ? s2 : 1.0f) * (g > 2 ? s3 : 1.0f);
              const float elast = ((s1 * s2) * s3) * s4;
              float kh[8], kt8[8];
#pragma unroll
              for (int i = 0; i < 8; ++i) { eb[i] *= pre; const float en = __builtin_amdgcn_rcpf(fmaxf(eb[i], 1e-30f)); kt8[i] = kk[i] * en; kh[i] = kt8[i] * elast; }
              *(LAS v4u*)(L + H_KHT + d * TRS + 16 * g) = pack8(kh);
              if (PASS == 2) { const bf16x8_t q8 = cat4(tr_read(L + H_RAWQ + (8 * g + q_) * HRS + 32 * w + 8 * p_), tr_read(L + H_RAWQ + (8 * g + 4 + q_) * HRS + 32 * w + 8 * p_));
                  float qh[8];
#pragma unroll
                  for (int i = 0; i < 8; ++i) qh[i] = siluf_(bfs(q8[i])) * eb[i];
                  *(LAS v4u*)(L + H_QHT + d * TRS + 16 * g) = pack8(qh); *(LAS v4u*)(L + H_KTT + d * TRS + 16 * g) = pack8(kt8); }
              if (g == 0) *(LAS float*)(L + H_DL + 4 * d) = elast;
              dprod *= elast; }
        LDS_BARRIER();
        for (int c0 = 0; c0 < NCH; c0 += HPF) {
#pragma unroll
          for (int k = 0; k < HPF; ++k) {
            const int c = c0 + k; const int vbuf = (k & 1) ? H_V2 : H_V;
            const bf16x8_t bVn = cat4(tr_read(L + vbuf + (8 * g + q_) * HRS + 32 * w + 8 * p_), tr_read(L + vbuf + (8 * g + 4 + q_) * HRS + 32 * w + 8 * p_));
            if (PASS == 2) {
                const bf16x8_t bVp = cat4(tr_read(L + vbuf + (4 * g + q_) * HRS + 32 * w + 8 * p_), tr_read(L + vbuf + (16 + 4 * g + q_) * HRS + 32 * w + 8 * p_));
                f32x4 o[2], pt00 = {0.f, 0.f, 0.f, 0.f}, pt01 = {0.f, 0.f, 0.f, 0.f}, pt11 = {0.f, 0.f, 0.f, 0.f};
                o[0] = (f32x4){0.f, 0.f, 0.f, 0.f}; o[1] = (f32x4){0.f, 0.f, 0.f, 0.f};
#pragma unroll
                for (int ks = 0; ks < 4; ++ks) {
                    const bf16x8_t sb = pack_acc(S[2 * ks], S[2 * ks + 1]);
#pragma unroll
                    for (int tm = 0; tm < 2; ++tm) {
                        const bf16x8_t aq = cat4(tr_read(L + H_QHT + (32 * ks + 4 * g + q_) * TRS + 32 * tm + 8 * p_), tr_read(L + H_QHT + (32 * ks + 16 + 4 * g + q_) * TRS + 32 * tm + 8 * p_));
                        o[tm] = __builtin_amdgcn_mfma_f32_16x16x32_bf16(aq, sb, o[tm], 0, 0, 0); }
                    const bf16x8_t aK0 = cat4(tr_read(L + H_KTT + (32 * ks + 8 * g + q_) * TRS + 8 * p_), tr_read(L + H_KTT + (32 * ks + 8 * g + 4 + q_) * TRS + 8 * p_));
                    const bf16x8_t aK1 = cat4(tr_read(L + H_KTT + (32 * ks + 8 * g + q_) * TRS + 32 + 8 * p_), tr_read(L + H_KTT + (32 * ks + 8 * g + 4 + q_) * TRS + 32 + 8 * p_));
                    const bf16x8_t bQ0 = cat4(tr_read(L + H_QHT + (32 * ks + 8 * g + q_) * TRS + 8 * p_), tr_read(L + H_QHT + (32 * ks + 8 * g + 4 + q_) * TRS + 8 * p_));
                    const bf16x8_t bQ1 = cat4(tr_read(L + H_QHT + (32 * ks + 8 * g + q_) * TRS + 32 + 8 * p_), tr_read(L + H_QHT + (32 * ks + 8 * g + 4 + q_) * TRS + 32 + 8 * p_));
                    pt00 = __builtin_amdgcn_mfma_f32_16x16x32_bf16(aK0, bQ0, pt00, 0, 0, 0);
                    pt01 = __builtin_amdgcn_mfma_f32_16x16x32_bf16(aK0, bQ1, pt01, 0, 0, 0);
                    pt11 = __builtin_amdgcn_mfma_f32_16x16x32_bf16(aK1, bQ1, pt11, 0, 0, 0);
                }
#pragma unroll
                for (int j = 0; j < 4; ++j) if (4 * g + j > n) { pt00[j] = 0.f; pt11[j] = 0.f; }
                const f32x4 z4 = {0.f, 0.f, 0.f, 0.f};
                o[0] = __builtin_amdgcn_mfma_f32_16x16x32_bf16(pack_acc(pt00, z4), bVp, o[0], 0, 0, 0);
                o[1] = __builtin_amdgcn_mfma_f32_16x16x32_bf16(pack_acc(pt01, pt11), bVp, o[1], 0, 0, 0);
#pragma unroll
                for (int tm = 0; tm < 2; ++tm)
#pragma unroll
                    for (int j = 0; j < 4; ++j) *(LAS float*)(L + H_OB + ((16 * tm + 4 * g + j) * H_OBS + 16 * w + n) * 4) = o[tm][j];
            }
#pragma unroll
            for (int kt = 0; kt < 8; ++kt) { const f32x4 dl4 = *(const LAS f32x4*)(L + H_DL + (16 * kt + 4 * g) * 4);
                const bf16x8_t aKh = *(const LAS bf16x8_t*)(L + H_KHT + (16 * kt + n) * TRS + 16 * g);
                S[kt] = __builtin_amdgcn_mfma_f32_16x16x32_bf16(aKh, bVn, S[kt] * dl4, 0, 0, 0); }
            if (c + 1 < NCH) { HG_WRITE((k + 1) % HPF, (k + 1) & 1); if (PASS == 2) cgn = rg[(k + 1) % HPF]; }
            LDS_BARRIER();
            if (c + 1 < NCH) HG_REFILL((k + 1) % HPF, c + 1 + HPF);
            if (PASS == 2) {
                const f32x4 o0 = *(const LAS f32x4*)(L + H_OB + (pt * H_OBS + pc8) * 4), o1 = *(const LAS f32x4*)(L + H_OB + (pt * H_OBS + pc8 + 4) * 4);
                const float o8[8] = {o0.x, o0.y, o0.z, o0.w, o1.x, o1.y, o1.z, o1.w};
                float ss = 0.f;
#pragma unroll
                for (int i = 0; i < 8; ++i) ss += o8[i] * o8[i];
                ss += shx(ss, 1, lane); ss += shx(ss, 2, lane); ss += shx(ss, 4, lane); ss += shx(ss, 8, lane);
                const float rs = 1.0f / sqrtf(ss * (1.0f / 128.0f) + EPS);
                float g8[8], y[8]; unpack8(cg, g8);
#pragma unroll
                for (int i = 0; i < 8; ++i) y[i] = o8[i] * rs * nw8[i] * siluf_(g8[i]);
                store_y8<Q_BR, 8>(yb, ((size_t)b * SEQ + (size_t)seg * HSEG + (size_t)c * HCH + pt) * 512 + h * 128 + pc8, y, lane, CLIP_YB);
            }
            if (c + 1 < NCH)
            { const bf16x8_t f8 = cat4(tr_read(L + H_RAWF + (8 * g + q_) * HRS + 32 * w + 8 * p_), tr_read(L + H_RAWF + (8 * g + 4 + q_) * HRS + 32 * w + 8 * p_));
              float eb[8], kk[8]; float cp = 1.0f;
#pragma unroll
              for (int i = 0; i < 8; ++i) { const float sg = __builtin_amdgcn_rcpf(1.0f + __expf(-bfs(f8[i]))); const float f = lbf + oml * sg; kk[i] = oml * (1.0f - sg); cp *= f; eb[i] = cp; }
              const float s1 = shl(cp, n), s2 = shl(cp, 16 + n), s3 = shl(cp, 32 + n), s4 = shl(cp, 48 + n);
              const float pre = (g > 0 ? s1 : 1.0f) * (g > 1 ? s2 : 1.0f) * (g > 2 ? s3 : 1.0f);
              const float elast = ((s1 * s2) * s3) * s4;
              float kh[8], kt8[8];
#pragma unroll
              for (int i = 0; i < 8; ++i) { eb[i] *= pre; const float en = __builtin_amdgcn_rcpf(fmaxf(eb[i], 1e-30f)); kt8[i] = kk[i] * en; kh[i] = kt8[i] * elast; }
              *(LAS v4u*)(L + H_KHT + d * TRS + 16 * g) = pack8(kh);
              if (PASS == 2) { const bf16x8_t q8 = cat4(tr_read(L + H_RAWQ + (8 * g + q_) * HRS + 32 * w + 8 * p_), tr_read(L + H_RAWQ + (8 * g + 4 + q_) * HRS + 32 * w + 8 * p_));
                  float qh[8];
#pragma unroll
                  for (int i = 0; i < 8; ++i) qh[i] = siluf_(bfs(q8[i])) * eb[i];
                  *(LAS v4u*)(L + H_QHT + d * TRS + 16 * g) = pack8(qh); *(LAS v4u*)(L + H_KTT + d * TRS + 16 * g) = pack8(kt8); }
              if (g == 0) *(LAS float*)(L + H_DL + 4 * d) = elast;
              dprod *= elast; }
            LDS_BARRIER();
            if (PASS == 2) cg = cgn;
          }
        }
#undef HG_WRITE
#undef HG_REFILL
        if (PASS == 1) {
#pragma unroll
            for (int kt = 0; kt < 8; ++kt) *(f32x4*)(ust + ((((size_t)u * 8 + w) * 8 + kt) * 64 + lane) * 4) = S[kt];
            if (g == 0) dst[(size_t)u * 128 + d] = dprod;
        }
        __syncthreads();
    }
}


constexpr int H1_G = 4, H1_RF = 0, H1_RV = H1_G * 8704, H1_KH = 2 * H1_G * 8704;
__device__ __forceinline__ void p_hgrn1(Frame& F, const bf16* P1, const float* lb_logits, int layer, float* ust, float* dst) {
    LAS unsigned char* L = F.lds;
    const int lane = F.lane, w = F.wave, g = lane >> 4, n = lane & 15, q_ = n >> 2, p_ = n & 3;
    const int pt = F.tid >> 4, pc8 = (F.tid & 15) * 8;
    constexpr int NCH = HSEG / HCH;
    for (int u = F.bid; u < BATCH * H_B * HNSEG; u += F.G) {
        const int seg = u & (HNSEG - 1), bh = u / HNSEG, b = bh >> 2, h = bh & 3;
        const int d = 16 * w + n;
        float lb; { const int ch = h * 128 + d; const float l0 = lb_logits[ch], l1 = lb_logits[512 + ch]; const float mx = fmaxf(l0, l1);
            const float e0 = expf(l0 - mx), e1 = expf(l1 - mx); const float p0 = e0 / (e0 + e1), p1 = e1 / (e0 + e1);
            const float lbx = (layer == 0) ? (p0 - p0) : ((p0 + p1) - p0); lb = fminf(fmaxf(lbx, 0.f), 1.f); }
        const float lbf = fmaxf(lb, 1e-30f), oml = 1.0f - lb;
        f32x4 S[8];
#pragma unroll
        for (int kt = 0; kt < 8; ++kt) S[kt] = (f32x4){0.f, 0.f, 0.f, 0.f};
        float R = 1.0f;
        const bf16* gp = P1 + ((size_t)b * SEQ + (size_t)seg * HSEG + pt) * P1E + P1_OB / 2 + h * 128 + pc8;
        v4u rf[H1_G], rv[H1_G];
#pragma unroll
        for (int j = 0; j < H1_G; ++j) { const bf16* np = gp + (size_t)(NCH - 1 - j) * HCH * P1E; rf[j] = *(const v4u*)(np + 512); rv[j] = *(const v4u*)(np + 1024); }
#pragma unroll 1
        for (int c0 = NCH - 1; c0 >= 0; c0 -= H1_G) {
#pragma unroll
            for (int j = 0; j < H1_G; ++j) { *(LAS v4u*)(L + H1_RF + j * 8704 + pt * HRS + pc8 * 2) = rf[j]; *(LAS v4u*)(L + H1_RV + j * 8704 + pt * HRS + pc8 * 2) = rv[j]; }
            LDS_BARRIER();
            if (c0 - H1_G >= 0) {
#pragma unroll
                for (int j = 0; j < H1_G; ++j) { const bf16* np = gp + (size_t)(c0 - H1_G - j) * HCH * P1E; rf[j] = *(const v4u*)(np + 512); rv[j] = *(const v4u*)(np + 1024); } }
#pragma unroll
            for (int j = 0; j < H1_G; ++j) {
                const bf16x8_t f8 = cat4(tr_read(L + H1_RF + j * 8704 + (8 * g + q_) * HRS + 32 * w + 8 * p_), tr_read(L + H1_RF + j * 8704 + (8 * g + 4 + q_) * HRS + 32 * w + 8 * p_));
                float eb[8], kk[8]; float cp = 1.0f;
#pragma unroll
                for (int i = 0; i < 8; ++i) { const float sg = __builtin_amdgcn_rcpf(1.0f + __expf(-bfs(f8[i]))); const float f = lbf + oml * sg; kk[i] = oml * (1.0f - sg); cp *= f; eb[i] = cp; }
                const float s1 = shl(cp, n), s2 = shl(cp, 16 + n), s3 = shl(cp, 32 + n), s4 = shl(cp, 48 + n);
                const float pre = (g > 0 ? s1 : 1.0f) * (g > 1 ? s2 : 1.0f) * (g > 2 ? s3 : 1.0f);
                const float elast = ((s1 * s2) * s3) * s4, er = elast * R;
                float kh[8];
#pragma unroll
                for (int i = 0; i < 8; ++i) { const float en = __builtin_amdgcn_rcpf(fmaxf(eb[i] * pre, 1e-30f)); kh[i] = (kk[i] * en) * er; }
                *(LAS v4u*)(L + H1_KH + j * 10240 + d * TRS + 16 * g) = pack8(kh);
                R = er; }
            LDS_BARRIER();
#pragma unroll
            for (int j = 0; j < H1_G; ++j) {
                const bf16x8_t bVn = cat4(tr_read(L + H1_RV + j * 8704 + (8 * g + q_) * HRS + 32 * w + 8 * p_), tr_read(L + H1_RV + j * 8704 + (8 * g + 4 + q_) * HRS + 32 * w + 8 * p_));
#pragma unroll
                for (int kt = 0; kt < 8; ++kt) { const bf16x8_t aKh = *(const LAS bf16x8_t*)(L + H1_KH + j * 10240 + (16 * kt + n) * TRS + 16 * g);
                    S[kt] = __builtin_amdgcn_mfma_f32_16x16x32_bf16(aKh, bVn, S[kt], 0, 0, 0); } }
            LDS_BARRIER();
        }
#pragma unroll
        for (int kt = 0; kt < 8; ++kt) *(f32x4*)(ust + ((((size_t)u * 8 + w) * 8 + kt) * 64 + lane) * 4) = S[kt];
        if (g == 0) dst[(size_t)u * 128 + d] = R;
        __syncthreads();
    }
}

constexpr int SG_V = 0, SG_OB = 34816, SG_OBS = 132, SG_RS = SG_OB + 128 * SG_OBS * 4;
__device__ __forceinline__ void p_sgu(Frame& F, const bf16* P1, const float* norm_w, const float* sgu_w, const float* sgu_b, bf16* yc) {
    LAS unsigned char* L = F.lds;
    const int lane = F.lane, w = F.wave, gq = lane >> 4, n = lane & 15, q_ = n >> 2, p_ = n & 3;
    const int sr = F.tid >> 4, c8 = (F.tid & 15) * 8;
    for (int u = F.bid; u < M / 128; u += F.G) {
        const size_t row0 = (size_t)u * 128;
        v2u_p1 rv[4][4]; float ssj[4] = {0.f, 0.f, 0.f, 0.f};
#pragma unroll
        for (int g = 0; g < 4; ++g)
#pragma unroll
            for (int j = 0; j < 4; ++j) { rv[g][j] = *(const v2u_p1*)((const unsigned char*)P1 + (row0 + sr + 32 * j) * P1_PITCH + P1_OC + 512 + g * 128 + c8); float f[8]; decode8u(rv[g][j], f);
#pragma unroll
                for (int i = 0; i < 8; ++i) ssj[j] += f[i] * f[i]; }
#pragma unroll
        for (int j = 0; j < 4; ++j) { float ss = ssj[j]; ss += shx(ss, 1, lane); ss += shx(ss, 2, lane); ss += shx(ss, 4, lane); ss += shx(ss, 8, lane);
            if (n == 0) *(LAS float*)(L + SG_RS + 4 * (sr + 32 * j)) = 1.0f / sqrtf(ss * (1.0f / 512.0f) + EPS); }
        const int kmax = w >> 1, t = 16 * w + n;
        f32x4 wl[4][2]; float nwl[8];
#define SG_WLOAD(g_) do { _Pragma("unroll") for (int ks = 0; ks < 4; ++ks) { const float* wp = sgu_w + ((size_t)(g_) * 128 + t) * 128 + 32 * ks + 8 * gq; wl[ks][0] = *(const f32x4*)wp; wl[ks][1] = *(const f32x4*)(wp + 4); } \
            _Pragma("unroll") for (int ct = 0; ct < 8; ++ct) nwl[ct] = norm_w[(g_) * 128 + 16 * ct + n]; asm volatile("" ::: "memory"); } while (0)

#pragma unroll
        for (int g = 0; g < 4; ++g) {
            SG_WLOAD(g);
            v2u_p1 ul[4]; float bl[4];
#pragma unroll
            for (int j = 0; j < 4; ++j) { ul[j] = *(const v2u_p1*)((const unsigned char*)P1 + (row0 + sr + 32 * j) * P1_PITCH + P1_OC + g * 128 + c8); bl[j] = sgu_b[g * 128 + sr + 32 * j]; }
            asm volatile("" ::: "memory");
#pragma unroll
            for (int j = 0; j < 4; ++j) { v2u_p1 rw = rv[g][j]; asm volatile("" : "+v"(rw.x), "+v"(rw.y));
                float f[8]; decode8u(rw, f); *(LAS v4u*)(L + SG_V + (sr + 32 * j) * HRS + c8 * 2) = pack8(f); }
            LDS_BARRIER();
            float nwv[8];
            bf16x8_t aW[4];
            {
#pragma unroll
              for (int ct = 0; ct < 8; ++ct) nwv[ct] = nwl[ct];
#pragma unroll
              for (int ks = 0; ks < 4; ++ks) { const int s0 = 32 * ks + 8 * gq;
                    const f32x4 w0 = wl[ks][0], w1 = wl[ks][1]; const f32x4 r0 = *(const LAS f32x4*)(L + SG_RS + 4 * s0), r1 = *(const LAS f32x4*)(L + SG_RS + 4 * (s0 + 4));
                    float a8[8] = {w0.x * r0.x, w0.y * r0.y, w0.z * r0.z, w0.w * r0.w, w1.x * r1.x, w1.y * r1.y, w1.z * r1.z, w1.w * r1.w};
#pragma unroll
                    for (int i = 0; i < 8; ++i) if (s0 + i > t) a8[i] = 0.f;
                    aW[ks] = __builtin_bit_cast(bf16x8_t, pack8(a8)); } }
            f32x4 acc[8];
#pragma unroll
            for (int ct = 0; ct < 8; ++ct) acc[ct] = (f32x4){0.f, 0.f, 0.f, 0.f};
#pragma unroll
            for (int ks = 0; ks < 4; ++ks) { if (ks <= kmax) {
#pragma unroll
                for (int ct = 0; ct < 8; ++ct) { const bf16x8_t bV = cat4(tr_read(L + SG_V + (32 * ks + 8 * gq + q_) * HRS + 32 * ct + 8 * p_), tr_read(L + SG_V + (32 * ks + 8 * gq + 4 + q_) * HRS + 32 * ct + 8 * p_));
                    acc[ct] = __builtin_amdgcn_mfma_f32_16x16x32_bf16(aW[ks], bV, acc[ct], 0, 0, 0); } } }
#pragma unroll
            for (int ct = 0; ct < 8; ++ct) { const float nw = nwv[ct];
#pragma unroll
                for (int j = 0; j < 4; ++j) *(LAS float*)(L + SG_OB + ((16 * w + 4 * gq + j) * SG_OBS + 16 * ct + n) * 4) = acc[ct][j] * nw; }
            LDS_BARRIER();
#pragma unroll
            for (int j = 0; j < 4; ++j) { const int tt = sr + 32 * j; const float bias = bl[j];
                const f32x4 o0 = *(const LAS f32x4*)(L + SG_OB + (tt * SG_OBS + c8) * 4), o1 = *(const LAS f32x4*)(L + SG_OB + (tt * SG_OBS + c8 + 4) * 4);
                float uu[8], y[8]; decode8u(ul[j], uu);
                y[0] = (o0.x + bias) * uu[0]; y[1] = (o0.y + bias) * uu[1]; y[2] = (o0.z + bias) * uu[2]; y[3] = (o0.w + bias) * uu[3];
                y[4] = (o1.x + bias) * uu[4]; y[5] = (o1.y + bias) * uu[5]; y[6] = (o1.z + bias) * uu[6]; y[7] = (o1.w + bias) * uu[7];
                store_y8<Q_BR, 8>(yc, (row0 + tt) * 512 + g * 128 + c8, y, lane, CLIP_YC); }
        }
        __syncthreads();
    }
#undef SG_WLOAD
}

__device__ __forceinline__ void p_norm_router(Frame& F, KArgs ka, const void* x, const float* w, const float* mod_l, bf16* h2) {
    const float* rw = ka->in[20]; const float* rb = ka->in[21]; unsigned* ctl = (unsigned*)(ka->ws + WS_CTL);
    float* topp = (float*)(ka->ws + WS_TOPP); int* list = (int*)(ka->ws + WS_LIST);
    LAS float* RWt = (LAS float*)F.lds;
    LAS int* lcnt = (LAS int*)(RWt + 8192);
    LAS int* lbase = lcnt + 16;
    LAS int* sel = lbase + 16;
    LAS int* rnk = sel + 128;
    unsigned char* aws = ka->ws;
    LAS float* scr = (LAS float*)(F.lds + 40960 + F.wave * 8704);
    const int gw = F.bid * NWAVES + F.wave, NGW = F.G * NWAVES;
    constexpr int I_F1 = (D / 64) * (D_FF / 32), I_F2 = (D_FF / 64) * (D / 32), I_E = 2 * I_F1 + I_F2;
    static_assert(16 * 2048 <= NE * I_E, "every wave has an item for each of its 16 rows");
    const LAS float* qsl = (const LAS float*)(F.lds + TAB_OFF + 3072);
    const float ws_13 = fminf(qsl[0], qsl[1]), ws_2 = qsl[2];
    for (int i = F.tid; i < D * NE; i += NT) { const int k = i >> 3, e = i & 7; RWt[e * D + k] = rw[i]; }
    __syncthreads();
    float rbv[8];
#pragma unroll
    for (int e = 0; e < 8; ++e) rbv[e] = rb[e];
    f32x4 wv[4];
#pragma unroll
    for (int j = 0; j < 4; ++j) wv[j] = ((const f32x4*)w)[F.lane + 64 * j];
    for (int batch = F.bid; batch < M / 128; batch += F.G) {
        const int row0 = batch * 128;
        if (F.tid < 16) lcnt[F.tid] = 0;
        const float* mb = mod_l + (size_t)(row0 >> 12) * MOD_LD;
        f32x4 scv[4], shv[4], xn[4];
#pragma unroll
        for (int j = 0; j < 4; ++j) { scv[j] = ((const f32x4*)(mb + 4 * D))[F.lane + 64 * j]; shv[j] = ((const f32x4*)(mb + 3 * D))[F.lane + 64 * j]; xn[j] = load_x4<true>(x, (size_t)(row0 + F.wave * 16), F.lane, j); }
        asm volatile("" ::: "memory");
#pragma unroll
        for (int j = 0; j < 4; ++j) scv[j] = wv[j] * (scv[j] + 1.0f);
        __syncthreads();
        for (int rr = 0; rr < 16; ++rr) {
            const int r = F.wave * 16 + rr, row = row0 + r;
            float va[32]; const float* src_; int N_, K_, n0_, ro_, fl_; unsigned char* dst_; float ws_;
            CV_DEC_MOE(gw + rr * NGW); cv_load(src_, N_, F.lane, va);
            f32x4 v[4];
#pragma unroll
            for (int j = 0; j < 4; ++j) v[j] = xn[j];
            if (rr + 1 < 16) {
#pragma unroll
                for (int j = 0; j < 4; ++j) xn[j] = load_x4<true>(x, (size_t)(row + 1), F.lane, j); }
            float ssq = 0.f;
#pragma unroll
            for (int j = 0; j < 4; ++j) ssq += (v[j].x * v[j].x + v[j].y * v[j].y) + (v[j].z * v[j].z + v[j].w * v[j].w);
            const float rstd = 1.0f / sqrtf(wave_sum(ssq, F.lane) * (1.0f / D) + EPS);
            f32x4 o[4];
#pragma unroll
            for (int j = 0; j < 4; ++j) o[j] = v[j] * rstd * scv[j] + shv[j];
            { unsigned* o4 = (unsigned*)((unsigned char*)h2 + (size_t)row * D) + F.lane;
#pragma unroll
                for (int j = 0; j < 4; ++j) { const f32x4 q = (Q_MUP == 2) ? rot64(o[j], F.lane) : o[j]; o4[64 * j] = pk4_q<Q_MUP>(q.x * sa_of(Q_MUP, CLIP_MOE), q.y * sa_of(Q_MUP, CLIP_MOE), q.z * sa_of(Q_MUP, CLIP_MOE), q.w * sa_of(Q_MUP, CLIP_MOE)); } }
            float lg[8];
#pragma unroll
            for (int e = 0; e < 8; ++e) { float s = 0.f;
#pragma unroll
                for (int j = 0; j < 4; ++j) { const f32x4 r4 = *(const LAS f32x4*)(RWt + e * D + 4 * F.lane + 256 * j); s += (o[j].x * r4.x + o[j].y * r4.y) + (o[j].z * r4.z + o[j].w * r4.w); }
                lg[e] = wave_sum(s, F.lane) + rbv[e]; }
            int i0 = 0; float v0 = lg[0];
#pragma unroll
            for (int e = 1; e < 8; ++e) if (lg[e] > v0) { v0 = lg[e]; i0 = e; }
            int i1 = -1; float v1 = -3.0e38f;
#pragma unroll
            for (int e = 0; e < 8; ++e) if (e != i0 && lg[e] > v1) { v1 = lg[e]; i1 = e; }
            if (F.lane == 0) {
                const float p0 = 1.0f / (1.0f + expf(v1 - v0));
                topp[(size_t)row * 2] = p0; topp[(size_t)row * 2 + 1] = 1.0f - p0;
                const int rk0 = __hip_atomic_fetch_add(lcnt + i0, 1, __ATOMIC_RELAXED, __HIP_MEMORY_SCOPE_WORKGROUP), rk1 = __hip_atomic_fetch_add(lcnt + 8 + i1, 1, __ATOMIC_RELAXED, __HIP_MEMORY_SCOPE_WORKGROUP);
                sel[r] = i0 | (i1 << 8); rnk[r] = rk0 | (rk1 << 16);
            }
            cv_store(va, dst_, K_, n0_, ro_, fl_, ws_, scr, F.lane);
        }
        __syncthreads();
        if (F.tid < 16) lbase[F.tid] = (int)__hip_atomic_fetch_add(ctl + CW_CNT + 64 * F.tid, (unsigned)lcnt[F.tid], __ATOMIC_RELAXED, __HIP_MEMORY_SCOPE_AGENT);
        __syncthreads();
        if (F.tid < 128) { const int sv = sel[F.tid], rv = rnk[F.tid]; const int e0 = sv & 255, e1 = sv >> 8;
            list[(size_t)e0 * LIST_CAP + lbase[e0] + (rv & 0xffff)] = row0 + F.tid;
            list[(size_t)(8 + e1) * LIST_CAP + lbase[8 + e1] + (rv >> 16)] = row0 + F.tid; }
        __syncthreads();
    }
    CV_PIPE(gw + 16 * NGW, NE * I_E, CV_DEC_MOE);
}
#undef CV_DEC_MOE
__device__ __forceinline__ void moe_tables(Frame& F, unsigned* ctl, int pass) {
    LAS int* tab = (LAS int*)(F.lds + TAB_OFF) + pass * 256;
    __syncthreads();
    if (F.tid < 8) { int c = (int)__hip_atomic_load(ctl + CW_CNT + 64 * (pass * 8 + F.tid), __ATOMIC_RELAXED, __HIP_MEMORY_SCOPE_AGENT); if (c > LIST_CAP) c = LIST_CAP; if (c < 0) c = 0; tab[F.tid] = c; }
    __syncthreads();
    if (F.tid == 0) { int pb = 0;
        for (int e = 0; e < 8; ++e) { const int c = tab[e]; const int np = (c + 255) >> 8; tab[8 + e] = pb; for (int p = 0; p < np; ++p) tab[32 + pb + p] = e; pb += np; }
        tab[16] = pb; }
    __syncthreads();
}
template <bool GATHER_>
struct MoeOrder {
    static constexpr bool GATHER = GATHER_;
    pg8::StaticOrder so; const LAS int* tab; const int* list; int npn; unsigned rowbytes;
    int pm0 = 0;
    int T = 0, HC = 0;
    __device__ __forceinline__ bool next(int i, pg8::Unit& u) const {
        const int G = so.G, c = so.c; long L;
        if (T == 0) L = (long)i * G + c;
        else if (c >= T) L = (i < HC) ? (long)i * (G - T) + (c - T) : (long)HC * (G - T) + (long)(i - HC) * G + c;
        else L = (long)HC * (G - T) + (long)i * G + c;
        if (!so.unit_of(L, u)) return false; u.pm += pm0; u.pb = tab[32 + u.pm] * npn + u.pn; return true; }
    __device__ __forceinline__ int tok_of(int pm, int r) const { const int e = tab[32 + pm]; const int idx = (pm - tab[8 + e]) * 256 + r; return idx < tab[e] ? list[(size_t)e * LIST_CAP + idx] : -1; }
    __device__ __forceinline__ unsigned a_row_off(const pg8::Unit& u, int r) const { const int t = tok_of(u.pm, r); return (unsigned)(t < 0 ? 0 : t) * rowbytes; }
};

#ifndef WIDE_ST
#define WIDE_ST 1
#endif
typedef unsigned v2u_t __attribute__((ext_vector_type(2)));
__device__ __forceinline__ v4u pair16(const v2u_t a, const v2u_t b) {
    const auto rx = __builtin_amdgcn_permlane16_swap(a.x, b.x, false, false); const auto ry = __builtin_amdgcn_permlane16_swap(a.y, b.y, false, false);
    return (v4u){rx[0], ry[0], rx[1], ry[1]};
}
template <int Q>
struct EpiP1 {
    static constexpr bool PERM = true;
    unsigned char* O; float scale;
    __device__ __forceinline__ void operator()(const pg8::f32x4 (&acc)[2][2][4][2], const pg8::Unit& u, int wr, int wc, int fr, int fq) const {
        const int row0 = u.pm * 256 + wr * 64 + fr, colt = u.pn * 256;
        if (u.pn >= 6 && u.pn < 14) {
            unsigned char* base = O + P1_OB + (size_t)(colt - 1536 + wc * 32 + 8 * fq) * 2;
#pragma unroll
            for (int ai = 0; ai < 2; ++ai)
#pragma unroll
                for (int m = 0; m < 4; ++m) { unsigned char* rowp = base + (size_t)(row0 + ai * 128 + m * 16) * P1_PITCH;
#pragma unroll
                    for (int bj = 0; bj < 2; ++bj) { pg8::f32x4 v0 = acc[ai][bj][m][0], v1 = acc[ai][bj][m][1];
                        if constexpr (Q == 2) { v0 = __builtin_convertvector(__builtin_bit_cast(pg8::v4i32_, v0), pg8::f32x4); v1 = __builtin_convertvector(__builtin_bit_cast(pg8::v4i32_, v1), pg8::f32x4); }
                        v0 *= scale; v1 *= scale;
                        v4u w; w.x = pk2(v0[0], v0[1]); w.y = pk2(v0[2], v0[3]); w.z = pk2(v1[0], v1[1]); w.w = pk2(v1[2], v1[3]);
                        *(v4u*)(rowp + bj * 256) = w; } }
        } else {
            unsigned char* base = O + (u.pn < 6 ? colt : P1_OC + colt - 3584) + wc * 32 + 8 * fq;
            const float qs = scale * (127.0f / CLIP_P1); constexpr float MGO = 12582912.0f + 128.0f;
#pragma unroll
            for (int ai = 0; ai < 2; ++ai)
#pragma unroll
                for (int m = 0; m < 4; ++m) { unsigned char* rowp = base + (size_t)(row0 + ai * 128 + m * 16) * P1_PITCH; v2u_t wb[2];
#pragma unroll
                    for (int bj = 0; bj < 2; ++bj)
#pragma unroll
                        for (int n = 0; n < 2; ++n) { const pg8::f32x4 v = acc[ai][bj][m][n]; unsigned ub[4];
#pragma unroll
                            for (int i = 0; i < 4; ++i) ub[i] = __float_as_uint(__builtin_amdgcn_fmed3f(accf<Q>(v[i]) * qs + MGO, MGO - 127.0f, MGO + 127.0f));
                            const unsigned pk = __builtin_amdgcn_perm(__builtin_amdgcn_perm(ub[3], ub[2], 0x0c0c0400u), __builtin_amdgcn_perm(ub[1], ub[0], 0x0c0c0400u), 0x05040100u);
                            if (n == 0) wb[bj].x = pk; else wb[bj].y = pk; }
                    *(v4u*)(rowp + ((fq & 1) ? 128 - 8 : 0)) = pair16(wb[0], wb[1]); } }
    }
};
template <bool GU8, int QB = 0, int QM = 0>
struct EpiBranch {
    static constexpr bool PERM = true;
    const bf16* gate; bf16* mrg; const float* qsb; unsigned char* mrg8;
    __device__ __forceinline__ void operator()(const pg8::f32x4 (&acc)[2][2][4][2], const pg8::Unit& u, int wr, int wc, int fr, int fq) const {
        typedef unsigned v2u_ __attribute__((ext_vector_type(2)));
        const int row0 = u.pm * 256 + wr * 64 + fr, col0 = u.pn * 256 + wc * 32 + 8 * fq + u.aux * D;
        const int first = (u.aux == 0), mshift = u.aux * D;
        const float bsc = (u.aux == 0 ? CLIP_YA : (u.aux == 1 ? CLIP_YB : CLIP_YC)) / (127.0f * (QB == 2 ? qsb[u.aux] : 1.0f));
        v4u gl[2][2][2], ml[2][2][2];
#define EB_LOAD(q) do { _Pragma("unroll") for (int mm_ = 0; mm_ < 2; ++mm_) _Pragma("unroll") for (int bj = 0; bj < 2; ++bj) { \
            const size_t row = (size_t)(row0 + ((q) >> 1) * 128 + (((q) & 1) * 2 + mm_) * 16); const int col = col0 + bj * 128; \
            if constexpr (GU8) { const v2u_ g2 = *(const v2u_*)((const unsigned char*)gate + row * N_G + col); gl[(q) & 1][mm_][bj].x = g2.x; gl[(q) & 1][mm_][bj].y = g2.y; } else gl[(q) & 1][mm_][bj] = *(const v4u*)(gate + row * N_G + col); \
            ml[(q) & 1][mm_][bj] = first ? (v4u){0u, 0u, 0u, 0u} : *(const v4u*)(mrg + row * D + col - mshift); } asm volatile("" ::: "memory"); } while (0)
        EB_LOAD(0);
#pragma unroll
        for (int q = 0; q < 4; ++q) {
            if (q < 3) EB_LOAD(q + 1);
            const int ai = q >> 1;
#pragma unroll
            for (int mm_ = 0; mm_ < 2; ++mm_)
#pragma unroll
                for (int bj = 0; bj < 2; ++bj) { const int m = (q & 1) * 2 + mm_; const size_t row = (size_t)(row0 + ai * 128 + m * 16); const int col = col0 + bj * 128;
                    float gg[8], mm[8], o[8]; unpack8(ml[q & 1][mm_][bj], mm);
                    if constexpr (GU8) {
#pragma unroll
                        for (int i = 0; i < 4; ++i) { gg[i] = (float)((gl[q & 1][mm_][bj].x >> (8 * i)) & 0xffu) * (1.0f / 255.0f); gg[4 + i] = (float)((gl[q & 1][mm_][bj].y >> (8 * i)) & 0xffu) * (1.0f / 255.0f); } }
                    else { unpack8(gl[q & 1][mm_][bj], gg);
#pragma unroll
                        for (int i = 0; i < 8; ++i) gg[i] = sigmoidf_(gg[i]); }
                    pg8::f32x4 v0 = acc[ai][bj][m][0], v1 = acc[ai][bj][m][1];
                    if constexpr (QB == 2) { v0 = __builtin_convertvector(__builtin_bit_cast(pg8::v4i32_, v0), pg8::f32x4) * bsc; v1 = __builtin_convertvector(__builtin_bit_cast(pg8::v4i32_, v1), pg8::f32x4) * bsc; }
                    o[0] = mm[0] + gg[0] * v0[0]; o[1] = mm[1] + gg[1] * v0[1]; o[2] = mm[2] + gg[2] * v0[2]; o[3] = mm[3] + gg[3] * v0[3];
                    o[4] = mm[4] + gg[4] * v1[0]; o[5] = mm[5] + gg[5] * v1[1]; o[6] = mm[6] + gg[6] * v1[2]; o[7] = mm[7] + gg[7] * v1[3];
                    if (QM == 2 && u.aux == 2) { fwht8(o); constexpr float s = 0.35355339f * 127.0f / CLIP_MRG; v2u_ w8; w8.x = pk4_q<2>(o[0] * s, o[1] * s, o[2] * s, o[3] * s); w8.y = pk4_q<2>(o[4] * s, o[5] * s, o[6] * s, o[7] * s);
                        *(v2u_*)(mrg8 + row * D + col - mshift) = w8; }
                    else *(v4u*)(mrg + row * D + col - mshift) = pack8(o); }
            asm volatile("" ::: "memory");
        }
#undef EB_LOAD
    }
};
#ifndef CLIP_PART1
#define CLIP_PART1 2.5f
#endif
#ifndef CLIP_PART2
#define CLIP_PART2 5.0f
#endif
__device__ __forceinline__ unsigned pk4_ob(float a, float b, float c, float d) {
    constexpr float MGO = 12582912.0f + 128.0f;
    const unsigned ua = __float_as_uint(__builtin_amdgcn_fmed3f(a + MGO, MGO - 127.0f, MGO + 127.0f)), ub = __float_as_uint(__builtin_amdgcn_fmed3f(b + MGO, MGO - 127.0f, MGO + 127.0f));
    const unsigned uc = __float_as_uint(__builtin_amdgcn_fmed3f(c + MGO, MGO - 127.0f, MGO + 127.0f)), ud = __float_as_uint(__builtin_amdgcn_fmed3f(d + MGO, MGO - 127.0f, MGO + 127.0f));
    return __builtin_amdgcn_perm(__builtin_amdgcn_perm(ud, uc, 0x0c0c0400u), __builtin_amdgcn_perm(ub, ua, 0x0c0c0400u), 0x05040100u);
}
template <int QB>
struct EpiBranch8 {
    static constexpr bool PERM = true;
    const unsigned char* gate; const float* qsb; unsigned char* mrg8;
    __device__ __forceinline__ void operator()(const pg8::f32x4 (&acc)[2][2][4][2], const pg8::Unit& u, int wr, int wc, int fr, int fq) const {
        const int row0 = u.pm * 256 + wr * 64 + fr, col0 = u.pn * 256 + wc * 32 + 8 * fq + u.aux * D;
        const int first = (u.aux == 1), last = (u.aux == 0), mshift = u.aux * D;
        const float bsc = (u.aux == 0 ? CLIP_YA : (u.aux == 1 ? CLIP_YB : CLIP_YC)) / (127.0f * (QB == 2 ? qsb[u.aux] : 1.0f));
        const float din = (u.aux == 2 ? CLIP_PART1 : CLIP_PART2) * (1.0f / 127.0f), dinb = -128.0f * din;
        const float sout = 127.0f / (u.aux == 1 ? CLIP_PART1 : CLIP_PART2);
        const int sto = (fq & 1) ? 128 - 8 : 0;
        v2u_t gl[2][2][2], ml[2][2][2];
#define EB_LOAD(q) do { _Pragma("unroll") for (int mm_ = 0; mm_ < 2; ++mm_) _Pragma("unroll") for (int bj = 0; bj < 2; ++bj) { \
            const size_t row = (size_t)(row0 + ((q) >> 1) * 128 + (((q) & 1) * 2 + mm_) * 16); const int col = col0 + bj * 128; \
            gl[(q) & 1][mm_][bj] = *(const v2u_t*)(gate + row * N_G + col); \
            ml[(q) & 1][mm_][bj] = first ? (v2u_t){0x80808080u, 0x80808080u} : *(const v2u_t*)(mrg8 + row * D + col - mshift); } asm volatile("" ::: "memory"); } while (0)
        EB_LOAD(0);
#pragma unroll
        for (int q = 0; q < 4; ++q) {
            if (q < 3) EB_LOAD(q + 1);
            const int ai = q >> 1;
#pragma unroll
            for (int mm_ = 0; mm_ < 2; ++mm_) { const int m = (q & 1) * 2 + mm_; const size_t row = (size_t)(row0 + ai * 128 + m * 16); v2u_t wb[2];
#pragma unroll
                for (int bj = 0; bj < 2; ++bj) { float gg[8], mm[8], o[8];
#pragma unroll
                    for (int i = 0; i < 4; ++i) { gg[i] = (float)((gl[q & 1][mm_][bj].x >> (8 * i)) & 0xffu) * (1.0f / 255.0f); gg[4 + i] = (float)((gl[q & 1][mm_][bj].y >> (8 * i)) & 0xffu) * (1.0f / 255.0f);
                        mm[i] = (float)((ml[q & 1][mm_][bj].x >> (8 * i)) & 0xffu) * din + dinb; mm[4 + i] = (float)((ml[q & 1][mm_][bj].y >> (8 * i)) & 0xffu) * din + dinb; }
                    pg8::f32x4 v0 = acc[ai][bj][m][0], v1 = acc[ai][bj][m][1];
                    if constexpr (QB == 2) { v0 = __builtin_convertvector(__builtin_bit_cast(pg8::v4i32_, v0), pg8::f32x4) * bsc; v1 = __builtin_convertvector(__builtin_bit_cast(pg8::v4i32_, v1), pg8::f32x4) * bsc; }
                    o[0] = mm[0] + gg[0] * v0[0]; o[1] = mm[1] + gg[1] * v0[1]; o[2] = mm[2] + gg[2] * v0[2]; o[3] = mm[3] + gg[3] * v0[3];
                    o[4] = mm[4] + gg[4] * v1[0]; o[5] = mm[5] + gg[5] * v1[1]; o[6] = mm[6] + gg[6] * v1[2]; o[7] = mm[7] + gg[7] * v1[3];
                    if (last) { fwht8(o); constexpr float s = 0.35355339f * 127.0f / CLIP_MRG; wb[bj].x = pk4_q<2>(o[0] * s, o[1] * s, o[2] * s, o[3] * s); wb[bj].y = pk4_q<2>(o[4] * s, o[5] * s, o[6] * s, o[7] * s); }
                    else { wb[bj].x = pk4_ob(o[0] * sout, o[1] * sout, o[2] * sout, o[3] * sout); wb[bj].y = pk4_ob(o[4] * sout, o[5] * sout, o[6] * sout, o[7] * sout); } }
                *(v4u*)(mrg8 + row * D + col0 - mshift + sto) = pair16(wb[0], wb[1]); }
            asm volatile("" ::: "memory");
        }
#undef EB_LOAD
    }
};
template <int Q>
struct EpiGateU8 {
    static constexpr bool PERM = true;
    unsigned char* O; float scale;
    __device__ __forceinline__ void operator()(const pg8::f32x4 (&acc)[2][2][4][2], const pg8::Unit& u, int wr, int wc, int fr, int fq) const {
        typedef unsigned v2u_ __attribute__((ext_vector_type(2)));
        const int row0 = u.pm * 256 + wr * 64 + fr, col0 = u.pn * 256 + wc * 32 + 8 * fq;
        const float nsl2 = -1.44269504f * scale;
#pragma unroll
        for (int ai = 0; ai < 2; ++ai)
#pragma unroll
            for (int m = 0; m < 4; ++m) { unsigned char* rowp = O + (size_t)(row0 + ai * 128 + m * 16) * N_G + col0;
                v2u_ wb[2];
#pragma unroll
                for (int bj = 0; bj < 2; ++bj) { v2u_ w;
#pragma unroll
                    for (int n = 0; n < 2; ++n) { const pg8::f32x4 v = acc[ai][bj][m][n]; unsigned ub[4];
#pragma unroll
                        for (int i = 0; i < 4; ++i) ub[i] = __float_as_uint(__builtin_amdgcn_rcpf(1.0f + __builtin_amdgcn_exp2f(accf<Q>(v[i]) * nsl2)) * 255.0f + 12582912.0f);
                        const unsigned p = __builtin_amdgcn_perm(__builtin_amdgcn_perm(ub[3], ub[2], 0x0c0c0400u), __builtin_amdgcn_perm(ub[1], ub[0], 0x0c0c0400u), 0x05040100u);
                        if (n == 0) w.x = p; else w.y = p; }
                    wb[bj] = w; }
                if (WIDE_ST) *(v4u*)(rowp + ((fq & 1) ? 128 - 8 : 0)) = pair16(wb[0], wb[1]);
                else { *(v2u_*)rowp = wb[0]; *(v2u_*)(rowp + 128) = wb[1]; } }
    }
};
template <bool IN_F32, int QI = 0>
struct EpiResid {
    static constexpr bool PERM = true;
    const void* xin; bf16* xout; const float* gmod; float onum, oden;
    __device__ __forceinline__ void operator()(const pg8::f32x4 (&acc)[2][2][4][2], const pg8::Unit& u, int wr, int wc, int fr, int fq) const {
        const int row0 = u.pm * 256 + wr * 64 + fr, col0 = u.pn * 256 + wc * 32 + 8 * fq;
        const float* gb = gmod + (size_t)((u.pm * 256) >> 12) * MOD_LD + col0;
        float od_ = oden; asm volatile("" : "+s"(od_)); const float oscale = onum / od_;
        pg8::f32x4 gv[2][2];
#pragma unroll
        for (int bj = 0; bj < 2; ++bj)
#pragma unroll
            for (int n = 0; n < 2; ++n) gv[bj][n] = *(const pg8::f32x4*)(gb + bj * 128 + n * 4) * oscale;
        constexpr int NB = 2;
#pragma unroll
        for (int b = 0; b < NB; ++b) {
            pg8::f32x4 xl[2 / NB][4][2][2];
#pragma unroll
            for (int a = 0; a < 2 / NB; ++a)
#pragma unroll
            for (int m = 0; m < 4; ++m)
#pragma unroll
                for (int bj = 0; bj < 2; ++bj) { const int ai = b * (2 / NB) + a; const size_t row = (size_t)(row0 + ai * 128 + m * 16); const int col = col0 + bj * 128;
                    if constexpr (IN_F32) { xl[a][m][bj][0] = *(const pg8::f32x4*)((const float*)xin + row * D + col); xl[a][m][bj][1] = *(const pg8::f32x4*)((const float*)xin + row * D + col + 4); }
                    else { const v4u w = *(const v4u*)((const bf16*)xin + row * XLD + col); xl[a][m][bj][0] = __builtin_bit_cast(pg8::f32x4, w); } }
            asm volatile("" ::: "memory");
#pragma unroll
            for (int a = 0; a < 2 / NB; ++a)
#pragma unroll
            for (int m = 0; m < 4; ++m)
#pragma unroll
                for (int bj = 0; bj < 2; ++bj) { const int ai = b * (2 / NB) + a; const size_t row = (size_t)(row0 + ai * 128 + m * 16); const int col = col0 + bj * 128;
                    pg8::f32x4 x0, x1;
                    if constexpr (IN_F32) { x0 = xl[a][m][bj][0]; x1 = xl[a][m][bj][1]; }
                    else { const v4u w = __builtin_bit_cast(v4u, xl[a][m][bj][0]); x0 = (pg8::f32x4){bf_lo(w.x), bf_hi(w.x), bf_lo(w.y), bf_hi(w.y)}; x1 = (pg8::f32x4){bf_lo(w.z), bf_hi(w.z), bf_lo(w.w), bf_hi(w.w)}; }
                    pg8::f32x4 c0 = acc[ai][bj][m][0], c1 = acc[ai][bj][m][1];
                    if constexpr (QI == 2) {
#pragma unroll
                        for (int i = 0; i < 4; ++i) { c0[i] = (float)__float_as_int(c0[i]); c1[i] = (float)__float_as_int(c1[i]); } }
                    const pg8::f32x4 o0 = x0 + gv[bj][0] * c0, o1 = x1 + gv[bj][1] * c1;
                    v4u w; w.x = pk2(o0[0], o0[1]); w.y = pk2(o0[2], o0[3]); w.z = pk2(o1[0], o1[1]); w.w = pk2(o1[2], o1[3]);
                    *(v4u*)(xout + row * XLD + col) = w; }
            asm volatile("" ::: "memory");
        }
    }
};
template <int QIN = 0, int QOUT = 0>
struct EpiSwiglu {
    static constexpr bool PERM = true;
    bf16* act; float inv;
    __device__ __forceinline__ void operator()(const pg8::f32x4 (&acc)[2][2][4][2], const pg8::Unit& u, int wr, int wc, int fr, int fq) const {
        const int row0 = u.pm * 256 + wr * 64 + fr, col0 = u.pn * 128 + wc * 32 + 8 * fq;
        v2u_t wprev = {0u, 0u};
        const float invq = QIN ? inv : 1.0f, inv2 = invq * invq, nil2 = -1.44269504f * invq;
#pragma unroll
        for (int ai = 0; ai < 2; ++ai)
#pragma unroll
            for (int m = 0; m < 4; ++m) { float o[8];
#pragma unroll
                for (int n = 0; n < 2; ++n)
#pragma unroll
                    for (int i = 0; i < 4; ++i) { const float c1 = accf<QIN>(acc[ai][0][m][n][i]), c3 = accf<QIN>(acc[ai][1][m][n][i]);
                        o[n * 4 + i] = (c1 * c3) * __builtin_amdgcn_rcpf(1.0f + __builtin_amdgcn_exp2f(c1 * nil2)); }
                if constexpr (QOUT != 0) { typedef unsigned v2u_ __attribute__((ext_vector_type(2))); v2u_ w8;
                    if constexpr (QOUT == 2) { fwht8(o); const float s = 0.35355339f * 127.0f / CLIP_ACT * inv2; w8.x = pk4_q<2>(o[0] * s, o[1] * s, o[2] * s, o[3] * s); w8.y = pk4_q<2>(o[4] * s, o[5] * s, o[6] * s, o[7] * s); }
                    else { const float s = F8_SACT * inv2; w8.x = pk4_q<1>(o[0] * s, o[1] * s, o[2] * s, o[3] * s); w8.y = pk4_q<1>(o[4] * s, o[5] * s, o[6] * s, o[7] * s); }
                    if (WIDE_ST) { if (m & 1) *(v4u*)((unsigned char*)act + (size_t)(row0 + ai * 128 + (m - 1 + (fq & 1)) * 16) * D_FF + col0 - (fq & 1) * 8) = pair16(wprev, w8);
                        else wprev = w8; }
                    else *(v2u_*)((unsigned char*)act + (size_t)(row0 + ai * 128 + m * 16) * D_FF + col0) = w8; }
                else {
#pragma unroll
                    for (int i = 0; i < 8; ++i) o[i] *= inv2;
                    *(v4u*)(act + (size_t)(row0 + ai * 128 + m * 16) * D_FF + col0) = pack8(o); } }
    }
};
struct EpiMoeDown {
    static constexpr bool PERM = true;
    bf16* x; const float* gmod; const float* topp; int pass; const LAS int* tab; const int* list; float oscale;
    bf16* y1; unsigned char* flag; int y1mode;
    __device__ __forceinline__ int tok_of(int pm, int r) const { const int e = tab[32 + pm]; const int idx = (pm - tab[8 + e]) * 256 + r; return idx < tab[e] ? list[(size_t)e * LIST_CAP + idx] : -1; }
    __device__ __forceinline__ void operator()(const pg8::f32x4 (&acc)[2][2][4][2], const pg8::Unit& u, int wr, int wc, int fr, int fq) const {
        const int col0 = u.pn * 256 + wc * 32 + 8 * fq;
        int tok[2][4];
#pragma unroll
        for (int ai = 0; ai < 2; ++ai)
#pragma unroll
            for (int m = 0; m < 4; ++m) tok[ai][m] = tok_of(u.pm, ai * 128 + wr * 64 + m * 16 + fr);
        asm volatile("" ::: "memory");
#pragma unroll
        for (int am = 0; am < 4; ++am) {
            const int ai = am >> 1, mb = (am & 1) * 2;
            v4u xl[2][2]; pg8::f32x4 gl[2][2][2]; float pv[2];
#pragma unroll
            for (int m = 0; m < 2; ++m) { const int t = tok[ai][mb + m] < 0 ? 0 : tok[ai][mb + m]; pv[m] = topp[(size_t)t * 2 + pass] * oscale; const float* gb = gmod + (size_t)(t >> 12) * MOD_LD + col0;
#pragma unroll
                for (int bj = 0; bj < 2; ++bj) { xl[m][bj] = *(const v4u*)(x + (size_t)t * XLD + col0 + bj * 128);
#pragma unroll
                    for (int n = 0; n < 2; ++n) gl[m][bj][n] = *(const pg8::f32x4*)(gb + bj * 128 + n * 4); } }
            asm volatile("" ::: "memory");
#pragma unroll
            for (int m = 0; m < 2; ++m) { if (tok[ai][mb + m] >= 0) { const int t = tok[ai][mb + m];
                if (y1mode) flag[t] = 1;
#pragma unroll
                for (int bj = 0; bj < 2; ++bj) { const v4u w = y1mode ? (v4u){0u, 0u, 0u, 0u} : xl[m][bj];
                    const pg8::f32x4 x0 = {bf_lo(w.x), bf_hi(w.x), bf_lo(w.y), bf_hi(w.y)}, x1 = {bf_lo(w.z), bf_hi(w.z), bf_lo(w.w), bf_hi(w.w)};
                    pg8::f32x4 c0 = acc[ai][bj][mb + m][0], c1 = acc[ai][bj][mb + m][1];
                    if constexpr (Q_MDN == 2) { c0 = __builtin_convertvector(__builtin_bit_cast(pg8::v4i32_, c0), pg8::f32x4); c1 = __builtin_convertvector(__builtin_bit_cast(pg8::v4i32_, c1), pg8::f32x4); }
                    const pg8::f32x4 o0 = x0 + gl[m][bj][0] * pv[m] * c0, o1 = x1 + gl[m][bj][1] * pv[m] * c1;
                    v4u r; r.x = pk2(o0[0], o0[1]); r.y = pk2(o0[2], o0[3]); r.z = pk2(o1[0], o1[1]); r.w = pk2(o1[2], o1[3]);
                    if (y1mode) *(v4u*)(y1 + (size_t)t * D + col0 + bj * 128) = r; else *(v4u*)(x + (size_t)t * XLD + col0 + bj * 128) = r; } } }
            asm volatile("" ::: "memory");
        }
    }
};

__device__ __forceinline__ void p_final_norm(Frame& F, float* x, const float* w, const bf16* y1, const unsigned char* flag) {
    const int gw = F.bid * NWAVES + F.wave, NGW = F.G * NWAVES, lane = F.lane;
    f32x4 wv[4];
#pragma unroll
    for (int j = 0; j < 4; ++j) wv[j] = ((const f32x4*)w)[lane + 64 * j];
    for (int r0 = gw * 4; r0 < M; r0 += NGW * 4) {
        f32x4 v[4][4];
#pragma unroll
        for (int r = 0; r < 4; ++r)
#pragma unroll
            for (int j = 0; j < 4; ++j) v[r][j] = load_x4<true>(x, (size_t)(r0 + r), lane, j);
#pragma unroll
        for (int r = 0; r < 4; ++r) if (flag[r0 + r]) {
#pragma unroll
            for (int j = 0; j < 4; ++j) { const v2u_p1 yw = ((const v2u_p1*)(y1 + (size_t)(r0 + r) * D))[lane + 64 * j]; v[r][j] += (f32x4){bf_lo(yw.x), bf_hi(yw.x), bf_lo(yw.y), bf_hi(yw.y)}; } }
        asm volatile("s_waitcnt vmcnt(0)" ::: "memory");
#pragma unroll
        for (int r = 0; r < 4; ++r) { float s = 0.f;
#pragma unroll
            for (int j = 0; j < 4; ++j) s += (v[r][j].x * v[r][j].x + v[r][j].y * v[r][j].y) + (v[r][j].z * v[r][j].z + v[r][j].w * v[r][j].w);
            const float rstd = 1.0f / sqrtf(wave_sum(s, lane) * (1.0f / D) + EPS);
#pragma unroll
            for (int j = 0; j < 4; ++j) ((f32x4*)(x + (size_t)(r0 + r) * D))[lane + 64 * j] = v[r][j] * rstd * wv[j]; }
    }
}
__device__ __forceinline__ bool fresh(Frame& F) {
    int w_ = F.w0, b_ = blockIdx.x, g_ = gridDim.x; asm volatile("" : "+s"(w_), "+s"(b_), "+s"(g_));
    int l_; asm volatile("v_mbcnt_lo_u32_b32 %0, -1, 0\n\tv_mbcnt_hi_u32_b32 %0, -1, %0" : "=v"(l_));
    int t_ = w_ * 64 + l_;
    F.tid = t_; F.lane = t_ & 63; F.wave = __builtin_amdgcn_readfirstlane(t_ >> 6); F.bid = b_; F.G = g_; return true;
}
constexpr int NPL = 13, NPHASE = 1 + DEPTH * NPL;
#if MK_PER_PHASE
#define GRID_BAR() do { } while (0)
#else
#define GRID_BAR() do { XcdBarrier b2_ = bar; asm volatile("" : "+s"(b2_.bar)); xcd_barrier(b2_); } while (0)
#endif
#ifdef ONLY_REL
#define IN(k) (KA()->ph_lo <= (k) && (k) < KA()->ph_hi && fresh(F) && ((k) == 0 ? 100 : ((k) - 1) % NPL) == ONLY_REL && (ONLY_L < 0 || ((k) - 1) / NPL == ONLY_L))
#else
#define IN(k) (KA()->ph_lo <= (k) && (k) < KA()->ph_hi && fresh(F))
#endif
#define SEAM(k) do { if ((k) + 1 < KA()->ph_hi) GRID_BAR(); } while (0)
template <int l>
__device__ __forceinline__ void layer_program(Frame& F, const XcdBarrier& bar, PG8_LAS unsigned char* ring) {
        const int pb = 1 + l * NPL;
#define WSP(off) (ka->ws + (off))
#define QSV(slot) (((const float*)WSP(WS_QS))[slot])
#define MODL ((const float*)WSP(WS_MOD) + (size_t)l * BATCH * MOD_LD)
#define WMIXL ((bf16*)WSP(WS_WMIX))
        if (IN(pb + 0)) {
#pragma unroll 1
          for (int rep = 0; rep < REPS(7); ++rep) { KArgs ka = KA(); p_norm<HQ_MIX == 0 ? 0 : (H_BF ? 2 : 1), l != 0, HQ_MIX ? HQ_MIX : 2>(F, l == 0 ? (const void*)ka->in[0] : (const void*)ka->out, ka->in[4] + l * D, MODL, 1 * D, 0, (HQ_MIX && !H_BF) ? (bf16*)WSP(WS_H8) : (bf16*)WSP(WS_H), WSP(WS_H8), sa_of(HQ_MIX, l == 0 ? CLIP_MIX0 : CLIP_MIX1)); }
          SEAM(pb + 0); }
        if (IN(pb + 1)) {
            KArgs ka = KA();
            constexpr int KD = Q_PROJ ? D / 2 : D;
            pg8::Gemm g{Q_PROJ ? (bf16*)WSP(WS_H8) : (bf16*)WSP(WS_H), WMIXL, KD, KD, KD}; pg8::StaticOrder S; S.init(M / 256, N_BCA / 256, F.G, F.bid);
            EpiP1<Q_PROJ> E{WSP(WS_P1), uni((Q_PROJ ? 1.0f / (sa_of(Q_PROJ, l == 0 ? CLIP_MIX0 : CLIP_MIX1) * (Q_PROJ == 2 ? QSV(QS_IN) : F8_SW)) : 1.0f) / (float)REPS(8) / (float)REPS(15))};
#pragma unroll 1
            for (int rep = 0; rep < REPS(3); ++rep)
            { stagger_wait(F.bid, 10); pg8::gemm_phase<REPS(8), Q_PROJ, REPS(15)>(ring, g, S, E, F.tid); } SEAM(pb + 1);
        }
        if (IN(pb + 2)) {
#define THIN_H1() { KArgs ka = KA(); p_hgrn1(F, (const bf16*)WSP(WS_P1), ka->in[8], l, (float*)WSP(WS_HU), (float*)WSP(WS_HD)); }
#define THIN_SC() { { KArgs ka = KA(); p_sgu(F, (const bf16*)WSP(WS_P1), ka->in[10] + l * D_C, ka->in[11] + (size_t)l * 4 * 128 * 128, ka->in[12] + l * 4 * 128, (bf16*)WSP(WS_YC)); } \
                    { KArgs ka = KA(); p_conv(F, (const bf16*)WSP(WS_P1), ka->in[7] + l * 3 * D_A, (bf16*)WSP(WS_YA)); } }
#pragma unroll 1
          for (int rep = 0; rep < REPS(1); ++rep) {
            __syncthreads();
            if ((F.bid >> 3) & 1) { THIN_H1(); __syncthreads(); fresh(F); THIN_SC(); }
            else { THIN_SC(); __syncthreads(); fresh(F); THIN_H1(); }
          }
#undef THIN_H1
#undef THIN_SC
            SEAM(pb + 2);
        }
        if (IN(pb + 3)) {
#pragma unroll 1
          for (int rep = 0; rep < REPS(2); ++rep)
            { KArgs ka = KA(); p_hgrn<2>(F, (const bf16*)WSP(WS_P1), ka->in[8], l, ka->in[9] + l * D_BV, (bf16*)WSP(WS_YB), (float*)WSP(WS_HU), (float*)WSP(WS_HD)); }
            SEAM(pb + 3);
        }
        if (IN(pb + 5)) {
            { KArgs ka = KA();
              pg8::GateOrder S; S.so.init(M / 256, D / 256, F.G, F.bid);
              if constexpr (Q_GATE != 0) { pg8::Gemm g{(bf16*)WSP(WS_H8), (bf16*)WSP(WS_WMIX + WMIX_G8), D / 2, D / 2, D / 2};
                  EpiGateU8<Q_GATE> E{(unsigned char*)WSP(WS_PG), uni(1.0f / (sa_of(Q_GATE, l == 0 ? CLIP_MIX0 : CLIP_MIX1) * (Q_GATE == 2 ? QSV(QS_IN) : F8_SW)))};
                  pg8::gemm_phase<1, Q_GATE>(ring, g, S, E, F.tid); }
              else { pg8::Gemm g{(bf16*)WSP(WS_H), WMIXL + (size_t)N_BCA * D, D, D, D};
                  pg8::EpiBf16<0> E{(bf16*)WSP(WS_PG), N_G, 1.0f};
                  pg8::gemm_phase(ring, g, S, E, F.tid); } }
            { KArgs ka = KA();
              constexpr int KB = Q_BR ? 256 : 512;
              pg8::Gemm g{(bf16*)WSP(WS_YA), WMIXL + (size_t)N_IN * D, KB, KB, KB, (size_t)32 * MiB, (size_t)512 * 1024 * (Q_BR ? 1 : 2)}; pg8::BranchOrder S; S.so.init(M / 256, D / 256, F.G, F.bid);
              static_assert(Q_GATE != 0 && Q_WO == 2, "the byte running sums need u8 gates and an int8 w_o GEMM");
              EpiBranch8<Q_BR> E{(const unsigned char*)WSP(WS_PG), (const float*)WSP(WS_QS) + QS_BR, WSP(WS_MRG8)};
              pg8::gemm_phase<1, Q_BR>(ring, g, S, E, F.tid); }
            SEAM(pb + 5);
        }
        if (IN(pb + 6)) {
            KArgs ka = KA();
            constexpr int KO = Q_WO ? D / 2 : D;
            pg8::Gemm g{Q_WO ? (bf16*)WSP(WS_MRG8) : (bf16*)WSP(WS_MRG), WMIXL + (size_t)N_IN * D + 3 * 512 * 1024, KO, KO, KO}; pg8::StaticOrder S; S.init(M / 256, D / 256, F.G, F.bid);
            EpiResid<l == 0, Q_WO> E{l == 0 ? (const void*)ka->in[0] : (const void*)ka->out, (bf16*)ka->out, MODL + 2 * D, Q_WO == 2 ? CLIP_MRG / 127.0f : 1.0f, Q_WO == 2 ? uni(QSV(QS_WO)) : 1.0f};
            pg8::gemm_phase<1, Q_WO>(ring, g, S, E, F.tid); SEAM(pb + 6);
        }
        if (l == 0) {
            constexpr int FES = Q_FUP ? 1 : 2, FDS = Q_FDN ? 1 : 2;
            if (IN(pb + 7)) { KArgs ka = KA(); p_norm<Q_FUP ? 1 : 0, true, Q_FUP ? Q_FUP : 2>(F, (const void*)ka->out, ka->in[5] + l * D, MODL, 4 * D, 3 * D, (bf16*)WSP(WS_H), nullptr, sa_of(Q_FUP, CLIP_FFN)); __syncthreads(); p_convert_mixer(F, KA(), 1, false);     SEAM(pb + 7); }
            if (IN(pb + 8)) {
                KArgs ka = KA();
                pg8::Gemm g{(bf16*)WSP(WS_H), (bf16*)WSP(WS_W13), D * FES / 2, D * FES / 2, D * FES / 2}; pg8::StaticOrder S; S.init(M / 256, N13 / 256, F.G, F.bid);
                EpiSwiglu<Q_FUP, Q_FDN> E{(bf16*)WSP(WS_ACT), uni(1.0f / (sa_of(Q_FUP, CLIP_FFN) * QSV(QS_F13)))};
                pg8::gemm_phase<1, Q_FUP>(ring, g, S, E, F.tid); SEAM(pb + 8);
            }
            if (IN(pb + 9)) {
                KArgs ka = KA();
                pg8::Gemm g{(bf16*)WSP(WS_ACT), (bf16*)WSP(WS_W2), D_FF * FDS / 2, D_FF * FDS / 2, D_FF * FDS / 2}; pg8::StaticOrder S; S.init(M / 256, D / 256, F.G, F.bid);
                EpiResid<false, Q_FDN> E{(const void*)ka->out, (bf16*)ka->out, MODL + 5 * D, Q_FDN == 2 ? CLIP_ACT / 127.0f : (Q_FDN ? 1.0f / (F8_SACT * F8_SW) : 1.0f), Q_FDN == 2 ? uni(QSV(QS_F2)) : 1.0f};
                pg8::gemm_phase<1, Q_FDN>(ring, g, S, E, F.tid); SEAM(pb + 9);
            }
        } else {
            if (IN(pb + 7)) {
                p_moe_scales(F, KA());
                __syncthreads(); { KArgs ka = KA(); p_norm_router(F, ka, (const void*)ka->out, ka->in[5] + l * D, MODL, (bf16*)WSP(WS_H2M)); } SEAM(pb + 7); }
            constexpr size_t ACT_BYTES = (size_t)MOE_ROWS * D_FF * MOE_ES;
#define MOE_UP(pass_, T_, HC_, pm0_, npan_) do { KArgs ka = KA(); \
                    const LAS int* tab = (const LAS int*)(F.lds + TAB_OFF) + (pass_) * 256; \
                    MoeOrder<true> S; S.so.init((npan_), N13 / 256, F.G, F.bid); S.pm0 = (pm0_); S.tab = tab; S.list = (const int*)WSP(WS_LIST) + (size_t)(pass_) * 8 * LIST_CAP; S.npn = N13 / 256; S.rowbytes = D * MOE_ES; S.T = (T_); S.HC = (HC_); \
                    pg8::Gemm g{(bf16*)WSP(WS_H2M), (bf16*)WSP(WS_WM13), D * MOE_ES / 2, D * MOE_ES / 2, D * MOE_ES / 2}; \
                    EpiSwiglu<Q_MUP, Q_MDN> E{(bf16*)WSP(WS_ACTM + (pass_) * ACT_BYTES), uni(1.0f / (sa_of(Q_MUP, CLIP_MOE) * QSV(QS_M13)))}; \
                    pg8::gemm_phase<1, Q_MUP>(ring, g, S, E, F.tid); } while (0)
#define MOE_DOWN(pass_, pm0_, npan_, y1m_, T_, HC_) do { KArgs ka = KA(); \
                    const LAS int* tab = (const LAS int*)(F.lds + TAB_OFF) + (pass_) * 256; \
                    MoeOrder<false> S; S.so.init((npan_), D / 256, F.G, F.bid); S.pm0 = (pm0_); S.T = (T_); S.HC = (HC_); S.tab = tab; S.list = (const int*)WSP(WS_LIST) + (size_t)(pass_) * 8 * LIST_CAP; S.npn = D / 256; S.rowbytes = 0; \
                    pg8::Gemm g{(bf16*)WSP(WS_ACTM + (pass_) * ACT_BYTES), (bf16*)WSP(WS_WM2), D_FF * MOE_ES / 2, D_FF * MOE_ES / 2, D_FF * MOE_ES / 2}; \
                    EpiMoeDown E{(bf16*)ka->out, MODL + 5 * D, (const float*)WSP(WS_TOPP), (pass_), tab, S.list, Q_MDN == 2 ? uni(CLIP_ACT / (127.0f * QSV(QS_M2))) : 1.0f / (F8_SACT * F8_SW), (bf16*)WSP(WS_Y1), (unsigned char*)WSP(WS_CTL + CTL_FLAG), (y1m_)}; \
                    pg8::gemm_phase<1, Q_MDN>(ring, g, S, E, F.tid); } while (0)
#define MOE_NP(pass_) (((const LAS int*)(F.lds + TAB_OFF))[(pass_) * 256 + 16])
            if (IN(pb + 8)) { { KArgs ka = KA(); moe_tables(F, (unsigned*)WSP(WS_CTL), 0); moe_tables(F, (unsigned*)WSP(WS_CTL), 1); }
                MOE_UP(0, 0, 0, 0, MOE_NP(0));
                { const int nx = MOE_NP(1) > MOE_XP ? MOE_NP(1) - MOE_XP : 0, nu0 = MOE_NP(0) * (N13 / 256);
                  MOE_UP(1, nu0 % F.G, 1, MOE_XP, nx); }
                SEAM(pb + 8); }
            if (IN(pb + 9)) {
                { KArgs ka = KA(); moe_tables(F, (unsigned*)WSP(WS_CTL), 0); moe_tables(F, (unsigned*)WSP(WS_CTL), 1); }
                MOE_DOWN(0, 0, MOE_NP(0), 0, 0, 0);
                { const int nx = MOE_NP(1) > MOE_XP ? MOE_NP(1) - MOE_XP : 0, nd0 = MOE_NP(0) * (D / 256);
                  MOE_DOWN(1, MOE_XP, nx, 1, nd0 % F.G, 1);
                  const int ndt = nd0 + nx * (D / 256);
                  MOE_UP(1, ndt % F.G, 3, 0, MOE_NP(1) < MOE_XP ? MOE_NP(1) : MOE_XP); }
                SEAM(pb + 9);
            }
            if (IN(pb + 11)) { { KArgs ka = KA(); moe_tables(F, (unsigned*)WSP(WS_CTL), 1); } MOE_DOWN(1, 0, MOE_NP(1) < MOE_XP ? MOE_NP(1) : MOE_XP, 0, 0, 0); SEAM(pb + 11); }
#undef MOE_NP
#undef MOE_UP
#undef MOE_DOWN
            if (IN(pb + 12)) { KArgs ka = KA(); p_final_norm(F, ka->out, ka->in[25], (const bf16*)WSP(WS_Y1), (const unsigned char*)WSP(WS_CTL + CTL_FLAG)); }
        }
}
__global__ void __launch_bounds__(NT, 2) fwd(Args args) {
    extern __shared__ __attribute__((aligned(16))) unsigned char lds[];
    Frame F;
    F.lds = (LAS unsigned char*)lds;
    F.tid = threadIdx.x; F.lane = F.tid & 63; F.wave = __builtin_amdgcn_readfirstlane(F.tid >> 6); F.w0 = F.wave;
    F.G = gridDim.x; F.bid = blockIdx.x;
    volatile LAS unsigned* MISC = (volatile LAS unsigned*)(F.lds + MISC_OFF);
    if (F.tid < 32) MISC[F.tid] = 0u;
    __syncthreads();
#if !MK_PER_PHASE
    XcdBarrier bar = xcd_barrier_post((unsigned*)(KA()->ws + WS_CTL) + CW_BAR, MISC + 8);
#else
    XcdBarrier bar; bar.bar = nullptr; bar.x = 0; bar.st = nullptr;
#endif
    PG8_LAS unsigned char* ring = (PG8_LAS unsigned char*)lds;

    if (IN(0)) {
#pragma unroll 1
        for (int rep = 0; rep < REPS(5); ++rep) { __syncthreads(); p_prologue(F, KA()); __syncthreads(); p_convert_mixer(F, KA(), 0, true); }
        SEAM(0); }

    layer_program<0>(F, bar, ring);
    layer_program<1>(F, bar, ring);
#undef IN
#undef SEAM
}

extern "C" void kernel_launch(void* const* d_in, const int* in_sizes, int n_in, void* d_out, int out_size, void* d_ws, size_t ws_size, hipStream_t stream) {
    static int grid = 0;
    if (grid == 0) {
        if (n_in != 26 || in_sizes[0] != M * D || out_size != M * D || ws_size < WS_NEED) { fprintf(stderr, "kernel_launch: unexpected shapes / workspace (n_in %d, ws %zu, need %zu); nothing launched\n", n_in, ws_size, (size_t)WS_NEED); grid = -1; return; }
        int dev = 0, cus = 0, per_cu = 0;
        if (hipGetDevice(&dev) != hipSuccess || hipDeviceGetAttribute(&cus, hipDeviceAttributeMultiprocessorCount, dev) != hipSuccess) { grid = -1; return; }
        if (hipFuncSetAttribute((const void*)fwd, hipFuncAttributeMaxDynamicSharedMemorySize, LDS_BYTES) != hipSuccess) { fprintf(stderr, "kernel_launch: hipFuncSetAttribute failed\n"); grid = -1; return; }
        if (hipOccupancyMaxActiveBlocksPerMultiprocessor(&per_cu, (const void*)fwd, NT, LDS_BYTES) != hipSuccess || per_cu < 1) fprintf(stderr, "kernel_launch: occupancy query reports %d\n", per_cu);
        (void)hipGetLastError();
        grid = cus;
    }
    if (grid < 0) return;
    if (hipMemsetAsync((char*)d_ws + WS_CTL, 0, CTL_ZERO_BYTES, stream) != hipSuccess) return;
    Args a{};
    for (int i = 0; i < 26; ++i) a.in[i] = (const float*)d_in[i];
    a.out = (float*)d_out; a.ws = (unsigned char*)d_ws;
#if MK_PER_PHASE
    for (int p = 0; p < NPHASE; ++p) {
        if ((p >= 1 + 10 && p <= 1 + 12) || p == 1 + 4 || p == 1 + NPL + 4 || p == 1 + NPL + 10) continue;
        a.ph_lo = p; a.ph_hi = p + 1;
        hipLaunchKernelGGL(fwd, dim3(grid), dim3(NT), LDS_BYTES, stream, a);
    }
#else
    a.ph_lo = 0; a.ph_hi = NPHASE;
    hipLaunchKernelGGL(fwd, dim3(grid), dim3(NT), LDS_BYTES, stream, a);
#endif
}
```

```cpp
#include <hip/hip_runtime.h>
#include <cstdio>
#include <cstdint>

#ifndef PROBE_DUP
#define PROBE_DUP 0
#endif
#ifndef PROBE_REPS
#define PROBE_REPS 2
#endif
#define REPS(k) ((PROBE_DUP == (k)) ? PROBE_REPS : 1)
#ifndef Q_PROJ
#define Q_PROJ 2
#endif
#ifndef Q_GATE
#define Q_GATE 2
#endif
#ifndef Q_FUP
#define Q_FUP 2
#endif
#ifndef Q_FDN
#define Q_FDN 2
#endif
#ifndef Q_MUP
#define Q_MUP 2
#endif
#ifndef Q_MDN
#define Q_MDN 2
#endif
#ifndef Q_BR
#define Q_BR 2
#endif
#ifndef Q_WO
#define Q_WO 2
#endif
#ifndef MK_PER_PHASE
#define MK_PER_PHASE 0
#endif

#define ACC_BIAS 12582912.0f
namespace pg8 {
#define PG8_LAS __attribute__((address_space(3)))
typedef unsigned short bf16_t;
typedef short bf16x8 __attribute__((ext_vector_type(8)));
typedef float f32x4 __attribute__((ext_vector_type(4)));
typedef unsigned u32x4 __attribute__((ext_vector_type(4)));
typedef int v4i32_ __attribute__((ext_vector_type(4)));
constexpr int BM = 256, BK = 64, HALF = 128, HTB = HALF * BK * 2, STAGE_BYTES = 8 * HTB, NXCD = 8, WGM = 8;

__host__ __device__ __forceinline__ int lds_byte(int r, int c) { const int st = (r >> 4) * 2 + (c >> 5), rr = r & 15, cc = c & 31, ob = rr * 64 + cc * 2; return st * 1024 + (ob ^ (((ob >> 9) & 1) << 5)); }
__host__ __device__ __forceinline__ void stage_rc(int b, int& R, int& C) { const int st = b / 1024, sb = b % 1024, swz = sb ^ (((sb >> 9) & 1) << 5); R = (st >> 1) * 16 + swz / 64; C = (st & 1) * 32 + (swz % 64) / 2; }
__host__ __device__ __forceinline__ int perm32(int rho) { const int n = rho >> 4, i = rho & 15; return 8 * (i >> 2) + 4 * n + (i & 3); }

struct Unit { int pm, pn, pb, aux; };
struct Gemm { const bf16_t* A; const bf16_t* Bt; int lda, ldb, K; size_t astride = 0, bstride = 0; };

struct StaticOrder {
    static constexpr bool GATHER = false;
    int nM, nN, nwg, G, c;
    __device__ __forceinline__ void init(int nM_, int nN_, int G_, int c_) { nM = nM_; nN = nN_; nwg = nM * nN; G = G_; c = c_; }
    __device__ __forceinline__ bool next(int i, Unit& u) const { return unit_of((long)i * G + c, u); }
    __device__ __forceinline__ bool unit_of(long L, Unit& u) const {
        if (L >= nwg) return false;
        int wgid = (int)L; { const int q = nwg / NXCD, r = nwg % NXCD, xcd = wgid % NXCD, off = wgid / NXCD; wgid = (xcd < r ? xcd * (q + 1) : r * (q + 1) + (xcd - r) * q) + off; }
        const int nig = WGM * nN, gid = wgid / nig, fm = gid * WGM, gsz = (nM - fm) < WGM ? (nM - fm) : WGM;
        u.pm = fm + ((wgid % nig) % gsz); u.pn = (wgid % nig) / gsz; u.pb = u.pn; u.aux = 0; return true;
    }
    __device__ __forceinline__ unsigned a_row_off(const Unit&, int) const { return 0u; }
};

struct GateOrder {
    static constexpr bool GATHER = false;
    StaticOrder so;
    __device__ __forceinline__ bool next(int k, Unit& u) const { Unit b; if (!so.next(k / 3, b)) return false; u.pm = b.pm; u.pn = b.pn + 4 * (k % 3); u.pb = u.pn; u.aux = 0; return true; }
    __device__ __forceinline__ unsigned a_row_off(const Unit&, int) const { return 0u; }
};
struct BranchOrder {
    static constexpr bool GATHER = false;
    StaticOrder so;
    __device__ __forceinline__ bool next(int k, Unit& u) const { Unit b; if (!so.next(k / 3, b)) return false; u.pm = b.pm; u.pn = b.pn; u.pb = b.pn; u.aux = (k % 3 + 1) % 3; return true; }
    __device__ __forceinline__ unsigned a_row_off(const Unit&, int) const { return 0u; }
};
__device__ __forceinline__ unsigned cvt_pk_bf16(float lo, float hi) { unsigned r; asm volatile("v_cvt_pk_bf16_f32 %0, %1, %2" : "=v"(r) : "v"(lo), "v"(hi)); return r; }

template <int Q = 0>
struct EpiBf16 {
    static constexpr bool PERM = true;
    bf16_t* O; int ldc; float scale;
    __device__ __forceinline__ void operator()(const f32x4 (&acc)[2][2][4][2], const Unit& u, int wr, int wc, int fr, int fq) const {
        const int row0 = u.pm * BM + wr * 64 + fr, col0 = u.pn * BM + wc * 32 + 8 * fq;
#pragma unroll 1
        for (int erep = 0; erep < REPS(9); ++erep)
#pragma unroll
        for (int ai = 0; ai < 2; ++ai)
#pragma unroll
            for (int m = 0; m < 4; ++m) { bf16_t* rowp = O + (size_t)(row0 + ai * HALF + m * 16) * ldc + col0;
#pragma unroll
                for (int bj = 0; bj < 2; ++bj) { f32x4 v0 = acc[ai][bj][m][0], v1 = acc[ai][bj][m][1];
                    if constexpr (Q == 2) { v0 = v0 - ACC_BIAS; v1 = v1 - ACC_BIAS; }
                    v0 *= scale; v1 *= scale;
                    u32x4 w; w.x = cvt_pk_bf16(v0[0], v0[1]); w.y = cvt_pk_bf16(v0[2], v0[3]); w.z = cvt_pk_bf16(v1[0], v1[1]); w.w = cvt_pk_bf16(v1[2], v1[3]);
                    *(u32x4*)(rowp + bj * HALF) = w; } }
    }
};

typedef int v8i32 __attribute__((ext_vector_type(8)));
typedef int v4i32 __attribute__((ext_vector_type(4)));
template <int KREP = 1, int Q = 0, int MREP = 1, class Epi, class Sched>
__device__ __forceinline__ void gemm_phase(PG8_LAS unsigned char* lds, const Gemm g, const Sched& S, const Epi& E, int tid_in) {
    constexpr bool GATHER = Sched::GATHER;
    int tid_ = tid_in; asm volatile("" : "+v"(tid_));
    const int tid = tid_, wid = __builtin_amdgcn_readfirstlane(tid >> 6), lane = tid & 63, wr = wid >> 2, wc = wid & 3, fr = lane & 15, fq = lane >> 4;
    const int K = g.K, nt = K / BK;
    unsigned voffB[2], vA0[2], vA1[2], nA0[2], nA1[2];
#pragma unroll
    for (int i = 0; i < 2; ++i) { int R, C; stage_rc(tid * 16 + i * 8192, R, C); const int Rb = Epi::PERM ? ((R & ~31) + perm32(R & 31)) : R;
        voffB[i] = (unsigned)(Rb * g.ldb + C) * 2u;
        vA0[i] = (unsigned)(R * g.lda + C) * 2u; vA1[i] = vA0[i]; nA0[i] = vA0[i]; nA1[i] = vA0[i]; }
    const size_t kstep = (size_t)(BK * 2);
    const size_t hstepB = (size_t)HALF * g.ldb * 2, tstepB = 2 * hstepB, tstepA = (size_t)BM * g.lda * 2;
    const size_t hstepA = GATHER ? (size_t)0 : (size_t)HALF * g.lda * 2;
    const unsigned ldsw = (unsigned)wid * 1024u;
    const int aoff = lds_byte(wr * 64 + fr, fq * 8), boff = lds_byte(wc * 32 + fr, fq * 8);
    PG8_LAS unsigned char* aptr = lds + aoff; PG8_LAS unsigned char* bptr = lds + 4 * HTB + boff; asm volatile("" : "+v"(aptr), "+v"(bptr));
#define PG8_SA(b, h) (((b) * 2 + (h)) * HTB)
#define PG8_SB(b, h) ((4 + (b) * 2 + (h)) * HTB)
#define PG8_STAGE(bufoff, gbase, voff) do { _Pragma("unroll") for (int _i = 0; _i < 2; ++_i) \
        __builtin_amdgcn_global_load_lds((const unsigned*)((const char*)(gbase) + (voff)[_i]), (PG8_LAS unsigned*)(lds + (bufoff) + ldsw + _i * 8192), 16, 0, 0); } while (0)
#define PG8_CAT8(x0, x1) __builtin_shufflevector(__builtin_bit_cast(v4i32, x0), __builtin_bit_cast(v4i32, x1), 0, 1, 2, 3, 4, 5, 6, 7)
#define PG8_RDA(off) (*(const PG8_LAS bf16x8*)(aptr + (off)))
#define PG8_RDB(off) (*(const PG8_LAS bf16x8*)(bptr + (off)))
#define PG8_LDA(dst, b, h) do { if constexpr (Q == 1) { _Pragma("unroll") for (int m = 0; m < 4; ++m) dst##8[m] = PG8_CAT8(PG8_RDA(PG8_SA(b, h) + m * 2048), PG8_RDA(PG8_SA(b, h) + m * 2048 + 1024)); } \
        else { _Pragma("unroll") for (int m = 0; m < 4; ++m) _Pragma("unroll") for (int k = 0; k < 2; ++k) dst[m][k] = PG8_RDA(PG8_SA(b, h) + m * 2048 + k * 1024); } } while (0)
#define PG8_LDB(dst, b, h) do { if constexpr (Q == 1) { _Pragma("unroll") for (int n = 0; n < 2; ++n) dst##8[n] = PG8_CAT8(PG8_RDB(PG8_SB(b, h) - 4 * HTB + n * 2048), PG8_RDB(PG8_SB(b, h) - 4 * HTB + n * 2048 + 1024)); } \
        else { _Pragma("unroll") for (int n = 0; n < 2; ++n) _Pragma("unroll") for (int k = 0; k < 2; ++k) dst[n][k] = PG8_RDB(PG8_SB(b, h) - 4 * HTB + n * 2048 + k * 1024); } } while (0)
#define PG8_MMA(ai, bj, At, Bt) do { __builtin_amdgcn_s_setprio(1); _Pragma("unroll") for (int r_ = 0; r_ < MREP; ++r_) { \
        if constexpr (Q == 2) { _Pragma("unroll") for (int m = 0; m < 4; ++m) _Pragma("unroll") for (int n = 0; n < 2; ++n) _Pragma("unroll") for (int k = 0; k < 2; ++k) \
            acc[ai][bj][m][n] = __builtin_bit_cast(f32x4, __builtin_amdgcn_mfma_i32_16x16x64_i8(__builtin_bit_cast(v4i32, Bt[n][k]), __builtin_bit_cast(v4i32, At[m][k]), __builtin_bit_cast(v4i32, acc[ai][bj][m][n]), 0, 0, 0)); } \
        else if constexpr (Q == 1) { _Pragma("unroll") for (int m = 0; m < 4; ++m) _Pragma("unroll") for (int n = 0; n < 2; ++n) \
            asm volatile("v_mfma_scale_f32_16x16x128_f8f6f4 %0, %1, %2, %0, %3, %3 op_sel_hi:[0,0,0]" : "+v"(acc[ai][bj][m][n]) : "v"(Bt##8[n]), "v"(At##8[m]), "v"(sc1)); } \
        else { _Pragma("unroll") for (int m = 0; m < 4; ++m) _Pragma("unroll") for (int n = 0; n < 2; ++n) _Pragma("unroll") for (int k = 0; k < 2; ++k) \
            acc[ai][bj][m][n] = __builtin_amdgcn_mfma_f32_16x16x32_bf16(Bt[n][k], At[m][k], acc[ai][bj][m][n], 0, 0, 0); } } \
        __builtin_amdgcn_s_setprio(0); } while (0)
#define PG8_WAIT_V(n) asm volatile("s_waitcnt vmcnt(" #n ")" ::: "memory")
#define PG8_WAIT_L(n) asm volatile("s_waitcnt lgkmcnt(" #n ")" ::: "memory")
#define PG8_BAR __builtin_amdgcn_s_barrier()
#define PG8_SCHED __builtin_amdgcn_sched_barrier(0)
#define PG8_GOFF(unit, d0, d1) do { _Pragma("unroll") for (int _i = 0; _i < 2; ++_i) { int R_, C_; stage_rc(tid * 16 + _i * 8192, R_, C_); \
        d0[_i] = S.a_row_off(unit, R_) + (unsigned)C_ * 2u; d1[_i] = S.a_row_off(unit, R_ + HALF) + (unsigned)C_ * 2u; } } while (0)
    Unit cur, nxt; int ui = 0;
    if (!S.next(0, cur)) return;
    f32x4 acc[2][2][4][2];
#pragma unroll
    for (int a = 0; a < 2; ++a)
#pragma unroll
        for (int b = 0; b < 2; ++b)
#pragma unroll
            for (int m = 0; m < 4; ++m)
#pragma unroll
                for (int n = 0; n < 2; ++n) acc[a][b][m][n] = (Q == 2) ? (f32x4){ACC_BIAS, ACC_BIAS, ACC_BIAS, ACC_BIAS} : (f32x4){0.f, 0.f, 0.f, 0.f};
    bf16x8 At[4][2], B0[2][2], B1[2][2];
    v8i32 At8[4], B08[2], B18[2];
    const int sc1 = 0x7f7f7f7f;
    if constexpr (GATHER) { PG8_GOFF(cur, vA0, vA1); }
    const char* cA = GATHER ? (const char*)g.A : (const char*)g.A + (size_t)cur.aux * g.astride + (size_t)cur.pm * tstepA; const char* cB = (const char*)g.Bt + (size_t)cur.aux * g.bstride + (size_t)cur.pb * tstepB;
    PG8_STAGE(PG8_SB(0, 0), cB, voffB); PG8_STAGE(PG8_SB(0, 1), cB + hstepB, voffB); PG8_STAGE(PG8_SA(0, 0), cA, vA0); PG8_STAGE(PG8_SA(0, 1), cA + hstepA, vA1);
    if (wr == 1) PG8_BAR;
    PG8_WAIT_V(2); PG8_BAR;
    PG8_STAGE(PG8_SB(1, 0), cB + kstep, voffB); PG8_STAGE(PG8_SA(1, 0), cA + kstep, vA0); PG8_STAGE(PG8_SB(1, 1), cB + hstepB + kstep, voffB);
    PG8_WAIT_V(6); PG8_BAR;
    for (;;) {
        const bool has_next = S.next(ui + 1, nxt);
        const char* nA = GATHER ? (const char*)g.A : (has_next ? (const char*)g.A + (size_t)nxt.aux * g.astride + (size_t)nxt.pm * tstepA : cA); const char* nB = has_next ? (const char*)g.Bt + (size_t)nxt.aux * g.bstride + (size_t)nxt.pb * tstepB : cB;
        if constexpr (GATHER) { if (has_next) { PG8_GOFF(nxt, nA0, nA1); } else {
#pragma unroll
            for (int i = 0; i < 2; ++i) { nA0[i] = vA0[i]; nA1[i] = vA1[i]; } } }
#pragma unroll 1
        for (int t = 0; t < nt * KREP; t += 2) {
            const bool last = (t == nt * KREP - 2);
            const int t1 = (KREP == 1) ? t + 1 : ((t + 1) & (nt - 1)), t2 = (KREP == 1) ? t + 2 : ((t + 2) & (nt - 1));
            const char* a1 = cA + (size_t)t1 * kstep;
            const char* a2 = last ? nA : cA + (size_t)t2 * kstep; const char* b2 = last ? nB : cB + (size_t)t2 * kstep;
            const char* a3 = a2 + kstep; const char* b3 = b2 + kstep;
            unsigned s0[2], s1[2];
#pragma unroll
            for (int i = 0; i < 2; ++i) { s0[i] = (GATHER && last) ? nA0[i] : vA0[i]; s1[i] = GATHER ? (last ? nA1[i] : vA1[i]) : vA0[i]; }
            PG8_LDB(B0, 0, 0); PG8_LDB(B1, 0, 1); PG8_SCHED; PG8_LDA(At, 0, 0); PG8_STAGE(PG8_SA(1, 1), a1 + hstepA, vA1);
            PG8_WAIT_V(8); PG8_WAIT_L(0); PG8_BAR; PG8_MMA(0, 0, At, B0); PG8_MMA(0, 1, At, B1); PG8_BAR; PG8_SCHED;
            PG8_LDA(At, 0, 1); PG8_STAGE(PG8_SB(0, 0), b2, voffB); PG8_STAGE(PG8_SB(0, 1), b2 + hstepB, voffB); PG8_STAGE(PG8_SA(0, 0), a2, s0);
            PG8_WAIT_V(8); PG8_WAIT_L(0); PG8_BAR; PG8_MMA(1, 0, At, B0); PG8_MMA(1, 1, At, B1); PG8_BAR; PG8_SCHED;
            PG8_LDB(B0, 1, 0); PG8_LDB(B1, 1, 1); PG8_SCHED; PG8_LDA(At, 1, 0); PG8_STAGE(PG8_SA(0, 1), a2 + hstepA, s1);
            PG8_WAIT_V(8); PG8_WAIT_L(0); PG8_BAR; PG8_MMA(0, 0, At, B0); PG8_MMA(0, 1, At, B1); PG8_BAR; PG8_SCHED;
            PG8_LDA(At, 1, 1); PG8_STAGE(PG8_SB(1, 0), b3, voffB); PG8_STAGE(PG8_SB(1, 1), b3 + hstepB, voffB); PG8_STAGE(PG8_SA(1, 0), a3, s0);
            PG8_WAIT_V(8); PG8_WAIT_L(0); PG8_BAR; PG8_MMA(1, 0, At, B0); PG8_MMA(1, 1, At, B1); PG8_BAR; PG8_SCHED;
        }
        if (wr == 0) PG8_BAR;
        E(acc, cur, wr, wc, fr, fq);
        if (!has_next) break;
#pragma unroll
        for (int a = 0; a < 2; ++a)
#pragma unroll
            for (int b = 0; b < 2; ++b)
#pragma unroll
                for (int m = 0; m < 4; ++m)
#pragma unroll
                    for (int n = 0; n < 2; ++n) acc[a][b][m][n] = (Q == 2) ? (f32x4){ACC_BIAS, ACC_BIAS, ACC_BIAS, ACC_BIAS} : (f32x4){0.f, 0.f, 0.f, 0.f};
        cur = nxt; cA = nA; cB = nB; ++ui;
        if constexpr (GATHER) {
#pragma unroll
            for (int i = 0; i < 2; ++i) { vA0[i] = nA0[i]; vA1[i] = nA1[i]; } }
        if (wr == 1) PG8_BAR;
    }
    PG8_WAIT_V(0);
    PG8_BAR;
#undef PG8_SA
#undef PG8_SB
#undef PG8_STAGE
#undef PG8_LDA
#undef PG8_LDB
#undef PG8_MMA
#undef PG8_WAIT_V
#undef PG8_WAIT_L
#undef PG8_BAR
#undef PG8_SCHED
#undef PG8_GOFF
#undef PG8_CAT8
#undef PG8_RDA
#undef PG8_RDB
}
}

constexpr int D = 1024, BATCH = 8, SEQ = 4096, M = BATCH * SEQ, DEPTH = 2;
constexpr int D_A = 512, D_BK = 512, D_BV = 512, D_C = 512, H_B = 4;
constexpr int N_IN = 7680, N_BCA = 4608, N_G = 3072;
constexpr int P1_PITCH = 1536 + 4096 + 1024, P1_OB = 1536, P1_OC = 5632, P1E = P1_PITCH / 2;
#ifndef CLIP_P1
#define CLIP_P1 5.5f
#endif
constexpr int D_FF = 2816, NE = 8, N13 = 2 * D_FF;
constexpr int MOD_LD = 6 * D;
constexpr float EPS = 1e-6f;
constexpr int XLD = 2 * D;
constexpr int LIST_CAP = M;
constexpr int MOE_ROWS = M + NE * 256;

constexpr size_t MiB = 1u << 20;
constexpr size_t WS_CTL = 0, CTL_ZERO_BYTES = 1 * MiB;
constexpr size_t WS_MOD = 1 * MiB;
constexpr size_t WS_TOPP = 2 * MiB;
constexpr size_t WS_QS = 2 * MiB + 768 * 1024;
constexpr size_t WS_LIST = 3 * MiB;
constexpr size_t WS_WMIX = 6 * MiB;
constexpr size_t WMIX_G8 = 9 * MiB;
constexpr size_t WS_W13 = 26 * MiB, WS_W2 = 37 * MiB;
constexpr size_t WS_BIG = 44 * MiB;
constexpr size_t WS_H = WS_BIG;
constexpr size_t WS_P1 = WS_BIG + 64 * MiB;
constexpr size_t WS_PG = WS_P1;
constexpr size_t WS_MRG = WS_P1 + 192 * MiB;
constexpr size_t WS_MRG8 = WS_P1 + 256 * MiB;
constexpr size_t WS_YA = WS_P1 + 288 * MiB, WS_YB = WS_YA + 32 * MiB, WS_YC = WS_YB + 32 * MiB;
constexpr size_t WS_ACT = WS_P1;
constexpr size_t WS_HU = WS_YC + 32 * MiB;
constexpr size_t WS_HD = WS_HU + 16 * MiB;
constexpr size_t WS_H8 = WS_HD + 1 * MiB;
constexpr size_t WS_MIX_END = WS_H8 + 32 * MiB;
static_assert((Q_PROJ == 0 || Q_GATE == 0 || Q_PROJ == Q_GATE) && Q_MDN != 0 && Q_MUP != 0, "supported operand encodings");
constexpr int HQ_MIX = Q_PROJ ? Q_PROJ : Q_GATE;
constexpr bool H_BF = (Q_PROJ == 0 || Q_GATE == 0);
constexpr float F8_SW = 64.0f, F8_SACT = 8.0f, W_CLIP = 4.0f;
#ifndef CLIP_MIX0
#define CLIP_MIX0 5.5f
#endif
#ifndef CLIP_MIX1
#define CLIP_MIX1 5.5f
#endif
#ifndef CLIP_FFN
#define CLIP_FFN 5.5f
#endif
#ifndef CLIP_MOE
#define CLIP_MOE 5.5f
#endif
#ifndef CLIP_YA
#define CLIP_YA 14.0f
#endif
#ifndef CLIP_YB
#define CLIP_YB 5.5f
#endif
#ifndef CLIP_YC
#define CLIP_YC 10.0f
#endif
#ifndef CLIP_ACT
#define CLIP_ACT 7.0f
#endif
#ifndef CLIP_MRG
#define CLIP_MRG 9.0f
#endif
__host__ __device__ constexpr float sa_of(int q, float clip) { return q == 2 ? 127.0f / clip : 4.0f; }
enum { QS_IN = 0, QS_F13 = 1, QS_F2 = 2, QS_M13 = 3, QS_BR = 4  , QS_WO = 7, QS_M2 = 8, QS_N = 16 };
constexpr int MOE_ES = 1;
constexpr size_t WS_WM13 = 6 * MiB;
constexpr size_t WS_WM2 = WS_WM13 + 88 * MiB;
constexpr size_t WS_H2M = WS_WM2 + 44 * MiB;
constexpr size_t WS_ACTM = WS_H2M + 64 * MiB;
constexpr size_t WS_MOE_END = WS_ACTM + 2 * (size_t)MOE_ROWS * D_FF * MOE_ES;
constexpr size_t WS_Y1 = WS_MOE_END;
constexpr size_t WS_NEED = WS_MIX_END > WS_Y1 + (size_t)M * D * 2 ? WS_MIX_END : WS_Y1 + (size_t)M * D * 2;
constexpr size_t CTL_FLAG = 512 * 1024;
constexpr int MOE_XP = 128;
static_assert(WS_W2 + (size_t)D * D_FF * 2 <= WS_BIG && WS_WMIX + 20 * MiB <= WS_W13, "ws map");
constexpr int CW_BAR = 4096;
constexpr int CW_CNT = 16384;

constexpr int LDS_BYTES = 147456;
constexpr int SCR_BYTES = 139264;
constexpr int TAB_OFF = SCR_BYTES;
constexpr int MISC_OFF = TAB_OFF + 4096;
static_assert(MISC_OFF + 128 <= LDS_BYTES, "LDS map");
constexpr int NWAVES = 8, NT = 512;

#define GAS __attribute__((address_space(1)))
#define LAS __attribute__((address_space(3)))
typedef unsigned short bf16;
typedef unsigned v4u __attribute__((ext_vector_type(4)));
typedef float f32x4 __attribute__((ext_vector_type(4)));
#define LDS_WAIT() asm volatile("s_waitcnt lgkmcnt(0)" ::: "memory")
#define LDS_BARRIER() asm volatile("s_waitcnt lgkmcnt(0)\n\ts_barrier" ::: "memory")

typedef float f32x2_t __attribute__((ext_vector_type(2)));
typedef __bf16 bf16x2_t __attribute__((ext_vector_type(2)));
__device__ __forceinline__ unsigned pk2(float lo, float hi) { f32x2_t v = {lo, hi}; bf16x2_t b = __builtin_convertvector(v, bf16x2_t); return __builtin_bit_cast(unsigned, b); }
__device__ __forceinline__ float bf_lo(unsigned u) { return __uint_as_float(u << 16); }
__device__ __forceinline__ float bf_hi(unsigned u) { return __uint_as_float(u & 0xffff0000u); }
__device__ __forceinline__ void unpack8(const v4u w, float (&f)[8]) { f[0] = bf_lo(w.x); f[1] = bf_hi(w.x); f[2] = bf_lo(w.y); f[3] = bf_hi(w.y); f[4] = bf_lo(w.z); f[5] = bf_hi(w.z); f[6] = bf_lo(w.w); f[7] = bf_hi(w.w); }
typedef unsigned v2u_p1 __attribute__((ext_vector_type(2)));
__device__ __forceinline__ void decode8u(const v2u_p1 w, float (&f)[8]) {
    constexpr float a = CLIP_P1 / 127.0f, b = -128.0f * CLIP_P1 / 127.0f;
#pragma unroll
    for (int i = 0; i < 4; ++i) { f[i] = (float)((w.x >> (8 * i)) & 0xffu) * a + b; f[4 + i] = (float)((w.y >> (8 * i)) & 0xffu) * a + b; }
}
__device__ __forceinline__ v4u pack8(const float (&f)[8]) { v4u w; w.x = pk2(f[0], f[1]); w.y = pk2(f[2], f[3]); w.z = pk2(f[4], f[5]); w.w = pk2(f[6], f[7]); return w; }
__device__ __forceinline__ float sigmoidf_(float x) { return __builtin_amdgcn_rcpf(1.0f + __expf(-x)); }
__device__ __forceinline__ float siluf_(float x) { return x * sigmoidf_(x); }
__device__ __forceinline__ float uni(float v) { return __int_as_float(__builtin_amdgcn_readfirstlane(__float_as_int(v))); }
template <int Q> __device__ __forceinline__ float accf(float v) { return (Q == 2) ? v - ACC_BIAS : v; }
template <int Q> __device__ __forceinline__ pg8::f32x4 accv(pg8::f32x4 v) { if constexpr (Q == 2) return v - ACC_BIAS; else return v; }
__device__ __forceinline__ float clamp_f8(float x) { return fminf(fmaxf(x, -448.0f), 448.0f); }
__device__ __forceinline__ unsigned q1_i8(float x) { return (unsigned)(int)rintf(fminf(fmaxf(x, -127.0f), 127.0f)) & 0xffu; }
template <int Q> __device__ __forceinline__ unsigned pk4_q(float a, float b, float c, float d) {
    if constexpr (Q == 2) {
        constexpr float MG = 12582912.0f;
        const unsigned ua = __float_as_uint(__builtin_amdgcn_fmed3f(a + MG, MG - 127.0f, MG + 127.0f)), ub = __float_as_uint(__builtin_amdgcn_fmed3f(b + MG, MG - 127.0f, MG + 127.0f));
        const unsigned uc = __float_as_uint(__builtin_amdgcn_fmed3f(c + MG, MG - 127.0f, MG + 127.0f)), ud = __float_as_uint(__builtin_amdgcn_fmed3f(d + MG, MG - 127.0f, MG + 127.0f));
        return __builtin_amdgcn_perm(__builtin_amdgcn_perm(ud, uc, 0x0c0c0400u), __builtin_amdgcn_perm(ub, ua, 0x0c0c0400u), 0x05040100u); }
    else { int v = 0; v = __builtin_amdgcn_cvt_pk_fp8_f32(clamp_f8(a), clamp_f8(b), v, false); v = __builtin_amdgcn_cvt_pk_fp8_f32(clamp_f8(c), clamp_f8(d), v, true); return (unsigned)v; } }
__device__ __forceinline__ float shx(float v, int mask, int lane) { return __int_as_float(__builtin_amdgcn_ds_bpermute((lane ^ mask) << 2, __float_as_int(v))); }
__device__ __forceinline__ float shl(float v, int src) { return __int_as_float(__builtin_amdgcn_ds_bpermute(src << 2, __float_as_int(v))); }
__device__ __forceinline__ float wave_sum(float v, int lane) {
#pragma unroll
    for (int o = 1; o < 64; o <<= 1) v += shx(v, o, lane);
    return v;
}

template <int CTRL> __device__ __forceinline__ float dppx(float x) { return __builtin_bit_cast(float, __builtin_amdgcn_mov_dpp(__builtin_bit_cast(int, x), CTRL, 0xf, 0xf, true)); }
__device__ __forceinline__ float dpp_xor4(float x) { const int xi = __builtin_bit_cast(int, x); int t = __builtin_amdgcn_update_dpp(xi, xi, 0x12C, 0xf, 0x5, false); t = __builtin_amdgcn_update_dpp(t, xi, 0x124, 0xf, 0xA, false); return __builtin_bit_cast(float, t); }
__device__ __forceinline__ f32x4 rot64(const f32x4 v, int lane) {
    const float a0 = v.x + v.y, a1 = v.x - v.y, a2 = v.z + v.w, a3 = v.z - v.w;
    f32x4 b = {a0 + a2, a1 + a3, a0 - a2, a1 - a3};
    const float s1 = (lane & 1) ? -1.0f : 1.0f, s2 = (lane & 2) ? -1.0f : 1.0f, s4 = (lane & 4) ? -1.0f : 1.0f, s8 = (lane & 8) ? -1.0f : 1.0f;
    b = (f32x4){dppx<0xB1>(b.x), dppx<0xB1>(b.y), dppx<0xB1>(b.z), dppx<0xB1>(b.w)} + b * s1;
    b = (f32x4){dppx<0x4E>(b.x), dppx<0x4E>(b.y), dppx<0x4E>(b.z), dppx<0x4E>(b.w)} + b * s2;
    b = (f32x4){dpp_xor4(b.x), dpp_xor4(b.y), dpp_xor4(b.z), dpp_xor4(b.w)} + b * s4;
    b = (f32x4){dppx<0x128>(b.x), dppx<0x128>(b.y), dppx<0x128>(b.z), dppx<0x128>(b.w)} + b * s8;
    return b * 0.125f;
}

__device__ __forceinline__ void fwht8(float (&y)[8]) {
#pragma unroll
    for (int t = 1; t < 8; t <<= 1)
#pragma unroll
        for (int i = 0; i < 8; ++i) if (!(i & t)) { const float a = y[i], b = y[i | t]; y[i] = a + b; y[i | t] = a - b; }
}
__device__ __forceinline__ void rot64_8(float (&y)[8], int lane) {
    fwht8(y);
    const float s1 = (lane & 1) ? -1.0f : 1.0f, s2 = (lane & 2) ? -1.0f : 1.0f, s4 = (lane & 4) ? -1.0f : 1.0f;
#pragma unroll
    for (int i = 0; i < 8; ++i) y[i] = dppx<0xB1>(y[i]) + y[i] * s1;
#pragma unroll
    for (int i = 0; i < 8; ++i) y[i] = dppx<0x4E>(y[i]) + y[i] * s2;
#pragma unroll
    for (int i = 0; i < 8; ++i) y[i] = dpp_xor4(y[i]) + y[i] * s4;
}
template <int Q, int RB = 64> __device__ __forceinline__ void store_y8(bf16* ybase, size_t elem, float (&y)[8], int lane, float clip) {
    if constexpr (Q == 2) { typedef unsigned v2u_ __attribute__((ext_vector_type(2)));
        if constexpr (RB == 8) fwht8(y); else rot64_8(y, lane);
        const float s = (RB == 8 ? 0.35355339f : 0.125f) * 127.0f / clip;
        v2u_ o8; o8.x = pk4_q<2>(y[0] * s, y[1] * s, y[2] * s, y[3] * s); o8.y = pk4_q<2>(y[4] * s, y[5] * s, y[6] * s, y[7] * s);
        *(v2u_*)((unsigned char*)ybase + elem) = o8; }
    else *(v4u*)(ybase + elem) = pack8(y);
}

#define XB_TMO      128
#define XB_XCNT(j)  (256  + 64 * (j))
#define XB_XSUB(j)  (1280 + 64 * (j))
#define XB_XGEN(j)  (2304 + 64 * (j))
#define XB_TOP      3328
#define XB_TOPGEN   3392
#define XCD_BAR_WORDS 3456
#define XB_SPIN_CAP (1u << 18)

__device__ __forceinline__ unsigned xb_ld(unsigned* p)              { return __hip_atomic_load(p, __ATOMIC_RELAXED, __HIP_MEMORY_SCOPE_AGENT); }
__device__ __forceinline__ unsigned xb_add(unsigned* p, unsigned v) { return __hip_atomic_fetch_add(p, v, __ATOMIC_RELAXED, __HIP_MEMORY_SCOPE_AGENT); }
__device__ __forceinline__ unsigned xb_xcc_id() { return (unsigned)__builtin_amdgcn_s_getreg((3 << 11) | 20) & 0xFu; }
#define XB_SPIN(cond, bar) do { unsigned _sp = 0; while (cond) { __builtin_amdgcn_s_sleep(1); \
    if ((++_sp & 255u) == 0u) { if (xb_ld(&(bar)[XB_TMO])) break; if (_sp > XB_SPIN_CAP) { atomicAdd(&(bar)[XB_TMO], 1u); break; } } } } while (0)

struct XcdBarrier { unsigned* bar; unsigned x; volatile LAS unsigned* st; };

__device__ __forceinline__ XcdBarrier xcd_barrier_post(unsigned* bar, volatile LAS unsigned* st) {
    XcdBarrier b; b.bar = bar; b.x = xb_xcc_id(); b.st = st;
    if (threadIdx.x == 0) (void)xb_add(&bar[XB_XCNT(b.x)], 1u);
    return b;
}
__device__ __forceinline__ void xcd_barrier_complete(unsigned* bar, unsigned x, unsigned& nloc, unsigned& nx) {
    const unsigned G = gridDim.x * gridDim.y * gridDim.z;
    unsigned sum, cnt, mine, sp = 0u;
    for (;;) {
        sum = 0u; cnt = 0u; mine = 0u;
        unsigned cv[16];
#pragma unroll
        for (unsigned j = 0; j < 16; ++j) cv[j] = xb_ld(&bar[XB_XCNT(j)]);
        asm volatile("" ::: "memory");
#pragma unroll
        for (unsigned j = 0; j < 16; ++j) { const unsigned c = cv[j]; sum += c; cnt += (c > 0u) ? 1u : 0u; mine = (j == x) ? c : mine; }
        if (sum == G) break;
        __builtin_amdgcn_s_sleep(1);
        if ((++sp & 255u) == 0u) { if (xb_ld(&bar[XB_TMO])) break; if (sp > XB_SPIN_CAP) { atomicAdd(&bar[XB_TMO], 1u); break; } }
    }
    nloc = mine > 0u ? mine : 1u; nx = cnt > 0u ? cnt : 1u;
}
__device__ __forceinline__ void xcd_barrier(const XcdBarrier& b) {
    asm volatile("s_waitcnt vmcnt(0)" ::: "memory");
    __syncthreads();
    if (threadIdx.x == 0) {
        unsigned* bar = b.bar;
        __builtin_amdgcn_s_waitcnt(0);
        unsigned nloc = b.st[0], nx = b.st[1];
        if (nloc == 0u) { xcd_barrier_complete(bar, b.x, nloc, nx); b.st[0] = nloc; b.st[1] = nx; }
        const unsigned old = xb_add(&bar[XB_XSUB(b.x)], 1u);
        const unsigned gen = old / nloc;
        if (old + 1u == (gen + 1u) * nloc) {
            __builtin_amdgcn_fence(__ATOMIC_RELEASE, "agent");
            asm volatile("s_waitcnt vmcnt(0)" ::: "memory");
            const unsigned og = xb_add(&bar[XB_TOP], 1u);
            const unsigned tg = og / nx;
            if (og + 1u == (tg + 1u) * nx) xb_add(&bar[XB_TOPGEN], 1u);
            else XB_SPIN(xb_ld(&bar[XB_TOPGEN]) == tg, bar);
            __builtin_amdgcn_fence(__ATOMIC_ACQUIRE, "agent");
            xb_add(&bar[XB_XGEN(b.x)], 1u);
            asm volatile("s_waitcnt vmcnt(0)" ::: "memory");
        } else {
            XB_SPIN(xb_ld(&bar[XB_XGEN(b.x)]) == gen, bar);
            __builtin_amdgcn_fence(__ATOMIC_ACQUIRE, "agent");
            asm volatile("s_waitcnt vmcnt(0)" ::: "memory");
        }
    }
    __syncthreads();
}

#ifndef STAGGER
#define STAGGER 0
#endif
__device__ __forceinline__ void stagger_wait(int bid, int us) {
    if (STAGGER && ((bid >> 3) & 1)) { const unsigned long long t0 = __builtin_amdgcn_s_memrealtime(); while (__builtin_amdgcn_s_memrealtime() - t0 < (unsigned long long)us * 100ull) __builtin_amdgcn_s_sleep(8); }
}
struct Args { const float* in[26]; float* out; unsigned char* ws; int ph_lo, ph_hi; };
typedef const Args __attribute__((address_space(4)))* KArgs;
#define KA() ({ KArgs p_ = (KArgs)__builtin_amdgcn_kernarg_segment_ptr(); asm volatile("" : "+s"(p_)); p_; })
struct Frame {
    LAS unsigned char* lds;
    int tid, lane, wave, G, bid;
    int w0;
};

template <int MAP, int F8 = 0, int RB = (F8 == 2 ? 64 : 0)>
__device__ __forceinline__ void transpose_item(const float* W, int K, int N, bf16* WT, int row_off, LAS float* scr, int item, int lane, float wscale = F8_SW) {
    const int nblk = N / 32, kb = item / nblk, nb = item % nblk, k0 = 64 * kb, n0 = 32 * nb;
    float vld[32];
#pragma unroll
    for (int i = 0; i < 32; ++i) vld[i] = W[(size_t)(k0 + 2 * i + (lane >> 5)) * N + n0 + (lane & 31)];
    asm volatile("" ::: "memory");
    if constexpr (RB != 0) {
#pragma unroll
        for (int t = 1; 2 * t < RB; t <<= 1)
#pragma unroll
            for (int i = 0; i < 32; ++i) if (!(i & t)) { const float a = vld[i], b = vld[i | t]; vld[i] = a + b; vld[i | t] = a - b; }
#pragma unroll
        for (int i = 0; i < 32; ++i) { const float pv = shx(vld[i], 32, lane); vld[i] = (lane & 32) ? pv - vld[i] : vld[i] + pv; }
        wscale *= (RB == 64 ? 0.125f : 0.35355339f);
    }
#pragma unroll
    for (int i = 0; i < 32; ++i) scr[(2 * i + (lane >> 5)) * 33 + (lane & 31)] = vld[i];
    LDS_WAIT(); asm volatile("" ::: "memory");
    const int c = lane & 7;
#pragma unroll
    for (int j = 0; j < 4; ++j) { const int n = (lane >> 3) + 8 * j; const LAS float* s = scr + (8 * c) * 33 + n;
        v4u o; o.x = pk2(s[0 * 33], s[1 * 33]); o.y = pk2(s[2 * 33], s[3 * 33]); o.z = pk2(s[4 * 33], s[5 * 33]); o.w = pk2(s[6 * 33], s[7 * 33]);
        const int nn = n0 + n; const int row = (MAP == 0) ? (row_off + nn) : ((nn >> 7) * 256 + row_off + (nn & 127));
        if constexpr (F8) { typedef unsigned v2u_ __attribute__((ext_vector_type(2))); v2u_ o8;
            o8.x = pk4_q<F8>(s[0 * 33] * wscale, s[1 * 33] * wscale, s[2 * 33] * wscale, s[3 * 33] * wscale); o8.y = pk4_q<F8>(s[4 * 33] * wscale, s[5 * 33] * wscale, s[6 * 33] * wscale, s[7 * 33] * wscale);
            *(v2u_*)((unsigned char*)WT + (size_t)row * K + k0 + 8 * c) = o8; }
        else *(v4u*)(WT + (size_t)row * K + k0 + 8 * c) = o; }
    LDS_WAIT(); asm volatile("" ::: "memory");
}

static_assert(Q_PROJ == 2 && Q_GATE == 2 && Q_BR == 2 && Q_WO == 2 && Q_FUP == 2 && Q_FDN == 2 && Q_MUP == 2 && Q_MDN == 2, "the pipelined conversion writes int8 rows only");
__device__ __forceinline__ void cv_load(const float* src, int N, int lane, float (&v)[32]) {
    const float* p = src + (size_t)(lane >> 5) * N + (lane & 31);
#pragma unroll
    for (int i = 0; i < 32; ++i) v[i] = p[(size_t)(2 * i) * N];
}
__device__ __forceinline__ void cv_store(float (&vld)[32], unsigned char* WTk, int K, int n0, int row_off, int fl, float wscale, LAS float* scr, int lane) {
#pragma unroll
    for (int t = 1; t < 4; t <<= 1)
#pragma unroll
        for (int i = 0; i < 32; ++i) if (!(i & t)) { const float a = vld[i], b = vld[i | t]; vld[i] = a + b; vld[i | t] = a - b; }
    if (fl & 2) {
#pragma unroll
        for (int t = 4; t < 32; t <<= 1)
#pragma unroll
            for (int i = 0; i < 32; ++i) if (!(i & t)) { const float a = vld[i], b = vld[i | t]; vld[i] = a + b; vld[i | t] = a - b; }
    }
#pragma unroll
    for (int i = 0; i < 32; ++i) { const float pv = shx(vld[i], 32, lane); vld[i] = (lane & 32) ? pv - vld[i] : vld[i] + pv; }
    wscale *= (fl & 2) ? 0.125f : 0.35355339f;
#pragma unroll
    for (int i = 0; i < 32; ++i) scr[(2 * i + (lane >> 5)) * 33 + (lane & 31)] = vld[i];
    LDS_WAIT(); asm volatile("" ::: "memory");
    const int c = lane & 7;
#pragma unroll
    for (int j = 0; j < 4; ++j) { const int n = (lane >> 3) + 8 * j; const LAS float* s = scr + (8 * c) * 33 + n;
        const int nn = n0 + n; const int row = (fl & 1) ? ((nn >> 7) * 256 + row_off + (nn & 127)) : (row_off + nn);
        typedef unsigned v2u_ __attribute__((ext_vector_type(2))); v2u_ o8;
        o8.x = pk4_q<2>(s[0 * 33] * wscale, s[1 * 33] * wscale, s[2 * 33] * wscale, s[3 * 33] * wscale); o8.y = pk4_q<2>(s[4 * 33] * wscale, s[5 * 33] * wscale, s[6 * 33] * wscale, s[7 * 33] * wscale);
        *(v2u_*)(WTk + (size_t)row * K + 8 * c) = o8; }
    LDS_WAIT(); asm volatile("" ::: "memory");
}
#define CV_PIPE(nitems_, DECODE) do { \
        float va[32]; int it = gw; const float* src_; int N_, K_, n0_, ro_, fl_; unsigned char* dst_; float ws_; \
        if (it < (nitems_)) { DECODE(it); cv_load(src_, N_, F.lane, va); } \
        unsigned char* cdst = dst_; int cK = K_, cn0 = n0_, cro = ro_, cfl = fl_; float cws = ws_; \
        while (it < (nitems_)) { \
            const int nx = it + NGW; float vb[32]; \
            if (nx < (nitems_)) { DECODE(nx); cv_load(src_, N_, F.lane, vb); } \
            asm volatile("" ::: "memory"); \
            cv_store(va, cdst, cK, cn0, cro, cfl, cws, scr, F.lane); \
            _Pragma("unroll") for (int i = 0; i < 32; ++i) va[i] = vb[i]; \
            cdst = dst_; cK = K_; cn0 = n0_; cro = ro_; cfl = fl_; cws = ws_; it = nx; } \
    } while (0)

__device__ __forceinline__ void p_prologue(Frame& F, KArgs ka) {
    const float* c = ka->in[1]; const float* ada_w = ka->in[2]; const float* ada_b = ka->in[3];
    unsigned char* aws = ka->ws; float* mod = (float*)(aws + WS_MOD);
    LAS float* cact = (LAS float*)F.lds;
    LAS float* red = cact + 8192;
    for (int i = F.tid; i < BATCH * D; i += NT) cact[i] = siluf_(c[i]);
    __syncthreads();
    for (int chunk = F.bid; chunk < 256; chunk += F.G) {
        const int l = chunk >> 7, n0 = (chunk & 127) * 48;
        if (F.tid < 480) {
            const int kg = F.tid / 48, col = F.tid % 48;
            float acc[8];
#pragma unroll
            for (int b = 0; b < 8; ++b) acc[b] = 0.f;
            const float* wp = ada_w + (size_t)l * D * MOD_LD + n0 + col;
            for (int kb = kg; kb < D; kb += 160) {
                float wv[16];
#pragma unroll
                for (int j = 0; j < 16; ++j) { const int k = kb + 10 * j; wv[j] = (k < D) ? wp[(size_t)k * MOD_LD] : 0.f; }
                asm volatile("" ::: "memory");
#pragma unroll
                for (int j = 0; j < 16; ++j) { const int k = kb + 10 * j; if (k < D) {
#pragma unroll
                    for (int b = 0; b < 8; ++b) acc[b] += cact[b * D + k] * wv[j]; } } }
#pragma unroll
            for (int b = 0; b < 8; ++b) red[(kg * 48 + col) * 8 + b] = acc[b];
        }
        __syncthreads();
        if (F.tid < 384) {
            const int col = F.tid >> 3, b = F.tid & 7; float s = 0.f;
#pragma unroll
            for (int kg = 0; kg < 10; ++kg) s += red[(kg * 48 + col) * 8 + b];
            mod[(size_t)(l * 8 + b) * MOD_LD + n0 + col] = s + ada_b[l * MOD_LD + n0 + col];
        }
        __syncthreads();
    }
}
__device__ __forceinline__ float wscale_sample(const float* W, size_t n, int lane) {
    float ss = 0.f;
#pragma unroll
    for (int j = 0; j < 32; ++j) { const size_t idx = ((size_t)(lane + 64 * j) * 1000003ull) % n; const float v = W[idx]; ss += v * v; }
    ss = wave_sum(ss, lane);
    return 127.0f / (W_CLIP * sqrtf(ss * (1.0f / 2048.0f)) + 1e-30f);
}
__device__ __forceinline__ void p_convert_mixer(Frame& F, KArgs ka, int l, bool with_ffn) {
    unsigned char* aws = ka->ws;
    LAS float* scr = (LAS float*)(F.lds + F.wave * 16384);
    const int gw = F.bid * NWAVES + F.wave, NGW = F.G * NWAVES;
    constexpr int I_BCA = (D / 64) * (N_BCA / 32), I_G = (D / 64) * (N_G / 32), I_BR = (512 / 64) * (D / 32), I_O = (D / 64) * (D / 32), I_L = I_BCA + I_G + 3 * I_BR + I_O;
    constexpr int I_F1 = (D / 64) * (D_FF / 32), I_F2 = (D_FF / 64) * (D / 32);
    const int nitems = I_L + (with_ffn ? 2 * I_F1 + I_F2 : 0);
    bf16* base = (bf16*)(aws + WS_WMIX);
    LAS float* qsl = (LAS float*)(F.lds + TAB_OFF + 3072);
    __syncthreads();
    if (F.wave == 0) { const float v = wscale_sample(ka->in[6] + (size_t)l * D * N_IN, (size_t)D * N_IN, F.lane); if (F.lane == 0) qsl[0] = v; }
    if (F.wave == 1) { const float v = wscale_sample(ka->in[17], (size_t)D * D_FF, F.lane); if (F.lane == 0) qsl[1] = v; }
    if (F.wave == 2) { const float v = wscale_sample(ka->in[18], (size_t)D * D_FF, F.lane); if (F.lane == 0) qsl[2] = v; }
    if (F.wave >= 3 && F.wave < 6) { const float v = wscale_sample(ka->in[13 + F.wave - 3] + (size_t)l * 512 * D, (size_t)512 * D, F.lane); if (F.lane == 0) qsl[F.wave] = v; }
    if (F.wave == 6) { const float v = wscale_sample(ka->in[16] + (size_t)l * D * D, (size_t)D * D, F.lane); if (F.lane == 0) qsl[6] = v; }
    if (F.wave == 7) { const float v = wscale_sample(ka->in[19], (size_t)D_FF * D, F.lane); if (F.lane == 0) qsl[7] = v; }
    __syncthreads();
    const float ws_in = qsl[0], ws_13 = (Q_FUP == 2) ? fminf(qsl[1], qsl[2]) : F8_SW;
    const float ws_p = (Q_PROJ == 2) ? ws_in : F8_SW, ws_g = (Q_GATE == 2) ? ws_in : F8_SW;
    const float ws_ba = qsl[3], ws_bb = qsl[4], ws_bc = qsl[5], ws_o = qsl[6], ws_2 = (Q_FDN == 2) ? qsl[7] : F8_SW;
    if (F.bid == 0 && F.tid == 0) { float* qs = (float*)(aws + WS_QS); qs[QS_IN] = ws_in; qs[QS_BR] = ws_ba; qs[QS_BR + 1] = ws_bb; qs[QS_BR + 2] = ws_bc; qs[QS_WO] = ws_o; if (with_ffn) { qs[QS_F13] = ws_13; qs[QS_F2] = ws_2; } }
    const float* in6 = ka->in[6] + (size_t)l * D * N_IN;
    constexpr int BRS = Q_BR ? 512 * 1024 / 2 : 512 * 1024;
#define CV_DEC_MIX(it_) do { int r = (it_); int kb, nb; const float* W; \
        if (r < I_BCA) { kb = r / (N_BCA / 32); nb = r % (N_BCA / 32); W = in6; K_ = D; N_ = N_IN; dst_ = (unsigned char*)base; ro_ = 0; fl_ = 2; ws_ = ws_p; }                         \
        else if ((r -= I_BCA) < I_G) { kb = r / (N_G / 32); nb = r % (N_G / 32) + N_BCA / 32; W = in6; K_ = D; N_ = N_IN; dst_ = aws + WS_WMIX + WMIX_G8; ro_ = -N_BCA; fl_ = 2; ws_ = ws_g; }     \
        else if ((r -= I_G) < 3 * I_BR) { const int b = r / I_BR; r -= b * I_BR; kb = r / (D / 32); nb = r % (D / 32); W = ka->in[13 + b] + (size_t)l * 512 * D; K_ = 512; N_ = D; dst_ = (unsigned char*)(base + (size_t)N_IN * D + (size_t)b * BRS); ro_ = 0; fl_ = (b == 0) ? 2 : 0; ws_ = (b == 0) ? ws_ba : (b == 1) ? ws_bb : ws_bc; }     \
        else if ((r -= 3 * I_BR) < I_O) { kb = r / (D / 32); nb = r % (D / 32); W = ka->in[16] + (size_t)l * D * D; K_ = D; N_ = D; dst_ = (unsigned char*)(base + (size_t)N_IN * D + 3 * 512 * 1024); ro_ = 0; fl_ = 0; ws_ = ws_o; } \
        else if ((r -= I_O) < 2 * I_F1) { const int h = r / I_F1; r -= h * I_F1; kb = r / (D_FF / 32); nb = r % (D_FF / 32); W = ka->in[17 + h]; K_ = D; N_ = D_FF; dst_ = aws + WS_W13; ro_ = 128 * h; fl_ = 3; ws_ = ws_13; } \
        else { r -= 2 * I_F1; kb = r / (D / 32); nb = r % (D / 32); W = ka->in[19]; K_ = D_FF; N_ = D; dst_ = aws + WS_W2; ro_ = 0; fl_ = 0; ws_ = ws_2; } \
        src_ = W + (size_t)(64 * kb) * N_ + 32 * nb; dst_ += 64 * kb; n0_ = 32 * nb; } while (0)
    CV_PIPE(nitems, CV_DEC_MIX);
#undef CV_DEC_MIX
}
__device__ __forceinline__ void p_moe_weights(Frame& F, KArgs ka) {
    unsigned char* aws = ka->ws;
    LAS float* scr = (LAS float*)(F.lds + F.wave * 16384);
    const int gw = F.bid * NWAVES + F.wave, NGW = F.G * NWAVES;
    constexpr int I_F1 = (D / 64) * (D_FF / 32), I_F2 = (D_FF / 64) * (D / 32), I_E = 2 * I_F1 + I_F2;
    LAS float* qsl = (LAS float*)(F.lds + TAB_OFF + 3072);
    __syncthreads();
    if (F.wave == 0) { const float v = wscale_sample(ka->in[22], (size_t)NE * D * D_FF, F.lane); if (F.lane == 0) qsl[0] = v; }
    if (F.wave == 1) { const float v = wscale_sample(ka->in[23], (size_t)NE * D * D_FF, F.lane); if (F.lane == 0) qsl[1] = v; }
    if (F.wave == 2) { const float v = wscale_sample(ka->in[24], (size_t)NE * D_FF * D, F.lane); if (F.lane == 0) qsl[2] = v; }
    __syncthreads();
    const float ws_13 = (Q_MUP == 2) ? fminf(qsl[0], qsl[1]) : F8_SW, ws_2 = (Q_MDN == 2) ? qsl[2] : F8_SW;
    if (F.bid == 0 && F.tid == 0) { float* qs = (float*)(aws + WS_QS); qs[QS_M13] = ws_13; qs[QS_M2] = ws_2; }
#define CV_DEC_MOE(it_) do { const int e = (it_) / I_E; int r = (it_) - e * I_E; int kb, nb; const float* W; \
        if (r < 2 * I_F1) { const int h = r / I_F1; r -= h * I_F1; kb = r / (D_FF / 32); nb = r % (D_FF / 32); W = ka->in[22 + h] + (size_t)e * D * D_FF; K_ = D; N_ = D_FF; dst_ = aws + WS_WM13 + (size_t)e * N13 * D * MOE_ES; ro_ = 128 * h; fl_ = 3; ws_ = ws_13; } \
        else { r -= 2 * I_F1; kb = r / (D / 32); nb = r % (D / 32); W = ka->in[24] + (size_t)e * D_FF * D; K_ = D_FF; N_ = D; dst_ = aws + WS_WM2 + (size_t)e * D * D_FF * MOE_ES; ro_ = 0; fl_ = 0; ws_ = ws_2; } \
        src_ = W + (size_t)(64 * kb) * N_ + 32 * nb; dst_ += 64 * kb; n0_ = 32 * nb; } while (0)
    CV_PIPE(NE * I_E, CV_DEC_MOE);
#undef CV_DEC_MOE
}

__device__ __forceinline__ void norm_row(const float* xrow, const float* w, const float* sc, const float* sh, int lane, f32x4 (&o)[4]) {
    const f32x4* xr = (const f32x4*)xrow + lane;
    f32x4 v[4]; float s = 0.f;
#pragma unroll
    for (int j = 0; j < 4; ++j) { v[j] = xr[64 * j]; s += (v[j].x * v[j].x + v[j].y * v[j].y) + (v[j].z * v[j].z + v[j].w * v[j].w); }
    const float rstd = 1.0f / sqrtf(wave_sum(s, lane) * (1.0f / D) + EPS);
#pragma unroll
    for (int j = 0; j < 4; ++j) { const f32x4 wv = ((const f32x4*)w)[lane + 64 * j], scv = ((const f32x4*)sc)[lane + 64 * j], shv = ((const f32x4*)sh)[lane + 64 * j];
        o[j] = v[j] * rstd * wv * (scv + 1.0f) + shv; }
}
template <bool XBF>
__device__ __forceinline__ f32x4 load_x4(const void* xbase, size_t row, int lane, int j) {
    if constexpr (XBF) { typedef unsigned v2u_ __attribute__((ext_vector_type(2))); const v2u_ w = ((const v2u_*)((const bf16*)xbase + row * XLD))[lane + 64 * j];
        return (f32x4){bf_lo(w.x), bf_hi(w.x), bf_lo(w.y), bf_hi(w.y)}; }
    else return ((const f32x4*)((const float*)xbase + row * D))[lane + 64 * j];
}
__device__ __forceinline__ void store_row_bf16(bf16* orow, int lane, const f32x4 (&o)[4]) {
    unsigned long long* o8 = (unsigned long long*)orow + lane;
#pragma unroll
    for (int j = 0; j < 4; ++j) o8[64 * j] = (unsigned long long)pk2(o[j].x, o[j].y) | ((unsigned long long)pk2(o[j].z, o[j].w) << 32);
}
template <int MODE = 0, bool XBF = true, int HQ = 2>
__device__ __forceinline__ void p_norm(Frame& F, const void* xin, const float* w, const float* mod_l, int sc_off, int sh_off, bf16* hout, unsigned char* hout8 = nullptr, float sa = 1.0f) {
    const int gw = F.bid * NWAVES + F.wave, NGW = F.G * NWAVES, lane = F.lane;
    f32x4 wv[4];
#pragma unroll
    for (int j = 0; j < 4; ++j) wv[j] = ((const f32x4*)w)[lane + 64 * j];
    for (int r0 = gw * 4; r0 < M; r0 += NGW * 4) {
        const float* mb = mod_l + (size_t)(r0 >> 12) * MOD_LD;
        f32x4 v[4][4], scv[4], shv[4];
#pragma unroll
        for (int r = 0; r < 4; ++r)
#pragma unroll
            for (int j = 0; j < 4; ++j) v[r][j] = load_x4<XBF>(xin, (size_t)(r0 + r), lane, j);
#pragma unroll
        for (int j = 0; j < 4; ++j) { scv[j] = ((const f32x4*)(mb + sc_off))[lane + 64 * j]; shv[j] = ((const f32x4*)(mb + sh_off))[lane + 64 * j]; }
        asm volatile("" ::: "memory");
#pragma unroll
        for (int j = 0; j < 4; ++j) scv[j] = wv[j] * (scv[j] + 1.0f);
#pragma unroll
        for (int r = 0; r < 4; ++r) { float s = 0.f;
#pragma unroll
            for (int j = 0; j < 4; ++j) s += (v[r][j].x * v[r][j].x + v[r][j].y * v[r][j].y) + (v[r][j].z * v[r][j].z + v[r][j].w * v[r][j].w);
            const float rstd = 1.0f / sqrtf(wave_sum(s, lane) * (1.0f / D) + EPS);
            f32x4 o[4];
#pragma unroll
            for (int j = 0; j < 4; ++j) o[j] = v[r][j] * rstd * scv[j] + shv[j];
            if constexpr (MODE != 0) { unsigned* o4 = (unsigned*)((MODE == 1 ? (unsigned char*)hout : hout8) + (size_t)(r0 + r) * D) + lane;
#pragma unroll
                for (int j = 0; j < 4; ++j) { const f32x4 q = (HQ == 2) ? rot64(o[j], lane) : o[j]; o4[64 * j] = pk4_q<HQ>(q.x * sa, q.y * sa, q.z * sa, q.w * sa); } }
            if constexpr (MODE != 1) store_row_bf16(hout + (size_t)(r0 + r) * D, lane, o); }
    }
}

constexpr int CONV_RUN = 16;
__device__ __forceinline__ void p_conv(Frame& F, const bf16* P1, const float* conv_w, bf16* ya) {
    const int gt = F.bid * NT + F.tid, NGT = F.G * NT;
    for (int run = gt >> 6; run < M / CONV_RUN; run += NGT >> 6) {
        const int c8 = (gt & 63) * 8, row0 = run * CONV_RUN, pos0 = row0 & (SEQ - 1);
        const unsigned char* p = (const unsigned char*)P1 + (size_t)row0 * P1_PITCH + c8;
        float w0[8], w1[8], w2[8], z1[8], z2[8];
#pragma unroll
        for (int i = 0; i < 8; ++i) { w0[i] = conv_w[c8 + i]; w1[i] = conv_w[512 + c8 + i]; w2[i] = conv_w[1024 + c8 + i]; z1[i] = 0.f; z2[i] = 0.f; }
        if (pos0 >= 2) {
            float c1[8], h1[8], c2[8], h2[8];
            decode8u(*(const v2u_p1*)(p - P1_PITCH + 512), c1); decode8u(*(const v2u_p1*)(p - P1_PITCH + 1024), h1);
            decode8u(*(const v2u_p1*)(p - 2 * P1_PITCH + 512), c2); decode8u(*(const v2u_p1*)(p - 2 * P1_PITCH + 1024), h2);
#pragma unroll
            for (int i = 0; i < 8; ++i) { z1[i] = c1[i] * h1[i]; z2[i] = c2[i] * h2[i]; } }
        v2u_p1 nb = *(const v2u_p1*)p, nc = *(const v2u_p1*)(p + 512), nh = *(const v2u_p1*)(p + 1024);
#pragma unroll 2
        for (int k = 0; k < CONV_RUN; ++k) {
            const v2u_p1 rb = nb, rc = nc, rh = nh;
            if (k + 1 < CONV_RUN) { const unsigned char* pn = p + (size_t)(k + 1) * P1_PITCH; nb = *(const v2u_p1*)pn; nc = *(const v2u_p1*)(pn + 512); nh = *(const v2u_p1*)(pn + 1024); }
            float ab[8], ac[8], ah[8], y[8];
            decode8u(rb, ab); decode8u(rc, ac); decode8u(rh, ah);
#pragma unroll
            for (int i = 0; i < 8; ++i) { const float z = ac[i] * ah[i]; y[i] = ab[i] * (w0[i] * z + w1[i] * z1[i] + w2[i] * z2[i]); z2[i] = z1[i]; z1[i] = z; }
            store_y8<Q_BR>(ya, (size_t)(row0 + k) * 512 + c8, y, F.lane, CLIP_YA);
        }
    }
}

typedef short v4i16_t __attribute__((ext_vector_type(4)));
typedef short bf16x8_t __attribute__((ext_vector_type(8)));
typedef unsigned v2u __attribute__((ext_vector_type(2)));
constexpr int HRS = 272;
constexpr int TRS = 80;
constexpr int H_RAWQ = 0, H_RAWF = 8704, H_V = 17408, H_QHT = 26112, H_KTT = 36352, H_KHT = 46592, H_DL = 56832, H_OB = 57344, H_OBS = 132, H_V2 = 74240;
constexpr int HSEG = 512, HNSEG = SEQ / HSEG, HCH = 32;
__device__ __forceinline__ v4i16_t tr_read(LAS unsigned char* p) { return __builtin_amdgcn_ds_read_tr16_b64_v4i16((LAS v4i16_t*)p); }
__device__ __forceinline__ bf16x8_t cat4(v4i16_t lo, v4i16_t hi) { return __builtin_shufflevector(lo, hi, 0, 1, 2, 3, 4, 5, 6, 7); }
__device__ __forceinline__ bf16x8_t pack_acc(const f32x4 a, const f32x4 b) { v4u w; w.x = pk2(a[0], a[1]); w.y = pk2(a[2], a[3]); w.z = pk2(b[0], b[1]); w.w = pk2(b[2], b[3]); return __builtin_bit_cast(bf16x8_t, w); }
__device__ __forceinline__ float bfs(short x) { return __uint_as_float((unsigned)(unsigned short)x << 16); }
template <int PASS>
__device__ __forceinline__ void p_hgrn(Frame& F, const bf16* P1, const float* lb_logits, int layer, const float* norm_w, bf16* yb, float* ust, float* dst) {
    LAS unsigned char* L = F.lds;
    const int lane = F.lane, w = F.wave, g = lane >> 4, n = lane & 15, q_ = n >> 2, p_ = n & 3;
    const int pt = F.tid >> 4, pc8 = (F.tid & 15) * 8;
    for (int u = F.bid; u < BATCH * H_B * HNSEG; u += F.G) {
        const int seg = u & (HNSEG - 1), bh = u / HNSEG, b = bh >> 2, h = bh & 3;
        const int d = 16 * w + n;
        float lb; { const int ch = h * 128 + d; const float l0 = lb_logits[ch], l1 = lb_logits[512 + ch]; const float mx = fmaxf(l0, l1);
            const float e0 = expf(l0 - mx), e1 = expf(l1 - mx); const float p0 = e0 / (e0 + e1), p1 = e1 / (e0 + e1);
            const float lbx = (layer == 0) ? (p0 - p0) : ((p0 + p1) - p0); lb = fminf(fmaxf(lbx, 0.f), 1.f); }
        const float lbf = fmaxf(lb, 1e-30f), oml = 1.0f - lb;
        f32x4 S[8];
#pragma unroll
        for (int kt = 0; kt < 8; ++kt) S[kt] = (f32x4){0.f, 0.f, 0.f, 0.f};
        if (PASS == 2) {
#pragma unroll 2
            for (int j = 0; j < seg; ++j) { const int uj = u - seg + j;
#pragma unroll
                for (int kt = 0; kt < 8; ++kt) { const f32x4 dj = *(const f32x4*)(dst + (size_t)uj * 128 + 16 * kt + 4 * g); const f32x4 uu = *(const f32x4*)(ust + ((((size_t)uj * 8 + w) * 8 + kt) * 64 + lane) * 4);
                    S[kt] = dj * S[kt] + uu; } }
        }
        float nw8[8];
        if (PASS == 2) {
#pragma unroll
            for (int i = 0; i < 8; ++i) nw8[i] = norm_w[h * 128 + pc8 + i]; }
        float dprod = 1.0f;
        const bf16* gp = P1 + ((size_t)b * SEQ + (size_t)seg * HSEG + pt) * P1E + P1_OB / 2 + h * 128 + pc8;
        constexpr int HPF = 4, NCH = HSEG / HCH;
        v4u rq[HPF], rf[HPF], rv[HPF], rg[HPF];
#pragma unroll
        for (int k = 0; k < HPF; ++k) { const bf16* np = gp + (size_t)k * HCH * P1E; rf[k] = *(const v4u*)(np + 512); rv[k] = *(const v4u*)(np + 1024);
            if (PASS == 2) { rq[k] = *(const v4u*)np; rg[k] = *(const v4u*)(np + 1536); } }
#define HG_WRITE(k_, vb_) do { *(LAS v4u*)(L + H_RAWF + pt * HRS + pc8 * 2) = rf[k_]; *(LAS v4u*)(L + ((vb_) ? H_V2 : H_V) + pt * HRS + pc8 * 2) = rv[k_]; \
            if (PASS == 2) *(LAS v4u*)(L + H_RAWQ + pt * HRS + pc8 * 2) = rq[k_]; } while (0)
#define HG_REFILL(k_, cn_) do { if ((cn_) < NCH) { const bf16* np = gp + (size_t)(cn_) * HCH * P1E; rf[k_] = *(const v4u*)(np + 512); rv[k_] = *(const v4u*)(np + 1024); \
            if (PASS == 2) { rq[k_] = *(const v4u*)np; rg[k_] = *(const v4u*)(np + 1536); } } } while (0)
        v4u cg, cgn;
        HG_WRITE(0, 0); if (PASS == 2) cg = rg[0];
        LDS_BARRIER();
        HG_REFILL(0, HPF);
            { const bf16x8_t f8 = cat4(tr_read(L + H_RAWF + (8 * g + q_) * HRS + 32 * w + 8 * p_), tr_read(L + H_RAWF + (8 * g + 4 + q_) * HRS + 32 * w + 8 * p_));
              float eb[8], kk[8]; float cp = 1.0f;
#pragma unroll
              for (int i = 0; i < 8; ++i) { const float sg = __builtin_amdgcn_rcpf(1.0f + __expf(-bfs(f8[i]))); const float f = lbf + oml * sg; kk[i] = oml * (1.0f - sg); cp *= f; eb[i] = cp; }
              const float s1 = shl(cp, n), s2 = shl(cp, 16 + n), s3 = shl(cp, 32 + n), s4 = shl(cp, 48 + n);
              const float pre = (g > 0 ? s1 : 1.0f) * (g > 1 ? s2 : 1.0f) * (g > 2 ? s3 : 1.0f);
              const float elast = ((s1 * s2) * s3) * s4;
              float kh[8], kt8[8];
#pragma unroll
              for (int i = 0; i < 8; ++i) { eb[i] *= pre; const float en = __builtin_amdgcn_rcpf(fmaxf(eb[i], 1e-30f)); kt8[i] = kk[i] * en; kh[i] = kt8[i] * elast; }
              *(LAS v4u*)(L + H_KHT + d * TRS + 16 * g) = pack8(kh);
              if (PASS == 2) { const bf16x8_t q8 = cat4(tr_read(L + H_RAWQ + (8 * g + q_) * HRS + 32 * w + 8 * p_), tr_read(L + H_RAWQ + (8 * g + 4 + q_) * HRS + 32 * w + 8 * p_));
                  float qh[8];
#pragma unroll
                  for (int i = 0; i < 8; ++i) qh[i] = siluf_(bfs(q8[i])) * eb[i];
                  *(LAS v4u*)(L + H_QHT + d * TRS + 16 * g) = pack8(qh); *(LAS v4u*)(L + H_KTT + d * TRS + 16 * g) = pack8(kt8); }
              if (g == 0) *(LAS float*)(L + H_DL + 4 * d) = elast;
              dprod *= elast; }
        LDS_BARRIER();
        for (int c0 = 0; c0 < NCH; c0 += HPF) {
#pragma unroll
          for (int k = 0; k < HPF; ++k) {
            const int c = c0 + k; const int vbuf = (k & 1) ? H_V2 : H_V;
            const bf16x8_t bVn = cat4(tr_read(L + vbuf + (8 * g + q_) * HRS + 32 * w + 8 * p_), tr_read(L + vbuf + (8 * g + 4 + q_) * HRS + 32 * w + 8 * p_));
            if (PASS == 2) {
                const bf16x8_t bVp = cat4(tr_read(L + vbuf + (4 * g + q_) * HRS + 32 * w + 8 * p_), tr_read(L + vbuf + (16 + 4 * g + q_) * HRS + 32 * w + 8 * p_));
                f32x4 o[2], pt00 = {0.f, 0.f, 0.f, 0.f}, pt01 = {0.f, 0.f, 0.f, 0.f}, pt11 = {0.f, 0.f, 0.f, 0.f};
                o[0] = (f32x4){0.f, 0.f, 0.f, 0.f}; o[1] = (f32x4){0.f, 0.f, 0.f, 0.f};
#pragma unroll
                for (int ks = 0; ks < 4; ++ks) {
                    const bf16x8_t sb = pack_acc(S[2 * ks], S[2 * ks + 1]);
#pragma unroll
                    for (int tm = 0; tm < 2; ++tm) {
                        const bf16x8_t aq = cat4(tr_read(L + H_QHT + (32 * ks + 4 * g + q_) * TRS + 32 * tm + 8 * p_), tr_read(L + H_QHT + (32 * ks + 16 + 4 * g + q_) * TRS + 32 * tm + 8 * p_));
                        o[tm] = __builtin_amdgcn_mfma_f32_16x16x32_bf16(aq, sb, o[tm], 0, 0, 0); }
                    const bf16x8_t aK0 = cat4(tr_read(L + H_KTT + (32 * ks + 8 * g + q_) * TRS + 8 * p_), tr_read(L + H_KTT + (32 * ks + 8 * g + 4 + q_) * TRS + 8 * p_));
                    const bf16x8_t aK1 = cat4(tr_read(L + H_KTT + (32 * ks + 8 * g + q_) * TRS + 32 + 8 * p_), tr_read(L + H_KTT + (32 * ks + 8 * g + 4 + q_) * TRS + 32 + 8 * p_));
                    const bf16x8_t bQ0 = cat4(tr_read(L + H_QHT + (32 * ks + 8 * g + q_) * TRS + 8 * p_), tr_read(L + H_QHT + (32 * ks + 8 * g + 4 + q_) * TRS + 8 * p_));
                    const bf16x8_t bQ1 = cat4(tr_read(L + H_QHT + (32 * ks + 8 * g + q_) * TRS + 32 + 8 * p_), tr_read(L + H_QHT + (32 * ks + 8 * g + 4 + q_) * TRS + 32 + 8 * p_));
                    pt00 = __builtin_amdgcn_mfma_f32_16x16x32_bf16(aK0, bQ0, pt00, 0, 0, 0);
                    pt01 = __builtin_amdgcn_mfma_f32_16x16x32_bf16(aK0, bQ1, pt01, 0, 0, 0);
                    pt11 = __builtin_amdgcn_mfma_f32_16x16x32_bf16(aK1, bQ1, pt11, 0, 0, 0);
                }
#pragma unroll
                for (int j = 0; j < 4; ++j) if (4 * g + j > n) { pt00[j] = 0.f; pt11[j] = 0.f; }
                const f32x4 z4 = {0.f, 0.f, 0.f, 0.f};
                o[0] = __builtin_amdgcn_mfma_f32_16x16x32_bf16(pack_acc(pt00, z4), bVp, o[0], 0, 0, 0);
                o[1] = __builtin_amdgcn_mfma_f32_16x16x32_bf16(pack_acc(pt01, pt11), bVp, o[1], 0, 0, 0);
#pragma unroll
                for (int tm = 0; tm < 2; ++tm)
#pragma unroll
                    for (int j = 0; j < 4; ++j) *(LAS float*)(L + H_OB + ((16 * tm + 4 * g + j) * H_OBS + 16 * w + n) * 4) = o[tm][j];
            }
#pragma unroll
            for (int kt = 0; kt < 8; ++kt) { const f32x4 dl4 = *(const LAS f32x4*)(L + H_DL + (16 * kt + 4 * g) * 4);
                const bf16x8_t aKh = *(const LAS bf16x8_t*)(L + H_KHT + (16 * kt + n) * TRS + 16 * g);
                S[kt] = __builtin_amdgcn_mfma_f32_16x16x32_bf16(aKh, bVn, S[kt] * dl4, 0, 0, 0); }
            if (c + 1 < NCH) { HG_WRITE((k + 1) % HPF, (k + 1) & 1); if (PASS == 2) cgn = rg[(k + 1) % HPF]; }
            LDS_BARRIER();
            if (c + 1 < NCH) HG_REFILL((k + 1) % HPF, c + 1 + HPF);
            if (PASS == 2) {
                const f32x4 o0 = *(const LAS f32x4*)(L + H_OB + (pt * H_OBS + pc8) * 4), o1 = *(const LAS f32x4*)(L + H_OB + (pt * H_OBS + pc8 + 4) * 4);
                const float o8[8] = {o0.x, o0.y, o0.z, o0.w, o1.x, o1.y, o1.z, o1.w};
                float ss = 0.f;
#pragma unroll
                for (int i = 0; i < 8; ++i) ss += o8[i] * o8[i];
                ss += shx(ss, 1, lane); ss += shx(ss, 2, lane); ss += shx(ss, 4, lane); ss += shx(ss, 8, lane);
                const float rs = 1.0f / sqrtf(ss * (1.0f / 128.0f) + EPS);
                float g8[8], y[8]; unpack8(cg, g8);
#pragma unroll
                for (int i = 0; i < 8; ++i) y[i] = o8[i] * rs * nw8[i] * siluf_(g8[i]);
                store_y8<Q_BR, 8>(yb, ((size_t)b * SEQ + (size_t)seg * HSEG + (size_t)c * HCH + pt) * 512 + h * 128 + pc8, y, lane, CLIP_YB);
            }
            if (c + 1 < NCH)
            { const bf16x8_t f8 = cat4(tr_read(L + H_RAWF + (8 * g + q_) * HRS + 32 * w + 8 * p_), tr_read(L + H_RAWF + (8 * g + 4 + q_) * HRS + 32 * w + 8 * p_));
              float eb[8], kk[8]; float cp = 1.0f;
#pragma unroll
              for (int i = 0; i < 8; ++i) { const float sg = __builtin_amdgcn_rcpf(1.0f + __expf(-bfs(f8[i]))); const float f = lbf + oml * sg; kk[i] = oml * (1.0f - sg); cp *= f; eb[i] = cp; }
              const float s1 = shl(cp, n), s2 = shl(cp, 16 + n), s3 = shl(cp, 32 + n), s4 = shl(cp, 48 + n);
              const float pre = (g > 0 ? s1 : 1.0f) * (g > 1 ? s2 : 1.0f) * (g > 2 ? s3 : 1.0f);
              const float elast = ((s1 * s2) * s3) * s4;
              float kh[8], kt8[8];
#pragma unroll
              for (int i = 0; i < 8; ++i) { eb[i] *= pre; const float en = __builtin_amdgcn_rcpf(fmaxf(eb[i], 1e-30f)); kt8[i] = kk[i] * en; kh[i] = kt8[i] * elast; }
              *(LAS v4u*)(L + H_KHT + d * TRS + 16 * g) = pack8(kh);
              if (PASS == 2) { const bf16x8_t q8 = cat4(tr_read(L + H_RAWQ + (8 * g + q_) * HRS + 32 * w + 8 * p_), tr_read(L + H_RAWQ + (8 * g + 4 + q_) * HRS + 32 * w + 8 * p_));
                  float qh[8];
#pragma unroll
                  for (int i = 0; i < 8; ++i) qh[i] = siluf_(bfs(q8[i])) * eb[i];
                  *(LAS v4u*)(L + H_QHT + d * TRS + 16 * g) = pack8(qh); *(LAS v4u*)(L + H_KTT + d * TRS + 16 * g) = pack8(kt8); }
              if (g == 0) *(LAS float*)(L + H_DL + 4 * d) = elast;
              dprod *= elast; }
            LDS_BARRIER();
            if (PASS == 2) cg = cgn;
          }
        }
#undef HG_WRITE
#undef HG_REFILL
        if (PASS == 1) {
#pragma unroll
            for (int kt = 0; kt < 8; ++kt) *(f32x4*)(ust + ((((size_t)u * 8 + w) * 8 + kt) * 64 + lane) * 4) = S[kt];
            if (g == 0) dst[(size_t)u * 128 + d] = dprod;
        }
        __syncthreads();
    }
}


constexpr int H1_G = 4, H1_RF = 0, H1_RV = H1_G * 8704, H1_KH = 2 * H1_G * 8704;
__device__ __forceinline__ void p_hgrn1(Frame& F, const bf16* P1, const float* lb_logits, int layer, float* ust, float* dst) {
    LAS unsigned char* L = F.lds;
    const int lane = F.lane, w = F.wave, g = lane >> 4, n = lane & 15, q_ = n >> 2, p_ = n & 3;
    const int pt = F.tid >> 4, pc8 = (F.tid & 15) * 8;
    constexpr int NCH = HSEG / HCH;
    for (int u = F.bid; u < BATCH * H_B * HNSEG; u += F.G) {
        const int seg = u & (HNSEG - 1), bh = u / HNSEG, b = bh >> 2, h = bh & 3;
        const int d = 16 * w + n;
        float lb; { const int ch = h * 128 + d; const float l0 = lb_logits[ch], l1 = lb_logits[512 + ch]; const float mx = fmaxf(l0, l1);
            const float e0 = expf(l0 - mx), e1 = expf(l1 - mx); const float p0 = e0 / (e0 + e1), p1 = e1 / (e0 + e1);
            const float lbx = (layer == 0) ? (p0 - p0) : ((p0 + p1) - p0); lb = fminf(fmaxf(lbx, 0.f), 1.f); }
        const float lbf = fmaxf(lb, 1e-30f), oml = 1.0f - lb;
        f32x4 S[8];
#pragma unroll
        for (int kt = 0; kt < 8; ++kt) S[kt] = (f32x4){0.f, 0.f, 0.f, 0.f};
        float R = 1.0f;
        const bf16* gp = P1 + ((size_t)b * SEQ + (size_t)seg * HSEG + pt) * P1E + P1_OB / 2 + h * 128 + pc8;
        v4u rf[H1_G], rv[H1_G];
#pragma unroll
        for (int j = 0; j < H1_G; ++j) { const bf16* np = gp + (size_t)(NCH - 1 - j) * HCH * P1E; rf[j] = *(const v4u*)(np + 512); rv[j] = *(const v4u*)(np + 1024); }
#pragma unroll 1
        for (int c0 = NCH - 1; c0 >= 0; c0 -= H1_G) {
#pragma unroll
            for (int j = 0; j < H1_G; ++j) { *(LAS v4u*)(L + H1_RF + j * 8704 + pt * HRS + pc8 * 2) = rf[j]; *(LAS v4u*)(L + H1_RV + j * 8704 + pt * HRS + pc8 * 2) = rv[j]; }
            LDS_BARRIER();
            if (c0 - H1_G >= 0) {
#pragma unroll
                for (int j = 0; j < H1_G; ++j) { const bf16* np = gp + (size_t)(c0 - H1_G - j) * HCH * P1E; rf[j] = *(const v4u*)(np + 512); rv[j] = *(const v4u*)(np + 1024); } }
#pragma unroll
            for (int j = 0; j < H1_G; ++j) {
                const bf16x8_t f8 = cat4(tr_read(L + H1_RF + j * 8704 + (8 * g + q_) * HRS + 32 * w + 8 * p_), tr_read(L + H1_RF + j * 8704 + (8 * g + 4 + q_) * HRS + 32 * w + 8 * p_));
                float eb[8], kk[8]; float cp = 1.0f;
#pragma unroll
                for (int i = 0; i < 8; ++i) { const float sg = __builtin_amdgcn_rcpf(1.0f + __expf(-bfs(f8[i]))); const float f = lbf + oml * sg; kk[i] = oml * (1.0f - sg); cp *= f; eb[i] = cp; }
                const float s1 = shl(cp, n), s2 = shl(cp, 16 + n), s3 = shl(cp, 32 + n), s4 = shl(cp, 48 + n);
                const float pre = (g > 0 ? s1 : 1.0f) * (g > 1 ? s2 : 1.0f) * (g > 2 ? s3 : 1.0f);
                const float elast = ((s1 * s2) * s3) * s4, er = elast * R;
                float kh[8];
#pragma unroll
                for (int i = 0; i < 8; ++i) { const float en = __builtin_amdgcn_rcpf(fmaxf(eb[i] * pre, 1e-30f)); kh[i] = (kk[i] * en) * er; }
                *(LAS v4u*)(L + H1_KH + j * 10240 + d * TRS + 16 * g) = pack8(kh);
                R = er; }
            LDS_BARRIER();
#pragma unroll
            for (int j = 0; j < H1_G; ++j) {
                const bf16x8_t bVn = cat4(tr_read(L + H1_RV + j * 8704 + (8 * g + q_) * HRS + 32 * w + 8 * p_), tr_read(L + H1_RV + j * 8704 + (8 * g + 4 + q_) * HRS + 32 * w + 8 * p_));
#pragma unroll
                for (int kt = 0; kt < 8; ++kt) { const bf16x8_t aKh = *(const LAS bf16x8_t*)(L + H1_KH + j * 10240 + (16 * kt + n) * TRS + 16 * g);
                    S[kt] = __builtin_amdgcn_mfma_f32_16x16x32_bf16(aKh, bVn, S[kt], 0, 0, 0); } }
            LDS_BARRIER();
        }
#pragma unroll
        for (int kt = 0; kt < 8; ++kt) *(f32x4*)(ust + ((((size_t)u * 8 + w) * 8 + kt) * 64 + lane) * 4) = S[kt];
        if (g == 0) dst[(size_t)u * 128 + d] = R;
        __syncthreads();
    }
}

constexpr int SG_V = 0, SG_OB = 34816, SG_OBS = 132, SG_RS = SG_OB + 128 * SG_OBS * 4;
__device__ __forceinline__ void p_sgu(Frame& F, const bf16* P1, const float* norm_w, const float* sgu_w, const float* sgu_b, bf16* yc) {
    LAS unsigned char* L = F.lds;
    const int lane = F.lane, w = F.wave, gq = lane >> 4, n = lane & 15, q_ = n >> 2, p_ = n & 3;
    const int sr = F.tid >> 4, c8 = (F.tid & 15) * 8;
    for (int u = F.bid; u < M / 128; u += F.G) {
        const size_t row0 = (size_t)u * 128;
        v2u_p1 rv[4][4]; float ssj[4] = {0.f, 0.f, 0.f, 0.f};
#pragma unroll
        for (int g = 0; g < 4; ++g)
#pragma unroll
            for (int j = 0; j < 4; ++j) { rv[g][j] = *(const v2u_p1*)((const unsigned char*)P1 + (row0 + sr + 32 * j) * P1_PITCH + P1_OC + 512 + g * 128 + c8); float f[8]; decode8u(rv[g][j], f);
#pragma unroll
                for (int i = 0; i < 8; ++i) ssj[j] += f[i] * f[i]; }
#pragma unroll
        for (int j = 0; j < 4; ++j) { float ss = ssj[j]; ss += shx(ss, 1, lane); ss += shx(ss, 2, lane); ss += shx(ss, 4, lane); ss += shx(ss, 8, lane);
            if (n == 0) *(LAS float*)(L + SG_RS + 4 * (sr + 32 * j)) = 1.0f / sqrtf(ss * (1.0f / 512.0f) + EPS); }
        const int kmax = w >> 1, t = 16 * w + n;
        f32x4 wl[4][2]; float nwl[8];
#define SG_WLOAD(g_) do { _Pragma("unroll") for (int ks = 0; ks < 4; ++ks) { const float* wp = sgu_w + ((size_t)(g_) * 128 + t) * 128 + 32 * ks + 8 * gq; wl[ks][0] = *(const f32x4*)wp; wl[ks][1] = *(const f32x4*)(wp + 4); } \
            _Pragma("unroll") for (int ct = 0; ct < 8; ++ct) nwl[ct] = norm_w[(g_) * 128 + 16 * ct + n]; asm volatile("" ::: "memory"); } while (0)

#pragma unroll
        for (int g = 0; g < 4; ++g) {
            SG_WLOAD(g);
            v2u_p1 ul[4]; float bl[4];
#pragma unroll
            for (int j = 0; j < 4; ++j) { ul[j] = *(const v2u_p1*)((const unsigned char*)P1 + (row0 + sr + 32 * j) * P1_PITCH + P1_OC + g * 128 + c8); bl[j] = sgu_b[g * 128 + sr + 32 * j]; }
            asm volatile("" ::: "memory");
#pragma unroll
            for (int j = 0; j < 4; ++j) { v2u_p1 rw = rv[g][j]; asm volatile("" : "+v"(rw.x), "+v"(rw.y));
                float f[8]; decode8u(rw, f); *(LAS v4u*)(L + SG_V + (sr + 32 * j) * HRS + c8 * 2) = pack8(f); }
            LDS_BARRIER();
            float nwv[8];
            bf16x8_t aW[4];
            {
#pragma unroll
              for (int ct = 0; ct < 8; ++ct) nwv[ct] = nwl[ct];
#pragma unroll
              for (int ks = 0; ks < 4; ++ks) { const int s0 = 32 * ks + 8 * gq;
                    const f32x4 w0 = wl[ks][0], w1 = wl[ks][1]; const f32x4 r0 = *(const LAS f32x4*)(L + SG_RS + 4 * s0), r1 = *(const LAS f32x4*)(L + SG_RS + 4 * (s0 + 4));
                    float a8[8] = {w0.x * r0.x, w0.y * r0.y, w0.z * r0.z, w0.w * r0.w, w1.x * r1.x, w1.y * r1.y, w1.z * r1.z, w1.w * r1.w};
#pragma unroll
                    for (int i = 0; i < 8; ++i) if (s0 + i > t) a8[i] = 0.f;
                    aW[ks] = __builtin_bit_cast(bf16x8_t, pack8(a8)); } }
            f32x4 acc[8];
#pragma unroll
            for (int ct = 0; ct < 8; ++ct) acc[ct] = (f32x4){0.f, 0.f, 0.f, 0.f};
#pragma unroll
            for (int ks = 0; ks < 4; ++ks) { if (ks <= kmax) {
#pragma unroll
                for (int ct = 0; ct < 8; ++ct) { const bf16x8_t bV = cat4(tr_read(L + SG_V + (32 * ks + 8 * gq + q_) * HRS + 32 * ct + 8 * p_), tr_read(L + SG_V + (32 * ks + 8 * gq + 4 + q_) * HRS + 32 * ct + 8 * p_));
                    acc[ct] = __builtin_amdgcn_mfma_f32_16x16x32_bf16(aW[ks], bV, acc[ct], 0, 0, 0); } } }
#pragma unroll
            for (int ct = 0; ct < 8; ++ct) { const float nw = nwv[ct];
#pragma unroll
                for (int j = 0; j < 4; ++j) *(LAS float*)(L + SG_OB + ((16 * w + 4 * gq + j) * SG_OBS + 16 * ct + n) * 4) = acc[ct][j] * nw; }
            LDS_BARRIER();
#pragma unroll
            for (int j = 0; j < 4; ++j) { const int tt = sr + 32 * j; const float bias = bl[j];
                const f32x4 o0 = *(const LAS f32x4*)(L + SG_OB + (tt * SG_OBS + c8) * 4), o1 = *(const LAS f32x4*)(L + SG_OB + (tt * SG_OBS + c8 + 4) * 4);
                float uu[8], y[8]; decode8u(ul[j], uu);
                y[0] = (o0.x + bias) * uu[0]; y[1] = (o0.y + bias) * uu[1]; y[2] = (o0.z + bias) * uu[2]; y[3] = (o0.w + bias) * uu[3];
                y[4] = (o1.x + bias) * uu[4]; y[5] = (o1.y + bias) * uu[5]; y[6] = (o1.z + bias) * uu[6]; y[7] = (o1.w + bias) * uu[7];
                store_y8<Q_BR, 8>(yc, (row0 + tt) * 512 + g * 128 + c8, y, lane, CLIP_YC); }
        }
        __syncthreads();
    }
#undef SG_WLOAD
}

__device__ __forceinline__ void p_norm_router(Frame& F, KArgs ka, const void* x, const float* w, const float* mod_l, bf16* h2) {
    const float* rw = ka->in[20]; const float* rb = ka->in[21]; unsigned* ctl = (unsigned*)(ka->ws + WS_CTL);
    float* topp = (float*)(ka->ws + WS_TOPP); int* list = (int*)(ka->ws + WS_LIST);
    LAS float* RWt = (LAS float*)F.lds;
    LAS int* lcnt = (LAS int*)(RWt + 8192);
    LAS int* lbase = lcnt + 16;
    LAS int* sel = lbase + 16;
    LAS int* rnk = sel + 128;
    for (int i = F.tid; i < D * NE; i += NT) { const int k = i >> 3, e = i & 7; RWt[e * D + k] = rw[i]; }
    __syncthreads();
    float rbv[8];
#pragma unroll
    for (int e = 0; e < 8; ++e) rbv[e] = rb[e];
    f32x4 wv[4];
#pragma unroll
    for (int j = 0; j < 4; ++j) wv[j] = ((const f32x4*)w)[F.lane + 64 * j];
    for (int batch = F.bid; batch < M / 128; batch += F.G) {
        const int row0 = batch * 128;
        if (F.tid < 16) lcnt[F.tid] = 0;
        const float* mb = mod_l + (size_t)(row0 >> 12) * MOD_LD;
        f32x4 scv[4], shv[4], xn[4];
#pragma unroll
        for (int j = 0; j < 4; ++j) { scv[j] = ((const f32x4*)(mb + 4 * D))[F.lane + 64 * j]; shv[j] = ((const f32x4*)(mb + 3 * D))[F.lane + 64 * j]; xn[j] = load_x4<true>(x, (size_t)(row0 + F.wave * 16), F.lane, j); }
        asm volatile("" ::: "memory");
#pragma unroll
        for (int j = 0; j < 4; ++j) scv[j] = wv[j] * (scv[j] + 1.0f);
        __syncthreads();
        for (int rr = 0; rr < 16; ++rr) {
            const int r = F.wave * 16 + rr, row = row0 + r;
            f32x4 v[4];
#pragma unroll
            for (int j = 0; j < 4; ++j) v[j] = xn[j];
            if (rr + 1 < 16) {
#pragma unroll
                for (int j = 0; j < 4; ++j) xn[j] = load_x4<true>(x, (size_t)(row + 1), F.lane, j); }
            float ssq = 0.f;
#pragma unroll
            for (int j = 0; j < 4; ++j) ssq += (v[j].x * v[j].x + v[j].y * v[j].y) + (v[j].z * v[j].z + v[j].w * v[j].w);
            const float rstd = 1.0f / sqrtf(wave_sum(ssq, F.lane) * (1.0f / D) + EPS);
            f32x4 o[4];
#pragma unroll
            for (int j = 0; j < 4; ++j) o[j] = v[j] * rstd * scv[j] + shv[j];
            { unsigned* o4 = (unsigned*)((unsigned char*)h2 + (size_t)row * D) + F.lane;
#pragma unroll
                for (int j = 0; j < 4; ++j) { const f32x4 q = (Q_MUP == 2) ? rot64(o[j], F.lane) : o[j]; o4[64 * j] = pk4_q<Q_MUP>(q.x * sa_of(Q_MUP, CLIP_MOE), q.y * sa_of(Q_MUP, CLIP_MOE), q.z * sa_of(Q_MUP, CLIP_MOE), q.w * sa_of(Q_MUP, CLIP_MOE)); } }
            float lg[8];
#pragma unroll
            for (int e = 0; e < 8; ++e) { float s = 0.f;
#pragma unroll
                for (int j = 0; j < 4; ++j) { const f32x4 r4 = *(const LAS f32x4*)(RWt + e * D + 4 * F.lane + 256 * j); s += (o[j].x * r4.x + o[j].y * r4.y) + (o[j].z * r4.z + o[j].w * r4.w); }
                lg[e] = wave_sum(s, F.lane) + rbv[e]; }
            int i0 = 0; float v0 = lg[0];
#pragma unroll
            for (int e = 1; e < 8; ++e) if (lg[e] > v0) { v0 = lg[e]; i0 = e; }
            int i1 = -1; float v1 = -3.0e38f;
#pragma unroll
            for (int e = 0; e < 8; ++e) if (e != i0 && lg[e] > v1) { v1 = lg[e]; i1 = e; }
            if (F.lane == 0) {
                const float p0 = 1.0f / (1.0f + expf(v1 - v0));
                topp[(size_t)row * 2] = p0; topp[(size_t)row * 2 + 1] = 1.0f - p0;
                const int rk0 = __hip_atomic_fetch_add(lcnt + i0, 1, __ATOMIC_RELAXED, __HIP_MEMORY_SCOPE_WORKGROUP), rk1 = __hip_atomic_fetch_add(lcnt + 8 + i1, 1, __ATOMIC_RELAXED, __HIP_MEMORY_SCOPE_WORKGROUP);
                sel[r] = i0 | (i1 << 8); rnk[r] = rk0 | (rk1 << 16);
            }
        }
        __syncthreads();
        if (F.tid < 16) lbase[F.tid] = (int)__hip_atomic_fetch_add(ctl + CW_CNT + 64 * F.tid, (unsigned)lcnt[F.tid], __ATOMIC_RELAXED, __HIP_MEMORY_SCOPE_AGENT);
        __syncthreads();
        if (F.tid < 128) { const int sv = sel[F.tid], rv = rnk[F.tid]; const int e0 = sv & 255, e1 = sv >> 8;
            list[(size_t)e0 * LIST_CAP + lbase[e0] + (rv & 0xffff)] = row0 + F.tid;
            list[(size_t)(8 + e1) * LIST_CAP + lbase[8 + e1] + (rv >> 16)] = row0 + F.tid; }
        __syncthreads();
    }
}
__device__ __forceinline__ void moe_tables(Frame& F, unsigned* ctl, int pass) {
    LAS int* tab = (LAS int*)(F.lds + TAB_OFF) + pass * 256;
    __syncthreads();
    if (F.tid < 8) { int c = (int)__hip_atomic_load(ctl + CW_CNT + 64 * (pass * 8 + F.tid), __ATOMIC_RELAXED, __HIP_MEMORY_SCOPE_AGENT); if (c > LIST_CAP) c = LIST_CAP; if (c < 0) c = 0; tab[F.tid] = c; }
    __syncthreads();
    if (F.tid == 0) { int pb = 0;
        for (int e = 0; e < 8; ++e) { const int c = tab[e]; const int np = (c + 255) >> 8; tab[8 + e] = pb; for (int p = 0; p < np; ++p) tab[32 + pb + p] = e; pb += np; }
        tab[16] = pb; }
    __syncthreads();
}
template <bool GATHER_>
struct MoeOrder {
    static constexpr bool GATHER = GATHER_;
    pg8::StaticOrder so; const LAS int* tab; const int* list; int npn; unsigned rowbytes;
    int pm0 = 0;
    int T = 0, HC = 0;
    __device__ __forceinline__ bool next(int i, pg8::Unit& u) const {
        const int G = so.G, c = so.c; long L;
        if (T == 0) L = (long)i * G + c;
        else if (c >= T) L = (i < HC) ? (long)i * (G - T) + (c - T) : (long)HC * (G - T) + (long)(i - HC) * G + c;
        else L = (long)HC * (G - T) + (long)i * G + c;
        if (!so.unit_of(L, u)) return false; u.pm += pm0; u.pb = tab[32 + u.pm] * npn + u.pn; return true; }
    __device__ __forceinline__ int tok_of(int pm, int r) const { const int e = tab[32 + pm]; const int idx = (pm - tab[8 + e]) * 256 + r; return idx < tab[e] ? list[(size_t)e * LIST_CAP + idx] : -1; }
    __device__ __forceinline__ unsigned a_row_off(const pg8::Unit& u, int r) const { const int t = tok_of(u.pm, r); return (unsigned)(t < 0 ? 0 : t) * rowbytes; }
};

#ifndef WIDE_ST
#define WIDE_ST 1
#endif
typedef unsigned v2u_t __attribute__((ext_vector_type(2)));
__device__ __forceinline__ v4u pair16(const v2u_t a, const v2u_t b) {
    const auto rx = __builtin_amdgcn_permlane16_swap(a.x, b.x, false, false); const auto ry = __builtin_amdgcn_permlane16_swap(a.y, b.y, false, false);
    return (v4u){rx[0], ry[0], rx[1], ry[1]};
}
template <int Q>
struct EpiP1 {
    static constexpr bool PERM = true;
    unsigned char* O; float scale;
    __device__ __forceinline__ void operator()(const pg8::f32x4 (&acc)[2][2][4][2], const pg8::Unit& u, int wr, int wc, int fr, int fq) const {
        const int row0 = u.pm * 256 + wr * 64 + fr, colt = u.pn * 256;
        if (u.pn >= 6 && u.pn < 14) {
            unsigned char* base = O + P1_OB + (size_t)(colt - 1536 + wc * 32 + 8 * fq) * 2;
#pragma unroll
            for (int ai = 0; ai < 2; ++ai)
#pragma unroll
                for (int m = 0; m < 4; ++m) { unsigned char* rowp = base + (size_t)(row0 + ai * 128 + m * 16) * P1_PITCH;
#pragma unroll
                    for (int bj = 0; bj < 2; ++bj) { pg8::f32x4 v0 = acc[ai][bj][m][0], v1 = acc[ai][bj][m][1];
                        if constexpr (Q == 2) { const float cb = -ACC_BIAS * scale; v0 = v0 * scale + cb; v1 = v1 * scale + cb; }
                        else { v0 *= scale; v1 *= scale; }
                        v4u w; w.x = pk2(v0[0], v0[1]); w.y = pk2(v0[2], v0[3]); w.z = pk2(v1[0], v1[1]); w.w = pk2(v1[2], v1[3]);
                        *(v4u*)(rowp + bj * 256) = w; } }
        } else {
            unsigned char* base = O + (u.pn < 6 ? colt : P1_OC + colt - 3584) + wc * 32 + 8 * fq;
            const float qs = scale * (127.0f / CLIP_P1); constexpr float MGO = 12582912.0f + 128.0f;
#pragma unroll
            for (int ai = 0; ai < 2; ++ai)
#pragma unroll
                for (int m = 0; m < 4; ++m) { unsigned char* rowp = base + (size_t)(row0 + ai * 128 + m * 16) * P1_PITCH; v2u_t wb[2];
#pragma unroll
                    for (int bj = 0; bj < 2; ++bj)
#pragma unroll
                        for (int n = 0; n < 2; ++n) { const pg8::f32x4 v = accv<Q>(acc[ai][bj][m][n]); unsigned ub[4];
#pragma unroll
                            for (int i = 0; i < 4; ++i) ub[i] = __float_as_uint(__builtin_amdgcn_fmed3f(v[i] * qs + MGO, MGO - 127.0f, MGO + 127.0f));
                            const unsigned pk = __builtin_amdgcn_perm(__builtin_amdgcn_perm(ub[3], ub[2], 0x0c0c0400u), __builtin_amdgcn_perm(ub[1], ub[0], 0x0c0c0400u), 0x05040100u);
                            if (n == 0) wb[bj].x = pk; else wb[bj].y = pk; }
                    *(v4u*)(rowp + ((fq & 1) ? 128 - 8 : 0)) = pair16(wb[0], wb[1]); } }
    }
};
template <bool GU8, int QB = 0, int QM = 0>
struct EpiBranch {
    static constexpr bool PERM = true;
    const bf16* gate; bf16* mrg; const float* qsb; unsigned char* mrg8;
    __device__ __forceinline__ void operator()(const pg8::f32x4 (&acc)[2][2][4][2], const pg8::Unit& u, int wr, int wc, int fr, int fq) const {
        typedef unsigned v2u_ __attribute__((ext_vector_type(2)));
        const int row0 = u.pm * 256 + wr * 64 + fr, col0 = u.pn * 256 + wc * 32 + 8 * fq + u.aux * D;
        const int first = (u.aux == 0), mshift = u.aux * D;
        const float bsc = (u.aux == 0 ? CLIP_YA : (u.aux == 1 ? CLIP_YB : CLIP_YC)) / (127.0f * (QB == 2 ? qsb[u.aux] : 1.0f));
        v4u gl[2][2][2], ml[2][2][2];
#define EB_LOAD(q) do { _Pragma("unroll") for (int mm_ = 0; mm_ < 2; ++mm_) _Pragma("unroll") for (int bj = 0; bj < 2; ++bj) { \
            const size_t row = (size_t)(row0 + ((q) >> 1) * 128 + (((q) & 1) * 2 + mm_) * 16); const int col = col0 + bj * 128; \
            if constexpr (GU8) { const v2u_ g2 = *(const v2u_*)((const unsigned char*)gate + row * N_G + col); gl[(q) & 1][mm_][bj].x = g2.x; gl[(q) & 1][mm_][bj].y = g2.y; } else gl[(q) & 1][mm_][bj] = *(const v4u*)(gate + row * N_G + col); \
            ml[(q) & 1][mm_][bj] = first ? (v4u){0u, 0u, 0u, 0u} : *(const v4u*)(mrg + row * D + col - mshift); } asm volatile("" ::: "memory"); } while (0)
        EB_LOAD(0);
#pragma unroll
        for (int q = 0; q < 4; ++q) {
            if (q < 3) EB_LOAD(q + 1);
            const int ai = q >> 1;
#pragma unroll
            for (int mm_ = 0; mm_ < 2; ++mm_)
#pragma unroll
                for (int bj = 0; bj < 2; ++bj) { const int m = (q & 1) * 2 + mm_; const size_t row = (size_t)(row0 + ai * 128 + m * 16); const int col = col0 + bj * 128;
                    float gg[8], mm[8], o[8]; unpack8(ml[q & 1][mm_][bj], mm);
                    if constexpr (GU8) {
#pragma unroll
                        for (int i = 0; i < 4; ++i) { gg[i] = (float)((gl[q & 1][mm_][bj].x >> (8 * i)) & 0xffu) * (1.0f / 255.0f); gg[4 + i] = (float)((gl[q & 1][mm_][bj].y >> (8 * i)) & 0xffu) * (1.0f / 255.0f); } }
                    else { unpack8(gl[q & 1][mm_][bj], gg);
#pragma unroll
                        for (int i = 0; i < 8; ++i) gg[i] = sigmoidf_(gg[i]); }
                    pg8::f32x4 v0 = acc[ai][bj][m][0], v1 = acc[ai][bj][m][1];
                    if constexpr (QB == 2) { const float cb = -ACC_BIAS * bsc; v0 = v0 * bsc + cb; v1 = v1 * bsc + cb; }
                    o[0] = mm[0] + gg[0] * v0[0]; o[1] = mm[1] + gg[1] * v0[1]; o[2] = mm[2] + gg[2] * v0[2]; o[3] = mm[3] + gg[3] * v0[3];
                    o[4] = mm[4] + gg[4] * v1[0]; o[5] = mm[5] + gg[5] * v1[1]; o[6] = mm[6] + gg[6] * v1[2]; o[7] = mm[7] + gg[7] * v1[3];
                    if (QM == 2 && u.aux == 2) { fwht8(o); constexpr float s = 0.35355339f * 127.0f / CLIP_MRG; v2u_ w8; w8.x = pk4_q<2>(o[0] * s, o[1] * s, o[2] * s, o[3] * s); w8.y = pk4_q<2>(o[4] * s, o[5] * s, o[6] * s, o[7] * s);
                        *(v2u_*)(mrg8 + row * D + col - mshift) = w8; }
                    else *(v4u*)(mrg + row * D + col - mshift) = pack8(o); }
            asm volatile("" ::: "memory");
        }
#undef EB_LOAD
    }
};
#ifndef CLIP_PART1
#define CLIP_PART1 2.5f
#endif
#ifndef CLIP_PART2
#define CLIP_PART2 5.0f
#endif
__device__ __forceinline__ unsigned pk4_ob(float a, float b, float c, float d) {
    constexpr float MGO = 12582912.0f + 128.0f;
    const unsigned ua = __float_as_uint(__builtin_amdgcn_fmed3f(a + MGO, MGO - 127.0f, MGO + 127.0f)), ub = __float_as_uint(__builtin_amdgcn_fmed3f(b + MGO, MGO - 127.0f, MGO + 127.0f));
    const unsigned uc = __float_as_uint(__builtin_amdgcn_fmed3f(c + MGO, MGO - 127.0f, MGO + 127.0f)), ud = __float_as_uint(__builtin_amdgcn_fmed3f(d + MGO, MGO - 127.0f, MGO + 127.0f));
    return __builtin_amdgcn_perm(__builtin_amdgcn_perm(ud, uc, 0x0c0c0400u), __builtin_amdgcn_perm(ub, ua, 0x0c0c0400u), 0x05040100u);
}
template <int QB>
struct EpiBranch8 {
    static constexpr bool PERM = true;
    const unsigned char* gate; const float* qsb; unsigned char* mrg8;
    __device__ __forceinline__ void operator()(const pg8::f32x4 (&acc)[2][2][4][2], const pg8::Unit& u, int wr, int wc, int fr, int fq) const {
        const int row0 = u.pm * 256 + wr * 64 + fr, col0 = u.pn * 256 + wc * 32 + 8 * fq + u.aux * D;
        const int first = (u.aux == 1), last = (u.aux == 0), mshift = u.aux * D;
        const float bsc = (u.aux == 0 ? CLIP_YA : (u.aux == 1 ? CLIP_YB : CLIP_YC)) / (127.0f * (QB == 2 ? qsb[u.aux] : 1.0f));
        const float din = (u.aux == 2 ? CLIP_PART1 : CLIP_PART2) * (1.0f / 127.0f), dinb = -128.0f * din;
        const float sout = 127.0f / (u.aux == 1 ? CLIP_PART1 : CLIP_PART2);
        const int sto = (fq & 1) ? 128 - 8 : 0;
        v2u_t gl[2][2][2], ml[2][2][2];
#define EB_LOAD(q) do { _Pragma("unroll") for (int mm_ = 0; mm_ < 2; ++mm_) _Pragma("unroll") for (int bj = 0; bj < 2; ++bj) { \
            const size_t row = (size_t)(row0 + ((q) >> 1) * 128 + (((q) & 1) * 2 + mm_) * 16); const int col = col0 + bj * 128; \
            gl[(q) & 1][mm_][bj] = *(const v2u_t*)(gate + row * N_G + col); \
            ml[(q) & 1][mm_][bj] = first ? (v2u_t){0x80808080u, 0x80808080u} : *(const v2u_t*)(mrg8 + row * D + col - mshift); } asm volatile("" ::: "memory"); } while (0)
        EB_LOAD(0);
#pragma unroll
        for (int q = 0; q < 4; ++q) {
            if (q < 3) EB_LOAD(q + 1);
            const int ai = q >> 1;
#pragma unroll
            for (int mm_ = 0; mm_ < 2; ++mm_) { const int m = (q & 1) * 2 + mm_; const size_t row = (size_t)(row0 + ai * 128 + m * 16); v2u_t wb[2];
#pragma unroll
                for (int bj = 0; bj < 2; ++bj) { float gg[8], mm[8], o[8];
#pragma unroll
                    for (int i = 0; i < 4; ++i) { gg[i] = (float)((gl[q & 1][mm_][bj].x >> (8 * i)) & 0xffu) * (1.0f / 255.0f); gg[4 + i] = (float)((gl[q & 1][mm_][bj].y >> (8 * i)) & 0xffu) * (1.0f / 255.0f);
                        mm[i] = (float)((ml[q & 1][mm_][bj].x >> (8 * i)) & 0xffu) * din + dinb; mm[4 + i] = (float)((ml[q & 1][mm_][bj].y >> (8 * i)) & 0xffu) * din + dinb; }
                    pg8::f32x4 v0 = acc[ai][bj][m][0], v1 = acc[ai][bj][m][1];
                    if constexpr (QB == 2) { const float cb = -ACC_BIAS * bsc; v0 = v0 * bsc + cb; v1 = v1 * bsc + cb; }
                    o[0] = mm[0] + gg[0] * v0[0]; o[1] = mm[1] + gg[1] * v0[1]; o[2] = mm[2] + gg[2] * v0[2]; o[3] = mm[3] + gg[3] * v0[3];
                    o[4] = mm[4] + gg[4] * v1[0]; o[5] = mm[5] + gg[5] * v1[1]; o[6] = mm[6] + gg[6] * v1[2]; o[7] = mm[7] + gg[7] * v1[3];
                    if (last) { fwht8(o); constexpr float s = 0.35355339f * 127.0f / CLIP_MRG; wb[bj].x = pk4_q<2>(o[0] * s, o[1] * s, o[2] * s, o[3] * s); wb[bj].y = pk4_q<2>(o[4] * s, o[5] * s, o[6] * s, o[7] * s); }
                    else { wb[bj].x = pk4_ob(o[0] * sout, o[1] * sout, o[2] * sout, o[3] * sout); wb[bj].y = pk4_ob(o[4] * sout, o[5] * sout, o[6] * sout, o[7] * sout); } }
                *(v4u*)(mrg8 + row * D + col0 - mshift + sto) = pair16(wb[0], wb[1]); }
            asm volatile("" ::: "memory");
        }
#undef EB_LOAD
    }
};
template <int Q>
struct EpiGateU8 {
    static constexpr bool PERM = true;
    unsigned char* O; float scale;
    __device__ __forceinline__ void operator()(const pg8::f32x4 (&acc)[2][2][4][2], const pg8::Unit& u, int wr, int wc, int fr, int fq) const {
        typedef unsigned v2u_ __attribute__((ext_vector_type(2)));
        const int row0 = u.pm * 256 + wr * 64 + fr, col0 = u.pn * 256 + wc * 32 + 8 * fq;
        const float nsl2 = -1.44269504f * scale, nslb = -ACC_BIAS * nsl2;
#pragma unroll
        for (int ai = 0; ai < 2; ++ai)
#pragma unroll
            for (int m = 0; m < 4; ++m) { unsigned char* rowp = O + (size_t)(row0 + ai * 128 + m * 16) * N_G + col0;
                v2u_ wb[2];
#pragma unroll
                for (int bj = 0; bj < 2; ++bj) { v2u_ w;
#pragma unroll
                    for (int n = 0; n < 2; ++n) { const pg8::f32x4 v = (Q == 2) ? acc[ai][bj][m][n] * nsl2 + nslb : acc[ai][bj][m][n] * nsl2; unsigned ub[4];
#pragma unroll
                        for (int i = 0; i < 4; ++i) ub[i] = __float_as_uint(__builtin_amdgcn_rcpf(1.0f + __builtin_amdgcn_exp2f(v[i])) * 255.0f + 12582912.0f);
                        const unsigned p = __builtin_amdgcn_perm(__builtin_amdgcn_perm(ub[3], ub[2], 0x0c0c0400u), __builtin_amdgcn_perm(ub[1], ub[0], 0x0c0c0400u), 0x05040100u);
                        if (n == 0) w.x = p; else w.y = p; }
                    wb[bj] = w; }
                if (WIDE_ST) *(v4u*)(rowp + ((fq & 1) ? 128 - 8 : 0)) = pair16(wb[0], wb[1]);
                else { *(v2u_*)rowp = wb[0]; *(v2u_*)(rowp + 128) = wb[1]; } }
    }
};
template <bool IN_F32, int QI = 0>
struct EpiResid {
    static constexpr bool PERM = true;
    const void* xin; bf16* xout; const float* gmod; float onum, oden;
    __device__ __forceinline__ void operator()(const pg8::f32x4 (&acc)[2][2][4][2], const pg8::Unit& u, int wr, int wc, int fr, int fq) const {
        const int row0 = u.pm * 256 + wr * 64 + fr, col0 = u.pn * 256 + wc * 32 + 8 * fq;
        const float* gb = gmod + (size_t)((u.pm * 256) >> 12) * MOD_LD + col0;
        float od_ = oden; asm volatile("" : "+s"(od_)); const float oscale = onum / od_;
        pg8::f32x4 gv[2][2];
#pragma unroll
        for (int bj = 0; bj < 2; ++bj)
#pragma unroll
            for (int n = 0; n < 2; ++n) gv[bj][n] = *(const pg8::f32x4*)(gb + bj * 128 + n * 4) * oscale;
        constexpr int NB = 2;
#pragma unroll
        for (int b = 0; b < NB; ++b) {
            pg8::f32x4 xl[2 / NB][4][2][2];
#pragma unroll
            for (int a = 0; a < 2 / NB; ++a)
#pragma unroll
            for (int m = 0; m < 4; ++m)
#pragma unroll
                for (int bj = 0; bj < 2; ++bj) { const int ai = b * (2 / NB) + a; const size_t row = (size_t)(row0 + ai * 128 + m * 16); const int col = col0 + bj * 128;
                    if constexpr (IN_F32) { xl[a][m][bj][0] = *(const pg8::f32x4*)((const float*)xin + row * D + col); xl[a][m][bj][1] = *(const pg8::f32x4*)((const float*)xin + row * D + col + 4); }
                    else { const v4u w = *(const v4u*)((const bf16*)xin + row * XLD + col); xl[a][m][bj][0] = __builtin_bit_cast(pg8::f32x4, w); } }
            asm volatile("" ::: "memory");
#pragma unroll
            for (int a = 0; a < 2 / NB; ++a)
#pragma unroll
            for (int m = 0; m < 4; ++m)
#pragma unroll
                for (int bj = 0; bj < 2; ++bj) { const int ai = b * (2 / NB) + a; const size_t row = (size_t)(row0 + ai * 128 + m * 16); const int col = col0 + bj * 128;
                    pg8::f32x4 x0, x1;
                    if constexpr (IN_F32) { x0 = xl[a][m][bj][0]; x1 = xl[a][m][bj][1]; }
                    else { const v4u w = __builtin_bit_cast(v4u, xl[a][m][bj][0]); x0 = (pg8::f32x4){bf_lo(w.x), bf_hi(w.x), bf_lo(w.y), bf_hi(w.y)}; x1 = (pg8::f32x4){bf_lo(w.z), bf_hi(w.z), bf_lo(w.w), bf_hi(w.w)}; }
                    pg8::f32x4 c0 = acc[ai][bj][m][0], c1 = acc[ai][bj][m][1];
                    if constexpr (QI == 2) {
#pragma unroll
                        for (int i = 0; i < 1; ++i) { c0 = c0 - ACC_BIAS; c1 = c1 - ACC_BIAS; } }
                    const pg8::f32x4 o0 = x0 + gv[bj][0] * c0, o1 = x1 + gv[bj][1] * c1;
                    v4u w; w.x = pk2(o0[0], o0[1]); w.y = pk2(o0[2], o0[3]); w.z = pk2(o1[0], o1[1]); w.w = pk2(o1[2], o1[3]);
                    *(v4u*)(xout + row * XLD + col) = w; }
            asm volatile("" ::: "memory");
        }
    }
};
template <int QIN = 0, int QOUT = 0>
struct EpiSwiglu {
    static constexpr bool PERM = true;
    bf16* act; float inv;
    __device__ __forceinline__ void operator()(const pg8::f32x4 (&acc)[2][2][4][2], const pg8::Unit& u, int wr, int wc, int fr, int fq) const {
        const int row0 = u.pm * 256 + wr * 64 + fr, col0 = u.pn * 128 + wc * 32 + 8 * fq;
        v2u_t wprev = {0u, 0u};
        const float invq = QIN ? inv : 1.0f, inv2 = invq * invq, nil2 = -1.44269504f * invq;
#pragma unroll
        for (int ai = 0; ai < 2; ++ai)
#pragma unroll
            for (int m = 0; m < 4; ++m) { float o[8];
#pragma unroll
                for (int n = 0; n < 2; ++n) { const pg8::f32x4 c1 = accv<QIN>(acc[ai][0][m][n]), c3 = accv<QIN>(acc[ai][1][m][n]), pv = c1 * c3, ev = c1 * nil2;
#pragma unroll
                    for (int i = 0; i < 4; ++i) o[n * 4 + i] = pv[i] * __builtin_amdgcn_rcpf(1.0f + __builtin_amdgcn_exp2f(ev[i])); }
                if constexpr (QOUT != 0) { typedef unsigned v2u_ __attribute__((ext_vector_type(2))); v2u_ w8;
                    if constexpr (QOUT == 2) { fwht8(o); const float s = 0.35355339f * 127.0f / CLIP_ACT * inv2; w8.x = pk4_q<2>(o[0] * s, o[1] * s, o[2] * s, o[3] * s); w8.y = pk4_q<2>(o[4] * s, o[5] * s, o[6] * s, o[7] * s); }
                    else { const float s = F8_SACT * inv2; w8.x = pk4_q<1>(o[0] * s, o[1] * s, o[2] * s, o[3] * s); w8.y = pk4_q<1>(o[4] * s, o[5] * s, o[6] * s, o[7] * s); }
                    if (WIDE_ST) { if (m & 1) *(v4u*)((unsigned char*)act + (size_t)(row0 + ai * 128 + (m - 1 + (fq & 1)) * 16) * D_FF + col0 - (fq & 1) * 8) = pair16(wprev, w8);
                        else wprev = w8; }
                    else *(v2u_*)((unsigned char*)act + (size_t)(row0 + ai * 128 + m * 16) * D_FF + col0) = w8; }
                else {
#pragma unroll
                    for (int i = 0; i < 8; ++i) o[i] *= inv2;
                    *(v4u*)(act + (size_t)(row0 + ai * 128 + m * 16) * D_FF + col0) = pack8(o); } }
    }
};
struct EpiMoeDown {
    static constexpr bool PERM = true;
    bf16* x; const float* gmod; const float* topp; int pass; const LAS int* tab; const int* list; float oscale;
    bf16* y1; unsigned char* flag; int y1mode;
    __device__ __forceinline__ int tok_of(int pm, int r) const { const int e = tab[32 + pm]; const int idx = (pm - tab[8 + e]) * 256 + r; return idx < tab[e] ? list[(size_t)e * LIST_CAP + idx] : -1; }
    __device__ __forceinline__ void operator()(const pg8::f32x4 (&acc)[2][2][4][2], const pg8::Unit& u, int wr, int wc, int fr, int fq) const {
        const int col0 = u.pn * 256 + wc * 32 + 8 * fq;
        int tok[2][4];
#pragma unroll
        for (int ai = 0; ai < 2; ++ai)
#pragma unroll
            for (int m = 0; m < 4; ++m) tok[ai][m] = tok_of(u.pm, ai * 128 + wr * 64 + m * 16 + fr);
        asm volatile("" ::: "memory");
#pragma unroll
        for (int am = 0; am < 4; ++am) {
            const int ai = am >> 1, mb = (am & 1) * 2;
            v4u xl[2][2]; pg8::f32x4 gl[2][2][2]; float pv[2];
#pragma unroll
            for (int m = 0; m < 2; ++m) { const int t = tok[ai][mb + m] < 0 ? 0 : tok[ai][mb + m]; pv[m] = topp[(size_t)t * 2 + pass] * oscale; const float* gb = gmod + (size_t)(t >> 12) * MOD_LD + col0;
#pragma unroll
                for (int bj = 0; bj < 2; ++bj) { xl[m][bj] = *(const v4u*)(x + (size_t)t * XLD + col0 + bj * 128);
#pragma unroll
                    for (int n = 0; n < 2; ++n) gl[m][bj][n] = *(const pg8::f32x4*)(gb + bj * 128 + n * 4); } }
            asm volatile("" ::: "memory");
#pragma unroll
            for (int m = 0; m < 2; ++m) { if (tok[ai][mb + m] >= 0) { const int t = tok[ai][mb + m];
                if (y1mode) flag[t] = 1;
#pragma unroll
                for (int bj = 0; bj < 2; ++bj) { const v4u w = y1mode ? (v4u){0u, 0u, 0u, 0u} : xl[m][bj];
                    const pg8::f32x4 x0 = {bf_lo(w.x), bf_hi(w.x), bf_lo(w.y), bf_hi(w.y)}, x1 = {bf_lo(w.z), bf_hi(w.z), bf_lo(w.w), bf_hi(w.w)};
                    pg8::f32x4 c0 = acc[ai][bj][mb + m][0], c1 = acc[ai][bj][mb + m][1];
                    if constexpr (Q_MDN == 2) { c0 = c0 - ACC_BIAS; c1 = c1 - ACC_BIAS; }
                    const pg8::f32x4 o0 = x0 + gl[m][bj][0] * pv[m] * c0, o1 = x1 + gl[m][bj][1] * pv[m] * c1;
                    v4u r; r.x = pk2(o0[0], o0[1]); r.y = pk2(o0[2], o0[3]); r.z = pk2(o1[0], o1[1]); r.w = pk2(o1[2], o1[3]);
                    if (y1mode) *(v4u*)(y1 + (size_t)t * D + col0 + bj * 128) = r; else *(v4u*)(x + (size_t)t * XLD + col0 + bj * 128) = r; } } }
            asm volatile("" ::: "memory");
        }
    }
};

__device__ __forceinline__ void p_final_norm(Frame& F, float* x, const float* w, const bf16* y1, const unsigned char* flag) {
    const int gw = F.bid * NWAVES + F.wave, NGW = F.G * NWAVES, lane = F.lane;
    f32x4 wv[4];
#pragma unroll
    for (int j = 0; j < 4; ++j) wv[j] = ((const f32x4*)w)[lane + 64 * j];
    for (int r0 = gw * 4; r0 < M; r0 += NGW * 4) {
        f32x4 v[4][4];
#pragma unroll
        for (int r = 0; r < 4; ++r)
#pragma unroll
            for (int j = 0; j < 4; ++j) v[r][j] = load_x4<true>(x, (size_t)(r0 + r), lane, j);
#pragma unroll
        for (int r = 0; r < 4; ++r) if (flag[r0 + r]) {
#pragma unroll
            for (int j = 0; j < 4; ++j) { const v2u_p1 yw = ((const v2u_p1*)(y1 + (size_t)(r0 + r) * D))[lane + 64 * j]; v[r][j] += (f32x4){bf_lo(yw.x), bf_hi(yw.x), bf_lo(yw.y), bf_hi(yw.y)}; } }
        asm volatile("s_waitcnt vmcnt(0)" ::: "memory");
#pragma unroll
        for (int r = 0; r < 4; ++r) { float s = 0.f;
#pragma unroll
            for (int j = 0; j < 4; ++j) s += (v[r][j].x * v[r][j].x + v[r][j].y * v[r][j].y) + (v[r][j].z * v[r][j].z + v[r][j].w * v[r][j].w);
            const float rstd = 1.0f / sqrtf(wave_sum(s, lane) * (1.0f / D) + EPS);
#pragma unroll
            for (int j = 0; j < 4; ++j) ((f32x4*)(x + (size_t)(r0 + r) * D))[lane + 64 * j] = v[r][j] * rstd * wv[j]; }
    }
}
__device__ __forceinline__ bool fresh(Frame& F) {
    int w_ = F.w0, b_ = blockIdx.x, g_ = gridDim.x; asm volatile("" : "+s"(w_), "+s"(b_), "+s"(g_));
    int l_; asm volatile("v_mbcnt_lo_u32_b32 %0, -1, 0\n\tv_mbcnt_hi_u32_b32 %0, -1, %0" : "=v"(l_));
    int t_ = w_ * 64 + l_;
    F.tid = t_; F.lane = t_ & 63; F.wave = __builtin_amdgcn_readfirstlane(t_ >> 6); F.bid = b_; F.G = g_; return true;
}
constexpr int NPL = 13, NPHASE = 1 + DEPTH * NPL;
#if MK_PER_PHASE
#define GRID_BAR() do { } while (0)
#else
#define GRID_BAR() do { XcdBarrier b2_ = bar; asm volatile("" : "+s"(b2_.bar)); xcd_barrier(b2_); } while (0)
#endif
#ifdef ONLY_REL
#define IN(k) (KA()->ph_lo <= (k) && (k) < KA()->ph_hi && fresh(F) && ((k) == 0 ? 100 : ((k) - 1) % NPL) == ONLY_REL && (ONLY_L < 0 || ((k) - 1) / NPL == ONLY_L))
#else
#define IN(k) (KA()->ph_lo <= (k) && (k) < KA()->ph_hi && fresh(F))
#endif
#define SEAM(k) do { if ((k) + 1 < KA()->ph_hi) GRID_BAR(); } while (0)
template <int l>
__device__ __forceinline__ void layer_program(Frame& F, const XcdBarrier& bar, PG8_LAS unsigned char* ring) {
        const int pb = 1 + l * NPL;
#define WSP(off) (ka->ws + (off))
#define QSV(slot) (((const float*)WSP(WS_QS))[slot])
#define MODL ((const float*)WSP(WS_MOD) + (size_t)l * BATCH * MOD_LD)
#define WMIXL ((bf16*)WSP(WS_WMIX))
        if (IN(pb + 0)) {
#pragma unroll 1
          for (int rep = 0; rep < REPS(7); ++rep) { KArgs ka = KA(); p_norm<HQ_MIX == 0 ? 0 : (H_BF ? 2 : 1), l != 0, HQ_MIX ? HQ_MIX : 2>(F, l == 0 ? (const void*)ka->in[0] : (const void*)ka->out, ka->in[4] + l * D, MODL, 1 * D, 0, (HQ_MIX && !H_BF) ? (bf16*)WSP(WS_H8) : (bf16*)WSP(WS_H), WSP(WS_H8), sa_of(HQ_MIX, l == 0 ? CLIP_MIX0 : CLIP_MIX1)); }
          SEAM(pb + 0); }
        if (IN(pb + 1)) {
            KArgs ka = KA();
            constexpr int KD = Q_PROJ ? D / 2 : D;
            pg8::Gemm g{Q_PROJ ? (bf16*)WSP(WS_H8) : (bf16*)WSP(WS_H), WMIXL, KD, KD, KD}; pg8::StaticOrder S; S.init(M / 256, N_BCA / 256, F.G, F.bid);
            EpiP1<Q_PROJ> E{WSP(WS_P1), uni((Q_PROJ ? 1.0f / (sa_of(Q_PROJ, l == 0 ? CLIP_MIX0 : CLIP_MIX1) * (Q_PROJ == 2 ? QSV(QS_IN) : F8_SW)) : 1.0f) / (float)REPS(8) / (float)REPS(15))};
#pragma unroll 1
            for (int rep = 0; rep < REPS(3); ++rep)
            { stagger_wait(F.bid, 10); pg8::gemm_phase<REPS(8), Q_PROJ, REPS(15)>(ring, g, S, E, F.tid); } SEAM(pb + 1);
        }
        if (IN(pb + 2)) {
#define THIN_H1() { KArgs ka = KA(); p_hgrn1(F, (const bf16*)WSP(WS_P1), ka->in[8], l, (float*)WSP(WS_HU), (float*)WSP(WS_HD)); }
#define THIN_SC() { { KArgs ka = KA(); p_sgu(F, (const bf16*)WSP(WS_P1), ka->in[10] + l * D_C, ka->in[11] + (size_t)l * 4 * 128 * 128, ka->in[12] + l * 4 * 128, (bf16*)WSP(WS_YC)); } \
                    { KArgs ka = KA(); p_conv(F, (const bf16*)WSP(WS_P1), ka->in[7] + l * 3 * D_A, (bf16*)WSP(WS_YA)); } }
#pragma unroll 1
          for (int rep = 0; rep < REPS(1); ++rep) {
            __syncthreads();
            if ((F.bid >> 3) & 1) { THIN_H1(); __syncthreads(); fresh(F); THIN_SC(); }
            else { THIN_SC(); __syncthreads(); fresh(F); THIN_H1(); }
          }
#undef THIN_H1
#undef THIN_SC
            SEAM(pb + 2);
        }
        if (IN(pb + 3)) {
#pragma unroll 1
          for (int rep = 0; rep < REPS(2); ++rep)
            { KArgs ka = KA(); p_hgrn<2>(F, (const bf16*)WSP(WS_P1), ka->in[8], l, ka->in[9] + l * D_BV, (bf16*)WSP(WS_YB), (float*)WSP(WS_HU), (float*)WSP(WS_HD)); }
            SEAM(pb + 3);
        }
        if (IN(pb + 5)) {
            { KArgs ka = KA();
              pg8::GateOrder S; S.so.init(M / 256, D / 256, F.G, F.bid);
              if constexpr (Q_GATE != 0) { pg8::Gemm g{(bf16*)WSP(WS_H8), (bf16*)WSP(WS_WMIX + WMIX_G8), D / 2, D / 2, D / 2};
                  EpiGateU8<Q_GATE> E{(unsigned char*)WSP(WS_PG), uni(1.0f / (sa_of(Q_GATE, l == 0 ? CLIP_MIX0 : CLIP_MIX1) * (Q_GATE == 2 ? QSV(QS_IN) : F8_SW)))};
                  pg8::gemm_phase<1, Q_GATE>(ring, g, S, E, F.tid); }
              else { pg8::Gemm g{(bf16*)WSP(WS_H), WMIXL + (size_t)N_BCA * D, D, D, D};
                  pg8::EpiBf16<0> E{(bf16*)WSP(WS_PG), N_G, 1.0f};
                  pg8::gemm_phase(ring, g, S, E, F.tid); } }
            { KArgs ka = KA();
              constexpr int KB = Q_BR ? 256 : 512;
              pg8::Gemm g{(bf16*)WSP(WS_YA), WMIXL + (size_t)N_IN * D, KB, KB, KB, (size_t)32 * MiB, (size_t)512 * 1024 * (Q_BR ? 1 : 2)}; pg8::BranchOrder S; S.so.init(M / 256, D / 256, F.G, F.bid);
              static_assert(Q_GATE != 0 && Q_WO == 2, "the byte running sums need u8 gates and an int8 w_o GEMM");
              EpiBranch8<Q_BR> E{(const unsigned char*)WSP(WS_PG), (const float*)WSP(WS_QS) + QS_BR, WSP(WS_MRG8)};
              pg8::gemm_phase<1, Q_BR>(ring, g, S, E, F.tid); }
            SEAM(pb + 5);
        }
        if (IN(pb + 6)) {
            KArgs ka = KA();
            constexpr int KO = Q_WO ? D / 2 : D;
            pg8::Gemm g{Q_WO ? (bf16*)WSP(WS_MRG8) : (bf16*)WSP(WS_MRG), WMIXL + (size_t)N_IN * D + 3 * 512 * 1024, KO, KO, KO}; pg8::StaticOrder S; S.init(M / 256, D / 256, F.G, F.bid);
            EpiResid<l == 0, Q_WO> E{l == 0 ? (const void*)ka->in[0] : (const void*)ka->out, (bf16*)ka->out, MODL + 2 * D, Q_WO == 2 ? CLIP_MRG / 127.0f : 1.0f, Q_WO == 2 ? uni(QSV(QS_WO)) : 1.0f};
            pg8::gemm_phase<1, Q_WO>(ring, g, S, E, F.tid); SEAM(pb + 6);
        }
        if (l == 0) {
            constexpr int FES = Q_FUP ? 1 : 2, FDS = Q_FDN ? 1 : 2;
            if (IN(pb + 7)) { KArgs ka = KA(); p_norm<Q_FUP ? 1 : 0, true, Q_FUP ? Q_FUP : 2>(F, (const void*)ka->out, ka->in[5] + l * D, MODL, 4 * D, 3 * D, (bf16*)WSP(WS_H), nullptr, sa_of(Q_FUP, CLIP_FFN)); __syncthreads(); p_convert_mixer(F, KA(), 1, false);     SEAM(pb + 7); }
            if (IN(pb + 8)) {
                KArgs ka = KA();
                pg8::Gemm g{(bf16*)WSP(WS_H), (bf16*)WSP(WS_W13), D * FES / 2, D * FES / 2, D * FES / 2}; pg8::StaticOrder S; S.init(M / 256, N13 / 256, F.G, F.bid);
                EpiSwiglu<Q_FUP, Q_FDN> E{(bf16*)WSP(WS_ACT), uni(1.0f / (sa_of(Q_FUP, CLIP_FFN) * QSV(QS_F13)))};
                pg8::gemm_phase<1, Q_FUP>(ring, g, S, E, F.tid); SEAM(pb + 8);
            }
            if (IN(pb + 9)) {
                KArgs ka = KA();
                pg8::Gemm g{(bf16*)WSP(WS_ACT), (bf16*)WSP(WS_W2), D_FF * FDS / 2, D_FF * FDS / 2, D_FF * FDS / 2}; pg8::StaticOrder S; S.init(M / 256, D / 256, F.G, F.bid);
                EpiResid<false, Q_FDN> E{(const void*)ka->out, (bf16*)ka->out, MODL + 5 * D, Q_FDN == 2 ? CLIP_ACT / 127.0f : (Q_FDN ? 1.0f / (F8_SACT * F8_SW) : 1.0f), Q_FDN == 2 ? uni(QSV(QS_F2)) : 1.0f};
                pg8::gemm_phase<1, Q_FDN>(ring, g, S, E, F.tid); SEAM(pb + 9);
            }
        } else {
            if (IN(pb + 7)) {
#pragma unroll 1
                for (int rep = 0; rep < REPS(6); ++rep) { __syncthreads(); p_moe_weights(F, KA()); }
                __syncthreads(); { KArgs ka = KA(); p_norm_router(F, ka, (const void*)ka->out, ka->in[5] + l * D, MODL, (bf16*)WSP(WS_H2M)); } SEAM(pb + 7); }
            constexpr size_t ACT_BYTES = (size_t)MOE_ROWS * D_FF * MOE_ES;
#define MOE_UP(pass_, T_, HC_, pm0_, npan_) do { KArgs ka = KA(); \
                    const LAS int* tab = (const LAS int*)(F.lds + TAB_OFF) + (pass_) * 256; \
                    MoeOrder<true> S; S.so.init((npan_), N13 / 256, F.G, F.bid); S.pm0 = (pm0_); S.tab = tab; S.list = (const int*)WSP(WS_LIST) + (size_t)(pass_) * 8 * LIST_CAP; S.npn = N13 / 256; S.rowbytes = D * MOE_ES; S.T = (T_); S.HC = (HC_); \
                    pg8::Gemm g{(bf16*)WSP(WS_H2M), (bf16*)WSP(WS_WM13), D * MOE_ES / 2, D * MOE_ES / 2, D * MOE_ES / 2}; \
                    EpiSwiglu<Q_MUP, Q_MDN> E{(bf16*)WSP(WS_ACTM + (pass_) * ACT_BYTES), uni(1.0f / (sa_of(Q_MUP, CLIP_MOE) * QSV(QS_M13)))}; \
                    pg8::gemm_phase<1, Q_MUP>(ring, g, S, E, F.tid); } while (0)
#define MOE_DOWN(pass_, pm0_, npan_, y1m_, T_, HC_) do { KArgs ka = KA(); \
                    const LAS int* tab = (const LAS int*)(F.lds + TAB_OFF) + (pass_) * 256; \
                    MoeOrder<false> S; S.so.init((npan_), D / 256, F.G, F.bid); S.pm0 = (pm0_); S.T = (T_); S.HC = (HC_); S.tab = tab; S.list = (const int*)WSP(WS_LIST) + (size_t)(pass_) * 8 * LIST_CAP; S.npn = D / 256; S.rowbytes = 0; \
                    pg8::Gemm g{(bf16*)WSP(WS_ACTM + (pass_) * ACT_BYTES), (bf16*)WSP(WS_WM2), D_FF * MOE_ES / 2, D_FF * MOE_ES / 2, D_FF * MOE_ES / 2}; \
                    EpiMoeDown E{(bf16*)ka->out, MODL + 5 * D, (const float*)WSP(WS_TOPP), (pass_), tab, S.list, Q_MDN == 2 ? uni(CLIP_ACT / (127.0f * QSV(QS_M2))) : 1.0f / (F8_SACT * F8_SW), (bf16*)WSP(WS_Y1), (unsigned char*)WSP(WS_CTL + CTL_FLAG), (y1m_)}; \
                    pg8::gemm_phase<1, Q_MDN>(ring, g, S, E, F.tid); } while (0)
#define MOE_NP(pass_) (((const LAS int*)(F.lds + TAB_OFF))[(pass_) * 256 + 16])
            if (IN(pb + 8)) { { KArgs ka = KA(); moe_tables(F, (unsigned*)WSP(WS_CTL), 0); moe_tables(F, (unsigned*)WSP(WS_CTL), 1); }
                MOE_UP(0, 0, 0, 0, MOE_NP(0));
                { const int nx = MOE_NP(1) > MOE_XP ? MOE_NP(1) - MOE_XP : 0, nu0 = MOE_NP(0) * (N13 / 256);
                  MOE_UP(1, nu0 % F.G, 1, MOE_XP, nx); }
                SEAM(pb + 8); }
            if (IN(pb + 9)) {
                { KArgs ka = KA(); moe_tables(F, (unsigned*)WSP(WS_CTL), 0); moe_tables(F, (unsigned*)WSP(WS_CTL), 1); }
                MOE_DOWN(0, 0, MOE_NP(0), 0, 0, 0);
                { const int nx = MOE_NP(1) > MOE_XP ? MOE_NP(1) - MOE_XP : 0, nd0 = MOE_NP(0) * (D / 256);
                  MOE_DOWN(1, MOE_XP, nx, 1, nd0 % F.G, 1);
                  const int ndt = nd0 + nx * (D / 256);
                  MOE_UP(1, ndt % F.G, 3, 0, MOE_NP(1) < MOE_XP ? MOE_NP(1) : MOE_XP); }
                SEAM(pb + 9);
            }
            if (IN(pb + 11)) { { KArgs ka = KA(); moe_tables(F, (unsigned*)WSP(WS_CTL), 1); } MOE_DOWN(1, 0, MOE_NP(1) < MOE_XP ? MOE_NP(1) : MOE_XP, 0, 0, 0); SEAM(pb + 11); }
#undef MOE_NP
#undef MOE_UP
#undef MOE_DOWN
            if (IN(pb + 12)) { KArgs ka = KA(); p_final_norm(F, ka->out, ka->in[25], (const bf16*)WSP(WS_Y1), (const unsigned char*)WSP(WS_CTL + CTL_FLAG)); }
        }
}
__global__ void __launch_bounds__(NT, 2) fwd(Args args) {
    extern __shared__ __attribute__((aligned(16))) unsigned char lds[];
    Frame F;
    F.lds = (LAS unsigned char*)lds;
    F.tid = threadIdx.x; F.lane = F.tid & 63; F.wave = __builtin_amdgcn_readfirstlane(F.tid >> 6); F.w0 = F.wave;
    F.G = gridDim.x; F.bid = blockIdx.x;
    volatile LAS unsigned* MISC = (volatile LAS unsigned*)(F.lds + MISC_OFF);
    if (F.tid < 32) MISC[F.tid] = 0u;
    __syncthreads();
#if !MK_PER_PHASE
    XcdBarrier bar = xcd_barrier_post((unsigned*)(KA()->ws + WS_CTL) + CW_BAR, MISC + 8);
#else
    XcdBarrier bar; bar.bar = nullptr; bar.x = 0; bar.st = nullptr;
#endif
    PG8_LAS unsigned char* ring = (PG8_LAS unsigned char*)lds;

    if (IN(0)) {
#pragma unroll 1
        for (int rep = 0; rep < REPS(5); ++rep) { __syncthreads(); p_prologue(F, KA()); __syncthreads(); p_convert_mixer(F, KA(), 0, true); }
        SEAM(0); }

    layer_program<0>(F, bar, ring);
    layer_program<1>(F, bar, ring);
#undef IN
#undef SEAM
}

extern "C" void kernel_launch(void* const* d_in, const int* in_sizes, int n_in, void* d_out, int out_size, void* d_ws, size_t ws_size, hipStream_t stream) {
    static int grid = 0;
    if (grid == 0) {
        if (n_in != 26 || in_sizes[0] != M * D || out_size != M * D || ws_size < WS_NEED) { fprintf(stderr, "kernel_launch: unexpected shapes / workspace (n_in %d, ws %zu, need %zu); nothing launched\n", n_in, ws_size, (size_t)WS_NEED); grid = -1; return; }
        int dev = 0, cus = 0, per_cu = 0;
        if (hipGetDevice(&dev) != hipSuccess || hipDeviceGetAttribute(&cus, hipDeviceAttributeMultiprocessorCount, dev) != hipSuccess) { grid = -1; return; }
        if (hipFuncSetAttribute((const void*)fwd, hipFuncAttributeMaxDynamicSharedMemorySize, LDS_BYTES) != hipSuccess) { fprintf(stderr, "kernel_launch: hipFuncSetAttribute failed\n"); grid = -1; return; }
        if (hipOccupancyMaxActiveBlocksPerMultiprocessor(&per_cu, (const void*)fwd, NT, LDS_BYTES) != hipSuccess || per_cu < 1) fprintf(stderr, "kernel_launch: occupancy query reports %d\n", per_cu);
        (void)hipGetLastError();
        grid = cus;
    }
    if (grid < 0) return;
    if (hipMemsetAsync((char*)d_ws + WS_CTL, 0, CTL_ZERO_BYTES, stream) != hipSuccess) return;
    Args a{};
    for (int i = 0; i < 26; ++i) a.in[i] = (const float*)d_in[i];
    a.out = (float*)d_out; a.ws = (unsigned char*)d_ws;
#if MK_PER_PHASE
    for (int p = 0; p < NPHASE; ++p) {
        if ((p >= 1 + 10 && p <= 1 + 12) || p == 1 + 4 || p == 1 + NPL + 4 || p == 1 + NPL + 10) continue;
        a.ph_lo = p; a.ph_hi = p + 1;
        hipLaunchKernelGGL(fwd, dim3(grid), dim3(NT), LDS_BYTES, stream, a);
    }
#else
    a.ph_lo = 0; a.ph_hi = NPHASE;
    hipLaunchKernelGGL(fwd, dim3(grid), dim3(NT), LDS_BYTES, stream, a);
#endif
}
```

```cpp
#include <hip/hip_runtime.h>
#include <cstdio>
#include <cstdint>

#ifndef PROBE_DUP
#define PROBE_DUP 0
#endif
#ifndef PROBE_REPS
#define PROBE_REPS 2
#endif
#define REPS(k) ((PROBE_DUP == (k)) ? PROBE_REPS : 1)
#ifndef Q_PROJ
#define Q_PROJ 2
#endif
#ifndef Q_GATE
#define Q_GATE 2
#endif
#ifndef Q_FUP
#define Q_FUP 2
#endif
#ifndef Q_FDN
#define Q_FDN 2
#endif
#ifndef Q_MUP
#define Q_MUP 2
#endif
#ifndef Q_MDN
#define Q_MDN 2
#endif
#ifndef Q_BR
#define Q_BR 2
#endif
#ifndef Q_WO
#define Q_WO 2
#endif
#ifndef MK_PER_PHASE
#define MK_PER_PHASE 0
#endif

#define ACC_BIAS 12582912.0f
namespace pg8 {
#define PG8_LAS __attribute__((address_space(3)))
typedef unsigned short bf16_t;
typedef short bf16x8 __attribute__((ext_vector_type(8)));
typedef float f32x4 __attribute__((ext_vector_type(4)));
typedef unsigned u32x4 __attribute__((ext_vector_type(4)));
typedef int v4i32_ __attribute__((ext_vector_type(4)));
constexpr int BM = 256, BK = 64, HALF = 128, HTB = HALF * BK * 2, STAGE_BYTES = 8 * HTB, NXCD = 8, WGM = 8;

__host__ __device__ __forceinline__ int lds_byte(int r, int c) { const int st = (r >> 4) * 2 + (c >> 5), rr = r & 15, cc = c & 31, ob = rr * 64 + cc * 2; return st * 1024 + (ob ^ (((ob >> 9) & 1) << 5)); }
__host__ __device__ __forceinline__ void stage_rc(int b, int& R, int& C) { const int st = b / 1024, sb = b % 1024, swz = sb ^ (((sb >> 9) & 1) << 5); R = (st >> 1) * 16 + swz / 64; C = (st & 1) * 32 + (swz % 64) / 2; }
__host__ __device__ __forceinline__ int perm32(int rho) { const int n = rho >> 4, i = rho & 15; return 8 * (i >> 2) + 4 * n + (i & 3); }

struct Unit { int pm, pn, pb, aux; };
struct Gemm { const bf16_t* A; const bf16_t* Bt; int lda, ldb, K; size_t astride = 0, bstride = 0; };

struct StaticOrder {
    static constexpr bool GATHER = false;
    int nM, nN, nwg, G, c;
    __device__ __forceinline__ void init(int nM_, int nN_, int G_, int c_) { nM = nM_; nN = nN_; nwg = nM * nN; G = G_; c = c_; }
    __device__ __forceinline__ bool next(int i, Unit& u) const { return unit_of((long)i * G + c, u); }
    __device__ __forceinline__ bool unit_of(long L, Unit& u) const {
        if (L >= nwg) return false;
        int wgid = (int)L; { const int q = nwg / NXCD, r = nwg % NXCD, xcd = wgid % NXCD, off = wgid / NXCD; wgid = (xcd < r ? xcd * (q + 1) : r * (q + 1) + (xcd - r) * q) + off; }
        const int nig = WGM * nN, gid = wgid / nig, fm = gid * WGM, gsz = (nM - fm) < WGM ? (nM - fm) : WGM;
        u.pm = fm + ((wgid % nig) % gsz); u.pn = (wgid % nig) / gsz; u.pb = u.pn; u.aux = 0; return true;
    }
    __device__ __forceinline__ unsigned a_row_off(const Unit&, int) const { return 0u; }
};

struct GateOrder {
    static constexpr bool GATHER = false;
    StaticOrder so;
    __device__ __forceinline__ bool next(int k, Unit& u) const { Unit b; if (!so.next(k / 3, b)) return false; u.pm = b.pm; u.pn = b.pn + 4 * (k % 3); u.pb = u.pn; u.aux = 0; return true; }
    __device__ __forceinline__ unsigned a_row_off(const Unit&, int) const { return 0u; }
};
struct BranchOrder {
    static constexpr bool GATHER = false;
    StaticOrder so;
    __device__ __forceinline__ bool next(int k, Unit& u) const { Unit b; if (!so.next(k / 3, b)) return false; u.pm = b.pm; u.pn = b.pn; u.pb = b.pn; u.aux = (k % 3 + 1) % 3; return true; }
    __device__ __forceinline__ unsigned a_row_off(const Unit&, int) const { return 0u; }
};
__device__ __forceinline__ unsigned cvt_pk_bf16(float lo, float hi) { unsigned r; asm volatile("v_cvt_pk_bf16_f32 %0, %1, %2" : "=v"(r) : "v"(lo), "v"(hi)); return r; }

template <int Q = 0>
struct EpiBf16 {
    static constexpr bool PERM = true;
    bf16_t* O; int ldc; float scale;
    __device__ __forceinline__ void operator()(const f32x4 (&acc)[2][2][4][2], const Unit& u, int wr, int wc, int fr, int fq) const {
        const int row0 = u.pm * BM + wr * 64 + fr, col0 = u.pn * BM + wc * 32 + 8 * fq;
#pragma unroll 1
        for (int erep = 0; erep < REPS(9); ++erep)
#pragma unroll
        for (int ai = 0; ai < 2; ++ai)
#pragma unroll
            for (int m = 0; m < 4; ++m) { bf16_t* rowp = O + (size_t)(row0 + ai * HALF + m * 16) * ldc + col0;
#pragma unroll
                for (int bj = 0; bj < 2; ++bj) { f32x4 v0 = acc[ai][bj][m][0], v1 = acc[ai][bj][m][1];
                    if constexpr (Q == 2) { v0 = v0 - ACC_BIAS; v1 = v1 - ACC_BIAS; }
                    v0 *= scale; v1 *= scale;
                    u32x4 w; w.x = cvt_pk_bf16(v0[0], v0[1]); w.y = cvt_pk_bf16(v0[2], v0[3]); w.z = cvt_pk_bf16(v1[0], v1[1]); w.w = cvt_pk_bf16(v1[2], v1[3]);
                    *(u32x4*)(rowp + bj * HALF) = w; } }
    }
};

typedef int v8i32 __attribute__((ext_vector_type(8)));
typedef int v4i32 __attribute__((ext_vector_type(4)));
template <int KREP = 1, int Q = 0, int MREP = 1, class Epi, class Sched>
__device__ __forceinline__ void gemm_phase(PG8_LAS unsigned char* lds, const Gemm g, const Sched& S, const Epi& E, int tid_in) {
    constexpr bool GATHER = Sched::GATHER;
    int tid_ = tid_in; asm volatile("" : "+v"(tid_));
    const int tid = tid_, wid = __builtin_amdgcn_readfirstlane(tid >> 6), lane = tid & 63, wr = wid >> 2, wc = wid & 3, fr = lane & 15, fq = lane >> 4;
    const int K = g.K, nt = K / BK;
    unsigned voffB[2], vA0[2], vA1[2], nA0[2], nA1[2];
#pragma unroll
    for (int i = 0; i < 2; ++i) { int R, C; stage_rc(tid * 16 + i * 8192, R, C); const int Rb = Epi::PERM ? ((R & ~31) + perm32(R & 31)) : R;
        voffB[i] = (unsigned)(Rb * g.ldb + C) * 2u;
        vA0[i] = (unsigned)(R * g.lda + C) * 2u; vA1[i] = vA0[i]; nA0[i] = vA0[i]; nA1[i] = vA0[i]; }
    const size_t kstep = (size_t)(BK * 2);
    const size_t hstepB = (size_t)HALF * g.ldb * 2, tstepB = 2 * hstepB, tstepA = (size_t)BM * g.lda * 2;
    const size_t hstepA = GATHER ? (size_t)0 : (size_t)HALF * g.lda * 2;
    const unsigned ldsw = (unsigned)wid * 1024u;
    const int aoff = lds_byte(wr * 64 + fr, fq * 8), boff = lds_byte(wc * 32 + fr, fq * 8);
    PG8_LAS unsigned char* aptr = lds + aoff; PG8_LAS unsigned char* bptr = lds + 4 * HTB + boff; asm volatile("" : "+v"(aptr), "+v"(bptr));
#define PG8_SA(b, h) (((b) * 2 + (h)) * HTB)
#define PG8_SB(b, h) ((4 + (b) * 2 + (h)) * HTB)
#define PG8_STAGE(bufoff, gbase, voff) do { _Pragma("unroll") for (int _i = 0; _i < 2; ++_i) \
        __builtin_amdgcn_global_load_lds((const unsigned*)((const char*)(gbase) + (voff)[_i]), (PG8_LAS unsigned*)(lds + (bufoff) + ldsw + _i * 8192), 16, 0, 0); } while (0)
#define PG8_CAT8(x0, x1) __builtin_shufflevector(__builtin_bit_cast(v4i32, x0), __builtin_bit_cast(v4i32, x1), 0, 1, 2, 3, 4, 5, 6, 7)
#define PG8_RDA(off) (*(const PG8_LAS bf16x8*)(aptr + (off)))
#define PG8_RDB(off) (*(const PG8_LAS bf16x8*)(bptr + (off)))
#define PG8_LDA(dst, b, h) do { if constexpr (Q == 1) { _Pragma("unroll") for (int m = 0; m < 4; ++m) dst##8[m] = PG8_CAT8(PG8_RDA(PG8_SA(b, h) + m * 2048), PG8_RDA(PG8_SA(b, h) + m * 2048 + 1024)); } \
        else { _Pragma("unroll") for (int m = 0; m < 4; ++m) _Pragma("unroll") for (int k = 0; k < 2; ++k) dst[m][k] = PG8_RDA(PG8_SA(b, h) + m * 2048 + k * 1024); } } while (0)
#define PG8_LDB(dst, b, h) do { if constexpr (Q == 1) { _Pragma("unroll") for (int n = 0; n < 2; ++n) dst##8[n] = PG8_CAT8(PG8_RDB(PG8_SB(b, h) - 4 * HTB + n * 2048), PG8_RDB(PG8_SB(b, h) - 4 * HTB + n * 2048 + 1024)); } \
        else { _Pragma("unroll") for (int n = 0; n < 2; ++n) _Pragma("unroll") for (int k = 0; k < 2; ++k) dst[n][k] = PG8_RDB(PG8_SB(b, h) - 4 * HTB + n * 2048 + k * 1024); } } while (0)
#define PG8_MMA(ai, bj, At, Bt) do { __builtin_amdgcn_s_setprio(1); _Pragma("unroll") for (int r_ = 0; r_ < MREP; ++r_) { \
        if constexpr (Q == 2) { _Pragma("unroll") for (int m = 0; m < 4; ++m) _Pragma("unroll") for (int n = 0; n < 2; ++n) _Pragma("unroll") for (int k = 0; k < 2; ++k) \
            acc[ai][bj][m][n] = __builtin_bit_cast(f32x4, __builtin_amdgcn_mfma_i32_16x16x64_i8(__builtin_bit_cast(v4i32, Bt[n][k]), __builtin_bit_cast(v4i32, At[m][k]), __builtin_bit_cast(v4i32, acc[ai][bj][m][n]), 0, 0, 0)); } \
        else if constexpr (Q == 1) { _Pragma("unroll") for (int m = 0; m < 4; ++m) _Pragma("unroll") for (int n = 0; n < 2; ++n) \
            asm volatile("v_mfma_scale_f32_16x16x128_f8f6f4 %0, %1, %2, %0, %3, %3 op_sel_hi:[0,0,0]" : "+v"(acc[ai][bj][m][n]) : "v"(Bt##8[n]), "v"(At##8[m]), "v"(sc1)); } \
        else { _Pragma("unroll") for (int m = 0; m < 4; ++m) _Pragma("unroll") for (int n = 0; n < 2; ++n) _Pragma("unroll") for (int k = 0; k < 2; ++k) \
            acc[ai][bj][m][n] = __builtin_amdgcn_mfma_f32_16x16x32_bf16(Bt[n][k], At[m][k], acc[ai][bj][m][n], 0, 0, 0); } } \
        __builtin_amdgcn_s_setprio(0); } while (0)
#define PG8_WAIT_V(n) asm volatile("s_waitcnt vmcnt(" #n ")" ::: "memory")
#define PG8_WAIT_L(n) asm volatile("s_waitcnt lgkmcnt(" #n ")" ::: "memory")
#define PG8_BAR __builtin_amdgcn_s_barrier()
#define PG8_SCHED __builtin_amdgcn_sched_barrier(0)
#define PG8_GOFF(unit, d0, d1) do { _Pragma("unroll") for (int _i = 0; _i < 2; ++_i) { int R_, C_; stage_rc(tid * 16 + _i * 8192, R_, C_); \
        d0[_i] = S.a_row_off(unit, R_) + (unsigned)C_ * 2u; d1[_i] = S.a_row_off(unit, R_ + HALF) + (unsigned)C_ * 2u; } } while (0)
    Unit cur, nxt; int ui = 0;
    if (!S.next(0, cur)) return;
    f32x4 acc[2][2][4][2];
#pragma unroll
    for (int a = 0; a < 2; ++a)
#pragma unroll
        for (int b = 0; b < 2; ++b)
#pragma unroll
            for (int m = 0; m < 4; ++m)
#pragma unroll
                for (int n = 0; n < 2; ++n) acc[a][b][m][n] = (Q == 2) ? (f32x4){ACC_BIAS, ACC_BIAS, ACC_BIAS, ACC_BIAS} : (f32x4){0.f, 0.f, 0.f, 0.f};
    bf16x8 At[4][2], B0[2][2], B1[2][2];
    v8i32 At8[4], B08[2], B18[2];
    const int sc1 = 0x7f7f7f7f;
    if constexpr (GATHER) { PG8_GOFF(cur, vA0, vA1); }
    const char* cA = GATHER ? (const char*)g.A : (const char*)g.A + (size_t)cur.aux * g.astride + (size_t)cur.pm * tstepA; const char* cB = (const char*)g.Bt + (size_t)cur.aux * g.bstride + (size_t)cur.pb * tstepB;
    PG8_STAGE(PG8_SB(0, 0), cB, voffB); PG8_STAGE(PG8_SB(0, 1), cB + hstepB, voffB); PG8_STAGE(PG8_SA(0, 0), cA, vA0); PG8_STAGE(PG8_SA(0, 1), cA + hstepA, vA1);
    if (wr == 1) PG8_BAR;
    PG8_WAIT_V(2); PG8_BAR;
    PG8_STAGE(PG8_SB(1, 0), cB + kstep, voffB); PG8_STAGE(PG8_SA(1, 0), cA + kstep, vA0); PG8_STAGE(PG8_SB(1, 1), cB + hstepB + kstep, voffB);
    PG8_WAIT_V(6); PG8_BAR;
    for (;;) {
        const bool has_next = S.next(ui + 1, nxt);
        const char* nA = GATHER ? (const char*)g.A : (has_next ? (const char*)g.A + (size_t)nxt.aux * g.astride + (size_t)nxt.pm * tstepA : cA); const char* nB = has_next ? (const char*)g.Bt + (size_t)nxt.aux * g.bstride + (size_t)nxt.pb * tstepB : cB;
        if constexpr (GATHER) { if (has_next) { PG8_GOFF(nxt, nA0, nA1); } else {
#pragma unroll
            for (int i = 0; i < 2; ++i) { nA0[i] = vA0[i]; nA1[i] = vA1[i]; } } }
#pragma unroll 1
        for (int t = 0; t < nt * KREP; t += 2) {
            const bool last = (t == nt * KREP - 2);
            const int t1 = (KREP == 1) ? t + 1 : ((t + 1) & (nt - 1)), t2 = (KREP == 1) ? t + 2 : ((t + 2) & (nt - 1));
            const char* a1 = cA + (size_t)t1 * kstep;
            const char* a2 = last ? nA : cA + (size_t)t2 * kstep; const char* b2 = last ? nB : cB + (size_t)t2 * kstep;
            const char* a3 = a2 + kstep; const char* b3 = b2 + kstep;
            unsigned s0[2], s1[2];
#pragma unroll
            for (int i = 0; i < 2; ++i) { s0[i] = (GATHER && last) ? nA0[i] : vA0[i]; s1[i] = GATHER ? (last ? nA1[i] : vA1[i]) : vA0[i]; }
            PG8_LDB(B0, 0, 0); PG8_LDB(B1, 0, 1); PG8_SCHED; PG8_LDA(At, 0, 0); PG8_STAGE(PG8_SA(1, 1), a1 + hstepA, vA1);
            PG8_WAIT_V(8); PG8_WAIT_L(0); PG8_BAR; PG8_MMA(0, 0, At, B0); PG8_MMA(0, 1, At, B1); PG8_BAR; PG8_SCHED;
            PG8_LDA(At, 0, 1); PG8_STAGE(PG8_SB(0, 0), b2, voffB); PG8_STAGE(PG8_SB(0, 1), b2 + hstepB, voffB); PG8_STAGE(PG8_SA(0, 0), a2, s0);
            PG8_WAIT_V(8); PG8_WAIT_L(0); PG8_BAR; PG8_MMA(1, 0, At, B0); PG8_MMA(1, 1, At, B1); PG8_BAR; PG8_SCHED;
            PG8_LDB(B0, 1, 0); PG8_LDB(B1, 1, 1); PG8_SCHED; PG8_LDA(At, 1, 0); PG8_STAGE(PG8_SA(0, 1), a2 + hstepA, s1);
            PG8_WAIT_V(8); PG8_WAIT_L(0); PG8_BAR; PG8_MMA(0, 0, At, B0); PG8_MMA(0, 1, At, B1); PG8_BAR; PG8_SCHED;
            PG8_LDA(At, 1, 1); PG8_STAGE(PG8_SB(1, 0), b3, voffB); PG8_STAGE(PG8_SB(1, 1), b3 + hstepB, voffB); PG8_STAGE(PG8_SA(1, 0), a3, s0);
            PG8_WAIT_V(8); PG8_WAIT_L(0); PG8_BAR; PG8_MMA(1, 0, At, B0); PG8_MMA(1, 1, At, B1); PG8_BAR; PG8_SCHED;
        }
        if (wr == 0) PG8_BAR;
        E(acc, cur, wr, wc, fr, fq);
        if (!has_next) break;
#pragma unroll
        for (int a = 0; a < 2; ++a)
#pragma unroll
            for (int b = 0; b < 2; ++b)
#pragma unroll
                for (int m = 0; m < 4; ++m)
#pragma unroll
                    for (int n = 0; n < 2; ++n) acc[a][b][m][n] = (Q == 2) ? (f32x4){ACC_BIAS, ACC_BIAS, ACC_BIAS, ACC_BIAS} : (f32x4){0.f, 0.f, 0.f, 0.f};
        cur = nxt; cA = nA; cB = nB; ++ui;
        if constexpr (GATHER) {
#pragma unroll
            for (int i = 0; i < 2; ++i) { vA0[i] = nA0[i]; vA1[i] = nA1[i]; } }
        if (wr == 1) PG8_BAR;
    }
    PG8_WAIT_V(0);
    PG8_BAR;
#undef PG8_SA
#undef PG8_SB
#undef PG8_STAGE
#undef PG8_LDA
#undef PG8_LDB
#undef PG8_MMA
#undef PG8_WAIT_V
#undef PG8_WAIT_L
#undef PG8_BAR
#undef PG8_SCHED
#undef PG8_GOFF
#undef PG8_CAT8
#undef PG8_RDA
#undef PG8_RDB
}
}

constexpr int D = 1024, BATCH = 8, SEQ = 4096, M = BATCH * SEQ, DEPTH = 2;
constexpr int D_A = 512, D_BK = 512, D_BV = 512, D_C = 512, H_B = 4;
constexpr int N_IN = 7680, N_BCA = 4608, N_G = 3072;
constexpr int P1_PITCH = 1536 + 4096 + 1024, P1_OB = 1536, P1_OC = 5632, P1E = P1_PITCH / 2;
#ifndef CLIP_P1
#define CLIP_P1 5.5f
#endif
constexpr int D_FF = 2816, NE = 8, N13 = 2 * D_FF;
constexpr int MOD_LD = 6 * D;
constexpr float EPS = 1e-6f;
constexpr int XLD = 2 * D;
constexpr int LIST_CAP = M;
constexpr int MOE_ROWS = M + NE * 256;

constexpr size_t MiB = 1u << 20;
constexpr size_t WS_CTL = 0, CTL_ZERO_BYTES = 1 * MiB;
constexpr size_t WS_MOD = 1 * MiB;
constexpr size_t WS_TOPP = 2 * MiB;
constexpr size_t WS_QS = 2 * MiB + 768 * 1024;
constexpr size_t WS_LIST = 3 * MiB;
constexpr size_t WS_WMIX = 6 * MiB;
constexpr size_t WMIX_G8 = 9 * MiB;
constexpr size_t WS_W13 = 26 * MiB, WS_W2 = 37 * MiB;
constexpr size_t WS_BIG = 44 * MiB;
constexpr size_t WS_H = WS_BIG;
constexpr size_t WS_P1 = WS_BIG + 64 * MiB;
constexpr size_t WS_PG = WS_P1;
constexpr size_t WS_MRG = WS_P1 + 192 * MiB;
constexpr size_t WS_MRG8 = WS_P1 + 256 * MiB;
constexpr size_t WS_YA = WS_P1 + 288 * MiB, WS_YB = WS_YA + 32 * MiB, WS_YC = WS_YB + 32 * MiB;
constexpr size_t WS_ACT = WS_P1;
constexpr size_t WS_HU = WS_YC + 32 * MiB;
constexpr size_t WS_HD = WS_HU + 16 * MiB;
constexpr size_t WS_H8 = WS_HD + 1 * MiB;
constexpr size_t WS_MIX_END = WS_H8 + 32 * MiB;
static_assert((Q_PROJ == 0 || Q_GATE == 0 || Q_PROJ == Q_GATE) && Q_MDN != 0 && Q_MUP != 0, "supported operand encodings");
constexpr int HQ_MIX = Q_PROJ ? Q_PROJ : Q_GATE;
constexpr bool H_BF = (Q_PROJ == 0 || Q_GATE == 0);
constexpr float F8_SW = 64.0f, F8_SACT = 8.0f, W_CLIP = 4.0f;
#ifndef CLIP_MIX0
#define CLIP_MIX0 5.5f
#endif
#ifndef CLIP_MIX1
#define CLIP_MIX1 5.5f
#endif
#ifndef CLIP_FFN
#define CLIP_FFN 5.5f
#endif
#ifndef CLIP_MOE
#define CLIP_MOE 5.5f
#endif
#ifndef CLIP_YA
#define CLIP_YA 14.0f
#endif
#ifndef CLIP_YB
#define CLIP_YB 5.5f
#endif
#ifndef CLIP_YC
#define CLIP_YC 10.0f
#endif
#ifndef CLIP_ACT
#define CLIP_ACT 7.0f
#endif
#ifndef CLIP_MRG
#define CLIP_MRG 9.0f
#endif
__host__ __device__ constexpr float sa_of(int q, float clip) { return q == 2 ? 127.0f / clip : 4.0f; }
enum { QS_IN = 0, QS_F13 = 1, QS_F2 = 2, QS_M13 = 3, QS_BR = 4  , QS_WO = 7, QS_M2 = 8, QS_N = 16 };
constexpr int MOE_ES = 1;
constexpr size_t WS_WM13 = 6 * MiB;
constexpr size_t WS_WM2 = WS_WM13 + 88 * MiB;
constexpr size_t WS_H2M = WS_WM2 + 44 * MiB;
constexpr size_t WS_ACTM = WS_H2M + 64 * MiB;
constexpr size_t WS_MOE_END = WS_ACTM + 2 * (size_t)MOE_ROWS * D_FF * MOE_ES;
constexpr size_t WS_Y1 = WS_MOE_END;
constexpr size_t WS_NEED = WS_MIX_END > WS_Y1 + (size_t)M * D * 2 ? WS_MIX_END : WS_Y1 + (size_t)M * D * 2;
constexpr size_t CTL_FLAG = 512 * 1024;
constexpr int MOE_XP = 128;
static_assert(WS_W2 + (size_t)D * D_FF * 2 <= WS_BIG && WS_WMIX + 20 * MiB <= WS_W13, "ws map");
constexpr int CW_BAR = 4096;
constexpr int CW_CNT = 16384;

constexpr int LDS_BYTES = 147456;
constexpr int SCR_BYTES = 139264;
constexpr int TAB_OFF = SCR_BYTES;
constexpr int MISC_OFF = TAB_OFF + 4096;
static_assert(MISC_OFF + 128 <= LDS_BYTES, "LDS map");
constexpr int NWAVES = 8, NT = 512;

#define GAS __attribute__((address_space(1)))
#define LAS __attribute__((address_space(3)))
typedef unsigned short bf16;
typedef unsigned v4u __attribute__((ext_vector_type(4)));
typedef float f32x4 __attribute__((ext_vector_type(4)));
#define LDS_WAIT() asm volatile("s_waitcnt lgkmcnt(0)" ::: "memory")
#define LDS_BARRIER() asm volatile("s_waitcnt lgkmcnt(0)\n\ts_barrier" ::: "memory")

typedef float f32x2_t __attribute__((ext_vector_type(2)));
typedef __bf16 bf16x2_t __attribute__((ext_vector_type(2)));
__device__ __forceinline__ unsigned pk2(float lo, float hi) { f32x2_t v = {lo, hi}; bf16x2_t b = __builtin_convertvector(v, bf16x2_t); return __builtin_bit_cast(unsigned, b); }
__device__ __forceinline__ float bf_lo(unsigned u) { return __uint_as_float(u << 16); }
__device__ __forceinline__ float bf_hi(unsigned u) { return __uint_as_float(u & 0xffff0000u); }
__device__ __forceinline__ void unpack8(const v4u w, float (&f)[8]) { f[0] = bf_lo(w.x); f[1] = bf_hi(w.x); f[2] = bf_lo(w.y); f[3] = bf_hi(w.y); f[4] = bf_lo(w.z); f[5] = bf_hi(w.z); f[6] = bf_lo(w.w); f[7] = bf_hi(w.w); }
typedef unsigned v2u_p1 __attribute__((ext_vector_type(2)));
__device__ __forceinline__ void decode8u(const v2u_p1 w, float (&f)[8]) {
    constexpr float a = CLIP_P1 / 127.0f, b = -128.0f * CLIP_P1 / 127.0f;
#pragma unroll
    for (int i = 0; i < 4; ++i) { f[i] = (float)((w.x >> (8 * i)) & 0xffu) * a + b; f[4 + i] = (float)((w.y >> (8 * i)) & 0xffu) * a + b; }
}
__device__ __forceinline__ v4u pack8(const float (&f)[8]) { v4u w; w.x = pk2(f[0], f[1]); w.y = pk2(f[2], f[3]); w.z = pk2(f[4], f[5]); w.w = pk2(f[6], f[7]); return w; }
__device__ __forceinline__ float sigmoidf_(float x) { return __builtin_amdgcn_rcpf(1.0f + __expf(-x)); }
__device__ __forceinline__ float siluf_(float x) { return x * sigmoidf_(x); }
__device__ __forceinline__ float uni(float v) { return __int_as_float(__builtin_amdgcn_readfirstlane(__float_as_int(v))); }
template <int Q> __device__ __forceinline__ float accf(float v) { return (Q == 2) ? v - ACC_BIAS : v; }
template <int Q> __device__ __forceinline__ pg8::f32x4 accv(pg8::f32x4 v) { if constexpr (Q == 2) return v - ACC_BIAS; else return v; }
__device__ __forceinline__ float clamp_f8(float x) { return fminf(fmaxf(x, -448.0f), 448.0f); }
__device__ __forceinline__ unsigned q1_i8(float x) { return (unsigned)(int)rintf(fminf(fmaxf(x, -127.0f), 127.0f)) & 0xffu; }
#define SAT_PK 1
#define SAT_OFF 128.0f
template <int Q> __device__ __forceinline__ unsigned pk4_q(float a, float b, float c, float d) {
    if constexpr (Q == 2 && SAT_PK) {
        unsigned r = __builtin_amdgcn_cvt_pk_u8_f32(a + SAT_OFF, 0u, 0u); r = __builtin_amdgcn_cvt_pk_u8_f32(b + SAT_OFF, 1u, r); r = __builtin_amdgcn_cvt_pk_u8_f32(c + SAT_OFF, 2u, r); r = __builtin_amdgcn_cvt_pk_u8_f32(d + SAT_OFF, 3u, r);
        return r ^ 0x80808080u; }
    else if constexpr (Q == 2) {
        constexpr float MG = 12582912.0f;
        const unsigned ua = __float_as_uint(__builtin_amdgcn_fmed3f(a + MG, MG - 127.0f, MG + 127.0f)), ub = __float_as_uint(__builtin_amdgcn_fmed3f(b + MG, MG - 127.0f, MG + 127.0f));
        const unsigned uc = __float_as_uint(__builtin_amdgcn_fmed3f(c + MG, MG - 127.0f, MG + 127.0f)), ud = __float_as_uint(__builtin_amdgcn_fmed3f(d + MG, MG - 127.0f, MG + 127.0f));
        return __builtin_amdgcn_perm(__builtin_amdgcn_perm(ud, uc, 0x0c0c0400u), __builtin_amdgcn_perm(ub, ua, 0x0c0c0400u), 0x05040100u); }
    else { int v = 0; v = __builtin_amdgcn_cvt_pk_fp8_f32(clamp_f8(a), clamp_f8(b), v, false); v = __builtin_amdgcn_cvt_pk_fp8_f32(clamp_f8(c), clamp_f8(d), v, true); return (unsigned)v; } }
__device__ __forceinline__ float shx(float v, int mask, int lane) { return __int_as_float(__builtin_amdgcn_ds_bpermute((lane ^ mask) << 2, __float_as_int(v))); }
__device__ __forceinline__ float shl(float v, int src) { return __int_as_float(__builtin_amdgcn_ds_bpermute(src << 2, __float_as_int(v))); }
__device__ __forceinline__ float wave_sum(float v, int lane) {
#pragma unroll
    for (int o = 1; o < 64; o <<= 1) v += shx(v, o, lane);
    return v;
}

template <int CTRL> __device__ __forceinline__ float dppx(float x) { return __builtin_bit_cast(float, __builtin_amdgcn_mov_dpp(__builtin_bit_cast(int, x), CTRL, 0xf, 0xf, true)); }
__device__ __forceinline__ float dpp_xor4(float x) { const int xi = __builtin_bit_cast(int, x); int t = __builtin_amdgcn_update_dpp(xi, xi, 0x12C, 0xf, 0x5, false); t = __builtin_amdgcn_update_dpp(t, xi, 0x124, 0xf, 0xA, false); return __builtin_bit_cast(float, t); }
__device__ __forceinline__ f32x4 rot64(const f32x4 v, int lane) {
    const float a0 = v.x + v.y, a1 = v.x - v.y, a2 = v.z + v.w, a3 = v.z - v.w;
    f32x4 b = {a0 + a2, a1 + a3, a0 - a2, a1 - a3};
    const float s1 = (lane & 1) ? -1.0f : 1.0f, s2 = (lane & 2) ? -1.0f : 1.0f, s4 = (lane & 4) ? -1.0f : 1.0f, s8 = (lane & 8) ? -1.0f : 1.0f;
    b = (f32x4){dppx<0xB1>(b.x), dppx<0xB1>(b.y), dppx<0xB1>(b.z), dppx<0xB1>(b.w)} + b * s1;
    b = (f32x4){dppx<0x4E>(b.x), dppx<0x4E>(b.y), dppx<0x4E>(b.z), dppx<0x4E>(b.w)} + b * s2;
    b = (f32x4){dpp_xor4(b.x), dpp_xor4(b.y), dpp_xor4(b.z), dpp_xor4(b.w)} + b * s4;
    b = (f32x4){dppx<0x128>(b.x), dppx<0x128>(b.y), dppx<0x128>(b.z), dppx<0x128>(b.w)} + b * s8;
    return b * 0.125f;
}

__device__ __forceinline__ void fwht8(float (&y)[8]) {
#pragma unroll
    for (int t = 1; t < 8; t <<= 1)
#pragma unroll
        for (int i = 0; i < 8; ++i) if (!(i & t)) { const float a = y[i], b = y[i | t]; y[i] = a + b; y[i | t] = a - b; }
}
__device__ __forceinline__ void rot64_8(float (&y)[8], int lane) {
    fwht8(y);
    const float s1 = (lane & 1) ? -1.0f : 1.0f, s2 = (lane & 2) ? -1.0f : 1.0f, s4 = (lane & 4) ? -1.0f : 1.0f;
#pragma unroll
    for (int i = 0; i < 8; ++i) y[i] = dppx<0xB1>(y[i]) + y[i] * s1;
#pragma unroll
    for (int i = 0; i < 8; ++i) y[i] = dppx<0x4E>(y[i]) + y[i] * s2;
#pragma unroll
    for (int i = 0; i < 8; ++i) y[i] = dpp_xor4(y[i]) + y[i] * s4;
}
template <int Q, int RB = 64> __device__ __forceinline__ void store_y8(bf16* ybase, size_t elem, float (&y)[8], int lane, float clip) {
    if constexpr (Q == 2) { typedef unsigned v2u_ __attribute__((ext_vector_type(2)));
        if constexpr (RB == 8) fwht8(y); else rot64_8(y, lane);
        const float s = (RB == 8 ? 0.35355339f : 0.125f) * 127.0f / clip;
        v2u_ o8; o8.x = pk4_q<2>(y[0] * s, y[1] * s, y[2] * s, y[3] * s); o8.y = pk4_q<2>(y[4] * s, y[5] * s, y[6] * s, y[7] * s);
        *(v2u_*)((unsigned char*)ybase + elem) = o8; }
    else *(v4u*)(ybase + elem) = pack8(y);
}

#define XB_TMO      128
#define XB_XCNT(j)  (256  + 64 * (j))
#define XB_XSUB(j)  (1280 + 64 * (j))
#define XB_XGEN(j)  (2304 + 64 * (j))
#define XB_TOP      3328
#define XB_TOPGEN   3392
#define XCD_BAR_WORDS 3456
#define XB_SPIN_CAP (1u << 18)

__device__ __forceinline__ unsigned xb_ld(unsigned* p)              { return __hip_atomic_load(p, __ATOMIC_RELAXED, __HIP_MEMORY_SCOPE_AGENT); }
__device__ __forceinline__ unsigned xb_add(unsigned* p, unsigned v) { return __hip_atomic_fetch_add(p, v, __ATOMIC_RELAXED, __HIP_MEMORY_SCOPE_AGENT); }
__device__ __forceinline__ unsigned xb_xcc_id() { return (unsigned)__builtin_amdgcn_s_getreg((3 << 11) | 20) & 0xFu; }
#define XB_SPIN(cond, bar) do { unsigned _sp = 0; while (cond) { __builtin_amdgcn_s_sleep(1); \
    if ((++_sp & 255u) == 0u) { if (xb_ld(&(bar)[XB_TMO])) break; if (_sp > XB_SPIN_CAP) { atomicAdd(&(bar)[XB_TMO], 1u); break; } } } } while (0)

struct XcdBarrier { unsigned* bar; unsigned x; volatile LAS unsigned* st; };

__device__ __forceinline__ XcdBarrier xcd_barrier_post(unsigned* bar, volatile LAS unsigned* st) {
    XcdBarrier b; b.bar = bar; b.x = xb_xcc_id(); b.st = st;
    if (threadIdx.x == 0) (void)xb_add(&bar[XB_XCNT(b.x)], 1u);
    return b;
}
__device__ __forceinline__ void xcd_barrier_complete(unsigned* bar, unsigned x, unsigned& nloc, unsigned& nx) {
    const unsigned G = gridDim.x * gridDim.y * gridDim.z;
    unsigned sum, cnt, mine, sp = 0u;
    for (;;) {
        sum = 0u; cnt = 0u; mine = 0u;
        unsigned cv[16];
#pragma unroll
        for (unsigned j = 0; j < 16; ++j) cv[j] = xb_ld(&bar[XB_XCNT(j)]);
        asm volatile("" ::: "memory");
#pragma unroll
        for (unsigned j = 0; j < 16; ++j) { const unsigned c = cv[j]; sum += c; cnt += (c > 0u) ? 1u : 0u; mine = (j == x) ? c : mine; }
        if (sum == G) break;
        __builtin_amdgcn_s_sleep(1);
        if ((++sp & 255u) == 0u) { if (xb_ld(&bar[XB_TMO])) break; if (sp > XB_SPIN_CAP) { atomicAdd(&bar[XB_TMO], 1u); break; } }
    }
    nloc = mine > 0u ? mine : 1u; nx = cnt > 0u ? cnt : 1u;
}
__device__ __forceinline__ void xcd_barrier(const XcdBarrier& b) {
    asm volatile("s_waitcnt vmcnt(0)" ::: "memory");
    __syncthreads();
    if (threadIdx.x == 0) {
        unsigned* bar = b.bar;
        __builtin_amdgcn_s_waitcnt(0);
        unsigned nloc = b.st[0], nx = b.st[1];
        if (nloc == 0u) { xcd_barrier_complete(bar, b.x, nloc, nx); b.st[0] = nloc; b.st[1] = nx; }
        const unsigned old = xb_add(&bar[XB_XSUB(b.x)], 1u);
        const unsigned gen = old / nloc;
        if (old + 1u == (gen + 1u) * nloc) {
            __builtin_amdgcn_fence(__ATOMIC_RELEASE, "agent");
            asm volatile("s_waitcnt vmcnt(0)" ::: "memory");
            const unsigned og = xb_add(&bar[XB_TOP], 1u);
            const unsigned tg = og / nx;
            if (og + 1u == (tg + 1u) * nx) xb_add(&bar[XB_TOPGEN], 1u);
            else XB_SPIN(xb_ld(&bar[XB_TOPGEN]) == tg, bar);
            __builtin_amdgcn_fence(__ATOMIC_ACQUIRE, "agent");
            xb_add(&bar[XB_XGEN(b.x)], 1u);
            asm volatile("s_waitcnt vmcnt(0)" ::: "memory");
        } else {
            XB_SPIN(xb_ld(&bar[XB_XGEN(b.x)]) == gen, bar);
            __builtin_amdgcn_fence(__ATOMIC_ACQUIRE, "agent");
            asm volatile("s_waitcnt vmcnt(0)" ::: "memory");
        }
    }
    __syncthreads();
}

#ifndef STAGGER
#define STAGGER 0
#endif
__device__ __forceinline__ void stagger_wait(int bid, int us) {
    if (STAGGER && ((bid >> 3) & 1)) { const unsigned long long t0 = __builtin_amdgcn_s_memrealtime(); while (__builtin_amdgcn_s_memrealtime() - t0 < (unsigned long long)us * 100ull) __builtin_amdgcn_s_sleep(8); }
}
struct Args { const float* in[26]; float* out; unsigned char* ws; int ph_lo, ph_hi; };
typedef const Args __attribute__((address_space(4)))* KArgs;
#define KA() ({ KArgs p_ = (KArgs)__builtin_amdgcn_kernarg_segment_ptr(); asm volatile("" : "+s"(p_)); p_; })
struct Frame {
    LAS unsigned char* lds;
    int tid, lane, wave, G, bid;
    int w0;
};

template <int MAP, int F8 = 0, int RB = (F8 == 2 ? 64 : 0)>
__device__ __forceinline__ void transpose_item(const float* W, int K, int N, bf16* WT, int row_off, LAS float* scr, int item, int lane, float wscale = F8_SW) {
    const int nblk = N / 32, kb = item / nblk, nb = item % nblk, k0 = 64 * kb, n0 = 32 * nb;
    float vld[32];
#pragma unroll
    for (int i = 0; i < 32; ++i) vld[i] = W[(size_t)(k0 + 2 * i + (lane >> 5)) * N + n0 + (lane & 31)];
    asm volatile("" ::: "memory");
    if constexpr (RB != 0) {
#pragma unroll
        for (int t = 1; 2 * t < RB; t <<= 1)
#pragma unroll
            for (int i = 0; i < 32; ++i) if (!(i & t)) { const float a = vld[i], b = vld[i | t]; vld[i] = a + b; vld[i | t] = a - b; }
#pragma unroll
        for (int i = 0; i < 32; ++i) { const float pv = shx(vld[i], 32, lane); vld[i] = (lane & 32) ? pv - vld[i] : vld[i] + pv; }
        wscale *= (RB == 64 ? 0.125f : 0.35355339f);
    }
#pragma unroll
    for (int i = 0; i < 32; ++i) scr[(2 * i + (lane >> 5)) * 33 + (lane & 31)] = vld[i];
    LDS_WAIT(); asm volatile("" ::: "memory");
    const int c = lane & 7;
#pragma unroll
    for (int j = 0; j < 4; ++j) { const int n = (lane >> 3) + 8 * j; const LAS float* s = scr + (8 * c) * 33 + n;
        v4u o; o.x = pk2(s[0 * 33], s[1 * 33]); o.y = pk2(s[2 * 33], s[3 * 33]); o.z = pk2(s[4 * 33], s[5 * 33]); o.w = pk2(s[6 * 33], s[7 * 33]);
        const int nn = n0 + n; const int row = (MAP == 0) ? (row_off + nn) : ((nn >> 7) * 256 + row_off + (nn & 127));
        if constexpr (F8) { typedef unsigned v2u_ __attribute__((ext_vector_type(2))); v2u_ o8;
            o8.x = pk4_q<F8>(s[0 * 33] * wscale, s[1 * 33] * wscale, s[2 * 33] * wscale, s[3 * 33] * wscale); o8.y = pk4_q<F8>(s[4 * 33] * wscale, s[5 * 33] * wscale, s[6 * 33] * wscale, s[7 * 33] * wscale);
            *(v2u_*)((unsigned char*)WT + (size_t)row * K + k0 + 8 * c) = o8; }
        else *(v4u*)(WT + (size_t)row * K + k0 + 8 * c) = o; }
    LDS_WAIT(); asm volatile("" ::: "memory");
}

static_assert(Q_PROJ == 2 && Q_GATE == 2 && Q_BR == 2 && Q_WO == 2 && Q_FUP == 2 && Q_FDN == 2 && Q_MUP == 2 && Q_MDN == 2, "the pipelined conversion writes int8 rows only");
__device__ __forceinline__ void cv_load(const float* src, int N, int lane, float (&v)[32]) {
    const float* p = src + (size_t)(lane >> 5) * N + (lane & 31);
#pragma unroll
    for (int i = 0; i < 32; ++i) v[i] = p[(size_t)(2 * i) * N];
}
__device__ __forceinline__ void cv_store(float (&vld)[32], unsigned char* WTk, int K, int n0, int row_off, int fl, float wscale, LAS float* scr, int lane) {
#pragma unroll
    for (int t = 1; t < 4; t <<= 1)
#pragma unroll
        for (int i = 0; i < 32; ++i) if (!(i & t)) { const float a = vld[i], b = vld[i | t]; vld[i] = a + b; vld[i | t] = a - b; }
    if (fl & 2) {
#pragma unroll
        for (int t = 4; t < 32; t <<= 1)
#pragma unroll
            for (int i = 0; i < 32; ++i) if (!(i & t)) { const float a = vld[i], b = vld[i | t]; vld[i] = a + b; vld[i | t] = a - b; }
    }
#pragma unroll
    for (int i = 0; i < 32; ++i) { const float pv = shx(vld[i], 32, lane); vld[i] = (lane & 32) ? pv - vld[i] : vld[i] + pv; }
    wscale *= (fl & 2) ? 0.125f : 0.35355339f;
#pragma unroll
    for (int i = 0; i < 32; ++i) scr[(2 * i + (lane >> 5)) * 33 + (lane & 31)] = vld[i];
    LDS_WAIT(); asm volatile("" ::: "memory");
    const int c = lane & 7;
#pragma unroll
    for (int j = 0; j < 4; ++j) { const int n = (lane >> 3) + 8 * j; const LAS float* s = scr + (8 * c) * 33 + n;
        const int nn = n0 + n; const int row = (fl & 1) ? ((nn >> 7) * 256 + row_off + (nn & 127)) : (row_off + nn);
        typedef unsigned v2u_ __attribute__((ext_vector_type(2))); v2u_ o8;
        o8.x = pk4_q<2>(s[0 * 33] * wscale, s[1 * 33] * wscale, s[2 * 33] * wscale, s[3 * 33] * wscale); o8.y = pk4_q<2>(s[4 * 33] * wscale, s[5 * 33] * wscale, s[6 * 33] * wscale, s[7 * 33] * wscale);
        *(v2u_*)(WTk + (size_t)row * K + 8 * c) = o8; }
    LDS_WAIT(); asm volatile("" ::: "memory");
}
#define CV_PIPE(nitems_, DECODE) do { \
        float va[32]; int it = gw; const float* src_; int N_, K_, n0_, ro_, fl_; unsigned char* dst_; float ws_; \
        if (it < (nitems_)) { DECODE(it); cv_load(src_, N_, F.lane, va); } \
        unsigned char* cdst = dst_; int cK = K_, cn0 = n0_, cro = ro_, cfl = fl_; float cws = ws_; \
        while (it < (nitems_)) { \
            const int nx = it + NGW; float vb[32]; \
            if (nx < (nitems_)) { DECODE(nx); cv_load(src_, N_, F.lane, vb); } \
            asm volatile("" ::: "memory"); \
            cv_store(va, cdst, cK, cn0, cro, cfl, cws, scr, F.lane); \
            _Pragma("unroll") for (int i = 0; i < 32; ++i) va[i] = vb[i]; \
            cdst = dst_; cK = K_; cn0 = n0_; cro = ro_; cfl = fl_; cws = ws_; it = nx; } \
    } while (0)

__device__ __forceinline__ void p_prologue(Frame& F, KArgs ka) {
    const float* c = ka->in[1]; const float* ada_w = ka->in[2]; const float* ada_b = ka->in[3];
    unsigned char* aws = ka->ws; float* mod = (float*)(aws + WS_MOD);
    LAS float* cact = (LAS float*)F.lds;
    LAS float* red = cact + 8192;
    for (int i = F.tid; i < BATCH * D; i += NT) cact[i] = siluf_(c[i]);
    __syncthreads();
    for (int chunk = F.bid; chunk < 256; chunk += F.G) {
        const int l = chunk >> 7, n0 = (chunk & 127) * 48;
        if (F.tid < 480) {
            const int kg = F.tid / 48, col = F.tid % 48;
            float acc[8];
#pragma unroll
            for (int b = 0; b < 8; ++b) acc[b] = 0.f;
            const float* wp = ada_w + (size_t)l * D * MOD_LD + n0 + col;
            for (int kb = kg; kb < D; kb += 160) {
                float wv[16];
#pragma unroll
                for (int j = 0; j < 16; ++j) { const int k = kb + 10 * j; wv[j] = (k < D) ? wp[(size_t)k * MOD_LD] : 0.f; }
                asm volatile("" ::: "memory");
#pragma unroll
                for (int j = 0; j < 16; ++j) { const int k = kb + 10 * j; if (k < D) {
#pragma unroll
                    for (int b = 0; b < 8; ++b) acc[b] += cact[b * D + k] * wv[j]; } } }
#pragma unroll
            for (int b = 0; b < 8; ++b) red[(kg * 48 + col) * 8 + b] = acc[b];
        }
        __syncthreads();
        if (F.tid < 384) {
            const int col = F.tid >> 3, b = F.tid & 7; float s = 0.f;
#pragma unroll
            for (int kg = 0; kg < 10; ++kg) s += red[(kg * 48 + col) * 8 + b];
            mod[(size_t)(l * 8 + b) * MOD_LD + n0 + col] = s + ada_b[l * MOD_LD + n0 + col];
        }
        __syncthreads();
    }
}
__device__ __forceinline__ float wscale_sample(const float* W, size_t n, int lane) {
    float ss = 0.f;
#pragma unroll
    for (int j = 0; j < 32; ++j) { const size_t idx = ((size_t)(lane + 64 * j) * 1000003ull) % n; const float v = W[idx]; ss += v * v; }
    ss = wave_sum(ss, lane);
    return 127.0f / (W_CLIP * sqrtf(ss * (1.0f / 2048.0f)) + 1e-30f);
}
__device__ __forceinline__ void p_convert_mixer(Frame& F, KArgs ka, int l, bool with_ffn) {
    unsigned char* aws = ka->ws;
    LAS float* scr = (LAS float*)(F.lds + F.wave * 16384);
    const int gw = F.bid * NWAVES + F.wave, NGW = F.G * NWAVES;
    constexpr int I_BCA = (D / 64) * (N_BCA / 32), I_G = (D / 64) * (N_G / 32), I_BR = (512 / 64) * (D / 32), I_O = (D / 64) * (D / 32), I_L = I_BCA + I_G + 3 * I_BR + I_O;
    constexpr int I_F1 = (D / 64) * (D_FF / 32), I_F2 = (D_FF / 64) * (D / 32);
    const int nitems = I_L + (with_ffn ? 2 * I_F1 + I_F2 : 0);
    bf16* base = (bf16*)(aws + WS_WMIX);
    LAS float* qsl = (LAS float*)(F.lds + TAB_OFF + 3072);
    __syncthreads();
    if (F.wave == 0) { const float v = wscale_sample(ka->in[6] + (size_t)l * D * N_IN, (size_t)D * N_IN, F.lane); if (F.lane == 0) qsl[0] = v; }
    if (F.wave == 1) { const float v = wscale_sample(ka->in[17], (size_t)D * D_FF, F.lane); if (F.lane == 0) qsl[1] = v; }
    if (F.wave == 2) { const float v = wscale_sample(ka->in[18], (size_t)D * D_FF, F.lane); if (F.lane == 0) qsl[2] = v; }
    if (F.wave >= 3 && F.wave < 6) { const float v = wscale_sample(ka->in[13 + F.wave - 3] + (size_t)l * 512 * D, (size_t)512 * D, F.lane); if (F.lane == 0) qsl[F.wave] = v; }
    if (F.wave == 6) { const float v = wscale_sample(ka->in[16] + (size_t)l * D * D, (size_t)D * D, F.lane); if (F.lane == 0) qsl[6] = v; }
    if (F.wave == 7) { const float v = wscale_sample(ka->in[19], (size_t)D_FF * D, F.lane); if (F.lane == 0) qsl[7] = v; }
    __syncthreads();
    const float ws_in = qsl[0], ws_13 = (Q_FUP == 2) ? fminf(qsl[1], qsl[2]) : F8_SW;
    const float ws_p = (Q_PROJ == 2) ? ws_in : F8_SW, ws_g = (Q_GATE == 2) ? ws_in : F8_SW;
    const float ws_ba = qsl[3], ws_bb = qsl[4], ws_bc = qsl[5], ws_o = qsl[6], ws_2 = (Q_FDN == 2) ? qsl[7] : F8_SW;
    if (F.bid == 0 && F.tid == 0) { float* qs = (float*)(aws + WS_QS); qs[QS_IN] = ws_in; qs[QS_BR] = ws_ba; qs[QS_BR + 1] = ws_bb; qs[QS_BR + 2] = ws_bc; qs[QS_WO] = ws_o; if (with_ffn) { qs[QS_F13] = ws_13; qs[QS_F2] = ws_2; } }
    const float* in6 = ka->in[6] + (size_t)l * D * N_IN;
    constexpr int BRS = Q_BR ? 512 * 1024 / 2 : 512 * 1024;
#define CV_DEC_MIX(it_) do { int r = (it_); int kb, nb; const float* W; \
        if (r < I_BCA) { kb = r / (N_BCA / 32); nb = r % (N_BCA / 32); W = in6; K_ = D; N_ = N_IN; dst_ = (unsigned char*)base; ro_ = 0; fl_ = 2; ws_ = ws_p; }                         \
        else if ((r -= I_BCA) < I_G) { kb = r / (N_G / 32); nb = r % (N_G / 32) + N_BCA / 32; W = in6; K_ = D; N_ = N_IN; dst_ = aws + WS_WMIX + WMIX_G8; ro_ = -N_BCA; fl_ = 2; ws_ = ws_g; }     \
        else if ((r -= I_G) < 3 * I_BR) { const int b = r / I_BR; r -= b * I_BR; kb = r / (D / 32); nb = r % (D / 32); W = ka->in[13 + b] + (size_t)l * 512 * D; K_ = 512; N_ = D; dst_ = (unsigned char*)(base + (size_t)N_IN * D + (size_t)b * BRS); ro_ = 0; fl_ = (b == 0) ? 2 : 0; ws_ = (b == 0) ? ws_ba : (b == 1) ? ws_bb : ws_bc; }     \
        else if ((r -= 3 * I_BR) < I_O) { kb = r / (D / 32); nb = r % (D / 32); W = ka->in[16] + (size_t)l * D * D; K_ = D; N_ = D; dst_ = (unsigned char*)(base + (size_t)N_IN * D + 3 * 512 * 1024); ro_ = 0; fl_ = 0; ws_ = ws_o; } \
        else if ((r -= I_O) < 2 * I_F1) { const int h = r / I_F1; r -= h * I_F1; kb = r / (D_FF / 32); nb = r % (D_FF / 32); W = ka->in[17 + h]; K_ = D; N_ = D_FF; dst_ = aws + WS_W13; ro_ = 128 * h; fl_ = 3; ws_ = ws_13; } \
        else { r -= 2 * I_F1; kb = r / (D / 32); nb = r % (D / 32); W = ka->in[19]; K_ = D_FF; N_ = D; dst_ = aws + WS_W2; ro_ = 0; fl_ = 0; ws_ = ws_2; } \
        src_ = W + (size_t)(64 * kb) * N_ + 32 * nb; dst_ += 64 * kb; n0_ = 32 * nb; } while (0)
    CV_PIPE(nitems, CV_DEC_MIX);
#undef CV_DEC_MIX
}
__device__ __forceinline__ void p_moe_weights(Frame& F, KArgs ka) {
    unsigned char* aws = ka->ws;
    LAS float* scr = (LAS float*)(F.lds + F.wave * 16384);
    const int gw = F.bid * NWAVES + F.wave, NGW = F.G * NWAVES;
    constexpr int I_F1 = (D / 64) * (D_FF / 32), I_F2 = (D_FF / 64) * (D / 32), I_E = 2 * I_F1 + I_F2;
    LAS float* qsl = (LAS float*)(F.lds + TAB_OFF + 3072);
    __syncthreads();
    if (F.wave == 0) { const float v = wscale_sample(ka->in[22], (size_t)NE * D * D_FF, F.lane); if (F.lane == 0) qsl[0] = v; }
    if (F.wave == 1) { const float v = wscale_sample(ka->in[23], (size_t)NE * D * D_FF, F.lane); if (F.lane == 0) qsl[1] = v; }
    if (F.wave == 2) { const float v = wscale_sample(ka->in[24], (size_t)NE * D_FF * D, F.lane); if (F.lane == 0) qsl[2] = v; }
    __syncthreads();
    const float ws_13 = (Q_MUP == 2) ? fminf(qsl[0], qsl[1]) : F8_SW, ws_2 = (Q_MDN == 2) ? qsl[2] : F8_SW;
    if (F.bid == 0 && F.tid == 0) { float* qs = (float*)(aws + WS_QS); qs[QS_M13] = ws_13; qs[QS_M2] = ws_2; }
#define CV_DEC_MOE(it_) do { const int e = (it_) / I_E; int r = (it_) - e * I_E; int kb, nb; const float* W; \
        if (r < 2 * I_F1) { const int h = r / I_F1; r -= h * I_F1; kb = r / (D_FF / 32); nb = r % (D_FF / 32); W = ka->in[22 + h] + (size_t)e * D * D_FF; K_ = D; N_ = D_FF; dst_ = aws + WS_WM13 + (size_t)e * N13 * D * MOE_ES; ro_ = 128 * h; fl_ = 3; ws_ = ws_13; } \
        else { r -= 2 * I_F1; kb = r / (D / 32); nb = r % (D / 32); W = ka->in[24] + (size_t)e * D_FF * D; K_ = D_FF; N_ = D; dst_ = aws + WS_WM2 + (size_t)e * D * D_FF * MOE_ES; ro_ = 0; fl_ = 0; ws_ = ws_2; } \
        src_ = W + (size_t)(64 * kb) * N_ + 32 * nb; dst_ += 64 * kb; n0_ = 32 * nb; } while (0)
    CV_PIPE(NE * I_E, CV_DEC_MOE);
#undef CV_DEC_MOE
}

__device__ __forceinline__ void norm_row(const float* xrow, const float* w, const float* sc, const float* sh, int lane, f32x4 (&o)[4]) {
    const f32x4* xr = (const f32x4*)xrow + lane;
    f32x4 v[4]; float s = 0.f;
#pragma unroll
    for (int j = 0; j < 4; ++j) { v[j] = xr[64 * j]; s += (v[j].x * v[j].x + v[j].y * v[j].y) + (v[j].z * v[j].z + v[j].w * v[j].w); }
    const float rstd = 1.0f / sqrtf(wave_sum(s, lane) * (1.0f / D) + EPS);
#pragma unroll
    for (int j = 0; j < 4; ++j) { const f32x4 wv = ((const f32x4*)w)[lane + 64 * j], scv = ((const f32x4*)sc)[lane + 64 * j], shv = ((const f32x4*)sh)[lane + 64 * j];
        o[j] = v[j] * rstd * wv * (scv + 1.0f) + shv; }
}
template <bool XBF>
__device__ __forceinline__ f32x4 load_x4(const void* xbase, size_t row, int lane, int j) {
    if constexpr (XBF) { typedef unsigned v2u_ __attribute__((ext_vector_type(2))); const v2u_ w = ((const v2u_*)((const bf16*)xbase + row * XLD))[lane + 64 * j];
        return (f32x4){bf_lo(w.x), bf_hi(w.x), bf_lo(w.y), bf_hi(w.y)}; }
    else return ((const f32x4*)((const float*)xbase + row * D))[lane + 64 * j];
}
__device__ __forceinline__ void store_row_bf16(bf16* orow, int lane, const f32x4 (&o)[4]) {
    unsigned long long* o8 = (unsigned long long*)orow + lane;
#pragma unroll
    for (int j = 0; j < 4; ++j) o8[64 * j] = (unsigned long long)pk2(o[j].x, o[j].y) | ((unsigned long long)pk2(o[j].z, o[j].w) << 32);
}
template <int MODE = 0, bool XBF = true, int HQ = 2>
__device__ __forceinline__ void p_norm(Frame& F, const void* xin, const float* w, const float* mod_l, int sc_off, int sh_off, bf16* hout, unsigned char* hout8 = nullptr, float sa = 1.0f) {
    const int gw = F.bid * NWAVES + F.wave, NGW = F.G * NWAVES, lane = F.lane;
    f32x4 wv[4];
#pragma unroll
    for (int j = 0; j < 4; ++j) wv[j] = ((const f32x4*)w)[lane + 64 * j];
    constexpr int CH = 16, GR = 2, NG = CH / GR, PD = 1, NB = PD + 1;
    typedef unsigned v2u_n __attribute__((ext_vector_type(2)));
    for (int c0 = gw * CH; c0 < M; c0 += NGW * CH) {
        const float* mb = mod_l + (size_t)(c0 >> 12) * MOD_LD;
        f32x4 scv[4], shv[4], rf[XBF ? 1 : NB][GR][4]; v2u_n rb[XBF ? NB : 1][GR][4];
#define PN_LOAD(g_) do { _Pragma("unroll") for (int r = 0; r < GR; ++r) _Pragma("unroll") for (int j = 0; j < 4; ++j) { \
            if constexpr (XBF) rb[(g_) % NB][r][j] = ((const v2u_n*)((const bf16*)xin + (size_t)(c0 + (g_) * GR + r) * XLD))[lane + 64 * j]; \
            else rf[(g_) % NB][r][j] = ((const f32x4*)((const float*)xin + (size_t)(c0 + (g_) * GR + r) * D))[lane + 64 * j]; } } while (0)
#pragma unroll
        for (int g = 0; g < PD; ++g) PN_LOAD(g);
#pragma unroll
        for (int j = 0; j < 4; ++j) { scv[j] = ((const f32x4*)(mb + sc_off))[lane + 64 * j]; shv[j] = ((const f32x4*)(mb + sh_off))[lane + 64 * j]; }
        asm volatile("" ::: "memory");
#pragma unroll
        for (int j = 0; j < 4; ++j) scv[j] = wv[j] * (scv[j] + 1.0f);
#pragma unroll
        for (int g = 0; g < NG; ++g) {
            const int r0 = c0 + g * GR;
            if (g + PD < NG) PN_LOAD(g + PD);
            asm volatile("" ::: "memory");
#pragma unroll
            for (int r = 0; r < GR; ++r) { f32x4 v[4]; float s = 0.f;
#pragma unroll
                for (int j = 0; j < 4; ++j) { if constexpr (XBF) { const v2u_n w = rb[g % NB][r][j]; v[j] = (f32x4){bf_lo(w.x), bf_hi(w.x), bf_lo(w.y), bf_hi(w.y)}; } else v[j] = rf[g % NB][r][j]; }
#pragma unroll
                for (int j = 0; j < 4; ++j) s += (v[j].x * v[j].x + v[j].y * v[j].y) + (v[j].z * v[j].z + v[j].w * v[j].w);
                const float rstd = 1.0f / sqrtf(wave_sum(s, lane) * (1.0f / D) + EPS);
                f32x4 o[4];
#pragma unroll
                for (int j = 0; j < 4; ++j) o[j] = v[j] * rstd * scv[j] + shv[j];
                if constexpr (MODE != 0) { unsigned* o4 = (unsigned*)((MODE == 1 ? (unsigned char*)hout : hout8) + (size_t)(r0 + r) * D) + lane;
#pragma unroll
                    for (int j = 0; j < 4; ++j) { const f32x4 q = (HQ == 2) ? rot64(o[j], lane) : o[j]; o4[64 * j] = pk4_q<HQ>(q.x * sa, q.y * sa, q.z * sa, q.w * sa); } }
                if constexpr (MODE != 1) store_row_bf16(hout + (size_t)(r0 + r) * D, lane, o); }
        }
#undef PN_LOAD
    }
}

constexpr int CONV_RUN = 16;
__device__ __forceinline__ void p_conv(Frame& F, const bf16* P1, const float* conv_w, bf16* ya) {
    const int gt = F.bid * NT + F.tid, NGT = F.G * NT;
    for (int run = gt >> 6; run < M / CONV_RUN; run += NGT >> 6) {
        const int c8 = (gt & 63) * 8, row0 = run * CONV_RUN, pos0 = row0 & (SEQ - 1);
        const unsigned char* p = (const unsigned char*)P1 + (size_t)row0 * P1_PITCH + c8;
        float w0[8], w1[8], w2[8], z1[8], z2[8];
#pragma unroll
        for (int i = 0; i < 8; ++i) { w0[i] = conv_w[c8 + i]; w1[i] = conv_w[512 + c8 + i]; w2[i] = conv_w[1024 + c8 + i]; z1[i] = 0.f; z2[i] = 0.f; }
        if (pos0 >= 2) {
            float c1[8], h1[8], c2[8], h2[8];
            decode8u(*(const v2u_p1*)(p - P1_PITCH + 512), c1); decode8u(*(const v2u_p1*)(p - P1_PITCH + 1024), h1);
            decode8u(*(const v2u_p1*)(p - 2 * P1_PITCH + 512), c2); decode8u(*(const v2u_p1*)(p - 2 * P1_PITCH + 1024), h2);
#pragma unroll
            for (int i = 0; i < 8; ++i) { z1[i] = c1[i] * h1[i]; z2[i] = c2[i] * h2[i]; } }
        v2u_p1 nb = *(const v2u_p1*)p, nc = *(const v2u_p1*)(p + 512), nh = *(const v2u_p1*)(p + 1024);
#pragma unroll 2
        for (int k = 0; k < CONV_RUN; ++k) {
            const v2u_p1 rb = nb, rc = nc, rh = nh;
            if (k + 1 < CONV_RUN) { const unsigned char* pn = p + (size_t)(k + 1) * P1_PITCH; nb = *(const v2u_p1*)pn; nc = *(const v2u_p1*)(pn + 512); nh = *(const v2u_p1*)(pn + 1024); }
            float ab[8], ac[8], ah[8], y[8];
            decode8u(rb, ab); decode8u(rc, ac); decode8u(rh, ah);
#pragma unroll
            for (int i = 0; i < 8; ++i) { const float z = ac[i] * ah[i]; y[i] = ab[i] * (w0[i] * z + w1[i] * z1[i] + w2[i] * z2[i]); z2[i] = z1[i]; z1[i] = z; }
            store_y8<Q_BR>(ya, (size_t)(row0 + k) * 512 + c8, y, F.lane, CLIP_YA);
        }
    }
}

typedef short v4i16_t __attribute__((ext_vector_type(4)));
typedef short bf16x8_t __attribute__((ext_vector_type(8)));
typedef unsigned v2u __attribute__((ext_vector_type(2)));
constexpr int HRS = 272;
constexpr int TRS = 80;
constexpr int H_RAWQ = 0, H_RAWF = 8704, H_V = 17408, H_QHT = 26112, H_KTT = 36352, H_KHT = 46592, H_DL = 56832, H_OB = 57344, H_OBS = 132, H_V2 = 74240;
constexpr int HSEG = 512, HNSEG = SEQ / HSEG, HCH = 32;
__device__ __forceinline__ v4i16_t tr_read(LAS unsigned char* p) { return __builtin_amdgcn_ds_read_tr16_b64_v4i16((LAS v4i16_t*)p); }
__device__ __forceinline__ bf16x8_t cat4(v4i16_t lo, v4i16_t hi) { return __builtin_shufflevector(lo, hi, 0, 1, 2, 3, 4, 5, 6, 7); }
__device__ __forceinline__ bf16x8_t pack_acc(const f32x4 a, const f32x4 b) { v4u w; w.x = pk2(a[0], a[1]); w.y = pk2(a[2], a[3]); w.z = pk2(b[0], b[1]); w.w = pk2(b[2], b[3]); return __builtin_bit_cast(bf16x8_t, w); }
__device__ __forceinline__ float bfs(short x) { return __uint_as_float((unsigned)(unsigned short)x << 16); }
template <int PASS>
__device__ __forceinline__ void p_hgrn(Frame& F, const bf16* P1, const float* lb_logits, int layer, const float* norm_w, bf16* yb, float* ust, float* dst) {
    LAS unsigned char* L = F.lds;
    const int lane = F.lane, w = F.wave, g = lane >> 4, n = lane & 15, q_ = n >> 2, p_ = n & 3;
    const int pt = F.tid >> 4, pc8 = (F.tid & 15) * 8;
    for (int u = F.bid; u < BATCH * H_B * HNSEG; u += F.G) {
        const int seg = u & (HNSEG - 1), bh = u / HNSEG, b = bh >> 2, h = bh & 3;
        const int d = 16 * w + n;
        float lb; { const int ch = h * 128 + d; const float l0 = lb_logits[ch], l1 = lb_logits[512 + ch]; const float mx = fmaxf(l0, l1);
            const float e0 = expf(l0 - mx), e1 = expf(l1 - mx); const float p0 = e0 / (e0 + e1), p1 = e1 / (e0 + e1);
            const float lbx = (layer == 0) ? (p0 - p0) : ((p0 + p1) - p0); lb = fminf(fmaxf(lbx, 0.f), 1.f); }
        const float lbf = fmaxf(lb, 1e-30f), oml = 1.0f - lb;
        f32x4 S[8];
#pragma unroll
        for (int kt = 0; kt < 8; ++kt) S[kt] = (f32x4){0.f, 0.f, 0.f, 0.f};
        if (PASS == 2) {
#pragma unroll 2
            for (int j = 0; j < seg; ++j) { const int uj = u - seg + j;
#pragma unroll
                for (int kt = 0; kt < 8; ++kt) { const f32x4 dj = *(const f32x4*)(dst + (size_t)uj * 128 + 16 * kt + 4 * g); const f32x4 uu = *(const f32x4*)(ust + ((((size_t)uj * 8 + w) * 8 + kt) * 64 + lane) * 4);
                    S[kt] = dj * S[kt] + uu; } }
        }
        float nw8[8];
        if (PASS == 2) {
#pragma unroll
            for (int i = 0; i < 8; ++i) nw8[i] = norm_w[h * 128 + pc8 + i]; }
        float dprod = 1.0f;
        const bf16* gp = P1 + ((size_t)b * SEQ + (size_t)seg * HSEG + pt) * P1E + P1_OB / 2 + h * 128 + pc8;
        constexpr int HPF = 4, NCH = HSEG / HCH;
        v4u rq[HPF], rf[HPF], rv[HPF], rg[HPF];
#pragma unroll
        for (int k = 0; k < HPF; ++k) { const bf16* np = gp + (size_t)k * HCH * P1E; rf[k] = *(const v4u*)(np + 512); rv[k] = *(const v4u*)(np + 1024);
            if (PASS == 2) { rq[k] = *(const v4u*)np; rg[k] = *(const v4u*)(np + 1536); } }
#define HG_WRITE(k_, vb_) do { *(LAS v4u*)(L + H_RAWF + pt * HRS + pc8 * 2) = rf[k_]; *(LAS v4u*)(L + ((vb_) ? H_V2 : H_V) + pt * HRS + pc8 * 2) = rv[k_]; \
            if (PASS == 2) *(LAS v4u*)(L + H_RAWQ + pt * HRS + pc8 * 2) = rq[k_]; } while (0)
#define HG_REFILL(k_, cn_) do { if ((cn_) < NCH) { const bf16* np = gp + (size_t)(cn_) * HCH * P1E; rf[k_] = *(const v4u*)(np + 512); rv[k_] = *(const v4u*)(np + 1024); \
            if (PASS == 2) { rq[k_] = *(const v4u*)np; rg[k_] = *(const v4u*)(np + 1536); } } } while (0)
        v4u cg, cgn;
        HG_WRITE(0, 0); if (PASS == 2) cg = rg[0];
        LDS_BARRIER();
        HG_REFILL(0, HPF);
            { const bf16x8_t f8 = cat4(tr_read(L + H_RAWF + (8 * g + q_) * HRS + 32 * w + 8 * p_), tr_read(L + H_RAWF + (8 * g + 4 + q_) * HRS + 32 * w + 8 * p_));
              float eb[8], kk[8]; float cp = 1.0f;
#pragma unroll
              for (int i = 0; i < 8; ++i) { const float sg = __builtin_amdgcn_rcpf(1.0f + __expf(-bfs(f8[i]))); const float f = lbf + oml * sg; kk[i] = oml * (1.0f - sg); cp *= f; eb[i] = cp; }
              const float s1 = shl(cp, n), s2 = shl(cp, 16 + n), s3 = shl(cp, 32 + n), s4 = shl(cp, 48 + n);
              const float pre = (g > 0 ? s1 : 1.0f) * (g > 1 ? s2 : 1.0f) * (g > 2 ? s3 : 1.0f);
              const float elast = ((s1 * s2) * s3) * s4;
              float kh[8], kt8[8];
#pragma unroll
              for (int i = 0; i < 8; ++i) { eb[i] *= pre; const float en = __builtin_amdgcn_rcpf(fmaxf(eb[i], 1e-30f)); kt8[i] = kk[i] * en; kh[i] = kt8[i] * elast; }
              *(LAS v4u*)(L + H_KHT + d * TRS + 16 * g) = pack8(kh);
              if (PASS == 2) { const bf16x8_t q8 = cat4(tr_read(L + H_RAWQ + (8 * g + q_) * HRS + 32 * w + 8 * p_), tr_read(L + H_RAWQ + (8 * g + 4 + q_) * HRS + 32 * w + 8 * p_));
                  float qh[8];
#pragma unroll
                  for (int i = 0; i < 8; ++i) qh[i] = siluf_(bfs(q8[i])) * eb[i];
                  *(LAS v4u*)(L + H_QHT + d * TRS + 16 * g) = pack8(qh); *(LAS v4u*)(L + H_KTT + d * TRS + 16 * g) = pack8(kt8); }
              if (g == 0) *(LAS float*)(L + H_DL + 4 * d) = elast;
              dprod *= elast; }
        LDS_BARRIER();
        for (int c0 = 0; c0 < NCH; c0 += HPF) {
#pragma unroll
          for (int k = 0; k < HPF; ++k) {
            const int c = c0 + k; const int vbuf = (k & 1) ? H_V2 : H_V;
            const bf16x8_t bVn = cat4(tr_read(L + vbuf + (8 * g + q_) * HRS + 32 * w + 8 * p_), tr_read(L + vbuf + (8 * g + 4 + q_) * HRS + 32 * w + 8 * p_));
            if (PASS == 2) {
                const bf16x8_t bVp = cat4(tr_read(L + vbuf + (4 * g + q_) * HRS + 32 * w + 8 * p_), tr_read(L + vbuf + (16 + 4 * g + q_) * HRS + 32 * w + 8 * p_));
                f32x4 o[2], pt00 = {0.f, 0.f, 0.f, 0.f}, pt01 = {0.f, 0.f, 0.f, 0.f}, pt11 = {0.f, 0.f, 0.f, 0.f};
                o[0] = (f32x4){0.f, 0.f, 0.f, 0.f}; o[1] = (f32x4){0.f, 0.f, 0.f, 0.f};
#pragma unroll
                for (int ks = 0; ks < 4; ++ks) {
                    const bf16x8_t sb = pack_acc(S[2 * ks], S[2 * ks + 1]);
#pragma unroll
                    for (int tm = 0; tm < 2; ++tm) {
                        const bf16x8_t aq = cat4(tr_read(L + H_QHT + (32 * ks + 4 * g + q_) * TRS + 32 * tm + 8 * p_), tr_read(L + H_QHT + (32 * ks + 16 + 4 * g + q_) * TRS + 32 * tm + 8 * p_));
                        o[tm] = __builtin_amdgcn_mfma_f32_16x16x32_bf16(aq, sb, o[tm], 0, 0, 0); }
                    const bf16x8_t aK0 = cat4(tr_read(L + H_KTT + (32 * ks + 8 * g + q_) * TRS + 8 * p_), tr_read(L + H_KTT + (32 * ks + 8 * g + 4 + q_) * TRS + 8 * p_));
                    const bf16x8_t aK1 = cat4(tr_read(L + H_KTT + (32 * ks + 8 * g + q_) * TRS + 32 + 8 * p_), tr_read(L + H_KTT + (32 * ks + 8 * g + 4 + q_) * TRS + 32 + 8 * p_));
                    const bf16x8_t bQ0 = cat4(tr_read(L + H_QHT + (32 * ks + 8 * g + q_) * TRS + 8 * p_), tr_read(L + H_QHT + (32 * ks + 8 * g + 4 + q_) * TRS + 8 * p_));
                    const bf16x8_t bQ1 = cat4(tr_read(L + H_QHT + (32 * ks + 8 * g + q_) * TRS + 32 + 8 * p_), tr_read(L + H_QHT + (32 * ks + 8 * g + 4 + q_) * TRS + 32 + 8 * p_));
                    pt00 = __builtin_amdgcn_mfma_f32_16x16x32_bf16(aK0, bQ0, pt00, 0, 0, 0);
                    pt01 = __builtin_amdgcn_mfma_f32_16x16x32_bf16(aK0, bQ1, pt01, 0, 0, 0);
                    pt11 = __builtin_amdgcn_mfma_f32_16x16x32_bf16(aK1, bQ1, pt11, 0, 0, 0);
                }
#pragma unroll
                for (int j = 0; j < 4; ++j) if (4 * g + j > n) { pt00[j] = 0.f; pt11[j] = 0.f; }
                const f32x4 z4 = {0.f, 0.f, 0.f, 0.f};
                o[0] = __builtin_amdgcn_mfma_f32_16x16x32_bf16(pack_acc(pt00, z4), bVp, o[0], 0, 0, 0);
                o[1] = __builtin_amdgcn_mfma_f32_16x16x32_bf16(pack_acc(pt01, pt11), bVp, o[1], 0, 0, 0);
#pragma unroll
                for (int tm = 0; tm < 2; ++tm)
#pragma unroll
                    for (int j = 0; j < 4; ++j) *(LAS float*)(L + H_OB + ((16 * tm + 4 * g + j) * H_OBS + 16 * w + n) * 4) = o[tm][j];
            }
#pragma unroll
            for (int kt = 0; kt < 8; ++kt) { const f32x4 dl4 = *(const LAS f32x4*)(L + H_DL + (16 * kt + 4 * g) * 4);
                const bf16x8_t aKh = *(const LAS bf16x8_t*)(L + H_KHT + (16 * kt + n) * TRS + 16 * g);
                S[kt] = __builtin_amdgcn_mfma_f32_16x16x32_bf16(aKh, bVn, S[kt] * dl4, 0, 0, 0); }
            if (c + 1 < NCH) { HG_WRITE((k + 1) % HPF, (k + 1) & 1); if (PASS == 2) cgn = rg[(k + 1) % HPF]; }
            LDS_BARRIER();
            if (c + 1 < NCH) HG_REFILL((k + 1) % HPF, c + 1 + HPF);
            if (PASS == 2) {
                const f32x4 o0 = *(const LAS f32x4*)(L + H_OB + (pt * H_OBS + pc8) * 4), o1 = *(const LAS f32x4*)(L + H_OB + (pt * H_OBS + pc8 + 4) * 4);
                const float o8[8] = {o0.x, o0.y, o0.z, o0.w, o1.x, o1.y, o1.z, o1.w};
                float ss = 0.f;
#pragma unroll
                for (int i = 0; i < 8; ++i) ss += o8[i] * o8[i];
                ss += shx(ss, 1, lane); ss += shx(ss, 2, lane); ss += shx(ss, 4, lane); ss += shx(ss, 8, lane);
                const float rs = 1.0f / sqrtf(ss * (1.0f / 128.0f) + EPS);
                float g8[8], y[8]; unpack8(cg, g8);
#pragma unroll
                for (int i = 0; i < 8; ++i) y[i] = o8[i] * rs * nw8[i] * siluf_(g8[i]);
                store_y8<Q_BR, 8>(yb, ((size_t)b * SEQ + (size_t)seg * HSEG + (size_t)c * HCH + pt) * 512 + h * 128 + pc8, y, lane, CLIP_YB);
            }
            if (c + 1 < NCH)
            { const bf16x8_t f8 = cat4(tr_read(L + H_RAWF + (8 * g + q_) * HRS + 32 * w + 8 * p_), tr_read(L + H_RAWF + (8 * g + 4 + q_) * HRS + 32 * w + 8 * p_));
              float eb[8], kk[8]; float cp = 1.0f;
#pragma unroll
              for (int i = 0; i < 8; ++i) { const float sg = __builtin_amdgcn_rcpf(1.0f + __expf(-bfs(f8[i]))); const float f = lbf + oml * sg; kk[i] = oml * (1.0f - sg); cp *= f; eb[i] = cp; }
              const float s1 = shl(cp, n), s2 = shl(cp, 16 + n), s3 = shl(cp, 32 + n), s4 = shl(cp, 48 + n);
              const float pre = (g > 0 ? s1 : 1.0f) * (g > 1 ? s2 : 1.0f) * (g > 2 ? s3 : 1.0f);
              const float elast = ((s1 * s2) * s3) * s4;
              float kh[8], kt8[8];
#pragma unroll
              for (int i = 0; i < 8; ++i) { eb[i] *= pre; const float en = __builtin_amdgcn_rcpf(fmaxf(eb[i], 1e-30f)); kt8[i] = kk[i] * en; kh[i] = kt8[i] * elast; }
              *(LAS v4u*)(L + H_KHT + d * TRS + 16 * g) = pack8(kh);
              if (PASS == 2) { const bf16x8_t q8 = cat4(tr_read(L + H_RAWQ + (8 * g + q_) * HRS + 32 * w + 8 * p_), tr_read(L + H_RAWQ + (8 * g + 4 + q_) * HRS + 32 * w + 8 * p_));
                  float qh[8];
#pragma unroll
                  for (int i = 0; i < 8; ++i) qh[i] = siluf_(bfs(q8[i])) * eb[i];
                  *(LAS v4u*)(L + H_QHT + d * TRS + 16 * g) = pack8(qh); *(LAS v4u*)(L + H_KTT + d * TRS + 16 * g) = pack8(kt8); }
              if (g == 0) *(LAS float*)(L + H_DL + 4 * d) = elast;
              dprod *= elast; }
            LDS_BARRIER();
            if (PASS == 2) cg = cgn;
          }
        }
#undef HG_WRITE
#undef HG_REFILL
        if (PASS == 1) {
#pragma unroll
            for (int kt = 0; kt < 8; ++kt) *(f32x4*)(ust + ((((size_t)u * 8 + w) * 8 + kt) * 64 + lane) * 4) = S[kt];
            if (g == 0) dst[(size_t)u * 128 + d] = dprod;
        }
        __syncthreads();
    }
}


constexpr int H1_G = 4, H1_RF = 0, H1_RV = H1_G * 8704, H1_KH = 2 * H1_G * 8704;
__device__ __forceinline__ void p_hgrn1(Frame& F, const bf16* P1, const float* lb_logits, int layer, float* ust, float* dst) {
    LAS unsigned char* L = F.lds;
    const int lane = F.lane, w = F.wave, g = lane >> 4, n = lane & 15, q_ = n >> 2, p_ = n & 3;
    const int pt = F.tid >> 4, pc8 = (F.tid & 15) * 8;
    constexpr int NCH = HSEG / HCH;
    for (int u = F.bid; u < BATCH * H_B * HNSEG; u += F.G) {
        const int seg = u & (HNSEG - 1), bh = u / HNSEG, b = bh >> 2, h = bh & 3;
        const int d = 16 * w + n;
        float lb; { const int ch = h * 128 + d; const float l0 = lb_logits[ch], l1 = lb_logits[512 + ch]; const float mx = fmaxf(l0, l1);
            const float e0 = expf(l0 - mx), e1 = expf(l1 - mx); const float p0 = e0 / (e0 + e1), p1 = e1 / (e0 + e1);
            const float lbx = (layer == 0) ? (p0 - p0) : ((p0 + p1) - p0); lb = fminf(fmaxf(lbx, 0.f), 1.f); }
        const float lbf = fmaxf(lb, 1e-30f), oml = 1.0f - lb;
        f32x4 S[8];
#pragma unroll
        for (int kt = 0; kt < 8; ++kt) S[kt] = (f32x4){0.f, 0.f, 0.f, 0.f};
        float R = 1.0f;
        const bf16* gp = P1 + ((size_t)b * SEQ + (size_t)seg * HSEG + pt) * P1E + P1_OB / 2 + h * 128 + pc8;
        v4u rf[H1_G], rv[H1_G];
#pragma unroll
        for (int j = 0; j < H1_G; ++j) { const bf16* np = gp + (size_t)(NCH - 1 - j) * HCH * P1E; rf[j] = *(const v4u*)(np + 512); rv[j] = *(const v4u*)(np + 1024); }
#pragma unroll 1
        for (int c0 = NCH - 1; c0 >= 0; c0 -= H1_G) {
#pragma unroll
            for (int j = 0; j < H1_G; ++j) { *(LAS v4u*)(L + H1_RF + j * 8704 + pt * HRS + pc8 * 2) = rf[j]; *(LAS v4u*)(L + H1_RV + j * 8704 + pt * HRS + pc8 * 2) = rv[j]; }
            LDS_BARRIER();
            if (c0 - H1_G >= 0) {
#pragma unroll
                for (int j = 0; j < H1_G; ++j) { const bf16* np = gp + (size_t)(c0 - H1_G - j) * HCH * P1E; rf[j] = *(const v4u*)(np + 512); rv[j] = *(const v4u*)(np + 1024); } }
#pragma unroll
            for (int j = 0; j < H1_G; ++j) {
                const bf16x8_t f8 = cat4(tr_read(L + H1_RF + j * 8704 + (8 * g + q_) * HRS + 32 * w + 8 * p_), tr_read(L + H1_RF + j * 8704 + (8 * g + 4 + q_) * HRS + 32 * w + 8 * p_));
                float eb[8], kk[8]; float cp = 1.0f;
#pragma unroll
                for (int i = 0; i < 8; ++i) { const float sg = __builtin_amdgcn_rcpf(1.0f + __expf(-bfs(f8[i]))); const float f = lbf + oml * sg; kk[i] = oml * (1.0f - sg); cp *= f; eb[i] = cp; }
                const float s1 = shl(cp, n), s2 = shl(cp, 16 + n), s3 = shl(cp, 32 + n), s4 = shl(cp, 48 + n);
                const float pre = (g > 0 ? s1 : 1.0f) * (g > 1 ? s2 : 1.0f) * (g > 2 ? s3 : 1.0f);
                const float elast = ((s1 * s2) * s3) * s4, er = elast * R;
                float kh[8];
#pragma unroll
                for (int i = 0; i < 8; ++i) { const float en = __builtin_amdgcn_rcpf(fmaxf(eb[i] * pre, 1e-30f)); kh[i] = (kk[i] * en) * er; }
                *(LAS v4u*)(L + H1_KH + j * 10240 + d * TRS + 16 * g) = pack8(kh);
                R = er; }
            LDS_BARRIER();
#pragma unroll
            for (int j = 0; j < H1_G; ++j) {
                const bf16x8_t bVn = cat4(tr_read(L + H1_RV + j * 8704 + (8 * g + q_) * HRS + 32 * w + 8 * p_), tr_read(L + H1_RV + j * 8704 + (8 * g + 4 + q_) * HRS + 32 * w + 8 * p_));
#pragma unroll
                for (int kt = 0; kt < 8; ++kt) { const bf16x8_t aKh = *(const LAS bf16x8_t*)(L + H1_KH + j * 10240 + (16 * kt + n) * TRS + 16 * g);
                    S[kt] = __builtin_amdgcn_mfma_f32_16x16x32_bf16(aKh, bVn, S[kt], 0, 0, 0); } }
            LDS_BARRIER();
        }
#pragma unroll
        for (int kt = 0; kt < 8; ++kt) *(f32x4*)(ust + ((((size_t)u * 8 + w) * 8 + kt) * 64 + lane) * 4) = S[kt];
        if (g == 0) dst[(size_t)u * 128 + d] = R;
        __syncthreads();
    }
}

constexpr int SG_V = 0, SG_OB = 34816, SG_OBS = 132, SG_RS = SG_OB + 128 * SG_OBS * 4;
__device__ __forceinline__ void p_sgu(Frame& F, const bf16* P1, const float* norm_w, const float* sgu_w, const float* sgu_b, bf16* yc) {
    LAS unsigned char* L = F.lds;
    const int lane = F.lane, w = F.wave, gq = lane >> 4, n = lane & 15, q_ = n >> 2, p_ = n & 3;
    const int sr = F.tid >> 4, c8 = (F.tid & 15) * 8;
    for (int u = F.bid; u < M / 128; u += F.G) {
        const size_t row0 = (size_t)u * 128;
        v2u_p1 rv[4][4]; float ssj[4] = {0.f, 0.f, 0.f, 0.f};
#pragma unroll
        for (int g = 0; g < 4; ++g)
#pragma unroll
            for (int j = 0; j < 4; ++j) { rv[g][j] = *(const v2u_p1*)((const unsigned char*)P1 + (row0 + sr + 32 * j) * P1_PITCH + P1_OC + 512 + g * 128 + c8); float f[8]; decode8u(rv[g][j], f);
#pragma unroll
                for (int i = 0; i < 8; ++i) ssj[j] += f[i] * f[i]; }
#pragma unroll
        for (int j = 0; j < 4; ++j) { float ss = ssj[j]; ss += shx(ss, 1, lane); ss += shx(ss, 2, lane); ss += shx(ss, 4, lane); ss += shx(ss, 8, lane);
            if (n == 0) *(LAS float*)(L + SG_RS + 4 * (sr + 32 * j)) = 1.0f / sqrtf(ss * (1.0f / 512.0f) + EPS); }
        const int kmax = w >> 1, t = 16 * w + n;
        f32x4 wl[4][2]; float nwl[8];
#define SG_WLOAD(g_) do { _Pragma("unroll") for (int ks = 0; ks < 4; ++ks) { const float* wp = sgu_w + ((size_t)(g_) * 128 + t) * 128 + 32 * ks + 8 * gq; wl[ks][0] = *(const f32x4*)wp; wl[ks][1] = *(const f32x4*)(wp + 4); } \
            _Pragma("unroll") for (int ct = 0; ct < 8; ++ct) nwl[ct] = norm_w[(g_) * 128 + 16 * ct + n]; asm volatile("" ::: "memory"); } while (0)

#pragma unroll
        for (int g = 0; g < 4; ++g) {
            SG_WLOAD(g);
            v2u_p1 ul[4]; float bl[4];
#pragma unroll
            for (int j = 0; j < 4; ++j) { ul[j] = *(const v2u_p1*)((const unsigned char*)P1 + (row0 + sr + 32 * j) * P1_PITCH + P1_OC + g * 128 + c8); bl[j] = sgu_b[g * 128 + sr + 32 * j]; }
            asm volatile("" ::: "memory");
#pragma unroll
            for (int j = 0; j < 4; ++j) { v2u_p1 rw = rv[g][j]; asm volatile("" : "+v"(rw.x), "+v"(rw.y));
                float f[8]; decode8u(rw, f); *(LAS v4u*)(L + SG_V + (sr + 32 * j) * HRS + c8 * 2) = pack8(f); }
            LDS_BARRIER();
            float nwv[8];
            bf16x8_t aW[4];
            {
#pragma unroll
              for (int ct = 0; ct < 8; ++ct) nwv[ct] = nwl[ct];
#pragma unroll
              for (int ks = 0; ks < 4; ++ks) { const int s0 = 32 * ks + 8 * gq;
                    const f32x4 w0 = wl[ks][0], w1 = wl[ks][1]; const f32x4 r0 = *(const LAS f32x4*)(L + SG_RS + 4 * s0), r1 = *(const LAS f32x4*)(L + SG_RS + 4 * (s0 + 4));
                    float a8[8] = {w0.x * r0.x, w0.y * r0.y, w0.z * r0.z, w0.w * r0.w, w1.x * r1.x, w1.y * r1.y, w1.z * r1.z, w1.w * r1.w};
#pragma unroll
                    for (int i = 0; i < 8; ++i) if (s0 + i > t) a8[i] = 0.f;
                    aW[ks] = __builtin_bit_cast(bf16x8_t, pack8(a8)); } }
            f32x4 acc[8];
#pragma unroll
            for (int ct = 0; ct < 8; ++ct) acc[ct] = (f32x4){0.f, 0.f, 0.f, 0.f};
#pragma unroll
            for (int ks = 0; ks < 4; ++ks) { if (ks <= kmax) {
#pragma unroll
                for (int ct = 0; ct < 8; ++ct) { const bf16x8_t bV = cat4(tr_read(L + SG_V + (32 * ks + 8 * gq + q_) * HRS + 32 * ct + 8 * p_), tr_read(L + SG_V + (32 * ks + 8 * gq + 4 + q_) * HRS + 32 * ct + 8 * p_));
                    acc[ct] = __builtin_amdgcn_mfma_f32_16x16x32_bf16(aW[ks], bV, acc[ct], 0, 0, 0); } } }
#pragma unroll
            for (int ct = 0; ct < 8; ++ct) { const float nw = nwv[ct];
#pragma unroll
                for (int j = 0; j < 4; ++j) *(LAS float*)(L + SG_OB + ((16 * w + 4 * gq + j) * SG_OBS + 16 * ct + n) * 4) = acc[ct][j] * nw; }
            LDS_BARRIER();
#pragma unroll
            for (int j = 0; j < 4; ++j) { const int tt = sr + 32 * j; const float bias = bl[j];
                const f32x4 o0 = *(const LAS f32x4*)(L + SG_OB + (tt * SG_OBS + c8) * 4), o1 = *(const LAS f32x4*)(L + SG_OB + (tt * SG_OBS + c8 + 4) * 4);
                float uu[8], y[8]; decode8u(ul[j], uu);
                y[0] = (o0.x + bias) * uu[0]; y[1] = (o0.y + bias) * uu[1]; y[2] = (o0.z + bias) * uu[2]; y[3] = (o0.w + bias) * uu[3];
                y[4] = (o1.x + bias) * uu[4]; y[5] = (o1.y + bias) * uu[5]; y[6] = (o1.z + bias) * uu[6]; y[7] = (o1.w + bias) * uu[7];
                store_y8<Q_BR, 8>(yc, (row0 + tt) * 512 + g * 128 + c8, y, lane, CLIP_YC); }
        }
        __syncthreads();
    }
#undef SG_WLOAD
}

__device__ __forceinline__ void p_norm_router(Frame& F, KArgs ka, const void* x, const float* w, const float* mod_l, bf16* h2) {
    const float* rw = ka->in[20]; const float* rb = ka->in[21]; unsigned* ctl = (unsigned*)(ka->ws + WS_CTL);
    float* topp = (float*)(ka->ws + WS_TOPP); int* list = (int*)(ka->ws + WS_LIST);
    LAS float* RWt = (LAS float*)F.lds;
    LAS int* lcnt = (LAS int*)(RWt + 8192);
    LAS int* lbase = lcnt + 16;
    LAS int* sel = lbase + 16;
    LAS int* rnk = sel + 128;
    for (int i = F.tid; i < D * NE; i += NT) { const int k = i >> 3, e = i & 7; RWt[e * D + k] = rw[i]; }
    __syncthreads();
    float rbv[8];
#pragma unroll
    for (int e = 0; e < 8; ++e) rbv[e] = rb[e];
    f32x4 wv[4];
#pragma unroll
    for (int j = 0; j < 4; ++j) wv[j] = ((const f32x4*)w)[F.lane + 64 * j];
    for (int batch = F.bid; batch < M / 128; batch += F.G) {
        const int row0 = batch * 128;
        if (F.tid < 16) lcnt[F.tid] = 0;
        const float* mb = mod_l + (size_t)(row0 >> 12) * MOD_LD;
        f32x4 scv[4], shv[4], xn[4];
#pragma unroll
        for (int j = 0; j < 4; ++j) { scv[j] = ((const f32x4*)(mb + 4 * D))[F.lane + 64 * j]; shv[j] = ((const f32x4*)(mb + 3 * D))[F.lane + 64 * j]; xn[j] = load_x4<true>(x, (size_t)(row0 + F.wave * 16), F.lane, j); }
        asm volatile("" ::: "memory");
#pragma unroll
        for (int j = 0; j < 4; ++j) scv[j] = wv[j] * (scv[j] + 1.0f);
        __syncthreads();
        for (int rr = 0; rr < 16; ++rr) {
            const int r = F.wave * 16 + rr, row = row0 + r;
            f32x4 v[4];
#pragma unroll
            for (int j = 0; j < 4; ++j) v[j] = xn[j];
            if (rr + 1 < 16) {
#pragma unroll
                for (int j = 0; j < 4; ++j) xn[j] = load_x4<true>(x, (size_t)(row + 1), F.lane, j); }
            float ssq = 0.f;
#pragma unroll
            for (int j = 0; j < 4; ++j) ssq += (v[j].x * v[j].x + v[j].y * v[j].y) + (v[j].z * v[j].z + v[j].w * v[j].w);
            const float rstd = 1.0f / sqrtf(wave_sum(ssq, F.lane) * (1.0f / D) + EPS);
            f32x4 o[4];
#pragma unroll
            for (int j = 0; j < 4; ++j) o[j] = v[j] * rstd * scv[j] + shv[j];
            { unsigned* o4 = (unsigned*)((unsigned char*)h2 + (size_t)row * D) + F.lane;
#pragma unroll
                for (int j = 0; j < 4; ++j) { const f32x4 q = (Q_MUP == 2) ? rot64(o[j], F.lane) : o[j]; o4[64 * j] = pk4_q<Q_MUP>(q.x * sa_of(Q_MUP, CLIP_MOE), q.y * sa_of(Q_MUP, CLIP_MOE), q.z * sa_of(Q_MUP, CLIP_MOE), q.w * sa_of(Q_MUP, CLIP_MOE)); } }
            float lg[8];
#pragma unroll
            for (int e = 0; e < 8; ++e) { float s = 0.f;
#pragma unroll
                for (int j = 0; j < 4; ++j) { const f32x4 r4 = *(const LAS f32x4*)(RWt + e * D + 4 * F.lane + 256 * j); s += (o[j].x * r4.x + o[j].y * r4.y) + (o[j].z * r4.z + o[j].w * r4.w); }
                lg[e] = wave_sum(s, F.lane) + rbv[e]; }
            int i0 = 0; float v0 = lg[0];
#pragma unroll
            for (int e = 1; e < 8; ++e) if (lg[e] > v0) { v0 = lg[e]; i0 = e; }
            int i1 = -1; float v1 = -3.0e38f;
#pragma unroll
            for (int e = 0; e < 8; ++e) if (e != i0 && lg[e] > v1) { v1 = lg[e]; i1 = e; }
            if (F.lane == 0) {
                const float p0 = 1.0f / (1.0f + expf(v1 - v0));
                topp[(size_t)row * 2] = p0; topp[(size_t)row * 2 + 1] = 1.0f - p0;
                const int rk0 = __hip_atomic_fetch_add(lcnt + i0, 1, __ATOMIC_RELAXED, __HIP_MEMORY_SCOPE_WORKGROUP), rk1 = __hip_atomic_fetch_add(lcnt + 8 + i1, 1, __ATOMIC_RELAXED, __HIP_MEMORY_SCOPE_WORKGROUP);
                sel[r] = i0 | (i1 << 8); rnk[r] = rk0 | (rk1 << 16);
            }
        }
        __syncthreads();
        if (F.tid < 16) lbase[F.tid] = (int)__hip_atomic_fetch_add(ctl + CW_CNT + 64 * F.tid, (unsigned)lcnt[F.tid], __ATOMIC_RELAXED, __HIP_MEMORY_SCOPE_AGENT);
        __syncthreads();
        if (F.tid < 128) { const int sv = sel[F.tid], rv = rnk[F.tid]; const int e0 = sv & 255, e1 = sv >> 8;
            list[(size_t)e0 * LIST_CAP + lbase[e0] + (rv & 0xffff)] = row0 + F.tid;
            list[(size_t)(8 + e1) * LIST_CAP + lbase[8 + e1] + (rv >> 16)] = row0 + F.tid; }
        __syncthreads();
    }
}
__device__ __forceinline__ void moe_tables(Frame& F, unsigned* ctl, int pass) {
    LAS int* tab = (LAS int*)(F.lds + TAB_OFF) + pass * 256;
    __syncthreads();
    if (F.tid < 8) { int c = (int)__hip_atomic_load(ctl + CW_CNT + 64 * (pass * 8 + F.tid), __ATOMIC_RELAXED, __HIP_MEMORY_SCOPE_AGENT); if (c > LIST_CAP) c = LIST_CAP; if (c < 0) c = 0; tab[F.tid] = c; }
    __syncthreads();
    if (F.tid == 0) { int pb = 0;
        for (int e = 0; e < 8; ++e) { const int c = tab[e]; const int np = (c + 255) >> 8; tab[8 + e] = pb; for (int p = 0; p < np; ++p) tab[32 + pb + p] = e; pb += np; }
        tab[16] = pb; }
    __syncthreads();
}
template <bool GATHER_>
struct MoeOrder {
    static constexpr bool GATHER = GATHER_;
    pg8::StaticOrder so; const LAS int* tab; const int* list; int npn; unsigned rowbytes;
    int pm0 = 0;
    int T = 0, HC = 0;
    __device__ __forceinline__ bool next(int i, pg8::Unit& u) const {
        const int G = so.G, c = so.c; long L;
        if (T == 0) L = (long)i * G + c;
        else if (c >= T) L = (i < HC) ? (long)i * (G - T) + (c - T) : (long)HC * (G - T) + (long)(i - HC) * G + c;
        else L = (long)HC * (G - T) + (long)i * G + c;
        if (!so.unit_of(L, u)) return false; u.pm += pm0; u.pb = tab[32 + u.pm] * npn + u.pn; return true; }
    __device__ __forceinline__ int tok_of(int pm, int r) const { const int e = tab[32 + pm]; const int idx = (pm - tab[8 + e]) * 256 + r; return idx < tab[e] ? list[(size_t)e * LIST_CAP + idx] : -1; }
    __device__ __forceinline__ unsigned a_row_off(const pg8::Unit& u, int r) const { const int t = tok_of(u.pm, r); return (unsigned)(t < 0 ? 0 : t) * rowbytes; }
};

#ifndef WIDE_ST
#define WIDE_ST 1
#endif
typedef unsigned v2u_t __attribute__((ext_vector_type(2)));
__device__ __forceinline__ v4u pair16(const v2u_t a, const v2u_t b) {
    const auto rx = __builtin_amdgcn_permlane16_swap(a.x, b.x, false, false); const auto ry = __builtin_amdgcn_permlane16_swap(a.y, b.y, false, false);
    return (v4u){rx[0], ry[0], rx[1], ry[1]};
}
template <int Q>
struct EpiP1 {
    static constexpr bool PERM = true;
    unsigned char* O; float scale;
    __device__ __forceinline__ void operator()(const pg8::f32x4 (&acc)[2][2][4][2], const pg8::Unit& u, int wr, int wc, int fr, int fq) const {
        const int row0 = u.pm * 256 + wr * 64 + fr, colt = u.pn * 256;
        if (u.pn >= 6 && u.pn < 14) {
            unsigned char* base = O + P1_OB + (size_t)(colt - 1536 + wc * 32 + 8 * fq) * 2;
#pragma unroll
            for (int ai = 0; ai < 2; ++ai)
#pragma unroll
                for (int m = 0; m < 4; ++m) { unsigned char* rowp = base + (size_t)(row0 + ai * 128 + m * 16) * P1_PITCH;
#pragma unroll
                    for (int bj = 0; bj < 2; ++bj) { pg8::f32x4 v0 = acc[ai][bj][m][0], v1 = acc[ai][bj][m][1];
                        if constexpr (Q == 2) { const float cb = -ACC_BIAS * scale; v0 = v0 * scale + cb; v1 = v1 * scale + cb; }
                        else { v0 *= scale; v1 *= scale; }
                        v4u w; w.x = pk2(v0[0], v0[1]); w.y = pk2(v0[2], v0[3]); w.z = pk2(v1[0], v1[1]); w.w = pk2(v1[2], v1[3]);
                        *(v4u*)(rowp + bj * 256) = w; } }
        } else {
            unsigned char* base = O + (u.pn < 6 ? colt : P1_OC + colt - 3584) + wc * 32 + 8 * fq;
            const float qs = scale * (127.0f / CLIP_P1);
#pragma unroll
            for (int ai = 0; ai < 2; ++ai)
#pragma unroll
                for (int m = 0; m < 4; ++m) { unsigned char* rowp = base + (size_t)(row0 + ai * 128 + m * 16) * P1_PITCH; v2u_t wb[2];
#pragma unroll
                    for (int bj = 0; bj < 2; ++bj)
#pragma unroll
                        for (int n = 0; n < 2; ++n) { const pg8::f32x4 v = accv<Q>(acc[ai][bj][m][n]) * qs + 128.0f;
                            unsigned pk = __builtin_amdgcn_cvt_pk_u8_f32(v[0], 0u, 0u); pk = __builtin_amdgcn_cvt_pk_u8_f32(v[1], 1u, pk); pk = __builtin_amdgcn_cvt_pk_u8_f32(v[2], 2u, pk); pk = __builtin_amdgcn_cvt_pk_u8_f32(v[3], 3u, pk);
                            if (n == 0) wb[bj].x = pk; else wb[bj].y = pk; }
                    *(v4u*)(rowp + ((fq & 1) ? 128 - 8 : 0)) = pair16(wb[0], wb[1]); } }
    }
};
template <bool GU8, int QB = 0, int QM = 0>
struct EpiBranch {
    static constexpr bool PERM = true;
    const bf16* gate; bf16* mrg; const float* qsb; unsigned char* mrg8;
    __device__ __forceinline__ void operator()(const pg8::f32x4 (&acc)[2][2][4][2], const pg8::Unit& u, int wr, int wc, int fr, int fq) const {
        typedef unsigned v2u_ __attribute__((ext_vector_type(2)));
        const int row0 = u.pm * 256 + wr * 64 + fr, col0 = u.pn * 256 + wc * 32 + 8 * fq + u.aux * D;
        const int first = (u.aux == 0), mshift = u.aux * D;
        const float bsc = (u.aux == 0 ? CLIP_YA : (u.aux == 1 ? CLIP_YB : CLIP_YC)) / (127.0f * (QB == 2 ? qsb[u.aux] : 1.0f));
        v4u gl[2][2][2], ml[2][2][2];
#define EB_LOAD(q) do { _Pragma("unroll") for (int mm_ = 0; mm_ < 2; ++mm_) _Pragma("unroll") for (int bj = 0; bj < 2; ++bj) { \
            const size_t row = (size_t)(row0 + ((q) >> 1) * 128 + (((q) & 1) * 2 + mm_) * 16); const int col = col0 + bj * 128; \
            if constexpr (GU8) { const v2u_ g2 = *(const v2u_*)((const unsigned char*)gate + row * N_G + col); gl[(q) & 1][mm_][bj].x = g2.x; gl[(q) & 1][mm_][bj].y = g2.y; } else gl[(q) & 1][mm_][bj] = *(const v4u*)(gate + row * N_G + col); \
            ml[(q) & 1][mm_][bj] = first ? (v4u){0u, 0u, 0u, 0u} : *(const v4u*)(mrg + row * D + col - mshift); } asm volatile("" ::: "memory"); } while (0)
        EB_LOAD(0);
#pragma unroll
        for (int q = 0; q < 4; ++q) {
            if (q < 3) EB_LOAD(q + 1);
            const int ai = q >> 1;
#pragma unroll
            for (int mm_ = 0; mm_ < 2; ++mm_)
#pragma unroll
                for (int bj = 0; bj < 2; ++bj) { const int m = (q & 1) * 2 + mm_; const size_t row = (size_t)(row0 + ai * 128 + m * 16); const int col = col0 + bj * 128;
                    float gg[8], mm[8], o[8]; unpack8(ml[q & 1][mm_][bj], mm);
                    if constexpr (GU8) {
#pragma unroll
                        for (int i = 0; i < 4; ++i) { gg[i] = (float)((gl[q & 1][mm_][bj].x >> (8 * i)) & 0xffu) * (1.0f / 255.0f); gg[4 + i] = (float)((gl[q & 1][mm_][bj].y >> (8 * i)) & 0xffu) * (1.0f / 255.0f); } }
                    else { unpack8(gl[q & 1][mm_][bj], gg);
#pragma unroll
                        for (int i = 0; i < 8; ++i) gg[i] = sigmoidf_(gg[i]); }
                    pg8::f32x4 v0 = acc[ai][bj][m][0], v1 = acc[ai][bj][m][1];
                    if constexpr (QB == 2) { const float cb = -ACC_BIAS * bsc; v0 = v0 * bsc + cb; v1 = v1 * bsc + cb; }
                    o[0] = mm[0] + gg[0] * v0[0]; o[1] = mm[1] + gg[1] * v0[1]; o[2] = mm[2] + gg[2] * v0[2]; o[3] = mm[3] + gg[3] * v0[3];
                    o[4] = mm[4] + gg[4] * v1[0]; o[5] = mm[5] + gg[5] * v1[1]; o[6] = mm[6] + gg[6] * v1[2]; o[7] = mm[7] + gg[7] * v1[3];
                    if (QM == 2 && u.aux == 2) { fwht8(o); constexpr float s = 0.35355339f * 127.0f / CLIP_MRG; v2u_ w8; w8.x = pk4_q<2>(o[0] * s, o[1] * s, o[2] * s, o[3] * s); w8.y = pk4_q<2>(o[4] * s, o[5] * s, o[6] * s, o[7] * s);
                        *(v2u_*)(mrg8 + row * D + col - mshift) = w8; }
                    else *(v4u*)(mrg + row * D + col - mshift) = pack8(o); }
            asm volatile("" ::: "memory");
        }
#undef EB_LOAD
    }
};
#ifndef CLIP_PART1
#define CLIP_PART1 2.5f
#endif
#ifndef CLIP_PART2
#define CLIP_PART2 5.0f
#endif
__device__ __forceinline__ unsigned pk4_ob(float a, float b, float c, float d) {
    if (SAT_PK) { unsigned r = __builtin_amdgcn_cvt_pk_u8_f32(a + SAT_OFF, 0u, 0u); r = __builtin_amdgcn_cvt_pk_u8_f32(b + SAT_OFF, 1u, r); r = __builtin_amdgcn_cvt_pk_u8_f32(c + SAT_OFF, 2u, r); return __builtin_amdgcn_cvt_pk_u8_f32(d + SAT_OFF, 3u, r); }
    constexpr float MGO = 12582912.0f + 128.0f;
    const unsigned ua = __float_as_uint(__builtin_amdgcn_fmed3f(a + MGO, MGO - 127.0f, MGO + 127.0f)), ub = __float_as_uint(__builtin_amdgcn_fmed3f(b + MGO, MGO - 127.0f, MGO + 127.0f));
    const unsigned uc = __float_as_uint(__builtin_amdgcn_fmed3f(c + MGO, MGO - 127.0f, MGO + 127.0f)), ud = __float_as_uint(__builtin_amdgcn_fmed3f(d + MGO, MGO - 127.0f, MGO + 127.0f));
    return __builtin_amdgcn_perm(__builtin_amdgcn_perm(ud, uc, 0x0c0c0400u), __builtin_amdgcn_perm(ub, ua, 0x0c0c0400u), 0x05040100u);
}
template <int QB>
struct EpiBranch8 {
    static constexpr bool PERM = true;
    const unsigned char* gate; const float* qsb; unsigned char* mrg8;
    __device__ __forceinline__ void operator()(const pg8::f32x4 (&acc)[2][2][4][2], const pg8::Unit& u, int wr, int wc, int fr, int fq) const {
        const int row0 = u.pm * 256 + wr * 64 + fr, col0 = u.pn * 256 + wc * 32 + 8 * fq + u.aux * D;
        const int first = (u.aux == 1), last = (u.aux == 0), mshift = u.aux * D;
        const float bsc = (u.aux == 0 ? CLIP_YA : (u.aux == 1 ? CLIP_YB : CLIP_YC)) / (255.0f * 127.0f * (QB == 2 ? qsb[u.aux] : 1.0f));
        const float din = (u.aux == 2 ? CLIP_PART1 : CLIP_PART2) * (1.0f / 127.0f), dinb = -128.0f * din;
        const float sout = 127.0f / (u.aux == 1 ? CLIP_PART1 : CLIP_PART2);
        const int sto = (fq & 1) ? 128 - 8 : 0;
        v2u_t gl[2][2][2], ml[2][2][2];
#define EB_LOAD(q) do { _Pragma("unroll") for (int mm_ = 0; mm_ < 2; ++mm_) _Pragma("unroll") for (int bj = 0; bj < 2; ++bj) { \
            const size_t row = (size_t)(row0 + ((q) >> 1) * 128 + (((q) & 1) * 2 + mm_) * 16); const int col = col0 + bj * 128; \
            gl[(q) & 1][mm_][bj] = *(const v2u_t*)(gate + row * N_G + col); \
            ml[(q) & 1][mm_][bj] = first ? (v2u_t){0x80808080u, 0x80808080u} : *(const v2u_t*)(mrg8 + row * D + col - mshift); } asm volatile("" ::: "memory"); } while (0)
        EB_LOAD(0);
#pragma unroll
        for (int q = 0; q < 4; ++q) {
            if (q < 3) EB_LOAD(q + 1);
            const int ai = q >> 1;
#pragma unroll
            for (int mm_ = 0; mm_ < 2; ++mm_) { const int m = (q & 1) * 2 + mm_; const size_t row = (size_t)(row0 + ai * 128 + m * 16); v2u_t wb[2];
#pragma unroll
                for (int bj = 0; bj < 2; ++bj) { float gg[8], mm[8], o[8];
#pragma unroll
                    for (int i = 0; i < 4; ++i) { gg[i] = (float)((gl[q & 1][mm_][bj].x >> (8 * i)) & 0xffu); gg[4 + i] = (float)((gl[q & 1][mm_][bj].y >> (8 * i)) & 0xffu);
                        mm[i] = (float)((ml[q & 1][mm_][bj].x >> (8 * i)) & 0xffu) * din + dinb; mm[4 + i] = (float)((ml[q & 1][mm_][bj].y >> (8 * i)) & 0xffu) * din + dinb; }
                    pg8::f32x4 v0 = acc[ai][bj][m][0], v1 = acc[ai][bj][m][1];
                    if constexpr (QB == 2) { const float cb = -ACC_BIAS * bsc; v0 = v0 * bsc + cb; v1 = v1 * bsc + cb; }
                    o[0] = mm[0] + gg[0] * v0[0]; o[1] = mm[1] + gg[1] * v0[1]; o[2] = mm[2] + gg[2] * v0[2]; o[3] = mm[3] + gg[3] * v0[3];
                    o[4] = mm[4] + gg[4] * v1[0]; o[5] = mm[5] + gg[5] * v1[1]; o[6] = mm[6] + gg[6] * v1[2]; o[7] = mm[7] + gg[7] * v1[3];
                    if (last) { fwht8(o); constexpr float s = 0.35355339f * 127.0f / CLIP_MRG; wb[bj].x = pk4_q<2>(o[0] * s, o[1] * s, o[2] * s, o[3] * s); wb[bj].y = pk4_q<2>(o[4] * s, o[5] * s, o[6] * s, o[7] * s); }
                    else { wb[bj].x = pk4_ob(o[0] * sout, o[1] * sout, o[2] * sout, o[3] * sout); wb[bj].y = pk4_ob(o[4] * sout, o[5] * sout, o[6] * sout, o[7] * sout); } }
                *(v4u*)(mrg8 + row * D + col0 - mshift + sto) = pair16(wb[0], wb[1]); }
            asm volatile("" ::: "memory");
        }
#undef EB_LOAD
    }
};
typedef float f32x2_e __attribute__((ext_vector_type(2)));
__device__ __forceinline__ f32x2_e pk_fma2(f32x2_e a, f32x2_e b, f32x2_e c) { f32x2_e d; asm("s_nop 0\n\tv_pk_fma_f32 %0, %1, %2, %3" : "=v"(d) : "v"(a), "v"(b), "v"(c)); return d; }
__device__ __forceinline__ f32x2_e pk_fma2a(f32x2_e a, f32x2_e b, f32x2_e c) { f32x2_e d; asm("v_pk_fma_f32 %0, %1, %2, %3" : "=v"(d) : "v"(a), "v"(b), "v"(c)); return d; }
__device__ __forceinline__ f32x2_e pk_add2(f32x2_e a, f32x2_e b) { f32x2_e d; asm("s_nop 0\n\tv_pk_add_f32 %0, %1, %2" : "=v"(d) : "v"(a), "v"(b)); return d; }
template <int Q>
struct EpiGateU8 {
    static constexpr bool PERM = true;
    unsigned char* O; float scale;
    __device__ __forceinline__ void operator()(const pg8::f32x4 (&acc)[2][2][4][2], const pg8::Unit& u, int wr, int wc, int fr, int fq) const {
        typedef unsigned v2u_ __attribute__((ext_vector_type(2)));
        const int row0 = u.pm * 256 + wr * 64 + fr, col0 = u.pn * 256 + wc * 32 + 8 * fq;
        const float nsl2 = -1.44269504f * scale, nslb = (Q == 2) ? -ACC_BIAS * nsl2 : 0.0f;
        const f32x2_e k2 = {nsl2, nsl2}, b2 = {nslb, nslb}, one2 = {1.0f, 1.0f}, c255 = {255.0f, 255.0f}, mg2 = {12582912.0f, 12582912.0f};
#pragma unroll
        for (int ai = 0; ai < 2; ++ai)
#pragma unroll
            for (int m = 0; m < 4; ++m) { unsigned char* rowp = O + (size_t)(row0 + ai * 128 + m * 16) * N_G + col0;
                v2u_ wb[2];
#pragma unroll
                for (int bj = 0; bj < 2; ++bj) { v2u_ w;
#pragma unroll
                    for (int n = 0; n < 2; ++n) { const pg8::f32x4 av = acc[ai][bj][m][n]; unsigned ub[4];
#pragma unroll
                        for (int h = 0; h < 2; ++h) { const f32x2_e t = pk_fma2a((f32x2_e){av[2 * h], av[2 * h + 1]}, k2, b2);
                            const f32x2_e e = {__builtin_amdgcn_exp2f(t.x), __builtin_amdgcn_exp2f(t.y)}, u1 = pk_add2(e, one2);
                            const f32x2_e r = {__builtin_amdgcn_rcpf(u1.x), __builtin_amdgcn_rcpf(u1.y)}, w2 = pk_fma2(r, c255, mg2);
                            ub[2 * h] = __float_as_uint(w2.x); ub[2 * h + 1] = __float_as_uint(w2.y); }
                        const unsigned p = __builtin_amdgcn_perm(__builtin_amdgcn_perm(ub[3], ub[2], 0x0c0c0400u), __builtin_amdgcn_perm(ub[1], ub[0], 0x0c0c0400u), 0x05040100u);
                        if (n == 0) w.x = p; else w.y = p; }
                    wb[bj] = w; }
                if (WIDE_ST) *(v4u*)(rowp + ((fq & 1) ? 128 - 8 : 0)) = pair16(wb[0], wb[1]);
                else { *(v2u_*)rowp = wb[0]; *(v2u_*)(rowp + 128) = wb[1]; } }
    }
};
template <bool IN_F32, int QI = 0>
struct EpiResid {
    static constexpr bool PERM = true;
    const void* xin; bf16* xout; const float* gmod; float onum, oden;
    __device__ __forceinline__ void operator()(const pg8::f32x4 (&acc)[2][2][4][2], const pg8::Unit& u, int wr, int wc, int fr, int fq) const {
        const int row0 = u.pm * 256 + wr * 64 + fr, col0 = u.pn * 256 + wc * 32 + 8 * fq;
        const float* gb = gmod + (size_t)((u.pm * 256) >> 12) * MOD_LD + col0;
        float od_ = oden; asm volatile("" : "+s"(od_)); const float oscale = onum / od_;
        pg8::f32x4 gv[2][2];
#pragma unroll
        for (int bj = 0; bj < 2; ++bj)
#pragma unroll
            for (int n = 0; n < 2; ++n) gv[bj][n] = *(const pg8::f32x4*)(gb + bj * 128 + n * 4) * oscale;
        constexpr int NB = 2;
#pragma unroll
        for (int b = 0; b < NB; ++b) {
            pg8::f32x4 xl[2 / NB][4][2][2];
#pragma unroll
            for (int a = 0; a < 2 / NB; ++a)
#pragma unroll
            for (int m = 0; m < 4; ++m)
#pragma unroll
                for (int bj = 0; bj < 2; ++bj) { const int ai = b * (2 / NB) + a; const size_t row = (size_t)(row0 + ai * 128 + m * 16); const int col = col0 + bj * 128;
                    if constexpr (IN_F32) { xl[a][m][bj][0] = *(const pg8::f32x4*)((const float*)xin + row * D + col); xl[a][m][bj][1] = *(const pg8::f32x4*)((const float*)xin + row * D + col + 4); }
                    else { const v4u w = *(const v4u*)((const bf16*)xin + row * XLD + col); xl[a][m][bj][0] = __builtin_bit_cast(pg8::f32x4, w); } }
            asm volatile("" ::: "memory");
#pragma unroll
            for (int a = 0; a < 2 / NB; ++a)
#pragma unroll
            for (int m = 0; m < 4; ++m)
#pragma unroll
                for (int bj = 0; bj < 2; ++bj) { const int ai = b * (2 / NB) + a; const size_t row = (size_t)(row0 + ai * 128 + m * 16); const int col = col0 + bj * 128;
                    pg8::f32x4 x0, x1;
                    if constexpr (IN_F32) { x0 = xl[a][m][bj][0]; x1 = xl[a][m][bj][1]; }
                    else { const v4u w = __builtin_bit_cast(v4u, xl[a][m][bj][0]); x0 = (pg8::f32x4){bf_lo(w.x), bf_hi(w.x), bf_lo(w.y), bf_hi(w.y)}; x1 = (pg8::f32x4){bf_lo(w.z), bf_hi(w.z), bf_lo(w.w), bf_hi(w.w)}; }
                    pg8::f32x4 c0 = acc[ai][bj][m][0], c1 = acc[ai][bj][m][1];
                    if constexpr (QI == 2) {
#pragma unroll
                        for (int i = 0; i < 1; ++i) { c0 = c0 - ACC_BIAS; c1 = c1 - ACC_BIAS; } }
                    const pg8::f32x4 o0 = x0 + gv[bj][0] * c0, o1 = x1 + gv[bj][1] * c1;
                    v4u w; w.x = pk2(o0[0], o0[1]); w.y = pk2(o0[2], o0[3]); w.z = pk2(o1[0], o1[1]); w.w = pk2(o1[2], o1[3]);
                    *(v4u*)(xout + row * XLD + col) = w; }
            asm volatile("" ::: "memory");
        }
    }
};
template <int QIN = 0, int QOUT = 0>
struct EpiSwiglu {
    static constexpr bool PERM = true;
    bf16* act; float inv;
    __device__ __forceinline__ void operator()(const pg8::f32x4 (&acc)[2][2][4][2], const pg8::Unit& u, int wr, int wc, int fr, int fq) const {
        const int row0 = u.pm * 256 + wr * 64 + fr, col0 = u.pn * 128 + wc * 32 + 8 * fq;
        v2u_t wprev = {0u, 0u};
        const float invq = QIN ? inv : 1.0f, inv2 = invq * invq, nil2 = -1.44269504f * invq;
#pragma unroll
        for (int ai = 0; ai < 2; ++ai)
#pragma unroll
            for (int m = 0; m < 4; ++m) { float o[8];
#pragma unroll
                for (int n = 0; n < 2; ++n) { const pg8::f32x4 c1 = accv<QIN>(acc[ai][0][m][n]), c3 = accv<QIN>(acc[ai][1][m][n]), pv = c1 * c3, ev = c1 * nil2;
#pragma unroll
                    for (int i = 0; i < 4; ++i) o[n * 4 + i] = pv[i] * __builtin_amdgcn_rcpf(1.0f + __builtin_amdgcn_exp2f(ev[i])); }
                if constexpr (QOUT != 0) { typedef unsigned v2u_ __attribute__((ext_vector_type(2))); v2u_ w8;
                    if constexpr (QOUT == 2) { fwht8(o); const float s = 0.35355339f * 127.0f / CLIP_ACT * inv2; w8.x = pk4_q<2>(o[0] * s, o[1] * s, o[2] * s, o[3] * s); w8.y = pk4_q<2>(o[4] * s, o[5] * s, o[6] * s, o[7] * s); }
                    else { const float s = F8_SACT * inv2; w8.x = pk4_q<1>(o[0] * s, o[1] * s, o[2] * s, o[3] * s); w8.y = pk4_q<1>(o[4] * s, o[5] * s, o[6] * s, o[7] * s); }
                    if (WIDE_ST) { if (m & 1) *(v4u*)((unsigned char*)act + (size_t)(row0 + ai * 128 + (m - 1 + (fq & 1)) * 16) * D_FF + col0 - (fq & 1) * 8) = pair16(wprev, w8);
                        else wprev = w8; }
                    else *(v2u_*)((unsigned char*)act + (size_t)(row0 + ai * 128 + m * 16) * D_FF + col0) = w8; }
                else {
#pragma unroll
                    for (int i = 0; i < 8; ++i) o[i] *= inv2;
                    *(v4u*)(act + (size_t)(row0 + ai * 128 + m * 16) * D_FF + col0) = pack8(o); } }
    }
};
struct EpiMoeDown {
    static constexpr bool PERM = true;
    bf16* x; const float* gmod; const float* topp; int pass; const LAS int* tab; const int* list; float oscale;
    bf16* y1; unsigned char* flag; int y1mode;
    __device__ __forceinline__ int tok_of(int pm, int r) const { const int e = tab[32 + pm]; const int idx = (pm - tab[8 + e]) * 256 + r; return idx < tab[e] ? list[(size_t)e * LIST_CAP + idx] : -1; }
    __device__ __forceinline__ void operator()(const pg8::f32x4 (&acc)[2][2][4][2], const pg8::Unit& u, int wr, int wc, int fr, int fq) const {
        const int col0 = u.pn * 256 + wc * 32 + 8 * fq;
        int tok[2][4];
#pragma unroll
        for (int ai = 0; ai < 2; ++ai)
#pragma unroll
            for (int m = 0; m < 4; ++m) tok[ai][m] = tok_of(u.pm, ai * 128 + wr * 64 + m * 16 + fr);
        asm volatile("" ::: "memory");
#pragma unroll
        for (int am = 0; am < 4; ++am) {
            const int ai = am >> 1, mb = (am & 1) * 2;
            v4u xl[2][2]; pg8::f32x4 gl[2][2][2]; float pv[2];
#pragma unroll
            for (int m = 0; m < 2; ++m) { const int t = tok[ai][mb + m] < 0 ? 0 : tok[ai][mb + m]; pv[m] = topp[(size_t)t * 2 + pass] * oscale; const float* gb = gmod + (size_t)(t >> 12) * MOD_LD + col0;
#pragma unroll
                for (int bj = 0; bj < 2; ++bj) { xl[m][bj] = *(const v4u*)(x + (size_t)t * XLD + col0 + bj * 128);
#pragma unroll
                    for (int n = 0; n < 2; ++n) gl[m][bj][n] = *(const pg8::f32x4*)(gb + bj * 128 + n * 4); } }
            asm volatile("" ::: "memory");
#pragma unroll
            for (int m = 0; m < 2; ++m) { if (tok[ai][mb + m] >= 0) { const int t = tok[ai][mb + m];
                if (y1mode) flag[t] = 1;
#pragma unroll
                for (int bj = 0; bj < 2; ++bj) { const v4u w = y1mode ? (v4u){0u, 0u, 0u, 0u} : xl[m][bj];
                    const pg8::f32x4 x0 = {bf_lo(w.x), bf_hi(w.x), bf_lo(w.y), bf_hi(w.y)}, x1 = {bf_lo(w.z), bf_hi(w.z), bf_lo(w.w), bf_hi(w.w)};
                    pg8::f32x4 c0 = acc[ai][bj][mb + m][0], c1 = acc[ai][bj][mb + m][1];
                    if constexpr (Q_MDN == 2) { c0 = c0 - ACC_BIAS; c1 = c1 - ACC_BIAS; }
                    const pg8::f32x4 o0 = x0 + gl[m][bj][0] * pv[m] * c0, o1 = x1 + gl[m][bj][1] * pv[m] * c1;
                    v4u r; r.x = pk2(o0[0], o0[1]); r.y = pk2(o0[2], o0[3]); r.z = pk2(o1[0], o1[1]); r.w = pk2(o1[2], o1[3]);
                    if (y1mode) *(v4u*)(y1 + (size_t)t * D + col0 + bj * 128) = r; else *(v4u*)(x + (size_t)t * XLD + col0 + bj * 128) = r; } } }
            asm volatile("" ::: "memory");
        }
    }
};

__device__ __forceinline__ void p_final_norm(Frame& F, float* x, const float* w, const bf16* y1, const unsigned char* flag) {
    const int gw = F.bid * NWAVES + F.wave, NGW = F.G * NWAVES, lane = F.lane;
    f32x4 wv[4];
#pragma unroll
    for (int j = 0; j < 4; ++j) wv[j] = ((const f32x4*)w)[lane + 64 * j];
    for (int r0 = gw * 4; r0 < M; r0 += NGW * 4) {
        f32x4 v[4][4];
#pragma unroll
        for (int r = 0; r < 4; ++r)
#pragma unroll
            for (int j = 0; j < 4; ++j) v[r][j] = load_x4<true>(x, (size_t)(r0 + r), lane, j);
#pragma unroll
        for (int r = 0; r < 4; ++r) if (flag[r0 + r]) {
#pragma unroll
            for (int j = 0; j < 4; ++j) { const v2u_p1 yw = ((const v2u_p1*)(y1 + (size_t)(r0 + r) * D))[lane + 64 * j]; v[r][j] += (f32x4){bf_lo(yw.x), bf_hi(yw.x), bf_lo(yw.y), bf_hi(yw.y)}; } }
        asm volatile("s_waitcnt vmcnt(0)" ::: "memory");
#pragma unroll
        for (int r = 0; r < 4; ++r) { float s = 0.f;
#pragma unroll
            for (int j = 0; j < 4; ++j) s += (v[r][j].x * v[r][j].x + v[r][j].y * v[r][j].y) + (v[r][j].z * v[r][j].z + v[r][j].w * v[r][j].w);
            const float rstd = 1.0f / sqrtf(wave_sum(s, lane) * (1.0f / D) + EPS);
#pragma unroll
            for (int j = 0; j < 4; ++j) ((f32x4*)(x + (size_t)(r0 + r) * D))[lane + 64 * j] = v[r][j] * rstd * wv[j]; }
    }
}
__device__ __forceinline__ bool fresh(Frame& F) {
    int w_ = F.w0, b_ = blockIdx.x, g_ = gridDim.x; asm volatile("" : "+s"(w_), "+s"(b_), "+s"(g_));
    int l_; asm volatile("v_mbcnt_lo_u32_b32 %0, -1, 0\n\tv_mbcnt_hi_u32_b32 %0, -1, %0" : "=v"(l_));
    int t_ = w_ * 64 + l_;
    F.tid = t_; F.lane = t_ & 63; F.wave = __builtin_amdgcn_readfirstlane(t_ >> 6); F.bid = b_; F.G = g_; return true;
}
constexpr int NPL = 13, NPHASE = 1 + DEPTH * NPL;
#if MK_PER_PHASE
#define GRID_BAR() do { } while (0)
#else
#define GRID_BAR() do { XcdBarrier b2_ = bar; asm volatile("" : "+s"(b2_.bar)); xcd_barrier(b2_); } while (0)
#endif
#ifdef ONLY_REL
#define IN(k) (KA()->ph_lo <= (k) && (k) < KA()->ph_hi && fresh(F) && ((k) == 0 ? 100 : ((k) - 1) % NPL) == ONLY_REL && (ONLY_L < 0 || ((k) - 1) / NPL == ONLY_L))
#else
#define IN(k) (KA()->ph_lo <= (k) && (k) < KA()->ph_hi && fresh(F))
#endif
#define SEAM(k) do { if ((k) + 1 < KA()->ph_hi) GRID_BAR(); } while (0)
template <int l>
__device__ __forceinline__ void layer_program(Frame& F, const XcdBarrier& bar, PG8_LAS unsigned char* ring) {
        const int pb = 1 + l * NPL;
#define WSP(off) (ka->ws + (off))
#define QSV(slot) (((const float*)WSP(WS_QS))[slot])
#define MODL ((const float*)WSP(WS_MOD) + (size_t)l * BATCH * MOD_LD)
#define WMIXL ((bf16*)WSP(WS_WMIX))
        if (IN(pb + 0)) {
#pragma unroll 1
          for (int rep = 0; rep < REPS(7); ++rep) { KArgs ka = KA(); p_norm<HQ_MIX == 0 ? 0 : (H_BF ? 2 : 1), l != 0, HQ_MIX ? HQ_MIX : 2>(F, l == 0 ? (const void*)ka->in[0] : (const void*)ka->out, ka->in[4] + l * D, MODL, 1 * D, 0, (HQ_MIX && !H_BF) ? (bf16*)WSP(WS_H8) : (bf16*)WSP(WS_H), WSP(WS_H8), sa_of(HQ_MIX, l == 0 ? CLIP_MIX0 : CLIP_MIX1)); }
          SEAM(pb + 0); }
        if (IN(pb + 1)) {
            KArgs ka = KA();
            constexpr int KD = Q_PROJ ? D / 2 : D;
            pg8::Gemm g{Q_PROJ ? (bf16*)WSP(WS_H8) : (bf16*)WSP(WS_H), WMIXL, KD, KD, KD}; pg8::StaticOrder S; S.init(M / 256, N_BCA / 256, F.G, F.bid);
            EpiP1<Q_PROJ> E{WSP(WS_P1), uni((Q_PROJ ? 1.0f / (sa_of(Q_PROJ, l == 0 ? CLIP_MIX0 : CLIP_MIX1) * (Q_PROJ == 2 ? QSV(QS_IN) : F8_SW)) : 1.0f) / (float)REPS(8) / (float)REPS(15))};
#pragma unroll 1
            for (int rep = 0; rep < REPS(3); ++rep)
            { stagger_wait(F.bid, 10); pg8::gemm_phase<REPS(8), Q_PROJ, REPS(15)>(ring, g, S, E, F.tid); } SEAM(pb + 1);
        }
        if (IN(pb + 2)) {
#define THIN_H1() { KArgs ka = KA(); p_hgrn1(F, (const bf16*)WSP(WS_P1), ka->in[8], l, (float*)WSP(WS_HU), (float*)WSP(WS_HD)); }
#define THIN_SC() { { KArgs ka = KA(); p_sgu(F, (const bf16*)WSP(WS_P1), ka->in[10] + l * D_C, ka->in[11] + (size_t)l * 4 * 128 * 128, ka->in[12] + l * 4 * 128, (bf16*)WSP(WS_YC)); } \
                    { KArgs ka = KA(); p_conv(F, (const bf16*)WSP(WS_P1), ka->in[7] + l * 3 * D_A, (bf16*)WSP(WS_YA)); } }
#pragma unroll 1
          for (int rep = 0; rep < REPS(1); ++rep) {
            __syncthreads();
            if ((F.bid >> 3) & 1) { THIN_H1(); __syncthreads(); fresh(F); THIN_SC(); }
            else { THIN_SC(); __syncthreads(); fresh(F); THIN_H1(); }
          }
#undef THIN_H1
#undef THIN_SC
            SEAM(pb + 2);
        }
        if (IN(pb + 3)) {
#pragma unroll 1
          for (int rep = 0; rep < REPS(2); ++rep)
            { KArgs ka = KA(); p_hgrn<2>(F, (const bf16*)WSP(WS_P1), ka->in[8], l, ka->in[9] + l * D_BV, (bf16*)WSP(WS_YB), (float*)WSP(WS_HU), (float*)WSP(WS_HD)); }
            SEAM(pb + 3);
        }
        if (IN(pb + 5)) {
            { KArgs ka = KA();
              pg8::GateOrder S; S.so.init(M / 256, D / 256, F.G, F.bid);
              if constexpr (Q_GATE != 0) { pg8::Gemm g{(bf16*)WSP(WS_H8), (bf16*)WSP(WS_WMIX + WMIX_G8), D / 2, D / 2, D / 2};
                  EpiGateU8<Q_GATE> E{(unsigned char*)WSP(WS_PG), uni(1.0f / (sa_of(Q_GATE, l == 0 ? CLIP_MIX0 : CLIP_MIX1) * (Q_GATE == 2 ? QSV(QS_IN) : F8_SW)))};
                  pg8::gemm_phase<1, Q_GATE>(ring, g, S, E, F.tid); }
              else { pg8::Gemm g{(bf16*)WSP(WS_H), WMIXL + (size_t)N_BCA * D, D, D, D};
                  pg8::EpiBf16<0> E{(bf16*)WSP(WS_PG), N_G, 1.0f};
                  pg8::gemm_phase(ring, g, S, E, F.tid); } }
            { KArgs ka = KA();
              constexpr int KB = Q_BR ? 256 : 512;
              pg8::Gemm g{(bf16*)WSP(WS_YA), WMIXL + (size_t)N_IN * D, KB, KB, KB, (size_t)32 * MiB, (size_t)512 * 1024 * (Q_BR ? 1 : 2)}; pg8::BranchOrder S; S.so.init(M / 256, D / 256, F.G, F.bid);
              static_assert(Q_GATE != 0 && Q_WO == 2, "the byte running sums need u8 gates and an int8 w_o GEMM");
              EpiBranch8<Q_BR> E{(const unsigned char*)WSP(WS_PG), (const float*)WSP(WS_QS) + QS_BR, WSP(WS_MRG8)};
              pg8::gemm_phase<1, Q_BR>(ring, g, S, E, F.tid); }
            SEAM(pb + 5);
        }
        if (IN(pb + 6)) {
            KArgs ka = KA();
            constexpr int KO = Q_WO ? D / 2 : D;
            pg8::Gemm g{Q_WO ? (bf16*)WSP(WS_MRG8) : (bf16*)WSP(WS_MRG), WMIXL + (size_t)N_IN * D + 3 * 512 * 1024, KO, KO, KO}; pg8::StaticOrder S; S.init(M / 256, D / 256, F.G, F.bid);
            EpiResid<l == 0, Q_WO> E{l == 0 ? (const void*)ka->in[0] : (const void*)ka->out, (bf16*)ka->out, MODL + 2 * D, Q_WO == 2 ? CLIP_MRG / 127.0f : 1.0f, Q_WO == 2 ? uni(QSV(QS_WO)) : 1.0f};
            pg8::gemm_phase<1, Q_WO>(ring, g, S, E, F.tid); SEAM(pb + 6);
        }
        if (l == 0) {
            constexpr int FES = Q_FUP ? 1 : 2, FDS = Q_FDN ? 1 : 2;
            if (IN(pb + 7)) { KArgs ka = KA(); p_norm<Q_FUP ? 1 : 0, true, Q_FUP ? Q_FUP : 2>(F, (const void*)ka->out, ka->in[5] + l * D, MODL, 4 * D, 3 * D, (bf16*)WSP(WS_H), nullptr, sa_of(Q_FUP, CLIP_FFN)); __syncthreads(); p_convert_mixer(F, KA(), 1, false);     SEAM(pb + 7); }
            if (IN(pb + 8)) {
                KArgs ka = KA();
                pg8::Gemm g{(bf16*)WSP(WS_H), (bf16*)WSP(WS_W13), D * FES / 2, D * FES / 2, D * FES / 2}; pg8::StaticOrder S; S.init(M / 256, N13 / 256, F.G, F.bid);
                EpiSwiglu<Q_FUP, Q_FDN> E{(bf16*)WSP(WS_ACT), uni(1.0f / (sa_of(Q_FUP, CLIP_FFN) * QSV(QS_F13)))};
                pg8::gemm_phase<1, Q_FUP>(ring, g, S, E, F.tid); SEAM(pb + 8);
            }
            if (IN(pb + 9)) {
                KArgs ka = KA();
                pg8::Gemm g{(bf16*)WSP(WS_ACT), (bf16*)WSP(WS_W2), D_FF * FDS / 2, D_FF * FDS / 2, D_FF * FDS / 2}; pg8::StaticOrder S; S.init(M / 256, D / 256, F.G, F.bid);
                EpiResid<false, Q_FDN> E{(const void*)ka->out, (bf16*)ka->out, MODL + 5 * D, Q_FDN == 2 ? CLIP_ACT / 127.0f : (Q_FDN ? 1.0f / (F8_SACT * F8_SW) : 1.0f), Q_FDN == 2 ? uni(QSV(QS_F2)) : 1.0f};
                pg8::gemm_phase<1, Q_FDN>(ring, g, S, E, F.tid); SEAM(pb + 9);
            }
        } else {
            if (IN(pb + 7)) {
#pragma unroll 1
                for (int rep = 0; rep < REPS(6); ++rep) { __syncthreads(); p_moe_weights(F, KA()); }
                __syncthreads(); { KArgs ka = KA(); p_norm_router(F, ka, (const void*)ka->out, ka->in[5] + l * D, MODL, (bf16*)WSP(WS_H2M)); } SEAM(pb + 7); }
            constexpr size_t ACT_BYTES = (size_t)MOE_ROWS * D_FF * MOE_ES;
#define MOE_UP(pass_, T_, HC_, pm0_, npan_) do { KArgs ka = KA(); \
                    const LAS int* tab = (const LAS int*)(F.lds + TAB_OFF) + (pass_) * 256; \
                    MoeOrder<true> S; S.so.init((npan_), N13 / 256, F.G, F.bid); S.pm0 = (pm0_); S.tab = tab; S.list = (const int*)WSP(WS_LIST) + (size_t)(pass_) * 8 * LIST_CAP; S.npn = N13 / 256; S.rowbytes = D * MOE_ES; S.T = (T_); S.HC = (HC_); \
                    pg8::Gemm g{(bf16*)WSP(WS_H2M), (bf16*)WSP(WS_WM13), D * MOE_ES / 2, D * MOE_ES / 2, D * MOE_ES / 2}; \
                    EpiSwiglu<Q_MUP, Q_MDN> E{(bf16*)WSP(WS_ACTM + (pass_) * ACT_BYTES), uni(1.0f / (sa_of(Q_MUP, CLIP_MOE) * QSV(QS_M13)))}; \
                    pg8::gemm_phase<1, Q_MUP>(ring, g, S, E, F.tid); } while (0)
#define MOE_DOWN(pass_, pm0_, npan_, y1m_, T_, HC_) do { KArgs ka = KA(); \
                    const LAS int* tab = (const LAS int*)(F.lds + TAB_OFF) + (pass_) * 256; \
                    MoeOrder<false> S; S.so.init((npan_), D / 256, F.G, F.bid); S.pm0 = (pm0_); S.T = (T_); S.HC = (HC_); S.tab = tab; S.list = (const int*)WSP(WS_LIST) + (size_t)(pass_) * 8 * LIST_CAP; S.npn = D / 256; S.rowbytes = 0; \
                    pg8::Gemm g{(bf16*)WSP(WS_ACTM + (pass_) * ACT_BYTES), (bf16*)WSP(WS_WM2), D_FF * MOE_ES / 2, D_FF * MOE_ES / 2, D_FF * MOE_ES / 2}; \
                    EpiMoeDown E{(bf16*)ka->out, MODL + 5 * D, (const float*)WSP(WS_TOPP), (pass_), tab, S.list, Q_MDN == 2 ? uni(CLIP_ACT / (127.0f * QSV(QS_M2))) : 1.0f / (F8_SACT * F8_SW), (bf16*)WSP(WS_Y1), (unsigned char*)WSP(WS_CTL + CTL_FLAG), (y1m_)}; \
                    pg8::gemm_phase<1, Q_MDN>(ring, g, S, E, F.tid); } while (0)
#define MOE_NP(pass_) (((const LAS int*)(F.lds + TAB_OFF))[(pass_) * 256 + 16])
            if (IN(pb + 8)) { { KArgs ka = KA(); moe_tables(F, (unsigned*)WSP(WS_CTL), 0); moe_tables(F, (unsigned*)WSP(WS_CTL), 1); }
                MOE_UP(0, 0, 0, 0, MOE_NP(0));
                { const int nx = MOE_NP(1) > MOE_XP ? MOE_NP(1) - MOE_XP : 0, nu0 = MOE_NP(0) * (N13 / 256);
                  MOE_UP(1, nu0 % F.G, 1, MOE_XP, nx); }
                SEAM(pb + 8); }
            if (IN(pb + 9)) {
                { KArgs ka = KA(); moe_tables(F, (unsigned*)WSP(WS_CTL), 0); moe_tables(F, (unsigned*)WSP(WS_CTL), 1); }
                MOE_DOWN(0, 0, MOE_NP(0), 0, 0, 0);
                { const int nx = MOE_NP(1) > MOE_XP ? MOE_NP(1) - MOE_XP : 0, nd0 = MOE_NP(0) * (D / 256);
                  MOE_DOWN(1, MOE_XP, nx, 1, nd0 % F.G, 1);
                  const int ndt = nd0 + nx * (D / 256);
                  MOE_UP(1, ndt % F.G, 3, 0, MOE_NP(1) < MOE_XP ? MOE_NP(1) : MOE_XP); }
                SEAM(pb + 9);
            }
            if (IN(pb + 11)) { { KArgs ka = KA(); moe_tables(F, (unsigned*)WSP(WS_CTL), 1); } MOE_DOWN(1, 0, MOE_NP(1) < MOE_XP ? MOE_NP(1) : MOE_XP, 0, 0, 0); SEAM(pb + 11); }
#undef MOE_NP
#undef MOE_UP
#undef MOE_DOWN
            if (IN(pb + 12)) { KArgs ka = KA(); p_final_norm(F, ka->out, ka->in[25], (const bf16*)WSP(WS_Y1), (const unsigned char*)WSP(WS_CTL + CTL_FLAG)); }
        }
}
__global__ void __launch_bounds__(NT, 2) fwd(Args args) {
    extern __shared__ __attribute__((aligned(16))) unsigned char lds[];
    Frame F;
    F.lds = (LAS unsigned char*)lds;
    F.tid = threadIdx.x; F.lane = F.tid & 63; F.wave = __builtin_amdgcn_readfirstlane(F.tid >> 6); F.w0 = F.wave;
    F.G = gridDim.x; F.bid = blockIdx.x;
    volatile LAS unsigned* MISC = (volatile LAS unsigned*)(F.lds + MISC_OFF);
    if (F.tid < 32) MISC[F.tid] = 0u;
    __syncthreads();
#if !MK_PER_PHASE
    XcdBarrier bar = xcd_barrier_post((unsigned*)(KA()->ws + WS_CTL) + CW_BAR, MISC + 8);
#else
    XcdBarrier bar; bar.bar = nullptr; bar.x = 0; bar.st = nullptr;
#endif
    PG8_LAS unsigned char* ring = (PG8_LAS unsigned char*)lds;

    if (IN(0)) {
#pragma unroll 1
        for (int rep = 0; rep < REPS(5); ++rep) { __syncthreads(); p_prologue(F, KA()); __syncthreads(); p_convert_mixer(F, KA(), 0, true); }
        SEAM(0); }

    layer_program<0>(F, bar, ring);
    layer_program<1>(F, bar, ring);
#undef IN
#undef SEAM
}

extern "C" void kernel_launch(void* const* d_in, const int* in_sizes, int n_in, void* d_out, int out_size, void* d_ws, size_t ws_size, hipStream_t stream) {
    static int grid = 0;
    if (grid == 0) {
        if (n_in != 26 || in_sizes[0] != M * D || out_size != M * D || ws_size < WS_NEED) { fprintf(stderr, "kernel_launch: unexpected shapes / workspace (n_in %d, ws %zu, need %zu); nothing launched\n", n_in, ws_size, (size_t)WS_NEED); grid = -1; return; }
        int dev = 0, cus = 0, per_cu = 0;
        if (hipGetDevice(&dev) != hipSuccess || hipDeviceGetAttribute(&cus, hipDeviceAttributeMultiprocessorCount, dev) != hipSuccess) { grid = -1; return; }
        if (hipFuncSetAttribute((const void*)fwd, hipFuncAttributeMaxDynamicSharedMemorySize, LDS_BYTES) != hipSuccess) { fprintf(stderr, "kernel_launch: hipFuncSetAttribute failed\n"); grid = -1; return; }
        if (hipOccupancyMaxActiveBlocksPerMultiprocessor(&per_cu, (const void*)fwd, NT, LDS_BYTES) != hipSuccess || per_cu < 1) fprintf(stderr, "kernel_launch: occupancy query reports %d\n", per_cu);
        (void)hipGetLastError();
        grid = cus;
    }
    if (grid < 0) return;
    if (hipMemsetAsync((char*)d_ws + WS_CTL, 0, CTL_ZERO_BYTES, stream) != hipSuccess) return;
    Args a{};
    for (int i = 0; i < 26; ++i) a.in[i] = (const float*)d_in[i];
    a.out = (float*)d_out; a.ws = (unsigned char*)d_ws;
#if MK_PER_PHASE
    for (int p = 0; p < NPHASE; ++p) {
        if ((p >= 1 + 10 && p <= 1 + 12) || p == 1 + 4 || p == 1 + NPL + 4 || p == 1 + NPL + 10) continue;
        a.ph_lo = p; a.ph_hi = p + 1;
        hipLaunchKernelGGL(fwd, dim3(grid), dim3(NT), LDS_BYTES, stream, a);
    }
#else
    a.ph_lo = 0; a.ph_hi = NPHASE;
    hipLaunchKernelGGL(fwd, dim3(grid), dim3(NT), LDS_BYTES, stream, a);
#endif
}
```
